# Optimizing an MI355X kernel written in HIP

```python
import jax
import jax.numpy as jnp
from jax import lax
import numpy as np

D_MODEL = 1024
BATCH = 2
SEQ = 8192
DEPTH = 4

N_HEADS = 4
HEAD_DIM = 64
BR_WIDTH = N_HEADS * HEAD_DIM
N_BRANCH = 5
N_MEM = 256
ROPE_THETA = 10000.0
EPS = 1e-6
Q_BLOCK = 128
DSA_TOPK_MAX = 256
IDX_HEADS = 4
IDX_DIM = 32
KV_LATENT = 128
NSA_KV_DIM = 64
CMP_LEN = 32
CMP_STRIDE = 16
CMP_HIDDEN = 128
SLC_BLOCK = 64
SLC_TOPN = 16
WINDOW = 512
FORCE_SCORE = 1e4

IN_LAYOUT = (
    ('dsa_q', BR_WIDTH), ('dsa_ckv', KV_LATENT), ('idx_q', IDX_HEADS * IDX_DIM), ('idx_k', IDX_DIM), ('idx_w', IDX_HEADS), ('dsa_z', BR_WIDTH),
    ('fox_q', BR_WIDTH), ('fox_k', BR_WIDTH), ('fox_v', BR_WIDTH), ('fox_f', N_HEADS), ('fox_z', BR_WIDTH),
    ('sb_q', BR_WIDTH), ('sb_k', BR_WIDTH), ('sb_v', BR_WIDTH), ('sb_z', BR_WIDTH),
    ('nsa_q', BR_WIDTH), ('nsa_kc', NSA_KV_DIM), ('nsa_vc', NSA_KV_DIM), ('nsa_ks', NSA_KV_DIM), ('nsa_vs', NSA_KV_DIM),
    ('nsa_kw', NSA_KV_DIM), ('nsa_vw', NSA_KV_DIM), ('nsa_g', 3 * N_HEADS), ('nsa_z', BR_WIDTH),
    ('mem_q', BR_WIDTH), ('mem_z', BR_WIDTH),
    ('merge', N_BRANCH * D_MODEL),
)
N_IN = sum(n for _, n in IN_LAYOUT)

kernel_name = 'gated_parallel_hybrid_trunk'


def _rmsnorm(x, g):
    xf = x.astype(jnp.float32)
    y = xf * lax.rsqrt(jnp.mean(xf * xf, axis=-1, keepdims=True) + EPS)
    return (y * g.astype(jnp.float32)).astype(x.dtype)


def _rope(x, pos):
    dh = x.shape[-1]
    inv = ROPE_THETA ** (-jnp.arange(0, dh, 2, dtype=jnp.float32) / dh)
    ang = pos.astype(jnp.float32)[..., None] * inv
    ang = ang.reshape(ang.shape[:2] + (1,) * (x.ndim - 3) + ang.shape[-1:])
    cos, sin = jnp.cos(ang), jnp.sin(ang)
    xf = x.astype(jnp.float32)
    x1, x2 = xf[..., : dh // 2], xf[..., dh // 2:]
    return jnp.concatenate([x1 * cos - x2 * sin, x2 * cos + x1 * sin], axis=-1).astype(x.dtype)


def _masked_softmax(logits, mask):
    l = jnp.where(mask, logits, -jnp.inf)
    m = jnp.max(l, axis=-1, keepdims=True)
    m = jnp.where(jnp.isfinite(m), m, 0.0)
    e = jnp.where(mask, jnp.exp(l - m), 0.0)
    return e / jnp.maximum(jnp.sum(e, axis=-1, keepdims=True), 1e-30)


def _to_blocks(a):
    b, s = a.shape[:2]
    return jnp.moveaxis(a.reshape((b, s // Q_BLOCK, Q_BLOCK) + a.shape[2:]), 1, 0)


def _from_blocks(a):
    nq, b, q = a.shape[:3]
    return jnp.moveaxis(a, 0, 1).reshape((b, nq * q) + a.shape[3:])


def _gather_rows(table, idx):
    return jax.vmap(lambda tb, ib: tb[ib])(table, idx)


def _split_columns(p):
    out, off = {}, 0
    for name, n in IN_LAYOUT:
        out[name] = p[..., off:off + n]
        off += n
    return out


def _dsa_attention(q, k, v, qi, ki, wi):
    B, S, H, Dh = q.shape
    k_sel = min(DSA_TOPK_MAX, S // 4)
    s_pos = jnp.arange(S)
    scale = Dh ** -0.5
    idx_scale = (IDX_DIM ** -0.5) * (IDX_HEADS ** -0.5)

    def block(args):
        qb, q_blk, qi_blk, wi_blk = args
        t = qb * Q_BLOCK + jnp.arange(Q_BLOCK)
        rel = jax.nn.relu(jnp.einsum('bqhd,bsd->bqhs', qi_blk, ki).astype(jnp.float32))
        score = jnp.einsum('bqhs,bqh->bqs', rel, wi_blk.astype(jnp.float32)) * idx_scale
        score = jnp.where(s_pos[None, None, :] <= t[None, :, None], score, -jnp.inf)
        _, sel = lax.top_k(score, k_sel)
        kg = _gather_rows(k, sel)
        vg = _gather_rows(v, sel)
        logits = jnp.einsum('bqhd,bqkhd->bhqk', q_blk, kg).astype(jnp.float32) * scale
        mask = (sel <= t[None, :, None])[:, None]
        p = _masked_softmax(logits, mask).astype(v.dtype)
        return jnp.einsum('bhqk,bqkhd->bqhd', p, vg)

    out = lax.map(block, (jnp.arange(S // Q_BLOCK), _to_blocks(q), _to_blocks(qi), _to_blocks(wi)))
    return _from_blocks(out)


def _fox_attention(q, k, v, log_f):
    B, S, H, Dh = q.shape
    s_pos = jnp.arange(S)
    scale = Dh ** -0.5
    cum = jnp.cumsum(log_f.astype(jnp.float32), axis=1)
    cum_s = jnp.moveaxis(cum, 1, 2)

    def block(args):
        qb, q_blk, c_blk = args
        t = qb * Q_BLOCK + jnp.arange(Q_BLOCK)
        logits = (jnp.einsum('bqhd,bshd->bhqs', q_blk, k).astype(jnp.float32) * scale
                  + jnp.moveaxis(c_blk, 1, 2)[..., None] - cum_s[:, :, None, :])
        mask = (s_pos[None, :] <= t[:, None])[None, None]
        p = _masked_softmax(logits, mask).astype(v.dtype)
        return jnp.einsum('bhqs,bshd->bqhd', p, v)

    out = lax.map(block, (jnp.arange(S // Q_BLOCK), _to_blocks(q), _to_blocks(cum)))
    return _from_blocks(out)


def _stick_breaking_attention(q, k, v):
    B, S, H, Dh = q.shape
    s_pos = jnp.arange(S)
    scale = Dh ** -0.5

    def block(args):
        qb, q_blk = args
        t = qb * Q_BLOCK + jnp.arange(Q_BLOCK)
        z = jnp.einsum('bqhd,bshd->bhqs', q_blk, k).astype(jnp.float32) * scale
        strict = (s_pos[None, :] < t[:, None])[None, None]
        log_keep = jnp.where(strict, jax.nn.log_sigmoid(-z), 0.0)
        later = lax.cumsum(log_keep, axis=3, reverse=True) - log_keep
        a = jnp.where(strict, jnp.exp(jax.nn.log_sigmoid(z) + later), 0.0).astype(v.dtype)
        return jnp.einsum('bhqs,bshd->bqhd', a, v)

    out = lax.map(block, (jnp.arange(S // Q_BLOCK), _to_blocks(q)))
    return _from_blocks(out)


def _nsa_attention(q, kc_tok, vc_tok, ks, vs, kw, vw, gates, pe_k, pe_v, wc1_k, wc2_k, wc1_v, wc2_v):
    B, S, H, Dh = q.shape
    scale = Dh ** -0.5
    n_cmp = (S - CMP_LEN) // CMP_STRIDE + 1
    n_blk = S // SLC_BLOCK
    n_sel = min(SLC_TOPN, n_blk)
    per_blk = SLC_BLOCK // CMP_STRIDE
    tok = (jnp.arange(n_cmp) * CMP_STRIDE)[:, None] + jnp.arange(CMP_LEN)[None, :]

    def compress(x_tok, pe, w1, w2):
        blocks = (x_tok[:, tok] + pe).reshape(B, n_cmp, CMP_LEN * x_tok.shape[-1])
        return jax.nn.silu(blocks @ w1) @ w2

    kc = compress(kc_tok, pe_k, wc1_k, wc2_k)
    vc = compress(vc_tok, pe_v, wc1_v, wc2_v)
    cmp_end = jnp.arange(n_cmp) * CMP_STRIDE + CMP_LEN - 1
    ks_blk = ks.reshape(B, n_blk, SLC_BLOCK, -1)
    vs_blk = vs.reshape(B, n_blk, SLC_BLOCK, -1)
    kw_pad = jnp.pad(kw, ((0, 0), (WINDOW, 0), (0, 0)))
    vw_pad = jnp.pad(vw, ((0, 0), (WINDOW, 0), (0, 0)))
    blk_ids = jnp.arange(n_blk)
    in_blk = jnp.arange(SLC_BLOCK)
    win_off = jnp.arange(WINDOW + Q_BLOCK) - WINDOW

    def block(args):
        qb, q_blk, g_blk = args
        t = qb * Q_BLOCK + jnp.arange(Q_BLOCK)
        lc = jnp.einsum('bqhd,bnd->bhqn', q_blk, kc).astype(jnp.float32) * scale
        pc = _masked_softmax(lc, (cmp_end[None, :] <= t[:, None])[None, None])
        o_cmp = jnp.einsum('bhqn,bnd->bqhd', pc.astype(vc.dtype), vc)
        imp = jnp.pad(jnp.sum(pc, axis=1), ((0, 0), (0, 0), (0, n_blk * per_blk - n_cmp)))
        imp = jnp.sum(imp.reshape(B, Q_BLOCK, n_blk, per_blk), axis=-1)
        cur = t // SLC_BLOCK
        forced = (blk_ids[None, :] == 0) | (blk_ids[None, :] == cur[:, None]) | (blk_ids[None, :] == cur[:, None] - 1)
        visible = blk_ids[None, :] <= cur[:, None]
        imp = jnp.where(forced[None], FORCE_SCORE, jnp.where(visible[None], imp, -1.0))
        _, sel = lax.top_k(imp, n_sel)
        ksg = _gather_rows(ks_blk, sel).reshape(B, Q_BLOCK, n_sel * SLC_BLOCK, -1)
        vsg = _gather_rows(vs_blk, sel).reshape(B, Q_BLOCK, n_sel * SLC_BLOCK, -1)
        pos = (sel[..., None] * SLC_BLOCK + in_blk).reshape(B, Q_BLOCK, n_sel * SLC_BLOCK)
        ls = jnp.einsum('bqhd,bqkd->bhqk', q_blk, ksg).astype(jnp.float32) * scale
        ps = _masked_softmax(ls, (pos <= t[None, :, None])[:, None])
        o_slc = jnp.einsum('bhqk,bqkd->bqhd', ps.astype(vs.dtype), vsg)
        kwb = lax.dynamic_slice_in_dim(kw_pad, qb * Q_BLOCK, WINDOW + Q_BLOCK, axis=1)
        vwb = lax.dynamic_slice_in_dim(vw_pad, qb * Q_BLOCK, WINDOW + Q_BLOCK, axis=1)
        s = qb * Q_BLOCK + win_off
        d = t[:, None] - s[None, :]
        mw = ((d >= 0) & (d < WINDOW) & (s[None, :] >= 0))[None, None]
        lw = jnp.einsum('bqhd,bkd->bhqk', q_blk, kwb).astype(jnp.float32) * scale
        pw = _masked_softmax(lw, mw)
        o_win = jnp.einsum('bhqk,bkd->bqhd', pw.astype(vw.dtype), vwb)
        return (g_blk[:, :, 0, :, None] * o_cmp + g_blk[:, :, 1, :, None] * o_slc
                + g_blk[:, :, 2, :, None] * o_win)

    out = lax.map(block, (jnp.arange(S // Q_BLOCK), _to_blocks(q), _to_blocks(gates)))
    return _from_blocks(out)


def _memory_attention(q, mem_k, mem_v):
    logits = jnp.einsum('bshd,bmhd->bhsm', q, mem_k).astype(jnp.float32) * HEAD_DIM ** -0.5
    p = jax.nn.softmax(logits, axis=-1).astype(mem_v.dtype)
    return jnp.einsum('bhsm,bmhd->bshd', p, mem_v)


def _layer(x, mem, positions, norm_g, w_in, kv_norm, w_uk, w_uv, fox_b, pe_k, pe_v,
           wc1_k, wc2_k, wc1_v, wc2_v, mem_norm, w_mem_kv, w_branch, w_out):
    B, S, _ = x.shape
    h = _rmsnorm(x, norm_g)
    p = _split_columns(h @ w_in)
    heads = lambda a: a.reshape(B, S, N_HEADS, HEAD_DIM)

    c_kv = _rmsnorm(p['dsa_ckv'], kv_norm)
    k_a = _rope(heads(c_kv @ w_uk), positions)
    v_a = heads(c_kv @ w_uv)
    q_a = _rope(heads(p['dsa_q']), positions)
    qi = _rope(p['idx_q'].reshape(B, S, IDX_HEADS, IDX_DIM), positions)
    ki = _rope(p['idx_k'], positions)
    y_a = _dsa_attention(q_a, k_a, v_a, qi, ki, p['idx_w'])

    log_f = jax.nn.log_sigmoid(p['fox_f'].astype(jnp.float32) + fox_b.astype(jnp.float32))
    y_b = _fox_attention(heads(p['fox_q']), heads(p['fox_k']), heads(p['fox_v']), log_f)

    y_c = _stick_breaking_attention(heads(p['sb_q']), heads(p['sb_k']), heads(p['sb_v']))

    q_d = _rope(heads(p['nsa_q']), positions)
    gates = jax.nn.sigmoid(p['nsa_g'].reshape(B, S, 3, N_HEADS))
    y_d = _nsa_attention(q_d, _rope(p['nsa_kc'], positions), p['nsa_vc'],
                         _rope(p['nsa_ks'], positions), p['nsa_vs'],
                         _rope(p['nsa_kw'], positions), p['nsa_vw'], gates,
                         pe_k, pe_v, wc1_k, wc2_k, wc1_v, wc2_v)

    mkv = _rmsnorm(mem, mem_norm) @ w_mem_kv
    mem_k = mkv[..., :BR_WIDTH].reshape(B, -1, N_HEADS, HEAD_DIM)
    mem_v = mkv[..., BR_WIDTH:].reshape(B, -1, N_HEADS, HEAD_DIM)
    y_e = _memory_attention(heads(p['mem_q']), mem_k, mem_v)

    ys = jnp.stack([
        y_a.reshape(B, S, BR_WIDTH) * jax.nn.silu(p['dsa_z']),
        y_b.reshape(B, S, BR_WIDTH) * jax.nn.silu(p['fox_z']),
        y_c.reshape(B, S, BR_WIDTH) * jax.nn.silu(p['sb_z']),
        y_d.reshape(B, S, BR_WIDTH) * jax.nn.silu(p['nsa_z']),
        y_e.reshape(B, S, BR_WIDTH) * jax.nn.silu(p['mem_z']),
    ], axis=2)
    merge = jax.nn.sigmoid(p['merge'].reshape(B, S, N_BRANCH, D_MODEL))
    merged = jnp.sum(merge * jnp.einsum('bsnc,ncd->bsnd', ys, w_branch), axis=2)
    return x + merged @ w_out


def setup_inputs(seed: int = 0) -> dict:
    key = jax.random.key(seed)
    ks = jax.random.split(key, 24)
    f32 = jnp.float32

    def nrm(k, shape, fan_in):
        return jax.random.normal(k, shape, f32) * fan_in ** -0.5

    def gain(k, shape):
        return 1.0 + 0.02 * jax.random.normal(k, shape, f32)

    return {
        'x': jax.random.normal(ks[0], (BATCH, SEQ, D_MODEL), f32),
        'mem': jax.random.normal(ks[1], (BATCH, N_MEM, D_MODEL), f32),
        'positions': jnp.broadcast_to(jnp.arange(SEQ, dtype=jnp.int32), (BATCH, SEQ)),
        'norm_g': gain(ks[2], (DEPTH, D_MODEL)),
        'w_in': nrm(ks[3], (DEPTH, D_MODEL, N_IN), D_MODEL),
        'kv_norm': gain(ks[4], (DEPTH, KV_LATENT)),
        'w_uk': nrm(ks[5], (DEPTH, KV_LATENT, BR_WIDTH), KV_LATENT),
        'w_uv': nrm(ks[6], (DEPTH, KV_LATENT, BR_WIDTH), KV_LATENT),
        'fox_bias': jnp.linspace(1.0, 4.0, N_HEADS, dtype=f32)[None, :] + 0.1 * jax.random.normal(ks[7], (DEPTH, N_HEADS), f32),
        'nsa_pe_k': 0.1 * jax.random.normal(ks[8], (DEPTH, CMP_LEN, NSA_KV_DIM), f32),
        'nsa_pe_v': 0.1 * jax.random.normal(ks[9], (DEPTH, CMP_LEN, NSA_KV_DIM), f32),
        'nsa_wc1_k': nrm(ks[10], (DEPTH, CMP_LEN * NSA_KV_DIM, CMP_HIDDEN), CMP_LEN * NSA_KV_DIM),
        'nsa_wc2_k': nrm(ks[11], (DEPTH, CMP_HIDDEN, NSA_KV_DIM), CMP_HIDDEN),
        'nsa_wc1_v': nrm(ks[12], (DEPTH, CMP_LEN * NSA_KV_DIM, CMP_HIDDEN), CMP_LEN * NSA_KV_DIM),
        'nsa_wc2_v': nrm(ks[13], (DEPTH, CMP_HIDDEN, NSA_KV_DIM), CMP_HIDDEN),
        'mem_norm': gain(ks[14], (DEPTH, D_MODEL)),
        'w_mem_kv': nrm(ks[15], (DEPTH, D_MODEL, 2 * BR_WIDTH), D_MODEL),
        'w_branch': nrm(ks[16], (DEPTH, N_BRANCH, BR_WIDTH, D_MODEL), BR_WIDTH),
        'w_out': nrm(ks[17], (DEPTH, D_MODEL, D_MODEL), D_MODEL),
        'final_norm': gain(ks[18], (D_MODEL,)),
    }


def reference(x, mem, positions, norm_g, w_in, kv_norm, w_uk, w_uv, fox_bias, nsa_pe_k, nsa_pe_v,
              nsa_wc1_k, nsa_wc2_k, nsa_wc1_v, nsa_wc2_v, mem_norm, w_mem_kv, w_branch, w_out, final_norm):
    for l in range(DEPTH):
        x = _layer(x, mem, positions, norm_g[l], w_in[l], kv_norm[l], w_uk[l], w_uv[l], fox_bias[l],
                   nsa_pe_k[l], nsa_pe_v[l], nsa_wc1_k[l], nsa_wc2_k[l], nsa_wc1_v[l], nsa_wc2_v[l],
                   mem_norm[l], w_mem_kv[l], w_branch[l], w_out[l])
    return _rmsnorm(x, final_norm)
```

```cpp
#include <hip/hip_runtime.h>
#include <stdint.h>
#include <math.h>

namespace {
constexpr int S = 8192, NBATCH = 2, T = NBATCH * S, D = 1024, NIN = 9396, NM = 4276, DEPTH = 4, NMEM = 256;
constexpr int NCMP = 511, NCMP_PAD = 512;
constexpr int C_DSA_Q = 0, C_CKV = 256, C_IDXQ = 384, C_IDXK = 512, C_IDXW = 544, C_DSA_Z = 548,
              C_FOX_Q = 804, C_FOX_K = 1060, C_FOX_V = 1316, C_FOX_F = 1572, C_FOX_Z = 1576,
              C_SB_Q = 1832, C_SB_K = 2088, C_SB_V = 2344, C_SB_Z = 2600,
              C_NSA_Q = 2856, C_NSA_KC = 3112, C_NSA_VC = 3176, C_NSA_KS = 3240, C_NSA_VS = 3304, C_NSA_KW = 3368, C_NSA_VW = 3432,
              C_NSA_G = 3496, C_NSA_Z = 3508, C_MEM_Q = 3764, C_MEM_Z = 4020, C_MERGE = 4276;

struct Params {
    const float* x; const float* mem; const int* pos; const float* norm_g; const float* w_in; const float* kv_norm;
    const float* w_uk; const float* w_uv; const float* fox_bias; const float* pe_k; const float* pe_v;
    const float* wc1_k; const float* wc2_k; const float* wc1_v; const float* wc2_v; const float* mem_norm;
    const float* w_mem_kv; const float* w_branch; const float* w_out; const float* final_norm;
    float* X;
    float *H, *P, *CKV, *KA, *VA, *LOGF, *CUM, *KC, *VC, *OCMP, *Y, *YB, *MG, *MEMN, *MKV, *ROPE;
    int* DSEL; int* DCNT; unsigned* SMASK;
};

__device__ __forceinline__ float sigmoid_(float x) { return 1.f / (1.f + expf(-x)); }
__device__ __forceinline__ float silu_(float x) { return x / (1.f + expf(-x)); }
__device__ __forceinline__ float logsig_(float x) { return fminf(x, 0.f) - log1pf(expf(-fabsf(x))); }
__device__ __forceinline__ float wave_sum(float v) {
#pragma unroll
    for (int o = 32; o > 0; o >>= 1) v += __shfl_xor(v, o, 64);
    return v;
}
__device__ __forceinline__ float wave_max(float v) {
#pragma unroll
    for (int o = 32; o > 0; o >>= 1) v = fmaxf(v, __shfl_xor(v, o, 64));
    return v;
}

__device__ void ph_rope_table(const Params& p, int bid, int nb) {
    for (int i = bid * 256 + threadIdx.x; i < T * 32; i += nb * 256) {
        const int t = i >> 5, f = i & 31;
        const double inv = pow(10000.0, -(double)f / 32.0);
        const double ang = (double)p.pos[t] * inv;
        p.ROPE[(size_t)t * 64 + f] = (float)cos(ang);
        p.ROPE[(size_t)t * 64 + 32 + f] = (float)sin(ang);
    }
}

__device__ void ph_rmsnorm(const float* in, const float* g, float* out, int rows, int bid, int nb) {
    const int lane = threadIdx.x & 63, wid = threadIdx.x >> 6;
    for (int r = bid * 4 + wid; r < rows; r += nb * 4) {
        const float4* ip = (const float4*)(in + (size_t)r * D);
        float4 v[4]; float ss = 0.f;
#pragma unroll
        for (int i = 0; i < 4; ++i) { v[i] = ip[lane + 64 * i]; ss += v[i].x * v[i].x + v[i].y * v[i].y + v[i].z * v[i].z + v[i].w * v[i].w; }
        ss = wave_sum(ss);
        const float sc = 1.0f / sqrtf(ss * (1.f / D) + 1e-6f);
        float4* op = (float4*)(out + (size_t)r * D);
#pragma unroll
        for (int i = 0; i < 4; ++i) {
            const float4 gg = ((const float4*)g)[lane + 64 * i];
            float4 o; o.x = v[i].x * sc * gg.x; o.y = v[i].y * sc * gg.y; o.z = v[i].z * sc * gg.z; o.w = v[i].w * sc * gg.w;
            op[lane + 64 * i] = o;
        }
    }
}

__device__ void ph_ckvnorm(const Params& p, int layer, int bid, int nb) {
    const int lane = threadIdx.x & 63, wid = threadIdx.x >> 6;
    const float* g = p.kv_norm + layer * 128;
    for (int r = bid * 4 + wid; r < T; r += nb * 4) {
        const float* ip = p.P + (size_t)r * NM + C_CKV;
        const float a = ip[lane], b = ip[lane + 64];
        const float ss = wave_sum(a * a + b * b);
        const float sc = 1.0f / sqrtf(ss * (1.f / 128.f) + 1e-6f);
        p.CKV[(size_t)r * 128 + lane] = a * sc * g[lane];
        p.CKV[(size_t)r * 128 + lane + 64] = b * sc * g[lane + 64];
    }
}

struct EpiStore { float* C; int ldc; __device__ __forceinline__ void operator()(int r, int c, float v) const { C[(size_t)r * ldc + c] = v; } };
struct EpiMerge { float* M; const float* YB; int first;
    __device__ __forceinline__ void operator()(int r, int c, float v) const {
        const size_t i = (size_t)r * D + c; const float y = YB[i] * sigmoid_(v); M[i] = first ? y : (M[i] + y); } };
struct EpiResid { const float* Xin; float* Xout;
    __device__ __forceinline__ void operator()(int r, int c, float v) const { const size_t i = (size_t)r * D + c; Xout[i] = Xin[i] + v; } };

template <class Epi>
__device__ void gemm_f32(const float* __restrict__ A, int lda, const float* __restrict__ B, int ldb, int M, int N, int K, const Epi& epi, int bid, int nb, float* sm) {
    float (*As)[68] = (float (*)[68])sm;
    float (*Bs)[68] = (float (*)[68])(sm + 16 * 68);
    const int tid = threadIdx.x, tx = tid & 15, ty = tid >> 4;
    const int tm = M / 64, tn = (N + 63) / 64;
    for (int tile = bid; tile < tm * tn; tile += nb) {
        const int m0 = (tile % tm) * 64, n0 = (tile / tm) * 64;
        float acc[4][4];
#pragma unroll
        for (int i = 0; i < 4; ++i)
#pragma unroll
            for (int j = 0; j < 4; ++j) acc[i][j] = 0.f;
        for (int k0 = 0; k0 < K; k0 += 16) {
            {
                const int r = tid >> 2, kc = (tid & 3) * 4;
                const float4 a = *(const float4*)(A + (size_t)(m0 + r) * lda + k0 + kc);
                As[kc + 0][r] = a.x; As[kc + 1][r] = a.y; As[kc + 2][r] = a.z; As[kc + 3][r] = a.w;
                const int kr = tid >> 4, c = (tid & 15) * 4;
                float4 b = make_float4(0.f, 0.f, 0.f, 0.f);
                if (n0 + c < N) b = *(const float4*)(B + (size_t)(k0 + kr) * ldb + n0 + c);
                *(float4*)&Bs[kr][c] = b;
            }
            __syncthreads();
#pragma unroll
            for (int k = 0; k < 16; ++k) {
                const float4 a = *(const float4*)&As[k][ty * 4];
                const float4 b = *(const float4*)&Bs[k][tx * 4];
                const float av[4] = {a.x, a.y, a.z, a.w}, bv[4] = {b.x, b.y, b.z, b.w};
#pragma unroll
                for (int i = 0; i < 4; ++i)
#pragma unroll
                    for (int j = 0; j < 4; ++j) acc[i][j] = fmaf(av[i], bv[j], acc[i][j]);
            }
            __syncthreads();
        }
#pragma unroll
        for (int i = 0; i < 4; ++i)
#pragma unroll
            for (int j = 0; j < 4; ++j) { const int c = n0 + tx * 4 + j; if (c < N) epi(m0 + ty * 4 + i, c, acc[i][j]); }
    }
}

__device__ __forceinline__ void rope_pair(float* base, int i0, int half, float c, float s) {
    const float x1 = base[i0], x2 = base[i0 + half];
    base[i0] = x1 * c - x2 * s; base[i0 + half] = x2 * c + x1 * s;
}
__device__ void ph_prep(const Params& p, int layer, int bid, int nb) {
    for (int t = bid; t < T; t += nb) {
        float* pr = p.P + (size_t)t * NM;
        const float* rt = p.ROPE + (size_t)t * 64;
        for (int i = threadIdx.x; i < 564; i += 256) {
            if (i < 128) { const int h = i >> 5, f = i & 31; rope_pair(pr + C_DSA_Q + h * 64, f, 32, rt[f], rt[32 + f]); }
            else if (i < 256) { const int j = i - 128, h = j >> 5, f = j & 31; rope_pair(p.KA + (size_t)t * 256 + h * 64, f, 32, rt[f], rt[32 + f]); }
            else if (i < 384) { const int j = i - 256, h = j >> 5, f = j & 31; rope_pair(pr + C_NSA_Q + h * 64, f, 32, rt[f], rt[32 + f]); }
            else if (i < 416) { const int f = i - 384; rope_pair(pr + C_NSA_KC, f, 32, rt[f], rt[32 + f]); }
            else if (i < 448) { const int f = i - 416; rope_pair(pr + C_NSA_KS, f, 32, rt[f], rt[32 + f]); }
            else if (i < 480) { const int f = i - 448; rope_pair(pr + C_NSA_KW, f, 32, rt[f], rt[32 + f]); }
            else if (i < 544) { const int j = i - 480, h = j >> 4, f = j & 15; rope_pair(pr + C_IDXQ + h * 32, f, 16, rt[2 * f], rt[32 + 2 * f]); }
            else if (i < 560) { const int f = i - 544; rope_pair(pr + C_IDXK, f, 16, rt[2 * f], rt[32 + 2 * f]); }
            else { const int h = i - 560; p.LOGF[(size_t)t * 4 + h] = logsig_(pr[C_FOX_F + h] + p.fox_bias[layer * 4 + h]); }
        }
    }
}

__device__ void ph_cumsum(const Params& p, int bid, int nb, float* sm) {
    const int tid = threadIdx.x;
    for (int item = bid; item < NBATCH * 4; item += nb) {
        const int b = item >> 2, h = item & 3;
        const float* src = p.LOGF + (size_t)b * S * 4 + h;
        float* dst = p.CUM + (size_t)b * S * 4 + h;
        float loc = 0.f;
        for (int i = 0; i < 32; ++i) loc += src[(size_t)(tid * 32 + i) * 4];
        sm[tid] = loc; __syncthreads();
        if (tid == 0) { float run = 0.f; for (int i = 0; i < 256; ++i) { const float v = sm[i]; sm[i] = run; run += v; } }
        __syncthreads();
        float run = sm[tid];
        for (int i = 0; i < 32; ++i) { run += src[(size_t)(tid * 32 + i) * 4]; dst[(size_t)(tid * 32 + i) * 4] = run; }
        __syncthreads();
    }
}

__device__ void ph_compress(const Params& p, int layer, int bid, int nb, float* sm) {
    float* xs = sm;
    float* part = sm + 2048;
    float* hid = sm + 2304;
    const int tid = threadIdx.x;
    for (int item = bid; item < 2 * NBATCH * NCMP; item += nb) {
        const int which = item / (NBATCH * NCMP), rem = item % (NBATCH * NCMP), b = rem / NCMP, n = rem % NCMP;
        const int coff = which ? C_NSA_VC : C_NSA_KC;
        const float* pe = (which ? p.pe_v : p.pe_k) + (size_t)layer * 2048;
        const float* w1 = (which ? p.wc1_v : p.wc1_k) + (size_t)layer * 2048 * 128;
        const float* w2 = (which ? p.wc2_v : p.wc2_k) + (size_t)layer * 128 * 64;
        for (int i = tid; i < 2048; i += 256) {
            const int tk = i >> 6, d = i & 63;
            xs[i] = p.P[(size_t)(b * S + 16 * n + tk) * NM + coff + d] + pe[i];
        }
        __syncthreads();
        {
            const int j = tid & 127, hf = tid >> 7;
            float a = 0.f;
            for (int k = hf * 1024; k < hf * 1024 + 1024; ++k) a = fmaf(xs[k], w1[(size_t)k * 128 + j], a);
            part[tid] = a;
        }
        __syncthreads();
        if (tid < 128) hid[tid] = silu_(part[tid] + part[tid + 128]);
        __syncthreads();
        {
            const int d = tid & 63, q = tid >> 6;
            float a = 0.f;
            for (int j = q * 32; j < q * 32 + 32; ++j) a = fmaf(hid[j], w2[j * 64 + d], a);
            part[tid] = a;
        }
        __syncthreads();
        if (tid < 64) {
            float* dst = (which ? p.VC : p.KC) + ((size_t)b * NCMP_PAD + n) * 64;
            dst[tid] = (part[tid] + part[tid + 64]) + (part[tid + 128] + part[tid + 192]);
        }
        __syncthreads();
    }
}

__device__ __forceinline__ int block_excl_scan(int v, int* sh, int tid, int& total) {
    sh[tid] = v; __syncthreads();
    for (int off = 1; off < 256; off <<= 1) { const int t = (tid >= off) ? sh[tid - off] : 0; __syncthreads(); sh[tid] += t; __syncthreads(); }
    const int incl = sh[tid]; total = sh[255]; __syncthreads();
    return incl - v;
}
__device__ void ph_dsa_select(const Params& p, int bid, int nb, float* smf) {
    unsigned* keys = (unsigned*)smf;
    int* hist = (int*)(smf + 8192);
    int* scan = (int*)(smf + 8192 + 256);
    float* qs = smf + 8192 + 512;
    int* ctl = (int*)(smf + 8192 + 512 + 160);
    const int tid = threadIdx.x;
    for (int g = bid; g < T; g += nb) {
        const int b = g / S, t = g % S, n = t + 1;
        if (n <= 256) {
            if (tid < n) p.DSEL[(size_t)g * 256 + tid] = tid;
            if (tid == 0) p.DCNT[g] = n;
            continue;
        }
        const float* pr = p.P + (size_t)g * NM;
        if (tid < 128) qs[tid] = pr[C_IDXQ + tid]; else if (tid < 132) qs[tid] = pr[C_IDXW + tid - 128];
        __syncthreads();
        for (int s = tid; s < n; s += 256) {
            const float4* kp = (const float4*)(p.P + (size_t)(b * S + s) * NM + C_IDXK);
            float kk[32];
#pragma unroll
            for (int i = 0; i < 8; ++i) { const float4 v = kp[i]; kk[4 * i] = v.x; kk[4 * i + 1] = v.y; kk[4 * i + 2] = v.z; kk[4 * i + 3] = v.w; }
            float sc = 0.f;
#pragma unroll
            for (int h = 0; h < 4; ++h) {
                float d = 0.f;
#pragma unroll
                for (int i = 0; i < 32; ++i) d = fmaf(qs[h * 32 + i], kk[i], d);
                sc = fmaf(fmaxf(d, 0.f), qs[128 + h], sc);
            }
            sc = sc * 0.08838834764831845f + 0.0f;
            const unsigned u = __float_as_uint(sc);
            keys[s] = (u & 0x80000000u) ? ~u : (u | 0x80000000u);
        }
        __syncthreads();
        const int chunk = (n + 255) >> 8, lo = tid * chunk, hi = min(n, lo + chunk);
        unsigned prefix = 0; int krem = 256;
        for (int pass = 0; pass < 4; ++pass) {
            const int shift = 24 - 8 * pass;
            hist[tid] = 0; __syncthreads();
            for (int i = lo; i < hi; ++i) {
                const unsigned k = keys[i];
                if (pass == 0 || (k >> (shift + 8)) == prefix) atomicAdd(&hist[(k >> shift) & 255], 1);
            }
            __syncthreads();
            int above = 0;
            for (int bb = tid + 1; bb < 256; ++bb) above += hist[bb];
            const int mine = hist[tid];
            if (above < krem && krem <= above + mine) { ctl[0] = tid; ctl[1] = krem - above; ctl[2] = mine; }
            __syncthreads();
            prefix = (prefix << 8) | (unsigned)ctl[0]; krem = ctl[1];
            __syncthreads();
        }
        const unsigned thr = prefix; const int need = krem;
        int nt = 0; for (int i = lo; i < hi; ++i) nt += (keys[i] == thr);
        int tot; int trank = block_excl_scan(nt, scan, tid, tot);
        int ns = 0;
        { int tr = trank; for (int i = lo; i < hi; ++i) { const unsigned k = keys[i]; if (k > thr) ++ns; else if (k == thr) { if (tr < need) ++ns; ++tr; } } }
        int wpos = block_excl_scan(ns, scan, tid, tot);
        { int tr = trank; for (int i = lo; i < hi; ++i) { const unsigned k = keys[i]; bool sel = false; if (k > thr) sel = true; else if (k == thr) { sel = tr < need; ++tr; }
              if (sel) { p.DSEL[(size_t)g * 256 + wpos] = i; ++wpos; } } }
        if (tid == 0) p.DCNT[g] = tot;
        __syncthreads();
    }
}

__device__ void ph_nsa_cmp(const Params& p, int bid, int nb, float* smf) {
    const int lane = threadIdx.x & 63, wid = threadIdx.x >> 6;
    float* ps = smf + wid * (2048 + 256 + 128);
    float* qs = ps + 2048;
    float* imp = qs + 256;
    for (int g = bid * 4 + wid; g < T; g += nb * 4) {
        const int b = g / S, t = g % S;
        const int nv = t >= 31 ? min(NCMP, (t - 31) / 16 + 1) : 0;
        const float* pr = p.P + (size_t)g * NM;
        for (int i = lane; i < 256; i += 64) qs[i] = pr[C_NSA_Q + i];
        for (int i = lane; i < 2048; i += 64) ps[i] = 0.f;
        __builtin_amdgcn_wave_barrier();
        const float* kc = p.KC + (size_t)b * NCMP_PAD * 64;
        const float* vc = p.VC + (size_t)b * NCMP_PAD * 64;
        for (int h = 0; h < 4; ++h) {
            float l[8]; float m = -INFINITY;
#pragma unroll
            for (int j = 0; j < 8; ++j) {
                const int n = lane + 64 * j; l[j] = -INFINITY;
                if (n < nv) { float d = 0.f; const float* kr = kc + (size_t)n * 64; for (int i = 0; i < 64; ++i) d = fmaf(qs[h * 64 + i], kr[i], d); l[j] = d * 0.125f; }
                m = fmaxf(m, l[j]);
            }
            m = wave_max(m);
            if (m == -INFINITY) m = 0.f;
            float sum = 0.f;
#pragma unroll
            for (int j = 0; j < 8; ++j) { const int n = lane + 64 * j; l[j] = (n < nv) ? expf(l[j] - m) : 0.f; sum += l[j]; }
            sum = wave_sum(sum);
            const float inv = 1.f / fmaxf(sum, 1e-30f);
#pragma unroll
            for (int j = 0; j < 8; ++j) { const int n = lane + 64 * j; if (n < nv) ps[h * 512 + n] = l[j] * inv; }
            __builtin_amdgcn_wave_barrier();
            float o = 0.f;
            for (int n = 0; n < nv; ++n) o = fmaf(ps[h * 512 + n], vc[(size_t)n * 64 + lane], o);
            p.OCMP[(size_t)g * 256 + h * 64 + lane] = o;
        }
        __builtin_amdgcn_wave_barrier();
        const int cur = t >> 6;
        float myimp[2];
#pragma unroll
        for (int jj = 0; jj < 2; ++jj) {
            const int j = lane + 64 * jj;
            float a = 0.f;
            for (int h = 0; h < 4; ++h) for (int i = 0; i < 4; ++i) a += ps[h * 512 + 4 * j + i];
            const bool forced = (j == 0) || (j == cur) || (j == cur - 1);
            const bool vis = j <= cur;
            a = forced ? 1e4f : (vis ? a : -1.0f);
            myimp[jj] = a; imp[j] = a;
        }
        __builtin_amdgcn_wave_barrier();
        unsigned long long m0, m1;
        {
            int r0 = 0, r1 = 0;
            for (int i = 0; i < 128; ++i) {
                const float v = imp[i];
                r0 += (v > myimp[0]) || (v == myimp[0] && i < lane);
                r1 += (v > myimp[1]) || (v == myimp[1] && i < lane + 64);
            }
            m0 = __ballot(r0 < 16); m1 = __ballot(r1 < 16);
        }
        if (lane == 0) {
            unsigned* dst = p.SMASK + (size_t)g * 4;
            dst[0] = (unsigned)m0; dst[1] = (unsigned)(m0 >> 32); dst[2] = (unsigned)m1; dst[3] = (unsigned)(m1 >> 32);
        }
        __builtin_amdgcn_wave_barrier();
    }
}

__device__ __forceinline__ float dot64(const float (&q)[64], const float* __restrict__ k) {
    const float4* k4 = (const float4*)k; float s0 = 0.f, s1 = 0.f, s2 = 0.f, s3 = 0.f;
#pragma unroll
    for (int i = 0; i < 16; ++i) { const float4 kk = k4[i]; s0 = fmaf(q[4 * i], kk.x, s0); s1 = fmaf(q[4 * i + 1], kk.y, s1); s2 = fmaf(q[4 * i + 2], kk.z, s2); s3 = fmaf(q[4 * i + 3], kk.w, s3); }
    return (s0 + s1) + (s2 + s3);
}
__device__ __forceinline__ void axpy64(float (&acc)[64], float a, const float* __restrict__ v) {
    const float4* v4 = (const float4*)v;
#pragma unroll
    for (int i = 0; i < 16; ++i) { const float4 vv = v4[i]; acc[4 * i] = fmaf(a, vv.x, acc[4 * i]); acc[4 * i + 1] = fmaf(a, vv.y, acc[4 * i + 1]); acc[4 * i + 2] = fmaf(a, vv.z, acc[4 * i + 2]); acc[4 * i + 3] = fmaf(a, vv.w, acc[4 * i + 3]); }
}
__device__ __forceinline__ void load64(float (&q)[64], const float* __restrict__ src) {
    const float4* s4 = (const float4*)src;
#pragma unroll
    for (int i = 0; i < 16; ++i) { const float4 v = s4[i]; q[4 * i] = v.x; q[4 * i + 1] = v.y; q[4 * i + 2] = v.z; q[4 * i + 3] = v.w; }
}
struct OnlineSm {
    float m, l; float acc[64];
    __device__ __forceinline__ void init() { m = -INFINITY; l = 0.f;
#pragma unroll
        for (int i = 0; i < 64; ++i) acc[i] = 0.f; }
    __device__ __forceinline__ void update(float x, const float* __restrict__ v) {
        const float mn = fmaxf(m, x); const float corr = expf(m - mn), pe = expf(x - mn);
        l = l * corr + pe;
#pragma unroll
        for (int i = 0; i < 64; ++i) acc[i] *= corr;
        axpy64(acc, pe, v); m = mn;
    }
    __device__ __forceinline__ void finish() { const float inv = 1.f / fmaxf(l, 1e-30f);
#pragma unroll
        for (int i = 0; i < 64; ++i) acc[i] *= inv; }
};
__device__ __forceinline__ void store_gated(float* __restrict__ dst, const float (&acc)[64], const float* __restrict__ z) {
#pragma unroll
    for (int i = 0; i < 16; ++i) {
        const float4 zz = ((const float4*)z)[i];
        float4 o; o.x = acc[4 * i] * silu_(zz.x); o.y = acc[4 * i + 1] * silu_(zz.y); o.z = acc[4 * i + 2] * silu_(zz.z); o.w = acc[4 * i + 3] * silu_(zz.w);
        ((float4*)dst)[i] = o;
    }
}

template <int BR>
__device__ void ph_attn(const Params& p, int bid, int nb) {
    const int lane = threadIdx.x & 63, wid = threadIdx.x >> 6;
    for (int unit = bid; unit < T / 64; unit += nb) {
        const int h = __builtin_amdgcn_readfirstlane(wid);
        const int g0 = unit * 64, b = g0 / S, t0 = g0 % S;
        const int g = g0 + lane, t = t0 + lane;
        const float* pr = p.P + (size_t)g * NM;
        const float* pb = p.P + (size_t)b * S * NM;
        float q[64];
        if (BR == 0) {
            load64(q, pr + C_DSA_Q + h * 64);
            OnlineSm os; os.init();
            const int cnt = p.DCNT[g];
            const int* sel = p.DSEL + (size_t)g * 256;
            for (int i = 0; i < cnt; ++i) {
                const int s = sel[i];
                if (s <= t) {
                    const float x = dot64(q, p.KA + (size_t)(b * S + s) * 256 + h * 64) * 0.125f;
                    os.update(x, p.VA + (size_t)(b * S + s) * 256 + h * 64);
                }
            }
            os.finish();
            store_gated(p.Y + (size_t)g * 1280 + 0 + h * 64, os.acc, pr + C_DSA_Z + h * 64);
        } else if (BR == 1) {
            load64(q, pr + C_FOX_Q + h * 64);
            OnlineSm os; os.init();
            const float ct = p.CUM[(size_t)g * 4 + h];
            for (int s = 0; s <= t0 + 63; ++s) {
                const float* kr = pb + (size_t)s * NM + C_FOX_K + h * 64;
                const float* vr = pb + (size_t)s * NM + C_FOX_V + h * 64;
                const float cs = p.CUM[(size_t)(b * S + s) * 4 + h];
                if (s <= t) { const float x = dot64(q, kr) * 0.125f + ct - cs; os.update(x, vr); }
            }
            os.finish();
            store_gated(p.Y + (size_t)g * 1280 + 256 + h * 64, os.acc, pr + C_FOX_Z + h * 64);
        } else if (BR == 2) {
            load64(q, pr + C_SB_Q + h * 64);
            float acc[64];
#pragma unroll
            for (int i = 0; i < 64; ++i) acc[i] = 0.f;
            float R = 0.f;
            for (int s = t0 + 62; s >= 0; --s) {
                const float* kr = pb + (size_t)s * NM + C_SB_K + h * 64;
                const float* vr = pb + (size_t)s * NM + C_SB_V + h * 64;
                if (s < t) {
                    const float z = dot64(q, kr) * 0.125f;
                    const float ls = logsig_(z);
                    const float a = expf(ls + R);
                    axpy64(acc, a, vr);
                    R += ls - z;
                }
            }
            store_gated(p.Y + (size_t)g * 1280 + 512 + h * 64, acc, pr + C_SB_Z + h * 64);
        } else if (BR == 3) {
            load64(q, pr + C_NSA_Q + h * 64);
            float res[64];
            {
                const float g0w = sigmoid_(pr[C_NSA_G + 0 * 4 + h]);
                const float* oc = p.OCMP + (size_t)g * 256 + h * 64;
#pragma unroll
                for (int i = 0; i < 64; ++i) res[i] = g0w * oc[i];
            }
            {
                OnlineSm os; os.init();
                const unsigned* mk = p.SMASK + (size_t)g * 4;
                for (int w = 0; w < 4; ++w) {
                    unsigned bits = mk[w];
                    while (bits) {
                        const int j = w * 32 + __builtin_ctz(bits); bits &= bits - 1;
                        for (int i = 0; i < 64; ++i) {
                            const int s = j * 64 + i;
                            if (s <= t) {
                                const float x = dot64(q, pb + (size_t)s * NM + C_NSA_KS) * 0.125f;
                                os.update(x, pb + (size_t)s * NM + C_NSA_VS);
                            }
                        }
                    }
                }
                os.finish();
                const float g1w = sigmoid_(pr[C_NSA_G + 1 * 4 + h]);
#pragma unroll
                for (int i = 0; i < 64; ++i) res[i] = fmaf(g1w, os.acc[i], res[i]);
            }
            {
                OnlineSm os; os.init();
                const int slo = max(0, t0 - 511);
                for (int s = slo; s <= t0 + 63; ++s) {
                    const float* kr = pb + (size_t)s * NM + C_NSA_KW;
                    const float* vr = pb + (size_t)s * NM + C_NSA_VW;
                    const int d = t - s;
                    if (d >= 0 && d < 512) { const float x = dot64(q, kr) * 0.125f; os.update(x, vr); }
                }
                os.finish();
                const float g2w = sigmoid_(pr[C_NSA_G + 2 * 4 + h]);
#pragma unroll
                for (int i = 0; i < 64; ++i) res[i] = fmaf(g2w, os.acc[i], res[i]);
            }
            store_gated(p.Y + (size_t)g * 1280 + 768 + h * 64, res, pr + C_NSA_Z + h * 64);
        } else {
            load64(q, pr + C_MEM_Q + h * 64);
            OnlineSm os; os.init();
            for (int m = 0; m < NMEM; ++m) {
                const float* kr = p.MKV + (size_t)(b * NMEM + m) * 512 + h * 64;
                const float x = dot64(q, kr) * 0.125f;
                os.update(x, kr + 256);
            }
            os.finish();
            store_gated(p.Y + (size_t)g * 1280 + 1024 + h * 64, os.acc, pr + C_MEM_Z + h * 64);
        }
    }
}

#define KSM __shared__ __attribute__((aligned(16))) float sm[10240]
__global__ void __launch_bounds__(256) k_rope_table(Params p) { ph_rope_table(p, blockIdx.x, gridDim.x); }
__global__ void __launch_bounds__(256) k_rmsnorm_x(Params p, int layer) { ph_rmsnorm(layer == 0 ? p.x : p.X, p.norm_g + layer * D, p.H, T, blockIdx.x, gridDim.x); }
__global__ void __launch_bounds__(256) k_rmsnorm_mem(Params p, int layer) { ph_rmsnorm(p.mem, p.mem_norm + layer * D, p.MEMN, NBATCH * NMEM, blockIdx.x, gridDim.x); }
__global__ void __launch_bounds__(256) k_rmsnorm_final(Params p) { ph_rmsnorm(p.X, p.final_norm, p.X, T, blockIdx.x, gridDim.x); }
__global__ void __launch_bounds__(256) k_gemm_store(const float* A, int lda, const float* B, int ldb, int M, int N, int K, float* C, int ldc) {
    KSM; EpiStore e{C, ldc}; gemm_f32(A, lda, B, ldb, M, N, K, e, blockIdx.x, gridDim.x, sm); }
__global__ void __launch_bounds__(256) k_gemm_merge(const float* A, const float* B, int ldb, float* Mg, const float* YB, int first) {
    KSM; EpiMerge e{Mg, YB, first}; gemm_f32(A, D, B, ldb, T, D, D, e, blockIdx.x, gridDim.x, sm); }
__global__ void __launch_bounds__(256) k_gemm_resid(const float* A, const float* B, const float* Xin, float* Xout) {
    KSM; EpiResid e{Xin, Xout}; gemm_f32(A, D, B, D, T, D, D, e, blockIdx.x, gridDim.x, sm); }
__global__ void __launch_bounds__(256) k_ckvnorm(Params p, int layer) { ph_ckvnorm(p, layer, blockIdx.x, gridDim.x); }
__global__ void __launch_bounds__(256) k_prep(Params p, int layer) { ph_prep(p, layer, blockIdx.x, gridDim.x); }
__global__ void __launch_bounds__(256) k_cumsum(Params p) { KSM; ph_cumsum(p, blockIdx.x, gridDim.x, sm); }
__global__ void __launch_bounds__(256) k_compress(Params p, int layer) { KSM; ph_compress(p, layer, blockIdx.x, gridDim.x, sm); }
__global__ void __launch_bounds__(256) k_dsa_select(Params p) { KSM; ph_dsa_select(p, blockIdx.x, gridDim.x, sm); }
__global__ void __launch_bounds__(256) k_nsa_cmp(Params p) { KSM; ph_nsa_cmp(p, blockIdx.x, gridDim.x, sm); }
template <int BR> __global__ void __launch_bounds__(256) k_attn(Params p) { ph_attn<BR>(p, blockIdx.x, gridDim.x); }
}

extern "C" void kernel_launch(void* const* d_in, const int* in_sizes, int n_in, void* d_out, int out_size, void* d_ws, size_t ws_size, hipStream_t stream) {
    (void)in_sizes; (void)n_in; (void)out_size;
    Params p{};
    p.x = (const float*)d_in[0]; p.mem = (const float*)d_in[1]; p.pos = (const int*)d_in[2]; p.norm_g = (const float*)d_in[3];
    p.w_in = (const float*)d_in[4]; p.kv_norm = (const float*)d_in[5]; p.w_uk = (const float*)d_in[6]; p.w_uv = (const float*)d_in[7];
    p.fox_bias = (const float*)d_in[8]; p.pe_k = (const float*)d_in[9]; p.pe_v = (const float*)d_in[10]; p.wc1_k = (const float*)d_in[11];
    p.wc2_k = (const float*)d_in[12]; p.wc1_v = (const float*)d_in[13]; p.wc2_v = (const float*)d_in[14]; p.mem_norm = (const float*)d_in[15];
    p.w_mem_kv = (const float*)d_in[16]; p.w_branch = (const float*)d_in[17]; p.w_out = (const float*)d_in[18]; p.final_norm = (const float*)d_in[19];
    p.X = (float*)d_out;
    size_t off = 0; char* ws = (char*)d_ws;
    auto carve = [&](size_t bytes) { char* r = ws + off; off += (bytes + 255) & ~(size_t)255; return r; };
    p.P = (float*)carve((size_t)T * NM * 4);
    p.YB = p.P; p.MG = p.P + (size_t)T * D;
    p.H = (float*)carve((size_t)T * D * 4);
    p.Y = (float*)carve((size_t)T * 1280 * 4);
    p.CKV = (float*)carve((size_t)T * 128 * 4);
    p.KA = (float*)carve((size_t)T * 256 * 4);
    p.VA = (float*)carve((size_t)T * 256 * 4);
    p.OCMP = (float*)carve((size_t)T * 256 * 4);
    p.LOGF = (float*)carve((size_t)T * 4 * 4);
    p.CUM = (float*)carve((size_t)T * 4 * 4);
    p.KC = (float*)carve((size_t)NBATCH * NCMP_PAD * 64 * 4);
    p.VC = (float*)carve((size_t)NBATCH * NCMP_PAD * 64 * 4);
    p.MEMN = (float*)carve((size_t)NBATCH * NMEM * D * 4);
    p.MKV = (float*)carve((size_t)NBATCH * NMEM * 512 * 4);
    p.ROPE = (float*)carve((size_t)T * 64 * 4);
    p.DSEL = (int*)carve((size_t)T * 256 * 4);
    p.DCNT = (int*)carve((size_t)T * 4);
    p.SMASK = (unsigned*)carve((size_t)T * 4 * 4);
    if (off > ws_size) return;

    const dim3 blk(256);
    const int G = 1024;
    hipLaunchKernelGGL(k_rope_table, dim3(G), blk, 0, stream, p);
    for (int l = 0; l < DEPTH; ++l) {
        const float* Xin = l == 0 ? p.x : p.X;
        const float* w_in = p.w_in + (size_t)l * D * NIN;
        hipLaunchKernelGGL(k_rmsnorm_x, dim3(G), blk, 0, stream, p, l);
        hipLaunchKernelGGL(k_rmsnorm_mem, dim3(128), blk, 0, stream, p, l);
        hipLaunchKernelGGL(k_gemm_store, dim3(2048), blk, 0, stream, (const float*)p.H, D, w_in, NIN, T, NM, D, p.P, NM);
        hipLaunchKernelGGL(k_gemm_store, dim3(64), blk, 0, stream, (const float*)p.MEMN, D, p.w_mem_kv + (size_t)l * D * 512, 512, NBATCH * NMEM, 512, D, p.MKV, 512);
        hipLaunchKernelGGL(k_ckvnorm, dim3(G), blk, 0, stream, p, l);
        hipLaunchKernelGGL(k_gemm_store, dim3(1024), blk, 0, stream, (const float*)p.CKV, 128, p.w_uk + (size_t)l * 128 * 256, 256, T, 256, 128, p.KA, 256);
        hipLaunchKernelGGL(k_gemm_store, dim3(1024), blk, 0, stream, (const float*)p.CKV, 128, p.w_uv + (size_t)l * 128 * 256, 256, T, 256, 128, p.VA, 256);
        hipLaunchKernelGGL(k_prep, dim3(2048), blk, 0, stream, p, l);
        hipLaunchKernelGGL(k_cumsum, dim3(8), blk, 0, stream, p);
        hipLaunchKernelGGL(k_compress, dim3(2044), blk, 0, stream, p, l);
        hipLaunchKernelGGL(k_dsa_select, dim3(2048), blk, 0, stream, p);
        hipLaunchKernelGGL(k_nsa_cmp, dim3(1024), blk, 0, stream, p);
        hipLaunchKernelGGL(k_attn<1>, dim3(256), blk, 0, stream, p);
        hipLaunchKernelGGL(k_attn<2>, dim3(256), blk, 0, stream, p);
        hipLaunchKernelGGL(k_attn<3>, dim3(256), blk, 0, stream, p);
        hipLaunchKernelGGL(k_attn<0>, dim3(256), blk, 0, stream, p);
        hipLaunchKernelGGL(k_attn<4>, dim3(256), blk, 0, stream, p);
        for (int n = 0; n < 5; ++n) {
            hipLaunchKernelGGL(k_gemm_store, dim3(2048), blk, 0, stream, (const float*)(p.Y + n * 256), 1280, p.w_branch + ((size_t)l * 5 + n) * 256 * D, D, T, D, 256, p.YB, D);
            hipLaunchKernelGGL(k_gemm_merge, dim3(2048), blk, 0, stream, (const float*)p.H, w_in + C_MERGE + n * D, NIN, p.MG, (const float*)p.YB, n == 0 ? 1 : 0);
        }
        hipLaunchKernelGGL(k_gemm_resid, dim3(2048), blk, 0, stream, (const float*)p.MG, p.w_out + (size_t)l * D * D, Xin, p.X);
    }
    hipLaunchKernelGGL(k_rmsnorm_final, dim3(G), blk, 0, stream, p);
}
```

```cpp
#include <hip/hip_runtime.h>
#include <stdint.h>
#include <math.h>
#include <cstdio>

namespace {
constexpr int S = 8192, NBATCH = 2, T = NBATCH * S, D = 1024, NIN = 9396, NM = 4276, DEPTH = 4, NMEM = 256;
constexpr int NCMP = 511, NCMP_PAD = 512;
constexpr int C_DSA_Q = 0, C_CKV = 256, C_IDXQ = 384, C_IDXK = 512, C_IDXW = 544, C_DSA_Z = 548,
              C_FOX_Q = 804, C_FOX_K = 1060, C_FOX_V = 1316, C_FOX_F = 1572, C_FOX_Z = 1576,
              C_SB_Q = 1832, C_SB_K = 2088, C_SB_V = 2344, C_SB_Z = 2600,
              C_NSA_Q = 2856, C_NSA_KC = 3112, C_NSA_VC = 3176, C_NSA_KS = 3240, C_NSA_VS = 3304, C_NSA_KW = 3368, C_NSA_VW = 3432,
              C_NSA_G = 3496, C_NSA_Z = 3508, C_MEM_Q = 3764, C_MEM_Z = 4020, C_MERGE = 4276;

typedef unsigned short bf16_t;
typedef short bf16x8 __attribute__((ext_vector_type(8)));
typedef float f32x16 __attribute__((ext_vector_type(16)));
typedef unsigned u32x4 __attribute__((ext_vector_type(4)));
typedef unsigned u32x2 __attribute__((ext_vector_type(2)));

struct Params {
    const float* x; const float* mem; const int* pos; const float* norm_g; const float* w_in; const float* kv_norm;
    const float* w_uk; const float* w_uv; const float* fox_bias; const float* pe_k; const float* pe_v;
    const float* wc1_k; const float* wc2_k; const float* wc1_v; const float* wc2_v; const float* mem_norm;
    const float* w_mem_kv; const float* w_branch; const float* w_out; const float* final_norm;
    float* X;
    float *P, *KA, *VA, *LOGF, *CUM, *KC, *VC, *OCMP, *MKV, *ROPE;
    bf16_t *H, *CKV, *Y, *MG, *MEMN;
    bf16_t *WIN, *WBR, *WOUT, *WMKV, *WUK, *WUV;
    int* DSEL; int* DCNT; unsigned* SMASK; unsigned* bar;
};

__device__ __forceinline__ unsigned cvt_pk_bf16(float lo, float hi) { unsigned r; asm volatile("v_cvt_pk_bf16_f32 %0, %1, %2" : "=v"(r) : "v"(lo), "v"(hi)); return r; }
__device__ __forceinline__ bf16_t f2bf(float x) { return (bf16_t)(cvt_pk_bf16(x, 0.f) & 0xffffu); }
__device__ __forceinline__ int tidx() { int t = threadIdx.x; asm volatile("" : "+v"(t)); return t; }
__device__ __forceinline__ float sigmoid_(float x) { return 1.f / (1.f + expf(-x)); }
__device__ __forceinline__ float silu_(float x) { return x / (1.f + expf(-x)); }
__device__ __forceinline__ float logsig_(float x) { return fminf(x, 0.f) - log1pf(expf(-fabsf(x))); }
__device__ __forceinline__ float wave_sum(float v) {
#pragma unroll
    for (int o = 32; o > 0; o >>= 1) v += __shfl_xor(v, o, 64);
    return v;
}
__device__ __forceinline__ float wave_max(float v) {
#pragma unroll
    for (int o = 32; o > 0; o >>= 1) v = fmaxf(v, __shfl_xor(v, o, 64));
    return v;
}

__device__ void ph_rope_table(const Params& p, int bid, int nb) {
    for (int i = bid * 256 + tidx(); i < T * 32; i += nb * 256) {
        const int t = i >> 5, f = i & 31;
        const double inv = pow(10000.0, -(double)f / 32.0);
        const double ang = (double)p.pos[t] * inv;
        p.ROPE[(size_t)t * 64 + f] = (float)cos(ang);
        p.ROPE[(size_t)t * 64 + 32 + f] = (float)sin(ang);
    }
}

template <class OUT>
__device__ void ph_rmsnorm(const float* in, const float* g, OUT* out, int rows, int bid, int nb) {
    const int lane = tidx() & 63, wid = tidx() >> 6;
    for (int r = bid * 4 + wid; r < rows; r += nb * 4) {
        const float4* ip = (const float4*)(in + (size_t)r * D);
        float4 v[4]; float ss = 0.f;
#pragma unroll
        for (int i = 0; i < 4; ++i) { v[i] = ip[lane + 64 * i]; ss += v[i].x * v[i].x + v[i].y * v[i].y + v[i].z * v[i].z + v[i].w * v[i].w; }
        ss = wave_sum(ss);
        const float sc = 1.0f / sqrtf(ss * (1.f / D) + 1e-6f);
#pragma unroll
        for (int i = 0; i < 4; ++i) {
            const float4 gg = ((const float4*)g)[lane + 64 * i];
            float4 o; o.x = v[i].x * sc * gg.x; o.y = v[i].y * sc * gg.y; o.z = v[i].z * sc * gg.z; o.w = v[i].w * sc * gg.w;
            if constexpr (sizeof(OUT) == 4) ((float4*)((float*)out + (size_t)r * D))[lane + 64 * i] = o;
            else { u32x2 w; w.x = cvt_pk_bf16(o.x, o.y); w.y = cvt_pk_bf16(o.z, o.w); ((u32x2*)((bf16_t*)out + (size_t)r * D))[lane + 64 * i] = w; }
        }
    }
}

__device__ void ph_ckvnorm(const Params& p, int layer, int bid, int nb) {
    const int lane = tidx() & 63, wid = tidx() >> 6;
    const float* g = p.kv_norm + layer * 128;
    for (int r = bid * 4 + wid; r < T; r += nb * 4) {
        const float* ip = p.P + (size_t)r * NM + C_CKV;
        const float a = ip[lane], b = ip[lane + 64];
        const float ss = wave_sum(a * a + b * b);
        const float sc = 1.0f / sqrtf(ss * (1.f / 128.f) + 1e-6f);
        p.CKV[(size_t)r * 128 + lane] = f2bf(a * sc * g[lane]);
        p.CKV[(size_t)r * 128 + lane + 64] = f2bf(b * sc * g[lane + 64]);
    }
}

__device__ void convert_wt(const float* __restrict__ src, bf16_t* __restrict__ dst, int K, int N, int nmat, int bid, int nb, float* sm) {
    float (*tl)[65] = (float (*)[65])sm;
    const int tid = tidx(), tk = K / 64, tn = (N + 63) / 64, per = tk * tn;
    for (int it = bid; it < per * nmat; it += nb) {
        const int mat = it / per, r = it % per, k0 = (r % tk) * 64, n0 = (r / tk) * 64;
        const float* s = src + (size_t)mat * K * N; bf16_t* d = dst + (size_t)mat * K * N;
        for (int i = tid; i < 64 * 64; i += 256) { const int kk = i >> 6, nn = i & 63; tl[kk][nn] = (n0 + nn < N) ? s[(size_t)(k0 + kk) * N + n0 + nn] : 0.f; }
        __syncthreads();
        {
            const int nn = tid >> 2, kq = (tid & 3) * 16;
            if (n0 + nn < N) {
                u32x4 w0, w1;
                w0.x = cvt_pk_bf16(tl[kq + 0][nn], tl[kq + 1][nn]); w0.y = cvt_pk_bf16(tl[kq + 2][nn], tl[kq + 3][nn]);
                w0.z = cvt_pk_bf16(tl[kq + 4][nn], tl[kq + 5][nn]); w0.w = cvt_pk_bf16(tl[kq + 6][nn], tl[kq + 7][nn]);
                w1.x = cvt_pk_bf16(tl[kq + 8][nn], tl[kq + 9][nn]); w1.y = cvt_pk_bf16(tl[kq + 10][nn], tl[kq + 11][nn]);
                w1.z = cvt_pk_bf16(tl[kq + 12][nn], tl[kq + 13][nn]); w1.w = cvt_pk_bf16(tl[kq + 14][nn], tl[kq + 15][nn]);
                u32x4* dp = (u32x4*)(d + (size_t)(n0 + nn) * K + k0 + kq);
                dp[0] = w0; dp[1] = w1;
            }
        }
        __syncthreads();
    }
}

constexpr int GROW = 80;
constexpr int GA_BYTES = 128 * GROW;
template <int BN>
__device__ __forceinline__ void tile_mac(f32x16 (&acc)[2][BN / 64], const bf16_t* __restrict__ A, int lda, int m0,
                                         const bf16_t* __restrict__ Bt, int ldb, int n0, int nmax, int K, char* sm) {
    constexpr int NT = BN / 64;
    constexpr int B_BYTES = BN * GROW;
    constexpr int BUF = GA_BYTES + B_BYTES;
    const int tid = tidx(), lane = tid & 63, wid = tid >> 6, wr = wid >> 1, wc = wid & 1;
    const int lr = lane & 31, lh = lane >> 5;
    const int ar0 = tid >> 2, akq = tid & 3;
    const bf16_t* ap0 = A + (size_t)(m0 + ar0) * lda + akq * 8;
    const bf16_t* ap1 = A + (size_t)(m0 + ar0 + 64) * lda + akq * 8;
    const int br0 = tid >> 2;
    const bool bv0 = (n0 + br0) < nmax, bv1 = (NT == 2) && ((n0 + br0 + 64) < nmax);
    const bf16_t* bp0 = Bt + (size_t)(bv0 ? (n0 + br0) : 0) * ldb + akq * 8;
    const bf16_t* bp1 = Bt + (size_t)(bv1 ? (n0 + br0 + 64) : 0) * ldb + akq * 8;
    const int st_a0 = ar0 * GROW + akq * 16, st_a1 = (ar0 + 64) * GROW + akq * 16;
    const int st_b0 = GA_BYTES + br0 * GROW + akq * 16, st_b1 = GA_BYTES + (br0 + 64) * GROW + akq * 16;
    const int rd_a = (wr * 64 + lr) * GROW + lh * 16, rd_b = GA_BYTES + (wc * (BN / 2) + lr) * GROW + lh * 16;
    const u32x4 zero4 = {0u, 0u, 0u, 0u};
    u32x4 ra0, ra1, rb0, rb1 = zero4;
    ra0 = *(const u32x4*)ap0; ra1 = *(const u32x4*)ap1;
    rb0 = bv0 ? *(const u32x4*)bp0 : zero4; if (NT == 2) rb1 = bv1 ? *(const u32x4*)bp1 : zero4;
    __syncthreads();
    *(u32x4*)(sm + st_a0) = ra0; *(u32x4*)(sm + st_a1) = ra1; *(u32x4*)(sm + st_b0) = rb0; if (NT == 2) *(u32x4*)(sm + st_b1) = rb1;
    __syncthreads();
    const int nk = K / 32;
    for (int ks = 0; ks < nk; ++ks) {
        char* cur = sm + (ks & 1) * BUF;
        char* nxt = sm + ((ks + 1) & 1) * BUF;
        const bool more = (ks + 1) < nk;
        if (more) {
            const int ko = (ks + 1) * 32;
            ra0 = *(const u32x4*)(ap0 + ko); ra1 = *(const u32x4*)(ap1 + ko);
            rb0 = bv0 ? *(const u32x4*)(bp0 + ko) : zero4; if (NT == 2) rb1 = bv1 ? *(const u32x4*)(bp1 + ko) : zero4;
        }
#pragma unroll
        for (int s = 0; s < 2; ++s) {
            bf16x8 a[2], b[NT];
#pragma unroll
            for (int mi = 0; mi < 2; ++mi) a[mi] = *(const bf16x8*)(cur + rd_a + mi * 32 * GROW + s * 32);
#pragma unroll
            for (int ni = 0; ni < NT; ++ni) b[ni] = *(const bf16x8*)(cur + rd_b + ni * 32 * GROW + s * 32);
#pragma unroll
            for (int mi = 0; mi < 2; ++mi)
#pragma unroll
                for (int ni = 0; ni < NT; ++ni) acc[mi][ni] = __builtin_amdgcn_mfma_f32_32x32x16_bf16(a[mi], b[ni], acc[mi][ni], 0, 0, 0);
        }
        if (more) { *(u32x4*)(nxt + st_a0) = ra0; *(u32x4*)(nxt + st_a1) = ra1; *(u32x4*)(nxt + st_b0) = rb0; if (NT == 2) *(u32x4*)(nxt + st_b1) = rb1; }
        __syncthreads();
    }
}
template <int NT> __device__ __forceinline__ void acc_zero(f32x16 (&acc)[2][NT]) {
#pragma unroll
    for (int mi = 0; mi < 2; ++mi)
#pragma unroll
        for (int ni = 0; ni < NT; ++ni)
#pragma unroll
            for (int r = 0; r < 16; ++r) acc[mi][ni][r] = 0.f;
}
template <int BN, class Epi>
__device__ void gemm_bf16(const bf16_t* A, int lda, const bf16_t* Bt, int ldb, int M, int N, int K, const Epi& epi, int bid, int nb, char* sm) {
    constexpr int NT = BN / 64;
    const int tm = M / 128, tn = (N + BN - 1) / BN;
    const int lane = tidx() & 63, wid = tidx() >> 6, wr = wid >> 1, wc = wid & 1, lr = lane & 31, lh = lane >> 5;
    for (int tile = bid; tile < tm * tn; tile += nb) {
        const int m0 = (tile % tm) * 128, n0 = (tile / tm) * BN;
        f32x16 acc[2][NT]; acc_zero<NT>(acc);
        tile_mac<BN>(acc, A, lda, m0, Bt, ldb, n0, N, K, sm);
#pragma unroll
        for (int mi = 0; mi < 2; ++mi)
#pragma unroll
            for (int ni = 0; ni < NT; ++ni) {
                const int col = n0 + wc * (BN / 2) + ni * 32 + lr;
                if (col < N) {
#pragma unroll
                    for (int r = 0; r < 16; ++r) epi(m0 + wr * 64 + mi * 32 + (r & 3) + 8 * (r >> 2) + 4 * lh, col, acc[mi][ni][r]);
                }
            }
    }
}
struct EpiStore { float* C; int ldc; __device__ __forceinline__ void operator()(int r, int c, float v) const { C[(size_t)r * ldc + c] = v; } };
struct EpiResid { const float* Xin; float* Xout;
    __device__ __forceinline__ void operator()(int r, int c, float v) const { const size_t i = (size_t)r * D + c; Xout[i] = Xin[i] + v; } };

__device__ void ph_merge(const Params& p, int layer, int bid, int nb, char* sm) {
    const int lane = tidx() & 63, wid = tidx() >> 6, wr = wid >> 1, wc = wid & 1, lr = lane & 31, lh = lane >> 5;
    const bf16_t* win = p.WIN + (size_t)layer * NIN * D;
    for (int tile = bid; tile < (T / 128) * (D / 64); tile += nb) {
        const int m0 = (tile % (T / 128)) * 128, n0 = (tile / (T / 128)) * 64;
        f32x16 mg[2][1]; acc_zero<1>(mg);
        for (int n = 0; n < 5; ++n) {
            f32x16 g[2][1], yb[2][1]; acc_zero<1>(g); acc_zero<1>(yb);
            tile_mac<64>(g, p.H, D, m0, win + (size_t)(C_MERGE + n * D) * D, D, n0, D, D, sm);
            tile_mac<64>(yb, p.Y + n * 256, 1280, m0, p.WBR + ((size_t)layer * 5 + n) * D * 256, 256, n0, D, 256, sm);
#pragma unroll
            for (int mi = 0; mi < 2; ++mi)
#pragma unroll
                for (int r = 0; r < 16; ++r) mg[mi][0][r] = fmaf(sigmoid_(g[mi][0][r]), yb[mi][0][r], mg[mi][0][r]);
        }
#pragma unroll
        for (int mi = 0; mi < 2; ++mi)
#pragma unroll
            for (int r = 0; r < 16; ++r) {
                const int row = m0 + wr * 64 + mi * 32 + (r & 3) + 8 * (r >> 2) + 4 * lh, col = n0 + wc * 32 + lr;
                p.MG[(size_t)row * D + col] = f2bf(mg[mi][0][r]);
            }
    }
}

__device__ __forceinline__ void rope_pair(float* base, int i0, int half, float c, float s) {
    const float x1 = base[i0], x2 = base[i0 + half];
    base[i0] = x1 * c - x2 * s; base[i0 + half] = x2 * c + x1 * s;
}
__device__ void ph_prep(const Params& p, int layer, int bid, int nb) {
    for (int t = bid; t < T; t += nb) {
        float* pr = p.P + (size_t)t * NM;
        const float* rt = p.ROPE + (size_t)t * 64;
        for (int i = tidx(); i < 564; i += 256) {
            if (i < 128) { const int h = i >> 5, f = i & 31; rope_pair(pr + C_DSA_Q + h * 64, f, 32, rt[f], rt[32 + f]); }
            else if (i < 256) { const int j = i - 128, h = j >> 5, f = j & 31; rope_pair(p.KA + (size_t)t * 256 + h * 64, f, 32, rt[f], rt[32 + f]); }
            else if (i < 384) { const int j = i - 256, h = j >> 5, f = j & 31; rope_pair(pr + C_NSA_Q + h * 64, f, 32, rt[f], rt[32 + f]); }
            else if (i < 416) { const int f = i - 384; rope_pair(pr + C_NSA_KC, f, 32, rt[f], rt[32 + f]); }
            else if (i < 448) { const int f = i - 416; rope_pair(pr + C_NSA_KS, f, 32, rt[f], rt[32 + f]); }
            else if (i < 480) { const int f = i - 448; rope_pair(pr + C_NSA_KW, f, 32, rt[f], rt[32 + f]); }
            else if (i < 544) { const int j = i - 480, h = j >> 4, f = j & 15; rope_pair(pr + C_IDXQ + h * 32, f, 16, rt[2 * f], rt[32 + 2 * f]); }
            else if (i < 560) { const int f = i - 544; rope_pair(pr + C_IDXK, f, 16, rt[2 * f], rt[32 + 2 * f]); }
            else { const int h = i - 560; p.LOGF[(size_t)t * 4 + h] = logsig_(pr[C_FOX_F + h] + p.fox_bias[layer * 4 + h]); }
        }
    }
}

__device__ void ph_cumsum(const Params& p, int bid, int nb, float* sm) {
    const int tid = tidx();
    for (int item = bid; item < NBATCH * 4; item += nb) {
        const int b = item >> 2, h = item & 3;
        const float* src = p.LOGF + (size_t)b * S * 4 + h;
        float* dst = p.CUM + (size_t)b * S * 4 + h;
        float loc = 0.f;
        for (int i = 0; i < 32; ++i) loc += src[(size_t)(tid * 32 + i) * 4];
        sm[tid] = loc; __syncthreads();
        if (tid == 0) { float run = 0.f; for (int i = 0; i < 256; ++i) { const float v = sm[i]; sm[i] = run; run += v; } }
        __syncthreads();
        float run = sm[tid];
        for (int i = 0; i < 32; ++i) { run += src[(size_t)(tid * 32 + i) * 4]; dst[(size_t)(tid * 32 + i) * 4] = run; }
        __syncthreads();
    }
}

__device__ void ph_compress(const Params& p, int layer, int bid, int nb, float* sm) {
    float* xs = sm;
    float* part = sm + 2048;
    float* hid = sm + 2304;
    const int tid = tidx();
    for (int item = bid; item < 2 * NBATCH * NCMP; item += nb) {
        const int which = item / (NBATCH * NCMP), rem = item % (NBATCH * NCMP), b = rem / NCMP, n = rem % NCMP;
        const int coff = which ? C_NSA_VC : C_NSA_KC;
        const float* pe = (which ? p.pe_v : p.pe_k) + (size_t)layer * 2048;
        const float* w1 = (which ? p.wc1_v : p.wc1_k) + (size_t)layer * 2048 * 128;
        const float* w2 = (which ? p.wc2_v : p.wc2_k) + (size_t)layer * 128 * 64;
        for (int i = tid; i < 2048; i += 256) {
            const int tk = i >> 6, d = i & 63;
            xs[i] = p.P[(size_t)(b * S + 16 * n + tk) * NM + coff + d] + pe[i];
        }
        __syncthreads();
        {
            const int j = tid & 127, hf = tid >> 7;
            float a = 0.f;
            for (int k = hf * 1024; k < hf * 1024 + 1024; ++k) a = fmaf(xs[k], w1[(size_t)k * 128 + j], a);
            part[tid] = a;
        }
        __syncthreads();
        if (tid < 128) hid[tid] = silu_(part[tid] + part[tid + 128]);
        __syncthreads();
        {
            const int d = tid & 63, q = tid >> 6;
            float a = 0.f;
#pragma unroll 4
            for (int j = q * 32; j < q * 32 + 32; ++j) a = fmaf(hid[j], w2[j * 64 + d], a);
            part[tid] = a;
        }
        __syncthreads();
        if (tid < 64) {
            float* dst = (which ? p.VC : p.KC) + ((size_t)b * NCMP_PAD + n) * 64;
            dst[tid] = (part[tid] + part[tid + 64]) + (part[tid + 128] + part[tid + 192]);
        }
        __syncthreads();
    }
}

__device__ __forceinline__ int block_excl_scan(int v, int* sh, int tid, int& total) {
    sh[tid] = v; __syncthreads();
    for (int off = 1; off < 256; off <<= 1) { const int t = (tid >= off) ? sh[tid - off] : 0; __syncthreads(); sh[tid] += t; __syncthreads(); }
    const int incl = sh[tid]; total = sh[255]; __syncthreads();
    return incl - v;
}
__device__ void ph_dsa_select(const Params& p, int bid, int nb, float* smf) {
    unsigned* keys = (unsigned*)smf;
    int* hist = (int*)(smf + 8192);
    int* scan = (int*)(smf + 8192 + 256);
    float* qs = smf + 8192 + 512;
    int* ctl = (int*)(smf + 8192 + 512 + 160);
    const int tid = tidx();
    for (int g = bid; g < T; g += nb) {
        const int b = g / S, t = g % S, n = t + 1;
        if (n <= 256) {
            if (tid < n) p.DSEL[(size_t)g * 256 + tid] = tid;
            if (tid == 0) p.DCNT[g] = n;
            continue;
        }
        const float* pr = p.P + (size_t)g * NM;
        if (tid < 128) qs[tid] = pr[C_IDXQ + tid]; else if (tid < 132) qs[tid] = pr[C_IDXW + tid - 128];
        __syncthreads();
        for (int s = tid; s < n; s += 256) {
            const float4* kp = (const float4*)(p.P + (size_t)(b * S + s) * NM + C_IDXK);
            float kk[32];
#pragma unroll
            for (int i = 0; i < 8; ++i) { const float4 v = kp[i]; kk[4 * i] = v.x; kk[4 * i + 1] = v.y; kk[4 * i + 2] = v.z; kk[4 * i + 3] = v.w; }
            float sc = 0.f;
#pragma unroll 1
            for (int h = 0; h < 4; ++h) {
                float d = 0.f;
#pragma unroll
                for (int i = 0; i < 32; ++i) d = fmaf(qs[h * 32 + i], kk[i], d);
                sc = fmaf(fmaxf(d, 0.f), qs[128 + h], sc);
            }
            sc = sc * 0.08838834764831845f + 0.0f;
            const unsigned u = __float_as_uint(sc);
            keys[s] = (u & 0x80000000u) ? ~u : (u | 0x80000000u);
        }
        __syncthreads();
        const int chunk = (n + 255) >> 8, lo = tid * chunk, hi = min(n, lo + chunk);
        unsigned prefix = 0; int krem = 256;
        for (int pass = 0; pass < 4; ++pass) {
            const int shift = 24 - 8 * pass;
            hist[tid] = 0; __syncthreads();
            for (int i = lo; i < hi; ++i) {
                const unsigned k = keys[i];
                if (pass == 0 || (k >> (shift + 8)) == prefix) atomicAdd(&hist[(k >> shift) & 255], 1);
            }
            __syncthreads();
            int above = 0;
            for (int bb = tid + 1; bb < 256; ++bb) above += hist[bb];
            const int mine = hist[tid];
            if (above < krem && krem <= above + mine) { ctl[0] = tid; ctl[1] = krem - above; ctl[2] = mine; }
            __syncthreads();
            prefix = (prefix << 8) | (unsigned)ctl[0]; krem = ctl[1];
            __syncthreads();
        }
        const unsigned thr = prefix; const int need = krem;
        int nt = 0; for (int i = lo; i < hi; ++i) nt += (keys[i] == thr);
        int tot; int trank = block_excl_scan(nt, scan, tid, tot);
        int ns = 0;
        { int tr = trank; for (int i = lo; i < hi; ++i) { const unsigned k = keys[i]; if (k > thr) ++ns; else if (k == thr) { if (tr < need) ++ns; ++tr; } } }
        int wpos = block_excl_scan(ns, scan, tid, tot);
        { int tr = trank; for (int i = lo; i < hi; ++i) { const unsigned k = keys[i]; bool sel = false; if (k > thr) sel = true; else if (k == thr) { sel = tr < need; ++tr; }
              if (sel) { p.DSEL[(size_t)g * 256 + wpos] = i; ++wpos; } } }
        if (tid == 0) p.DCNT[g] = tot;
        __syncthreads();
    }
}

__device__ void ph_nsa_cmp(const Params& p, int bid, int nb, float* smf) {
    const int lane = tidx() & 63, wid = tidx() >> 6;
    float* ps = smf + wid * (2048 + 256 + 128);
    float* qs = ps + 2048;
    float* imp = qs + 256;
    for (int g = bid * 4 + wid; g < T; g += nb * 4) {
        const int b = g / S, t = g % S;
        const int nv = t >= 31 ? min(NCMP, (t - 31) / 16 + 1) : 0;
        const float* pr = p.P + (size_t)g * NM;
        for (int i = lane; i < 256; i += 64) qs[i] = pr[C_NSA_Q + i];
        for (int i = lane; i < 2048; i += 64) ps[i] = 0.f;
        __builtin_amdgcn_wave_barrier();
        const float* kc = p.KC + (size_t)b * NCMP_PAD * 64;
        const float* vc = p.VC + (size_t)b * NCMP_PAD * 64;
        for (int h = 0; h < 4; ++h) {
            float l[8]; float m = -INFINITY;
#pragma unroll
            for (int j = 0; j < 8; ++j) {
                const int n = lane + 64 * j; l[j] = -INFINITY;
                if (n < nv) { float d = 0.f; const float* kr = kc + (size_t)n * 64; for (int i = 0; i < 64; ++i) d = fmaf(qs[h * 64 + i], kr[i], d); l[j] = d * 0.125f; }
                m = fmaxf(m, l[j]);
            }
            m = wave_max(m);
            if (m == -INFINITY) m = 0.f;
            float sum = 0.f;
#pragma unroll
            for (int j = 0; j < 8; ++j) { const int n = lane + 64 * j; l[j] = (n < nv) ? expf(l[j] - m) : 0.f; sum += l[j]; }
            sum = wave_sum(sum);
            const float inv = 1.f / fmaxf(sum, 1e-30f);
#pragma unroll
            for (int j = 0; j < 8; ++j) { const int n = lane + 64 * j; if (n < nv) ps[h * 512 + n] = l[j] * inv; }
            __builtin_amdgcn_wave_barrier();
            float o = 0.f;
            for (int n = 0; n < nv; ++n) o = fmaf(ps[h * 512 + n], vc[(size_t)n * 64 + lane], o);
            p.OCMP[(size_t)g * 256 + h * 64 + lane] = o;
        }
        __builtin_amdgcn_wave_barrier();
        const int cur = t >> 6;
        float myimp[2];
#pragma unroll
        for (int jj = 0; jj < 2; ++jj) {
            const int j = lane + 64 * jj;
            float a = 0.f;
            for (int h = 0; h < 4; ++h) for (int i = 0; i < 4; ++i) a += ps[h * 512 + 4 * j + i];
            const bool forced = (j == 0) || (j == cur) || (j == cur - 1);
            const bool vis = j <= cur;
            a = forced ? 1e4f : (vis ? a : -1.0f);
            myimp[jj] = a; imp[j] = a;
        }
        __builtin_amdgcn_wave_barrier();
        unsigned long long m0, m1;
        {
            int r0 = 0, r1 = 0;
            for (int i = 0; i < 128; ++i) {
                const float v = imp[i];
                r0 += (v > myimp[0]) || (v == myimp[0] && i < lane);
                r1 += (v > myimp[1]) || (v == myimp[1] && i < lane + 64);
            }
            m0 = __ballot(r0 < 16); m1 = __ballot(r1 < 16);
        }
        if (lane == 0) {
            unsigned* dst = p.SMASK + (size_t)g * 4;
            dst[0] = (unsigned)m0; dst[1] = (unsigned)(m0 >> 32); dst[2] = (unsigned)m1; dst[3] = (unsigned)(m1 >> 32);
        }
        __builtin_amdgcn_wave_barrier();
    }
}

__device__ __forceinline__ float dot64(const float (&q)[64], const float* __restrict__ k) {
    const float4* k4 = (const float4*)k; float s0 = 0.f, s1 = 0.f, s2 = 0.f, s3 = 0.f;
#pragma unroll
    for (int i = 0; i < 16; ++i) { const float4 kk = k4[i]; s0 = fmaf(q[4 * i], kk.x, s0); s1 = fmaf(q[4 * i + 1], kk.y, s1); s2 = fmaf(q[4 * i + 2], kk.z, s2); s3 = fmaf(q[4 * i + 3], kk.w, s3); }
    return (s0 + s1) + (s2 + s3);
}
__device__ __forceinline__ void axpy64(float (&acc)[64], float a, const float* __restrict__ v) {
    const float4* v4 = (const float4*)v;
#pragma unroll
    for (int i = 0; i < 16; ++i) { const float4 vv = v4[i]; acc[4 * i] = fmaf(a, vv.x, acc[4 * i]); acc[4 * i + 1] = fmaf(a, vv.y, acc[4 * i + 1]); acc[4 * i + 2] = fmaf(a, vv.z, acc[4 * i + 2]); acc[4 * i + 3] = fmaf(a, vv.w, acc[4 * i + 3]); }
}
__device__ __forceinline__ void load64(float (&q)[64], const float* __restrict__ src) {
    const float4* s4 = (const float4*)src;
#pragma unroll
    for (int i = 0; i < 16; ++i) { const float4 v = s4[i]; q[4 * i] = v.x; q[4 * i + 1] = v.y; q[4 * i + 2] = v.z; q[4 * i + 3] = v.w; }
}
struct OnlineSm {
    float m, l; float acc[64];
    __device__ __forceinline__ void init() { m = -INFINITY; l = 0.f;
#pragma unroll
        for (int i = 0; i < 64; ++i) acc[i] = 0.f; }
    __device__ __forceinline__ void update(float x, const float* __restrict__ v) {
        const float mn = fmaxf(m, x); const float corr = expf(m - mn), pe = expf(x - mn);
        l = l * corr + pe;
#pragma unroll
        for (int i = 0; i < 64; ++i) acc[i] *= corr;
        axpy64(acc, pe, v); m = mn;
    }
    __device__ __forceinline__ void finish() { const float inv = 1.f / fmaxf(l, 1e-30f);
#pragma unroll
        for (int i = 0; i < 64; ++i) acc[i] *= inv; }
};
__device__ __forceinline__ void store_gated(bf16_t* __restrict__ dst, const float (&acc)[64], const float* __restrict__ z) {
#pragma unroll
    for (int i = 0; i < 8; ++i) {
        const float4 z0 = ((const float4*)z)[2 * i], z1 = ((const float4*)z)[2 * i + 1];
        u32x4 o;
        o.x = cvt_pk_bf16(acc[8 * i] * silu_(z0.x), acc[8 * i + 1] * silu_(z0.y)); o.y = cvt_pk_bf16(acc[8 * i + 2] * silu_(z0.z), acc[8 * i + 3] * silu_(z0.w));
        o.z = cvt_pk_bf16(acc[8 * i + 4] * silu_(z1.x), acc[8 * i + 5] * silu_(z1.y)); o.w = cvt_pk_bf16(acc[8 * i + 6] * silu_(z1.z), acc[8 * i + 7] * silu_(z1.w));
        ((u32x4*)dst)[i] = o;
    }
}

template <int BR>
__device__ void ph_attn(const Params& p, int bid, int nb) {
    const int lane = tidx() & 63, wid = tidx() >> 6;
    for (int unit = bid; unit < T / 64; unit += nb) {
        const int h = __builtin_amdgcn_readfirstlane(wid);
        const int g0 = unit * 64, b = g0 / S, t0 = g0 % S;
        const int g = g0 + lane, t = t0 + lane;
        const float* pr = p.P + (size_t)g * NM;
        const float* pb = p.P + (size_t)b * S * NM;
        float q[64];
        if (BR == 0) {
            load64(q, pr + C_DSA_Q + h * 64);
            OnlineSm os; os.init();
            const int cnt = p.DCNT[g];
            const int* sel = p.DSEL + (size_t)g * 256;
            for (int i = 0; i < cnt; ++i) {
                const int s = sel[i];
                if (s <= t) {
                    const float x = dot64(q, p.KA + (size_t)(b * S + s) * 256 + h * 64) * 0.125f;
                    os.update(x, p.VA + (size_t)(b * S + s) * 256 + h * 64);
                }
            }
            os.finish();
            store_gated(p.Y + (size_t)g * 1280 + 0 + h * 64, os.acc, pr + C_DSA_Z + h * 64);
        } else if (BR == 1) {
            load64(q, pr + C_FOX_Q + h * 64);
            OnlineSm os; os.init();
            const float ct = p.CUM[(size_t)g * 4 + h];
            for (int s = 0; s <= t0 + 63; ++s) {
                const float* kr = pb + (size_t)s * NM + C_FOX_K + h * 64;
                const float* vr = pb + (size_t)s * NM + C_FOX_V + h * 64;
                const float cs = p.CUM[(size_t)(b * S + s) * 4 + h];
                if (s <= t) { const float x = dot64(q, kr) * 0.125f + ct - cs; os.update(x, vr); }
            }
            os.finish();
            store_gated(p.Y + (size_t)g * 1280 + 256 + h * 64, os.acc, pr + C_FOX_Z + h * 64);
        } else if (BR == 2) {
            load64(q, pr + C_SB_Q + h * 64);
            float acc[64];
#pragma unroll
            for (int i = 0; i < 64; ++i) acc[i] = 0.f;
            float R = 0.f;
            for (int s = t0 + 62; s >= 0; --s) {
                const float* kr = pb + (size_t)s * NM + C_SB_K + h * 64;
                const float* vr = pb + (size_t)s * NM + C_SB_V + h * 64;
                if (s < t) {
                    const float z = dot64(q, kr) * 0.125f;
                    const float ls = logsig_(z);
                    const float a = expf(ls + R);
                    axpy64(acc, a, vr);
                    R += ls - z;
                }
            }
            store_gated(p.Y + (size_t)g * 1280 + 512 + h * 64, acc, pr + C_SB_Z + h * 64);
        } else if (BR == 3) {
            load64(q, pr + C_NSA_Q + h * 64);
            OnlineSm os; os.init();
            const unsigned* mk = p.SMASK + (size_t)g * 4;
            for (int w = 0; w < 4; ++w) {
                unsigned bits = mk[w];
                while (bits) {
                    const int j = w * 32 + __builtin_ctz(bits); bits &= bits - 1;
                    for (int i = 0; i < 64; ++i) {
                        const int s = j * 64 + i;
                        if (s <= t) {
                            const float x = dot64(q, pb + (size_t)s * NM + C_NSA_KS) * 0.125f;
                            os.update(x, pb + (size_t)s * NM + C_NSA_VS);
                        }
                    }
                }
            }
            os.finish();
            const float g0w = sigmoid_(pr[C_NSA_G + 0 * 4 + h]), g1w = sigmoid_(pr[C_NSA_G + 1 * 4 + h]);
            float* oc = p.OCMP + (size_t)g * 256 + h * 64;
#pragma unroll
            for (int i = 0; i < 16; ++i) {
                float4 v = ((float4*)oc)[i];
                v.x = g0w * v.x + g1w * os.acc[4 * i]; v.y = g0w * v.y + g1w * os.acc[4 * i + 1]; v.z = g0w * v.z + g1w * os.acc[4 * i + 2]; v.w = g0w * v.w + g1w * os.acc[4 * i + 3];
                ((float4*)oc)[i] = v;
            }
        } else if (BR == 5) {
            load64(q, pr + C_NSA_Q + h * 64);
            OnlineSm os; os.init();
            const int slo = max(0, t0 - 511);
            for (int s = slo; s <= t0 + 63; ++s) {
                const float* kr = pb + (size_t)s * NM + C_NSA_KW;
                const float* vr = pb + (size_t)s * NM + C_NSA_VW;
                const int d = t - s;
                if (d >= 0 && d < 512) { const float x = dot64(q, kr) * 0.125f; os.update(x, vr); }
            }
            os.finish();
            const float g2w = sigmoid_(pr[C_NSA_G + 2 * 4 + h]);
            const float* oc = p.OCMP + (size_t)g * 256 + h * 64;
#pragma unroll
            for (int i = 0; i < 16; ++i) {
                const float4 v = ((const float4*)oc)[i];
                os.acc[4 * i] = fmaf(g2w, os.acc[4 * i], v.x); os.acc[4 * i + 1] = fmaf(g2w, os.acc[4 * i + 1], v.y);
                os.acc[4 * i + 2] = fmaf(g2w, os.acc[4 * i + 2], v.z); os.acc[4 * i + 3] = fmaf(g2w, os.acc[4 * i + 3], v.w);
            }
            store_gated(p.Y + (size_t)g * 1280 + 768 + h * 64, os.acc, pr + C_NSA_Z + h * 64);
        } else {
            load64(q, pr + C_MEM_Q + h * 64);
            OnlineSm os; os.init();
            for (int m = 0; m < NMEM; ++m) {
                const float* kr = p.MKV + (size_t)(b * NMEM + m) * 512 + h * 64;
                const float x = dot64(q, kr) * 0.125f;
                os.update(x, kr + 256);
            }
            os.finish();
            store_gated(p.Y + (size_t)g * 1280 + 1024 + h * 64, os.acc, pr + C_MEM_Z + h * 64);
        }
    }
}

#define XB_TMO      128
#define XB_XCNT(j)  (256  + 64 * (j))
#define XB_XSUB(j)  (1280 + 64 * (j))
#define XB_XGEN(j)  (2304 + 64 * (j))
#define XB_TOP      3328
#define XB_TOPGEN   3392
#define XCD_BAR_WORDS 3456
#define XB_SPIN_CAP (1u << 18)
#define LAS __attribute__((address_space(3)))

__device__ __forceinline__ unsigned xb_ld(unsigned* p)              { return __hip_atomic_load(p, __ATOMIC_RELAXED, __HIP_MEMORY_SCOPE_AGENT); }
__device__ __forceinline__ unsigned xb_add(unsigned* p, unsigned v) { return __hip_atomic_fetch_add(p, v, __ATOMIC_RELAXED, __HIP_MEMORY_SCOPE_AGENT); }
__device__ __forceinline__ unsigned xb_xcc_id() { return (unsigned)__builtin_amdgcn_s_getreg((3 << 11) | 20) & 0xFu; }
#define XB_SPIN(cond, bar) do { unsigned _sp = 0; while (cond) { __builtin_amdgcn_s_sleep(1); \
    if ((++_sp & 255u) == 0u) { if (xb_ld(&(bar)[XB_TMO])) break; if (_sp > XB_SPIN_CAP) { atomicAdd(&(bar)[XB_TMO], 1u); break; } } } } while (0)

struct XcdBarrier {
    unsigned* bar; unsigned x;
    volatile LAS unsigned* st;
};
__device__ __forceinline__ XcdBarrier xcd_barrier_post(unsigned* bar, volatile LAS unsigned* st) {
    XcdBarrier b; b.bar = bar; b.x = xb_xcc_id(); b.st = st;
    if (threadIdx.x == 0) (void)xb_add(&bar[XB_XCNT(b.x)], 1u);
    return b;
}
__device__ __forceinline__ void xcd_barrier_complete(unsigned* bar, unsigned x, unsigned& nloc, unsigned& nx) {
    const unsigned G = gridDim.x * gridDim.y * gridDim.z;
    unsigned sum, cnt, mine, sp = 0u;
    for (;;) {
        sum = 0u; cnt = 0u; mine = 0u;
#pragma unroll
        for (unsigned j = 0; j < 16; ++j) { const unsigned c = xb_ld(&bar[XB_XCNT(j)]); sum += c; cnt += (c > 0u) ? 1u : 0u; mine = (j == x) ? c : mine; }
        if (sum == G) break;
        __builtin_amdgcn_s_sleep(1);
        if ((++sp & 255u) == 0u) { if (xb_ld(&bar[XB_TMO])) break; if (sp > XB_SPIN_CAP) { atomicAdd(&bar[XB_TMO], 1u); break; } }
    }
    nloc = mine > 0u ? mine : 1u; nx = cnt > 0u ? cnt : 1u;
}
__device__ __forceinline__ void xcd_barrier(const XcdBarrier& b) {
    asm volatile("s_waitcnt vmcnt(0)" ::: "memory");
    __syncthreads();
    if (threadIdx.x == 0) {
        unsigned* bar = b.bar;
        __builtin_amdgcn_s_waitcnt(0);
        unsigned nloc = b.st[0], nx = b.st[1];
        if (nloc == 0u) { xcd_barrier_complete(bar, b.x, nloc, nx); b.st[0] = nloc; b.st[1] = nx; }
        const unsigned old = xb_add(&bar[XB_XSUB(b.x)], 1u);
        const unsigned gen = old / nloc;
        if (old + 1u == (gen + 1u) * nloc) {
            __builtin_amdgcn_fence(__ATOMIC_RELEASE, "agent");
            asm volatile("s_waitcnt vmcnt(0)" ::: "memory");
            const unsigned og = xb_add(&bar[XB_TOP], 1u);
            const unsigned tg = og / nx;
            if (og + 1u == (tg + 1u) * nx) xb_add(&bar[XB_TOPGEN], 1u);
            else XB_SPIN(xb_ld(&bar[XB_TOPGEN]) == tg, bar);
            __builtin_amdgcn_fence(__ATOMIC_ACQUIRE, "agent");
            xb_add(&bar[XB_XGEN(b.x)], 1u);
            asm volatile("s_waitcnt vmcnt(0)" ::: "memory");
        } else {
            XB_SPIN(xb_ld(&bar[XB_XGEN(b.x)]) == gen, bar);
            __builtin_amdgcn_fence(__ATOMIC_ACQUIRE, "agent");
            asm volatile("s_waitcnt vmcnt(0)" ::: "memory");
        }
    }
    __syncthreads();
}

__global__ void __launch_bounds__(256, 2) mega(Params p) {
    __shared__ __attribute__((aligned(16))) char smem[40960];
    __shared__ uint4 xb_words;
    if (threadIdx.x == 0) xb_words = make_uint4(0u, 0u, 0u, 0u);
    __syncthreads();
    XcdBarrier bar = xcd_barrier_post(p.bar, (volatile LAS unsigned*)&xb_words);
    const int bid = blockIdx.x, nb = gridDim.x;
    float* smf = (float*)smem;

    convert_wt(p.w_in, p.WIN, D, NIN, DEPTH, bid, nb, smf);
    convert_wt(p.w_branch, p.WBR, 256, D, DEPTH * 5, bid, nb, smf);
    convert_wt(p.w_out, p.WOUT, D, D, DEPTH, bid, nb, smf);
    convert_wt(p.w_mem_kv, p.WMKV, D, 512, DEPTH, bid, nb, smf);
    convert_wt(p.w_uk, p.WUK, 128, 256, DEPTH, bid, nb, smf);
    convert_wt(p.w_uv, p.WUV, 128, 256, DEPTH, bid, nb, smf);
    ph_rope_table(p, bid, nb);
    for (int l = 0; l < DEPTH; ++l) {
        const float* Xin = l == 0 ? p.x : p.X;
        ph_rmsnorm<bf16_t>(Xin, p.norm_g + l * D, p.H, T, bid, nb);
        ph_rmsnorm<bf16_t>(p.mem, p.mem_norm + l * D, p.MEMN, NBATCH * NMEM, bid, nb);
        xcd_barrier(bar);
        { EpiStore e{p.P, NM}; gemm_bf16<128>(p.H, D, p.WIN + (size_t)l * NIN * D, D, T, NM, D, e, bid, nb, smem); }
        { EpiStore e{p.MKV, 512}; gemm_bf16<128>(p.MEMN, D, p.WMKV + (size_t)l * 512 * D, D, NBATCH * NMEM, 512, D, e, bid, nb, smem); }
        xcd_barrier(bar);
        ph_ckvnorm(p, l, bid, nb);
        xcd_barrier(bar);
        { EpiStore e{p.KA, 256}; gemm_bf16<128>(p.CKV, 128, p.WUK + (size_t)l * 256 * 128, 128, T, 256, 128, e, bid, nb, smem); }
        { EpiStore e{p.VA, 256}; gemm_bf16<128>(p.CKV, 128, p.WUV + (size_t)l * 256 * 128, 128, T, 256, 128, e, bid, nb, smem); }
        xcd_barrier(bar);
        ph_prep(p, l, bid, nb);
        xcd_barrier(bar);
        ph_cumsum(p, bid, nb, smf);
        ph_compress(p, l, bid, nb, smf);
        xcd_barrier(bar);
        ph_dsa_select(p, bid, nb, smf);
        ph_nsa_cmp(p, bid, nb, smf);
        xcd_barrier(bar);
        ph_attn<1>(p, bid, nb);
        ph_attn<2>(p, bid, nb);
        ph_attn<3>(p, bid, nb);
        ph_attn<5>(p, bid, nb);
        ph_attn<0>(p, bid, nb);
        ph_attn<4>(p, bid, nb);
        xcd_barrier(bar);
        ph_merge(p, l, bid, nb, smem);
        xcd_barrier(bar);
        { EpiResid e{Xin, p.X}; gemm_bf16<128>(p.MG, D, p.WOUT + (size_t)l * D * D, D, T, D, D, e, bid, nb, smem); }
        xcd_barrier(bar);
    }
    ph_rmsnorm<float>(p.X, p.final_norm, p.X, T, bid, nb);
}
}

extern "C" void kernel_launch(void* const* d_in, const int* in_sizes, int n_in, void* d_out, int out_size, void* d_ws, size_t ws_size, hipStream_t stream) {
    (void)in_sizes; (void)n_in; (void)out_size;
    Params p{};
    p.x = (const float*)d_in[0]; p.mem = (const float*)d_in[1]; p.pos = (const int*)d_in[2]; p.norm_g = (const float*)d_in[3];
    p.w_in = (const float*)d_in[4]; p.kv_norm = (const float*)d_in[5]; p.w_uk = (const float*)d_in[6]; p.w_uv = (const float*)d_in[7];
    p.fox_bias = (const float*)d_in[8]; p.pe_k = (const float*)d_in[9]; p.pe_v = (const float*)d_in[10]; p.wc1_k = (const float*)d_in[11];
    p.wc2_k = (const float*)d_in[12]; p.wc1_v = (const float*)d_in[13]; p.wc2_v = (const float*)d_in[14]; p.mem_norm = (const float*)d_in[15];
    p.w_mem_kv = (const float*)d_in[16]; p.w_branch = (const float*)d_in[17]; p.w_out = (const float*)d_in[18]; p.final_norm = (const float*)d_in[19];
    p.X = (float*)d_out;
    size_t off = 0; char* ws = (char*)d_ws;
    auto carve = [&](size_t bytes) { char* r = ws + off; off += (bytes + 255) & ~(size_t)255; return r; };
    p.bar = (unsigned*)carve(XCD_BAR_WORDS * 4);
    p.P = (float*)carve((size_t)T * NM * 4);
    p.MG = (bf16_t*)p.P;
    p.H = (bf16_t*)carve((size_t)T * D * 2);
    p.Y = (bf16_t*)carve((size_t)T * 1280 * 2);
    p.CKV = (bf16_t*)carve((size_t)T * 128 * 2);
    p.KA = (float*)carve((size_t)T * 256 * 4);
    p.VA = (float*)carve((size_t)T * 256 * 4);
    p.OCMP = (float*)carve((size_t)T * 256 * 4);
    p.LOGF = (float*)carve((size_t)T * 4 * 4);
    p.CUM = (float*)carve((size_t)T * 4 * 4);
    p.KC = (float*)carve((size_t)NBATCH * NCMP_PAD * 64 * 4);
    p.VC = (float*)carve((size_t)NBATCH * NCMP_PAD * 64 * 4);
    p.MEMN = (bf16_t*)carve((size_t)NBATCH * NMEM * D * 2);
    p.MKV = (float*)carve((size_t)NBATCH * NMEM * 512 * 4);
    p.ROPE = (float*)carve((size_t)T * 64 * 4);
    p.DSEL = (int*)carve((size_t)T * 256 * 4);
    p.DCNT = (int*)carve((size_t)T * 4);
    p.SMASK = (unsigned*)carve((size_t)T * 4 * 4);
    p.WIN = (bf16_t*)carve((size_t)DEPTH * NIN * D * 2);
    p.WBR = (bf16_t*)carve((size_t)DEPTH * 5 * D * 256 * 2);
    p.WOUT = (bf16_t*)carve((size_t)DEPTH * D * D * 2);
    p.WMKV = (bf16_t*)carve((size_t)DEPTH * 512 * D * 2);
    p.WUK = (bf16_t*)carve((size_t)DEPTH * 256 * 128 * 2);
    p.WUV = (bf16_t*)carve((size_t)DEPTH * 256 * 128 * 2);
    if (off > ws_size) { fprintf(stderr, "kernel_launch: workspace too small (%zu > %zu)\n", off, ws_size); return; }

    static int grid = 0;
    if (grid == 0) {
        int dev = 0, cus = 0, per_cu = 0;
        hipGetDevice(&dev);
        hipDeviceGetAttribute(&cus, hipDeviceAttributeMultiprocessorCount, dev);
        hipOccupancyMaxActiveBlocksPerMultiprocessor(&per_cu, (const void*)mega, 256, 0);
        (void)hipGetLastError();
        if (per_cu < 1) per_cu = 1;
        grid = cus * (per_cu < 2 ? per_cu : 2);
    }
    hipMemsetAsync(p.bar, 0, XCD_BAR_WORDS * sizeof(unsigned), stream);
    hipLaunchKernelGGL(mega, dim3(grid), dim3(256), 0, stream, p);
}
```

```cpp
#include <hip/hip_runtime.h>
#include <stdint.h>
#include <math.h>
#include <cstdio>

namespace {
constexpr int S = 8192, NBATCH = 2, T = NBATCH * S, D = 1024, NIN = 9396, NM = 4276, DEPTH = 4, NMEM = 256;
constexpr int NCMP = 511, NCMP_PAD = 512;
constexpr int C_DSA_Q = 0, C_CKV = 256, C_IDXQ = 384, C_IDXK = 512, C_IDXW = 544, C_DSA_Z = 548,
              C_FOX_Q = 804, C_FOX_K = 1060, C_FOX_V = 1316, C_FOX_F = 1572, C_FOX_Z = 1576,
              C_SB_Q = 1832, C_SB_K = 2088, C_SB_V = 2344, C_SB_Z = 2600,
              C_NSA_Q = 2856, C_NSA_KC = 3112, C_NSA_VC = 3176, C_NSA_KS = 3240, C_NSA_VS = 3304, C_NSA_KW = 3368, C_NSA_VW = 3432,
              C_NSA_G = 3496, C_NSA_Z = 3508, C_MEM_Q = 3764, C_MEM_Z = 4020, C_MERGE = 4276;

typedef unsigned short bf16_t;
typedef short bf16x8 __attribute__((ext_vector_type(8)));
typedef float f32x16 __attribute__((ext_vector_type(16)));
typedef unsigned u32x4 __attribute__((ext_vector_type(4)));
typedef unsigned u32x2 __attribute__((ext_vector_type(2)));

struct Params {
    const float* x; const float* mem; const int* pos; const float* norm_g; const float* w_in; const float* kv_norm;
    const float* w_uk; const float* w_uv; const float* fox_bias; const float* pe_k; const float* pe_v;
    const float* wc1_k; const float* wc2_k; const float* wc1_v; const float* wc2_v; const float* mem_norm;
    const float* w_mem_kv; const float* w_branch; const float* w_out; const float* final_norm;
    float* X;
    float *P, *KA, *VA, *LOGF, *CUM, *KC, *VC, *OCMP, *MKV, *ROPE;
    bf16_t *H, *CKV, *Y, *MG, *MEMN;
    bf16_t *WIN, *WBR, *WOUT, *WMKV, *WUK, *WUV;
    bf16_t *QA, *KAB, *VAT, *QF, *KF, *VFT, *QS, *KSB, *VST, *QN, *KSLC, *VSLCT, *KWIN, *VWINT, *QM, *MKB, *MVT;
    float *CUMT, *OSLC, *OWIN;
    unsigned* DMASK; unsigned* SMASK; unsigned* bar; unsigned* qctr;
};

typedef __bf16 bf16x2_t __attribute__((ext_vector_type(2)));
__device__ __forceinline__ unsigned cvt_pk_bf16(float lo, float hi) { bf16x2_t v; v.x = (__bf16)lo; v.y = (__bf16)hi; return __builtin_bit_cast(unsigned, v); }
__device__ __forceinline__ bf16_t f2bf(float x) { return (bf16_t)(cvt_pk_bf16(x, 0.f) & 0xffffu); }
__device__ __forceinline__ int tidx() { int t = threadIdx.x; asm volatile("" : "+v"(t)); return t; }
__device__ __forceinline__ float sigmoid_(float x) { return 1.f / (1.f + expf(-x)); }
__device__ __forceinline__ float silu_(float x) { return x / (1.f + expf(-x)); }
__device__ __forceinline__ float logsig_(float x) { return fminf(x, 0.f) - log1pf(expf(-fabsf(x))); }
__device__ __forceinline__ float wave_sum(float v) {
#pragma unroll
    for (int o = 32; o > 0; o >>= 1) v += __shfl_xor(v, o, 64);
    return v;
}
__device__ __forceinline__ float wave_max(float v) {
#pragma unroll
    for (int o = 32; o > 0; o >>= 1) v = fmaxf(v, __shfl_xor(v, o, 64));
    return v;
}

__device__ void ph_rope_table(const Params& p, int bid, int nb) {
    for (int i = bid * 256 + tidx(); i < T * 32; i += nb * 256) {
        const int t = i >> 5, f = i & 31;
        const double inv = pow(10000.0, -(double)f / 32.0);
        const double ang = (double)p.pos[t] * inv;
        p.ROPE[(size_t)t * 64 + f] = (float)cos(ang);
        p.ROPE[(size_t)t * 64 + 32 + f] = (float)sin(ang);
    }
}

template <class OUT>
__device__ void ph_rmsnorm(const float* in, const float* g, OUT* out, int rows, int bid, int nb) {
    const int lane = tidx() & 63, wid = tidx() >> 6;
    for (int r = bid * 4 + wid; r < rows; r += nb * 4) {
        const float4* ip = (const float4*)(in + (size_t)r * D);
        float4 v[4]; float ss = 0.f;
#pragma unroll
        for (int i = 0; i < 4; ++i) { v[i] = ip[lane + 64 * i]; ss += v[i].x * v[i].x + v[i].y * v[i].y + v[i].z * v[i].z + v[i].w * v[i].w; }
        ss = wave_sum(ss);
        const float sc = 1.0f / sqrtf(ss * (1.f / D) + 1e-6f);
#pragma unroll
        for (int i = 0; i < 4; ++i) {
            const float4 gg = ((const float4*)g)[lane + 64 * i];
            float4 o; o.x = v[i].x * sc * gg.x; o.y = v[i].y * sc * gg.y; o.z = v[i].z * sc * gg.z; o.w = v[i].w * sc * gg.w;
            if constexpr (sizeof(OUT) == 4) ((float4*)((float*)out + (size_t)r * D))[lane + 64 * i] = o;
            else { u32x2 w; w.x = cvt_pk_bf16(o.x, o.y); w.y = cvt_pk_bf16(o.z, o.w); ((u32x2*)((bf16_t*)out + (size_t)r * D))[lane + 64 * i] = w; }
        }
    }
}

__device__ void ph_ckvnorm(const Params& p, int layer, int bid, int nb) {
    const int lane = tidx() & 63, wid = tidx() >> 6;
    const float* g = p.kv_norm + layer * 128;
    for (int r = bid * 4 + wid; r < T; r += nb * 4) {
        const float* ip = p.P + (size_t)r * NM + C_CKV;
        const float a = ip[lane], b = ip[lane + 64];
        const float ss = wave_sum(a * a + b * b);
        const float sc = 1.0f / sqrtf(ss * (1.f / 128.f) + 1e-6f);
        p.CKV[(size_t)r * 128 + lane] = f2bf(a * sc * g[lane]);
        p.CKV[(size_t)r * 128 + lane + 64] = f2bf(b * sc * g[lane + 64]);
    }
}

__device__ void convert_wt(const float* __restrict__ src, bf16_t* __restrict__ dst, int K, int N, int nmat, int bid, int nb, float* sm) {
    float (*tl)[65] = (float (*)[65])sm;
    const int tid = tidx(), tk = K / 64, tn = (N + 63) / 64, per = tk * tn;
    for (int it = bid; it < per * nmat; it += nb) {
        const int mat = it / per, r = it % per, k0 = (r % tk) * 64, n0 = (r / tk) * 64;
        const float* s = src + (size_t)mat * K * N; bf16_t* d = dst + (size_t)mat * K * N;
        for (int i = tid; i < 64 * 64; i += 256) { const int kk = i >> 6, nn = i & 63; tl[kk][nn] = (n0 + nn < N) ? s[(size_t)(k0 + kk) * N + n0 + nn] : 0.f; }
        __syncthreads();
        {
            const int nn = tid >> 2, kq = (tid & 3) * 16;
            if (n0 + nn < N) {
                u32x4 w0, w1;
                w0.x = cvt_pk_bf16(tl[kq + 0][nn], tl[kq + 1][nn]); w0.y = cvt_pk_bf16(tl[kq + 2][nn], tl[kq + 3][nn]);
                w0.z = cvt_pk_bf16(tl[kq + 4][nn], tl[kq + 5][nn]); w0.w = cvt_pk_bf16(tl[kq + 6][nn], tl[kq + 7][nn]);
                w1.x = cvt_pk_bf16(tl[kq + 8][nn], tl[kq + 9][nn]); w1.y = cvt_pk_bf16(tl[kq + 10][nn], tl[kq + 11][nn]);
                w1.z = cvt_pk_bf16(tl[kq + 12][nn], tl[kq + 13][nn]); w1.w = cvt_pk_bf16(tl[kq + 14][nn], tl[kq + 15][nn]);
                u32x4* dp = (u32x4*)(d + (size_t)(n0 + nn) * K + k0 + kq);
                dp[0] = w0; dp[1] = w1;
            }
        }
        __syncthreads();
    }
}

constexpr int GROW = 80;
constexpr int GA_BYTES = 128 * GROW;
template <int BN>
__device__ __forceinline__ void tile_mac(f32x16 (&acc)[2][BN / 64], const bf16_t* __restrict__ A, int lda, int m0,
                                         const bf16_t* __restrict__ Bt, int ldb, int n0, int nmax, int K, char* sm) {
    constexpr int NT = BN / 64;
    constexpr int B_BYTES = BN * GROW;
    constexpr int BUF = GA_BYTES + B_BYTES;
    const int tid = tidx(), lane = tid & 63, wid = tid >> 6, wr = wid >> 1, wc = wid & 1;
    const int lr = lane & 31, lh = lane >> 5;
    const int ar0 = tid >> 2, akq = tid & 3;
    const bf16_t* ap0 = A + (size_t)(m0 + ar0) * lda + akq * 8;
    const bf16_t* ap1 = A + (size_t)(m0 + ar0 + 64) * lda + akq * 8;
    const int br0 = tid >> 2;
    const bool bv0 = (n0 + br0) < nmax, bv1 = (NT == 2) && ((n0 + br0 + 64) < nmax);
    const bf16_t* bp0 = Bt + (size_t)(bv0 ? (n0 + br0) : 0) * ldb + akq * 8;
    const bf16_t* bp1 = Bt + (size_t)(bv1 ? (n0 + br0 + 64) : 0) * ldb + akq * 8;
    const int st_a0 = ar0 * GROW + akq * 16, st_a1 = (ar0 + 64) * GROW + akq * 16;
    const int st_b0 = GA_BYTES + br0 * GROW + akq * 16, st_b1 = GA_BYTES + (br0 + 64) * GROW + akq * 16;
    const int rd_a = (wr * 64 + lr) * GROW + lh * 16, rd_b = GA_BYTES + (wc * (BN / 2) + lr) * GROW + lh * 16;
    const u32x4 zero4 = {0u, 0u, 0u, 0u};
    u32x4 ra0, ra1, rb0, rb1 = zero4;
    ra0 = *(const u32x4*)ap0; ra1 = *(const u32x4*)ap1;
    rb0 = bv0 ? *(const u32x4*)bp0 : zero4; if (NT == 2) rb1 = bv1 ? *(const u32x4*)bp1 : zero4;
    __syncthreads();
    *(u32x4*)(sm + st_a0) = ra0; *(u32x4*)(sm + st_a1) = ra1; *(u32x4*)(sm + st_b0) = rb0; if (NT == 2) *(u32x4*)(sm + st_b1) = rb1;
    __syncthreads();
    const int nk = K / 32;
    for (int ks = 0; ks < nk; ++ks) {
        char* cur = sm + (ks & 1) * BUF;
        char* nxt = sm + ((ks + 1) & 1) * BUF;
        const bool more = (ks + 1) < nk;
        if (more) {
            const int ko = (ks + 1) * 32;
            ra0 = *(const u32x4*)(ap0 + ko); ra1 = *(const u32x4*)(ap1 + ko);
            rb0 = bv0 ? *(const u32x4*)(bp0 + ko) : zero4; if (NT == 2) rb1 = bv1 ? *(const u32x4*)(bp1 + ko) : zero4;
        }
#pragma unroll
        for (int s = 0; s < 2; ++s) {
            bf16x8 a[2], b[NT];
#pragma unroll
            for (int mi = 0; mi < 2; ++mi) a[mi] = *(const bf16x8*)(cur + rd_a + mi * 32 * GROW + s * 32);
#pragma unroll
            for (int ni = 0; ni < NT; ++ni) b[ni] = *(const bf16x8*)(cur + rd_b + ni * 32 * GROW + s * 32);
#pragma unroll
            for (int mi = 0; mi < 2; ++mi)
#pragma unroll
                for (int ni = 0; ni < NT; ++ni) acc[mi][ni] = __builtin_amdgcn_mfma_f32_32x32x16_bf16(a[mi], b[ni], acc[mi][ni], 0, 0, 0);
        }
        if (more) { *(u32x4*)(nxt + st_a0) = ra0; *(u32x4*)(nxt + st_a1) = ra1; *(u32x4*)(nxt + st_b0) = rb0; if (NT == 2) *(u32x4*)(nxt + st_b1) = rb1; }
        __syncthreads();
    }
}
template <int NT> __device__ __forceinline__ void acc_zero(f32x16 (&acc)[2][NT]) {
#pragma unroll
    for (int mi = 0; mi < 2; ++mi)
#pragma unroll
        for (int ni = 0; ni < NT; ++ni)
#pragma unroll
            for (int r = 0; r < 16; ++r) acc[mi][ni][r] = 0.f;
}
template <int BN, class Epi>
__device__ void gemm_bf16(const bf16_t* A, int lda, const bf16_t* Bt, int ldb, int M, int N, int K, const Epi& epi, int bid, int nb, char* sm) {
    constexpr int NT = BN / 64;
    const int tm = M / 128, tn = (N + BN - 1) / BN;
    const int lane = tidx() & 63, wid = tidx() >> 6, wr = wid >> 1, wc = wid & 1, lr = lane & 31, lh = lane >> 5;
    for (int tile = bid; tile < tm * tn; tile += nb) {
        const int m0 = (tile % tm) * 128, n0 = (tile / tm) * BN;
        f32x16 acc[2][NT]; acc_zero<NT>(acc);
        tile_mac<BN>(acc, A, lda, m0, Bt, ldb, n0, N, K, sm);
#pragma unroll
        for (int mi = 0; mi < 2; ++mi)
#pragma unroll
            for (int ni = 0; ni < NT; ++ni) {
                const int col = n0 + wc * (BN / 2) + ni * 32 + lr;
                if (col < N) {
#pragma unroll
                    for (int r = 0; r < 16; ++r) epi(m0 + wr * 64 + mi * 32 + (r & 3) + 8 * (r >> 2) + 4 * lh, col, acc[mi][ni][r]);
                }
            }
    }
}
struct EpiStore { float* C; int ldc; __device__ __forceinline__ void operator()(int r, int c, float v) const { C[(size_t)r * ldc + c] = v; } };
struct EpiResid { const float* Xin; float* Xout;
    __device__ __forceinline__ void operator()(int r, int c, float v) const { const size_t i = (size_t)r * D + c; Xout[i] = Xin[i] + v; } };

__device__ void ph_merge(const Params& p, int layer, int bid, int nb, char* sm) {
    const int lane = tidx() & 63, wid = tidx() >> 6, wr = wid >> 1, wc = wid & 1, lr = lane & 31, lh = lane >> 5;
    const bf16_t* win = p.WIN;
    for (int tile = bid; tile < (T / 128) * (D / 64); tile += nb) {
        const int m0 = (tile % (T / 128)) * 128, n0 = (tile / (T / 128)) * 64;
        f32x16 mg[2][1]; acc_zero<1>(mg);
        for (int n = 0; n < 5; ++n) {
            f32x16 g[2][1], yb[2][1]; acc_zero<1>(g); acc_zero<1>(yb);
            tile_mac<64>(g, p.H, D, m0, win + (size_t)(C_MERGE + n * D) * D, D, n0, D, D, sm);
            tile_mac<64>(yb, p.Y + n * 256, 1280, m0, p.WBR + ((size_t)layer * 5 + n) * D * 256, 256, n0, D, 256, sm);
#pragma unroll
            for (int mi = 0; mi < 2; ++mi)
#pragma unroll
                for (int r = 0; r < 16; ++r) mg[mi][0][r] = fmaf(sigmoid_(g[mi][0][r]), yb[mi][0][r], mg[mi][0][r]);
        }
#pragma unroll
        for (int mi = 0; mi < 2; ++mi)
#pragma unroll
            for (int r = 0; r < 16; ++r) {
                const int row = m0 + wr * 64 + mi * 32 + (r & 3) + 8 * (r >> 2) + 4 * lh, col = n0 + wc * 32 + lr;
                p.MG[(size_t)row * D + col] = f2bf(mg[mi][0][r]);
            }
    }
}

__device__ __forceinline__ void rope_vals(const float* src, int i0, int half, float c, float s, float& o1, float& o2) {
    const float x1 = src[i0], x2 = src[i0 + half]; o1 = x1 * c - x2 * s; o2 = x2 * c + x1 * s;
}
__device__ __forceinline__ void transpose64(const float* __restrict__ src, int ld_src, bf16_t* __restrict__ dst, size_t ldd, float* sm, int tid) {
    float (*tl)[65] = (float (*)[65])sm;
    for (int i = tid; i < 4096; i += 256) { const int r = i >> 6, c = i & 63; tl[r][c] = src[(size_t)r * ld_src + c]; }
    __syncthreads();
    {
        const int c = tid >> 2, rq = (tid & 3) * 16;
        u32x4 w0, w1;
        w0.x = cvt_pk_bf16(tl[rq + 0][c], tl[rq + 1][c]); w0.y = cvt_pk_bf16(tl[rq + 2][c], tl[rq + 3][c]);
        w0.z = cvt_pk_bf16(tl[rq + 4][c], tl[rq + 5][c]); w0.w = cvt_pk_bf16(tl[rq + 6][c], tl[rq + 7][c]);
        w1.x = cvt_pk_bf16(tl[rq + 8][c], tl[rq + 9][c]); w1.y = cvt_pk_bf16(tl[rq + 10][c], tl[rq + 11][c]);
        w1.z = cvt_pk_bf16(tl[rq + 12][c], tl[rq + 13][c]); w1.w = cvt_pk_bf16(tl[rq + 14][c], tl[rq + 15][c]);
        u32x4* dp = (u32x4*)(dst + (size_t)c * ldd + rq);
        dp[0] = w0; dp[1] = w1;
    }
    __syncthreads();
}
__device__ void ph_prep(const Params& p, int layer, int bid, int nb, float* sm) {
    const int tid = tidx();
    constexpr int ITEMS = 1844;
    for (int tile = bid; tile < T / 64 + 8; tile += nb) {
        if (tile >= T / 64) {
            const int r0 = (tile - T / 64) * 64, b = r0 / NMEM, m0 = r0 % NMEM;
            for (int i = tid; i < 64 * 256; i += 256) { const int r = i >> 8, c = i & 255; p.MKB[(size_t)(r0 + r) * 256 + c] = f2bf(p.MKV[(size_t)(r0 + r) * 512 + c]); }
            for (int h = 0; h < 4; ++h) transpose64(p.MKV + (size_t)r0 * 512 + 256 + h * 64, 512, p.MVT + ((size_t)(b * 4 + h) * 64) * NMEM + m0, NMEM, sm, tid);
            continue;
        }
        const int g0 = tile * 64, b = g0 / S, t0 = g0 % S;
        for (int idx = tid; idx < 64 * ITEMS; idx += 256) {
            const int tk = idx / ITEMS, i = idx % ITEMS;
            const size_t g = (size_t)g0 + tk;
            float* pr = p.P + g * NM;
            const float* rt = p.ROPE + g * 64;
            float o1, o2;
            if (i < 128) { const int h = i >> 5, f = i & 31; rope_vals(pr + C_DSA_Q + h * 64, f, 32, rt[f], rt[32 + f], o1, o2); p.QA[g * 256 + h * 64 + f] = f2bf(o1); p.QA[g * 256 + h * 64 + 32 + f] = f2bf(o2); }
            else if (i < 256) { const int j = i - 128, h = j >> 5, f = j & 31; rope_vals(p.KA + g * 256 + h * 64, f, 32, rt[f], rt[32 + f], o1, o2); p.KAB[g * 256 + h * 64 + f] = f2bf(o1); p.KAB[g * 256 + h * 64 + 32 + f] = f2bf(o2); }
            else if (i < 384) { const int j = i - 256, h = j >> 5, f = j & 31; float* q = pr + C_NSA_Q + h * 64; rope_vals(q, f, 32, rt[f], rt[32 + f], o1, o2); q[f] = o1; q[f + 32] = o2; p.QN[g * 256 + h * 64 + f] = f2bf(o1); p.QN[g * 256 + h * 64 + 32 + f] = f2bf(o2); }
            else if (i < 416) { const int f = i - 384; float* q = pr + C_NSA_KC; rope_vals(q, f, 32, rt[f], rt[32 + f], o1, o2); q[f] = o1; q[f + 32] = o2; }
            else if (i < 448) { const int f = i - 416; rope_vals(pr + C_NSA_KS, f, 32, rt[f], rt[32 + f], o1, o2); p.KSLC[g * 64 + f] = f2bf(o1); p.KSLC[g * 64 + 32 + f] = f2bf(o2); }
            else if (i < 480) { const int f = i - 448; rope_vals(pr + C_NSA_KW, f, 32, rt[f], rt[32 + f], o1, o2); p.KWIN[g * 64 + f] = f2bf(o1); p.KWIN[g * 64 + 32 + f] = f2bf(o2); }
            else if (i < 544) { const int j = i - 480, h = j >> 4, f = j & 15; float* q = pr + C_IDXQ + h * 32; rope_vals(q, f, 16, rt[2 * f], rt[32 + 2 * f], o1, o2); q[f] = o1; q[f + 16] = o2; }
            else if (i < 560) { const int f = i - 544; float* q = pr + C_IDXK; rope_vals(q, f, 16, rt[2 * f], rt[32 + 2 * f], o1, o2); q[f] = o1; q[f + 16] = o2; }
            else if (i < 564) { const int h = i - 560; p.LOGF[g * 4 + h] = logsig_(pr[C_FOX_F + h] + p.fox_bias[layer * 4 + h]); }
            else if (i < 820) { const int c = i - 564; p.QF[g * 256 + c] = f2bf(pr[C_FOX_Q + c]); }
            else if (i < 1076) { const int c = i - 820; p.KF[g * 256 + c] = f2bf(pr[C_FOX_K + c]); }
            else if (i < 1332) { const int c = i - 1076; p.QS[g * 256 + c] = f2bf(pr[C_SB_Q + c]); }
            else if (i < 1588) { const int c = i - 1332; p.KSB[g * 256 + c] = f2bf(pr[C_SB_K + c]); }
            else { const int c = i - 1588; p.QM[g * 256 + c] = f2bf(pr[C_MEM_Q + c]); }
        }
        const float* pt = p.P + (size_t)g0 * NM;
        for (int h = 0; h < 4; ++h) {
            transpose64(p.VA + (size_t)g0 * 256 + h * 64, 256, p.VAT + ((size_t)(b * 4 + h) * 64) * S + t0, S, sm, tid);
            transpose64(pt + C_FOX_V + h * 64, NM, p.VFT + ((size_t)(b * 4 + h) * 64) * S + t0, S, sm, tid);
            transpose64(pt + C_SB_V + h * 64, NM, p.VST + ((size_t)(b * 4 + h) * 64) * S + t0, S, sm, tid);
        }
        transpose64(pt + C_NSA_VS, NM, p.VSLCT + ((size_t)b * 64) * S + t0, S, sm, tid);
        transpose64(pt + C_NSA_VW, NM, p.VWINT + ((size_t)b * 64) * S + t0, S, sm, tid);
    }
}

__device__ void ph_cumsum(const Params& p, int bid, int nb, float* sm) {
    const int tid = tidx();
    for (int item = bid; item < NBATCH * 4; item += nb) {
        const int b = item >> 2, h = item & 3;
        const float* src = p.LOGF + (size_t)b * S * 4 + h;
        float* dst = p.CUM + (size_t)b * S * 4 + h;
        float loc = 0.f;
        for (int i = 0; i < 32; ++i) loc += src[(size_t)(tid * 32 + i) * 4];
        sm[tid] = loc; __syncthreads();
        if (tid == 0) { float run = 0.f; for (int i = 0; i < 256; ++i) { const float v = sm[i]; sm[i] = run; run += v; } }
        __syncthreads();
        float run = sm[tid];
        float* dt = p.CUMT + (size_t)item * S;
        for (int i = 0; i < 32; ++i) { run += src[(size_t)(tid * 32 + i) * 4]; dst[(size_t)(tid * 32 + i) * 4] = run; dt[tid * 32 + i] = run * 1.4426950408889634f; }
        __syncthreads();
    }
}

__device__ void ph_compress(const Params& p, int layer, int bid, int nb, float* sm) {
    float* xs = sm;
    float* part = sm + 2048;
    float* hid = sm + 2304;
    const int tid = tidx();
    for (int item = bid; item < 2 * NBATCH * NCMP; item += nb) {
        const int which = item / (NBATCH * NCMP), rem = item % (NBATCH * NCMP), b = rem / NCMP, n = rem % NCMP;
        const int coff = which ? C_NSA_VC : C_NSA_KC;
        const float* pe = (which ? p.pe_v : p.pe_k) + (size_t)layer * 2048;
        const float* w1 = (which ? p.wc1_v : p.wc1_k) + (size_t)layer * 2048 * 128;
        const float* w2 = (which ? p.wc2_v : p.wc2_k) + (size_t)layer * 128 * 64;
        for (int i = tid; i < 2048; i += 256) {
            const int tk = i >> 6, d = i & 63;
            xs[i] = p.P[(size_t)(b * S + 16 * n + tk) * NM + coff + d] + pe[i];
        }
        __syncthreads();
        {
            const int j = tid & 127, hf = tid >> 7;
            float a = 0.f;
            for (int k = hf * 1024; k < hf * 1024 + 1024; ++k) a = fmaf(xs[k], w1[(size_t)k * 128 + j], a);
            part[tid] = a;
        }
        __syncthreads();
        if (tid < 128) hid[tid] = silu_(part[tid] + part[tid + 128]);
        __syncthreads();
        {
            const int d = tid & 63, q = tid >> 6;
            float a = 0.f;
#pragma unroll 4
            for (int j = q * 32; j < q * 32 + 32; ++j) a = fmaf(hid[j], w2[j * 64 + d], a);
            part[tid] = a;
        }
        __syncthreads();
        if (tid < 64) {
            float* dst = (which ? p.VC : p.KC) + ((size_t)b * NCMP_PAD + n) * 64;
            dst[tid] = (part[tid] + part[tid + 64]) + (part[tid + 128] + part[tid + 192]);
        }
        __syncthreads();
    }
}

__device__ __forceinline__ int block_excl_scan(int v, int* sh, int tid, int& total) {
    sh[tid] = v; __syncthreads();
    for (int off = 1; off < 256; off <<= 1) { const int t = (tid >= off) ? sh[tid - off] : 0; __syncthreads(); sh[tid] += t; __syncthreads(); }
    const int incl = sh[tid]; total = sh[255]; __syncthreads();
    return incl - v;
}
__device__ void ph_dsa_select(const Params& p, int bid, int nb, float* smf) {
    unsigned* keys = (unsigned*)smf;
    int* hist = (int*)(smf + 8192);
    int* scan = (int*)(smf + 8192 + 256);
    float* qs = smf + 8192 + 512;
    int* ctl = (int*)(smf + 8192 + 512 + 160);
    const int tid = tidx();
    for (int g = bid; g < T; g += nb) {
        const int b = g / S, t = g % S, n = t + 1;
        unsigned* mrow = p.DMASK + (size_t)g * 256;
        const int lo = tid * 32, hi = min(n, lo + 32);
        if (n <= 256) {
            const int cnt = hi - lo;
            mrow[tid] = cnt >= 32 ? 0xffffffffu : (cnt > 0 ? ((1u << cnt) - 1u) : 0u);
            continue;
        }
        const float* pr = p.P + (size_t)g * NM;
        if (tid < 128) qs[tid] = pr[C_IDXQ + tid]; else if (tid < 132) qs[tid] = pr[C_IDXW + tid - 128];
        __syncthreads();
        for (int s = tid; s < n; s += 256) {
            const float4* kp = (const float4*)(p.P + (size_t)(b * S + s) * NM + C_IDXK);
            float kk[32];
#pragma unroll
            for (int i = 0; i < 8; ++i) { const float4 v = kp[i]; kk[4 * i] = v.x; kk[4 * i + 1] = v.y; kk[4 * i + 2] = v.z; kk[4 * i + 3] = v.w; }
            float sc = 0.f;
#pragma unroll 1
            for (int h = 0; h < 4; ++h) {
                float d = 0.f;
#pragma unroll
                for (int i = 0; i < 32; ++i) d = fmaf(qs[h * 32 + i], kk[i], d);
                sc = fmaf(fmaxf(d, 0.f), qs[128 + h], sc);
            }
            sc = sc * 0.08838834764831845f + 0.0f;
            const unsigned u = __float_as_uint(sc);
            keys[s] = (u & 0x80000000u) ? ~u : (u | 0x80000000u);
        }
        __syncthreads();
        unsigned prefix = 0; int krem = 256;
        for (int pass = 0; pass < 4; ++pass) {
            const int shift = 24 - 8 * pass;
            hist[tid] = 0; __syncthreads();
            for (int i = lo; i < hi; ++i) {
                const unsigned k = keys[i];
                if (pass == 0 || (k >> (shift + 8)) == prefix) atomicAdd(&hist[(k >> shift) & 255], 1);
            }
            __syncthreads();
            int above = 0;
            for (int bb = tid + 1; bb < 256; ++bb) above += hist[bb];
            const int mine = hist[tid];
            if (above < krem && krem <= above + mine) { ctl[0] = tid; ctl[1] = krem - above; ctl[2] = mine; }
            __syncthreads();
            prefix = (prefix << 8) | (unsigned)ctl[0]; krem = ctl[1];
            __syncthreads();
        }
        const unsigned thr = prefix; const int need = krem;
        int nt = 0; for (int i = lo; i < hi; ++i) nt += (keys[i] == thr);
        int tot; int tr = block_excl_scan(nt, scan, tid, tot);
        unsigned bits = 0u;
        for (int i = lo; i < hi; ++i) { const unsigned k = keys[i]; bool sel = false; if (k > thr) sel = true; else if (k == thr) { sel = tr < need; ++tr; }
            if (sel) bits |= 1u << (i - lo); }
        mrow[tid] = bits;
        __syncthreads();
    }
}

__device__ void ph_nsa_cmp(const Params& p, int bid, int nb, float* smf) {
    const int lane = tidx() & 63, wid = tidx() >> 6;
    float* ps = smf + wid * (2048 + 256 + 128);
    float* qs = ps + 2048;
    float* imp = qs + 256;
    for (int g = bid * 4 + wid; g < T; g += nb * 4) {
        const int b = g / S, t = g % S;
        const int nv = t >= 31 ? min(NCMP, (t - 31) / 16 + 1) : 0;
        const float* pr = p.P + (size_t)g * NM;
        for (int i = lane; i < 256; i += 64) qs[i] = pr[C_NSA_Q + i];
        for (int i = lane; i < 2048; i += 64) ps[i] = 0.f;
        __builtin_amdgcn_wave_barrier();
        const float* kc = p.KC + (size_t)b * NCMP_PAD * 64;
        const float* vc = p.VC + (size_t)b * NCMP_PAD * 64;
        for (int h = 0; h < 4; ++h) {
            float l[8]; float m = -INFINITY;
#pragma unroll
            for (int j = 0; j < 8; ++j) {
                const int n = lane + 64 * j; l[j] = -INFINITY;
                if (n < nv) { float d = 0.f; const float* kr = kc + (size_t)n * 64; for (int i = 0; i < 64; ++i) d = fmaf(qs[h * 64 + i], kr[i], d); l[j] = d * 0.125f; }
                m = fmaxf(m, l[j]);
            }
            m = wave_max(m);
            if (m == -INFINITY) m = 0.f;
            float sum = 0.f;
#pragma unroll
            for (int j = 0; j < 8; ++j) { const int n = lane + 64 * j; l[j] = (n < nv) ? expf(l[j] - m) : 0.f; sum += l[j]; }
            sum = wave_sum(sum);
            const float inv = 1.f / fmaxf(sum, 1e-30f);
#pragma unroll
            for (int j = 0; j < 8; ++j) { const int n = lane + 64 * j; if (n < nv) ps[h * 512 + n] = l[j] * inv; }
            __builtin_amdgcn_wave_barrier();
            float o = 0.f;
            for (int n = 0; n < nv; ++n) o = fmaf(ps[h * 512 + n], vc[(size_t)n * 64 + lane], o);
            p.OCMP[(size_t)g * 256 + h * 64 + lane] = o;
        }
        __builtin_amdgcn_wave_barrier();
        const int cur = t >> 6;
        float myimp[2];
#pragma unroll
        for (int jj = 0; jj < 2; ++jj) {
            const int j = lane + 64 * jj;
            float a = 0.f;
            for (int h = 0; h < 4; ++h) for (int i = 0; i < 4; ++i) a += ps[h * 512 + 4 * j + i];
            const bool forced = (j == 0) || (j == cur) || (j == cur - 1);
            const bool vis = j <= cur;
            a = forced ? 1e4f : (vis ? a : -1.0f);
            myimp[jj] = a; imp[j] = a;
        }
        __builtin_amdgcn_wave_barrier();
        unsigned long long m0, m1;
        {
            int r0 = 0, r1 = 0;
            for (int i = 0; i < 128; ++i) {
                const float v = imp[i];
                r0 += (v > myimp[0]) || (v == myimp[0] && i < lane);
                r1 += (v > myimp[1]) || (v == myimp[1] && i < lane + 64);
            }
            m0 = __ballot(r0 < 16); m1 = __ballot(r1 < 16);
        }
        if (lane == 0) {
            unsigned* dst = p.SMASK + (size_t)g * 4;
            dst[0] = (unsigned)m0; dst[1] = (unsigned)(m0 >> 32); dst[2] = (unsigned)m1; dst[3] = (unsigned)(m1 >> 32);
        }
        __builtin_amdgcn_wave_barrier();
    }
}

enum { AM_FOX = 0, AM_DSA = 1, AM_SLC = 2, AM_SB = 3, AM_WIN = 4, AM_MEM = 5 };
constexpr int AK_ROW = 144;
constexpr int AK_TILE = 64 * AK_ROW;
constexpr int ABUF = 2 * AK_TILE + 256;
constexpr float LOG2E = 1.4426950408889634f;
#define NEG_INF (-__builtin_inff())

template <int MODE>
__device__ __forceinline__ void attn_unit(const Params& p, int b, int head, int qblk, char* sm) {
    const int tid = tidx(), lane = tid & 63, wid = tid >> 6, lr = lane & 31, lh = lane >> 5;
    const int q0 = qblk * 128, qw0 = q0 + 32 * wid, tq = qw0 + lr;
    const size_t gq = (size_t)b * S + tq;
    const bf16_t *Qp, *Kp, *VTp; int ldk, ldv;
    if (MODE == AM_FOX)      { Qp = p.QF + gq * 256 + head * 64; Kp = p.KF + (size_t)b * S * 256 + head * 64; ldk = 256; VTp = p.VFT + ((size_t)(b * 4 + head) * 64) * S; ldv = S; }
    else if (MODE == AM_DSA) { Qp = p.QA + gq * 256 + head * 64; Kp = p.KAB + (size_t)b * S * 256 + head * 64; ldk = 256; VTp = p.VAT + ((size_t)(b * 4 + head) * 64) * S; ldv = S; }
    else if (MODE == AM_SB)  { Qp = p.QS + gq * 256 + head * 64; Kp = p.KSB + (size_t)b * S * 256 + head * 64; ldk = 256; VTp = p.VST + ((size_t)(b * 4 + head) * 64) * S; ldv = S; }
    else if (MODE == AM_SLC) { Qp = p.QN + gq * 256 + head * 64; Kp = p.KSLC + (size_t)b * S * 64; ldk = 64; VTp = p.VSLCT + ((size_t)b * 64) * S; ldv = S; }
    else if (MODE == AM_WIN) { Qp = p.QN + gq * 256 + head * 64; Kp = p.KWIN + (size_t)b * S * 64; ldk = 64; VTp = p.VWINT + ((size_t)b * 64) * S; ldv = S; }
    else                     { Qp = p.QM + gq * 256 + head * 64; Kp = p.MKB + (size_t)b * NMEM * 256 + head * 64; ldk = 256; VTp = p.MVT + ((size_t)(b * 4 + head) * 64) * NMEM; ldv = NMEM; }
    int kt_lo = 0, kt_hi = 2 * qblk + 2;
    if (MODE == AM_WIN) kt_lo = q0 >= 512 ? (q0 - 512) / 64 : 0;
    if (MODE == AM_MEM) kt_hi = NMEM / 64;
    const int ntile = kt_hi - kt_lo;
    constexpr bool REV = (MODE == AM_SB);

    bf16x8 qf[4];
#pragma unroll
    for (int s = 0; s < 4; ++s) qf[s] = *(const bf16x8*)(Qp + 16 * s + 8 * lh);
    unsigned smw[4] = {0u, 0u, 0u, 0u};
    if (MODE == AM_SLC) { const u32x4 w = *(const u32x4*)(p.SMASK + gq * 4); smw[0] = w.x; smw[1] = w.y; smw[2] = w.z; smw[3] = w.w; }
    const unsigned long long* mrow = (const unsigned long long*)(p.DMASK + gq * 256);
    const float* csp = p.CUMT + (size_t)(b * 4 + head) * S;

    const int srow = tid >> 3, sc16 = tid & 7;
    const int st0 = srow * AK_ROW + sc16 * 16, st1 = (srow + 32) * AK_ROW + sc16 * 16;
    const bf16_t* kg0 = Kp + (size_t)srow * ldk + sc16 * 8;
    const bf16_t* kg1 = Kp + (size_t)(srow + 32) * ldk + sc16 * 8;
    const bf16_t* vg0 = VTp + (size_t)srow * ldv + sc16 * 8;
    const bf16_t* vg1 = VTp + (size_t)(srow + 32) * ldv + sc16 * 8;
    u32x4 rk0, rk1, rv0, rv1; float rcs = 0.f;
    auto gload = [&](int kt) {
        rk0 = *(const u32x4*)(kg0 + (size_t)kt * 64 * ldk); rk1 = *(const u32x4*)(kg1 + (size_t)kt * 64 * ldk);
        rv0 = *(const u32x4*)(vg0 + kt * 64); rv1 = *(const u32x4*)(vg1 + kt * 64);
        if (MODE == AM_FOX) { if (tid < 64) rcs = csp[kt * 64 + tid]; }
    };
    auto lstore = [&](char* buf) {
        *(u32x4*)(buf + st0) = rk0; *(u32x4*)(buf + st1) = rk1;
        *(u32x4*)(buf + AK_TILE + st0) = rv0; *(u32x4*)(buf + AK_TILE + st1) = rv1;
        if (MODE == AM_FOX) { if (tid < 64) *(float*)(buf + 2 * AK_TILE + tid * 4) = rcs; }
    };
    const int pil = (lr & 0x13) | ((lr & 4) << 1) | ((lr & 8) >> 1);
    const int rdk = pil * AK_ROW + lh * 16;
    const int rdv = AK_TILE + lr * AK_ROW + lh * 16;

    float m = NEG_INF, l = 0.f, R = 0.f;
    f32x16 O[2];
#pragma unroll
    for (int i = 0; i < 16; ++i) { O[0][i] = 0.f; O[1][i] = 0.f; }

    gload(REV ? kt_hi - 1 : kt_lo);
    __syncthreads();
    lstore(sm);
    __syncthreads();
    for (int it = 0; it < ntile; ++it) {
        const int kt = REV ? kt_hi - 1 - it : kt_lo + it;
        char* cur = sm + (it & 1) * ABUF;
        const bool more = (it + 1) < ntile;
        if (more) gload(REV ? kt - 1 : kt + 1);
        unsigned long long mw = 0ull;
        if (MODE == AM_DSA) mw = mrow[kt];
        bool need = true;
        if (MODE != AM_MEM) need = kt * 64 <= qw0 + 31;
        if (MODE == AM_WIN) need = need && (kt * 64 + 63 >= qw0 - 511);
        if (need) {
#pragma unroll
            for (int sb2 = 0; sb2 < 2; ++sb2) {
                const int sub = REV ? 1 - sb2 : sb2;
                const int kb = kt * 64 + sub * 32;
                bool sneed = true;
                if (MODE != AM_MEM) sneed = kb <= qw0 + 31;
                if (MODE == AM_WIN) sneed = sneed && (kb + 31 >= qw0 - 511);
                if (sneed) {
                    f32x16 s;
#pragma unroll
                    for (int i = 0; i < 16; ++i) s[i] = 0.f;
#pragma unroll
                    for (int s4 = 0; s4 < 4; ++s4) {
                        const bf16x8 kf = *(const bf16x8*)(cur + rdk + sub * 32 * AK_ROW + s4 * 32);
                        s = __builtin_amdgcn_mfma_f32_32x32x16_bf16(kf, qf[s4], s, 0, 0, 0);
                    }
                    const int thl = tq - kb - 8 * lh;
                    bf16x8 pf[2];
                    if (MODE == AM_SB) {
                        float lk[16];
#pragma unroll
                        for (int r = 0; r < 16; ++r) {
                            const int cr = 16 * (r >> 3) + (r & 7);
                            const float z = s[r] * 0.125f;
                            const float az = fabsf(z);
                            const float sp = fmaxf(z, 0.f) + __builtin_amdgcn_logf(1.f + __builtin_amdgcn_exp2f(-az * LOG2E)) * 0.6931471805599453f;
                            const bool ok = cr < thl;
                            lk[r] = ok ? -sp : 0.f;
                            s[r] = ok ? z : NEG_INF;
                        }
                        float g0 = 0.f, g1 = 0.f;
#pragma unroll
                        for (int r = 0; r < 8; ++r) { g0 += lk[r]; g1 += lk[8 + r]; }
                        const float pg0 = __shfl_xor(g0, 32, 64), pg1 = __shfl_xor(g1, 32, 64);
                        const float off0 = R + (lh == 0 ? (pg0 + g1 + pg1) : (pg1 + g1));
                        const float off1 = R + (lh == 0 ? pg1 : 0.f);
                        float run0 = off0, run1 = off1;
#pragma unroll
                        for (int r = 7; r >= 0; --r) {
                            const float a0 = __builtin_amdgcn_exp2f((s[r] + lk[r] + run0) * LOG2E); run0 += lk[r];
                            const float a1 = __builtin_amdgcn_exp2f((s[8 + r] + lk[8 + r] + run1) * LOG2E); run1 += lk[8 + r];
                            s[r] = a0; s[8 + r] = a1;
                        }
                        R += (g0 + g1) + (pg0 + pg1);
                    } else {
                        constexpr float c = 0.125f * LOG2E;
                        if (MODE == AM_FOX) {
                            const float4* cs4 = (const float4*)(cur + 2 * AK_TILE + (sub * 32 + 8 * lh) * 4);
                            const float4 c0 = cs4[0], c1 = cs4[1], c2 = cs4[4], c3 = cs4[5];
                            const float cv[16] = {c0.x, c0.y, c0.z, c0.w, c1.x, c1.y, c1.z, c1.w, c2.x, c2.y, c2.z, c2.w, c3.x, c3.y, c3.z, c3.w};
#pragma unroll
                            for (int r = 0; r < 16; ++r) s[r] = fmaf(s[r], c, -cv[r]);
                        } else {
#pragma unroll
                            for (int r = 0; r < 16; ++r) s[r] *= c;
                        }
                        if (MODE == AM_DSA) {
                            const unsigned w = (unsigned)(mw >> (32 * sub)) >> (8 * lh);
#pragma unroll
                            for (int r = 0; r < 16; ++r) { const int cr = 16 * (r >> 3) + (r & 7); s[r] = (w & (1u << cr)) ? s[r] : NEG_INF; }
                        }
                        if (MODE == AM_SLC) {
                            const unsigned w = smw[0] * (kt < 32) + smw[1] * (kt >= 32 && kt < 64) + smw[2] * (kt >= 64 && kt < 96) + smw[3] * (kt >= 96);
                            const bool sel = (w >> (kt & 31)) & 1u;
#pragma unroll
                            for (int r = 0; r < 16; ++r) s[r] = sel ? s[r] : NEG_INF;
                        }
                        if (MODE == AM_FOX || MODE == AM_SLC) {
                            if (kb + 31 > qw0) {
#pragma unroll
                                for (int r = 0; r < 16; ++r) { const int cr = 16 * (r >> 3) + (r & 7); s[r] = (cr <= thl) ? s[r] : NEG_INF; }
                            }
                        }
                        if (MODE == AM_WIN) {
                            if (kb + 31 > qw0 || kb < qw0 + 31 - 511) {
#pragma unroll
                                for (int r = 0; r < 16; ++r) { const int cr = 16 * (r >> 3) + (r & 7); s[r] = (cr <= thl && cr > thl - 512) ? s[r] : NEG_INF; }
                            }
                        }
                        float tmax = s[0];
#pragma unroll
                        for (int r = 1; r < 16; ++r) tmax = fmaxf(tmax, s[r]);
                        tmax = fmaxf(tmax, __shfl_xor(tmax, 32, 64));
                        const float mn = fmaxf(m, tmax);
                        const float mu = (mn == NEG_INF) ? 0.f : mn;
                        const float corr = __builtin_amdgcn_exp2f(m - mu);
                        m = mn;
                        float ls = 0.f;
#pragma unroll
                        for (int r = 0; r < 16; ++r) { s[r] = __builtin_amdgcn_exp2f(s[r] - mu); ls += s[r]; }
                        l = l * corr + ls;
                        if (!__all(corr == 1.0f)) {
#pragma unroll
                            for (int i = 0; i < 16; ++i) { O[0][i] *= corr; O[1][i] *= corr; }
                        }
                    }
                    {
                        u32x4 w0, w1;
                        w0.x = cvt_pk_bf16(s[0], s[1]); w0.y = cvt_pk_bf16(s[2], s[3]); w0.z = cvt_pk_bf16(s[4], s[5]); w0.w = cvt_pk_bf16(s[6], s[7]);
                        w1.x = cvt_pk_bf16(s[8], s[9]); w1.y = cvt_pk_bf16(s[10], s[11]); w1.z = cvt_pk_bf16(s[12], s[13]); w1.w = cvt_pk_bf16(s[14], s[15]);
                        pf[0] = __builtin_bit_cast(bf16x8, w0); pf[1] = __builtin_bit_cast(bf16x8, w1);
                    }
#pragma unroll
                    for (int s2 = 0; s2 < 2; ++s2)
#pragma unroll
                        for (int dt = 0; dt < 2; ++dt) {
                            const bf16x8 vf = *(const bf16x8*)(cur + rdv + dt * 32 * AK_ROW + sub * 64 + s2 * 32);
                            O[dt] = __builtin_amdgcn_mfma_f32_32x32x16_bf16(vf, pf[s2], O[dt], 0, 0, 0);
                        }
                }
            }
        }
        if (more) lstore(sm + ((it + 1) & 1) * ABUF);
        __syncthreads();
    }
    float inv = 1.f;
    if (MODE != AM_SB) { const float lt = l + __shfl_xor(l, 32, 64); inv = 1.f / fmaxf(lt, 1e-30f); }
    const float* pr = p.P + gq * NM;
    if (MODE == AM_SLC || MODE == AM_WIN) {
        const float gs = sigmoid_(pr[C_NSA_G + (MODE == AM_SLC ? 4 : 8) + head]) * inv;
        float* dst = (MODE == AM_SLC ? p.OSLC : p.OWIN) + gq * 256 + head * 64;
#pragma unroll
        for (int dt = 0; dt < 2; ++dt)
#pragma unroll
            for (int g = 0; g < 4; ++g) {
                float4 o; o.x = O[dt][4 * g] * gs; o.y = O[dt][4 * g + 1] * gs; o.z = O[dt][4 * g + 2] * gs; o.w = O[dt][4 * g + 3] * gs;
                *(float4*)(dst + 32 * dt + 8 * g + 4 * lh) = o;
            }
    } else {
        const int zc = MODE == AM_FOX ? C_FOX_Z : MODE == AM_DSA ? C_DSA_Z : MODE == AM_SB ? C_SB_Z : C_MEM_Z;
        const int yc = MODE == AM_FOX ? 256 : MODE == AM_DSA ? 0 : MODE == AM_SB ? 512 : 1024;
        const float* zp = pr + zc + head * 64;
        bf16_t* dst = p.Y + gq * 1280 + yc + head * 64;
#pragma unroll
        for (int dt = 0; dt < 2; ++dt)
#pragma unroll
            for (int g = 0; g < 4; ++g) {
                const int d0 = 32 * dt + 8 * g + 4 * lh;
                const float4 z = *(const float4*)(zp + d0);
                u32x2 o;
                o.x = cvt_pk_bf16(O[dt][4 * g] * inv * silu_(z.x), O[dt][4 * g + 1] * inv * silu_(z.y));
                o.y = cvt_pk_bf16(O[dt][4 * g + 2] * inv * silu_(z.z), O[dt][4 * g + 3] * inv * silu_(z.w));
                *(u32x2*)(dst + d0) = o;
            }
    }
}

__device__ void ph_attention(const Params& p, int layer, int bid, int nb, char* sm) {
    (void)bid; (void)nb;
    __shared__ int s_unit;
    unsigned* ctr = p.qctr + 64 * layer;
    for (;;) {
        __syncthreads();
        if (threadIdx.x == 0) s_unit = (int)atomicAdd(ctr, 1u);
        __syncthreads();
        const int u = s_unit;
        if (u >= 3072) break;
        if (u < 2048) {
            const int qblk = 63 - (u >> 5), r = u & 31, br = r >> 3, b = (r >> 2) & 1, h = r & 3;
            if (br == 0) attn_unit<AM_SB>(p, b, h, qblk, sm);
            else if (br == 1) attn_unit<AM_FOX>(p, b, h, qblk, sm);
            else if (br == 2) attn_unit<AM_DSA>(p, b, h, qblk, sm);
            else attn_unit<AM_SLC>(p, b, h, qblk, sm);
        } else {
            const int v = u - 2048, br = v >> 9, w = v & 511, qblk = w >> 3, b = (w >> 2) & 1, h = w & 3;
            if (br == 0) attn_unit<AM_WIN>(p, b, h, qblk, sm);
            else attn_unit<AM_MEM>(p, b, h, qblk, sm);
        }
    }
}

__device__ void ph_nsa_combine(const Params& p, int bid, int nb) {
    for (size_t i = (size_t)bid * 256 + tidx(); i < (size_t)T * 64; i += (size_t)nb * 256) {
        const size_t g = i >> 6; const int c = (int)(i & 63) * 4, h = c >> 6;
        const float* pr = p.P + g * NM;
        const float g0 = sigmoid_(pr[C_NSA_G + h]);
        const float4 a = *(const float4*)(p.OCMP + g * 256 + c), s = *(const float4*)(p.OSLC + g * 256 + c), w = *(const float4*)(p.OWIN + g * 256 + c);
        const float4 z = *(const float4*)(pr + C_NSA_Z + c);
        u32x2 o;
        o.x = cvt_pk_bf16((g0 * a.x + s.x + w.x) * silu_(z.x), (g0 * a.y + s.y + w.y) * silu_(z.y));
        o.y = cvt_pk_bf16((g0 * a.z + s.z + w.z) * silu_(z.z), (g0 * a.w + s.w + w.w) * silu_(z.w));
        *(u32x2*)(p.Y + g * 1280 + 768 + c) = o;
    }
}

#define XB_TMO      128
#define XB_XCNT(j)  (256  + 64 * (j))
#define XB_XSUB(j)  (1280 + 64 * (j))
#define XB_XGEN(j)  (2304 + 64 * (j))
#define XB_TOP      3328
#define XB_TOPGEN   3392
#define XCD_BAR_WORDS 3456
#define XB_SPIN_CAP (1u << 18)
#define LAS __attribute__((address_space(3)))

__device__ __forceinline__ unsigned xb_ld(unsigned* p)              { return __hip_atomic_load(p, __ATOMIC_RELAXED, __HIP_MEMORY_SCOPE_AGENT); }
__device__ __forceinline__ unsigned xb_add(unsigned* p, unsigned v) { return __hip_atomic_fetch_add(p, v, __ATOMIC_RELAXED, __HIP_MEMORY_SCOPE_AGENT); }
__device__ __forceinline__ unsigned xb_xcc_id() { return (unsigned)__builtin_amdgcn_s_getreg((3 << 11) | 20) & 0xFu; }
#define XB_SPIN(cond, bar) do { unsigned _sp = 0; while (cond) { __builtin_amdgcn_s_sleep(1); \
    if ((++_sp & 255u) == 0u) { if (xb_ld(&(bar)[XB_TMO])) break; if (_sp > XB_SPIN_CAP) { atomicAdd(&(bar)[XB_TMO], 1u); break; } } } } while (0)

struct XcdBarrier {
    unsigned* bar; unsigned x;
    volatile LAS unsigned* st;
};
__device__ __forceinline__ XcdBarrier xcd_barrier_post(unsigned* bar, volatile LAS unsigned* st) {
    XcdBarrier b; b.bar = bar; b.x = xb_xcc_id(); b.st = st;
    if (threadIdx.x == 0) (void)xb_add(&bar[XB_XCNT(b.x)], 1u);
    return b;
}
__device__ __forceinline__ void xcd_barrier_complete(unsigned* bar, unsigned x, unsigned& nloc, unsigned& nx) {
    const unsigned G = gridDim.x * gridDim.y * gridDim.z;
    unsigned sum, cnt, mine, sp = 0u;
    for (;;) {
        sum = 0u; cnt = 0u; mine = 0u;
#pragma unroll
        for (unsigned j = 0; j < 16; ++j) { const unsigned c = xb_ld(&bar[XB_XCNT(j)]); sum += c; cnt += (c > 0u) ? 1u : 0u; mine = (j == x) ? c : mine; }
        if (sum == G) break;
        __builtin_amdgcn_s_sleep(1);
        if ((++sp & 255u) == 0u) { if (xb_ld(&bar[XB_TMO])) break; if (sp > XB_SPIN_CAP) { atomicAdd(&bar[XB_TMO], 1u); break; } }
    }
    nloc = mine > 0u ? mine : 1u; nx = cnt > 0u ? cnt : 1u;
}
__device__ __forceinline__ void xcd_barrier(const XcdBarrier& b) {
    asm volatile("s_waitcnt vmcnt(0)" ::: "memory");
    __syncthreads();
    if (threadIdx.x == 0) {
        unsigned* bar = b.bar;
        __builtin_amdgcn_s_waitcnt(0);
        unsigned nloc = b.st[0], nx = b.st[1];
        if (nloc == 0u) { xcd_barrier_complete(bar, b.x, nloc, nx); b.st[0] = nloc; b.st[1] = nx; }
        const unsigned old = xb_add(&bar[XB_XSUB(b.x)], 1u);
        const unsigned gen = old / nloc;
        if (old + 1u == (gen + 1u) * nloc) {
            __builtin_amdgcn_fence(__ATOMIC_RELEASE, "agent");
            asm volatile("s_waitcnt vmcnt(0)" ::: "memory");
            const unsigned og = xb_add(&bar[XB_TOP], 1u);
            const unsigned tg = og / nx;
            if (og + 1u == (tg + 1u) * nx) xb_add(&bar[XB_TOPGEN], 1u);
            else XB_SPIN(xb_ld(&bar[XB_TOPGEN]) == tg, bar);
            __builtin_amdgcn_fence(__ATOMIC_ACQUIRE, "agent");
            xb_add(&bar[XB_XGEN(b.x)], 1u);
            asm volatile("s_waitcnt vmcnt(0)" ::: "memory");
        } else {
            XB_SPIN(xb_ld(&bar[XB_XGEN(b.x)]) == gen, bar);
            __builtin_amdgcn_fence(__ATOMIC_ACQUIRE, "agent");
            asm volatile("s_waitcnt vmcnt(0)" ::: "memory");
        }
    }
    __syncthreads();
}

__global__ void __launch_bounds__(256, 2) mega(Params p) {
    __shared__ __attribute__((aligned(16))) char smem[40960];
    __shared__ uint4 xb_words;
    if (threadIdx.x == 0) xb_words = make_uint4(0u, 0u, 0u, 0u);
    __syncthreads();
    XcdBarrier bar = xcd_barrier_post(p.bar, (volatile LAS unsigned*)&xb_words);
    const int bid = blockIdx.x, nb = gridDim.x;
    float* smf = (float*)smem;

    convert_wt(p.w_branch, p.WBR, 256, D, DEPTH * 5, bid, nb, smf);
    convert_wt(p.w_out, p.WOUT, D, D, DEPTH, bid, nb, smf);
    convert_wt(p.w_mem_kv, p.WMKV, D, 512, DEPTH, bid, nb, smf);
    convert_wt(p.w_uk, p.WUK, 128, 256, DEPTH, bid, nb, smf);
    convert_wt(p.w_uv, p.WUV, 128, 256, DEPTH, bid, nb, smf);
    ph_rope_table(p, bid, nb);
    for (int l = 0; l < DEPTH; ++l) {
        const float* Xin = l == 0 ? p.x : p.X;
        convert_wt(p.w_in + (size_t)l * D * NIN, p.WIN, D, NIN, 1, bid, nb, smf);
        ph_rmsnorm<bf16_t>(Xin, p.norm_g + l * D, p.H, T, bid, nb);
        ph_rmsnorm<bf16_t>(p.mem, p.mem_norm + l * D, p.MEMN, NBATCH * NMEM, bid, nb);
        xcd_barrier(bar);
        { EpiStore e{p.P, NM}; gemm_bf16<128>(p.H, D, p.WIN, D, T, NM, D, e, bid, nb, smem); }
        { EpiStore e{p.MKV, 512}; gemm_bf16<128>(p.MEMN, D, p.WMKV + (size_t)l * 512 * D, D, NBATCH * NMEM, 512, D, e, bid, nb, smem); }
        xcd_barrier(bar);
        ph_ckvnorm(p, l, bid, nb);
        xcd_barrier(bar);
        { EpiStore e{p.KA, 256}; gemm_bf16<128>(p.CKV, 128, p.WUK + (size_t)l * 256 * 128, 128, T, 256, 128, e, bid, nb, smem); }
        { EpiStore e{p.VA, 256}; gemm_bf16<128>(p.CKV, 128, p.WUV + (size_t)l * 256 * 128, 128, T, 256, 128, e, bid, nb, smem); }
        xcd_barrier(bar);
        ph_prep(p, l, bid, nb, smf);
        xcd_barrier(bar);
        ph_cumsum(p, bid, nb, smf);
        ph_compress(p, l, bid, nb, smf);
        xcd_barrier(bar);
        ph_dsa_select(p, bid, nb, smf);
        ph_nsa_cmp(p, bid, nb, smf);
        xcd_barrier(bar);
        ph_attention(p, l, bid, nb, smem);
        xcd_barrier(bar);
        ph_nsa_combine(p, bid, nb);
        xcd_barrier(bar);
        ph_merge(p, l, bid, nb, smem);
        xcd_barrier(bar);
        { EpiResid e{Xin, p.X}; gemm_bf16<128>(p.MG, D, p.WOUT + (size_t)l * D * D, D, T, D, D, e, bid, nb, smem); }
        xcd_barrier(bar);
    }
    ph_rmsnorm<float>(p.X, p.final_norm, p.X, T, bid, nb);
}
}

extern "C" void kernel_launch(void* const* d_in, const int* in_sizes, int n_in, void* d_out, int out_size, void* d_ws, size_t ws_size, hipStream_t stream) {
    (void)in_sizes; (void)n_in; (void)out_size;
    Params p{};
    p.x = (const float*)d_in[0]; p.mem = (const float*)d_in[1]; p.pos = (const int*)d_in[2]; p.norm_g = (const float*)d_in[3];
    p.w_in = (const float*)d_in[4]; p.kv_norm = (const float*)d_in[5]; p.w_uk = (const float*)d_in[6]; p.w_uv = (const float*)d_in[7];
    p.fox_bias = (const float*)d_in[8]; p.pe_k = (const float*)d_in[9]; p.pe_v = (const float*)d_in[10]; p.wc1_k = (const float*)d_in[11];
    p.wc2_k = (const float*)d_in[12]; p.wc1_v = (const float*)d_in[13]; p.wc2_v = (const float*)d_in[14]; p.mem_norm = (const float*)d_in[15];
    p.w_mem_kv = (const float*)d_in[16]; p.w_branch = (const float*)d_in[17]; p.w_out = (const float*)d_in[18]; p.final_norm = (const float*)d_in[19];
    p.X = (float*)d_out;
    size_t off = 0; char* ws = (char*)d_ws;
    auto carve = [&](size_t bytes) { char* r = ws + off; off += (bytes + 255) & ~(size_t)255; return r; };
    p.bar = (unsigned*)carve((4096 + 64 * 8) * 4);
    p.qctr = p.bar + 4096;
    p.P = (float*)carve((size_t)T * NM * 4);
    p.MG = (bf16_t*)p.P;
    p.H = (bf16_t*)carve((size_t)T * D * 2);
    p.Y = (bf16_t*)carve((size_t)T * 1280 * 2);
    p.CKV = (bf16_t*)carve((size_t)T * 128 * 2);
    p.KA = (float*)carve((size_t)T * 256 * 4);
    p.VA = (float*)carve((size_t)T * 256 * 4);
    p.OCMP = (float*)carve((size_t)T * 256 * 4);
    p.LOGF = (float*)carve((size_t)T * 4 * 4);
    p.CUM = (float*)carve((size_t)T * 4 * 4);
    p.KC = (float*)carve((size_t)NBATCH * NCMP_PAD * 64 * 4);
    p.VC = (float*)carve((size_t)NBATCH * NCMP_PAD * 64 * 4);
    p.MEMN = (bf16_t*)carve((size_t)NBATCH * NMEM * D * 2);
    p.MKV = (float*)carve((size_t)NBATCH * NMEM * 512 * 4);
    p.ROPE = (float*)carve((size_t)T * 64 * 4);
    p.DMASK = (unsigned*)carve((size_t)T * 256 * 4);
    p.QA = (bf16_t*)carve((size_t)T * 256 * 2); p.KAB = (bf16_t*)carve((size_t)T * 256 * 2); p.VAT = (bf16_t*)carve((size_t)T * 256 * 2);
    p.QF = (bf16_t*)carve((size_t)T * 256 * 2); p.KF = (bf16_t*)carve((size_t)T * 256 * 2); p.VFT = (bf16_t*)carve((size_t)T * 256 * 2);
    p.QS = (bf16_t*)carve((size_t)T * 256 * 2); p.KSB = (bf16_t*)carve((size_t)T * 256 * 2); p.VST = (bf16_t*)carve((size_t)T * 256 * 2);
    p.QN = (bf16_t*)carve((size_t)T * 256 * 2); p.QM = (bf16_t*)carve((size_t)T * 256 * 2);
    p.KSLC = (bf16_t*)carve((size_t)T * 64 * 2); p.VSLCT = (bf16_t*)carve((size_t)T * 64 * 2);
    p.KWIN = (bf16_t*)carve((size_t)T * 64 * 2); p.VWINT = (bf16_t*)carve((size_t)T * 64 * 2);
    p.MKB = (bf16_t*)carve((size_t)NBATCH * NMEM * 256 * 2); p.MVT = (bf16_t*)carve((size_t)NBATCH * NMEM * 256 * 2);
    p.CUMT = (float*)carve((size_t)T * 4 * 4);
    p.OSLC = p.KA; p.OWIN = p.VA;
    p.SMASK = (unsigned*)carve((size_t)T * 4 * 4);
    p.WIN = (bf16_t*)carve((size_t)NIN * D * 2);
    p.WBR = (bf16_t*)carve((size_t)DEPTH * 5 * D * 256 * 2);
    p.WOUT = (bf16_t*)carve((size_t)DEPTH * D * D * 2);
    p.WMKV = (bf16_t*)carve((size_t)DEPTH * 512 * D * 2);
    p.WUK = (bf16_t*)carve((size_t)DEPTH * 256 * 128 * 2);
    p.WUV = (bf16_t*)carve((size_t)DEPTH * 256 * 128 * 2);
    if (off > ws_size) { fprintf(stderr, "kernel_launch: workspace too small (%zu > %zu)\n", off, ws_size); return; }

    static int grid = 0;
    if (grid == 0) {
        int dev = 0, cus = 0, per_cu = 0;
        hipGetDevice(&dev);
        hipDeviceGetAttribute(&cus, hipDeviceAttributeMultiprocessorCount, dev);
        hipOccupancyMaxActiveBlocksPerMultiprocessor(&per_cu, (const void*)mega, 256, 0);
        (void)hipGetLastError();
        if (per_cu < 1) per_cu = 1;
        grid = cus * (per_cu < 2 ? per_cu : 2);
    }
    hipMemsetAsync(p.bar, 0, (4096 + 64 * 8) * sizeof(unsigned), stream);
    hipLaunchKernelGGL(mega, dim3(grid), dim3(256), 0, stream, p);
}
```

```cpp
#include <hip/hip_runtime.h>
#include <stdint.h>
#include <math.h>
#include <cstdio>

namespace {
constexpr int S = 8192, NBATCH = 2, T = NBATCH * S, D = 1024, NIN = 9396, NM = 4276, DEPTH = 4, NMEM = 256;
constexpr int NCMP = 511, NCMP_PAD = 512;
constexpr int C_DSA_Q = 0, C_CKV = 256, C_IDXQ = 384, C_IDXK = 512, C_IDXW = 544, C_DSA_Z = 548,
              C_FOX_Q = 804, C_FOX_K = 1060, C_FOX_V = 1316, C_FOX_F = 1572, C_FOX_Z = 1576,
              C_SB_Q = 1832, C_SB_K = 2088, C_SB_V = 2344, C_SB_Z = 2600,
              C_NSA_Q = 2856, C_NSA_KC = 3112, C_NSA_VC = 3176, C_NSA_KS = 3240, C_NSA_VS = 3304, C_NSA_KW = 3368, C_NSA_VW = 3432,
              C_NSA_G = 3496, C_NSA_Z = 3508, C_MEM_Q = 3764, C_MEM_Z = 4020, C_MERGE = 4276;

typedef unsigned short bf16_t;
typedef short bf16x8 __attribute__((ext_vector_type(8)));
typedef float f32x16 __attribute__((ext_vector_type(16)));
typedef unsigned u32x4 __attribute__((ext_vector_type(4)));
typedef unsigned u32x2 __attribute__((ext_vector_type(2)));

struct Params {
    const float* x; const float* mem; const int* pos; const float* norm_g; const float* w_in; const float* kv_norm;
    const float* w_uk; const float* w_uv; const float* fox_bias; const float* pe_k; const float* pe_v;
    const float* wc1_k; const float* wc2_k; const float* wc1_v; const float* wc2_v; const float* mem_norm;
    const float* w_mem_kv; const float* w_branch; const float* w_out; const float* final_norm;
    float* X;
    float *P, *KA, *VA, *LOGF, *CUM, *OCMP, *MKV, *ROPE;
    bf16_t *H, *CKV, *Y, *MG, *MEMN;
    bf16_t *WIN, *WBR, *WOUT, *WMKV, *WUK, *WUV;
    bf16_t *QA, *KAB, *VAT, *QF, *KF, *VFT, *QS, *KSB, *VST, *QN, *KSLC, *VSLCT, *KWIN, *VWINT, *QM, *MKB, *MVT;
    bf16_t *QI, *KI, *KCB, *VCT;
    float *CUMT, *OSLC, *OWIN;
    unsigned* DMASK; unsigned* SMASK; unsigned* bar; unsigned* qctr;
};

typedef __bf16 bf16x2_t __attribute__((ext_vector_type(2)));
__device__ __forceinline__ unsigned cvt_pk_bf16(float lo, float hi) { bf16x2_t v; v.x = (__bf16)lo; v.y = (__bf16)hi; return __builtin_bit_cast(unsigned, v); }
__device__ __forceinline__ bf16_t f2bf(float x) { return (bf16_t)(cvt_pk_bf16(x, 0.f) & 0xffffu); }
__device__ __forceinline__ int tidx() { int t = threadIdx.x; asm volatile("" : "+v"(t)); return t; }
__device__ __forceinline__ float sigmoid_(float x) { return 1.f / (1.f + expf(-x)); }
__device__ __forceinline__ float silu_(float x) { return x / (1.f + expf(-x)); }
__device__ __forceinline__ float logsig_(float x) { return fminf(x, 0.f) - log1pf(expf(-fabsf(x))); }
__device__ __forceinline__ float wave_sum(float v) {
#pragma unroll
    for (int o = 32; o > 0; o >>= 1) v += __shfl_xor(v, o, 64);
    return v;
}
__device__ __forceinline__ float wave_max(float v) {
#pragma unroll
    for (int o = 32; o > 0; o >>= 1) v = fmaxf(v, __shfl_xor(v, o, 64));
    return v;
}

__device__ void ph_rope_table(const Params& p, int bid, int nb) {
    for (int i = bid * 256 + tidx(); i < T * 32; i += nb * 256) {
        const int t = i >> 5, f = i & 31;
        const double inv = pow(10000.0, -(double)f / 32.0);
        const double ang = (double)p.pos[t] * inv;
        p.ROPE[(size_t)t * 64 + f] = (float)cos(ang);
        p.ROPE[(size_t)t * 64 + 32 + f] = (float)sin(ang);
    }
}

template <class OUT>
__device__ void ph_rmsnorm(const float* in, const float* g, OUT* out, int rows, int bid, int nb) {
    const int lane = tidx() & 63, wid = tidx() >> 6;
    for (int r = bid * 4 + wid; r < rows; r += nb * 4) {
        const float4* ip = (const float4*)(in + (size_t)r * D);
        float4 v[4]; float ss = 0.f;
#pragma unroll
        for (int i = 0; i < 4; ++i) { v[i] = ip[lane + 64 * i]; ss += v[i].x * v[i].x + v[i].y * v[i].y + v[i].z * v[i].z + v[i].w * v[i].w; }
        ss = wave_sum(ss);
        const float sc = 1.0f / sqrtf(ss * (1.f / D) + 1e-6f);
#pragma unroll
        for (int i = 0; i < 4; ++i) {
            const float4 gg = ((const float4*)g)[lane + 64 * i];
            float4 o; o.x = v[i].x * sc * gg.x; o.y = v[i].y * sc * gg.y; o.z = v[i].z * sc * gg.z; o.w = v[i].w * sc * gg.w;
            if constexpr (sizeof(OUT) == 4) ((float4*)((float*)out + (size_t)r * D))[lane + 64 * i] = o;
            else { u32x2 w; w.x = cvt_pk_bf16(o.x, o.y); w.y = cvt_pk_bf16(o.z, o.w); ((u32x2*)((bf16_t*)out + (size_t)r * D))[lane + 64 * i] = w; }
        }
    }
}

__device__ void ph_ckvnorm(const Params& p, int layer, int bid, int nb) {
    const int lane = tidx() & 63, wid = tidx() >> 6;
    const float* g = p.kv_norm + layer * 128;
    for (int r = bid * 4 + wid; r < T; r += nb * 4) {
        const float* ip = p.P + (size_t)r * NM + C_CKV;
        const float a = ip[lane], b = ip[lane + 64];
        const float ss = wave_sum(a * a + b * b);
        const float sc = 1.0f / sqrtf(ss * (1.f / 128.f) + 1e-6f);
        p.CKV[(size_t)r * 128 + lane] = f2bf(a * sc * g[lane]);
        p.CKV[(size_t)r * 128 + lane + 64] = f2bf(b * sc * g[lane + 64]);
    }
}

__device__ void convert_wt(const float* __restrict__ src, bf16_t* __restrict__ dst, int K, int N, int nmat, int bid, int nb, float* sm) {
    float (*tl)[65] = (float (*)[65])sm;
    const int tid = tidx(), tk = K / 64, tn = (N + 63) / 64, per = tk * tn;
    for (int it = bid; it < per * nmat; it += nb) {
        const int mat = it / per, r = it % per, k0 = (r % tk) * 64, n0 = (r / tk) * 64;
        const float* s = src + (size_t)mat * K * N; bf16_t* d = dst + (size_t)mat * K * N;
        for (int i = tid; i < 64 * 64; i += 256) { const int kk = i >> 6, nn = i & 63; tl[kk][nn] = (n0 + nn < N) ? s[(size_t)(k0 + kk) * N + n0 + nn] : 0.f; }
        __syncthreads();
        {
            const int nn = tid >> 2, kq = (tid & 3) * 16;
            if (n0 + nn < N) {
                u32x4 w0, w1;
                w0.x = cvt_pk_bf16(tl[kq + 0][nn], tl[kq + 1][nn]); w0.y = cvt_pk_bf16(tl[kq + 2][nn], tl[kq + 3][nn]);
                w0.z = cvt_pk_bf16(tl[kq + 4][nn], tl[kq + 5][nn]); w0.w = cvt_pk_bf16(tl[kq + 6][nn], tl[kq + 7][nn]);
                w1.x = cvt_pk_bf16(tl[kq + 8][nn], tl[kq + 9][nn]); w1.y = cvt_pk_bf16(tl[kq + 10][nn], tl[kq + 11][nn]);
                w1.z = cvt_pk_bf16(tl[kq + 12][nn], tl[kq + 13][nn]); w1.w = cvt_pk_bf16(tl[kq + 14][nn], tl[kq + 15][nn]);
                u32x4* dp = (u32x4*)(d + (size_t)(n0 + nn) * K + k0 + kq);
                dp[0] = w0; dp[1] = w1;
            }
        }
        __syncthreads();
    }
}

constexpr int GROW = 80;
constexpr int GA_BYTES = 128 * GROW;
template <int BN>
__device__ __forceinline__ void tile_mac(f32x16 (&acc)[2][BN / 64], const bf16_t* __restrict__ A, int lda, int m0,
                                         const bf16_t* __restrict__ Bt, int ldb, int n0, int nmax, int K, char* sm) {
    constexpr int NT = BN / 64;
    constexpr int B_BYTES = BN * GROW;
    constexpr int BUF = GA_BYTES + B_BYTES;
    const int tid = tidx(), lane = tid & 63, wid = tid >> 6, wr = wid >> 1, wc = wid & 1;
    const int lr = lane & 31, lh = lane >> 5;
    const int ar0 = tid >> 2, akq = tid & 3;
    const bf16_t* ap0 = A + (size_t)(m0 + ar0) * lda + akq * 8;
    const bf16_t* ap1 = A + (size_t)(m0 + ar0 + 64) * lda + akq * 8;
    const int br0 = tid >> 2;
    const bool bv0 = (n0 + br0) < nmax, bv1 = (NT == 2) && ((n0 + br0 + 64) < nmax);
    const bf16_t* bp0 = Bt + (size_t)(bv0 ? (n0 + br0) : 0) * ldb + akq * 8;
    const bf16_t* bp1 = Bt + (size_t)(bv1 ? (n0 + br0 + 64) : 0) * ldb + akq * 8;
    const int st_a0 = ar0 * GROW + akq * 16, st_a1 = (ar0 + 64) * GROW + akq * 16;
    const int st_b0 = GA_BYTES + br0 * GROW + akq * 16, st_b1 = GA_BYTES + (br0 + 64) * GROW + akq * 16;
    const int rd_a = (wr * 64 + lr) * GROW + lh * 16, rd_b = GA_BYTES + (wc * (BN / 2) + lr) * GROW + lh * 16;
    const u32x4 zero4 = {0u, 0u, 0u, 0u};
    u32x4 ra0, ra1, rb0, rb1 = zero4;
    ra0 = *(const u32x4*)ap0; ra1 = *(const u32x4*)ap1;
    rb0 = bv0 ? *(const u32x4*)bp0 : zero4; if (NT == 2) rb1 = bv1 ? *(const u32x4*)bp1 : zero4;
    __syncthreads();
    *(u32x4*)(sm + st_a0) = ra0; *(u32x4*)(sm + st_a1) = ra1; *(u32x4*)(sm + st_b0) = rb0; if (NT == 2) *(u32x4*)(sm + st_b1) = rb1;
    __syncthreads();
    const int nk = K / 32;
    for (int ks = 0; ks < nk; ++ks) {
        char* cur = sm + (ks & 1) * BUF;
        char* nxt = sm + ((ks + 1) & 1) * BUF;
        const bool more = (ks + 1) < nk;
        if (more) {
            const int ko = (ks + 1) * 32;
            ra0 = *(const u32x4*)(ap0 + ko); ra1 = *(const u32x4*)(ap1 + ko);
            rb0 = bv0 ? *(const u32x4*)(bp0 + ko) : zero4; if (NT == 2) rb1 = bv1 ? *(const u32x4*)(bp1 + ko) : zero4;
        }
#pragma unroll
        for (int s = 0; s < 2; ++s) {
            bf16x8 a[2], b[NT];
#pragma unroll
            for (int mi = 0; mi < 2; ++mi) a[mi] = *(const bf16x8*)(cur + rd_a + mi * 32 * GROW + s * 32);
#pragma unroll
            for (int ni = 0; ni < NT; ++ni) b[ni] = *(const bf16x8*)(cur + rd_b + ni * 32 * GROW + s * 32);
#pragma unroll
            for (int mi = 0; mi < 2; ++mi)
#pragma unroll
                for (int ni = 0; ni < NT; ++ni) acc[mi][ni] = __builtin_amdgcn_mfma_f32_32x32x16_bf16(a[mi], b[ni], acc[mi][ni], 0, 0, 0);
        }
        if (more) { *(u32x4*)(nxt + st_a0) = ra0; *(u32x4*)(nxt + st_a1) = ra1; *(u32x4*)(nxt + st_b0) = rb0; if (NT == 2) *(u32x4*)(nxt + st_b1) = rb1; }
        __syncthreads();
    }
}
template <int NT> __device__ __forceinline__ void acc_zero(f32x16 (&acc)[2][NT]) {
#pragma unroll
    for (int mi = 0; mi < 2; ++mi)
#pragma unroll
        for (int ni = 0; ni < NT; ++ni)
#pragma unroll
            for (int r = 0; r < 16; ++r) acc[mi][ni][r] = 0.f;
}
template <int BN, class Epi>
__device__ void gemm_bf16(const bf16_t* A, int lda, const bf16_t* Bt, int ldb, int M, int N, int K, const Epi& epi, int bid, int nb, char* sm) {
    constexpr int NT = BN / 64;
    const int tm = M / 128, tn = (N + BN - 1) / BN;
    const int lane = tidx() & 63, wid = tidx() >> 6, wr = wid >> 1, wc = wid & 1, lr = lane & 31, lh = lane >> 5;
    for (int tile = bid; tile < tm * tn; tile += nb) {
        const int m0 = (tile % tm) * 128, n0 = (tile / tm) * BN;
        f32x16 acc[2][NT]; acc_zero<NT>(acc);
        tile_mac<BN>(acc, A, lda, m0, Bt, ldb, n0, N, K, sm);
#pragma unroll
        for (int mi = 0; mi < 2; ++mi)
#pragma unroll
            for (int ni = 0; ni < NT; ++ni) {
                const int col = n0 + wc * (BN / 2) + ni * 32 + lr;
                if (col < N) {
#pragma unroll
                    for (int r = 0; r < 16; ++r) epi(m0 + wr * 64 + mi * 32 + (r & 3) + 8 * (r >> 2) + 4 * lh, col, acc[mi][ni][r]);
                }
            }
    }
}
struct EpiStore { float* C; int ldc; __device__ __forceinline__ void operator()(int r, int c, float v) const { C[(size_t)r * ldc + c] = v; } };
struct EpiResid { const float* Xin; float* Xout;
    __device__ __forceinline__ void operator()(int r, int c, float v) const { const size_t i = (size_t)r * D + c; Xout[i] = Xin[i] + v; } };

__device__ void ph_merge(const Params& p, int layer, int bid, int nb, char* sm) {
    const int lane = tidx() & 63, wid = tidx() >> 6, wr = wid >> 1, wc = wid & 1, lr = lane & 31, lh = lane >> 5;
    const bf16_t* win = p.WIN;
    for (int tile = bid; tile < (T / 128) * (D / 64); tile += nb) {
        const int m0 = (tile % (T / 128)) * 128, n0 = (tile / (T / 128)) * 64;
        f32x16 mg[2][1]; acc_zero<1>(mg);
        for (int n = 0; n < 5; ++n) {
            f32x16 g[2][1], yb[2][1]; acc_zero<1>(g); acc_zero<1>(yb);
            tile_mac<64>(g, p.H, D, m0, win + (size_t)(C_MERGE + n * D) * D, D, n0, D, D, sm);
            tile_mac<64>(yb, p.Y + n * 256, 1280, m0, p.WBR + ((size_t)layer * 5 + n) * D * 256, 256, n0, D, 256, sm);
#pragma unroll
            for (int mi = 0; mi < 2; ++mi)
#pragma unroll
                for (int r = 0; r < 16; ++r) mg[mi][0][r] = fmaf(sigmoid_(g[mi][0][r]), yb[mi][0][r], mg[mi][0][r]);
        }
#pragma unroll
        for (int mi = 0; mi < 2; ++mi)
#pragma unroll
            for (int r = 0; r < 16; ++r) {
                const int row = m0 + wr * 64 + mi * 32 + (r & 3) + 8 * (r >> 2) + 4 * lh, col = n0 + wc * 32 + lr;
                p.MG[(size_t)row * D + col] = f2bf(mg[mi][0][r]);
            }
    }
}

__device__ __forceinline__ void rope_vals(const float* src, int i0, int half, float c, float s, float& o1, float& o2) {
    const float x1 = src[i0], x2 = src[i0 + half]; o1 = x1 * c - x2 * s; o2 = x2 * c + x1 * s;
}
__device__ __forceinline__ void transpose64(const float* __restrict__ src, int ld_src, bf16_t* __restrict__ dst, size_t ldd, float* sm, int tid) {
    float (*tl)[65] = (float (*)[65])sm;
    for (int i = tid; i < 4096; i += 256) { const int r = i >> 6, c = i & 63; tl[r][c] = src[(size_t)r * ld_src + c]; }
    __syncthreads();
    {
        const int c = tid >> 2, rq = (tid & 3) * 16;
        u32x4 w0, w1;
        w0.x = cvt_pk_bf16(tl[rq + 0][c], tl[rq + 1][c]); w0.y = cvt_pk_bf16(tl[rq + 2][c], tl[rq + 3][c]);
        w0.z = cvt_pk_bf16(tl[rq + 4][c], tl[rq + 5][c]); w0.w = cvt_pk_bf16(tl[rq + 6][c], tl[rq + 7][c]);
        w1.x = cvt_pk_bf16(tl[rq + 8][c], tl[rq + 9][c]); w1.y = cvt_pk_bf16(tl[rq + 10][c], tl[rq + 11][c]);
        w1.z = cvt_pk_bf16(tl[rq + 12][c], tl[rq + 13][c]); w1.w = cvt_pk_bf16(tl[rq + 14][c], tl[rq + 15][c]);
        u32x4* dp = (u32x4*)(dst + (size_t)c * ldd + rq);
        dp[0] = w0; dp[1] = w1;
    }
    __syncthreads();
}
__device__ void ph_prep(const Params& p, int layer, int bid, int nb, float* sm) {
    const int tid = tidx();
    constexpr int ITEMS = 1844;
    for (int tile = bid; tile < T / 64 + 8; tile += nb) {
        if (tile >= T / 64) {
            const int r0 = (tile - T / 64) * 64, b = r0 / NMEM, m0 = r0 % NMEM;
            for (int i = tid; i < 64 * 256; i += 256) { const int r = i >> 8, c = i & 255; p.MKB[(size_t)(r0 + r) * 256 + c] = f2bf(p.MKV[(size_t)(r0 + r) * 512 + c]); }
            for (int h = 0; h < 4; ++h) transpose64(p.MKV + (size_t)r0 * 512 + 256 + h * 64, 512, p.MVT + ((size_t)(b * 4 + h) * 64) * NMEM + m0, NMEM, sm, tid);
            continue;
        }
        const int g0 = tile * 64, b = g0 / S, t0 = g0 % S;
        for (int idx = tid; idx < 64 * ITEMS; idx += 256) {
            const int tk = idx / ITEMS, i = idx % ITEMS;
            const size_t g = (size_t)g0 + tk;
            float* pr = p.P + g * NM;
            const float* rt = p.ROPE + g * 64;
            float o1, o2;
            if (i < 128) { const int h = i >> 5, f = i & 31; rope_vals(pr + C_DSA_Q + h * 64, f, 32, rt[f], rt[32 + f], o1, o2); p.QA[g * 256 + h * 64 + f] = f2bf(o1); p.QA[g * 256 + h * 64 + 32 + f] = f2bf(o2); }
            else if (i < 256) { const int j = i - 128, h = j >> 5, f = j & 31; rope_vals(p.KA + g * 256 + h * 64, f, 32, rt[f], rt[32 + f], o1, o2); p.KAB[g * 256 + h * 64 + f] = f2bf(o1); p.KAB[g * 256 + h * 64 + 32 + f] = f2bf(o2); }
            else if (i < 384) { const int j = i - 256, h = j >> 5, f = j & 31; float* q = pr + C_NSA_Q + h * 64; rope_vals(q, f, 32, rt[f], rt[32 + f], o1, o2); q[f] = o1; q[f + 32] = o2; p.QN[g * 256 + h * 64 + f] = f2bf(o1); p.QN[g * 256 + h * 64 + 32 + f] = f2bf(o2); }
            else if (i < 416) { const int f = i - 384; float* q = pr + C_NSA_KC; rope_vals(q, f, 32, rt[f], rt[32 + f], o1, o2); q[f] = o1; q[f + 32] = o2; }
            else if (i < 448) { const int f = i - 416; rope_vals(pr + C_NSA_KS, f, 32, rt[f], rt[32 + f], o1, o2); p.KSLC[g * 64 + f] = f2bf(o1); p.KSLC[g * 64 + 32 + f] = f2bf(o2); }
            else if (i < 480) { const int f = i - 448; rope_vals(pr + C_NSA_KW, f, 32, rt[f], rt[32 + f], o1, o2); p.KWIN[g * 64 + f] = f2bf(o1); p.KWIN[g * 64 + 32 + f] = f2bf(o2); }
            else if (i < 544) { const int j = i - 480, h = j >> 4, f = j & 15; float* q = pr + C_IDXQ + h * 32; rope_vals(q, f, 16, rt[2 * f], rt[32 + 2 * f], o1, o2); q[f] = o1; q[f + 16] = o2; p.QI[g * 128 + h * 32 + f] = f2bf(o1); p.QI[g * 128 + h * 32 + 16 + f] = f2bf(o2); }
            else if (i < 560) { const int f = i - 544; float* q = pr + C_IDXK; rope_vals(q, f, 16, rt[2 * f], rt[32 + 2 * f], o1, o2); q[f] = o1; q[f + 16] = o2; p.KI[g * 32 + f] = f2bf(o1); p.KI[g * 32 + 16 + f] = f2bf(o2); }
            else if (i < 564) { const int h = i - 560; p.LOGF[g * 4 + h] = logsig_(pr[C_FOX_F + h] + p.fox_bias[layer * 4 + h]); }
            else if (i < 820) { const int c = i - 564; p.QF[g * 256 + c] = f2bf(pr[C_FOX_Q + c]); }
            else if (i < 1076) { const int c = i - 820; p.KF[g * 256 + c] = f2bf(pr[C_FOX_K + c]); }
            else if (i < 1332) { const int c = i - 1076; p.QS[g * 256 + c] = f2bf(pr[C_SB_Q + c]); }
            else if (i < 1588) { const int c = i - 1332; p.KSB[g * 256 + c] = f2bf(pr[C_SB_K + c]); }
            else { const int c = i - 1588; p.QM[g * 256 + c] = f2bf(pr[C_MEM_Q + c]); }
        }
        const float* pt = p.P + (size_t)g0 * NM;
        for (int h = 0; h < 4; ++h) {
            transpose64(p.VA + (size_t)g0 * 256 + h * 64, 256, p.VAT + ((size_t)(b * 4 + h) * 64) * S + t0, S, sm, tid);
            transpose64(pt + C_FOX_V + h * 64, NM, p.VFT + ((size_t)(b * 4 + h) * 64) * S + t0, S, sm, tid);
            transpose64(pt + C_SB_V + h * 64, NM, p.VST + ((size_t)(b * 4 + h) * 64) * S + t0, S, sm, tid);
        }
        transpose64(pt + C_NSA_VS, NM, p.VSLCT + ((size_t)b * 64) * S + t0, S, sm, tid);
        transpose64(pt + C_NSA_VW, NM, p.VWINT + ((size_t)b * 64) * S + t0, S, sm, tid);
    }
}

__device__ void ph_cumsum(const Params& p, int bid, int nb, float* sm) {
    const int tid = tidx();
    for (int item = bid; item < NBATCH * 4; item += nb) {
        const int b = item >> 2, h = item & 3;
        const float* src = p.LOGF + (size_t)b * S * 4 + h;
        float* dst = p.CUM + (size_t)b * S * 4 + h;
        float loc = 0.f;
        for (int i = 0; i < 32; ++i) loc += src[(size_t)(tid * 32 + i) * 4];
        sm[tid] = loc; __syncthreads();
        if (tid == 0) { float run = 0.f; for (int i = 0; i < 256; ++i) { const float v = sm[i]; sm[i] = run; run += v; } }
        __syncthreads();
        float run = sm[tid];
        float* dt = p.CUMT + (size_t)item * S;
        for (int i = 0; i < 32; ++i) { run += src[(size_t)(tid * 32 + i) * 4]; dst[(size_t)(tid * 32 + i) * 4] = run; dt[tid * 32 + i] = run * 1.4426950408889634f; }
        __syncthreads();
    }
}

__device__ void ph_compress(const Params& p, int layer, int bid, int nb, float* sm) {
    float* xs = sm;
    float* part = sm + 2048;
    float* hid = sm + 2304;
    const int tid = tidx();
    for (int item = bid; item < 2 * NBATCH * NCMP_PAD; item += nb) {
        const int which = item / (NBATCH * NCMP_PAD), rem = item % (NBATCH * NCMP_PAD), b = rem / NCMP_PAD, n = rem % NCMP_PAD;
        if (n == NCMP) {
            if (tid < 64) { if (which) p.VCT[((size_t)b * 64 + tid) * NCMP_PAD + n] = 0; else p.KCB[((size_t)b * NCMP_PAD + n) * 64 + tid] = 0; }
            continue;
        }
        const int coff = which ? C_NSA_VC : C_NSA_KC;
        const float* pe = (which ? p.pe_v : p.pe_k) + (size_t)layer * 2048;
        const float* w1 = (which ? p.wc1_v : p.wc1_k) + (size_t)layer * 2048 * 128;
        const float* w2 = (which ? p.wc2_v : p.wc2_k) + (size_t)layer * 128 * 64;
        for (int i = tid; i < 2048; i += 256) {
            const int tk = i >> 6, d = i & 63;
            xs[i] = p.P[(size_t)(b * S + 16 * n + tk) * NM + coff + d] + pe[i];
        }
        __syncthreads();
        {
            const int j = tid & 127, hf = tid >> 7;
            float a = 0.f;
            for (int k = hf * 1024; k < hf * 1024 + 1024; ++k) a = fmaf(xs[k], w1[(size_t)k * 128 + j], a);
            part[tid] = a;
        }
        __syncthreads();
        if (tid < 128) hid[tid] = silu_(part[tid] + part[tid + 128]);
        __syncthreads();
        {
            const int d = tid & 63, q = tid >> 6;
            float a = 0.f;
#pragma unroll 4
            for (int j = q * 32; j < q * 32 + 32; ++j) a = fmaf(hid[j], w2[j * 64 + d], a);
            part[tid] = a;
        }
        __syncthreads();
        if (tid < 64) {
            const float r = (part[tid] + part[tid + 64]) + (part[tid + 128] + part[tid + 192]);
            if (which) p.VCT[((size_t)b * 64 + tid) * NCMP_PAD + n] = f2bf(r); else p.KCB[((size_t)b * NCMP_PAD + n) * 64 + tid] = f2bf(r);
        }
        __syncthreads();
    }
}

enum { AM_FOX = 0, AM_DSA = 1, AM_SLC = 2, AM_SB = 3, AM_WIN = 4, AM_MEM = 5, AM_CMP = 6 };
constexpr int AK_ROW = 144;
constexpr int AK_TILE = 64 * AK_ROW;
constexpr int ABUF = 2 * AK_TILE + 256;
constexpr float LOG2E = 1.4426950408889634f;
#define NEG_INF (-__builtin_inff())

template <int MODE>
__device__ __forceinline__ void attn_unit(const Params& p, int b, int head, int qblk, char* sm) {
    const int tid = tidx(), lane = tid & 63, wid = __builtin_amdgcn_readfirstlane(tid >> 6), lr = lane & 31, lh = lane >> 5;
    const int q0 = qblk * 128, qw0 = q0 + 32 * wid, tq = qw0 + lr;
    const size_t gq = (size_t)b * S + tq;
    const bf16_t *Qp, *Kp, *VTp; int ldk, ldv;
    if (MODE == AM_FOX)      { Qp = p.QF + gq * 256 + head * 64; Kp = p.KF + (size_t)b * S * 256 + head * 64; ldk = 256; VTp = p.VFT + ((size_t)(b * 4 + head) * 64) * S; ldv = S; }
    else if (MODE == AM_DSA) { Qp = p.QA + gq * 256 + head * 64; Kp = p.KAB + (size_t)b * S * 256 + head * 64; ldk = 256; VTp = p.VAT + ((size_t)(b * 4 + head) * 64) * S; ldv = S; }
    else if (MODE == AM_SB)  { Qp = p.QS + gq * 256 + head * 64; Kp = p.KSB + (size_t)b * S * 256 + head * 64; ldk = 256; VTp = p.VST + ((size_t)(b * 4 + head) * 64) * S; ldv = S; }
    else if (MODE == AM_SLC) { Qp = p.QN + gq * 256 + head * 64; Kp = p.KSLC + (size_t)b * S * 64; ldk = 64; VTp = p.VSLCT + ((size_t)b * 64) * S; ldv = S; }
    else if (MODE == AM_WIN) { Qp = p.QN + gq * 256 + head * 64; Kp = p.KWIN + (size_t)b * S * 64; ldk = 64; VTp = p.VWINT + ((size_t)b * 64) * S; ldv = S; }
    else if (MODE == AM_CMP) { Qp = p.QN + gq * 256 + head * 64; Kp = p.KCB + (size_t)b * NCMP_PAD * 64; ldk = 64; VTp = p.VCT + ((size_t)b * 64) * NCMP_PAD; ldv = NCMP_PAD; }
    else                     { Qp = p.QM + gq * 256 + head * 64; Kp = p.MKB + (size_t)b * NMEM * 256 + head * 64; ldk = 256; VTp = p.MVT + ((size_t)(b * 4 + head) * 64) * NMEM; ldv = NMEM; }
    int kt_lo = 0, kt_hi = 2 * qblk + 2;
    if (MODE == AM_WIN) kt_lo = q0 >= 512 ? (q0 - 512) / 64 : 0;
    if (MODE == AM_MEM) kt_hi = NMEM / 64;
    if (MODE == AM_CMP) kt_hi = min(8, (((q0 + 96) >> 4) >> 6) + 1);
    const int nlim = (tq - 31) >> 4;
    const int ntile = kt_hi - kt_lo;
    constexpr bool REV = (MODE == AM_SB);

    bf16x8 qf[4];
#pragma unroll
    for (int s = 0; s < 4; ++s) qf[s] = *(const bf16x8*)(Qp + 16 * s + 8 * lh);
    unsigned smw[4] = {0u, 0u, 0u, 0u};
    if (MODE == AM_SLC) { const u32x4 w = *(const u32x4*)(p.SMASK + gq * 4); smw[0] = w.x; smw[1] = w.y; smw[2] = w.z; smw[3] = w.w; }
    const unsigned long long* mrow = (const unsigned long long*)(p.DMASK + gq * 256);
    const float* csp = p.CUMT + (size_t)(b * 4 + head) * S;

    const int srow = tid >> 3, sc16 = tid & 7;
    const int st0 = srow * AK_ROW + sc16 * 16, st1 = (srow + 32) * AK_ROW + sc16 * 16;
    const bf16_t* kg0 = Kp + (size_t)srow * ldk + sc16 * 8;
    const bf16_t* kg1 = Kp + (size_t)(srow + 32) * ldk + sc16 * 8;
    const bf16_t* vg0 = VTp + (size_t)srow * ldv + sc16 * 8;
    const bf16_t* vg1 = VTp + (size_t)(srow + 32) * ldv + sc16 * 8;
    u32x4 rk0, rk1, rv0, rv1; float rcs = 0.f;
    auto gload = [&](int kt) {
        rk0 = *(const u32x4*)(kg0 + (size_t)kt * 64 * ldk); rk1 = *(const u32x4*)(kg1 + (size_t)kt * 64 * ldk);
        rv0 = *(const u32x4*)(vg0 + kt * 64); rv1 = *(const u32x4*)(vg1 + kt * 64);
        if (MODE == AM_FOX) { if (tid < 64) rcs = csp[kt * 64 + tid]; }
    };
    auto lstore = [&](char* buf) {
        *(u32x4*)(buf + st0) = rk0; *(u32x4*)(buf + st1) = rk1;
        *(u32x4*)(buf + AK_TILE + st0) = rv0; *(u32x4*)(buf + AK_TILE + st1) = rv1;
        if (MODE == AM_FOX) { if (tid < 64) *(float*)(buf + 2 * AK_TILE + tid * 4) = rcs; }
    };
    const int pil = (lr & 0x13) | ((lr & 4) << 1) | ((lr & 8) >> 1);
    const int rdk = pil * AK_ROW + lh * 16;
    const int rdv = AK_TILE + lr * AK_ROW + lh * 16;

    float m = NEG_INF, l = 0.f, R = 0.f;
    f32x16 O[2];
#pragma unroll
    for (int i = 0; i < 16; ++i) { O[0][i] = 0.f; O[1][i] = 0.f; }

    gload(REV ? kt_hi - 1 : kt_lo);
    __syncthreads();
    lstore(sm);
    __syncthreads();
    for (int it = 0; it < ntile; ++it) {
        const int kt = REV ? kt_hi - 1 - it : kt_lo + it;
        char* cur = sm + (it & 1) * ABUF;
        const bool more = (it + 1) < ntile;
        if (more) gload(REV ? kt - 1 : kt + 1);
        unsigned long long mw = 0ull;
        if (MODE == AM_DSA) mw = mrow[kt];
        bool need = true;
        if (MODE == AM_CMP) need = kt * 64 <= (qw0 >> 4);
        else if (MODE != AM_MEM) need = kt * 64 <= qw0 + 31;
        if (MODE == AM_WIN) need = need && (kt * 64 + 63 >= qw0 - 511);
        if (need) {
#pragma unroll
            for (int sb2 = 0; sb2 < 2; ++sb2) {
                const int sub = REV ? 1 - sb2 : sb2;
                const int kb = kt * 64 + sub * 32;
                bool sneed = true;
                if (MODE == AM_CMP) sneed = kb <= (qw0 >> 4);
                else if (MODE != AM_MEM) sneed = kb <= qw0 + 31;
                if (MODE == AM_WIN) sneed = sneed && (kb + 31 >= qw0 - 511);
                if (sneed) {
                    f32x16 s;
#pragma unroll
                    for (int i = 0; i < 16; ++i) s[i] = 0.f;
#pragma unroll
                    for (int s4 = 0; s4 < 4; ++s4) {
                        const bf16x8 kf = *(const bf16x8*)(cur + rdk + sub * 32 * AK_ROW + s4 * 32);
                        s = __builtin_amdgcn_mfma_f32_32x32x16_bf16(kf, qf[s4], s, 0, 0, 0);
                    }
                    const int thl = tq - kb - 8 * lh;
                    bf16x8 pf[2];
                    if (MODE == AM_SB) {
                        float lk[16];
#pragma unroll
                        for (int r = 0; r < 16; ++r) {
                            const int cr = 16 * (r >> 3) + (r & 7);
                            const float z = s[r] * 0.125f;
                            const float az = fabsf(z);
                            const float sp = fmaxf(z, 0.f) + __builtin_amdgcn_logf(1.f + __builtin_amdgcn_exp2f(-az * LOG2E)) * 0.6931471805599453f;
                            const bool ok = cr < thl;
                            lk[r] = ok ? -sp : 0.f;
                            s[r] = ok ? z : NEG_INF;
                        }
                        float g0 = 0.f, g1 = 0.f;
#pragma unroll
                        for (int r = 0; r < 8; ++r) { g0 += lk[r]; g1 += lk[8 + r]; }
                        const float pg0 = __shfl_xor(g0, 32, 64), pg1 = __shfl_xor(g1, 32, 64);
                        const float off0 = R + (lh == 0 ? (pg0 + g1 + pg1) : (pg1 + g1));
                        const float off1 = R + (lh == 0 ? pg1 : 0.f);
                        float run0 = off0, run1 = off1;
#pragma unroll
                        for (int r = 7; r >= 0; --r) {
                            const float a0 = __builtin_amdgcn_exp2f((s[r] + lk[r] + run0) * LOG2E); run0 += lk[r];
                            const float a1 = __builtin_amdgcn_exp2f((s[8 + r] + lk[8 + r] + run1) * LOG2E); run1 += lk[8 + r];
                            s[r] = a0; s[8 + r] = a1;
                        }
                        R += (g0 + g1) + (pg0 + pg1);
                    } else {
                        constexpr float c = 0.125f * LOG2E;
                        if (MODE == AM_FOX) {
                            const float4* cs4 = (const float4*)(cur + 2 * AK_TILE + (sub * 32 + 8 * lh) * 4);
                            const float4 c0 = cs4[0], c1 = cs4[1], c2 = cs4[4], c3 = cs4[5];
                            const float cv[16] = {c0.x, c0.y, c0.z, c0.w, c1.x, c1.y, c1.z, c1.w, c2.x, c2.y, c2.z, c2.w, c3.x, c3.y, c3.z, c3.w};
#pragma unroll
                            for (int r = 0; r < 16; ++r) s[r] = fmaf(s[r], c, -cv[r]);
                        } else {
#pragma unroll
                            for (int r = 0; r < 16; ++r) s[r] *= c;
                        }
                        if (MODE == AM_DSA) {
                            const unsigned w = (unsigned)(mw >> (32 * sub)) >> (8 * lh);
#pragma unroll
                            for (int r = 0; r < 16; ++r) { const int cr = 16 * (r >> 3) + (r & 7); s[r] = (w & (1u << cr)) ? s[r] : NEG_INF; }
                        }
                        if (MODE == AM_SLC) {
                            const unsigned w = smw[0] * (kt < 32) + smw[1] * (kt >= 32 && kt < 64) + smw[2] * (kt >= 64 && kt < 96) + smw[3] * (kt >= 96);
                            const bool sel = (w >> (kt & 31)) & 1u;
#pragma unroll
                            for (int r = 0; r < 16; ++r) s[r] = sel ? s[r] : NEG_INF;
                        }
                        if (MODE == AM_FOX || MODE == AM_SLC) {
                            if (kb + 31 > qw0) {
#pragma unroll
                                for (int r = 0; r < 16; ++r) { const int cr = 16 * (r >> 3) + (r & 7); s[r] = (cr <= thl) ? s[r] : NEG_INF; }
                            }
                        }
                        if (MODE == AM_CMP) {
                            const int tc = nlim - kb - 8 * lh;
#pragma unroll
                            for (int r = 0; r < 16; ++r) { const int cr = 16 * (r >> 3) + (r & 7); s[r] = (cr <= tc) ? s[r] : NEG_INF; }
                        }
                        if (MODE == AM_WIN) {
                            if (kb + 31 > qw0 || kb < qw0 + 31 - 511) {
#pragma unroll
                                for (int r = 0; r < 16; ++r) { const int cr = 16 * (r >> 3) + (r & 7); s[r] = (cr <= thl && cr > thl - 512) ? s[r] : NEG_INF; }
                            }
                        }
                        float tmax = s[0];
#pragma unroll
                        for (int r = 1; r < 16; ++r) tmax = fmaxf(tmax, s[r]);
                        tmax = fmaxf(tmax, __shfl_xor(tmax, 32, 64));
                        const float mn = fmaxf(m, tmax);
                        const float mu = (mn == NEG_INF) ? 0.f : mn;
                        const float corr = __builtin_amdgcn_exp2f(m - mu);
                        m = mn;
                        float ls = 0.f;
#pragma unroll
                        for (int r = 0; r < 16; ++r) { s[r] = __builtin_amdgcn_exp2f(s[r] - mu); ls += s[r]; }
                        l = l * corr + ls;
                        if (!__all(corr == 1.0f)) {
#pragma unroll
                            for (int i = 0; i < 16; ++i) { O[0][i] *= corr; O[1][i] *= corr; }
                        }
                    }
                    {
                        u32x4 w0, w1;
                        w0.x = cvt_pk_bf16(s[0], s[1]); w0.y = cvt_pk_bf16(s[2], s[3]); w0.z = cvt_pk_bf16(s[4], s[5]); w0.w = cvt_pk_bf16(s[6], s[7]);
                        w1.x = cvt_pk_bf16(s[8], s[9]); w1.y = cvt_pk_bf16(s[10], s[11]); w1.z = cvt_pk_bf16(s[12], s[13]); w1.w = cvt_pk_bf16(s[14], s[15]);
                        pf[0] = __builtin_bit_cast(bf16x8, w0); pf[1] = __builtin_bit_cast(bf16x8, w1);
                    }
#pragma unroll
                    for (int s2 = 0; s2 < 2; ++s2)
#pragma unroll
                        for (int dt = 0; dt < 2; ++dt) {
                            const bf16x8 vf = *(const bf16x8*)(cur + rdv + dt * 32 * AK_ROW + sub * 64 + s2 * 32);
                            O[dt] = __builtin_amdgcn_mfma_f32_32x32x16_bf16(vf, pf[s2], O[dt], 0, 0, 0);
                        }
                }
            }
        }
        if (more) lstore(sm + ((it + 1) & 1) * ABUF);
        __syncthreads();
    }
    float inv = 1.f;
    if (MODE != AM_SB) { const float lt = l + __shfl_xor(l, 32, 64); inv = 1.f / fmaxf(lt, 1e-30f); }
    const float* pr = p.P + gq * NM;
    if (MODE == AM_SLC || MODE == AM_WIN || MODE == AM_CMP) {
        const float gs = (MODE == AM_CMP) ? inv : sigmoid_(pr[C_NSA_G + (MODE == AM_SLC ? 4 : 8) + head]) * inv;
        float* dst = (MODE == AM_SLC ? p.OSLC : MODE == AM_WIN ? p.OWIN : p.OCMP) + gq * 256 + head * 64;
#pragma unroll
        for (int dt = 0; dt < 2; ++dt)
#pragma unroll
            for (int g = 0; g < 4; ++g) {
                float4 o; o.x = O[dt][4 * g] * gs; o.y = O[dt][4 * g + 1] * gs; o.z = O[dt][4 * g + 2] * gs; o.w = O[dt][4 * g + 3] * gs;
                *(float4*)(dst + 32 * dt + 8 * g + 4 * lh) = o;
            }
    } else {
        const int zc = MODE == AM_FOX ? C_FOX_Z : MODE == AM_DSA ? C_DSA_Z : MODE == AM_SB ? C_SB_Z : C_MEM_Z;
        const int yc = MODE == AM_FOX ? 256 : MODE == AM_DSA ? 0 : MODE == AM_SB ? 512 : 1024;
        const float* zp = pr + zc + head * 64;
        bf16_t* dst = p.Y + gq * 1280 + yc + head * 64;
#pragma unroll
        for (int dt = 0; dt < 2; ++dt)
#pragma unroll
            for (int g = 0; g < 4; ++g) {
                const int d0 = 32 * dt + 8 * g + 4 * lh;
                const float4 z = *(const float4*)(zp + d0);
                u32x2 o;
                o.x = cvt_pk_bf16(O[dt][4 * g] * inv * silu_(z.x), O[dt][4 * g + 1] * inv * silu_(z.y));
                o.y = cvt_pk_bf16(O[dt][4 * g + 2] * inv * silu_(z.z), O[dt][4 * g + 3] * inv * silu_(z.w));
                *(u32x2*)(dst + d0) = o;
            }
    }
}

__device__ __forceinline__ unsigned sortable_key(float x) { const unsigned u = __float_as_uint(x + 0.0f); return (u & 0x80000000u) ? ~u : (u | 0x80000000u); }
__device__ void dsa_select_unit(const Params& p, int b, int qt, char* sm) {
    const int tid = tidx(), lane = tid & 63, wid = __builtin_amdgcn_readfirstlane(tid >> 6), lr = lane & 31, lh = lane >> 5;
    unsigned* hist = (unsigned*)sm;
    unsigned char* tcnt = (unsigned char*)sm;
    unsigned short* tbase = (unsigned short*)(sm + 8192);
    unsigned* st_prefix = (unsigned*)(sm + 32 * 257 * 4);
    int* st_krem = (int*)(st_prefix + 32);
    int* st_ties = st_krem + 32;
    int* st_flag = st_ties + 32;
    const int q0 = qt * 32, tq = q0 + lr, ntile = qt + 1;
    const size_t gq = (size_t)b * S + tq;
    const bool small = tq + 1 <= 256;
    bf16x8 qf[4][2];
    float w[4];
#pragma unroll
    for (int h = 0; h < 4; ++h) {
        qf[h][0] = *(const bf16x8*)(p.QI + gq * 128 + h * 32 + 8 * lh);
        qf[h][1] = *(const bf16x8*)(p.QI + gq * 128 + h * 32 + 16 + 8 * lh);
        w[h] = p.P[gq * NM + C_IDXW + h] * 0.08838834764831845f;
    }
    const bf16_t* kbase = p.KI + (size_t)b * S * 32 + (size_t)lr * 32 + 8 * lh;
    auto score_tile = [&](int kt, unsigned (&key)[16]) {
        const bf16x8 k0 = *(const bf16x8*)(kbase + (size_t)kt * 32 * 32), k1 = *(const bf16x8*)(kbase + (size_t)kt * 32 * 32 + 16);
        float sc[16];
#pragma unroll
        for (int r = 0; r < 16; ++r) sc[r] = 0.f;
#pragma unroll
        for (int h = 0; h < 4; ++h) {
            f32x16 a;
#pragma unroll
            for (int r = 0; r < 16; ++r) a[r] = 0.f;
            a = __builtin_amdgcn_mfma_f32_32x32x16_bf16(k0, qf[h][0], a, 0, 0, 0);
            a = __builtin_amdgcn_mfma_f32_32x32x16_bf16(k1, qf[h][1], a, 0, 0, 0);
#pragma unroll
            for (int r = 0; r < 16; ++r) sc[r] = fmaf(fmaxf(a[r], 0.f), w[h], sc[r]);
        }
#pragma unroll
        for (int r = 0; r < 16; ++r) key[r] = sortable_key(sc[r]);
    };
    unsigned prefix = 0u;
    for (int pass = 0; pass < 4; ++pass) {
        const int shift = 24 - 8 * pass;
        __syncthreads();
        for (int i = tid; i < 32 * 257; i += 256) hist[i] = 0u;
        __syncthreads();
        for (int kt = wid; kt < ntile; kt += 4) {
            unsigned key[16];
            score_tile(kt, key);
            const int vlim = (kt == qt) ? lr : 64;
#pragma unroll
            for (int r = 0; r < 16; ++r) {
                const int rho = (r & 3) + 8 * (r >> 2) + 4 * lh;
                const bool match = (pass == 0) || ((key[r] >> (shift + 8)) == prefix);
                if (rho <= vlim && match) atomicAdd(&hist[lr * 257 + ((key[r] >> shift) & 255u)], 1u);
            }
        }
        __syncthreads();
        if (tid < 32) {
            const int tqq = q0 + tid;
            if (tqq + 1 <= 256) { if (pass == 0) { st_prefix[tid] = 0u; st_krem[tid] = 1 << 30; st_ties[tid] = 0; } }
            else {
                int krem = (pass == 0) ? 256 : st_krem[tid];
                unsigned cum = 0u; int bin = 255;
                for (; bin > 0; --bin) { const unsigned c = hist[tid * 257 + bin]; if (cum + c >= (unsigned)krem) break; cum += c; }
                st_prefix[tid] = ((pass == 0 ? 0u : st_prefix[tid]) << 8) | (unsigned)bin;
                st_krem[tid] = krem - (int)cum;
                st_ties[tid] = (int)hist[tid * 257 + bin];
            }
        }
        __syncthreads();
        prefix = st_prefix[lr];
    }
    const unsigned thr = prefix;
    const int need = st_krem[lr];
    if (tid == 0) st_flag[0] = 0;
    __syncthreads();
    if (!small && st_ties[lr] > need) st_flag[0] = 1;
    __syncthreads();
    const bool tiepass = st_flag[0] != 0;
    if (tiepass) {
        for (int kt = wid; kt < ntile; kt += 4) {
            unsigned key[16];
            score_tile(kt, key);
            const int vlim = (kt == qt) ? lr : 64;
            int c = 0;
#pragma unroll
            for (int r = 0; r < 16; ++r) { const int rho = (r & 3) + 8 * (r >> 2) + 4 * lh; c += (rho <= vlim && key[r] == thr) ? 1 : 0; }
            c += __shfl_xor(c, 32, 64);
            if (lh == 0) tcnt[lr * 256 + kt] = (unsigned char)c;
        }
        __syncthreads();
        if (tid < 32) { int run = 0; for (int kt = 0; kt < ntile; ++kt) { tbase[tid * 256 + kt] = (unsigned short)run; run += tcnt[tid * 256 + kt]; } }
        __syncthreads();
    }
    unsigned* mrow = p.DMASK + gq * 256;
    for (int kt = wid; kt < 256; kt += 4) {
        unsigned word = 0u;
        if (kt < ntile) {
            unsigned key[16];
            score_tile(kt, key);
            const int vlim = (kt == qt) ? lr : 64;
            unsigned gt = 0u, tie = 0u;
#pragma unroll
            for (int r = 0; r < 16; ++r) {
                const int rho = (r & 3) + 8 * (r >> 2) + 4 * lh;
                if (rho <= vlim) { gt |= (key[r] > thr) ? (1u << rho) : 0u; tie |= (key[r] == thr) ? (1u << rho) : 0u; }
            }
            gt |= __shfl_xor(gt, 32, 64); tie |= __shfl_xor(tie, 32, 64);
            if (tiepass && !small) {
                int allow = need - (int)tbase[lr * 256 + kt];
                if (allow <= 0) tie = 0u;
                else if (allow < __builtin_popcount(tie)) { unsigned wv = tie, kept = 0u; for (int i = 0; i < allow; ++i) { const unsigned low = wv & (0u - wv); kept |= low; wv ^= low; } tie = kept; }
            }
            word = gt | tie;
        }
        if (lh == 0) mrow[kt] = word;
    }
    __syncthreads();
}

__device__ __forceinline__ bool imp_better(float v1, int i1, float v2, int i2) { return (v1 > v2) || (v1 == v2 && i1 < i2); }
__device__ void nsa_select_unit(const Params& p, int b, int q0w, char* sm) {
    const int lane = tidx() & 63, lr = lane & 31, lh = lane >> 5;
    const int tq = q0w + lr;
    const size_t gq = (size_t)b * S + tq;
    const int nlim = (tq - 31) >> 4;
    const int nst = min(16, ((((q0w + 31 - 31) >> 4)) >> 5) + 1);
    const int pil = (lr & 0x13) | ((lr & 4) << 1) | ((lr & 8) >> 1);
    const bf16_t* kc = p.KCB + (size_t)b * NCMP_PAD * 64 + (size_t)pil * 64 + 8 * lh;
    constexpr float c = 0.125f * LOG2E;
    float mh[4], il[4];
#pragma unroll
    for (int h = 0; h < 4; ++h) {
        bf16x8 qf[4];
#pragma unroll
        for (int s = 0; s < 4; ++s) qf[s] = *(const bf16x8*)(p.QN + gq * 256 + h * 64 + 16 * s + 8 * lh);
        float m = NEG_INF, l = 0.f;
        for (int st = 0; st < nst; ++st) {
            f32x16 s;
#pragma unroll
            for (int i = 0; i < 16; ++i) s[i] = 0.f;
#pragma unroll
            for (int s4 = 0; s4 < 4; ++s4) { const bf16x8 kf = *(const bf16x8*)(kc + (size_t)st * 32 * 64 + s4 * 16); s = __builtin_amdgcn_mfma_f32_32x32x16_bf16(kf, qf[s4], s, 0, 0, 0); }
            const int thl = nlim - st * 32 - 8 * lh;
            float tmax = NEG_INF;
#pragma unroll
            for (int r = 0; r < 16; ++r) { const int cr = 16 * (r >> 3) + (r & 7); s[r] = (cr <= thl) ? s[r] * c : NEG_INF; tmax = fmaxf(tmax, s[r]); }
            tmax = fmaxf(tmax, __shfl_xor(tmax, 32, 64));
            const float mn = fmaxf(m, tmax), mu = (mn == NEG_INF) ? 0.f : mn;
            float ls = 0.f;
#pragma unroll
            for (int r = 0; r < 16; ++r) ls += __builtin_amdgcn_exp2f(s[r] - mu);
            l = l * __builtin_amdgcn_exp2f(m - mu) + ls; m = mn;
        }
        l += __shfl_xor(l, 32, 64);
        mh[h] = (m == NEG_INF) ? 0.f : m; il[h] = 1.f / fmaxf(l, 1e-30f);
    }
    float val[16]; int idx[16];
#pragma unroll
    for (int i = 0; i < 16; ++i) { val[i] = NEG_INF; idx[i] = 1 << 20; }
    const int cur = tq >> 6;
    for (int st = 0; st < 16; ++st) {
        float bs[4] = {0.f, 0.f, 0.f, 0.f};
        if (st < nst) {
            const int thl = nlim - st * 32 - 8 * lh;
#pragma unroll
            for (int h = 0; h < 4; ++h) {
                f32x16 s;
#pragma unroll
                for (int i = 0; i < 16; ++i) s[i] = 0.f;
#pragma unroll
                for (int s4 = 0; s4 < 4; ++s4) {
                    const bf16x8 kf = *(const bf16x8*)(kc + (size_t)st * 32 * 64 + s4 * 16);
                    const bf16x8 qfr = *(const bf16x8*)(p.QN + gq * 256 + h * 64 + 16 * s4 + 8 * lh);
                    s = __builtin_amdgcn_mfma_f32_32x32x16_bf16(kf, qfr, s, 0, 0, 0);
                }
#pragma unroll
                for (int r = 0; r < 16; ++r) {
                    const int cr = 16 * (r >> 3) + (r & 7);
                    const float pr = (cr <= thl) ? __builtin_amdgcn_exp2f(s[r] * c - mh[h]) * il[h] : 0.f;
                    bs[r >> 2] += pr;
                }
            }
        }
#pragma unroll
        for (int g = 0; g < 4; ++g) {
            const int j = st * 8 + 4 * (g >> 1) + 2 * lh + (g & 1);
            const bool forced = (j == 0) || (j == cur) || (j == cur - 1);
            float v = forced ? 1e4f : ((j <= cur) ? bs[g] : -1.0f);
            int jj = j;
            if (__any(imp_better(v, jj, val[15], idx[15]))) {
#pragma unroll
                for (int i = 0; i < 16; ++i) {
                    const bool bt = imp_better(v, jj, val[i], idx[i]);
                    const float tv = bt ? val[i] : v; const int ti = bt ? idx[i] : jj;
                    val[i] = bt ? v : val[i]; idx[i] = bt ? jj : idx[i];
                    v = tv; jj = ti;
                }
            }
        }
    }
    {
        float* lv = (float*)(sm + (tidx() >> 6) * 8192);
        int* li = (int*)(lv + 1024);
#pragma unroll
        for (int i = 0; i < 16; ++i) { lv[i * 64 + lane] = val[i]; li[i * 64 + lane] = idx[i]; }
        __builtin_amdgcn_wave_barrier();
#pragma unroll 1
        for (int k = 0; k < 16; ++k) {
            float v = lv[k * 64 + (lane ^ 32)]; int jj = li[k * 64 + (lane ^ 32)];
#pragma unroll
            for (int i = 0; i < 16; ++i) {
                const bool bt = imp_better(v, jj, val[i], idx[i]);
                const float tv = bt ? val[i] : v; const int ti = bt ? idx[i] : jj;
                val[i] = bt ? v : val[i]; idx[i] = bt ? jj : idx[i];
                v = tv; jj = ti;
            }
        }
        __builtin_amdgcn_wave_barrier();
    }
    unsigned m0 = 0u, m1 = 0u, m2 = 0u, m3 = 0u;
#pragma unroll
    for (int i = 0; i < 16; ++i) {
        const unsigned bit = 1u << (idx[i] & 31); const int wsel = idx[i] >> 5;
        m0 |= (wsel == 0) ? bit : 0u; m1 |= (wsel == 1) ? bit : 0u; m2 |= (wsel == 2) ? bit : 0u; m3 |= (wsel == 3) ? bit : 0u;
    }
    if (lh == 0) { u32x4 o; o.x = m0; o.y = m1; o.z = m2; o.w = m3; *(u32x4*)(p.SMASK + gq * 4) = o; }
}

__device__ void ph_select(const Params& p, int layer, char* sm) {
    __shared__ int s_unit2;
    unsigned* ctr = p.qctr + 64 * layer + 32;
    for (;;) {
        __syncthreads();
        if (threadIdx.x == 0) s_unit2 = (int)atomicAdd(ctr, 1u);
        __syncthreads();
        const int u = __builtin_amdgcn_readfirstlane(s_unit2);
        if (u >= 512 + 128) break;
        if (u < 512) { const int qt = 255 - (u >> 1), b = u & 1; dsa_select_unit(p, b, qt, sm); }
        else { const int v = u - 512, b = v & 1, qb = v >> 1; nsa_select_unit(p, b, qb * 128 + 32 * __builtin_amdgcn_readfirstlane(tidx() >> 6), sm); }
    }
}

__device__ void ph_attention(const Params& p, int layer, int bid, int nb, char* sm) {
    (void)bid; (void)nb;
    __shared__ int s_unit;
    unsigned* ctr = p.qctr + 64 * layer;
    for (;;) {
        __syncthreads();
        if (threadIdx.x == 0) s_unit = (int)atomicAdd(ctr, 1u);
        __syncthreads();
        const int u = __builtin_amdgcn_readfirstlane(s_unit);
        if (u >= 3584) break;
        if (u < 2048) {
            const int qblk = 63 - (u >> 5), r = u & 31, br = r >> 3, b = (r >> 2) & 1, h = r & 3;
            if (br == 0) attn_unit<AM_SB>(p, b, h, qblk, sm);
            else if (br == 1) attn_unit<AM_FOX>(p, b, h, qblk, sm);
            else if (br == 2) attn_unit<AM_DSA>(p, b, h, qblk, sm);
            else attn_unit<AM_SLC>(p, b, h, qblk, sm);
        } else {
            const int v = u - 2048, br = v >> 9, w = v & 511, qblk = w >> 3, b = (w >> 2) & 1, h = w & 3;
            if (br == 0) attn_unit<AM_WIN>(p, b, h, qblk, sm);
            else if (br == 1) attn_unit<AM_CMP>(p, b, h, 63 - qblk, sm);
            else attn_unit<AM_MEM>(p, b, h, qblk, sm);
        }
    }
}

__device__ void ph_nsa_combine(const Params& p, int bid, int nb) {
    for (size_t i = (size_t)bid * 256 + tidx(); i < (size_t)T * 64; i += (size_t)nb * 256) {
        const size_t g = i >> 6; const int c = (int)(i & 63) * 4, h = c >> 6;
        const float* pr = p.P + g * NM;
        const float g0 = sigmoid_(pr[C_NSA_G + h]);
        const float4 a = *(const float4*)(p.OCMP + g * 256 + c), s = *(const float4*)(p.OSLC + g * 256 + c), w = *(const float4*)(p.OWIN + g * 256 + c);
        const float4 z = *(const float4*)(pr + C_NSA_Z + c);
        u32x2 o;
        o.x = cvt_pk_bf16((g0 * a.x + s.x + w.x) * silu_(z.x), (g0 * a.y + s.y + w.y) * silu_(z.y));
        o.y = cvt_pk_bf16((g0 * a.z + s.z + w.z) * silu_(z.z), (g0 * a.w + s.w + w.w) * silu_(z.w));
        *(u32x2*)(p.Y + g * 1280 + 768 + c) = o;
    }
}

#define XB_TMO      128
#define XB_XCNT(j)  (256  + 64 * (j))
#define XB_XSUB(j)  (1280 + 64 * (j))
#define XB_XGEN(j)  (2304 + 64 * (j))
#define XB_TOP      3328
#define XB_TOPGEN   3392
#define XCD_BAR_WORDS 3456
#define XB_SPIN_CAP (1u << 18)
#define LAS __attribute__((address_space(3)))

__device__ __forceinline__ unsigned xb_ld(unsigned* p)              { return __hip_atomic_load(p, __ATOMIC_RELAXED, __HIP_MEMORY_SCOPE_AGENT); }
__device__ __forceinline__ unsigned xb_add(unsigned* p, unsigned v) { return __hip_atomic_fetch_add(p, v, __ATOMIC_RELAXED, __HIP_MEMORY_SCOPE_AGENT); }
__device__ __forceinline__ unsigned xb_xcc_id() { return (unsigned)__builtin_amdgcn_s_getreg((3 << 11) | 20) & 0xFu; }
#define XB_SPIN(cond, bar) do { unsigned _sp = 0; while (cond) { __builtin_amdgcn_s_sleep(1); \
    if ((++_sp & 255u) == 0u) { if (xb_ld(&(bar)[XB_TMO])) break; if (_sp > XB_SPIN_CAP) { atomicAdd(&(bar)[XB_TMO], 1u); break; } } } } while (0)

struct XcdBarrier {
    unsigned* bar; unsigned x;
    volatile LAS unsigned* st;
};
__device__ __forceinline__ XcdBarrier xcd_barrier_post(unsigned* bar, volatile LAS unsigned* st) {
    XcdBarrier b; b.bar = bar; b.x = xb_xcc_id(); b.st = st;
    if (threadIdx.x == 0) (void)xb_add(&bar[XB_XCNT(b.x)], 1u);
    return b;
}
__device__ __forceinline__ void xcd_barrier_complete(unsigned* bar, unsigned x, unsigned& nloc, unsigned& nx) {
    const unsigned G = gridDim.x * gridDim.y * gridDim.z;
    unsigned sum, cnt, mine, sp = 0u;
    for (;;) {
        sum = 0u; cnt = 0u; mine = 0u;
#pragma unroll
        for (unsigned j = 0; j < 16; ++j) { const unsigned c = xb_ld(&bar[XB_XCNT(j)]); sum += c; cnt += (c > 0u) ? 1u : 0u; mine = (j == x) ? c : mine; }
        if (sum == G) break;
        __builtin_amdgcn_s_sleep(1);
        if ((++sp & 255u) == 0u) { if (xb_ld(&bar[XB_TMO])) break; if (sp > XB_SPIN_CAP) { atomicAdd(&bar[XB_TMO], 1u); break; } }
    }
    nloc = mine > 0u ? mine : 1u; nx = cnt > 0u ? cnt : 1u;
}
__device__ __forceinline__ void xcd_barrier(const XcdBarrier& b) {
    asm volatile("s_waitcnt vmcnt(0)" ::: "memory");
    __syncthreads();
    if (threadIdx.x == 0) {
        unsigned* bar = b.bar;
        __builtin_amdgcn_s_waitcnt(0);
        unsigned nloc = b.st[0], nx = b.st[1];
        if (nloc == 0u) { xcd_barrier_complete(bar, b.x, nloc, nx); b.st[0] = nloc; b.st[1] = nx; }
        const unsigned old = xb_add(&bar[XB_XSUB(b.x)], 1u);
        const unsigned gen = old / nloc;
        if (old + 1u == (gen + 1u) * nloc) {
            __builtin_amdgcn_fence(__ATOMIC_RELEASE, "agent");
            asm volatile("s_waitcnt vmcnt(0)" ::: "memory");
            const unsigned og = xb_add(&bar[XB_TOP], 1u);
            const unsigned tg = og / nx;
            if (og + 1u == (tg + 1u) * nx) xb_add(&bar[XB_TOPGEN], 1u);
            else XB_SPIN(xb_ld(&bar[XB_TOPGEN]) == tg, bar);
            __builtin_amdgcn_fence(__ATOMIC_ACQUIRE, "agent");
            xb_add(&bar[XB_XGEN(b.x)], 1u);
            asm volatile("s_waitcnt vmcnt(0)" ::: "memory");
        } else {
            XB_SPIN(xb_ld(&bar[XB_XGEN(b.x)]) == gen, bar);
            __builtin_amdgcn_fence(__ATOMIC_ACQUIRE, "agent");
            asm volatile("s_waitcnt vmcnt(0)" ::: "memory");
        }
    }
    __syncthreads();
}

#ifndef DIAG
#define DIAG 0
#endif
#ifndef DIAG_A
#define DIAG_A 8
#define DIAG_B 7
#endif
#if DIAG
#define STAMP(k) do { if (blockIdx.x == 0 && threadIdx.x == 0) { const unsigned long long t_ = wall_clock64(); dg[k] += t_ - dlast; dlast = t_; } } while (0)
#else
#define STAMP(k) do { } while (0)
#endif
__global__ void __launch_bounds__(256, 2) mega(Params p) {
    __shared__ __attribute__((aligned(16))) char smem[40960];
    __shared__ uint4 xb_words;
    if (threadIdx.x == 0) xb_words = make_uint4(0u, 0u, 0u, 0u);
    __syncthreads();
    XcdBarrier bar = xcd_barrier_post(p.bar, (volatile LAS unsigned*)&xb_words);
    const int bid = blockIdx.x, nb = gridDim.x;
    float* smf = (float*)smem;
#if DIAG
    __shared__ unsigned long long dg[16];
    unsigned long long dlast = 0;
    if (threadIdx.x == 0) { for (int i = 0; i < 16; ++i) dg[i] = 0; dlast = wall_clock64(); }
#endif

    convert_wt(p.w_branch, p.WBR, 256, D, DEPTH * 5, bid, nb, smf);
    convert_wt(p.w_out, p.WOUT, D, D, DEPTH, bid, nb, smf);
    convert_wt(p.w_mem_kv, p.WMKV, D, 512, DEPTH, bid, nb, smf);
    convert_wt(p.w_uk, p.WUK, 128, 256, DEPTH, bid, nb, smf);
    convert_wt(p.w_uv, p.WUV, 128, 256, DEPTH, bid, nb, smf);
    ph_rope_table(p, bid, nb);
    STAMP(0);
    for (int l = 0; l < DEPTH; ++l) {
        const float* Xin = l == 0 ? p.x : p.X;
        convert_wt(p.w_in + (size_t)l * D * NIN, p.WIN, D, NIN, 1, bid, nb, smf);
        ph_rmsnorm<bf16_t>(Xin, p.norm_g + l * D, p.H, T, bid, nb);
        ph_rmsnorm<bf16_t>(p.mem, p.mem_norm + l * D, p.MEMN, NBATCH * NMEM, bid, nb);
        xcd_barrier(bar); STAMP(1);
        { EpiStore e{p.P, NM}; gemm_bf16<128>(p.H, D, p.WIN, D, T, NM, D, e, bid, nb, smem); }
        { EpiStore e{p.MKV, 512}; gemm_bf16<128>(p.MEMN, D, p.WMKV + (size_t)l * 512 * D, D, NBATCH * NMEM, 512, D, e, bid, nb, smem); }
        xcd_barrier(bar); STAMP(2);
        ph_ckvnorm(p, l, bid, nb);
        xcd_barrier(bar); STAMP(3);
        { EpiStore e{p.KA, 256}; gemm_bf16<128>(p.CKV, 128, p.WUK + (size_t)l * 256 * 128, 128, T, 256, 128, e, bid, nb, smem); }
        { EpiStore e{p.VA, 256}; gemm_bf16<128>(p.CKV, 128, p.WUV + (size_t)l * 256 * 128, 128, T, 256, 128, e, bid, nb, smem); }
        xcd_barrier(bar); STAMP(4);
        ph_prep(p, l, bid, nb, smf);
        xcd_barrier(bar); STAMP(5);
        ph_cumsum(p, bid, nb, smf);
        ph_compress(p, l, bid, nb, smf);
        xcd_barrier(bar); STAMP(6);
        ph_select(p, l, smem);
        xcd_barrier(bar); STAMP(7);
        ph_attention(p, l, bid, nb, smem);
        xcd_barrier(bar); STAMP(8);
        ph_nsa_combine(p, bid, nb);
        xcd_barrier(bar); STAMP(9);
        ph_merge(p, l, bid, nb, smem);
        xcd_barrier(bar); STAMP(10);
        { EpiResid e{Xin, p.X}; gemm_bf16<128>(p.MG, D, p.WOUT + (size_t)l * D * D, D, T, D, D, e, bid, nb, smem); }
        xcd_barrier(bar); STAMP(11);
    }
    ph_rmsnorm<float>(p.X, p.final_norm, p.X, T, bid, nb);
#if DIAG
    {
        float* dgw = (float*)(p.bar + 4096 + 512);
        if (blockIdx.x == 0 && threadIdx.x == 0) {
            unsigned long long tot = 0; for (int i = 0; i < 16; ++i) tot += dg[i];
            dgw[0] = (float)((double)dg[DIAG_A] / (double)tot); dgw[1] = (float)((double)dg[DIAG_B] / (double)tot);
        }
        xcd_barrier(bar);
        const float fa = 1.0f + dgw[0], fb = dgw[1];
        for (size_t i = (size_t)bid * 256 + threadIdx.x; i < (size_t)T * D; i += (size_t)nb * 256) p.X[i] *= fa;
        xcd_barrier(bar);
        if (blockIdx.x == 0 && threadIdx.x == 0) p.X[0] += 100.f * fb;
    }
#endif
}
}

extern "C" void kernel_launch(void* const* d_in, const int* in_sizes, int n_in, void* d_out, int out_size, void* d_ws, size_t ws_size, hipStream_t stream) {
    (void)in_sizes; (void)n_in; (void)out_size;
    Params p{};
    p.x = (const float*)d_in[0]; p.mem = (const float*)d_in[1]; p.pos = (const int*)d_in[2]; p.norm_g = (const float*)d_in[3];
    p.w_in = (const float*)d_in[4]; p.kv_norm = (const float*)d_in[5]; p.w_uk = (const float*)d_in[6]; p.w_uv = (const float*)d_in[7];
    p.fox_bias = (const float*)d_in[8]; p.pe_k = (const float*)d_in[9]; p.pe_v = (const float*)d_in[10]; p.wc1_k = (const float*)d_in[11];
    p.wc2_k = (const float*)d_in[12]; p.wc1_v = (const float*)d_in[13]; p.wc2_v = (const float*)d_in[14]; p.mem_norm = (const float*)d_in[15];
    p.w_mem_kv = (const float*)d_in[16]; p.w_branch = (const float*)d_in[17]; p.w_out = (const float*)d_in[18]; p.final_norm = (const float*)d_in[19];
    p.X = (float*)d_out;
    size_t off = 0; char* ws = (char*)d_ws;
    auto carve = [&](size_t bytes) { char* r = ws + off; off += (bytes + 255) & ~(size_t)255; return r; };
    p.bar = (unsigned*)carve((4096 + 64 * 8 + 64) * 4);
    p.qctr = p.bar + 4096;
    p.P = (float*)carve((size_t)T * NM * 4);
    p.MG = (bf16_t*)p.P;
    p.H = (bf16_t*)carve((size_t)T * D * 2);
    p.Y = (bf16_t*)carve((size_t)T * 1280 * 2);
    p.CKV = (bf16_t*)carve((size_t)T * 128 * 2);
    p.KA = (float*)carve((size_t)T * 256 * 4);
    p.VA = (float*)carve((size_t)T * 256 * 4);
    p.OCMP = (float*)carve((size_t)T * 256 * 4);
    p.LOGF = (float*)carve((size_t)T * 4 * 4);
    p.CUM = (float*)carve((size_t)T * 4 * 4);
    p.KCB = (bf16_t*)carve((size_t)NBATCH * NCMP_PAD * 64 * 2);
    p.VCT = (bf16_t*)carve((size_t)NBATCH * NCMP_PAD * 64 * 2);
    p.QI = (bf16_t*)carve((size_t)T * 128 * 2);
    p.KI = (bf16_t*)carve((size_t)T * 32 * 2);
    p.MEMN = (bf16_t*)carve((size_t)NBATCH * NMEM * D * 2);
    p.MKV = (float*)carve((size_t)NBATCH * NMEM * 512 * 4);
    p.ROPE = (float*)carve((size_t)T * 64 * 4);
    p.DMASK = (unsigned*)carve((size_t)T * 256 * 4);
    p.QA = (bf16_t*)carve((size_t)T * 256 * 2); p.KAB = (bf16_t*)carve((size_t)T * 256 * 2); p.VAT = (bf16_t*)carve((size_t)T * 256 * 2);
    p.QF = (bf16_t*)carve((size_t)T * 256 * 2); p.KF = (bf16_t*)carve((size_t)T * 256 * 2); p.VFT = (bf16_t*)carve((size_t)T * 256 * 2);
    p.QS = (bf16_t*)carve((size_t)T * 256 * 2); p.KSB = (bf16_t*)carve((size_t)T * 256 * 2); p.VST = (bf16_t*)carve((size_t)T * 256 * 2);
    p.QN = (bf16_t*)carve((size_t)T * 256 * 2); p.QM = (bf16_t*)carve((size_t)T * 256 * 2);
    p.KSLC = (bf16_t*)carve((size_t)T * 64 * 2); p.VSLCT = (bf16_t*)carve((size_t)T * 64 * 2);
    p.KWIN = (bf16_t*)carve((size_t)T * 64 * 2); p.VWINT = (bf16_t*)carve((size_t)T * 64 * 2);
    p.MKB = (bf16_t*)carve((size_t)NBATCH * NMEM * 256 * 2); p.MVT = (bf16_t*)carve((size_t)NBATCH * NMEM * 256 * 2);
    p.CUMT = (float*)carve((size_t)T * 4 * 4);
    p.OSLC = p.KA; p.OWIN = p.VA;
    p.SMASK = (unsigned*)carve((size_t)T * 4 * 4);
    p.WIN = (bf16_t*)carve((size_t)NIN * D * 2);
    p.WBR = (bf16_t*)carve((size_t)DEPTH * 5 * D * 256 * 2);
    p.WOUT = (bf16_t*)carve((size_t)DEPTH * D * D * 2);
    p.WMKV = (bf16_t*)carve((size_t)DEPTH * 512 * D * 2);
    p.WUK = (bf16_t*)carve((size_t)DEPTH * 256 * 128 * 2);
    p.WUV = (bf16_t*)carve((size_t)DEPTH * 256 * 128 * 2);
    if (off > ws_size) { fprintf(stderr, "kernel_launch: workspace too small (%zu > %zu)\n", off, ws_size); return; }

    static int grid = 0;
    if (grid == 0) {
        int dev = 0, cus = 0, per_cu = 0;
        hipGetDevice(&dev);
        hipDeviceGetAttribute(&cus, hipDeviceAttributeMultiprocessorCount, dev);
        hipOccupancyMaxActiveBlocksPerMultiprocessor(&per_cu, (const void*)mega, 256, 0);
        (void)hipGetLastError();
        if (per_cu < 1) per_cu = 1;
        grid = cus * (per_cu < 2 ? per_cu : 2);
    }
    hipMemsetAsync(p.bar, 0, (4096 + 64 * 8) * sizeof(unsigned), stream);
    hipLaunchKernelGGL(mega, dim3(grid), dim3(256), 0, stream, p);
}
```

```cpp
#include <hip/hip_runtime.h>
#include <stdint.h>
#include <math.h>
#include <cstdio>

namespace {
constexpr int S = 8192, NBATCH = 2, T = NBATCH * S, D = 1024, NIN = 9396, NM = 4276, DEPTH = 4, NMEM = 256;
constexpr int NCMP = 511, NCMP_PAD = 512;
constexpr int C_DSA_Q = 0, C_CKV = 256, C_IDXQ = 384, C_IDXK = 512, C_IDXW = 544, C_DSA_Z = 548,
              C_FOX_Q = 804, C_FOX_K = 1060, C_FOX_V = 1316, C_FOX_F = 1572, C_FOX_Z = 1576,
              C_SB_Q = 1832, C_SB_K = 2088, C_SB_V = 2344, C_SB_Z = 2600,
              C_NSA_Q = 2856, C_NSA_KC = 3112, C_NSA_VC = 3176, C_NSA_KS = 3240, C_NSA_VS = 3304, C_NSA_KW = 3368, C_NSA_VW = 3432,
              C_NSA_G = 3496, C_NSA_Z = 3508, C_MEM_Q = 3764, C_MEM_Z = 4020, C_MERGE = 4276;

typedef unsigned short bf16_t;
typedef short bf16x8 __attribute__((ext_vector_type(8)));
typedef float f32x16 __attribute__((ext_vector_type(16)));
typedef unsigned u32x4 __attribute__((ext_vector_type(4)));
typedef unsigned u32x2 __attribute__((ext_vector_type(2)));

constexpr int M_QA = 0, M_QN = 256, M_KSLC = 512, M_KWIN = 576, M_KC = 640, M_VC = 704, M_QF = 768, M_KF = 1024, M_QS = 1280, M_KSB = 1536, M_QM = 1792,
              M_VF = 2048, M_VS = 2304, M_VSLC = 2560, M_VWIN = 2624, M_QI = 2688, M_SPC = 2816, M_CKV = 2880, M_Z = 3008, M_MERGE = 4288, NPM = 4288, NP = 9408;
constexpr size_t al256(size_t x) { return (x + 255) & ~(size_t)255; }
constexpr size_t OFF_bar = 0;
constexpr size_t OFF_H = OFF_bar + al256((4096 + 64 * 8 + 64) * 4);
constexpr size_t OFF_Y = OFF_H + al256((size_t)T * D * 2);
constexpr size_t OFF_ZG = OFF_Y + al256((size_t)T * 1280 * 2);
constexpr size_t OFF_MG = OFF_ZG + al256((size_t)T * 1280 * 2);
constexpr size_t OFF_CKVR = OFF_MG + al256((size_t)T * D * 2);
constexpr size_t OFF_CKV = OFF_CKVR + al256((size_t)T * 128 * 4);
constexpr size_t OFF_OCMP = OFF_CKV + al256((size_t)T * 128 * 2);
constexpr size_t OFF_OSLC = OFF_OCMP + al256((size_t)T * 256 * 4);
constexpr size_t OFF_OWIN = OFF_OSLC + al256((size_t)T * 256 * 4);
constexpr size_t OFF_LOGF = OFF_OWIN + al256((size_t)T * 256 * 4);
constexpr size_t OFF_CUM = OFF_LOGF + al256((size_t)T * 4 * 4);
constexpr size_t OFF_CUMT = OFF_CUM + al256((size_t)T * 4 * 4);
constexpr size_t OFF_WI = OFF_CUMT + al256((size_t)T * 4 * 4);
constexpr size_t OFF_GN = OFF_WI + al256((size_t)T * 4 * 4);
constexpr size_t OFF_KCT = OFF_GN + al256((size_t)T * 12 * 4);
constexpr size_t OFF_VCTOK = OFF_KCT + al256(((size_t)T * 64 + 2048) * 2);
constexpr size_t OFF_HIDK = OFF_VCTOK + al256(((size_t)T * 64 + 2048) * 2);
constexpr size_t OFF_HIDV = OFF_HIDK + al256((size_t)1024 * 128 * 2);
constexpr size_t OFF_KCB = OFF_HIDV + al256((size_t)1024 * 128 * 2);
constexpr size_t OFF_VCT = OFF_KCB + al256((size_t)NBATCH * NCMP_PAD * 64 * 2);
constexpr size_t OFF_QI = OFF_VCT + al256((size_t)NBATCH * NCMP_PAD * 64 * 2);
constexpr size_t OFF_KI = OFF_QI + al256((size_t)T * 128 * 2);
constexpr size_t OFF_MEMN = OFF_KI + al256((size_t)T * 32 * 2);
constexpr size_t OFF_ROPE = OFF_MEMN + al256((size_t)NBATCH * NMEM * D * 2);
constexpr size_t OFF_DMASK = OFF_ROPE + al256((size_t)T * 64 * 4);
constexpr size_t OFF_SMASK = OFF_DMASK + al256((size_t)T * 256 * 4);
constexpr size_t OFF_QA = OFF_SMASK + al256((size_t)T * 4 * 4);
constexpr size_t OFF_KAB = OFF_QA + al256((size_t)T * 256 * 2);
constexpr size_t OFF_VAT = OFF_KAB + al256((size_t)T * 256 * 2);
constexpr size_t OFF_QF = OFF_VAT + al256((size_t)T * 256 * 2);
constexpr size_t OFF_KF = OFF_QF + al256((size_t)T * 256 * 2);
constexpr size_t OFF_VFT = OFF_KF + al256((size_t)T * 256 * 2);
constexpr size_t OFF_QS = OFF_VFT + al256((size_t)T * 256 * 2);
constexpr size_t OFF_KSB = OFF_QS + al256((size_t)T * 256 * 2);
constexpr size_t OFF_VST = OFF_KSB + al256((size_t)T * 256 * 2);
constexpr size_t OFF_QN = OFF_VST + al256((size_t)T * 256 * 2);
constexpr size_t OFF_QM = OFF_QN + al256((size_t)T * 256 * 2);
constexpr size_t OFF_KSLC = OFF_QM + al256((size_t)T * 256 * 2);
constexpr size_t OFF_VSLCT = OFF_KSLC + al256((size_t)T * 64 * 2);
constexpr size_t OFF_KWIN = OFF_VSLCT + al256((size_t)T * 64 * 2);
constexpr size_t OFF_VWINT = OFF_KWIN + al256((size_t)T * 64 * 2);
constexpr size_t OFF_MKB = OFF_VWINT + al256((size_t)T * 64 * 2);
constexpr size_t OFF_MVT = OFF_MKB + al256((size_t)NBATCH * NMEM * 256 * 2);
constexpr size_t OFF_WIN = OFF_MVT + al256((size_t)NBATCH * NMEM * 256 * 2);
constexpr size_t OFF_WBR = OFF_WIN + al256((size_t)NP * D * 2);
constexpr size_t OFF_WOUT = OFF_WBR + al256((size_t)DEPTH * 5 * D * 256 * 2);
constexpr size_t OFF_WMKV = OFF_WOUT + al256((size_t)DEPTH * D * D * 2);
constexpr size_t OFF_WUK = OFF_WMKV + al256((size_t)DEPTH * 512 * D * 2);
constexpr size_t OFF_WUV = OFF_WUK + al256((size_t)DEPTH * 256 * 128 * 2);
constexpr size_t OFF_WC1T = OFF_WUV + al256((size_t)DEPTH * 256 * 128 * 2);
constexpr size_t OFF_WC2T = OFF_WC1T + al256((size_t)DEPTH * 2 * 128 * 2048 * 2);
constexpr size_t OFF_BIASC = OFF_WC2T + al256((size_t)DEPTH * 2 * 64 * 128 * 2);
constexpr size_t WS_TOTAL = OFF_BIASC + al256((size_t)DEPTH * 2 * 128 * 4);

__device__ __forceinline__ int map_in_col(int n) {
    constexpr int seg[27][3] = {{0, 256, M_QA}, {256, 128, M_CKV}, {384, 128, M_QI}, {512, 32, M_SPC}, {544, 4, M_SPC + 32}, {548, 256, M_Z}, {804, 256, M_QF}, {1060, 256, M_KF},
        {1316, 256, M_VF}, {1572, 4, M_SPC + 36}, {1576, 256, M_Z + 256}, {1832, 256, M_QS}, {2088, 256, M_KSB}, {2344, 256, M_VS}, {2600, 256, M_Z + 512}, {2856, 256, M_QN},
        {3112, 64, M_KC}, {3176, 64, M_VC}, {3240, 64, M_KSLC}, {3304, 64, M_VSLC}, {3368, 64, M_KWIN}, {3432, 64, M_VWIN}, {3496, 12, M_SPC + 40}, {3508, 256, M_Z + 768},
        {3764, 256, M_QM}, {4020, 256, M_Z + 1024}, {4276, 5120, M_MERGE}};
    int r = 0;
#pragma unroll
    for (int i = 0; i < 27; ++i) r = (n >= seg[i][0] && n < seg[i][0] + seg[i][1]) ? (seg[i][2] + n - seg[i][0]) : r;
    return r;
}
struct Params {
    const float* x; const float* mem; const int* pos; const float* norm_g; const float* w_in; const float* kv_norm;
    const float* w_uk; const float* w_uv; const float* fox_bias; const float* pe_k; const float* pe_v;
    const float* wc1_k; const float* wc2_k; const float* wc1_v; const float* wc2_v; const float* mem_norm;
    const float* w_mem_kv; const float* w_branch; const float* w_out; const float* final_norm;
    float* X; char* ws;
    __device__ __forceinline__ unsigned* bar() const { return (unsigned*)(ws + OFF_bar); }
    __device__ __forceinline__ bf16_t* H() const { return (bf16_t*)(ws + OFF_H); }
    __device__ __forceinline__ bf16_t* Y() const { return (bf16_t*)(ws + OFF_Y); }
    __device__ __forceinline__ bf16_t* ZG() const { return (bf16_t*)(ws + OFF_ZG); }
    __device__ __forceinline__ bf16_t* MG() const { return (bf16_t*)(ws + OFF_MG); }
    __device__ __forceinline__ float* CKVR() const { return (float*)(ws + OFF_CKVR); }
    __device__ __forceinline__ bf16_t* CKV() const { return (bf16_t*)(ws + OFF_CKV); }
    __device__ __forceinline__ float* OCMP() const { return (float*)(ws + OFF_OCMP); }
    __device__ __forceinline__ float* OSLC() const { return (float*)(ws + OFF_OSLC); }
    __device__ __forceinline__ float* OWIN() const { return (float*)(ws + OFF_OWIN); }
    __device__ __forceinline__ float* LOGF() const { return (float*)(ws + OFF_LOGF); }
    __device__ __forceinline__ float* CUM() const { return (float*)(ws + OFF_CUM); }
    __device__ __forceinline__ float* CUMT() const { return (float*)(ws + OFF_CUMT); }
    __device__ __forceinline__ float* WI() const { return (float*)(ws + OFF_WI); }
    __device__ __forceinline__ float* GN() const { return (float*)(ws + OFF_GN); }
    __device__ __forceinline__ bf16_t* KCT() const { return (bf16_t*)(ws + OFF_KCT); }
    __device__ __forceinline__ bf16_t* VCTOK() const { return (bf16_t*)(ws + OFF_VCTOK); }
    __device__ __forceinline__ bf16_t* HIDK() const { return (bf16_t*)(ws + OFF_HIDK); }
    __device__ __forceinline__ bf16_t* HIDV() const { return (bf16_t*)(ws + OFF_HIDV); }
    __device__ __forceinline__ bf16_t* KCB() const { return (bf16_t*)(ws + OFF_KCB); }
    __device__ __forceinline__ bf16_t* VCT() const { return (bf16_t*)(ws + OFF_VCT); }
    __device__ __forceinline__ bf16_t* QI() const { return (bf16_t*)(ws + OFF_QI); }
    __device__ __forceinline__ bf16_t* KI() const { return (bf16_t*)(ws + OFF_KI); }
    __device__ __forceinline__ bf16_t* MEMN() const { return (bf16_t*)(ws + OFF_MEMN); }
    __device__ __forceinline__ float* ROPE() const { return (float*)(ws + OFF_ROPE); }
    __device__ __forceinline__ unsigned* DMASK() const { return (unsigned*)(ws + OFF_DMASK); }
    __device__ __forceinline__ unsigned* SMASK() const { return (unsigned*)(ws + OFF_SMASK); }
    __device__ __forceinline__ bf16_t* QA() const { return (bf16_t*)(ws + OFF_QA); }
    __device__ __forceinline__ bf16_t* KAB() const { return (bf16_t*)(ws + OFF_KAB); }
    __device__ __forceinline__ bf16_t* VAT() const { return (bf16_t*)(ws + OFF_VAT); }
    __device__ __forceinline__ bf16_t* QF() const { return (bf16_t*)(ws + OFF_QF); }
    __device__ __forceinline__ bf16_t* KF() const { return (bf16_t*)(ws + OFF_KF); }
    __device__ __forceinline__ bf16_t* VFT() const { return (bf16_t*)(ws + OFF_VFT); }
    __device__ __forceinline__ bf16_t* QS() const { return (bf16_t*)(ws + OFF_QS); }
    __device__ __forceinline__ bf16_t* KSB() const { return (bf16_t*)(ws + OFF_KSB); }
    __device__ __forceinline__ bf16_t* VST() const { return (bf16_t*)(ws + OFF_VST); }
    __device__ __forceinline__ bf16_t* QN() const { return (bf16_t*)(ws + OFF_QN); }
    __device__ __forceinline__ bf16_t* QM() const { return (bf16_t*)(ws + OFF_QM); }
    __device__ __forceinline__ bf16_t* KSLC() const { return (bf16_t*)(ws + OFF_KSLC); }
    __device__ __forceinline__ bf16_t* VSLCT() const { return (bf16_t*)(ws + OFF_VSLCT); }
    __device__ __forceinline__ bf16_t* KWIN() const { return (bf16_t*)(ws + OFF_KWIN); }
    __device__ __forceinline__ bf16_t* VWINT() const { return (bf16_t*)(ws + OFF_VWINT); }
    __device__ __forceinline__ bf16_t* MKB() const { return (bf16_t*)(ws + OFF_MKB); }
    __device__ __forceinline__ bf16_t* MVT() const { return (bf16_t*)(ws + OFF_MVT); }
    __device__ __forceinline__ bf16_t* WIN() const { return (bf16_t*)(ws + OFF_WIN); }
    __device__ __forceinline__ bf16_t* WBR() const { return (bf16_t*)(ws + OFF_WBR); }
    __device__ __forceinline__ bf16_t* WOUT() const { return (bf16_t*)(ws + OFF_WOUT); }
    __device__ __forceinline__ bf16_t* WMKV() const { return (bf16_t*)(ws + OFF_WMKV); }
    __device__ __forceinline__ bf16_t* WUK() const { return (bf16_t*)(ws + OFF_WUK); }
    __device__ __forceinline__ bf16_t* WUV() const { return (bf16_t*)(ws + OFF_WUV); }
    __device__ __forceinline__ bf16_t* WC1T() const { return (bf16_t*)(ws + OFF_WC1T); }
    __device__ __forceinline__ bf16_t* WC2T() const { return (bf16_t*)(ws + OFF_WC2T); }
    __device__ __forceinline__ float* BIASC() const { return (float*)(ws + OFF_BIASC); }
    __device__ __forceinline__ unsigned* qctr() const { return (unsigned*)(ws + OFF_bar) + 4096; }
};

typedef __bf16 bf16x2_t __attribute__((ext_vector_type(2)));
__device__ __forceinline__ unsigned cvt_pk_bf16(float lo, float hi) { bf16x2_t v; v.x = (__bf16)lo; v.y = (__bf16)hi; return __builtin_bit_cast(unsigned, v); }
__device__ __forceinline__ bf16_t f2bf(float x) { return (bf16_t)(cvt_pk_bf16(x, 0.f) & 0xffffu); }
__device__ __forceinline__ int tidx() { int t = threadIdx.x; asm volatile("" : "+v"(t)); return t; }
__device__ __forceinline__ float sigmoid_(float x) { return 1.f / (1.f + expf(-x)); }
__device__ __forceinline__ float silu_(float x) { return x / (1.f + expf(-x)); }
__device__ __forceinline__ float logsig_(float x) { return fminf(x, 0.f) - log1pf(expf(-fabsf(x))); }
__device__ __forceinline__ float wave_sum(float v) {
#pragma unroll
    for (int o = 32; o > 0; o >>= 1) v += __shfl_xor(v, o, 64);
    return v;
}
__device__ __forceinline__ float wave_max(float v) {
#pragma unroll
    for (int o = 32; o > 0; o >>= 1) v = fmaxf(v, __shfl_xor(v, o, 64));
    return v;
}

__device__ __forceinline__ void ph_rope_table(const Params& p, int bid, int nb) {
    for (int i = bid * 256 + tidx(); i < T * 32; i += nb * 256) {
        const int t = i >> 5, f = i & 31;
        const double inv = pow(10000.0, -(double)f / 32.0);
        const double ang = (double)p.pos[t] * inv;
        p.ROPE()[(size_t)t * 64 + f] = (float)cos(ang);
        p.ROPE()[(size_t)t * 64 + 32 + f] = (float)sin(ang);
    }
}

template <class OUT>
__device__ __forceinline__ void ph_rmsnorm(const float* in, const float* g, OUT* out, int rows, int bid, int nb, float dscale = 1.0f) {
    const int lane = tidx() & 63, wid = tidx() >> 6;
    for (int r = bid * 4 + wid; r < rows; r += nb * 4) {
        const float4* ip = (const float4*)(in + (size_t)r * D);
        float4 v[4]; float ss = 0.f;
#pragma unroll
        for (int i = 0; i < 4; ++i) { v[i] = ip[lane + 64 * i]; ss += v[i].x * v[i].x + v[i].y * v[i].y + v[i].z * v[i].z + v[i].w * v[i].w; }
        ss = wave_sum(ss);
        const float sc = dscale / sqrtf(ss * (1.f / D) + 1e-6f);
#pragma unroll
        for (int i = 0; i < 4; ++i) {
            const float4 gg = ((const float4*)g)[lane + 64 * i];
            float4 o; o.x = v[i].x * sc * gg.x; o.y = v[i].y * sc * gg.y; o.z = v[i].z * sc * gg.z; o.w = v[i].w * sc * gg.w;
            if constexpr (sizeof(OUT) == 4) ((float4*)((float*)out + (size_t)r * D))[lane + 64 * i] = o;
            else { u32x2 w; w.x = cvt_pk_bf16(o.x, o.y); w.y = cvt_pk_bf16(o.z, o.w); ((u32x2*)((bf16_t*)out + (size_t)r * D))[lane + 64 * i] = w; }
        }
    }
}

__device__ __forceinline__ void ph_ckvnorm(const Params& p, int layer, int bid, int nb) {
    const int lane = tidx() & 63, wid = tidx() >> 6;
    const float* g = p.kv_norm + layer * 128;
    for (int r = bid * 4 + wid; r < T; r += nb * 4) {
        const float* ip = p.CKVR() + (size_t)r * 128;
        const float a = ip[lane], b = ip[lane + 64];
        const float ss = wave_sum(a * a + b * b);
        const float sc = 1.0f / sqrtf(ss * (1.f / 128.f) + 1e-6f);
        p.CKV()[(size_t)r * 128 + lane] = f2bf(a * sc * g[lane]);
        p.CKV()[(size_t)r * 128 + lane + 64] = f2bf(b * sc * g[lane + 64]);
    }
}

template <bool MAPIN = false>
__device__ __forceinline__ void convert_wt(const float* __restrict__ src, bf16_t* __restrict__ dst, int K, int N, int nmat, int bid, int nb, float* sm) {
    float (*tl)[65] = (float (*)[65])sm;
    const int tid = tidx(), tk = K / 64, tn = (N + 63) / 64, per = tk * tn;
    for (int it = bid; it < per * nmat; it += nb) {
        const int mat = it / per, r = it % per, k0 = (r % tk) * 64, n0 = (r / tk) * 64;
        const float* s = src + (size_t)mat * K * N; bf16_t* d = dst + (size_t)mat * K * N;
        for (int i = tid; i < 64 * 64; i += 256) { const int kk = i >> 6, nn = i & 63; tl[kk][nn] = (n0 + nn < N) ? s[(size_t)(k0 + kk) * N + n0 + nn] : 0.f; }
        __syncthreads();
        {
            const int nn = tid >> 2, kq = (tid & 3) * 16;
            if (n0 + nn < N) {
                u32x4 w0, w1;
                w0.x = cvt_pk_bf16(tl[kq + 0][nn], tl[kq + 1][nn]); w0.y = cvt_pk_bf16(tl[kq + 2][nn], tl[kq + 3][nn]);
                w0.z = cvt_pk_bf16(tl[kq + 4][nn], tl[kq + 5][nn]); w0.w = cvt_pk_bf16(tl[kq + 6][nn], tl[kq + 7][nn]);
                w1.x = cvt_pk_bf16(tl[kq + 8][nn], tl[kq + 9][nn]); w1.y = cvt_pk_bf16(tl[kq + 10][nn], tl[kq + 11][nn]);
                w1.z = cvt_pk_bf16(tl[kq + 12][nn], tl[kq + 13][nn]); w1.w = cvt_pk_bf16(tl[kq + 14][nn], tl[kq + 15][nn]);
                const int drow = MAPIN ? map_in_col(n0 + nn) : (n0 + nn);
                u32x4* dp = (u32x4*)(d + (size_t)drow * K + k0 + kq);
                dp[0] = w0; dp[1] = w1;
            }
        }
        __syncthreads();
    }
}

constexpr int GROW = 80;
constexpr int GA_BYTES = 128 * GROW;
template <int BN>
__device__ __forceinline__ void tile_mac(f32x16 (&acc)[2][BN / 64], const bf16_t* __restrict__ A, int lda, int m0,
                                         const bf16_t* __restrict__ Bt, int ldb, int n0, int nmax, int K, char* sm) {
    constexpr int NT = BN / 64;
    constexpr int B_BYTES = BN * GROW;
    constexpr int BUF = GA_BYTES + B_BYTES;
    const int tid = tidx(), lane = tid & 63, wid = tid >> 6, wr = wid >> 1, wc = wid & 1;
    const int lr = lane & 31, lh = lane >> 5;
    const int ar0 = tid >> 2, akq = tid & 3;
    const bf16_t* ap0 = A + (size_t)(m0 + ar0) * lda + akq * 8;
    const bf16_t* ap1 = A + (size_t)(m0 + ar0 + 64) * lda + akq * 8;
    const int br0 = tid >> 2;
    const bool bv0 = (n0 + br0) < nmax, bv1 = (NT == 2) && ((n0 + br0 + 64) < nmax);
    const bf16_t* bp0 = Bt + (size_t)(bv0 ? (n0 + br0) : 0) * ldb + akq * 8;
    const bf16_t* bp1 = Bt + (size_t)(bv1 ? (n0 + br0 + 64) : 0) * ldb + akq * 8;
    const int st_a0 = ar0 * GROW + akq * 16, st_a1 = (ar0 + 64) * GROW + akq * 16;
    const int st_b0 = GA_BYTES + br0 * GROW + akq * 16, st_b1 = GA_BYTES + (br0 + 64) * GROW + akq * 16;
    const int rd_a = (wr * 64 + lr) * GROW + lh * 16, rd_b = GA_BYTES + (wc * (BN / 2) + lr) * GROW + lh * 16;
    const u32x4 zero4 = {0u, 0u, 0u, 0u};
    u32x4 ra0, ra1, rb0, rb1 = zero4;
    ra0 = *(const u32x4*)ap0; ra1 = *(const u32x4*)ap1;
    rb0 = bv0 ? *(const u32x4*)bp0 : zero4; if (NT == 2) rb1 = bv1 ? *(const u32x4*)bp1 : zero4;
    __syncthreads();
    *(u32x4*)(sm + st_a0) = ra0; *(u32x4*)(sm + st_a1) = ra1; *(u32x4*)(sm + st_b0) = rb0; if (NT == 2) *(u32x4*)(sm + st_b1) = rb1;
    __syncthreads();
    const int nk = K / 32;
    for (int ks = 0; ks < nk; ++ks) {
        char* cur = sm + (ks & 1) * BUF;
        char* nxt = sm + ((ks + 1) & 1) * BUF;
        const bool more = (ks + 1) < nk;
        if (more) {
            const int ko = (ks + 1) * 32;
            ra0 = *(const u32x4*)(ap0 + ko); ra1 = *(const u32x4*)(ap1 + ko);
            rb0 = bv0 ? *(const u32x4*)(bp0 + ko) : zero4; if (NT == 2) rb1 = bv1 ? *(const u32x4*)(bp1 + ko) : zero4;
        }
#pragma unroll
        for (int s = 0; s < 2; ++s) {
            bf16x8 a[2], b[NT];
#pragma unroll
            for (int mi = 0; mi < 2; ++mi) a[mi] = *(const bf16x8*)(cur + rd_a + mi * 32 * GROW + s * 32);
#pragma unroll
            for (int ni = 0; ni < NT; ++ni) b[ni] = *(const bf16x8*)(cur + rd_b + ni * 32 * GROW + s * 32);
#pragma unroll
            for (int mi = 0; mi < 2; ++mi)
#pragma unroll
                for (int ni = 0; ni < NT; ++ni) acc[mi][ni] = __builtin_amdgcn_mfma_f32_32x32x16_bf16(a[mi], b[ni], acc[mi][ni], 0, 0, 0);
        }
        if (more) { *(u32x4*)(nxt + st_a0) = ra0; *(u32x4*)(nxt + st_a1) = ra1; *(u32x4*)(nxt + st_b0) = rb0; if (NT == 2) *(u32x4*)(nxt + st_b1) = rb1; }
        __syncthreads();
    }
}
template <int NT> __device__ __forceinline__ void acc_zero(f32x16 (&acc)[2][NT]) {
#pragma unroll
    for (int mi = 0; mi < 2; ++mi)
#pragma unroll
        for (int ni = 0; ni < NT; ++ni)
#pragma unroll
            for (int r = 0; r < 16; ++r) acc[mi][ni][r] = 0.f;
}
template <int BN, class Epi>
__device__ __forceinline__ void gemm_bf16(const bf16_t* A, int lda, const bf16_t* Bt, int ldb, int M, int N, int K, const Epi& epi, int bid, int nb, char* sm) {
    constexpr int NT = BN / 64;
    const int tm = M / 128, tn = (N + BN - 1) / BN;
    const int lane = tidx() & 63, wid = __builtin_amdgcn_readfirstlane(tidx() >> 6), wr = wid >> 1, wc = wid & 1, lr = lane & 31, lh = lane >> 5;
    for (int tile = bid; tile < tm * tn; tile += nb) {
        const int m0 = (tile % tm) * 128, n0 = (tile / tm) * BN;
        f32x16 acc[2][NT]; acc_zero<NT>(acc);
        tile_mac<BN>(acc, A, lda, m0, Bt, ldb, n0, N, K, sm);
        const int col0 = n0 + wc * (BN / 2);
        if (col0 < N) epi(acc, m0 + wr * 64, col0, lr, lh);
    }
}
#define EROW(mi, r) (row0 + (mi) * 32 + ((r) & 3) + 8 * ((r) >> 2) + 4 * lh)
__device__ __forceinline__ float bf2f(bf16_t h) { return __uint_as_float((unsigned)h << 16); }
__device__ __forceinline__ void epi_rope64(const f32x16 (&acc)[2][2], int row0, int lr, int lh, const float* __restrict__ rope, bf16_t* __restrict__ dst, int ld, int cbase) {
#pragma unroll
    for (int mi = 0; mi < 2; ++mi)
#pragma unroll
        for (int r = 0; r < 16; ++r) {
            const size_t row = EROW(mi, r);
            const float c = rope[row * 64 + lr], s = rope[row * 64 + 32 + lr], x1 = acc[mi][0][r], x2 = acc[mi][1][r];
            dst[row * ld + cbase + lr] = f2bf(x1 * c - x2 * s); dst[row * ld + cbase + 32 + lr] = f2bf(x2 * c + x1 * s);
        }
}
template <int NTI>
__device__ __forceinline__ void epi_rope32(const f32x16 (&acc)[2][2], int row0, int lr, int lh, const float* __restrict__ rope, bf16_t* __restrict__ dst, int ld, int cbase) {
    const int f = lr & 15;
#pragma unroll
    for (int mi = 0; mi < 2; ++mi)
#pragma unroll
        for (int ni = 0; ni < NTI; ++ni)
#pragma unroll
            for (int r = 0; r < 16; ++r) {
                const size_t row = EROW(mi, r);
                const float x = acc[mi][ni][r], xo = __shfl_xor(x, 16, 64);
                const float c = rope[row * 64 + 2 * f], s = rope[row * 64 + 32 + 2 * f];
                dst[row * ld + cbase + ni * 32 + lr] = f2bf((lr & 16) ? (x * c + xo * s) : (x * c - xo * s));
            }
}
template <int NT, bool SILU>
__device__ __forceinline__ void epi_bf16(const f32x16 (&acc)[2][NT], int row0, int lr, int lh, bf16_t* __restrict__ dst, int ld, int cbase) {
#pragma unroll
    for (int mi = 0; mi < 2; ++mi)
#pragma unroll
        for (int ni = 0; ni < NT; ++ni)
#pragma unroll
            for (int r = 0; r < 16; ++r) { const float v = acc[mi][ni][r]; dst[(size_t)EROW(mi, r) * ld + cbase + ni * 32 + lr] = f2bf(SILU ? silu_(v) : v); }
}
template <int NT>
__device__ __forceinline__ void epi_vt(const f32x16 (&acc)[2][NT], int trow0, int lr, int lh, bf16_t* __restrict__ vt, size_t ldv) {
#pragma unroll
    for (int mi = 0; mi < 2; ++mi)
#pragma unroll
        for (int ni = 0; ni < NT; ++ni)
#pragma unroll
            for (int g = 0; g < 4; ++g) {
                u32x2 o; o.x = cvt_pk_bf16(acc[mi][ni][4 * g], acc[mi][ni][4 * g + 1]); o.y = cvt_pk_bf16(acc[mi][ni][4 * g + 2], acc[mi][ni][4 * g + 3]);
                *(u32x2*)(vt + (size_t)(ni * 32 + lr) * ldv + trow0 + mi * 32 + 8 * g + 4 * lh) = o;
            }
}
template <int NT>
__device__ __forceinline__ void epi_f32(const f32x16 (&acc)[2][NT], int row0, int lr, int lh, float* __restrict__ dst, int ld, int cbase) {
#pragma unroll
    for (int mi = 0; mi < 2; ++mi)
#pragma unroll
        for (int ni = 0; ni < NT; ++ni)
#pragma unroll
            for (int r = 0; r < 16; ++r) dst[(size_t)EROW(mi, r) * ld + cbase + ni * 32 + lr] = acc[mi][ni][r];
}
struct EpiInProj {
    const Params& p; int layer;
    __device__ __forceinline__ void operator()(const f32x16 (&acc)[2][2], int row0, int col0, int lr, int lh) const {
        const int b = row0 / S, t0 = row0 % S;
        const float* rope = p.ROPE();
        int kind, ld = 256, cbase = 0; size_t off = 0; bool silu = false;
        if (col0 < M_QN)         { kind = 0; off = OFF_QA; cbase = col0 - M_QA; }
        else if (col0 < M_KSLC)  { kind = 0; off = OFF_QN; cbase = col0 - M_QN; }
        else if (col0 == M_KSLC) { kind = 0; off = OFF_KSLC; ld = 64; }
        else if (col0 == M_KWIN) { kind = 0; off = OFF_KWIN; ld = 64; }
        else if (col0 == M_KC)   { kind = 0; off = OFF_KCT; ld = 64; }
        else if (col0 == M_VC)   { kind = 1; off = OFF_VCTOK; ld = 64; }
        else if (col0 < M_KF)    { kind = 1; off = OFF_QF; cbase = col0 - M_QF; }
        else if (col0 < M_QS)    { kind = 1; off = OFF_KF; cbase = col0 - M_KF; }
        else if (col0 < M_KSB)   { kind = 1; off = OFF_QS; cbase = col0 - M_QS; }
        else if (col0 < M_QM)    { kind = 1; off = OFF_KSB; cbase = col0 - M_KSB; }
        else if (col0 < M_VF)    { kind = 1; off = OFF_QM; cbase = col0 - M_QM; }
        else if (col0 < M_VS)    { kind = 2; off = OFF_VFT + ((size_t)(b * 4 + (col0 - M_VF) / 64) * 64) * S * 2; }
        else if (col0 < M_VSLC)  { kind = 2; off = OFF_VST + ((size_t)(b * 4 + (col0 - M_VS) / 64) * 64) * S * 2; }
        else if (col0 == M_VSLC) { kind = 2; off = OFF_VSLCT + ((size_t)b * 64) * S * 2; }
        else if (col0 == M_VWIN) { kind = 2; off = OFF_VWINT + ((size_t)b * 64) * S * 2; }
        else if (col0 < M_SPC)   { kind = 3; off = OFF_QI; ld = 128; cbase = col0 - M_QI; }
        else if (col0 == M_SPC)  { kind = 4; }
        else if (col0 < M_Z)     { kind = 5; off = OFF_CKVR; ld = 128; cbase = col0 - M_CKV; }
        else                     { kind = 1; off = OFF_ZG; ld = 1280; cbase = col0 - M_Z; silu = true; }
        bf16_t* dst = (bf16_t*)(p.ws + off);
        if (kind == 0) epi_rope64(acc, row0, lr, lh, rope, dst, ld, cbase);
        else if (kind == 1) {
#pragma unroll
            for (int mi = 0; mi < 2; ++mi)
#pragma unroll
                for (int ni = 0; ni < 2; ++ni)
#pragma unroll
                    for (int r = 0; r < 16; ++r) { const float v = acc[mi][ni][r]; dst[(size_t)EROW(mi, r) * ld + cbase + ni * 32 + lr] = f2bf(silu ? silu_(v) : v); }
        }
        else if (kind == 2) epi_vt<2>(acc, t0, lr, lh, dst, S);
        else if (kind == 3) epi_rope32<2>(acc, row0, lr, lh, rope, dst, ld, cbase);
        else if (kind == 5) epi_f32<2>(acc, row0, lr, lh, (float*)dst, ld, cbase);
        else {
            epi_rope32<1>(acc, row0, lr, lh, rope, p.KI(), 32, 0);
            const float fb = p.fox_bias[layer * 4 + (lr & 3)];
#pragma unroll
            for (int mi = 0; mi < 2; ++mi)
#pragma unroll
                for (int r = 0; r < 16; ++r) {
                    const size_t row = EROW(mi, r); const float v = acc[mi][1][r];
                    if (lr < 4) p.WI()[row * 4 + lr] = v * 0.08838834764831845f;
                    else if (lr < 8) p.LOGF()[row * 4 + lr - 4] = logsig_(v + fb);
                    else if (lr < 20) p.GN()[row * 12 + lr - 8] = sigmoid_(v);
                }
        }
    }
};
struct EpiMemKV {
    const Params& p;
    __device__ __forceinline__ void operator()(const f32x16 (&acc)[2][2], int row0, int col0, int lr, int lh) const {
        if (col0 < 256) epi_bf16<2, false>(acc, row0, lr, lh, p.MKB(), 256, col0);
        else epi_vt<2>(acc, row0 % NMEM, lr, lh, p.MVT() + ((size_t)((row0 / NMEM) * 4 + (col0 - 256) / 64) * 64) * NMEM, NMEM);
    }
};
struct EpiKA { const Params& p;
    __device__ __forceinline__ void operator()(const f32x16 (&acc)[2][2], int row0, int col0, int lr, int lh) const { epi_rope64(acc, row0, lr, lh, p.ROPE(), p.KAB(), 256, col0); } };
struct EpiVA { const Params& p;
    __device__ __forceinline__ void operator()(const f32x16 (&acc)[2][2], int row0, int col0, int lr, int lh) const {
        epi_vt<2>(acc, row0 % S, lr, lh, p.VAT() + ((size_t)((row0 / S) * 4 + col0 / 64) * 64) * S, S); } };
struct EpiResid { const float* Xin; float* Xout;
    __device__ __forceinline__ void operator()(const f32x16 (&acc)[2][2], int row0, int col0, int lr, int lh) const {
#pragma unroll
        for (int mi = 0; mi < 2; ++mi)
#pragma unroll
            for (int ni = 0; ni < 2; ++ni)
#pragma unroll
                for (int r = 0; r < 16; ++r) { const size_t i = (size_t)EROW(mi, r) * D + col0 + ni * 32 + lr; Xout[i] = Xin[i] + acc[mi][ni][r]; }
    } };
struct EpiCmp1 { const float* bias; bf16_t* hid;
    __device__ __forceinline__ void operator()(const f32x16 (&acc)[2][1], int row0, int col0, int lr, int lh) const {
        const float bv = bias[col0 + lr];
#pragma unroll
        for (int mi = 0; mi < 2; ++mi)
#pragma unroll
            for (int r = 0; r < 16; ++r) hid[(size_t)EROW(mi, r) * 128 + col0 + lr] = f2bf(silu_(acc[mi][0][r] + bv));
    } };
struct EpiCmp2K { bf16_t* kcb;
    __device__ __forceinline__ void operator()(const f32x16 (&acc)[2][1], int row0, int col0, int lr, int lh) const {
#pragma unroll
        for (int mi = 0; mi < 2; ++mi)
#pragma unroll
            for (int r = 0; r < 16; ++r) { const int row = EROW(mi, r); kcb[(size_t)row * 64 + col0 + lr] = ((row & 511) == 511) ? (bf16_t)0 : f2bf(acc[mi][0][r]); }
    } };
struct EpiCmp2V { bf16_t* vct;
    __device__ __forceinline__ void operator()(const f32x16 (&acc)[2][1], int row0, int col0, int lr, int lh) const {
        bf16_t* base = vct + ((size_t)(row0 / 512) * 64 + col0) * 512;
        const int n0 = row0 % 512;
#pragma unroll
        for (int mi = 0; mi < 2; ++mi)
#pragma unroll
            for (int g = 0; g < 4; ++g) {
                const int n = n0 + mi * 32 + 8 * g + 4 * lh;
                u32x2 o; o.x = cvt_pk_bf16(acc[mi][0][4 * g], acc[mi][0][4 * g + 1]); o.y = cvt_pk_bf16(acc[mi][0][4 * g + 2], (n + 3 == 511) ? 0.f : acc[mi][0][4 * g + 3]);
                *(u32x2*)(base + (size_t)lr * 512 + n) = o;
            }
    } };

__device__ __forceinline__ void ph_merge(const Params& p, int layer, int bid, int nb, char* sm) {
    const int lane = tidx() & 63, wid = tidx() >> 6, wr = wid >> 1, wc = wid & 1, lr = lane & 31, lh = lane >> 5;
    const bf16_t* win = p.WIN();
    for (int tile = bid; tile < (T / 128) * (D / 64); tile += nb) {
        const int m0 = (tile % (T / 128)) * 128, n0 = (tile / (T / 128)) * 64;
        f32x16 mg[2][1]; acc_zero<1>(mg);
        for (int n = 0; n < 5; ++n) {
            f32x16 g[2][1], yb[2][1]; acc_zero<1>(g); acc_zero<1>(yb);
            tile_mac<64>(g, p.H(), D, m0, win + (size_t)(M_MERGE + n * D) * D, D, n0, D, D, sm);
            tile_mac<64>(yb, p.Y() + n * 256, 1280, m0, p.WBR() + ((size_t)layer * 5 + n) * D * 256, 256, n0, D, 256, sm);
#pragma unroll
            for (int mi = 0; mi < 2; ++mi)
#pragma unroll
                for (int r = 0; r < 16; ++r) mg[mi][0][r] = fmaf(sigmoid_(g[mi][0][r]), yb[mi][0][r], mg[mi][0][r]);
        }
#pragma unroll
        for (int mi = 0; mi < 2; ++mi)
#pragma unroll
            for (int r = 0; r < 16; ++r) {
                const int row = m0 + wr * 64 + mi * 32 + (r & 3) + 8 * (r >> 2) + 4 * lh, col = n0 + wc * 32 + lr;
                p.MG()[(size_t)row * D + col] = f2bf(mg[mi][0][r]);
            }
    }
}

__device__ __forceinline__ void ph_cumsum(const Params& p, int bid, int nb, float* sm) {
    const int tid = tidx();
    for (int item = bid; item < NBATCH * 4; item += nb) {
        const int b = item >> 2, h = item & 3;
        const float* src = p.LOGF() + (size_t)b * S * 4 + h;
        float* dst = p.CUM() + (size_t)b * S * 4 + h;
        float loc = 0.f;
        for (int i = 0; i < 32; ++i) loc += src[(size_t)(tid * 32 + i) * 4];
        sm[tid] = loc; __syncthreads();
        if (tid == 0) { float run = 0.f; for (int i = 0; i < 256; ++i) { const float v = sm[i]; sm[i] = run; run += v; } }
        __syncthreads();
        float run = sm[tid];
        float* dt = p.CUMT() + (size_t)item * S;
        for (int i = 0; i < 32; ++i) { run += src[(size_t)(tid * 32 + i) * 4]; dst[(size_t)(tid * 32 + i) * 4] = run; dt[tid * 32 + i] = run * 1.4426950408889634f; }
        __syncthreads();
    }
}

enum { AM_FOX = 0, AM_DSA = 1, AM_SLC = 2, AM_SB = 3, AM_WIN = 4, AM_MEM = 5, AM_CMP = 6 };
constexpr int AK_ROW = 144;
constexpr int AK_TILE = 64 * AK_ROW;
constexpr int ABUF = 2 * AK_TILE + 256;
constexpr float LOG2E = 1.4426950408889634f;
#define NEG_INF (-__builtin_inff())

template <int MODE>
__device__ __forceinline__ void attn_unit(const Params& p, int b, int head, int qblk, char* sm) {
    const int tid = tidx(), lane = tid & 63, wid = __builtin_amdgcn_readfirstlane(tid >> 6), lr = lane & 31, lh = lane >> 5;
    const int q0 = qblk * 128, qw0 = q0 + 32 * wid, tq = qw0 + lr;
    const size_t gq = (size_t)b * S + tq;
    const bf16_t *Qp, *Kp, *VTp; int ldk, ldv;
    if (MODE == AM_FOX)      { Qp = p.QF() + gq * 256 + head * 64; Kp = p.KF() + (size_t)b * S * 256 + head * 64; ldk = 256; VTp = p.VFT() + ((size_t)(b * 4 + head) * 64) * S; ldv = S; }
    else if (MODE == AM_DSA) { Qp = p.QA() + gq * 256 + head * 64; Kp = p.KAB() + (size_t)b * S * 256 + head * 64; ldk = 256; VTp = p.VAT() + ((size_t)(b * 4 + head) * 64) * S; ldv = S; }
    else if (MODE == AM_SB)  { Qp = p.QS() + gq * 256 + head * 64; Kp = p.KSB() + (size_t)b * S * 256 + head * 64; ldk = 256; VTp = p.VST() + ((size_t)(b * 4 + head) * 64) * S; ldv = S; }
    else if (MODE == AM_SLC) { Qp = p.QN() + gq * 256 + head * 64; Kp = p.KSLC() + (size_t)b * S * 64; ldk = 64; VTp = p.VSLCT() + ((size_t)b * 64) * S; ldv = S; }
    else if (MODE == AM_WIN) { Qp = p.QN() + gq * 256 + head * 64; Kp = p.KWIN() + (size_t)b * S * 64; ldk = 64; VTp = p.VWINT() + ((size_t)b * 64) * S; ldv = S; }
    else if (MODE == AM_CMP) { Qp = p.QN() + gq * 256 + head * 64; Kp = p.KCB() + (size_t)b * NCMP_PAD * 64; ldk = 64; VTp = p.VCT() + ((size_t)b * 64) * NCMP_PAD; ldv = NCMP_PAD; }
    else                     { Qp = p.QM() + gq * 256 + head * 64; Kp = p.MKB() + (size_t)b * NMEM * 256 + head * 64; ldk = 256; VTp = p.MVT() + ((size_t)(b * 4 + head) * 64) * NMEM; ldv = NMEM; }
    int kt_lo = 0, kt_hi = 2 * qblk + 2;
    if (MODE == AM_WIN) kt_lo = q0 >= 512 ? (q0 - 512) / 64 : 0;
    if (MODE == AM_MEM) kt_hi = NMEM / 64;
    if (MODE == AM_CMP) kt_hi = min(8, (((q0 + 96) >> 4) >> 6) + 1);
    const int nlim = (tq - 31) >> 4;
    const int ntile = kt_hi - kt_lo;
    constexpr bool REV = (MODE == AM_SB);

    bf16x8 qf[4];
#pragma unroll
    for (int s = 0; s < 4; ++s) qf[s] = *(const bf16x8*)(Qp + 16 * s + 8 * lh);
    unsigned smw[4] = {0u, 0u, 0u, 0u};
    if (MODE == AM_SLC) { const u32x4 w = *(const u32x4*)(p.SMASK() + gq * 4); smw[0] = w.x; smw[1] = w.y; smw[2] = w.z; smw[3] = w.w; }
    const unsigned long long* mrow = (const unsigned long long*)(p.DMASK() + gq * 256);
    const float* csp = p.CUMT() + (size_t)(b * 4 + head) * S;

    const int srow = tid >> 3, sc16 = tid & 7;
    const int st0 = srow * AK_ROW + sc16 * 16, st1 = (srow + 32) * AK_ROW + sc16 * 16;
    const bf16_t* kg0 = Kp + (size_t)srow * ldk + sc16 * 8;
    const bf16_t* kg1 = Kp + (size_t)(srow + 32) * ldk + sc16 * 8;
    const bf16_t* vg0 = VTp + (size_t)srow * ldv + sc16 * 8;
    const bf16_t* vg1 = VTp + (size_t)(srow + 32) * ldv + sc16 * 8;
    u32x4 rk0, rk1, rv0, rv1; float rcs = 0.f;
    auto gload = [&](int kt) {
        rk0 = *(const u32x4*)(kg0 + (size_t)kt * 64 * ldk); rk1 = *(const u32x4*)(kg1 + (size_t)kt * 64 * ldk);
        rv0 = *(const u32x4*)(vg0 + kt * 64); rv1 = *(const u32x4*)(vg1 + kt * 64);
        if (MODE == AM_FOX) { if (tid < 64) rcs = csp[kt * 64 + tid]; }
    };
    auto lstore = [&](char* buf) {
        *(u32x4*)(buf + st0) = rk0; *(u32x4*)(buf + st1) = rk1;
        *(u32x4*)(buf + AK_TILE + st0) = rv0; *(u32x4*)(buf + AK_TILE + st1) = rv1;
        if (MODE == AM_FOX) { if (tid < 64) *(float*)(buf + 2 * AK_TILE + tid * 4) = rcs; }
    };
    const int pil = (lr & 0x13) | ((lr & 4) << 1) | ((lr & 8) >> 1);
    const int rdk = pil * AK_ROW + lh * 16;
    const int rdv = AK_TILE + lr * AK_ROW + lh * 16;

    float m = NEG_INF, l = 0.f, R = 0.f;
    f32x16 O[2];
#pragma unroll
    for (int i = 0; i < 16; ++i) { O[0][i] = 0.f; O[1][i] = 0.f; }

    gload(REV ? kt_hi - 1 : kt_lo);
    __syncthreads();
    lstore(sm);
    __syncthreads();
#pragma unroll 1
    for (int it = 0; it < ntile; ++it) {
        const int kt = REV ? kt_hi - 1 - it : kt_lo + it;
        char* cur = sm + (it & 1) * ABUF;
        const bool more = (it + 1) < ntile;
        if (more) gload(REV ? kt - 1 : kt + 1);
        unsigned long long mw = 0ull;
        if (MODE == AM_DSA) mw = mrow[kt];
        bool need = true;
        if (MODE == AM_CMP) need = kt * 64 <= (qw0 >> 4);
        else if (MODE != AM_MEM) need = kt * 64 <= qw0 + 31;
        if (MODE == AM_WIN) need = need && (kt * 64 + 63 >= qw0 - 511);
        if (need) {
#pragma unroll
            for (int sb2 = 0; sb2 < 2; ++sb2) {
                const int sub = REV ? 1 - sb2 : sb2;
                const int kb = kt * 64 + sub * 32;
                bool sneed = true;
                if (MODE == AM_CMP) sneed = kb <= (qw0 >> 4);
                else if (MODE != AM_MEM) sneed = kb <= qw0 + 31;
                if (MODE == AM_WIN) sneed = sneed && (kb + 31 >= qw0 - 511);
                if (sneed) {
                    f32x16 s;
#pragma unroll
                    for (int i = 0; i < 16; ++i) s[i] = 0.f;
#pragma unroll
                    for (int s4 = 0; s4 < 4; ++s4) {
                        const bf16x8 kf = *(const bf16x8*)(cur + rdk + sub * 32 * AK_ROW + s4 * 32);
                        s = __builtin_amdgcn_mfma_f32_32x32x16_bf16(kf, qf[s4], s, 0, 0, 0);
                    }
                    const int thl = tq - kb - 8 * lh;
                    bf16x8 pf[2];
                    if (MODE == AM_SB) {
                        float lk[16];
#pragma unroll
                        for (int r = 0; r < 16; ++r) {
                            const int cr = 16 * (r >> 3) + (r & 7);
                            const float z = s[r] * 0.125f;
                            const float az = fabsf(z);
                            const float sp = fmaxf(z, 0.f) + __builtin_amdgcn_logf(1.f + __builtin_amdgcn_exp2f(-az * LOG2E)) * 0.6931471805599453f;
                            const bool ok = cr < thl;
                            lk[r] = ok ? -sp : 0.f;
                            s[r] = ok ? z : NEG_INF;
                        }
                        float g0 = 0.f, g1 = 0.f;
#pragma unroll
                        for (int r = 0; r < 8; ++r) { g0 += lk[r]; g1 += lk[8 + r]; }
                        const float pg0 = __shfl_xor(g0, 32, 64), pg1 = __shfl_xor(g1, 32, 64);
                        const float off0 = R + (lh == 0 ? (pg0 + g1 + pg1) : (pg1 + g1));
                        const float off1 = R + (lh == 0 ? pg1 : 0.f);
                        float run0 = off0, run1 = off1;
#pragma unroll
                        for (int r = 7; r >= 0; --r) {
                            const float a0 = __builtin_amdgcn_exp2f((s[r] + lk[r] + run0) * LOG2E); run0 += lk[r];
                            const float a1 = __builtin_amdgcn_exp2f((s[8 + r] + lk[8 + r] + run1) * LOG2E); run1 += lk[8 + r];
                            s[r] = a0; s[8 + r] = a1;
                        }
                        R += (g0 + g1) + (pg0 + pg1);
                    } else {
                        constexpr float c = 0.125f * LOG2E;
                        if (MODE == AM_FOX) {
                            const float4* cs4 = (const float4*)(cur + 2 * AK_TILE + (sub * 32 + 8 * lh) * 4);
                            const float4 c0 = cs4[0], c1 = cs4[1], c2 = cs4[4], c3 = cs4[5];
                            const float cv[16] = {c0.x, c0.y, c0.z, c0.w, c1.x, c1.y, c1.z, c1.w, c2.x, c2.y, c2.z, c2.w, c3.x, c3.y, c3.z, c3.w};
#pragma unroll
                            for (int r = 0; r < 16; ++r) s[r] = fmaf(s[r], c, -cv[r]);
                        } else {
#pragma unroll
                            for (int r = 0; r < 16; ++r) s[r] *= c;
                        }
                        if (MODE == AM_DSA) {
                            const unsigned w = (unsigned)(mw >> (32 * sub)) >> (8 * lh);
#pragma unroll
                            for (int r = 0; r < 16; ++r) { const int cr = 16 * (r >> 3) + (r & 7); s[r] = (w & (1u << cr)) ? s[r] : NEG_INF; }
                        }
                        if (MODE == AM_SLC) {
                            const unsigned w = smw[0] * (kt < 32) + smw[1] * (kt >= 32 && kt < 64) + smw[2] * (kt >= 64 && kt < 96) + smw[3] * (kt >= 96);
                            const bool sel = (w >> (kt & 31)) & 1u;
#pragma unroll
                            for (int r = 0; r < 16; ++r) s[r] = sel ? s[r] : NEG_INF;
                        }
                        if (MODE == AM_FOX || MODE == AM_SLC) {
                            if (kb + 31 > qw0) {
#pragma unroll
                                for (int r = 0; r < 16; ++r) { const int cr = 16 * (r >> 3) + (r & 7); s[r] = (cr <= thl) ? s[r] : NEG_INF; }
                            }
                        }
                        if (MODE == AM_CMP) {
                            const int tc = nlim - kb - 8 * lh;
#pragma unroll
                            for (int r = 0; r < 16; ++r) { const int cr = 16 * (r >> 3) + (r & 7); s[r] = (cr <= tc) ? s[r] : NEG_INF; }
                        }
                        if (MODE == AM_WIN) {
                            if (kb + 31 > qw0 || kb < qw0 + 31 - 511) {
#pragma unroll
                                for (int r = 0; r < 16; ++r) { const int cr = 16 * (r >> 3) + (r & 7); s[r] = (cr <= thl && cr > thl - 512) ? s[r] : NEG_INF; }
                            }
                        }
                        float tmax = s[0];
#pragma unroll
                        for (int r = 1; r < 16; ++r) tmax = fmaxf(tmax, s[r]);
                        tmax = fmaxf(tmax, __shfl_xor(tmax, 32, 64));
                        const float mn = fmaxf(m, tmax);
                        const float mu = (mn == NEG_INF) ? 0.f : mn;
                        const float corr = __builtin_amdgcn_exp2f(m - mu);
                        m = mn;
                        float ls = 0.f;
#pragma unroll
                        for (int r = 0; r < 16; ++r) { s[r] = __builtin_amdgcn_exp2f(s[r] - mu); ls += s[r]; }
                        l = l * corr + ls;
                        if (!__all(corr == 1.0f)) {
#pragma unroll
                            for (int i = 0; i < 16; ++i) { O[0][i] *= corr; O[1][i] *= corr; }
                        }
                    }
                    {
                        u32x4 w0, w1;
                        w0.x = cvt_pk_bf16(s[0], s[1]); w0.y = cvt_pk_bf16(s[2], s[3]); w0.z = cvt_pk_bf16(s[4], s[5]); w0.w = cvt_pk_bf16(s[6], s[7]);
                        w1.x = cvt_pk_bf16(s[8], s[9]); w1.y = cvt_pk_bf16(s[10], s[11]); w1.z = cvt_pk_bf16(s[12], s[13]); w1.w = cvt_pk_bf16(s[14], s[15]);
                        pf[0] = __builtin_bit_cast(bf16x8, w0); pf[1] = __builtin_bit_cast(bf16x8, w1);
                    }
#pragma unroll
                    for (int s2 = 0; s2 < 2; ++s2)
#pragma unroll
                        for (int dt = 0; dt < 2; ++dt) {
                            const bf16x8 vf = *(const bf16x8*)(cur + rdv + dt * 32 * AK_ROW + sub * 64 + s2 * 32);
                            O[dt] = __builtin_amdgcn_mfma_f32_32x32x16_bf16(vf, pf[s2], O[dt], 0, 0, 0);
                        }
                }
            }
        }
        if (more) lstore(sm + ((it + 1) & 1) * ABUF);
        __syncthreads();
    }
    float inv = 1.f;
    if (MODE != AM_SB) { const float lt = l + __shfl_xor(l, 32, 64); inv = 1.f / fmaxf(lt, 1e-30f); }
    if (MODE == AM_SLC || MODE == AM_WIN || MODE == AM_CMP) {
        const float gs = (MODE == AM_CMP) ? inv : p.GN()[gq * 12 + (MODE == AM_SLC ? 4 : 8) + head] * inv;
        float* dst = (MODE == AM_SLC ? p.OSLC() : MODE == AM_WIN ? p.OWIN() : p.OCMP()) + gq * 256 + head * 64;
#pragma unroll
        for (int dt = 0; dt < 2; ++dt)
#pragma unroll
            for (int g = 0; g < 4; ++g) {
                float4 o; o.x = O[dt][4 * g] * gs; o.y = O[dt][4 * g + 1] * gs; o.z = O[dt][4 * g + 2] * gs; o.w = O[dt][4 * g + 3] * gs;
                *(float4*)(dst + 32 * dt + 8 * g + 4 * lh) = o;
            }
    } else {
        const int yc = MODE == AM_FOX ? 256 : MODE == AM_DSA ? 0 : MODE == AM_SB ? 512 : 1024;
        const bf16_t* zp = p.ZG() + gq * 1280 + yc + head * 64;
        bf16_t* dst = p.Y() + gq * 1280 + yc + head * 64;
#pragma unroll
        for (int dt = 0; dt < 2; ++dt)
#pragma unroll
            for (int g = 0; g < 4; ++g) {
                const int d0 = 32 * dt + 8 * g + 4 * lh;
                const u32x2 z = *(const u32x2*)(zp + d0);
                u32x2 o;
                o.x = cvt_pk_bf16(O[dt][4 * g] * inv * __uint_as_float(z.x << 16), O[dt][4 * g + 1] * inv * __uint_as_float(z.x & 0xffff0000u));
                o.y = cvt_pk_bf16(O[dt][4 * g + 2] * inv * __uint_as_float(z.y << 16), O[dt][4 * g + 3] * inv * __uint_as_float(z.y & 0xffff0000u));
                *(u32x2*)(dst + d0) = o;
            }
    }
}

__device__ __forceinline__ unsigned sortable_key(float x) { const unsigned u = __float_as_uint(x + 0.0f); return (u & 0x80000000u) ? ~u : (u | 0x80000000u); }
#ifndef DIAG
#define DIAG 0
#endif
#if DIAG
#define UNIT_ATTR
#else
#define UNIT_ATTR
#endif
UNIT_ATTR __device__ __forceinline__ void dsa_select_unit(const Params& p, int b, int qt, char* sm) {
    const int tid = tidx(), lane = tid & 63, wid = __builtin_amdgcn_readfirstlane(tid >> 6), lr = lane & 31, lh = lane >> 5;
    unsigned* hist = (unsigned*)sm;
    unsigned char* tcnt = (unsigned char*)sm;
    unsigned short* tbase = (unsigned short*)(sm + 8192);
    unsigned* st_prefix = (unsigned*)(sm + 32 * 257 * 4);
    int* st_krem = (int*)(st_prefix + 32);
    int* st_ties = st_krem + 32;
    int* st_flag = st_ties + 32;
    const int q0 = qt * 32, tq = q0 + lr, ntile = qt + 1;
    const size_t gq = (size_t)b * S + tq;
    const bool small = tq + 1 <= 256;
    bf16x8 qf[4][2];
    float w[4];
#pragma unroll
    for (int h = 0; h < 4; ++h) {
        qf[h][0] = *(const bf16x8*)(p.QI() + gq * 128 + h * 32 + 8 * lh);
        qf[h][1] = *(const bf16x8*)(p.QI() + gq * 128 + h * 32 + 16 + 8 * lh);
        w[h] = p.WI()[gq * 4 + h];
    }
    const bf16_t* kbase = p.KI() + (size_t)b * S * 32 + (size_t)lr * 32 + 8 * lh;
    auto score_tile = [&](int kt, unsigned (&key)[16]) {
        const bf16x8 k0 = *(const bf16x8*)(kbase + (size_t)kt * 32 * 32), k1 = *(const bf16x8*)(kbase + (size_t)kt * 32 * 32 + 16);
        float sc[16];
#pragma unroll
        for (int r = 0; r < 16; ++r) sc[r] = 0.f;
#pragma unroll
        for (int h = 0; h < 4; ++h) {
            f32x16 a;
#pragma unroll
            for (int r = 0; r < 16; ++r) a[r] = 0.f;
            a = __builtin_amdgcn_mfma_f32_32x32x16_bf16(k0, qf[h][0], a, 0, 0, 0);
            a = __builtin_amdgcn_mfma_f32_32x32x16_bf16(k1, qf[h][1], a, 0, 0, 0);
#pragma unroll
            for (int r = 0; r < 16; ++r) sc[r] = fmaf(fmaxf(a[r], 0.f), w[h], sc[r]);
            __builtin_amdgcn_sched_barrier(0);
        }
#pragma unroll
        for (int r = 0; r < 16; ++r) key[r] = sortable_key(sc[r]);
    };
    unsigned prefix = 0u;
#pragma unroll 1
    for (int pass = 0; pass < 4; ++pass) {
        const int shift = 24 - 8 * pass;
        __syncthreads();
        for (int i = tid; i < 32 * 257; i += 256) hist[i] = 0u;
        __syncthreads();
#pragma unroll 1
        for (int kt = wid; kt < ntile; kt += 4) {
            unsigned key[16];
            score_tile(kt, key);
            const int vlim = (kt == qt) ? lr : 64;
#pragma unroll
            for (int r = 0; r < 16; ++r) {
                const int rho = (r & 3) + 8 * (r >> 2) + 4 * lh;
                const bool match = (pass == 0) || ((key[r] >> (shift + 8)) == prefix);
                if (rho <= vlim && match) atomicAdd(&hist[lr * 257 + ((key[r] >> shift) & 255u)], 1u);
            }
        }
        __syncthreads();
        if (tid < 32) {
            const int tqq = q0 + tid;
            if (tqq + 1 <= 256) { if (pass == 0) { st_prefix[tid] = 0u; st_krem[tid] = 1 << 30; st_ties[tid] = 0; } }
            else {
                int krem = (pass == 0) ? 256 : st_krem[tid];
                unsigned cum = 0u; int bin = 255;
                for (; bin > 0; --bin) { const unsigned c = hist[tid * 257 + bin]; if (cum + c >= (unsigned)krem) break; cum += c; }
                st_prefix[tid] = ((pass == 0 ? 0u : st_prefix[tid]) << 8) | (unsigned)bin;
                st_krem[tid] = krem - (int)cum;
                st_ties[tid] = (int)hist[tid * 257 + bin];
            }
        }
        __syncthreads();
        prefix = st_prefix[lr];
    }
    const unsigned thr = prefix;
    const int need = st_krem[lr];
    if (tid == 0) st_flag[0] = 0;
    __syncthreads();
    if (!small && st_ties[lr] > need) st_flag[0] = 1;
    __syncthreads();
    const bool tiepass = st_flag[0] != 0;
    if (tiepass) {
#pragma unroll 1
        for (int kt = wid; kt < ntile; kt += 4) {
            unsigned key[16];
            score_tile(kt, key);
            const int vlim = (kt == qt) ? lr : 64;
            int c = 0;
#pragma unroll
            for (int r = 0; r < 16; ++r) { const int rho = (r & 3) + 8 * (r >> 2) + 4 * lh; c += (rho <= vlim && key[r] == thr) ? 1 : 0; }
            c += __shfl_xor(c, 32, 64);
            if (lh == 0) tcnt[lr * 256 + kt] = (unsigned char)c;
        }
        __syncthreads();
        if (tid < 32) { int run = 0; for (int kt = 0; kt < ntile; ++kt) { tbase[tid * 256 + kt] = (unsigned short)run; run += tcnt[tid * 256 + kt]; } }
        __syncthreads();
    }
    unsigned* mrow = p.DMASK() + gq * 256;
#pragma unroll 1
    for (int kt = wid; kt < 256; kt += 4) {
        unsigned word = 0u;
        if (kt < ntile) {
            unsigned key[16];
            score_tile(kt, key);
            const int vlim = (kt == qt) ? lr : 64;
            unsigned gt = 0u, tie = 0u;
#pragma unroll
            for (int r = 0; r < 16; ++r) {
                const int rho = (r & 3) + 8 * (r >> 2) + 4 * lh;
                if (rho <= vlim) { gt |= (key[r] > thr) ? (1u << rho) : 0u; tie |= (key[r] == thr) ? (1u << rho) : 0u; }
            }
            gt |= __shfl_xor(gt, 32, 64); tie |= __shfl_xor(tie, 32, 64);
            if (tiepass && !small) {
                int allow = need - (int)tbase[lr * 256 + kt];
                if (allow <= 0) tie = 0u;
                else if (allow < __builtin_popcount(tie)) { unsigned wv = tie, kept = 0u; for (int i = 0; i < allow; ++i) { const unsigned low = wv & (0u - wv); kept |= low; wv ^= low; } tie = kept; }
            }
            word = gt | tie;
        }
        if (lh == 0) mrow[kt] = word;
    }
    __syncthreads();
}

__device__ __forceinline__ bool imp_better(float v1, int i1, float v2, int i2) { return (v1 > v2) || (v1 == v2 && i1 < i2); }
UNIT_ATTR __device__ __forceinline__ void nsa_select_unit(const Params& p, int b, int q0w, char* sm) {
    const int lane = tidx() & 63, lr = lane & 31, lh = lane >> 5;
    const int tq = q0w + lr;
    const size_t gq = (size_t)b * S + tq;
    const int nlim = (tq - 31) >> 4;
    const int nst = min(16, ((((q0w + 31 - 31) >> 4)) >> 5) + 1);
    const int pil = (lr & 0x13) | ((lr & 4) << 1) | ((lr & 8) >> 1);
    const bf16_t* kc = p.KCB() + (size_t)b * NCMP_PAD * 64 + (size_t)pil * 64 + 8 * lh;
    constexpr float c = 0.125f * LOG2E;
    float mh[4], il[4];
#pragma unroll
    for (int h = 0; h < 4; ++h) {
        bf16x8 qf[4];
#pragma unroll
        for (int s = 0; s < 4; ++s) qf[s] = *(const bf16x8*)(p.QN() + gq * 256 + h * 64 + 16 * s + 8 * lh);
        float m = NEG_INF, l = 0.f;
#pragma unroll 1
        for (int st = 0; st < nst; ++st) {
            f32x16 s;
#pragma unroll
            for (int i = 0; i < 16; ++i) s[i] = 0.f;
#pragma unroll
            for (int s4 = 0; s4 < 4; ++s4) { const bf16x8 kf = *(const bf16x8*)(kc + (size_t)st * 32 * 64 + s4 * 16); s = __builtin_amdgcn_mfma_f32_32x32x16_bf16(kf, qf[s4], s, 0, 0, 0); }
            const int thl = nlim - st * 32 - 8 * lh;
            float tmax = NEG_INF;
#pragma unroll
            for (int r = 0; r < 16; ++r) { const int cr = 16 * (r >> 3) + (r & 7); s[r] = (cr <= thl) ? s[r] * c : NEG_INF; tmax = fmaxf(tmax, s[r]); }
            tmax = fmaxf(tmax, __shfl_xor(tmax, 32, 64));
            const float mn = fmaxf(m, tmax), mu = (mn == NEG_INF) ? 0.f : mn;
            float ls = 0.f;
#pragma unroll
            for (int r = 0; r < 16; ++r) ls += __builtin_amdgcn_exp2f(s[r] - mu);
            l = l * __builtin_amdgcn_exp2f(m - mu) + ls; m = mn;
        }
        l += __shfl_xor(l, 32, 64);
        mh[h] = (m == NEG_INF) ? 0.f : m; il[h] = 1.f / fmaxf(l, 1e-30f);
    }
    float val[16]; int idx[16];
#pragma unroll
    for (int i = 0; i < 16; ++i) { val[i] = NEG_INF; idx[i] = 1 << 20; }
    const int cur = tq >> 6;
#pragma unroll 1
    for (int st = 0; st < 16; ++st) {
        float bs[4] = {0.f, 0.f, 0.f, 0.f};
        if (st < nst) {
            const int thl = nlim - st * 32 - 8 * lh;
#pragma unroll
            for (int h = 0; h < 4; ++h) {
                f32x16 s;
#pragma unroll
                for (int i = 0; i < 16; ++i) s[i] = 0.f;
#pragma unroll
                for (int s4 = 0; s4 < 4; ++s4) {
                    const bf16x8 kf = *(const bf16x8*)(kc + (size_t)st * 32 * 64 + s4 * 16);
                    const bf16x8 qfr = *(const bf16x8*)(p.QN() + gq * 256 + h * 64 + 16 * s4 + 8 * lh);
                    s = __builtin_amdgcn_mfma_f32_32x32x16_bf16(kf, qfr, s, 0, 0, 0);
                }
#pragma unroll
                for (int r = 0; r < 16; ++r) {
                    const int cr = 16 * (r >> 3) + (r & 7);
                    const float pr = (cr <= thl) ? __builtin_amdgcn_exp2f(s[r] * c - mh[h]) * il[h] : 0.f;
                    bs[r >> 2] += pr;
                }
                __builtin_amdgcn_sched_barrier(0);
            }
        }
#pragma unroll
        for (int g = 0; g < 4; ++g) {
            const int j = st * 8 + 4 * (g >> 1) + 2 * lh + (g & 1);
            const bool forced = (j == 0) || (j == cur) || (j == cur - 1);
            float v = forced ? 1e4f : ((j <= cur) ? bs[g] : -1.0f);
            int jj = j;
            if (__any(imp_better(v, jj, val[15], idx[15]))) {
#pragma unroll
                for (int i = 0; i < 16; ++i) {
                    const bool bt = imp_better(v, jj, val[i], idx[i]);
                    const float tv = bt ? val[i] : v; const int ti = bt ? idx[i] : jj;
                    val[i] = bt ? v : val[i]; idx[i] = bt ? jj : idx[i];
                    v = tv; jj = ti;
                }
            }
        }
    }
    {
        float* lv = (float*)(sm + (tidx() >> 6) * 8192);
        int* li = (int*)(lv + 1024);
#pragma unroll
        for (int i = 0; i < 16; ++i) { lv[i * 64 + lane] = val[i]; li[i * 64 + lane] = idx[i]; }
        __builtin_amdgcn_wave_barrier();
#pragma unroll 1
        for (int k = 0; k < 16; ++k) {
            float v = lv[k * 64 + (lane ^ 32)]; int jj = li[k * 64 + (lane ^ 32)];
#pragma unroll
            for (int i = 0; i < 16; ++i) {
                const bool bt = imp_better(v, jj, val[i], idx[i]);
                const float tv = bt ? val[i] : v; const int ti = bt ? idx[i] : jj;
                val[i] = bt ? v : val[i]; idx[i] = bt ? jj : idx[i];
                v = tv; jj = ti;
            }
        }
        __builtin_amdgcn_wave_barrier();
    }
    unsigned m0 = 0u, m1 = 0u, m2 = 0u, m3 = 0u;
#pragma unroll
    for (int i = 0; i < 16; ++i) {
        const unsigned bit = 1u << (idx[i] & 31); const int wsel = idx[i] >> 5;
        m0 |= (wsel == 0) ? bit : 0u; m1 |= (wsel == 1) ? bit : 0u; m2 |= (wsel == 2) ? bit : 0u; m3 |= (wsel == 3) ? bit : 0u;
    }
    if (lh == 0) { u32x4 o; o.x = m0; o.y = m1; o.z = m2; o.w = m3; *(u32x4*)(p.SMASK() + gq * 4) = o; }
}

__device__ __forceinline__ void ph_select(const Params& p, int layer, char* sm) {
    __shared__ int s_unit2;
    unsigned* ctr = p.qctr() + 64 * layer + 32;
    for (;;) {
        __syncthreads();
        if (threadIdx.x == 0) s_unit2 = (int)atomicAdd(ctr, 1u);
        __syncthreads();
        const int u = __builtin_amdgcn_readfirstlane(s_unit2);
        if (u >= 512 + 128) break;
        if (u < 512) { const int qt = 255 - (u >> 1), b = u & 1; dsa_select_unit(p, b, qt, sm); }
        else { const int v = u - 512, b = v & 1, qb = v >> 1; nsa_select_unit(p, b, qb * 128 + 32 * __builtin_amdgcn_readfirstlane(tidx() >> 6), sm); }
    }
}

__device__ __forceinline__ void ph_attention(const Params& p, int layer, int bid, int nb, char* sm) {
    (void)bid; (void)nb;
    __shared__ int s_unit;
    unsigned* ctr = p.qctr() + 64 * layer;
    for (;;) {
        __syncthreads();
        if (threadIdx.x == 0) s_unit = (int)atomicAdd(ctr, 1u);
        __syncthreads();
        const int u = __builtin_amdgcn_readfirstlane(s_unit);
        if (u >= 3584) break;
        if (u < 2048) {
            const int qblk = 63 - (u >> 5), r = u & 31, br = r >> 3, b = (r >> 2) & 1, h = r & 3;
            if (br == 0) attn_unit<AM_SB>(p, b, h, qblk, sm);
            else if (br == 1) attn_unit<AM_FOX>(p, b, h, qblk, sm);
            else if (br == 2) attn_unit<AM_DSA>(p, b, h, qblk, sm);
            else attn_unit<AM_SLC>(p, b, h, qblk, sm);
        } else {
            const int v = u - 2048, br = v >> 9, w = v & 511, qblk = w >> 3, b = (w >> 2) & 1, h = w & 3;
            if (br == 0) attn_unit<AM_WIN>(p, b, h, qblk, sm);
            else if (br == 1) attn_unit<AM_CMP>(p, b, h, 63 - qblk, sm);
            else attn_unit<AM_MEM>(p, b, h, qblk, sm);
        }
    }
}

__device__ __forceinline__ void ph_nsa_combine(const Params& p, int bid, int nb) {
    for (size_t i = (size_t)bid * 256 + tidx(); i < (size_t)T * 64; i += (size_t)nb * 256) {
        const size_t g = i >> 6; const int c = (int)(i & 63) * 4, h = c >> 6;
        const float g0 = p.GN()[g * 12 + h];
        const float4 a = *(const float4*)(p.OCMP() + g * 256 + c), s = *(const float4*)(p.OSLC() + g * 256 + c), w = *(const float4*)(p.OWIN() + g * 256 + c);
        const u32x2 z = *(const u32x2*)(p.ZG() + g * 1280 + 768 + c);
        u32x2 o;
        o.x = cvt_pk_bf16((g0 * a.x + s.x + w.x) * __uint_as_float(z.x << 16), (g0 * a.y + s.y + w.y) * __uint_as_float(z.x & 0xffff0000u));
        o.y = cvt_pk_bf16((g0 * a.z + s.z + w.z) * __uint_as_float(z.y << 16), (g0 * a.w + s.w + w.w) * __uint_as_float(z.y & 0xffff0000u));
        *(u32x2*)(p.Y() + g * 1280 + 768 + c) = o;
    }
}

__device__ __forceinline__ void ph_setup_misc(const Params& p, int bid, int nb) {
    const int lane = tidx() & 63, gw = bid * 4 + (tidx() >> 6);
    for (int o = gw; o < DEPTH * 2 * 128; o += nb * 4) {
        const int l = o >> 8, which = (o >> 7) & 1, j = o & 127;
        const float* pe = (which ? p.pe_v : p.pe_k) + (size_t)l * 2048;
        const float* w1 = (which ? p.wc1_v : p.wc1_k) + (size_t)l * 2048 * 128;
        float a = 0.f;
        for (int k = lane; k < 2048; k += 64) a = fmaf(pe[k], w1[(size_t)k * 128 + j], a);
        a = wave_sum(a);
        if (lane == 0) p.BIASC()[o] = a;
    }
    for (int i = bid * 256 + tidx(); i < 2048; i += nb * 256) { p.KCT()[(size_t)T * 64 + i] = 0; p.VCTOK()[(size_t)T * 64 + i] = 0; }
    for (int i = bid * 256 + tidx(); i < 12 * D; i += nb * 256) p.WIN()[(size_t)(M_SPC + 52) * D + i] = 0;
}

#define XB_TMO      128
#define XB_XCNT(j)  (256  + 64 * (j))
#define XB_XSUB(j)  (1280 + 64 * (j))
#define XB_XGEN(j)  (2304 + 64 * (j))
#define XB_TOP      3328
#define XB_TOPGEN   3392
#define XCD_BAR_WORDS 3456
#define XB_SPIN_CAP (1u << 18)
#define LAS __attribute__((address_space(3)))

__device__ __forceinline__ unsigned xb_ld(unsigned* p)              { return __hip_atomic_load(p, __ATOMIC_RELAXED, __HIP_MEMORY_SCOPE_AGENT); }
__device__ __forceinline__ unsigned xb_add(unsigned* p, unsigned v) { return __hip_atomic_fetch_add(p, v, __ATOMIC_RELAXED, __HIP_MEMORY_SCOPE_AGENT); }
__device__ __forceinline__ unsigned xb_xcc_id() { return (unsigned)__builtin_amdgcn_s_getreg((3 << 11) | 20) & 0xFu; }
#define XB_SPIN(cond, bar) do { unsigned _sp = 0; while (cond) { __builtin_amdgcn_s_sleep(1); \
    if ((++_sp & 255u) == 0u) { if (xb_ld(&(bar)[XB_TMO])) break; if (_sp > XB_SPIN_CAP) { atomicAdd(&(bar)[XB_TMO], 1u); break; } } } } while (0)

struct XcdBarrier {
    unsigned* bar; unsigned x;
    volatile LAS unsigned* st;
};
__device__ __forceinline__ XcdBarrier xcd_barrier_post(unsigned* bar, volatile LAS unsigned* st) {
    XcdBarrier b; b.bar = bar; b.x = xb_xcc_id(); b.st = st;
    if (threadIdx.x == 0) (void)xb_add(&bar[XB_XCNT(b.x)], 1u);
    return b;
}
__device__ __forceinline__ void xcd_barrier_complete(unsigned* bar, unsigned x, unsigned& nloc, unsigned& nx) {
    const unsigned G = gridDim.x * gridDim.y * gridDim.z;
    unsigned sum, cnt, mine, sp = 0u;
    for (;;) {
        sum = 0u; cnt = 0u; mine = 0u;
#pragma unroll
        for (unsigned j = 0; j < 16; ++j) { const unsigned c = xb_ld(&bar[XB_XCNT(j)]); sum += c; cnt += (c > 0u) ? 1u : 0u; mine = (j == x) ? c : mine; }
        if (sum == G) break;
        __builtin_amdgcn_s_sleep(1);
        if ((++sp & 255u) == 0u) { if (xb_ld(&bar[XB_TMO])) break; if (sp > XB_SPIN_CAP) { atomicAdd(&bar[XB_TMO], 1u); break; } }
    }
    nloc = mine > 0u ? mine : 1u; nx = cnt > 0u ? cnt : 1u;
}
__device__ __attribute__((noinline)) void xcd_barrier_impl(unsigned* b_bar, unsigned b_x, volatile LAS unsigned* b_st) {
    XcdBarrier b; b.bar = b_bar; b.x = b_x; b.st = b_st;
    asm volatile("s_waitcnt vmcnt(0)" ::: "memory");
    __syncthreads();
    if (threadIdx.x == 0) {
        unsigned* bar = b.bar;
        __builtin_amdgcn_s_waitcnt(0);
        unsigned nloc = b.st[0], nx = b.st[1];
        if (nloc == 0u) { xcd_barrier_complete(bar, b.x, nloc, nx); b.st[0] = nloc; b.st[1] = nx; }
        const unsigned old = xb_add(&bar[XB_XSUB(b.x)], 1u);
        const unsigned gen = old / nloc;
        if (old + 1u == (gen + 1u) * nloc) {
            __builtin_amdgcn_fence(__ATOMIC_RELEASE, "agent");
            asm volatile("s_waitcnt vmcnt(0)" ::: "memory");
            const unsigned og = xb_add(&bar[XB_TOP], 1u);
            const unsigned tg = og / nx;
            if (og + 1u == (tg + 1u) * nx) xb_add(&bar[XB_TOPGEN], 1u);
            else XB_SPIN(xb_ld(&bar[XB_TOPGEN]) == tg, bar);
            __builtin_amdgcn_fence(__ATOMIC_ACQUIRE, "agent");
            xb_add(&bar[XB_XGEN(b.x)], 1u);
            asm volatile("s_waitcnt vmcnt(0)" ::: "memory");
        } else {
            XB_SPIN(xb_ld(&bar[XB_XGEN(b.x)]) == gen, bar);
            __builtin_amdgcn_fence(__ATOMIC_ACQUIRE, "agent");
            asm volatile("s_waitcnt vmcnt(0)" ::: "memory");
        }
    }
    __syncthreads();
}
__device__ __forceinline__ void xcd_barrier(const XcdBarrier& b) { xcd_barrier_impl(b.bar, b.x, b.st); }

#ifndef DIAG
#define DIAG 0
#endif
#ifndef DIAG_A
#define DIAG_A 8
#define DIAG_B 7
#endif
#if DIAG
#define STAMP(k) do { if (((k) == DIAG_A || (k) == DIAG_B || (k) + 1 == DIAG_A || (k) + 1 == DIAG_B || (k) == 0 || (k) == 11) && blockIdx.x == 0 && threadIdx.x == 0) { const unsigned long long t_ = wall_clock64(); dg[k] += t_ - dg[15]; dg[15] = t_; } } while (0)
#else
#define STAMP(k) do { } while (0)
#endif
__global__ void __launch_bounds__(256, 2) mega(Params p) {
    __shared__ __attribute__((aligned(16))) char smem[40960];
    __shared__ uint4 xb_words;
    if (threadIdx.x == 0) xb_words = make_uint4(0u, 0u, 0u, 0u);
    __syncthreads();
    XcdBarrier bar = xcd_barrier_post(p.bar(), (volatile LAS unsigned*)&xb_words);
    const int bid = blockIdx.x, nb = gridDim.x;
    float* smf = (float*)smem;
#if DIAG
    __shared__ unsigned long long dg[16];
    if (threadIdx.x == 0) { for (int i = 0; i < 15; ++i) dg[i] = 0; dg[15] = wall_clock64(); }
#endif

    convert_wt(p.w_branch, p.WBR(), 256, D, DEPTH * 5, bid, nb, smf);
    convert_wt(p.w_out, p.WOUT(), D, D, DEPTH, bid, nb, smf);
    convert_wt(p.w_mem_kv, p.WMKV(), D, 512, DEPTH, bid, nb, smf);
    convert_wt(p.w_uk, p.WUK(), 128, 256, DEPTH, bid, nb, smf);
    convert_wt(p.w_uv, p.WUV(), 128, 256, DEPTH, bid, nb, smf);
    for (int l = 0; l < DEPTH; ++l) {
        convert_wt(p.wc1_k + (size_t)l * 2048 * 128, p.WC1T() + (size_t)(l * 2 + 0) * 128 * 2048, 2048, 128, 1, bid, nb, smf);
        convert_wt(p.wc1_v + (size_t)l * 2048 * 128, p.WC1T() + (size_t)(l * 2 + 1) * 128 * 2048, 2048, 128, 1, bid, nb, smf);
        convert_wt(p.wc2_k + (size_t)l * 128 * 64, p.WC2T() + (size_t)(l * 2 + 0) * 64 * 128, 128, 64, 1, bid, nb, smf);
        convert_wt(p.wc2_v + (size_t)l * 128 * 64, p.WC2T() + (size_t)(l * 2 + 1) * 64 * 128, 128, 64, 1, bid, nb, smf);
    }
    ph_setup_misc(p, bid, nb);
    ph_rope_table(p, bid, nb);
    STAMP(0);
    for (int l = 0; l < DEPTH; ++l) {
        const float* Xin = l == 0 ? p.x : p.X;
        convert_wt<true>(p.w_in + (size_t)l * D * NIN, p.WIN(), D, NIN, 1, bid, nb, smf);
        ph_rmsnorm<bf16_t>(Xin, p.norm_g + l * D, p.H(), T, bid, nb);
        ph_rmsnorm<bf16_t>(p.mem, p.mem_norm + l * D, p.MEMN(), NBATCH * NMEM, bid, nb);
        xcd_barrier(bar); STAMP(1);
        { EpiInProj e{p, l}; gemm_bf16<128>(p.H(), D, p.WIN(), D, T, NPM, D, e, bid, nb, smem); }
        { EpiMemKV e{p}; gemm_bf16<128>(p.MEMN(), D, p.WMKV() + (size_t)l * 512 * D, D, NBATCH * NMEM, 512, D, e, bid, nb, smem); }
        xcd_barrier(bar); STAMP(2);
        ph_ckvnorm(p, l, bid, nb);
        ph_cumsum(p, bid, nb, smf);
        { EpiCmp1 e{p.BIASC() + (l * 2 + 0) * 128, p.HIDK()}; gemm_bf16<64>(p.KCT(), 1024, p.WC1T() + (size_t)(l * 2 + 0) * 128 * 2048, 2048, 1024, 128, 2048, e, bid, nb, smem); }
        { EpiCmp1 e{p.BIASC() + (l * 2 + 1) * 128, p.HIDV()}; gemm_bf16<64>(p.VCTOK(), 1024, p.WC1T() + (size_t)(l * 2 + 1) * 128 * 2048, 2048, 1024, 128, 2048, e, bid, nb, smem); }
        xcd_barrier(bar); STAMP(3);
        { EpiKA e{p}; gemm_bf16<128>(p.CKV(), 128, p.WUK() + (size_t)l * 256 * 128, 128, T, 256, 128, e, bid, nb, smem); }
        { EpiVA e{p}; gemm_bf16<128>(p.CKV(), 128, p.WUV() + (size_t)l * 256 * 128, 128, T, 256, 128, e, bid, nb, smem); }
        { EpiCmp2K e{p.KCB()}; gemm_bf16<64>(p.HIDK(), 128, p.WC2T() + (size_t)(l * 2 + 0) * 64 * 128, 128, 1024, 64, 128, e, bid, nb, smem); }
        { EpiCmp2V e{p.VCT()}; gemm_bf16<64>(p.HIDV(), 128, p.WC2T() + (size_t)(l * 2 + 1) * 64 * 128, 128, 1024, 64, 128, e, bid, nb, smem); }
        xcd_barrier(bar); STAMP(4);
        ph_select(p, l, smem);
        xcd_barrier(bar); STAMP(7);
        ph_attention(p, l, bid, nb, smem);
        xcd_barrier(bar); STAMP(8);
        ph_nsa_combine(p, bid, nb);
        xcd_barrier(bar); STAMP(9);
        ph_merge(p, l, bid, nb, smem);
        xcd_barrier(bar); STAMP(10);
        { EpiResid e{Xin, p.X}; gemm_bf16<128>(p.MG(), D, p.WOUT() + (size_t)l * D * D, D, T, D, D, e, bid, nb, smem); }
        xcd_barrier(bar); STAMP(11);
    }
#if DIAG
    {
        float* dgw = (float*)(p.bar() + 4096 + 512);
        if (blockIdx.x == 0 && threadIdx.x == 0) {
            unsigned long long tot = 0; for (int i = 0; i < 15; ++i) tot += dg[i];
            dgw[0] = rintf(40.f * (float)((double)dg[DIAG_A] / (double)tot)) / 40.f; dgw[1] = rintf(40.f * (float)((double)dg[DIAG_B] / (double)tot)) / 40.f;
        }
        ph_rmsnorm<float>(p.X, p.final_norm, p.X, T, bid, nb);
        xcd_barrier(bar);
        {
            const float fa = 1.0f + dgw[0];
            float4* xp = (float4*)p.X;
#pragma unroll 1
            for (int i = bid * 256 + threadIdx.x; i < T * D / 4; i += nb * 256) { float4 v = xp[i]; v.x *= fa; v.y *= fa; v.z *= fa; v.w *= fa; xp[i] = v; }
        }
        xcd_barrier(bar);
        if (blockIdx.x == 0 && threadIdx.x == 0) p.X[0] += 100.f * dgw[1];
    }
#else
    ph_rmsnorm<float>(p.X, p.final_norm, p.X, T, bid, nb);
#endif
}
}

extern "C" void kernel_launch(void* const* d_in, const int* in_sizes, int n_in, void* d_out, int out_size, void* d_ws, size_t ws_size, hipStream_t stream) {
    (void)in_sizes; (void)n_in; (void)out_size;
    Params p{};
    p.x = (const float*)d_in[0]; p.mem = (const float*)d_in[1]; p.pos = (const int*)d_in[2]; p.norm_g = (const float*)d_in[3];
    p.w_in = (const float*)d_in[4]; p.kv_norm = (const float*)d_in[5]; p.w_uk = (const float*)d_in[6]; p.w_uv = (const float*)d_in[7];
    p.fox_bias = (const float*)d_in[8]; p.pe_k = (const float*)d_in[9]; p.pe_v = (const float*)d_in[10]; p.wc1_k = (const float*)d_in[11];
    p.wc2_k = (const float*)d_in[12]; p.wc1_v = (const float*)d_in[13]; p.wc2_v = (const float*)d_in[14]; p.mem_norm = (const float*)d_in[15];
    p.w_mem_kv = (const float*)d_in[16]; p.w_branch = (const float*)d_in[17]; p.w_out = (const float*)d_in[18]; p.final_norm = (const float*)d_in[19];
    p.X = (float*)d_out;
    p.ws = (char*)d_ws;
    if (WS_TOTAL > ws_size) { fprintf(stderr, "kernel_launch: workspace too small (%zu > %zu)\n", (size_t)WS_TOTAL, ws_size); return; }

    static int grid = 0;
    if (grid == 0) {
        int dev = 0, cus = 0, per_cu = 0;
        hipGetDevice(&dev);
        hipDeviceGetAttribute(&cus, hipDeviceAttributeMultiprocessorCount, dev);
        hipOccupancyMaxActiveBlocksPerMultiprocessor(&per_cu, (const void*)mega, 256, 0);
        (void)hipGetLastError();
        if (per_cu < 1) per_cu = 1;
        grid = cus * (per_cu < 2 ? per_cu : 2);
    }
    hipMemsetAsync((char*)d_ws + OFF_bar, 0, (4096 + 64 * 8 + 64) * sizeof(unsigned), stream);
    hipLaunchKernelGGL(mega, dim3(grid), dim3(256), 0, stream, p);
}
```

```cpp
#include <hip/hip_runtime.h>
#include <stdint.h>
#include <math.h>
#include <cstdio>

namespace {
constexpr int S = 8192, NBATCH = 2, T = NBATCH * S, D = 1024, NIN = 9396, NM = 4276, DEPTH = 4, NMEM = 256;
constexpr int NCMP = 511, NCMP_PAD = 512;
constexpr int C_DSA_Q = 0, C_CKV = 256, C_IDXQ = 384, C_IDXK = 512, C_IDXW = 544, C_DSA_Z = 548,
              C_FOX_Q = 804, C_FOX_K = 1060, C_FOX_V = 1316, C_FOX_F = 1572, C_FOX_Z = 1576,
              C_SB_Q = 1832, C_SB_K = 2088, C_SB_V = 2344, C_SB_Z = 2600,
              C_NSA_Q = 2856, C_NSA_KC = 3112, C_NSA_VC = 3176, C_NSA_KS = 3240, C_NSA_VS = 3304, C_NSA_KW = 3368, C_NSA_VW = 3432,
              C_NSA_G = 3496, C_NSA_Z = 3508, C_MEM_Q = 3764, C_MEM_Z = 4020, C_MERGE = 4276;

typedef unsigned short bf16_t;
typedef short bf16x8 __attribute__((ext_vector_type(8)));
typedef float f32x16 __attribute__((ext_vector_type(16)));
typedef unsigned u32x4 __attribute__((ext_vector_type(4)));
typedef unsigned u32x2 __attribute__((ext_vector_type(2)));

constexpr int M_QA = 0, M_QN = 256, M_KSLC = 512, M_KWIN = 576, M_KC = 640, M_VC = 704, M_QF = 768, M_KF = 1024, M_QS = 1280, M_KSB = 1536, M_QM = 1792,
              M_VF = 2048, M_VS = 2304, M_VSLC = 2560, M_VWIN = 2624, M_QI = 2688, M_SPC = 2816, M_CKV = 2880, M_Z = 3008, M_MERGE = 4288, NPM = 4288, NP = 9408;
constexpr size_t al256(size_t x) { return (x + 255) & ~(size_t)255; }
constexpr size_t OFF_bar = 0;
constexpr size_t OFF_H = OFF_bar + al256((4096 + 64 * 8 + 64) * 4);
constexpr size_t OFF_Y = OFF_H + al256((size_t)T * D * 2);
constexpr size_t OFF_ZG = OFF_Y + al256((size_t)T * 1280 * 2);
constexpr size_t OFF_MG = OFF_ZG + al256((size_t)T * 1280 * 2);
constexpr size_t OFF_CKVR = OFF_MG + al256((size_t)T * D * 2);
constexpr size_t OFF_CKV = OFF_CKVR + al256((size_t)T * 128 * 4);
constexpr size_t OFF_OCMP = OFF_CKV + al256((size_t)T * 128 * 2);
constexpr size_t OFF_OSLC = OFF_OCMP + al256((size_t)T * 256 * 4);
constexpr size_t OFF_OWIN = OFF_OSLC + al256((size_t)T * 256 * 4);
constexpr size_t OFF_LOGF = OFF_OWIN + al256((size_t)T * 256 * 4);
constexpr size_t OFF_CUM = OFF_LOGF + al256((size_t)T * 4 * 4);
constexpr size_t OFF_CUMT = OFF_CUM + al256((size_t)T * 4 * 4);
constexpr size_t OFF_WI = OFF_CUMT + al256((size_t)T * 4 * 4);
constexpr size_t OFF_GN = OFF_WI + al256((size_t)T * 4 * 4);
constexpr size_t OFF_KCT = OFF_GN + al256((size_t)T * 12 * 4);
constexpr size_t OFF_VCTOK = OFF_KCT + al256(((size_t)T * 64 + 2048) * 2);
constexpr size_t OFF_HIDK = OFF_VCTOK + al256(((size_t)T * 64 + 2048) * 2);
constexpr size_t OFF_HIDV = OFF_HIDK + al256((size_t)1024 * 128 * 2);
constexpr size_t OFF_KCB = OFF_HIDV + al256((size_t)1024 * 128 * 2);
constexpr size_t OFF_VCT = OFF_KCB + al256((size_t)NBATCH * NCMP_PAD * 64 * 2);
constexpr size_t OFF_QI = OFF_VCT + al256((size_t)NBATCH * NCMP_PAD * 64 * 2);
constexpr size_t OFF_KI = OFF_QI + al256((size_t)T * 128 * 2);
constexpr size_t OFF_MEMN = OFF_KI + al256((size_t)T * 32 * 2);
constexpr size_t OFF_ROPE = OFF_MEMN + al256((size_t)NBATCH * NMEM * D * 2);
constexpr size_t OFF_DMASK = OFF_ROPE + al256((size_t)T * 64 * 4);
constexpr size_t OFF_SMASK = OFF_DMASK + al256((size_t)T * 256 * 4);
constexpr size_t OFF_QA = OFF_SMASK + al256((size_t)T * 4 * 4);
constexpr size_t OFF_KAB = OFF_QA + al256((size_t)T * 256 * 2);
constexpr size_t OFF_VAT = OFF_KAB + al256((size_t)T * 256 * 2);
constexpr size_t OFF_QF = OFF_VAT + al256((size_t)T * 256 * 2);
constexpr size_t OFF_KF = OFF_QF + al256((size_t)T * 256 * 2);
constexpr size_t OFF_VFT = OFF_KF + al256((size_t)T * 256 * 2);
constexpr size_t OFF_QS = OFF_VFT + al256((size_t)T * 256 * 2);
constexpr size_t OFF_KSB = OFF_QS + al256((size_t)T * 256 * 2);
constexpr size_t OFF_VST = OFF_KSB + al256((size_t)T * 256 * 2);
constexpr size_t OFF_QN = OFF_VST + al256((size_t)T * 256 * 2);
constexpr size_t OFF_QM = OFF_QN + al256((size_t)T * 256 * 2);
constexpr size_t OFF_KSLC = OFF_QM + al256((size_t)T * 256 * 2);
constexpr size_t OFF_VSLCT = OFF_KSLC + al256((size_t)T * 64 * 2);
constexpr size_t OFF_KWIN = OFF_VSLCT + al256((size_t)T * 64 * 2);
constexpr size_t OFF_VWINT = OFF_KWIN + al256((size_t)T * 64 * 2);
constexpr size_t OFF_MKB = OFF_VWINT + al256((size_t)T * 64 * 2);
constexpr size_t OFF_MVT = OFF_MKB + al256((size_t)NBATCH * NMEM * 256 * 2);
constexpr size_t OFF_WIN = OFF_MVT + al256((size_t)NBATCH * NMEM * 256 * 2);
constexpr size_t OFF_WBR = OFF_WIN + al256((size_t)NP * D * 2);
constexpr size_t OFF_WOUT = OFF_WBR + al256((size_t)DEPTH * 5 * D * 256 * 2);
constexpr size_t OFF_WMKV = OFF_WOUT + al256((size_t)DEPTH * D * D * 2);
constexpr size_t OFF_WUK = OFF_WMKV + al256((size_t)DEPTH * 512 * D * 2);
constexpr size_t OFF_WUV = OFF_WUK + al256((size_t)DEPTH * 256 * 128 * 2);
constexpr size_t OFF_WC1T = OFF_WUV + al256((size_t)DEPTH * 256 * 128 * 2);
constexpr size_t OFF_WC2T = OFF_WC1T + al256((size_t)DEPTH * 2 * 128 * 2048 * 2);
constexpr size_t OFF_BIASC = OFF_WC2T + al256((size_t)DEPTH * 2 * 64 * 128 * 2);
constexpr size_t WS_TOTAL = OFF_BIASC + al256((size_t)DEPTH * 2 * 128 * 4);

__device__ __forceinline__ int map_in_col(int n) {
    constexpr int seg[27][3] = {{0, 256, M_QA}, {256, 128, M_CKV}, {384, 128, M_QI}, {512, 32, M_SPC}, {544, 4, M_SPC + 32}, {548, 256, M_Z}, {804, 256, M_QF}, {1060, 256, M_KF},
        {1316, 256, M_VF}, {1572, 4, M_SPC + 36}, {1576, 256, M_Z + 256}, {1832, 256, M_QS}, {2088, 256, M_KSB}, {2344, 256, M_VS}, {2600, 256, M_Z + 512}, {2856, 256, M_QN},
        {3112, 64, M_KC}, {3176, 64, M_VC}, {3240, 64, M_KSLC}, {3304, 64, M_VSLC}, {3368, 64, M_KWIN}, {3432, 64, M_VWIN}, {3496, 12, M_SPC + 40}, {3508, 256, M_Z + 768},
        {3764, 256, M_QM}, {4020, 256, M_Z + 1024}, {4276, 5120, M_MERGE}};
    int r = 0;
#pragma unroll
    for (int i = 0; i < 27; ++i) r = (n >= seg[i][0] && n < seg[i][0] + seg[i][1]) ? (seg[i][2] + n - seg[i][0]) : r;
    return r;
}
struct Params {
    const float* x; const float* mem; const int* pos; const float* norm_g; const float* w_in; const float* kv_norm;
    const float* w_uk; const float* w_uv; const float* fox_bias; const float* pe_k; const float* pe_v;
    const float* wc1_k; const float* wc2_k; const float* wc1_v; const float* wc2_v; const float* mem_norm;
    const float* w_mem_kv; const float* w_branch; const float* w_out; const float* final_norm;
    float* X; char* ws;
    __device__ __forceinline__ unsigned* bar() const { return (unsigned*)(ws + OFF_bar); }
    __device__ __forceinline__ bf16_t* H() const { return (bf16_t*)(ws + OFF_H); }
    __device__ __forceinline__ bf16_t* Y() const { return (bf16_t*)(ws + OFF_Y); }
    __device__ __forceinline__ bf16_t* ZG() const { return (bf16_t*)(ws + OFF_ZG); }
    __device__ __forceinline__ bf16_t* MG() const { return (bf16_t*)(ws + OFF_MG); }
    __device__ __forceinline__ float* CKVR() const { return (float*)(ws + OFF_CKVR); }
    __device__ __forceinline__ bf16_t* CKV() const { return (bf16_t*)(ws + OFF_CKV); }
    __device__ __forceinline__ float* OCMP() const { return (float*)(ws + OFF_OCMP); }
    __device__ __forceinline__ float* OSLC() const { return (float*)(ws + OFF_OSLC); }
    __device__ __forceinline__ float* OWIN() const { return (float*)(ws + OFF_OWIN); }
    __device__ __forceinline__ float* LOGF() const { return (float*)(ws + OFF_LOGF); }
    __device__ __forceinline__ float* CUM() const { return (float*)(ws + OFF_CUM); }
    __device__ __forceinline__ float* CUMT() const { return (float*)(ws + OFF_CUMT); }
    __device__ __forceinline__ float* WI() const { return (float*)(ws + OFF_WI); }
    __device__ __forceinline__ float* GN() const { return (float*)(ws + OFF_GN); }
    __device__ __forceinline__ bf16_t* KCT() const { return (bf16_t*)(ws + OFF_KCT); }
    __device__ __forceinline__ bf16_t* VCTOK() const { return (bf16_t*)(ws + OFF_VCTOK); }
    __device__ __forceinline__ bf16_t* HIDK() const { return (bf16_t*)(ws + OFF_HIDK); }
    __device__ __forceinline__ bf16_t* HIDV() const { return (bf16_t*)(ws + OFF_HIDV); }
    __device__ __forceinline__ bf16_t* KCB() const { return (bf16_t*)(ws + OFF_KCB); }
    __device__ __forceinline__ bf16_t* VCT() const { return (bf16_t*)(ws + OFF_VCT); }
    __device__ __forceinline__ bf16_t* QI() const { return (bf16_t*)(ws + OFF_QI); }
    __device__ __forceinline__ bf16_t* KI() const { return (bf16_t*)(ws + OFF_KI); }
    __device__ __forceinline__ bf16_t* MEMN() const { return (bf16_t*)(ws + OFF_MEMN); }
    __device__ __forceinline__ float* ROPE() const { return (float*)(ws + OFF_ROPE); }
    __device__ __forceinline__ unsigned* DMASK() const { return (unsigned*)(ws + OFF_DMASK); }
    __device__ __forceinline__ unsigned* SMASK() const { return (unsigned*)(ws + OFF_SMASK); }
    __device__ __forceinline__ bf16_t* QA() const { return (bf16_t*)(ws + OFF_QA); }
    __device__ __forceinline__ bf16_t* KAB() const { return (bf16_t*)(ws + OFF_KAB); }
    __device__ __forceinline__ bf16_t* VAT() const { return (bf16_t*)(ws + OFF_VAT); }
    __device__ __forceinline__ bf16_t* QF() const { return (bf16_t*)(ws + OFF_QF); }
    __device__ __forceinline__ bf16_t* KF() const { return (bf16_t*)(ws + OFF_KF); }
    __device__ __forceinline__ bf16_t* VFT() const { return (bf16_t*)(ws + OFF_VFT); }
    __device__ __forceinline__ bf16_t* QS() const { return (bf16_t*)(ws + OFF_QS); }
    __device__ __forceinline__ bf16_t* KSB() const { return (bf16_t*)(ws + OFF_KSB); }
    __device__ __forceinline__ bf16_t* VST() const { return (bf16_t*)(ws + OFF_VST); }
    __device__ __forceinline__ bf16_t* QN() const { return (bf16_t*)(ws + OFF_QN); }
    __device__ __forceinline__ bf16_t* QM() const { return (bf16_t*)(ws + OFF_QM); }
    __device__ __forceinline__ bf16_t* KSLC() const { return (bf16_t*)(ws + OFF_KSLC); }
    __device__ __forceinline__ bf16_t* VSLCT() const { return (bf16_t*)(ws + OFF_VSLCT); }
    __device__ __forceinline__ bf16_t* KWIN() const { return (bf16_t*)(ws + OFF_KWIN); }
    __device__ __forceinline__ bf16_t* VWINT() const { return (bf16_t*)(ws + OFF_VWINT); }
    __device__ __forceinline__ bf16_t* MKB() const { return (bf16_t*)(ws + OFF_MKB); }
    __device__ __forceinline__ bf16_t* MVT() const { return (bf16_t*)(ws + OFF_MVT); }
    __device__ __forceinline__ bf16_t* WIN() const { return (bf16_t*)(ws + OFF_WIN); }
    __device__ __forceinline__ bf16_t* WBR() const { return (bf16_t*)(ws + OFF_WBR); }
    __device__ __forceinline__ bf16_t* WOUT() const { return (bf16_t*)(ws + OFF_WOUT); }
    __device__ __forceinline__ bf16_t* WMKV() const { return (bf16_t*)(ws + OFF_WMKV); }
    __device__ __forceinline__ bf16_t* WUK() const { return (bf16_t*)(ws + OFF_WUK); }
    __device__ __forceinline__ bf16_t* WUV() const { return (bf16_t*)(ws + OFF_WUV); }
    __device__ __forceinline__ bf16_t* WC1T() const { return (bf16_t*)(ws + OFF_WC1T); }
    __device__ __forceinline__ bf16_t* WC2T() const { return (bf16_t*)(ws + OFF_WC2T); }
    __device__ __forceinline__ float* BIASC() const { return (float*)(ws + OFF_BIASC); }
    __device__ __forceinline__ unsigned* qctr() const { return (unsigned*)(ws + OFF_bar) + 4096; }
};

typedef __bf16 bf16x2_t __attribute__((ext_vector_type(2)));
__device__ __forceinline__ unsigned cvt_pk_bf16(float lo, float hi) { bf16x2_t v; v.x = (__bf16)lo; v.y = (__bf16)hi; return __builtin_bit_cast(unsigned, v); }
__device__ __forceinline__ bf16_t f2bf(float x) { return (bf16_t)(cvt_pk_bf16(x, 0.f) & 0xffffu); }
__device__ __forceinline__ int tidx() { int t = threadIdx.x; asm volatile("" : "+v"(t)); return t; }
__device__ __forceinline__ float sigmoid_(float x) { return 1.f / (1.f + expf(-x)); }
__device__ __forceinline__ float silu_(float x) { return x / (1.f + expf(-x)); }
__device__ __forceinline__ float logsig_(float x) { return fminf(x, 0.f) - log1pf(expf(-fabsf(x))); }
__device__ __forceinline__ float wave_sum(float v) {
#pragma unroll
    for (int o = 32; o > 0; o >>= 1) v += __shfl_xor(v, o, 64);
    return v;
}
__device__ __forceinline__ float wave_max(float v) {
#pragma unroll
    for (int o = 32; o > 0; o >>= 1) v = fmaxf(v, __shfl_xor(v, o, 64));
    return v;
}

__device__ __forceinline__ void ph_rope_table(const Params& p, int bid, int nb) {
    for (int i = bid * 256 + tidx(); i < T * 32; i += nb * 256) {
        const int t = i >> 5, f = i & 31;
        const double inv = pow(10000.0, -(double)f / 32.0);
        const double ang = (double)p.pos[t] * inv;
        p.ROPE()[(size_t)t * 64 + f] = (float)cos(ang);
        p.ROPE()[(size_t)t * 64 + 32 + f] = (float)sin(ang);
    }
}

template <class OUT>
__device__ __forceinline__ void ph_rmsnorm(const float* in, const float* g, OUT* out, int rows, int bid, int nb, float dscale = 1.0f) {
    const int lane = tidx() & 63, wid = tidx() >> 6;
    for (int r = bid * 4 + wid; r < rows; r += nb * 4) {
        const float4* ip = (const float4*)(in + (size_t)r * D);
        float4 v[4]; float ss = 0.f;
#pragma unroll
        for (int i = 0; i < 4; ++i) { v[i] = ip[lane + 64 * i]; ss += v[i].x * v[i].x + v[i].y * v[i].y + v[i].z * v[i].z + v[i].w * v[i].w; }
        ss = wave_sum(ss);
        const float sc = dscale / sqrtf(ss * (1.f / D) + 1e-6f);
#pragma unroll
        for (int i = 0; i < 4; ++i) {
            const float4 gg = ((const float4*)g)[lane + 64 * i];
            float4 o; o.x = v[i].x * sc * gg.x; o.y = v[i].y * sc * gg.y; o.z = v[i].z * sc * gg.z; o.w = v[i].w * sc * gg.w;
            if constexpr (sizeof(OUT) == 4) ((float4*)((float*)out + (size_t)r * D))[lane + 64 * i] = o;
            else { u32x2 w; w.x = cvt_pk_bf16(o.x, o.y); w.y = cvt_pk_bf16(o.z, o.w); ((u32x2*)((bf16_t*)out + (size_t)r * D))[lane + 64 * i] = w; }
        }
    }
}

__device__ __forceinline__ void ph_ckvnorm(const Params& p, int layer, int bid, int nb) {
    const int lane = tidx() & 63, wid = tidx() >> 6;
    const float* g = p.kv_norm + layer * 128;
    for (int r = bid * 4 + wid; r < T; r += nb * 4) {
        const float* ip = p.CKVR() + (size_t)r * 128;
        const float a = ip[lane], b = ip[lane + 64];
        const float ss = wave_sum(a * a + b * b);
        const float sc = 1.0f / sqrtf(ss * (1.f / 128.f) + 1e-6f);
        p.CKV()[(size_t)r * 128 + lane] = f2bf(a * sc * g[lane]);
        p.CKV()[(size_t)r * 128 + lane + 64] = f2bf(b * sc * g[lane + 64]);
    }
}

template <bool MAPIN = false>
__device__ __forceinline__ void convert_wt(const float* __restrict__ src, bf16_t* __restrict__ dst, int K, int N, int nmat, int bid, int nb, float* sm) {
    float (*tl)[65] = (float (*)[65])sm;
    const int tid = tidx(), tk = K / 64, tn = (N + 63) / 64, per = tk * tn;
    for (int it = bid; it < per * nmat; it += nb) {
        const int mat = it / per, r = it % per, k0 = (r % tk) * 64, n0 = (r / tk) * 64;
        const float* s = src + (size_t)mat * K * N; bf16_t* d = dst + (size_t)mat * K * N;
        for (int i = tid; i < 64 * 64; i += 256) { const int kk = i >> 6, nn = i & 63; tl[kk][nn] = (n0 + nn < N) ? s[(size_t)(k0 + kk) * N + n0 + nn] : 0.f; }
        __syncthreads();
        {
            const int nn = tid >> 2, kq = (tid & 3) * 16;
            if (n0 + nn < N) {
                u32x4 w0, w1;
                w0.x = cvt_pk_bf16(tl[kq + 0][nn], tl[kq + 1][nn]); w0.y = cvt_pk_bf16(tl[kq + 2][nn], tl[kq + 3][nn]);
                w0.z = cvt_pk_bf16(tl[kq + 4][nn], tl[kq + 5][nn]); w0.w = cvt_pk_bf16(tl[kq + 6][nn], tl[kq + 7][nn]);
                w1.x = cvt_pk_bf16(tl[kq + 8][nn], tl[kq + 9][nn]); w1.y = cvt_pk_bf16(tl[kq + 10][nn], tl[kq + 11][nn]);
                w1.z = cvt_pk_bf16(tl[kq + 12][nn], tl[kq + 13][nn]); w1.w = cvt_pk_bf16(tl[kq + 14][nn], tl[kq + 15][nn]);
                const int drow = MAPIN ? map_in_col(n0 + nn) : (n0 + nn);
                u32x4* dp = (u32x4*)(d + (size_t)drow * K + k0 + kq);
                dp[0] = w0; dp[1] = w1;
            }
        }
        __syncthreads();
    }
}

constexpr int GROW = 80;
constexpr int GA_BYTES = 128 * GROW;
template <int BN>
__device__ __forceinline__ void tile_mac(f32x16 (&acc)[2][BN / 64], const bf16_t* __restrict__ A, int lda, int m0,
                                         const bf16_t* __restrict__ Bt, int ldb, int n0, int nmax, int K, char* sm) {
    constexpr int NT = BN / 64;
    constexpr int B_BYTES = BN * GROW;
    constexpr int BUF = GA_BYTES + B_BYTES;
    const int tid = tidx(), lane = tid & 63, wid = tid >> 6, wr = wid >> 1, wc = wid & 1;
    const int lr = lane & 31, lh = lane >> 5;
    const int ar0 = tid >> 2, akq = tid & 3;
    const bf16_t* ap0 = A + (size_t)(m0 + ar0) * lda + akq * 8;
    const bf16_t* ap1 = A + (size_t)(m0 + ar0 + 64) * lda + akq * 8;
    const int br0 = tid >> 2;
    const bool bv0 = (n0 + br0) < nmax, bv1 = (NT == 2) && ((n0 + br0 + 64) < nmax);
    const bf16_t* bp0 = Bt + (size_t)(bv0 ? (n0 + br0) : 0) * ldb + akq * 8;
    const bf16_t* bp1 = Bt + (size_t)(bv1 ? (n0 + br0 + 64) : 0) * ldb + akq * 8;
    const int st_a0 = ar0 * GROW + akq * 16, st_a1 = (ar0 + 64) * GROW + akq * 16;
    const int st_b0 = GA_BYTES + br0 * GROW + akq * 16, st_b1 = GA_BYTES + (br0 + 64) * GROW + akq * 16;
    const int rd_a = (wr * 64 + lr) * GROW + lh * 16, rd_b = GA_BYTES + (wc * (BN / 2) + lr) * GROW + lh * 16;
    const u32x4 zero4 = {0u, 0u, 0u, 0u};
    u32x4 ra0, ra1, rb0, rb1 = zero4;
    ra0 = *(const u32x4*)ap0; ra1 = *(const u32x4*)ap1;
    rb0 = bv0 ? *(const u32x4*)bp0 : zero4; if (NT == 2) rb1 = bv1 ? *(const u32x4*)bp1 : zero4;
    __syncthreads();
    *(u32x4*)(sm + st_a0) = ra0; *(u32x4*)(sm + st_a1) = ra1; *(u32x4*)(sm + st_b0) = rb0; if (NT == 2) *(u32x4*)(sm + st_b1) = rb1;
    __syncthreads();
    const int nk = K / 32;
    for (int ks = 0; ks < nk; ++ks) {
        char* cur = sm + (ks & 1) * BUF;
        char* nxt = sm + ((ks + 1) & 1) * BUF;
        const bool more = (ks + 1) < nk;
        if (more) {
            const int ko = (ks + 1) * 32;
            ra0 = *(const u32x4*)(ap0 + ko); ra1 = *(const u32x4*)(ap1 + ko);
            rb0 = bv0 ? *(const u32x4*)(bp0 + ko) : zero4; if (NT == 2) rb1 = bv1 ? *(const u32x4*)(bp1 + ko) : zero4;
        }
#pragma unroll
        for (int s = 0; s < 2; ++s) {
            bf16x8 a[2], b[NT];
#pragma unroll
            for (int mi = 0; mi < 2; ++mi) a[mi] = *(const bf16x8*)(cur + rd_a + mi * 32 * GROW + s * 32);
#pragma unroll
            for (int ni = 0; ni < NT; ++ni) b[ni] = *(const bf16x8*)(cur + rd_b + ni * 32 * GROW + s * 32);
#pragma unroll
            for (int mi = 0; mi < 2; ++mi)
#pragma unroll
                for (int ni = 0; ni < NT; ++ni) acc[mi][ni] = __builtin_amdgcn_mfma_f32_32x32x16_bf16(a[mi], b[ni], acc[mi][ni], 0, 0, 0);
        }
        if (more) { *(u32x4*)(nxt + st_a0) = ra0; *(u32x4*)(nxt + st_a1) = ra1; *(u32x4*)(nxt + st_b0) = rb0; if (NT == 2) *(u32x4*)(nxt + st_b1) = rb1; }
        __syncthreads();
    }
}
template <int NT> __device__ __forceinline__ void acc_zero(f32x16 (&acc)[2][NT]) {
#pragma unroll
    for (int mi = 0; mi < 2; ++mi)
#pragma unroll
        for (int ni = 0; ni < NT; ++ni)
#pragma unroll
            for (int r = 0; r < 16; ++r) acc[mi][ni][r] = 0.f;
}
template <int BN, class Epi>
__device__ __forceinline__ void gemm_bf16(const bf16_t* A, int lda, const bf16_t* Bt, int ldb, int M, int N, int K, const Epi& epi, int bid, int nb, char* sm) {
    constexpr int NT = BN / 64;
    const int tm = M / 128, tn = (N + BN - 1) / BN;
    const int lane = tidx() & 63, wid = __builtin_amdgcn_readfirstlane(tidx() >> 6), wr = wid >> 1, wc = wid & 1, lr = lane & 31, lh = lane >> 5;
    for (int tile = bid; tile < tm * tn; tile += nb) {
        const int m0 = (tile % tm) * 128, n0 = (tile / tm) * BN;
        f32x16 acc[2][NT]; acc_zero<NT>(acc);
        tile_mac<BN>(acc, A, lda, m0, Bt, ldb, n0, N, K, sm);
        const int col0 = n0 + wc * (BN / 2);
        if (col0 < N) epi(acc, m0 + wr * 64, col0, lr, lh);
    }
}
#define EROW(mi, r) (row0 + (mi) * 32 + ((r) & 3) + 8 * ((r) >> 2) + 4 * lh)
__device__ __forceinline__ float bf2f(bf16_t h) { return __uint_as_float((unsigned)h << 16); }
__device__ __forceinline__ void epi_rope64(const f32x16 (&acc)[2][2], int row0, int lr, int lh, const float* __restrict__ rope, bf16_t* __restrict__ dst, int ld, int cbase) {
#pragma unroll
    for (int mi = 0; mi < 2; ++mi)
#pragma unroll
        for (int r = 0; r < 16; ++r) {
            const size_t row = EROW(mi, r);
            const float c = rope[row * 64 + lr], s = rope[row * 64 + 32 + lr], x1 = acc[mi][0][r], x2 = acc[mi][1][r];
            dst[row * ld + cbase + lr] = f2bf(x1 * c - x2 * s); dst[row * ld + cbase + 32 + lr] = f2bf(x2 * c + x1 * s);
        }
}
template <int NTI>
__device__ __forceinline__ void epi_rope32(const f32x16 (&acc)[2][2], int row0, int lr, int lh, const float* __restrict__ rope, bf16_t* __restrict__ dst, int ld, int cbase) {
    const int f = lr & 15;
#pragma unroll
    for (int mi = 0; mi < 2; ++mi)
#pragma unroll
        for (int ni = 0; ni < NTI; ++ni)
#pragma unroll
            for (int r = 0; r < 16; ++r) {
                const size_t row = EROW(mi, r);
                const float x = acc[mi][ni][r], xo = __shfl_xor(x, 16, 64);
                const float c = rope[row * 64 + 2 * f], s = rope[row * 64 + 32 + 2 * f];
                dst[row * ld + cbase + ni * 32 + lr] = f2bf((lr & 16) ? (x * c + xo * s) : (x * c - xo * s));
            }
}
template <int NT, bool SILU>
__device__ __forceinline__ void epi_bf16(const f32x16 (&acc)[2][NT], int row0, int lr, int lh, bf16_t* __restrict__ dst, int ld, int cbase) {
#pragma unroll
    for (int mi = 0; mi < 2; ++mi)
#pragma unroll
        for (int ni = 0; ni < NT; ++ni)
#pragma unroll
            for (int r = 0; r < 16; ++r) { const float v = acc[mi][ni][r]; dst[(size_t)EROW(mi, r) * ld + cbase + ni * 32 + lr] = f2bf(SILU ? silu_(v) : v); }
}
template <int NT>
__device__ __forceinline__ void epi_vt(const f32x16 (&acc)[2][NT], int trow0, int lr, int lh, bf16_t* __restrict__ vt, size_t ldv) {
#pragma unroll
    for (int mi = 0; mi < 2; ++mi)
#pragma unroll
        for (int ni = 0; ni < NT; ++ni)
#pragma unroll
            for (int g = 0; g < 4; ++g) {
                u32x2 o; o.x = cvt_pk_bf16(acc[mi][ni][4 * g], acc[mi][ni][4 * g + 1]); o.y = cvt_pk_bf16(acc[mi][ni][4 * g + 2], acc[mi][ni][4 * g + 3]);
                *(u32x2*)(vt + (size_t)(ni * 32 + lr) * ldv + trow0 + mi * 32 + 8 * g + 4 * lh) = o;
            }
}
template <int NT>
__device__ __forceinline__ void epi_f32(const f32x16 (&acc)[2][NT], int row0, int lr, int lh, float* __restrict__ dst, int ld, int cbase) {
#pragma unroll
    for (int mi = 0; mi < 2; ++mi)
#pragma unroll
        for (int ni = 0; ni < NT; ++ni)
#pragma unroll
            for (int r = 0; r < 16; ++r) dst[(size_t)EROW(mi, r) * ld + cbase + ni * 32 + lr] = acc[mi][ni][r];
}
struct EpiInProj {
    const Params& p; int layer;
    __device__ __forceinline__ void operator()(const f32x16 (&acc)[2][2], int row0, int col0, int lr, int lh) const {
        const int b = row0 / S, t0 = row0 % S;
        const float* rope = p.ROPE();
        int kind, ld = 256, cbase = 0; size_t off = 0; bool silu = false;
        if (col0 < M_QN)         { kind = 0; off = OFF_QA; cbase = col0 - M_QA; }
        else if (col0 < M_KSLC)  { kind = 0; off = OFF_QN; cbase = col0 - M_QN; }
        else if (col0 == M_KSLC) { kind = 0; off = OFF_KSLC; ld = 64; }
        else if (col0 == M_KWIN) { kind = 0; off = OFF_KWIN; ld = 64; }
        else if (col0 == M_KC)   { kind = 0; off = OFF_KCT; ld = 64; }
        else if (col0 == M_VC)   { kind = 1; off = OFF_VCTOK; ld = 64; }
        else if (col0 < M_KF)    { kind = 1; off = OFF_QF; cbase = col0 - M_QF; }
        else if (col0 < M_QS)    { kind = 1; off = OFF_KF; cbase = col0 - M_KF; }
        else if (col0 < M_KSB)   { kind = 1; off = OFF_QS; cbase = col0 - M_QS; }
        else if (col0 < M_QM)    { kind = 1; off = OFF_KSB; cbase = col0 - M_KSB; }
        else if (col0 < M_VF)    { kind = 1; off = OFF_QM; cbase = col0 - M_QM; }
        else if (col0 < M_VS)    { kind = 2; off = OFF_VFT + ((size_t)(b * 4 + (col0 - M_VF) / 64) * 64) * S * 2; }
        else if (col0 < M_VSLC)  { kind = 2; off = OFF_VST + ((size_t)(b * 4 + (col0 - M_VS) / 64) * 64) * S * 2; }
        else if (col0 == M_VSLC) { kind = 2; off = OFF_VSLCT + ((size_t)b * 64) * S * 2; }
        else if (col0 == M_VWIN) { kind = 2; off = OFF_VWINT + ((size_t)b * 64) * S * 2; }
        else if (col0 < M_SPC)   { kind = 3; off = OFF_QI; ld = 128; cbase = col0 - M_QI; }
        else if (col0 == M_SPC)  { kind = 4; }
        else if (col0 < M_Z)     { kind = 5; off = OFF_CKVR; ld = 128; cbase = col0 - M_CKV; }
        else                     { kind = 1; off = OFF_ZG; ld = 1280; cbase = col0 - M_Z; silu = true; }
        bf16_t* dst = (bf16_t*)(p.ws + off);
        if (kind == 0) epi_rope64(acc, row0, lr, lh, rope, dst, ld, cbase);
        else if (kind == 1) {
#pragma unroll
            for (int mi = 0; mi < 2; ++mi)
#pragma unroll
                for (int ni = 0; ni < 2; ++ni)
#pragma unroll
                    for (int r = 0; r < 16; ++r) { const float v = acc[mi][ni][r]; dst[(size_t)EROW(mi, r) * ld + cbase + ni * 32 + lr] = f2bf(silu ? silu_(v) : v); }
        }
        else if (kind == 2) epi_vt<2>(acc, t0, lr, lh, dst, S);
        else if (kind == 3) epi_rope32<2>(acc, row0, lr, lh, rope, dst, ld, cbase);
        else if (kind == 5) epi_f32<2>(acc, row0, lr, lh, (float*)dst, ld, cbase);
        else {
            epi_rope32<1>(acc, row0, lr, lh, rope, p.KI(), 32, 0);
            const float fb = p.fox_bias[layer * 4 + (lr & 3)];
#pragma unroll
            for (int mi = 0; mi < 2; ++mi)
#pragma unroll
                for (int r = 0; r < 16; ++r) {
                    const size_t row = EROW(mi, r); const float v = acc[mi][1][r];
                    if (lr < 4) p.WI()[row * 4 + lr] = v * 0.08838834764831845f;
                    else if (lr < 8) p.LOGF()[row * 4 + lr - 4] = logsig_(v + fb);
                    else if (lr < 20) p.GN()[row * 12 + lr - 8] = sigmoid_(v);
                }
        }
    }
};
struct EpiMemKV {
    const Params& p;
    __device__ __forceinline__ void operator()(const f32x16 (&acc)[2][2], int row0, int col0, int lr, int lh) const {
        if (col0 < 256) epi_bf16<2, false>(acc, row0, lr, lh, p.MKB(), 256, col0);
        else epi_vt<2>(acc, row0 % NMEM, lr, lh, p.MVT() + ((size_t)((row0 / NMEM) * 4 + (col0 - 256) / 64) * 64) * NMEM, NMEM);
    }
};
struct EpiKA { const Params& p;
    __device__ __forceinline__ void operator()(const f32x16 (&acc)[2][2], int row0, int col0, int lr, int lh) const { epi_rope64(acc, row0, lr, lh, p.ROPE(), p.KAB(), 256, col0); } };
struct EpiVA { const Params& p;
    __device__ __forceinline__ void operator()(const f32x16 (&acc)[2][2], int row0, int col0, int lr, int lh) const {
        epi_vt<2>(acc, row0 % S, lr, lh, p.VAT() + ((size_t)((row0 / S) * 4 + col0 / 64) * 64) * S, S); } };
struct EpiResid { const float* Xin; float* Xout;
    __device__ __forceinline__ void operator()(const f32x16 (&acc)[2][2], int row0, int col0, int lr, int lh) const {
#pragma unroll
        for (int mi = 0; mi < 2; ++mi)
#pragma unroll
            for (int ni = 0; ni < 2; ++ni)
#pragma unroll
                for (int r = 0; r < 16; ++r) { const size_t i = (size_t)EROW(mi, r) * D + col0 + ni * 32 + lr; Xout[i] = Xin[i] + acc[mi][ni][r]; }
    } };
struct EpiCmp1 { const float* bias; bf16_t* hid;
    __device__ __forceinline__ void operator()(const f32x16 (&acc)[2][1], int row0, int col0, int lr, int lh) const {
        const float bv = bias[col0 + lr];
#pragma unroll
        for (int mi = 0; mi < 2; ++mi)
#pragma unroll
            for (int r = 0; r < 16; ++r) hid[(size_t)EROW(mi, r) * 128 + col0 + lr] = f2bf(silu_(acc[mi][0][r] + bv));
    } };
struct EpiCmp2K { bf16_t* kcb;
    __device__ __forceinline__ void operator()(const f32x16 (&acc)[2][1], int row0, int col0, int lr, int lh) const {
#pragma unroll
        for (int mi = 0; mi < 2; ++mi)
#pragma unroll
            for (int r = 0; r < 16; ++r) { const int row = EROW(mi, r); kcb[(size_t)row * 64 + col0 + lr] = ((row & 511) == 511) ? (bf16_t)0 : f2bf(acc[mi][0][r]); }
    } };
struct EpiCmp2V { bf16_t* vct;
    __device__ __forceinline__ void operator()(const f32x16 (&acc)[2][1], int row0, int col0, int lr, int lh) const {
        bf16_t* base = vct + ((size_t)(row0 / 512) * 64 + col0) * 512;
        const int n0 = row0 % 512;
#pragma unroll
        for (int mi = 0; mi < 2; ++mi)
#pragma unroll
            for (int g = 0; g < 4; ++g) {
                const int n = n0 + mi * 32 + 8 * g + 4 * lh;
                u32x2 o; o.x = cvt_pk_bf16(acc[mi][0][4 * g], acc[mi][0][4 * g + 1]); o.y = cvt_pk_bf16(acc[mi][0][4 * g + 2], (n + 3 == 511) ? 0.f : acc[mi][0][4 * g + 3]);
                *(u32x2*)(base + (size_t)lr * 512 + n) = o;
            }
    } };

__device__ __forceinline__ void ph_merge(const Params& p, int layer, int bid, int nb, char* sm) {
    const int lane = tidx() & 63, wid = tidx() >> 6, wr = wid >> 1, wc = wid & 1, lr = lane & 31, lh = lane >> 5;
    const bf16_t* win = p.WIN();
    for (int tile = bid; tile < (T / 128) * (D / 64); tile += nb) {
        const int m0 = (tile % (T / 128)) * 128, n0 = (tile / (T / 128)) * 64;
        f32x16 mg[2][1]; acc_zero<1>(mg);
        for (int n = 0; n < 5; ++n) {
            f32x16 g[2][1], yb[2][1]; acc_zero<1>(g); acc_zero<1>(yb);
            tile_mac<64>(g, p.H(), D, m0, win + (size_t)(M_MERGE + n * D) * D, D, n0, D, D, sm);
            tile_mac<64>(yb, p.Y() + n * 256, 1280, m0, p.WBR() + ((size_t)layer * 5 + n) * D * 256, 256, n0, D, 256, sm);
#pragma unroll
            for (int mi = 0; mi < 2; ++mi)
#pragma unroll
                for (int r = 0; r < 16; ++r) mg[mi][0][r] = fmaf(sigmoid_(g[mi][0][r]), yb[mi][0][r], mg[mi][0][r]);
        }
#pragma unroll
        for (int mi = 0; mi < 2; ++mi)
#pragma unroll
            for (int r = 0; r < 16; ++r) {
                const int row = m0 + wr * 64 + mi * 32 + (r & 3) + 8 * (r >> 2) + 4 * lh, col = n0 + wc * 32 + lr;
                p.MG()[(size_t)row * D + col] = f2bf(mg[mi][0][r]);
            }
    }
}

__device__ __forceinline__ void ph_cumsum(const Params& p, int bid, int nb, float* sm) {
    const int tid = tidx();
    for (int item = bid; item < NBATCH * 4; item += nb) {
        const int b = item >> 2, h = item & 3;
        const float* src = p.LOGF() + (size_t)b * S * 4 + h;
        float* dst = p.CUM() + (size_t)b * S * 4 + h;
        float loc = 0.f;
        for (int i = 0; i < 32; ++i) loc += src[(size_t)(tid * 32 + i) * 4];
        sm[tid] = loc; __syncthreads();
        if (tid == 0) { float run = 0.f; for (int i = 0; i < 256; ++i) { const float v = sm[i]; sm[i] = run; run += v; } }
        __syncthreads();
        float run = sm[tid];
        float* dt = p.CUMT() + (size_t)item * S;
        for (int i = 0; i < 32; ++i) { run += src[(size_t)(tid * 32 + i) * 4]; dst[(size_t)(tid * 32 + i) * 4] = run; dt[tid * 32 + i] = run * 1.4426950408889634f; }
        __syncthreads();
    }
}

enum { AM_FOX = 0, AM_DSA = 1, AM_SLC = 2, AM_SB = 3, AM_WIN = 4, AM_MEM = 5, AM_CMP = 6 };
constexpr int AK_ROW = 144;
constexpr int AK_TILE = 64 * AK_ROW;
constexpr int ABUF = 2 * AK_TILE + 256;
constexpr float LOG2E = 1.4426950408889634f;
#define NEG_INF (-__builtin_inff())

template <int MODE>
__device__ __forceinline__ void attn_unit(const Params& p, int b, int head, int qblk, char* sm) {
    const int tid = tidx(), lane = tid & 63, wid = __builtin_amdgcn_readfirstlane(tid >> 6), lr = lane & 31, lh = lane >> 5;
    const int q0 = qblk * 128, qw0 = q0 + 32 * wid, tq = qw0 + lr;
    const size_t gq = (size_t)b * S + tq;
    const bf16_t *Qp, *Kp, *VTp; int ldk, ldv;
    if (MODE == AM_FOX)      { Qp = p.QF() + gq * 256 + head * 64; Kp = p.KF() + (size_t)b * S * 256 + head * 64; ldk = 256; VTp = p.VFT() + ((size_t)(b * 4 + head) * 64) * S; ldv = S; }
    else if (MODE == AM_DSA) { Qp = p.QA() + gq * 256 + head * 64; Kp = p.KAB() + (size_t)b * S * 256 + head * 64; ldk = 256; VTp = p.VAT() + ((size_t)(b * 4 + head) * 64) * S; ldv = S; }
    else if (MODE == AM_SB)  { Qp = p.QS() + gq * 256 + head * 64; Kp = p.KSB() + (size_t)b * S * 256 + head * 64; ldk = 256; VTp = p.VST() + ((size_t)(b * 4 + head) * 64) * S; ldv = S; }
    else if (MODE == AM_SLC) { Qp = p.QN() + gq * 256 + head * 64; Kp = p.KSLC() + (size_t)b * S * 64; ldk = 64; VTp = p.VSLCT() + ((size_t)b * 64) * S; ldv = S; }
    else if (MODE == AM_WIN) { Qp = p.QN() + gq * 256 + head * 64; Kp = p.KWIN() + (size_t)b * S * 64; ldk = 64; VTp = p.VWINT() + ((size_t)b * 64) * S; ldv = S; }
    else if (MODE == AM_CMP) { Qp = p.QN() + gq * 256 + head * 64; Kp = p.KCB() + (size_t)b * NCMP_PAD * 64; ldk = 64; VTp = p.VCT() + ((size_t)b * 64) * NCMP_PAD; ldv = NCMP_PAD; }
    else                     { Qp = p.QM() + gq * 256 + head * 64; Kp = p.MKB() + (size_t)b * NMEM * 256 + head * 64; ldk = 256; VTp = p.MVT() + ((size_t)(b * 4 + head) * 64) * NMEM; ldv = NMEM; }
    int kt_lo = 0, kt_hi = 2 * qblk + 2;
    if (MODE == AM_WIN) kt_lo = q0 >= 512 ? (q0 - 512) / 64 : 0;
    if (MODE == AM_MEM) kt_hi = NMEM / 64;
    if (MODE == AM_CMP) kt_hi = min(8, (((q0 + 96) >> 4) >> 6) + 1);
    const int nlim = (tq - 31) >> 4;
    const int ntile = kt_hi - kt_lo;
    constexpr bool REV = (MODE == AM_SB);

    bf16x8 qf[4];
#pragma unroll
    for (int s = 0; s < 4; ++s) qf[s] = *(const bf16x8*)(Qp + 16 * s + 8 * lh);
    unsigned smw[4] = {0u, 0u, 0u, 0u};
    if (MODE == AM_SLC) { const u32x4 w = *(const u32x4*)(p.SMASK() + gq * 4); smw[0] = w.x; smw[1] = w.y; smw[2] = w.z; smw[3] = w.w; }
    const unsigned long long* mrow = (const unsigned long long*)(p.DMASK() + gq * 256);
    const float* csp = p.CUMT() + (size_t)(b * 4 + head) * S;

    const int srow = tid >> 3, sc16 = tid & 7;
    const int st0 = srow * AK_ROW + sc16 * 16, st1 = (srow + 32) * AK_ROW + sc16 * 16;
    const bf16_t* kg0 = Kp + (size_t)srow * ldk + sc16 * 8;
    const bf16_t* kg1 = Kp + (size_t)(srow + 32) * ldk + sc16 * 8;
    const bf16_t* vg0 = VTp + (size_t)srow * ldv + sc16 * 8;
    const bf16_t* vg1 = VTp + (size_t)(srow + 32) * ldv + sc16 * 8;
    u32x4 rk0, rk1, rv0, rv1; float rcs = 0.f;
    auto gload = [&](int kt) {
        rk0 = *(const u32x4*)(kg0 + (size_t)kt * 64 * ldk); rk1 = *(const u32x4*)(kg1 + (size_t)kt * 64 * ldk);
        rv0 = *(const u32x4*)(vg0 + kt * 64); rv1 = *(const u32x4*)(vg1 + kt * 64);
        if (MODE == AM_FOX) { if (tid < 64) rcs = csp[kt * 64 + tid]; }
    };
    auto lstore = [&](char* buf) {
        *(u32x4*)(buf + st0) = rk0; *(u32x4*)(buf + st1) = rk1;
        *(u32x4*)(buf + AK_TILE + st0) = rv0; *(u32x4*)(buf + AK_TILE + st1) = rv1;
        if (MODE == AM_FOX) { if (tid < 64) *(float*)(buf + 2 * AK_TILE + tid * 4) = rcs; }
    };
    const int pil = (lr & 0x13) | ((lr & 4) << 1) | ((lr & 8) >> 1);
    const int rdk = pil * AK_ROW + lh * 16;
    const int rdv = AK_TILE + lr * AK_ROW + lh * 16;

    float m = NEG_INF, l = 0.f, R = 0.f;
    f32x16 O[2];
#pragma unroll
    for (int i = 0; i < 16; ++i) { O[0][i] = 0.f; O[1][i] = 0.f; }

    gload(REV ? kt_hi - 1 : kt_lo);
    __syncthreads();
    lstore(sm);
    __syncthreads();
#pragma unroll 1
    for (int it = 0; it < ntile; ++it) {
        const int kt = REV ? kt_hi - 1 - it : kt_lo + it;
        char* cur = sm + (it & 1) * ABUF;
        const bool more = (it + 1) < ntile;
        if (more) gload(REV ? kt - 1 : kt + 1);
        unsigned long long mw = 0ull;
        if (MODE == AM_DSA) mw = mrow[kt];
        bool need = true;
        if (MODE == AM_CMP) need = kt * 64 <= (qw0 >> 4);
        else if (MODE != AM_MEM) need = kt * 64 <= qw0 + 31;
        if (MODE == AM_WIN) need = need && (kt * 64 + 63 >= qw0 - 511);
        if (need) {
#pragma unroll
            for (int sb2 = 0; sb2 < 2; ++sb2) {
                const int sub = REV ? 1 - sb2 : sb2;
                const int kb = kt * 64 + sub * 32;
                bool sneed = true;
                if (MODE == AM_CMP) sneed = kb <= (qw0 >> 4);
                else if (MODE != AM_MEM) sneed = kb <= qw0 + 31;
                if (MODE == AM_WIN) sneed = sneed && (kb + 31 >= qw0 - 511);
                if (sneed) {
                    f32x16 s;
#pragma unroll
                    for (int i = 0; i < 16; ++i) s[i] = 0.f;
#pragma unroll
                    for (int s4 = 0; s4 < 4; ++s4) {
                        const bf16x8 kf = *(const bf16x8*)(cur + rdk + sub * 32 * AK_ROW + s4 * 32);
                        s = __builtin_amdgcn_mfma_f32_32x32x16_bf16(kf, qf[s4], s, 0, 0, 0);
                    }
                    const int thl = tq - kb - 8 * lh;
                    bf16x8 pf[2];
                    if (MODE == AM_SB) {
                        float lk[16];
#pragma unroll
                        for (int r = 0; r < 16; ++r) {
                            const int cr = 16 * (r >> 3) + (r & 7);
                            const float z = s[r] * 0.125f;
                            const float az = fabsf(z);
                            const float sp = fmaxf(z, 0.f) + __builtin_amdgcn_logf(1.f + __builtin_amdgcn_exp2f(-az * LOG2E)) * 0.6931471805599453f;
                            const bool ok = cr < thl;
                            lk[r] = ok ? -sp : 0.f;
                            s[r] = ok ? z : NEG_INF;
                        }
                        float g0 = 0.f, g1 = 0.f;
#pragma unroll
                        for (int r = 0; r < 8; ++r) { g0 += lk[r]; g1 += lk[8 + r]; }
                        const float pg0 = __shfl_xor(g0, 32, 64), pg1 = __shfl_xor(g1, 32, 64);
                        const float off0 = R + (lh == 0 ? (pg0 + g1 + pg1) : (pg1 + g1));
                        const float off1 = R + (lh == 0 ? pg1 : 0.f);
                        float run0 = off0, run1 = off1;
#pragma unroll
                        for (int r = 7; r >= 0; --r) {
                            const float a0 = __builtin_amdgcn_exp2f((s[r] + lk[r] + run0) * LOG2E); run0 += lk[r];
                            const float a1 = __builtin_amdgcn_exp2f((s[8 + r] + lk[8 + r] + run1) * LOG2E); run1 += lk[8 + r];
                            s[r] = a0; s[8 + r] = a1;
                        }
                        R += (g0 + g1) + (pg0 + pg1);
                    } else {
                        constexpr float c = 0.125f * LOG2E;
                        if (MODE == AM_FOX) {
                            const float4* cs4 = (const float4*)(cur + 2 * AK_TILE + (sub * 32 + 8 * lh) * 4);
                            const float4 c0 = cs4[0], c1 = cs4[1], c2 = cs4[4], c3 = cs4[5];
                            const float cv[16] = {c0.x, c0.y, c0.z, c0.w, c1.x, c1.y, c1.z, c1.w, c2.x, c2.y, c2.z, c2.w, c3.x, c3.y, c3.z, c3.w};
#pragma unroll
                            for (int r = 0; r < 16; ++r) s[r] = fmaf(s[r], c, -cv[r]);
                        } else {
#pragma unroll
                            for (int r = 0; r < 16; ++r) s[r] *= c;
                        }
                        if (MODE == AM_DSA) {
                            const unsigned w = (unsigned)(mw >> (32 * sub)) >> (8 * lh);
#pragma unroll
                            for (int r = 0; r < 16; ++r) { const int cr = 16 * (r >> 3) + (r & 7); s[r] = (w & (1u << cr)) ? s[r] : NEG_INF; }
                        }
                        if (MODE == AM_SLC) {
                            const unsigned w = smw[0] * (kt < 32) + smw[1] * (kt >= 32 && kt < 64) + smw[2] * (kt >= 64 && kt < 96) + smw[3] * (kt >= 96);
                            const bool sel = (w >> (kt & 31)) & 1u;
#pragma unroll
                            for (int r = 0; r < 16; ++r) s[r] = sel ? s[r] : NEG_INF;
                        }
                        if (MODE == AM_FOX || MODE == AM_SLC) {
                            if (kb + 31 > qw0) {
#pragma unroll
                                for (int r = 0; r < 16; ++r) { const int cr = 16 * (r >> 3) + (r & 7); s[r] = (cr <= thl) ? s[r] : NEG_INF; }
                            }
                        }
                        if (MODE == AM_CMP) {
                            const int tc = nlim - kb - 8 * lh;
#pragma unroll
                            for (int r = 0; r < 16; ++r) { const int cr = 16 * (r >> 3) + (r & 7); s[r] = (cr <= tc) ? s[r] : NEG_INF; }
                        }
                        if (MODE == AM_WIN) {
                            if (kb + 31 > qw0 || kb < qw0 + 31 - 511) {
#pragma unroll
                                for (int r = 0; r < 16; ++r) { const int cr = 16 * (r >> 3) + (r & 7); s[r] = (cr <= thl && cr > thl - 512) ? s[r] : NEG_INF; }
                            }
                        }
                        float tmax = s[0];
#pragma unroll
                        for (int r = 1; r < 16; ++r) tmax = fmaxf(tmax, s[r]);
                        tmax = fmaxf(tmax, __shfl_xor(tmax, 32, 64));
                        const float mn = fmaxf(m, tmax);
                        const float mu = (mn == NEG_INF) ? 0.f : mn;
                        const float corr = __builtin_amdgcn_exp2f(m - mu);
                        m = mn;
                        float ls = 0.f;
#pragma unroll
                        for (int r = 0; r < 16; ++r) { s[r] = __builtin_amdgcn_exp2f(s[r] - mu); ls += s[r]; }
                        l = l * corr + ls;
                        if (!__all(corr == 1.0f)) {
#pragma unroll
                            for (int i = 0; i < 16; ++i) { O[0][i] *= corr; O[1][i] *= corr; }
                        }
                    }
                    {
                        u32x4 w0, w1;
                        w0.x = cvt_pk_bf16(s[0], s[1]); w0.y = cvt_pk_bf16(s[2], s[3]); w0.z = cvt_pk_bf16(s[4], s[5]); w0.w = cvt_pk_bf16(s[6], s[7]);
                        w1.x = cvt_pk_bf16(s[8], s[9]); w1.y = cvt_pk_bf16(s[10], s[11]); w1.z = cvt_pk_bf16(s[12], s[13]); w1.w = cvt_pk_bf16(s[14], s[15]);
                        pf[0] = __builtin_bit_cast(bf16x8, w0); pf[1] = __builtin_bit_cast(bf16x8, w1);
                    }
#pragma unroll
                    for (int s2 = 0; s2 < 2; ++s2)
#pragma unroll
                        for (int dt = 0; dt < 2; ++dt) {
                            const bf16x8 vf = *(const bf16x8*)(cur + rdv + dt * 32 * AK_ROW + sub * 64 + s2 * 32);
                            O[dt] = __builtin_amdgcn_mfma_f32_32x32x16_bf16(vf, pf[s2], O[dt], 0, 0, 0);
                        }
                }
            }
        }
        if (more) lstore(sm + ((it + 1) & 1) * ABUF);
        __syncthreads();
    }
    float inv = 1.f;
    if (MODE != AM_SB) { const float lt = l + __shfl_xor(l, 32, 64); inv = 1.f / fmaxf(lt, 1e-30f); }
    if (MODE == AM_SLC || MODE == AM_WIN || MODE == AM_CMP) {
        const float gs = (MODE == AM_CMP) ? inv : p.GN()[gq * 12 + (MODE == AM_SLC ? 4 : 8) + head] * inv;
        float* dst = (MODE == AM_SLC ? p.OSLC() : MODE == AM_WIN ? p.OWIN() : p.OCMP()) + gq * 256 + head * 64;
#pragma unroll
        for (int dt = 0; dt < 2; ++dt)
#pragma unroll
            for (int g = 0; g < 4; ++g) {
                float4 o; o.x = O[dt][4 * g] * gs; o.y = O[dt][4 * g + 1] * gs; o.z = O[dt][4 * g + 2] * gs; o.w = O[dt][4 * g + 3] * gs;
                *(float4*)(dst + 32 * dt + 8 * g + 4 * lh) = o;
            }
    } else {
        const int yc = MODE == AM_FOX ? 256 : MODE == AM_DSA ? 0 : MODE == AM_SB ? 512 : 1024;
        const bf16_t* zp = p.ZG() + gq * 1280 + yc + head * 64;
        bf16_t* dst = p.Y() + gq * 1280 + yc + head * 64;
#pragma unroll
        for (int dt = 0; dt < 2; ++dt)
#pragma unroll
            for (int g = 0; g < 4; ++g) {
                const int d0 = 32 * dt + 8 * g + 4 * lh;
                const u32x2 z = *(const u32x2*)(zp + d0);
                u32x2 o;
                o.x = cvt_pk_bf16(O[dt][4 * g] * inv * __uint_as_float(z.x << 16), O[dt][4 * g + 1] * inv * __uint_as_float(z.x & 0xffff0000u));
                o.y = cvt_pk_bf16(O[dt][4 * g + 2] * inv * __uint_as_float(z.y << 16), O[dt][4 * g + 3] * inv * __uint_as_float(z.y & 0xffff0000u));
                *(u32x2*)(dst + d0) = o;
            }
    }
}

__device__ __forceinline__ unsigned sortable_key(float x) { const unsigned u = __float_as_uint(x + 0.0f); return (u & 0x80000000u) ? ~u : (u | 0x80000000u); }
#ifndef DIAG
#define DIAG 0
#endif
#if DIAG
#define UNIT_ATTR
#else
#define UNIT_ATTR
#endif
UNIT_ATTR __device__ __forceinline__ void dsa_select_unit(const Params& p, int b, int qt, char* sm) {
    const int tid = tidx(), lane = tid & 63, wid = __builtin_amdgcn_readfirstlane(tid >> 6), lr = lane & 31, lh = lane >> 5;
    unsigned* hist = (unsigned*)sm;
    unsigned char* tcnt = (unsigned char*)sm;
    unsigned short* tbase = (unsigned short*)(sm + 8192);
    unsigned* st_prefix = (unsigned*)(sm + 32 * 257 * 4);
    int* st_krem = (int*)(st_prefix + 32);
    int* st_ties = st_krem + 32;
    int* st_flag = st_ties + 32;
    const int q0 = qt * 32, tq = q0 + lr, ntile = qt + 1;
    const size_t gq = (size_t)b * S + tq;
    const bool small = tq + 1 <= 256;
    bf16x8 qf[4][2];
    float w[4];
#pragma unroll
    for (int h = 0; h < 4; ++h) {
        qf[h][0] = *(const bf16x8*)(p.QI() + gq * 128 + h * 32 + 8 * lh);
        qf[h][1] = *(const bf16x8*)(p.QI() + gq * 128 + h * 32 + 16 + 8 * lh);
        w[h] = p.WI()[gq * 4 + h];
    }
    const bf16_t* kbase = p.KI() + (size_t)b * S * 32 + (size_t)lr * 32 + 8 * lh;
    auto score_tile = [&](int kt, unsigned (&key)[16]) {
        const bf16x8 k0 = *(const bf16x8*)(kbase + (size_t)kt * 32 * 32), k1 = *(const bf16x8*)(kbase + (size_t)kt * 32 * 32 + 16);
        float sc[16];
#pragma unroll
        for (int r = 0; r < 16; ++r) sc[r] = 0.f;
#pragma unroll
        for (int h = 0; h < 4; ++h) {
            f32x16 a;
#pragma unroll
            for (int r = 0; r < 16; ++r) a[r] = 0.f;
            a = __builtin_amdgcn_mfma_f32_32x32x16_bf16(k0, qf[h][0], a, 0, 0, 0);
            a = __builtin_amdgcn_mfma_f32_32x32x16_bf16(k1, qf[h][1], a, 0, 0, 0);
#pragma unroll
            for (int r = 0; r < 16; ++r) sc[r] = fmaf(fmaxf(a[r], 0.f), w[h], sc[r]);
            __builtin_amdgcn_sched_barrier(0);
        }
#pragma unroll
        for (int r = 0; r < 16; ++r) key[r] = sortable_key(sc[r]);
    };
    unsigned prefix = 0u;
#pragma unroll 1
    for (int pass = 0; pass < 4; ++pass) {
        const int shift = 24 - 8 * pass;
        __syncthreads();
        for (int i = tid; i < 32 * 257; i += 256) hist[i] = 0u;
        __syncthreads();
#pragma unroll 1
        for (int kt = wid; kt < ntile; kt += 4) {
            unsigned key[16];
            score_tile(kt, key);
            const int vlim = (kt == qt) ? lr : 64;
#pragma unroll
            for (int r = 0; r < 16; ++r) {
                const int rho = (r & 3) + 8 * (r >> 2) + 4 * lh;
                const bool match = (pass == 0) || ((key[r] >> (shift + 8)) == prefix);
                if (rho <= vlim && match) atomicAdd(&hist[lr * 257 + ((key[r] >> shift) & 255u)], 1u);
            }
        }
        __syncthreads();
        if (tid < 32) {
            const int tqq = q0 + tid;
            if (tqq + 1 <= 256) { if (pass == 0) { st_prefix[tid] = 0u; st_krem[tid] = 1 << 30; st_ties[tid] = 0; } }
            else {
                int krem = (pass == 0) ? 256 : st_krem[tid];
                unsigned cum = 0u; int bin = 255;
                for (; bin > 0; --bin) { const unsigned c = hist[tid * 257 + bin]; if (cum + c >= (unsigned)krem) break; cum += c; }
                st_prefix[tid] = ((pass == 0 ? 0u : st_prefix[tid]) << 8) | (unsigned)bin;
                st_krem[tid] = krem - (int)cum;
                st_ties[tid] = (int)hist[tid * 257 + bin];
            }
        }
        __syncthreads();
        prefix = st_prefix[lr];
    }
    const unsigned thr = prefix;
    const int need = st_krem[lr];
    if (tid == 0) st_flag[0] = 0;
    __syncthreads();
    if (!small && st_ties[lr] > need) st_flag[0] = 1;
    __syncthreads();
    const bool tiepass = st_flag[0] != 0;
    if (tiepass) {
#pragma unroll 1
        for (int kt = wid; kt < ntile; kt += 4) {
            unsigned key[16];
            score_tile(kt, key);
            const int vlim = (kt == qt) ? lr : 64;
            int c = 0;
#pragma unroll
            for (int r = 0; r < 16; ++r) { const int rho = (r & 3) + 8 * (r >> 2) + 4 * lh; c += (rho <= vlim && key[r] == thr) ? 1 : 0; }
            c += __shfl_xor(c, 32, 64);
            if (lh == 0) tcnt[lr * 256 + kt] = (unsigned char)c;
        }
        __syncthreads();
        if (tid < 32) { int run = 0; for (int kt = 0; kt < ntile; ++kt) { tbase[tid * 256 + kt] = (unsigned short)run; run += tcnt[tid * 256 + kt]; } }
        __syncthreads();
    }
    unsigned* mrow = p.DMASK() + gq * 256;
#pragma unroll 1
    for (int kt = wid; kt < 256; kt += 4) {
        unsigned word = 0u;
        if (kt < ntile) {
            unsigned key[16];
            score_tile(kt, key);
            const int vlim = (kt == qt) ? lr : 64;
            unsigned gt = 0u, tie = 0u;
#pragma unroll
            for (int r = 0; r < 16; ++r) {
                const int rho = (r & 3) + 8 * (r >> 2) + 4 * lh;
                if (rho <= vlim) { gt |= (key[r] > thr) ? (1u << rho) : 0u; tie |= (key[r] == thr) ? (1u << rho) : 0u; }
            }
            gt |= __shfl_xor(gt, 32, 64); tie |= __shfl_xor(tie, 32, 64);
            if (tiepass && !small) {
                int allow = need - (int)tbase[lr * 256 + kt];
                if (allow <= 0) tie = 0u;
                else if (allow < __builtin_popcount(tie)) { unsigned wv = tie, kept = 0u; for (int i = 0; i < allow; ++i) { const unsigned low = wv & (0u - wv); kept |= low; wv ^= low; } tie = kept; }
            }
            word = gt | tie;
        }
        if (lh == 0) mrow[kt] = word;
    }
    __syncthreads();
}

__device__ __forceinline__ bool imp_better(float v1, int i1, float v2, int i2) { return (v1 > v2) || (v1 == v2 && i1 < i2); }
UNIT_ATTR __device__ __forceinline__ void nsa_select_unit(const Params& p, int b, int q0w, char* sm) {
    const int lane = tidx() & 63, lr = lane & 31, lh = lane >> 5;
    const int tq = q0w + lr;
    const size_t gq = (size_t)b * S + tq;
    const int nlim = (tq - 31) >> 4;
    const int nst = min(16, ((((q0w + 31 - 31) >> 4)) >> 5) + 1);
    const int pil = (lr & 0x13) | ((lr & 4) << 1) | ((lr & 8) >> 1);
    const bf16_t* kc = p.KCB() + (size_t)b * NCMP_PAD * 64 + (size_t)pil * 64 + 8 * lh;
    constexpr float c = 0.125f * LOG2E;
    float mh[4], il[4];
#pragma unroll
    for (int h = 0; h < 4; ++h) {
        bf16x8 qf[4];
#pragma unroll
        for (int s = 0; s < 4; ++s) qf[s] = *(const bf16x8*)(p.QN() + gq * 256 + h * 64 + 16 * s + 8 * lh);
        float m = NEG_INF, l = 0.f;
#pragma unroll 1
        for (int st = 0; st < nst; ++st) {
            f32x16 s;
#pragma unroll
            for (int i = 0; i < 16; ++i) s[i] = 0.f;
#pragma unroll
            for (int s4 = 0; s4 < 4; ++s4) { const bf16x8 kf = *(const bf16x8*)(kc + (size_t)st * 32 * 64 + s4 * 16); s = __builtin_amdgcn_mfma_f32_32x32x16_bf16(kf, qf[s4], s, 0, 0, 0); }
            const int thl = nlim - st * 32 - 8 * lh;
            float tmax = NEG_INF;
#pragma unroll
            for (int r = 0; r < 16; ++r) { const int cr = 16 * (r >> 3) + (r & 7); s[r] = (cr <= thl) ? s[r] * c : NEG_INF; tmax = fmaxf(tmax, s[r]); }
            tmax = fmaxf(tmax, __shfl_xor(tmax, 32, 64));
            const float mn = fmaxf(m, tmax), mu = (mn == NEG_INF) ? 0.f : mn;
            float ls = 0.f;
#pragma unroll
            for (int r = 0; r < 16; ++r) ls += __builtin_amdgcn_exp2f(s[r] - mu);
            l = l * __builtin_amdgcn_exp2f(m - mu) + ls; m = mn;
        }
        l += __shfl_xor(l, 32, 64);
        mh[h] = (m == NEG_INF) ? 0.f : m; il[h] = 1.f / fmaxf(l, 1e-30f);
    }
    float val[16]; int idx[16];
#pragma unroll
    for (int i = 0; i < 16; ++i) { val[i] = NEG_INF; idx[i] = 1 << 20; }
    const int cur = tq >> 6;
#pragma unroll 1
    for (int st = 0; st < 16; ++st) {
        float bs[4] = {0.f, 0.f, 0.f, 0.f};
        if (st < nst) {
            const int thl = nlim - st * 32 - 8 * lh;
#pragma unroll
            for (int h = 0; h < 4; ++h) {
                f32x16 s;
#pragma unroll
                for (int i = 0; i < 16; ++i) s[i] = 0.f;
#pragma unroll
                for (int s4 = 0; s4 < 4; ++s4) {
                    const bf16x8 kf = *(const bf16x8*)(kc + (size_t)st * 32 * 64 + s4 * 16);
                    const bf16x8 qfr = *(const bf16x8*)(p.QN() + gq * 256 + h * 64 + 16 * s4 + 8 * lh);
                    s = __builtin_amdgcn_mfma_f32_32x32x16_bf16(kf, qfr, s, 0, 0, 0);
                }
#pragma unroll
                for (int r = 0; r < 16; ++r) {
                    const int cr = 16 * (r >> 3) + (r & 7);
                    const float pr = (cr <= thl) ? __builtin_amdgcn_exp2f(s[r] * c - mh[h]) * il[h] : 0.f;
                    bs[r >> 2] += pr;
                }
                __builtin_amdgcn_sched_barrier(0);
            }
        }
#pragma unroll
        for (int g = 0; g < 4; ++g) {
            const int j = st * 8 + 4 * (g >> 1) + 2 * lh + (g & 1);
            const bool forced = (j == 0) || (j == cur) || (j == cur - 1);
            float v = forced ? 1e4f : ((j <= cur) ? bs[g] : -1.0f);
            int jj = j;
            if (__any(imp_better(v, jj, val[15], idx[15]))) {
#pragma unroll
                for (int i = 0; i < 16; ++i) {
                    const bool bt = imp_better(v, jj, val[i], idx[i]);
                    const float tv = bt ? val[i] : v; const int ti = bt ? idx[i] : jj;
                    val[i] = bt ? v : val[i]; idx[i] = bt ? jj : idx[i];
                    v = tv; jj = ti;
                }
            }
        }
    }
    {
        float* lv = (float*)(sm + (tidx() >> 6) * 8192);
        int* li = (int*)(lv + 1024);
#pragma unroll
        for (int i = 0; i < 16; ++i) { lv[i * 64 + lane] = val[i]; li[i * 64 + lane] = idx[i]; }
        __builtin_amdgcn_wave_barrier();
#pragma unroll 1
        for (int k = 0; k < 16; ++k) {
            float v = lv[k * 64 + (lane ^ 32)]; int jj = li[k * 64 + (lane ^ 32)];
#pragma unroll
            for (int i = 0; i < 16; ++i) {
                const bool bt = imp_better(v, jj, val[i], idx[i]);
                const float tv = bt ? val[i] : v; const int ti = bt ? idx[i] : jj;
                val[i] = bt ? v : val[i]; idx[i] = bt ? jj : idx[i];
                v = tv; jj = ti;
            }
        }
        __builtin_amdgcn_wave_barrier();
    }
    unsigned m0 = 0u, m1 = 0u, m2 = 0u, m3 = 0u;
#pragma unroll
    for (int i = 0; i < 16; ++i) {
        const unsigned bit = 1u << (idx[i] & 31); const int wsel = idx[i] >> 5;
        m0 |= (wsel == 0) ? bit : 0u; m1 |= (wsel == 1) ? bit : 0u; m2 |= (wsel == 2) ? bit : 0u; m3 |= (wsel == 3) ? bit : 0u;
    }
    if (lh == 0) { u32x4 o; o.x = m0; o.y = m1; o.z = m2; o.w = m3; *(u32x4*)(p.SMASK() + gq * 4) = o; }
}

template <class BAR>
__device__ __forceinline__ void ph_work(const Params& p, int layer, char* sm, const BAR& barrier) {
    __shared__ int s_unit;
#pragma unroll 1
    for (int stage = 0; stage < 2; ++stage) {
        unsigned* ctr = p.qctr() + 64 * layer + 32 * stage;
        const int total = stage == 0 ? 3200 : 1024;
        for (;;) {
            __syncthreads();
            if (threadIdx.x == 0) s_unit = (int)atomicAdd(ctr, 1u);
            __syncthreads();
            const int u = __builtin_amdgcn_readfirstlane(s_unit);
            if (u >= total) break;
            int kind, b, h = 0, q;
            if (stage == 1) { const int r = u & 15; kind = 2 + ((r >> 3) ? AM_SLC : AM_DSA); q = 63 - (u >> 4); b = (r >> 2) & 1; h = r & 3; }
            else if (u < 512) { kind = 0; q = 255 - (u >> 1); b = u & 1; }
            else if (u < 640) { kind = 1; const int v = u - 512; b = v & 1; q = v >> 1; }
            else if (u < 1664) { const int v = u - 640, r = v & 15; kind = 2 + ((r >> 3) ? AM_FOX : AM_SB); q = 63 - (v >> 4); b = (r >> 2) & 1; h = r & 3; }
            else { const int v = u - 1664, br = v >> 9, w = v & 511; kind = 2 + (br == 0 ? AM_WIN : br == 1 ? AM_CMP : AM_MEM); q = w >> 3; b = (w >> 2) & 1; h = w & 3; }
            if (kind == 0) dsa_select_unit(p, b, q, sm);
            else if (kind == 1) nsa_select_unit(p, b, q * 128 + 32 * __builtin_amdgcn_readfirstlane(tidx() >> 6), sm);
            else if (kind == 2 + AM_SB) attn_unit<AM_SB>(p, b, h, q, sm);
            else if (kind == 2 + AM_FOX) attn_unit<AM_FOX>(p, b, h, q, sm);
            else if (kind == 2 + AM_DSA) attn_unit<AM_DSA>(p, b, h, q, sm);
            else if (kind == 2 + AM_SLC) attn_unit<AM_SLC>(p, b, h, q, sm);
            else if (kind == 2 + AM_WIN) attn_unit<AM_WIN>(p, b, h, q, sm);
            else if (kind == 2 + AM_CMP) attn_unit<AM_CMP>(p, b, h, q, sm);
            else attn_unit<AM_MEM>(p, b, h, q, sm);
        }
        barrier(stage);
    }
}

__device__ __forceinline__ void ph_nsa_combine(const Params& p, int bid, int nb) {
    for (size_t i = (size_t)bid * 256 + tidx(); i < (size_t)T * 64; i += (size_t)nb * 256) {
        const size_t g = i >> 6; const int c = (int)(i & 63) * 4, h = c >> 6;
        const float g0 = p.GN()[g * 12 + h];
        const float4 a = *(const float4*)(p.OCMP() + g * 256 + c), s = *(const float4*)(p.OSLC() + g * 256 + c), w = *(const float4*)(p.OWIN() + g * 256 + c);
        const u32x2 z = *(const u32x2*)(p.ZG() + g * 1280 + 768 + c);
        u32x2 o;
        o.x = cvt_pk_bf16((g0 * a.x + s.x + w.x) * __uint_as_float(z.x << 16), (g0 * a.y + s.y + w.y) * __uint_as_float(z.x & 0xffff0000u));
        o.y = cvt_pk_bf16((g0 * a.z + s.z + w.z) * __uint_as_float(z.y << 16), (g0 * a.w + s.w + w.w) * __uint_as_float(z.y & 0xffff0000u));
        *(u32x2*)(p.Y() + g * 1280 + 768 + c) = o;
    }
}

__device__ __forceinline__ void ph_setup_misc(const Params& p, int bid, int nb) {
    const int lane = tidx() & 63, gw = bid * 4 + (tidx() >> 6);
    for (int o = gw; o < DEPTH * 2 * 128; o += nb * 4) {
        const int l = o >> 8, which = (o >> 7) & 1, j = o & 127;
        const float* pe = (which ? p.pe_v : p.pe_k) + (size_t)l * 2048;
        const float* w1 = (which ? p.wc1_v : p.wc1_k) + (size_t)l * 2048 * 128;
        float a = 0.f;
        for (int k = lane; k < 2048; k += 64) a = fmaf(pe[k], w1[(size_t)k * 128 + j], a);
        a = wave_sum(a);
        if (lane == 0) p.BIASC()[o] = a;
    }
    for (int i = bid * 256 + tidx(); i < 2048; i += nb * 256) { p.KCT()[(size_t)T * 64 + i] = 0; p.VCTOK()[(size_t)T * 64 + i] = 0; }
    for (int i = bid * 256 + tidx(); i < 12 * D; i += nb * 256) p.WIN()[(size_t)(M_SPC + 52) * D + i] = 0;
}

#define XB_TMO      128
#define XB_XCNT(j)  (256  + 64 * (j))
#define XB_XSUB(j)  (1280 + 64 * (j))
#define XB_XGEN(j)  (2304 + 64 * (j))
#define XB_TOP      3328
#define XB_TOPGEN   3392
#define XCD_BAR_WORDS 3456
#define XB_SPIN_CAP (1u << 18)
#define LAS __attribute__((address_space(3)))

__device__ __forceinline__ unsigned xb_ld(unsigned* p)              { return __hip_atomic_load(p, __ATOMIC_RELAXED, __HIP_MEMORY_SCOPE_AGENT); }
__device__ __forceinline__ unsigned xb_add(unsigned* p, unsigned v) { return __hip_atomic_fetch_add(p, v, __ATOMIC_RELAXED, __HIP_MEMORY_SCOPE_AGENT); }
__device__ __forceinline__ unsigned xb_xcc_id() { return (unsigned)__builtin_amdgcn_s_getreg((3 << 11) | 20) & 0xFu; }
#define XB_SPIN(cond, bar) do { unsigned _sp = 0; while (cond) { __builtin_amdgcn_s_sleep(1); \
    if ((++_sp & 255u) == 0u) { if (xb_ld(&(bar)[XB_TMO])) break; if (_sp > XB_SPIN_CAP) { atomicAdd(&(bar)[XB_TMO], 1u); break; } } } } while (0)

struct XcdBarrier {
    unsigned* bar; unsigned x;
    volatile LAS unsigned* st;
};
__device__ __forceinline__ XcdBarrier xcd_barrier_post(unsigned* bar, volatile LAS unsigned* st) {
    XcdBarrier b; b.bar = bar; b.x = xb_xcc_id(); b.st = st;
    if (threadIdx.x == 0) (void)xb_add(&bar[XB_XCNT(b.x)], 1u);
    return b;
}
__device__ __forceinline__ void xcd_barrier_complete(unsigned* bar, unsigned x, unsigned& nloc, unsigned& nx) {
    const unsigned G = gridDim.x * gridDim.y * gridDim.z;
    unsigned sum, cnt, mine, sp = 0u;
    for (;;) {
        sum = 0u; cnt = 0u; mine = 0u;
#pragma unroll
        for (unsigned j = 0; j < 16; ++j) { const unsigned c = xb_ld(&bar[XB_XCNT(j)]); sum += c; cnt += (c > 0u) ? 1u : 0u; mine = (j == x) ? c : mine; }
        if (sum == G) break;
        __builtin_amdgcn_s_sleep(1);
        if ((++sp & 255u) == 0u) { if (xb_ld(&bar[XB_TMO])) break; if (sp > XB_SPIN_CAP) { atomicAdd(&bar[XB_TMO], 1u); break; } }
    }
    nloc = mine > 0u ? mine : 1u; nx = cnt > 0u ? cnt : 1u;
}
__device__ __attribute__((noinline)) void xcd_barrier_impl(unsigned* b_bar, unsigned b_x, volatile LAS unsigned* b_st) {
    XcdBarrier b; b.bar = b_bar; b.x = b_x; b.st = b_st;
    asm volatile("s_waitcnt vmcnt(0)" ::: "memory");
    __syncthreads();
    if (threadIdx.x == 0) {
        unsigned* bar = b.bar;
        __builtin_amdgcn_s_waitcnt(0);
        unsigned nloc = b.st[0], nx = b.st[1];
        if (nloc == 0u) { xcd_barrier_complete(bar, b.x, nloc, nx); b.st[0] = nloc; b.st[1] = nx; }
        const unsigned old = xb_add(&bar[XB_XSUB(b.x)], 1u);
        const unsigned gen = old / nloc;
        if (old + 1u == (gen + 1u) * nloc) {
            __builtin_amdgcn_fence(__ATOMIC_RELEASE, "agent");
            asm volatile("s_waitcnt vmcnt(0)" ::: "memory");
            const unsigned og = xb_add(&bar[XB_TOP], 1u);
            const unsigned tg = og / nx;
            if (og + 1u == (tg + 1u) * nx) xb_add(&bar[XB_TOPGEN], 1u);
            else XB_SPIN(xb_ld(&bar[XB_TOPGEN]) == tg, bar);
            __builtin_amdgcn_fence(__ATOMIC_ACQUIRE, "agent");
            xb_add(&bar[XB_XGEN(b.x)], 1u);
            asm volatile("s_waitcnt vmcnt(0)" ::: "memory");
        } else {
            XB_SPIN(xb_ld(&bar[XB_XGEN(b.x)]) == gen, bar);
            __builtin_amdgcn_fence(__ATOMIC_ACQUIRE, "agent");
            asm volatile("s_waitcnt vmcnt(0)" ::: "memory");
        }
    }
    __syncthreads();
}
__device__ __forceinline__ void xcd_barrier(const XcdBarrier& b) { xcd_barrier_impl(b.bar, b.x, b.st); }

#ifndef DIAG
#define DIAG 0
#endif
#ifndef DIAG_A
#define DIAG_A 8
#define DIAG_B 7
#endif
#if DIAG
#define STAMP(k) do { if (((k) == DIAG_A || (k) == DIAG_B || (k) + 1 == DIAG_A || (k) + 1 == DIAG_B || (k) == 0 || (k) == 11) && blockIdx.x == 0 && threadIdx.x == 0) { const unsigned long long t_ = wall_clock64(); dg[k] += t_ - dg[15]; dg[15] = t_; } } while (0)
#else
#define STAMP(k) do { } while (0)
#endif
__global__ void __launch_bounds__(256, 2) mega(Params p) {
    __shared__ __attribute__((aligned(16))) char smem[40960];
    __shared__ uint4 xb_words;
    if (threadIdx.x == 0) xb_words = make_uint4(0u, 0u, 0u, 0u);
    __syncthreads();
    XcdBarrier bar = xcd_barrier_post(p.bar(), (volatile LAS unsigned*)&xb_words);
    const int bid = blockIdx.x, nb = gridDim.x;
    float* smf = (float*)smem;
#if DIAG
    __shared__ unsigned long long dg[16];
    if (threadIdx.x == 0) { for (int i = 0; i < 15; ++i) dg[i] = 0; dg[15] = wall_clock64(); }
#endif

    convert_wt(p.w_branch, p.WBR(), 256, D, DEPTH * 5, bid, nb, smf);
    convert_wt(p.w_out, p.WOUT(), D, D, DEPTH, bid, nb, smf);
    convert_wt(p.w_mem_kv, p.WMKV(), D, 512, DEPTH, bid, nb, smf);
    convert_wt(p.w_uk, p.WUK(), 128, 256, DEPTH, bid, nb, smf);
    convert_wt(p.w_uv, p.WUV(), 128, 256, DEPTH, bid, nb, smf);
    for (int l = 0; l < DEPTH; ++l) {
        convert_wt(p.wc1_k + (size_t)l * 2048 * 128, p.WC1T() + (size_t)(l * 2 + 0) * 128 * 2048, 2048, 128, 1, bid, nb, smf);
        convert_wt(p.wc1_v + (size_t)l * 2048 * 128, p.WC1T() + (size_t)(l * 2 + 1) * 128 * 2048, 2048, 128, 1, bid, nb, smf);
        convert_wt(p.wc2_k + (size_t)l * 128 * 64, p.WC2T() + (size_t)(l * 2 + 0) * 64 * 128, 128, 64, 1, bid, nb, smf);
        convert_wt(p.wc2_v + (size_t)l * 128 * 64, p.WC2T() + (size_t)(l * 2 + 1) * 64 * 128, 128, 64, 1, bid, nb, smf);
    }
    ph_setup_misc(p, bid, nb);
    ph_rope_table(p, bid, nb);
    STAMP(0);
    for (int l = 0; l < DEPTH; ++l) {
        const float* Xin = l == 0 ? p.x : p.X;
        convert_wt<true>(p.w_in + (size_t)l * D * NIN, p.WIN(), D, NIN, 1, bid, nb, smf);
        ph_rmsnorm<bf16_t>(Xin, p.norm_g + l * D, p.H(), T, bid, nb);
        ph_rmsnorm<bf16_t>(p.mem, p.mem_norm + l * D, p.MEMN(), NBATCH * NMEM, bid, nb);
        xcd_barrier(bar); STAMP(1);
        { EpiInProj e{p, l}; gemm_bf16<128>(p.H(), D, p.WIN(), D, T, NPM, D, e, bid, nb, smem); }
        { EpiMemKV e{p}; gemm_bf16<128>(p.MEMN(), D, p.WMKV() + (size_t)l * 512 * D, D, NBATCH * NMEM, 512, D, e, bid, nb, smem); }
        xcd_barrier(bar); STAMP(2);
        ph_ckvnorm(p, l, bid, nb);
        ph_cumsum(p, bid, nb, smf);
        { EpiCmp1 e{p.BIASC() + (l * 2 + 0) * 128, p.HIDK()}; gemm_bf16<64>(p.KCT(), 1024, p.WC1T() + (size_t)(l * 2 + 0) * 128 * 2048, 2048, 1024, 128, 2048, e, bid, nb, smem); }
        { EpiCmp1 e{p.BIASC() + (l * 2 + 1) * 128, p.HIDV()}; gemm_bf16<64>(p.VCTOK(), 1024, p.WC1T() + (size_t)(l * 2 + 1) * 128 * 2048, 2048, 1024, 128, 2048, e, bid, nb, smem); }
        xcd_barrier(bar); STAMP(3);
        { EpiKA e{p}; gemm_bf16<128>(p.CKV(), 128, p.WUK() + (size_t)l * 256 * 128, 128, T, 256, 128, e, bid, nb, smem); }
        { EpiVA e{p}; gemm_bf16<128>(p.CKV(), 128, p.WUV() + (size_t)l * 256 * 128, 128, T, 256, 128, e, bid, nb, smem); }
        { EpiCmp2K e{p.KCB()}; gemm_bf16<64>(p.HIDK(), 128, p.WC2T() + (size_t)(l * 2 + 0) * 64 * 128, 128, 1024, 64, 128, e, bid, nb, smem); }
        { EpiCmp2V e{p.VCT()}; gemm_bf16<64>(p.HIDV(), 128, p.WC2T() + (size_t)(l * 2 + 1) * 64 * 128, 128, 1024, 64, 128, e, bid, nb, smem); }
        xcd_barrier(bar); STAMP(4);
        ph_work(p, l, smem, [&](int stage) { xcd_barrier(bar); if (stage == 0) { STAMP(7); } else { STAMP(8); } });
        ph_nsa_combine(p, bid, nb);
        xcd_barrier(bar); STAMP(9);
        ph_merge(p, l, bid, nb, smem);
        xcd_barrier(bar); STAMP(10);
        { EpiResid e{Xin, p.X}; gemm_bf16<128>(p.MG(), D, p.WOUT() + (size_t)l * D * D, D, T, D, D, e, bid, nb, smem); }
        xcd_barrier(bar); STAMP(11);
    }
#if DIAG
    {
        float* dgw = (float*)(p.bar() + 4096 + 512);
        if (blockIdx.x == 0 && threadIdx.x == 0) {
            unsigned long long tot = 0; for (int i = 0; i < 15; ++i) tot += dg[i];
            dgw[0] = rintf(40.f * (float)((double)dg[DIAG_A] / (double)tot)) / 40.f; dgw[1] = rintf(40.f * (float)((double)dg[DIAG_B] / (double)tot)) / 40.f;
        }
        ph_rmsnorm<float>(p.X, p.final_norm, p.X, T, bid, nb);
        xcd_barrier(bar);
        {
            const float fa = 1.0f + dgw[0];
            float4* xp = (float4*)p.X;
#pragma unroll 1
            for (int i = bid * 256 + threadIdx.x; i < T * D / 4; i += nb * 256) { float4 v = xp[i]; v.x *= fa; v.y *= fa; v.z *= fa; v.w *= fa; xp[i] = v; }
        }
        xcd_barrier(bar);
        if (blockIdx.x == 0 && threadIdx.x == 0) p.X[0] += 100.f * dgw[1];
    }
#else
    ph_rmsnorm<float>(p.X, p.final_norm, p.X, T, bid, nb);
#endif
}
}

extern "C" void kernel_launch(void* const* d_in, const int* in_sizes, int n_in, void* d_out, int out_size, void* d_ws, size_t ws_size, hipStream_t stream) {
    (void)in_sizes; (void)n_in; (void)out_size;
    Params p{};
    p.x = (const float*)d_in[0]; p.mem = (const float*)d_in[1]; p.pos = (const int*)d_in[2]; p.norm_g = (const float*)d_in[3];
    p.w_in = (const float*)d_in[4]; p.kv_norm = (const float*)d_in[5]; p.w_uk = (const float*)d_in[6]; p.w_uv = (const float*)d_in[7];
    p.fox_bias = (const float*)d_in[8]; p.pe_k = (const float*)d_in[9]; p.pe_v = (const float*)d_in[10]; p.wc1_k = (const float*)d_in[11];
    p.wc2_k = (const float*)d_in[12]; p.wc1_v = (const float*)d_in[13]; p.wc2_v = (const float*)d_in[14]; p.mem_norm = (const float*)d_in[15];
    p.w_mem_kv = (const float*)d_in[16]; p.w_branch = (const float*)d_in[17]; p.w_out = (const float*)d_in[18]; p.final_norm = (const float*)d_in[19];
    p.X = (float*)d_out;
    p.ws = (char*)d_ws;
    if (WS_TOTAL > ws_size) { fprintf(stderr, "kernel_launch: workspace too small (%zu > %zu)\n", (size_t)WS_TOTAL, ws_size); return; }

    static int grid = 0;
    if (grid == 0) {
        int dev = 0, cus = 0, per_cu = 0;
        hipGetDevice(&dev);
        hipDeviceGetAttribute(&cus, hipDeviceAttributeMultiprocessorCount, dev);
        hipOccupancyMaxActiveBlocksPerMultiprocessor(&per_cu, (const void*)mega, 256, 0);
        (void)hipGetLastError();
        if (per_cu < 1) per_cu = 1;
        grid = cus * (per_cu < 2 ? per_cu : 2);
    }
    hipMemsetAsync((char*)d_ws + OFF_bar, 0, (4096 + 64 * 8 + 64) * sizeof(unsigned), stream);
    hipLaunchKernelGGL(mega, dim3(grid), dim3(256), 0, stream, p);
}
```

```cpp
#include <hip/hip_runtime.h>
#include <stdint.h>
#include <math.h>
#include <cstdio>

namespace {
constexpr int S = 8192, NBATCH = 2, T = NBATCH * S, D = 1024, NIN = 9396, NM = 4276, DEPTH = 4, NMEM = 256;
constexpr int NCMP = 511, NCMP_PAD = 512;
constexpr int C_DSA_Q = 0, C_CKV = 256, C_IDXQ = 384, C_IDXK = 512, C_IDXW = 544, C_DSA_Z = 548,
              C_FOX_Q = 804, C_FOX_K = 1060, C_FOX_V = 1316, C_FOX_F = 1572, C_FOX_Z = 1576,
              C_SB_Q = 1832, C_SB_K = 2088, C_SB_V = 2344, C_SB_Z = 2600,
              C_NSA_Q = 2856, C_NSA_KC = 3112, C_NSA_VC = 3176, C_NSA_KS = 3240, C_NSA_VS = 3304, C_NSA_KW = 3368, C_NSA_VW = 3432,
              C_NSA_G = 3496, C_NSA_Z = 3508, C_MEM_Q = 3764, C_MEM_Z = 4020, C_MERGE = 4276;

typedef unsigned short bf16_t;
typedef short bf16x8 __attribute__((ext_vector_type(8)));
typedef float f32x16 __attribute__((ext_vector_type(16)));
typedef unsigned u32x4 __attribute__((ext_vector_type(4)));
typedef unsigned u32x2 __attribute__((ext_vector_type(2)));

constexpr int M_QA = 0, M_QN = 256, M_KSLC = 512, M_KWIN = 576, M_KC = 640, M_VC = 704, M_QF = 768, M_KF = 1024, M_QS = 1280, M_KSB = 1536, M_QM = 1792,
              M_VF = 2048, M_VS = 2304, M_VSLC = 2560, M_VWIN = 2624, M_QI = 2688, M_SPC = 2816, M_CKV = 2880, M_Z = 3008, M_MERGE = 4288, NPM = 4288, NP = 9408;
constexpr size_t al256(size_t x) { return (x + 255) & ~(size_t)255; }
constexpr size_t OFF_bar = 0;
constexpr size_t OFF_H = OFF_bar + al256((4096 + 64 * 8 + 64) * 4);
constexpr size_t OFF_Y = OFF_H + al256((size_t)T * D * 2);
constexpr size_t OFF_ZG = OFF_Y + al256((size_t)T * 1280 * 2);
constexpr size_t OFF_MG = OFF_ZG + al256((size_t)T * 1280 * 2);
constexpr size_t OFF_CKVR = OFF_MG + al256((size_t)T * D * 2);
constexpr size_t OFF_CKV = OFF_CKVR + al256((size_t)T * 128 * 4);
constexpr size_t OFF_OCMP = OFF_CKV + al256((size_t)T * 128 * 2);
constexpr size_t OFF_OSLC = OFF_OCMP + al256((size_t)T * 256 * 4);
constexpr size_t OFF_OWIN = OFF_OSLC + al256((size_t)T * 256 * 4);
constexpr size_t OFF_LOGF = OFF_OWIN + al256((size_t)T * 256 * 4);
constexpr size_t OFF_CUM = OFF_LOGF + al256((size_t)T * 4 * 4);
constexpr size_t OFF_CUMT = OFF_CUM + al256((size_t)T * 4 * 4);
constexpr size_t OFF_WI = OFF_CUMT + al256((size_t)T * 4 * 4);
constexpr size_t OFF_GN = OFF_WI + al256((size_t)T * 4 * 4);
constexpr size_t OFF_KCT = OFF_GN + al256((size_t)T * 12 * 4);
constexpr size_t OFF_VCTOK = OFF_KCT + al256(((size_t)T * 64 + 2048) * 2);
constexpr size_t OFF_HIDK = OFF_VCTOK + al256(((size_t)T * 64 + 2048) * 2);
constexpr size_t OFF_HIDV = OFF_HIDK + al256((size_t)1024 * 128 * 2);
constexpr size_t OFF_KCB = OFF_HIDV + al256((size_t)1024 * 128 * 2);
constexpr size_t OFF_VCT = OFF_KCB + al256((size_t)NBATCH * NCMP_PAD * 64 * 2);
constexpr size_t OFF_QI = OFF_VCT + al256((size_t)NBATCH * NCMP_PAD * 64 * 2);
constexpr size_t OFF_KI = OFF_QI + al256((size_t)T * 128 * 2);
constexpr size_t OFF_MEMN = OFF_KI + al256((size_t)T * 32 * 2);
constexpr size_t OFF_ROPE = OFF_MEMN + al256((size_t)NBATCH * NMEM * D * 2);
constexpr size_t OFF_DMASK = OFF_ROPE + al256((size_t)T * 64 * 4);
constexpr size_t OFF_SMASK = OFF_DMASK + al256((size_t)T * 256 * 4);
constexpr size_t OFF_QA = OFF_SMASK + al256((size_t)T * 4 * 4);
constexpr size_t OFF_KAB = OFF_QA + al256((size_t)T * 256 * 2);
constexpr size_t OFF_VAT = OFF_KAB + al256((size_t)T * 256 * 2);
constexpr size_t OFF_QF = OFF_VAT + al256((size_t)T * 256 * 2);
constexpr size_t OFF_KF = OFF_QF + al256((size_t)T * 256 * 2);
constexpr size_t OFF_VFT = OFF_KF + al256((size_t)T * 256 * 2);
constexpr size_t OFF_QS = OFF_VFT + al256((size_t)T * 256 * 2);
constexpr size_t OFF_KSB = OFF_QS + al256((size_t)T * 256 * 2);
constexpr size_t OFF_VST = OFF_KSB + al256((size_t)T * 256 * 2);
constexpr size_t OFF_QN = OFF_VST + al256((size_t)T * 256 * 2);
constexpr size_t OFF_QM = OFF_QN + al256((size_t)T * 256 * 2);
constexpr size_t OFF_KSLC = OFF_QM + al256((size_t)T * 256 * 2);
constexpr size_t OFF_VSLCT = OFF_KSLC + al256((size_t)T * 64 * 2);
constexpr size_t OFF_KWIN = OFF_VSLCT + al256((size_t)T * 64 * 2);
constexpr size_t OFF_VWINT = OFF_KWIN + al256((size_t)T * 64 * 2);
constexpr size_t OFF_MKB = OFF_VWINT + al256((size_t)T * 64 * 2);
constexpr size_t OFF_MVT = OFF_MKB + al256((size_t)NBATCH * NMEM * 256 * 2);
constexpr size_t OFF_WIN = OFF_MVT + al256((size_t)NBATCH * NMEM * 256 * 2);
constexpr size_t OFF_WBR = OFF_WIN + al256((size_t)NP * D * 2);
constexpr size_t OFF_WOUT = OFF_WBR + al256((size_t)DEPTH * 5 * D * 256 * 2);
constexpr size_t OFF_WMKV = OFF_WOUT + al256((size_t)DEPTH * D * D * 2);
constexpr size_t OFF_WUK = OFF_WMKV + al256((size_t)DEPTH * 512 * D * 2);
constexpr size_t OFF_WUV = OFF_WUK + al256((size_t)DEPTH * 256 * 128 * 2);
constexpr size_t OFF_WC1T = OFF_WUV + al256((size_t)DEPTH * 256 * 128 * 2);
constexpr size_t OFF_WC2T = OFF_WC1T + al256((size_t)DEPTH * 2 * 128 * 2048 * 2);
constexpr size_t OFF_BIASC = OFF_WC2T + al256((size_t)DEPTH * 2 * 64 * 128 * 2);
constexpr size_t WS_TOTAL = OFF_BIASC + al256((size_t)DEPTH * 2 * 128 * 4);

__device__ __forceinline__ int map_in_col(int n) {
    constexpr int seg[27][3] = {{0, 256, M_QA}, {256, 128, M_CKV}, {384, 128, M_QI}, {512, 32, M_SPC}, {544, 4, M_SPC + 32}, {548, 256, M_Z}, {804, 256, M_QF}, {1060, 256, M_KF},
        {1316, 256, M_VF}, {1572, 4, M_SPC + 36}, {1576, 256, M_Z + 256}, {1832, 256, M_QS}, {2088, 256, M_KSB}, {2344, 256, M_VS}, {2600, 256, M_Z + 512}, {2856, 256, M_QN},
        {3112, 64, M_KC}, {3176, 64, M_VC}, {3240, 64, M_KSLC}, {3304, 64, M_VSLC}, {3368, 64, M_KWIN}, {3432, 64, M_VWIN}, {3496, 12, M_SPC + 40}, {3508, 256, M_Z + 768},
        {3764, 256, M_QM}, {4020, 256, M_Z + 1024}, {4276, 5120, M_MERGE}};
    int r = 0;
#pragma unroll
    for (int i = 0; i < 27; ++i) r = (n >= seg[i][0] && n < seg[i][0] + seg[i][1]) ? (seg[i][2] + n - seg[i][0]) : r;
    return r;
}
struct Params {
    const float* x; const float* mem; const int* pos; const float* norm_g; const float* w_in; const float* kv_norm;
    const float* w_uk; const float* w_uv; const float* fox_bias; const float* pe_k; const float* pe_v;
    const float* wc1_k; const float* wc2_k; const float* wc1_v; const float* wc2_v; const float* mem_norm;
    const float* w_mem_kv; const float* w_branch; const float* w_out; const float* final_norm;
    float* X; char* ws;
    __device__ __forceinline__ unsigned* bar() const { return (unsigned*)(ws + OFF_bar); }
    __device__ __forceinline__ bf16_t* H() const { return (bf16_t*)(ws + OFF_H); }
    __device__ __forceinline__ bf16_t* Y() const { return (bf16_t*)(ws + OFF_Y); }
    __device__ __forceinline__ bf16_t* ZG() const { return (bf16_t*)(ws + OFF_ZG); }
    __device__ __forceinline__ bf16_t* MG() const { return (bf16_t*)(ws + OFF_MG); }
    __device__ __forceinline__ float* CKVR() const { return (float*)(ws + OFF_CKVR); }
    __device__ __forceinline__ bf16_t* CKV() const { return (bf16_t*)(ws + OFF_CKV); }
    __device__ __forceinline__ float* OCMP() const { return (float*)(ws + OFF_OCMP); }
    __device__ __forceinline__ float* OSLC() const { return (float*)(ws + OFF_OSLC); }
    __device__ __forceinline__ float* OWIN() const { return (float*)(ws + OFF_OWIN); }
    __device__ __forceinline__ float* LOGF() const { return (float*)(ws + OFF_LOGF); }
    __device__ __forceinline__ float* CUM() const { return (float*)(ws + OFF_CUM); }
    __device__ __forceinline__ float* CUMT() const { return (float*)(ws + OFF_CUMT); }
    __device__ __forceinline__ float* WI() const { return (float*)(ws + OFF_WI); }
    __device__ __forceinline__ float* GN() const { return (float*)(ws + OFF_GN); }
    __device__ __forceinline__ bf16_t* KCT() const { return (bf16_t*)(ws + OFF_KCT); }
    __device__ __forceinline__ bf16_t* VCTOK() const { return (bf16_t*)(ws + OFF_VCTOK); }
    __device__ __forceinline__ bf16_t* HIDK() const { return (bf16_t*)(ws + OFF_HIDK); }
    __device__ __forceinline__ bf16_t* HIDV() const { return (bf16_t*)(ws + OFF_HIDV); }
    __device__ __forceinline__ bf16_t* KCB() const { return (bf16_t*)(ws + OFF_KCB); }
    __device__ __forceinline__ bf16_t* VCT() const { return (bf16_t*)(ws + OFF_VCT); }
    __device__ __forceinline__ bf16_t* QI() const { return (bf16_t*)(ws + OFF_QI); }
    __device__ __forceinline__ bf16_t* KI() const { return (bf16_t*)(ws + OFF_KI); }
    __device__ __forceinline__ bf16_t* MEMN() const { return (bf16_t*)(ws + OFF_MEMN); }
    __device__ __forceinline__ float* ROPE() const { return (float*)(ws + OFF_ROPE); }
    __device__ __forceinline__ unsigned* DMASK() const { return (unsigned*)(ws + OFF_DMASK); }
    __device__ __forceinline__ unsigned* SMASK() const { return (unsigned*)(ws + OFF_SMASK); }
    __device__ __forceinline__ bf16_t* QA() const { return (bf16_t*)(ws + OFF_QA); }
    __device__ __forceinline__ bf16_t* KAB() const { return (bf16_t*)(ws + OFF_KAB); }
    __device__ __forceinline__ bf16_t* VAT() const { return (bf16_t*)(ws + OFF_VAT); }
    __device__ __forceinline__ bf16_t* QF() const { return (bf16_t*)(ws + OFF_QF); }
    __device__ __forceinline__ bf16_t* KF() const { return (bf16_t*)(ws + OFF_KF); }
    __device__ __forceinline__ bf16_t* VFT() const { return (bf16_t*)(ws + OFF_VFT); }
    __device__ __forceinline__ bf16_t* QS() const { return (bf16_t*)(ws + OFF_QS); }
    __device__ __forceinline__ bf16_t* KSB() const { return (bf16_t*)(ws + OFF_KSB); }
    __device__ __forceinline__ bf16_t* VST() const { return (bf16_t*)(ws + OFF_VST); }
    __device__ __forceinline__ bf16_t* QN() const { return (bf16_t*)(ws + OFF_QN); }
    __device__ __forceinline__ bf16_t* QM() const { return (bf16_t*)(ws + OFF_QM); }
    __device__ __forceinline__ bf16_t* KSLC() const { return (bf16_t*)(ws + OFF_KSLC); }
    __device__ __forceinline__ bf16_t* VSLCT() const { return (bf16_t*)(ws + OFF_VSLCT); }
    __device__ __forceinline__ bf16_t* KWIN() const { return (bf16_t*)(ws + OFF_KWIN); }
    __device__ __forceinline__ bf16_t* VWINT() const { return (bf16_t*)(ws + OFF_VWINT); }
    __device__ __forceinline__ bf16_t* MKB() const { return (bf16_t*)(ws + OFF_MKB); }
    __device__ __forceinline__ bf16_t* MVT() const { return (bf16_t*)(ws + OFF_MVT); }
    __device__ __forceinline__ bf16_t* WIN() const { return (bf16_t*)(ws + OFF_WIN); }
    __device__ __forceinline__ bf16_t* WBR() const { return (bf16_t*)(ws + OFF_WBR); }
    __device__ __forceinline__ bf16_t* WOUT() const { return (bf16_t*)(ws + OFF_WOUT); }
    __device__ __forceinline__ bf16_t* WMKV() const { return (bf16_t*)(ws + OFF_WMKV); }
    __device__ __forceinline__ bf16_t* WUK() const { return (bf16_t*)(ws + OFF_WUK); }
    __device__ __forceinline__ bf16_t* WUV() const { return (bf16_t*)(ws + OFF_WUV); }
    __device__ __forceinline__ bf16_t* WC1T() const { return (bf16_t*)(ws + OFF_WC1T); }
    __device__ __forceinline__ bf16_t* WC2T() const { return (bf16_t*)(ws + OFF_WC2T); }
    __device__ __forceinline__ float* BIASC() const { return (float*)(ws + OFF_BIASC); }
    __device__ __forceinline__ unsigned* qctr() const { return (unsigned*)(ws + OFF_bar) + 4096; }
};

typedef __bf16 bf16x2_t __attribute__((ext_vector_type(2)));
__device__ __forceinline__ unsigned cvt_pk_bf16(float lo, float hi) { bf16x2_t v; v.x = (__bf16)lo; v.y = (__bf16)hi; return __builtin_bit_cast(unsigned, v); }
__device__ __forceinline__ bf16_t f2bf(float x) { return (bf16_t)(cvt_pk_bf16(x, 0.f) & 0xffffu); }
__device__ __forceinline__ int tidx() { int t = threadIdx.x; asm volatile("" : "+v"(t)); return t; }
__device__ __forceinline__ float sigmoid_(float x) { return 1.f / (1.f + expf(-x)); }
__device__ __forceinline__ float silu_(float x) { return x / (1.f + expf(-x)); }
__device__ __forceinline__ float logsig_(float x) { return fminf(x, 0.f) - log1pf(expf(-fabsf(x))); }
__device__ __forceinline__ float wave_sum(float v) {
#pragma unroll
    for (int o = 32; o > 0; o >>= 1) v += __shfl_xor(v, o, 64);
    return v;
}
__device__ __forceinline__ float wave_max(float v) {
#pragma unroll
    for (int o = 32; o > 0; o >>= 1) v = fmaxf(v, __shfl_xor(v, o, 64));
    return v;
}

__device__ __forceinline__ void ph_rope_table(const Params& p, int bid, int nb) {
    for (int i = bid * 256 + tidx(); i < T * 32; i += nb * 256) {
        const int t = i >> 5, f = i & 31;
        const double inv = pow(10000.0, -(double)f / 32.0);
        const double ang = (double)p.pos[t] * inv;
        p.ROPE()[(size_t)t * 64 + f] = (float)cos(ang);
        p.ROPE()[(size_t)t * 64 + 32 + f] = (float)sin(ang);
    }
}

template <class OUT>
__device__ __forceinline__ void ph_rmsnorm(const float* in, const float* g, OUT* out, int rows, int bid, int nb, float dscale = 1.0f) {
    const int lane = tidx() & 63, wid = tidx() >> 6;
    for (int r = bid * 4 + wid; r < rows; r += nb * 4) {
        const float4* ip = (const float4*)(in + (size_t)r * D);
        float4 v[4]; float ss = 0.f;
#pragma unroll
        for (int i = 0; i < 4; ++i) { v[i] = ip[lane + 64 * i]; ss += v[i].x * v[i].x + v[i].y * v[i].y + v[i].z * v[i].z + v[i].w * v[i].w; }
        ss = wave_sum(ss);
        const float sc = dscale / sqrtf(ss * (1.f / D) + 1e-6f);
#pragma unroll
        for (int i = 0; i < 4; ++i) {
            const float4 gg = ((const float4*)g)[lane + 64 * i];
            float4 o; o.x = v[i].x * sc * gg.x; o.y = v[i].y * sc * gg.y; o.z = v[i].z * sc * gg.z; o.w = v[i].w * sc * gg.w;
            if constexpr (sizeof(OUT) == 4) ((float4*)((float*)out + (size_t)r * D))[lane + 64 * i] = o;
            else { u32x2 w; w.x = cvt_pk_bf16(o.x, o.y); w.y = cvt_pk_bf16(o.z, o.w); ((u32x2*)((bf16_t*)out + (size_t)r * D))[lane + 64 * i] = w; }
        }
    }
}

__device__ __forceinline__ void ph_ckvnorm(const Params& p, int layer, int bid, int nb) {
    const int lane = tidx() & 63, wid = tidx() >> 6;
    const float* g = p.kv_norm + layer * 128;
    for (int r = bid * 4 + wid; r < T; r += nb * 4) {
        const float* ip = p.CKVR() + (size_t)r * 128;
        const float a = ip[lane], b = ip[lane + 64];
        const float ss = wave_sum(a * a + b * b);
        const float sc = 1.0f / sqrtf(ss * (1.f / 128.f) + 1e-6f);
        p.CKV()[(size_t)r * 128 + lane] = f2bf(a * sc * g[lane]);
        p.CKV()[(size_t)r * 128 + lane + 64] = f2bf(b * sc * g[lane + 64]);
    }
}

template <bool MAPIN = false>
__device__ __forceinline__ void convert_wt(const float* __restrict__ src, bf16_t* __restrict__ dst, int K, int N, int nmat, int bid, int nb, float* sm) {
    float (*tl)[65] = (float (*)[65])sm;
    const int tid = tidx(), tk = K / 64, tn = (N + 63) / 64, per = tk * tn;
    for (int it = bid; it < per * nmat; it += nb) {
        const int mat = it / per, r = it % per, k0 = (r % tk) * 64, n0 = (r / tk) * 64;
        const float* s = src + (size_t)mat * K * N; bf16_t* d = dst + (size_t)mat * K * N;
        for (int i = tid; i < 64 * 64; i += 256) { const int kk = i >> 6, nn = i & 63; tl[kk][nn] = (n0 + nn < N) ? s[(size_t)(k0 + kk) * N + n0 + nn] : 0.f; }
        __syncthreads();
        {
            const int nn = tid >> 2, kq = (tid & 3) * 16;
            if (n0 + nn < N) {
                u32x4 w0, w1;
                w0.x = cvt_pk_bf16(tl[kq + 0][nn], tl[kq + 1][nn]); w0.y = cvt_pk_bf16(tl[kq + 2][nn], tl[kq + 3][nn]);
                w0.z = cvt_pk_bf16(tl[kq + 4][nn], tl[kq + 5][nn]); w0.w = cvt_pk_bf16(tl[kq + 6][nn], tl[kq + 7][nn]);
                w1.x = cvt_pk_bf16(tl[kq + 8][nn], tl[kq + 9][nn]); w1.y = cvt_pk_bf16(tl[kq + 10][nn], tl[kq + 11][nn]);
                w1.z = cvt_pk_bf16(tl[kq + 12][nn], tl[kq + 13][nn]); w1.w = cvt_pk_bf16(tl[kq + 14][nn], tl[kq + 15][nn]);
                const int drow = MAPIN ? map_in_col(n0 + nn) : (n0 + nn);
                u32x4* dp = (u32x4*)(d + (size_t)drow * K + k0 + kq);
                dp[0] = w0; dp[1] = w1;
            }
        }
        __syncthreads();
    }
}

constexpr int GROW = 80;
constexpr int GA_BYTES = 128 * GROW;
struct GStage { u32x4 a0, a1, b0, b1; };
template <int BN>
__device__ __forceinline__ void tile_mac(f32x16 (&acc)[2][BN / 64], const bf16_t* __restrict__ A, int lda, int m0,
                                         const bf16_t* __restrict__ Bt, int ldb, int n0, int nmax, int K, char* sm) {
    constexpr int NT = BN / 64;
    constexpr int B_BYTES = BN * GROW;
    constexpr int BUF = GA_BYTES + B_BYTES;
    const int tid = tidx(), lane = tid & 63, wid = __builtin_amdgcn_readfirstlane(tid >> 6), wr = wid >> 1, wc = wid & 1;
    const int lr = lane & 31, lh = lane >> 5;
    const int ar0 = tid >> 2, akq = tid & 3;
    const bf16_t* ap0 = A + (size_t)(m0 + ar0) * lda + akq * 8;
    const bf16_t* ap1 = A + (size_t)(m0 + ar0 + 64) * lda + akq * 8;
    const int br0 = tid >> 2;
    const bool bv0 = (n0 + br0) < nmax, bv1 = (NT == 2) && ((n0 + br0 + 64) < nmax);
    const bf16_t* bp0 = Bt + (size_t)(bv0 ? (n0 + br0) : 0) * ldb + akq * 8;
    const bf16_t* bp1 = Bt + (size_t)(bv1 ? (n0 + br0 + 64) : 0) * ldb + akq * 8;
    const int st_a0 = ar0 * GROW + akq * 16, st_a1 = (ar0 + 64) * GROW + akq * 16;
    const int st_b0 = GA_BYTES + br0 * GROW + akq * 16, st_b1 = GA_BYTES + (br0 + 64) * GROW + akq * 16;
    const int rd_a = (wr * 64 + lr) * GROW + lh * 16, rd_b = GA_BYTES + (wc * (BN / 2) + lr) * GROW + lh * 16;
    const u32x4 zero4 = {0u, 0u, 0u, 0u};
    const int nk = K / 32;
    auto gload = [&](GStage& g, int ks) {
        const int ko = ks * 32;
        g.a0 = *(const u32x4*)(ap0 + ko); g.a1 = *(const u32x4*)(ap1 + ko);
        g.b0 = *(const u32x4*)(bp0 + ko); if (NT == 2) g.b1 = *(const u32x4*)(bp1 + ko);
    };
    auto lstore = [&](const GStage& g, char* buf) {
        *(u32x4*)(buf + st_a0) = g.a0; *(u32x4*)(buf + st_a1) = g.a1;
        *(u32x4*)(buf + st_b0) = bv0 ? g.b0 : zero4; if (NT == 2) *(u32x4*)(buf + st_b1) = bv1 ? g.b1 : zero4;
    };
    auto compute = [&](const char* cur) {
#pragma unroll
        for (int s = 0; s < 2; ++s) {
            bf16x8 a[2], b[NT];
#pragma unroll
            for (int mi = 0; mi < 2; ++mi) a[mi] = *(const bf16x8*)(cur + rd_a + mi * 32 * GROW + s * 32);
#pragma unroll
            for (int ni = 0; ni < NT; ++ni) b[ni] = *(const bf16x8*)(cur + rd_b + ni * 32 * GROW + s * 32);
#pragma unroll
            for (int mi = 0; mi < 2; ++mi)
#pragma unroll
                for (int ni = 0; ni < NT; ++ni) acc[mi][ni] = __builtin_amdgcn_mfma_f32_32x32x16_bf16(a[mi], b[ni], acc[mi][ni], 0, 0, 0);
        }
    };
    GStage g0, g1, g2;
    g1.b1 = zero4; g2.b1 = zero4; g0.b1 = zero4;
    const int last = nk - 1;
    gload(g0, 0);
    gload(g1, min(1, last));
    gload(g2, min(2, last));
    __syncthreads();
    lstore(g0, sm);
    __syncthreads();
#define GSTEP(k, GL, GS) { gload(GL, min((k) + 3, last)); compute(sm + ((k) & 1) * BUF); lstore(GS, sm + (((k) + 1) & 1) * BUF); __syncthreads(); }
    int ks = 0;
#pragma unroll 1
    for (; ks + 3 <= nk; ks += 3) {
        GSTEP(ks, g0, g1)
        GSTEP(ks + 1, g1, g2)
        GSTEP(ks + 2, g2, g0)
    }
    if (ks < nk) {
        GSTEP(ks, g0, g1)
        if (ks + 1 < nk) GSTEP(ks + 1, g1, g2)
    }
#undef GSTEP
}
template <int NT> __device__ __forceinline__ void acc_zero(f32x16 (&acc)[2][NT]) {
#pragma unroll
    for (int mi = 0; mi < 2; ++mi)
#pragma unroll
        for (int ni = 0; ni < NT; ++ni)
#pragma unroll
            for (int r = 0; r < 16; ++r) acc[mi][ni][r] = 0.f;
}
template <int BN, class Epi>
__device__ __forceinline__ void gemm_bf16(const bf16_t* A, int lda, const bf16_t* Bt, int ldb, int M, int N, int K, const Epi& epi, int bid, int nb, char* sm) {
    constexpr int NT = BN / 64;
    const int tm = M / 128, tn = (N + BN - 1) / BN;
    const int lane = tidx() & 63, wid = __builtin_amdgcn_readfirstlane(tidx() >> 6), wr = wid >> 1, wc = wid & 1, lr = lane & 31, lh = lane >> 5;
    for (int tile = bid; tile < tm * tn; tile += nb) {
        const int m0 = (tile % tm) * 128, n0 = (tile / tm) * BN;
        f32x16 acc[2][NT]; acc_zero<NT>(acc);
        tile_mac<BN>(acc, A, lda, m0, Bt, ldb, n0, N, K, sm);
        const int col0 = n0 + wc * (BN / 2);
        if (col0 < N) epi(acc, m0 + wr * 64, col0, lr, lh);
    }
}
#define EROW(mi, r) (row0 + (mi) * 32 + ((r) & 3) + 8 * ((r) >> 2) + 4 * lh)
__device__ __forceinline__ float bf2f(bf16_t h) { return __uint_as_float((unsigned)h << 16); }
__device__ __forceinline__ void epi_rope64(const f32x16 (&acc)[2][2], int row0, int lr, int lh, const float* __restrict__ rope, bf16_t* __restrict__ dst, int ld, int cbase) {
#pragma unroll
    for (int mi = 0; mi < 2; ++mi)
#pragma unroll
        for (int r = 0; r < 16; ++r) {
            const size_t row = EROW(mi, r);
            const float c = rope[row * 64 + lr], s = rope[row * 64 + 32 + lr], x1 = acc[mi][0][r], x2 = acc[mi][1][r];
            dst[row * ld + cbase + lr] = f2bf(x1 * c - x2 * s); dst[row * ld + cbase + 32 + lr] = f2bf(x2 * c + x1 * s);
        }
}
template <int NTI>
__device__ __forceinline__ void epi_rope32(const f32x16 (&acc)[2][2], int row0, int lr, int lh, const float* __restrict__ rope, bf16_t* __restrict__ dst, int ld, int cbase) {
    const int f = lr & 15;
#pragma unroll
    for (int mi = 0; mi < 2; ++mi)
#pragma unroll
        for (int ni = 0; ni < NTI; ++ni)
#pragma unroll
            for (int r = 0; r < 16; ++r) {
                const size_t row = EROW(mi, r);
                const float x = acc[mi][ni][r], xo = __shfl_xor(x, 16, 64);
                const float c = rope[row * 64 + 2 * f], s = rope[row * 64 + 32 + 2 * f];
                dst[row * ld + cbase + ni * 32 + lr] = f2bf((lr & 16) ? (x * c + xo * s) : (x * c - xo * s));
            }
}
template <int NT, bool SILU>
__device__ __forceinline__ void epi_bf16(const f32x16 (&acc)[2][NT], int row0, int lr, int lh, bf16_t* __restrict__ dst, int ld, int cbase) {
#pragma unroll
    for (int mi = 0; mi < 2; ++mi)
#pragma unroll
        for (int ni = 0; ni < NT; ++ni)
#pragma unroll
            for (int r = 0; r < 16; ++r) { const float v = acc[mi][ni][r]; dst[(size_t)EROW(mi, r) * ld + cbase + ni * 32 + lr] = f2bf(SILU ? silu_(v) : v); }
}
template <int NT>
__device__ __forceinline__ void epi_vt(const f32x16 (&acc)[2][NT], int trow0, int lr, int lh, bf16_t* __restrict__ vt, size_t ldv) {
#pragma unroll
    for (int mi = 0; mi < 2; ++mi)
#pragma unroll
        for (int ni = 0; ni < NT; ++ni)
#pragma unroll
            for (int g = 0; g < 4; ++g) {
                u32x2 o; o.x = cvt_pk_bf16(acc[mi][ni][4 * g], acc[mi][ni][4 * g + 1]); o.y = cvt_pk_bf16(acc[mi][ni][4 * g + 2], acc[mi][ni][4 * g + 3]);
                *(u32x2*)(vt + (size_t)(ni * 32 + lr) * ldv + trow0 + mi * 32 + 8 * g + 4 * lh) = o;
            }
}
template <int NT>
__device__ __forceinline__ void epi_f32(const f32x16 (&acc)[2][NT], int row0, int lr, int lh, float* __restrict__ dst, int ld, int cbase) {
#pragma unroll
    for (int mi = 0; mi < 2; ++mi)
#pragma unroll
        for (int ni = 0; ni < NT; ++ni)
#pragma unroll
            for (int r = 0; r < 16; ++r) dst[(size_t)EROW(mi, r) * ld + cbase + ni * 32 + lr] = acc[mi][ni][r];
}
struct EpiInProj {
    const Params& p; int layer;
    __device__ __forceinline__ void operator()(const f32x16 (&acc)[2][2], int row0, int col0, int lr, int lh) const {
        const int b = row0 / S, t0 = row0 % S;
        const float* rope = p.ROPE();
        int kind, ld = 256, cbase = 0; size_t off = 0; bool silu = false;
        if (col0 < M_QN)         { kind = 0; off = OFF_QA; cbase = col0 - M_QA; }
        else if (col0 < M_KSLC)  { kind = 0; off = OFF_QN; cbase = col0 - M_QN; }
        else if (col0 == M_KSLC) { kind = 0; off = OFF_KSLC; ld = 64; }
        else if (col0 == M_KWIN) { kind = 0; off = OFF_KWIN; ld = 64; }
        else if (col0 == M_KC)   { kind = 0; off = OFF_KCT; ld = 64; }
        else if (col0 == M_VC)   { kind = 1; off = OFF_VCTOK; ld = 64; }
        else if (col0 < M_KF)    { kind = 1; off = OFF_QF; cbase = col0 - M_QF; }
        else if (col0 < M_QS)    { kind = 1; off = OFF_KF; cbase = col0 - M_KF; }
        else if (col0 < M_KSB)   { kind = 1; off = OFF_QS; cbase = col0 - M_QS; }
        else if (col0 < M_QM)    { kind = 1; off = OFF_KSB; cbase = col0 - M_KSB; }
        else if (col0 < M_VF)    { kind = 1; off = OFF_QM; cbase = col0 - M_QM; }
        else if (col0 < M_VS)    { kind = 2; off = OFF_VFT + ((size_t)(b * 4 + (col0 - M_VF) / 64) * 64) * S * 2; }
        else if (col0 < M_VSLC)  { kind = 2; off = OFF_VST + ((size_t)(b * 4 + (col0 - M_VS) / 64) * 64) * S * 2; }
        else if (col0 == M_VSLC) { kind = 2; off = OFF_VSLCT + ((size_t)b * 64) * S * 2; }
        else if (col0 == M_VWIN) { kind = 2; off = OFF_VWINT + ((size_t)b * 64) * S * 2; }
        else if (col0 < M_SPC)   { kind = 3; off = OFF_QI; ld = 128; cbase = col0 - M_QI; }
        else if (col0 == M_SPC)  { kind = 4; }
        else if (col0 < M_Z)     { kind = 5; off = OFF_CKVR; ld = 128; cbase = col0 - M_CKV; }
        else                     { kind = 1; off = OFF_ZG; ld = 1280; cbase = col0 - M_Z; silu = true; }
        bf16_t* dst = (bf16_t*)(p.ws + off);
        if (kind == 0) epi_rope64(acc, row0, lr, lh, rope, dst, ld, cbase);
        else if (kind == 1) {
#pragma unroll
            for (int mi = 0; mi < 2; ++mi)
#pragma unroll
                for (int ni = 0; ni < 2; ++ni)
#pragma unroll
                    for (int r = 0; r < 16; ++r) { const float v = acc[mi][ni][r]; dst[(size_t)EROW(mi, r) * ld + cbase + ni * 32 + lr] = f2bf(silu ? silu_(v) : v); }
        }
        else if (kind == 2) epi_vt<2>(acc, t0, lr, lh, dst, S);
        else if (kind == 3) epi_rope32<2>(acc, row0, lr, lh, rope, dst, ld, cbase);
        else if (kind == 5) epi_f32<2>(acc, row0, lr, lh, (float*)dst, ld, cbase);
        else {
            epi_rope32<1>(acc, row0, lr, lh, rope, p.KI(), 32, 0);
            const float fb = p.fox_bias[layer * 4 + (lr & 3)];
#pragma unroll
            for (int mi = 0; mi < 2; ++mi)
#pragma unroll
                for (int r = 0; r < 16; ++r) {
                    const size_t row = EROW(mi, r); const float v = acc[mi][1][r];
                    if (lr < 4) p.WI()[row * 4 + lr] = v * 0.08838834764831845f;
                    else if (lr < 8) p.LOGF()[row * 4 + lr - 4] = logsig_(v + fb);
                    else if (lr < 20) p.GN()[row * 12 + lr - 8] = sigmoid_(v);
                }
        }
    }
};
struct EpiMemKV {
    const Params& p;
    __device__ __forceinline__ void operator()(const f32x16 (&acc)[2][2], int row0, int col0, int lr, int lh) const {
        if (col0 < 256) epi_bf16<2, false>(acc, row0, lr, lh, p.MKB(), 256, col0);
        else epi_vt<2>(acc, row0 % NMEM, lr, lh, p.MVT() + ((size_t)((row0 / NMEM) * 4 + (col0 - 256) / 64) * 64) * NMEM, NMEM);
    }
};
struct EpiKA { const Params& p;
    __device__ __forceinline__ void operator()(const f32x16 (&acc)[2][2], int row0, int col0, int lr, int lh) const { epi_rope64(acc, row0, lr, lh, p.ROPE(), p.KAB(), 256, col0); } };
struct EpiVA { const Params& p;
    __device__ __forceinline__ void operator()(const f32x16 (&acc)[2][2], int row0, int col0, int lr, int lh) const {
        epi_vt<2>(acc, row0 % S, lr, lh, p.VAT() + ((size_t)((row0 / S) * 4 + col0 / 64) * 64) * S, S); } };
struct EpiResid { const float* Xin; float* Xout;
    __device__ __forceinline__ void operator()(const f32x16 (&acc)[2][2], int row0, int col0, int lr, int lh) const {
#pragma unroll
        for (int mi = 0; mi < 2; ++mi) {
            float xv[2][16];
#pragma unroll
            for (int ni = 0; ni < 2; ++ni)
#pragma unroll
                for (int r = 0; r < 16; ++r) xv[ni][r] = Xin[(size_t)EROW(mi, r) * D + col0 + ni * 32 + lr];
#pragma unroll
            for (int ni = 0; ni < 2; ++ni)
#pragma unroll
                for (int r = 0; r < 16; ++r) Xout[(size_t)EROW(mi, r) * D + col0 + ni * 32 + lr] = xv[ni][r] + acc[mi][ni][r];
        }
    } };
struct EpiCmp1 { const float* bias; bf16_t* hid;
    __device__ __forceinline__ void operator()(const f32x16 (&acc)[2][1], int row0, int col0, int lr, int lh) const {
        const float bv = bias[col0 + lr];
#pragma unroll
        for (int mi = 0; mi < 2; ++mi)
#pragma unroll
            for (int r = 0; r < 16; ++r) hid[(size_t)EROW(mi, r) * 128 + col0 + lr] = f2bf(silu_(acc[mi][0][r] + bv));
    } };
struct EpiCmp2K { bf16_t* kcb;
    __device__ __forceinline__ void operator()(const f32x16 (&acc)[2][1], int row0, int col0, int lr, int lh) const {
#pragma unroll
        for (int mi = 0; mi < 2; ++mi)
#pragma unroll
            for (int r = 0; r < 16; ++r) { const int row = EROW(mi, r); kcb[(size_t)row * 64 + col0 + lr] = ((row & 511) == 511) ? (bf16_t)0 : f2bf(acc[mi][0][r]); }
    } };
struct EpiCmp2V { bf16_t* vct;
    __device__ __forceinline__ void operator()(const f32x16 (&acc)[2][1], int row0, int col0, int lr, int lh) const {
        bf16_t* base = vct + ((size_t)(row0 / 512) * 64 + col0) * 512;
        const int n0 = row0 % 512;
#pragma unroll
        for (int mi = 0; mi < 2; ++mi)
#pragma unroll
            for (int g = 0; g < 4; ++g) {
                const int n = n0 + mi * 32 + 8 * g + 4 * lh;
                u32x2 o; o.x = cvt_pk_bf16(acc[mi][0][4 * g], acc[mi][0][4 * g + 1]); o.y = cvt_pk_bf16(acc[mi][0][4 * g + 2], (n + 3 == 511) ? 0.f : acc[mi][0][4 * g + 3]);
                *(u32x2*)(base + (size_t)lr * 512 + n) = o;
            }
    } };

__device__ __forceinline__ void ph_merge(const Params& p, int layer, int bid, int nb, char* sm) {
    const int lane = tidx() & 63, wid = tidx() >> 6, wr = wid >> 1, wc = wid & 1, lr = lane & 31, lh = lane >> 5;
    const bf16_t* win = p.WIN();
    for (int tile = bid; tile < (T / 128) * (D / 64); tile += nb) {
        const int m0 = (tile % (T / 128)) * 128, n0 = (tile / (T / 128)) * 64;
        f32x16 mg[2][1]; acc_zero<1>(mg);
        for (int n = 0; n < 5; ++n) {
            f32x16 g[2][1], yb[2][1]; acc_zero<1>(g); acc_zero<1>(yb);
            tile_mac<64>(g, p.H(), D, m0, win + (size_t)(M_MERGE + n * D) * D, D, n0, D, D, sm);
            tile_mac<64>(yb, p.Y() + n * 256, 1280, m0, p.WBR() + ((size_t)layer * 5 + n) * D * 256, 256, n0, D, 256, sm);
#pragma unroll
            for (int mi = 0; mi < 2; ++mi)
#pragma unroll
                for (int r = 0; r < 16; ++r) mg[mi][0][r] = fmaf(sigmoid_(g[mi][0][r]), yb[mi][0][r], mg[mi][0][r]);
        }
#pragma unroll
        for (int mi = 0; mi < 2; ++mi)
#pragma unroll
            for (int r = 0; r < 16; ++r) {
                const int row = m0 + wr * 64 + mi * 32 + (r & 3) + 8 * (r >> 2) + 4 * lh, col = n0 + wc * 32 + lr;
                p.MG()[(size_t)row * D + col] = f2bf(mg[mi][0][r]);
            }
    }
}

__device__ __forceinline__ void ph_cumsum(const Params& p, int bid, int nb, float* sm) {
    const int tid = tidx();
    for (int item = bid; item < NBATCH * 4; item += nb) {
        const int b = item >> 2, h = item & 3;
        const float* src = p.LOGF() + (size_t)b * S * 4 + h;
        float* dst = p.CUM() + (size_t)b * S * 4 + h;
        float loc = 0.f;
        for (int i = 0; i < 32; ++i) loc += src[(size_t)(tid * 32 + i) * 4];
        sm[tid] = loc; __syncthreads();
        if (tid == 0) { float run = 0.f; for (int i = 0; i < 256; ++i) { const float v = sm[i]; sm[i] = run; run += v; } }
        __syncthreads();
        float run = sm[tid];
        float* dt = p.CUMT() + (size_t)item * S;
        for (int i = 0; i < 32; ++i) { run += src[(size_t)(tid * 32 + i) * 4]; dst[(size_t)(tid * 32 + i) * 4] = run; dt[tid * 32 + i] = run * 1.4426950408889634f; }
        __syncthreads();
    }
}

enum { AM_FOX = 0, AM_DSA = 1, AM_SLC = 2, AM_SB = 3, AM_WIN = 4, AM_MEM = 5, AM_CMP = 6 };
constexpr int AK_ROW = 144;
constexpr int AK_TILE = 64 * AK_ROW;
constexpr int ABUF = 2 * AK_TILE + 256;
constexpr float LOG2E = 1.4426950408889634f;
#define NEG_INF (-__builtin_inff())

template <int MODE>
__device__ __forceinline__ void attn_unit(const Params& p, int b, int head, int qblk, char* sm) {
    const int tid = tidx(), lane = tid & 63, wid = __builtin_amdgcn_readfirstlane(tid >> 6), lr = lane & 31, lh = lane >> 5;
    const int q0 = qblk * 128, qw0 = q0 + 32 * wid, tq = qw0 + lr;
    const size_t gq = (size_t)b * S + tq;
    const bf16_t *Qp, *Kp, *VTp; int ldk, ldv;
    if (MODE == AM_FOX)      { Qp = p.QF() + gq * 256 + head * 64; Kp = p.KF() + (size_t)b * S * 256 + head * 64; ldk = 256; VTp = p.VFT() + ((size_t)(b * 4 + head) * 64) * S; ldv = S; }
    else if (MODE == AM_DSA) { Qp = p.QA() + gq * 256 + head * 64; Kp = p.KAB() + (size_t)b * S * 256 + head * 64; ldk = 256; VTp = p.VAT() + ((size_t)(b * 4 + head) * 64) * S; ldv = S; }
    else if (MODE == AM_SB)  { Qp = p.QS() + gq * 256 + head * 64; Kp = p.KSB() + (size_t)b * S * 256 + head * 64; ldk = 256; VTp = p.VST() + ((size_t)(b * 4 + head) * 64) * S; ldv = S; }
    else if (MODE == AM_SLC) { Qp = p.QN() + gq * 256 + head * 64; Kp = p.KSLC() + (size_t)b * S * 64; ldk = 64; VTp = p.VSLCT() + ((size_t)b * 64) * S; ldv = S; }
    else if (MODE == AM_WIN) { Qp = p.QN() + gq * 256 + head * 64; Kp = p.KWIN() + (size_t)b * S * 64; ldk = 64; VTp = p.VWINT() + ((size_t)b * 64) * S; ldv = S; }
    else if (MODE == AM_CMP) { Qp = p.QN() + gq * 256 + head * 64; Kp = p.KCB() + (size_t)b * NCMP_PAD * 64; ldk = 64; VTp = p.VCT() + ((size_t)b * 64) * NCMP_PAD; ldv = NCMP_PAD; }
    else                     { Qp = p.QM() + gq * 256 + head * 64; Kp = p.MKB() + (size_t)b * NMEM * 256 + head * 64; ldk = 256; VTp = p.MVT() + ((size_t)(b * 4 + head) * 64) * NMEM; ldv = NMEM; }
    int kt_lo = 0, kt_hi = 2 * qblk + 2;
    if (MODE == AM_WIN) kt_lo = q0 >= 512 ? (q0 - 512) / 64 : 0;
    if (MODE == AM_MEM) kt_hi = NMEM / 64;
    if (MODE == AM_CMP) kt_hi = min(8, (((q0 + 96) >> 4) >> 6) + 1);
    const int nlim = (tq - 31) >> 4;
    const int ntile = kt_hi - kt_lo;
    constexpr bool REV = (MODE == AM_SB);

    bf16x8 qf[4];
#pragma unroll
    for (int s = 0; s < 4; ++s) qf[s] = *(const bf16x8*)(Qp + 16 * s + 8 * lh);
    unsigned smw[4] = {0u, 0u, 0u, 0u};
    if (MODE == AM_SLC) { const u32x4 w = *(const u32x4*)(p.SMASK() + gq * 4); smw[0] = w.x; smw[1] = w.y; smw[2] = w.z; smw[3] = w.w; }
    const unsigned long long* mrow = (const unsigned long long*)(p.DMASK() + gq * 256);
    const float* csp = p.CUMT() + (size_t)(b * 4 + head) * S;

    const int srow = tid >> 3, sc16 = tid & 7;
    const int st0 = srow * AK_ROW + sc16 * 16, st1 = (srow + 32) * AK_ROW + sc16 * 16;
    const bf16_t* kg0 = Kp + (size_t)srow * ldk + sc16 * 8;
    const bf16_t* kg1 = Kp + (size_t)(srow + 32) * ldk + sc16 * 8;
    const bf16_t* vg0 = VTp + (size_t)srow * ldv + sc16 * 8;
    const bf16_t* vg1 = VTp + (size_t)(srow + 32) * ldv + sc16 * 8;
    u32x4 rk0, rk1, rv0, rv1; float rcs = 0.f;
    auto gload = [&](int kt) {
        rk0 = *(const u32x4*)(kg0 + (size_t)kt * 64 * ldk); rk1 = *(const u32x4*)(kg1 + (size_t)kt * 64 * ldk);
        rv0 = *(const u32x4*)(vg0 + kt * 64); rv1 = *(const u32x4*)(vg1 + kt * 64);
        if (MODE == AM_FOX) { if (tid < 64) rcs = csp[kt * 64 + tid]; }
    };
    auto lstore = [&](char* buf) {
        *(u32x4*)(buf + st0) = rk0; *(u32x4*)(buf + st1) = rk1;
        *(u32x4*)(buf + AK_TILE + st0) = rv0; *(u32x4*)(buf + AK_TILE + st1) = rv1;
        if (MODE == AM_FOX) { if (tid < 64) *(float*)(buf + 2 * AK_TILE + tid * 4) = rcs; }
    };
    const int pil = (lr & 0x13) | ((lr & 4) << 1) | ((lr & 8) >> 1);
    const int rdk = pil * AK_ROW + lh * 16;
    const int rdv = AK_TILE + lr * AK_ROW + lh * 16;

    float m = NEG_INF, l = 0.f, R = 0.f;
    f32x16 O[2];
#pragma unroll
    for (int i = 0; i < 16; ++i) { O[0][i] = 0.f; O[1][i] = 0.f; }

    gload(REV ? kt_hi - 1 : kt_lo);
    __syncthreads();
    lstore(sm);
    __syncthreads();
#pragma unroll 1
    for (int it = 0; it < ntile; ++it) {
        const int kt = REV ? kt_hi - 1 - it : kt_lo + it;
        char* cur = sm + (it & 1) * ABUF;
        const bool more = (it + 1) < ntile;
        if (more) gload(REV ? kt - 1 : kt + 1);
        unsigned long long mw = 0ull;
        if (MODE == AM_DSA) mw = mrow[kt];
        bool need = true;
        if (MODE == AM_CMP) need = kt * 64 <= (qw0 >> 4);
        else if (MODE != AM_MEM) need = kt * 64 <= qw0 + 31;
        if (MODE == AM_WIN) need = need && (kt * 64 + 63 >= qw0 - 511);
        if (need) {
#pragma unroll
            for (int sb2 = 0; sb2 < 2; ++sb2) {
                const int sub = REV ? 1 - sb2 : sb2;
                const int kb = kt * 64 + sub * 32;
                bool sneed = true;
                if (MODE == AM_CMP) sneed = kb <= (qw0 >> 4);
                else if (MODE != AM_MEM) sneed = kb <= qw0 + 31;
                if (MODE == AM_WIN) sneed = sneed && (kb + 31 >= qw0 - 511);
                if (sneed) {
                    f32x16 s;
#pragma unroll
                    for (int i = 0; i < 16; ++i) s[i] = 0.f;
#pragma unroll
                    for (int s4 = 0; s4 < 4; ++s4) {
                        const bf16x8 kf = *(const bf16x8*)(cur + rdk + sub * 32 * AK_ROW + s4 * 32);
                        s = __builtin_amdgcn_mfma_f32_32x32x16_bf16(kf, qf[s4], s, 0, 0, 0);
                    }
                    const int thl = tq - kb - 8 * lh;
                    bf16x8 pf[2];
                    if (MODE == AM_SB) {
                        float lk[16];
#pragma unroll
                        for (int r = 0; r < 16; ++r) {
                            const int cr = 16 * (r >> 3) + (r & 7);
                            const float z = s[r] * 0.125f;
                            const float az = fabsf(z);
                            const float sp = fmaxf(z, 0.f) + __builtin_amdgcn_logf(1.f + __builtin_amdgcn_exp2f(-az * LOG2E)) * 0.6931471805599453f;
                            const bool ok = cr < thl;
                            lk[r] = ok ? -sp : 0.f;
                            s[r] = ok ? z : NEG_INF;
                        }
                        float g0 = 0.f, g1 = 0.f;
#pragma unroll
                        for (int r = 0; r < 8; ++r) { g0 += lk[r]; g1 += lk[8 + r]; }
                        const float pg0 = __shfl_xor(g0, 32, 64), pg1 = __shfl_xor(g1, 32, 64);
                        const float off0 = R + (lh == 0 ? (pg0 + g1 + pg1) : (pg1 + g1));
                        const float off1 = R + (lh == 0 ? pg1 : 0.f);
                        float run0 = off0, run1 = off1;
#pragma unroll
                        for (int r = 7; r >= 0; --r) {
                            const float a0 = __builtin_amdgcn_exp2f((s[r] + lk[r] + run0) * LOG2E); run0 += lk[r];
                            const float a1 = __builtin_amdgcn_exp2f((s[8 + r] + lk[8 + r] + run1) * LOG2E); run1 += lk[8 + r];
                            s[r] = a0; s[8 + r] = a1;
                        }
                        R += (g0 + g1) + (pg0 + pg1);
                    } else {
                        constexpr float c = 0.125f * LOG2E;
                        if (MODE == AM_FOX) {
                            const float4* cs4 = (const float4*)(cur + 2 * AK_TILE + (sub * 32 + 8 * lh) * 4);
                            const float4 c0 = cs4[0], c1 = cs4[1], c2 = cs4[4], c3 = cs4[5];
                            const float cv[16] = {c0.x, c0.y, c0.z, c0.w, c1.x, c1.y, c1.z, c1.w, c2.x, c2.y, c2.z, c2.w, c3.x, c3.y, c3.z, c3.w};
#pragma unroll
                            for (int r = 0; r < 16; ++r) s[r] = fmaf(s[r], c, -cv[r]);
                        } else {
#pragma unroll
                            for (int r = 0; r < 16; ++r) s[r] *= c;
                        }
                        if (MODE == AM_DSA) {
                            const unsigned w = (unsigned)(mw >> (32 * sub)) >> (8 * lh);
#pragma unroll
                            for (int r = 0; r < 16; ++r) { const int cr = 16 * (r >> 3) + (r & 7); s[r] = (w & (1u << cr)) ? s[r] : NEG_INF; }
                        }
                        if (MODE == AM_SLC) {
                            const unsigned w = smw[0] * (kt < 32) + smw[1] * (kt >= 32 && kt < 64) + smw[2] * (kt >= 64 && kt < 96) + smw[3] * (kt >= 96);
                            const bool sel = (w >> (kt & 31)) & 1u;
#pragma unroll
                            for (int r = 0; r < 16; ++r) s[r] = sel ? s[r] : NEG_INF;
                        }
                        if (MODE == AM_FOX || MODE == AM_SLC) {
                            if (kb + 31 > qw0) {
#pragma unroll
                                for (int r = 0; r < 16; ++r) { const int cr = 16 * (r >> 3) + (r & 7); s[r] = (cr <= thl) ? s[r] : NEG_INF; }
                            }
                        }
                        if (MODE == AM_CMP) {
                            const int tc = nlim - kb - 8 * lh;
#pragma unroll
                            for (int r = 0; r < 16; ++r) { const int cr = 16 * (r >> 3) + (r & 7); s[r] = (cr <= tc) ? s[r] : NEG_INF; }
                        }
                        if (MODE == AM_WIN) {
                            if (kb + 31 > qw0 || kb < qw0 + 31 - 511) {
#pragma unroll
                                for (int r = 0; r < 16; ++r) { const int cr = 16 * (r >> 3) + (r & 7); s[r] = (cr <= thl && cr > thl - 512) ? s[r] : NEG_INF; }
                            }
                        }
                        float tmax = s[0];
#pragma unroll
                        for (int r = 1; r < 16; ++r) tmax = fmaxf(tmax, s[r]);
                        tmax = fmaxf(tmax, __shfl_xor(tmax, 32, 64));
                        const float mn = fmaxf(m, tmax);
                        const float mu = (mn == NEG_INF) ? 0.f : mn;
                        const float corr = __builtin_amdgcn_exp2f(m - mu);
                        m = mn;
                        float ls = 0.f;
#pragma unroll
                        for (int r = 0; r < 16; ++r) { s[r] = __builtin_amdgcn_exp2f(s[r] - mu); ls += s[r]; }
                        l = l * corr + ls;
                        if (!__all(corr == 1.0f)) {
#pragma unroll
                            for (int i = 0; i < 16; ++i) { O[0][i] *= corr; O[1][i] *= corr; }
                        }
                    }
                    {
                        u32x4 w0, w1;
                        w0.x = cvt_pk_bf16(s[0], s[1]); w0.y = cvt_pk_bf16(s[2], s[3]); w0.z = cvt_pk_bf16(s[4], s[5]); w0.w = cvt_pk_bf16(s[6], s[7]);
                        w1.x = cvt_pk_bf16(s[8], s[9]); w1.y = cvt_pk_bf16(s[10], s[11]); w1.z = cvt_pk_bf16(s[12], s[13]); w1.w = cvt_pk_bf16(s[14], s[15]);
                        pf[0] = __builtin_bit_cast(bf16x8, w0); pf[1] = __builtin_bit_cast(bf16x8, w1);
                    }
#pragma unroll
                    for (int s2 = 0; s2 < 2; ++s2)
#pragma unroll
                        for (int dt = 0; dt < 2; ++dt) {
                            const bf16x8 vf = *(const bf16x8*)(cur + rdv + dt * 32 * AK_ROW + sub * 64 + s2 * 32);
                            O[dt] = __builtin_amdgcn_mfma_f32_32x32x16_bf16(vf, pf[s2], O[dt], 0, 0, 0);
                        }
                }
            }
        }
        if (more) lstore(sm + ((it + 1) & 1) * ABUF);
        __syncthreads();
    }
    float inv = 1.f;
    if (MODE != AM_SB) { const float lt = l + __shfl_xor(l, 32, 64); inv = 1.f / fmaxf(lt, 1e-30f); }
    if (MODE == AM_SLC || MODE == AM_WIN || MODE == AM_CMP) {
        const float gs = (MODE == AM_CMP) ? inv : p.GN()[gq * 12 + (MODE == AM_SLC ? 4 : 8) + head] * inv;
        float* dst = (MODE == AM_SLC ? p.OSLC() : MODE == AM_WIN ? p.OWIN() : p.OCMP()) + gq * 256 + head * 64;
#pragma unroll
        for (int dt = 0; dt < 2; ++dt)
#pragma unroll
            for (int g = 0; g < 4; ++g) {
                float4 o; o.x = O[dt][4 * g] * gs; o.y = O[dt][4 * g + 1] * gs; o.z = O[dt][4 * g + 2] * gs; o.w = O[dt][4 * g + 3] * gs;
                *(float4*)(dst + 32 * dt + 8 * g + 4 * lh) = o;
            }
    } else {
        const int yc = MODE == AM_FOX ? 256 : MODE == AM_DSA ? 0 : MODE == AM_SB ? 512 : 1024;
        const bf16_t* zp = p.ZG() + gq * 1280 + yc + head * 64;
        bf16_t* dst = p.Y() + gq * 1280 + yc + head * 64;
#pragma unroll
        for (int dt = 0; dt < 2; ++dt)
#pragma unroll
            for (int g = 0; g < 4; ++g) {
                const int d0 = 32 * dt + 8 * g + 4 * lh;
                const u32x2 z = *(const u32x2*)(zp + d0);
                u32x2 o;
                o.x = cvt_pk_bf16(O[dt][4 * g] * inv * __uint_as_float(z.x << 16), O[dt][4 * g + 1] * inv * __uint_as_float(z.x & 0xffff0000u));
                o.y = cvt_pk_bf16(O[dt][4 * g + 2] * inv * __uint_as_float(z.y << 16), O[dt][4 * g + 3] * inv * __uint_as_float(z.y & 0xffff0000u));
                *(u32x2*)(dst + d0) = o;
            }
    }
}

__device__ __forceinline__ unsigned sortable_key(float x) { const unsigned u = __float_as_uint(x + 0.0f); return (u & 0x80000000u) ? ~u : (u | 0x80000000u); }
#ifndef DIAG
#define DIAG 0
#endif
#if DIAG
#define UNIT_ATTR
#else
#define UNIT_ATTR
#endif
UNIT_ATTR __device__ __forceinline__ void dsa_select_unit(const Params& p, int b, int qt, char* sm) {
    const int tid = tidx(), lane = tid & 63, wid = __builtin_amdgcn_readfirstlane(tid >> 6), lr = lane & 31, lh = lane >> 5;
    unsigned* hist = (unsigned*)sm;
    unsigned char* tcnt = (unsigned char*)sm;
    unsigned short* tbase = (unsigned short*)(sm + 8192);
    unsigned* st_prefix = (unsigned*)(sm + 32 * 257 * 4);
    int* st_krem = (int*)(st_prefix + 32);
    int* st_ties = st_krem + 32;
    int* st_flag = st_ties + 32;
    const int q0 = qt * 32, tq = q0 + lr, ntile = qt + 1;
    const size_t gq = (size_t)b * S + tq;
    const bool small = tq + 1 <= 256;
    bf16x8 qf[4][2];
    float w[4];
#pragma unroll
    for (int h = 0; h < 4; ++h) {
        qf[h][0] = *(const bf16x8*)(p.QI() + gq * 128 + h * 32 + 8 * lh);
        qf[h][1] = *(const bf16x8*)(p.QI() + gq * 128 + h * 32 + 16 + 8 * lh);
        w[h] = p.WI()[gq * 4 + h];
    }
    const bf16_t* kbase = p.KI() + (size_t)b * S * 32 + (size_t)lr * 32 + 8 * lh;
    auto score_tile = [&](int kt, unsigned (&key)[16]) {
        const bf16x8 k0 = *(const bf16x8*)(kbase + (size_t)kt * 32 * 32), k1 = *(const bf16x8*)(kbase + (size_t)kt * 32 * 32 + 16);
        float sc[16];
#pragma unroll
        for (int r = 0; r < 16; ++r) sc[r] = 0.f;
#pragma unroll
        for (int h = 0; h < 4; ++h) {
            f32x16 a;
#pragma unroll
            for (int r = 0; r < 16; ++r) a[r] = 0.f;
            a = __builtin_amdgcn_mfma_f32_32x32x16_bf16(k0, qf[h][0], a, 0, 0, 0);
            a = __builtin_amdgcn_mfma_f32_32x32x16_bf16(k1, qf[h][1], a, 0, 0, 0);
#pragma unroll
            for (int r = 0; r < 16; ++r) sc[r] = fmaf(fmaxf(a[r], 0.f), w[h], sc[r]);
            __builtin_amdgcn_sched_barrier(0);
        }
#pragma unroll
        for (int r = 0; r < 16; ++r) key[r] = sortable_key(sc[r]);
    };
    unsigned prefix = 0u;
#pragma unroll 1
    for (int pass = 0; pass < 4; ++pass) {
        const int shift = 24 - 8 * pass;
        __syncthreads();
        for (int i = tid; i < 32 * 257; i += 256) hist[i] = 0u;
        __syncthreads();
#pragma unroll 1
        for (int kt = wid; kt < ntile; kt += 4) {
            unsigned key[16];
            score_tile(kt, key);
            const int vlim = (kt == qt) ? lr : 64;
#pragma unroll
            for (int r = 0; r < 16; ++r) {
                const int rho = (r & 3) + 8 * (r >> 2) + 4 * lh;
                const bool match = (pass == 0) || ((key[r] >> (shift + 8)) == prefix);
                if (rho <= vlim && match) atomicAdd(&hist[lr * 257 + ((key[r] >> shift) & 255u)], 1u);
            }
        }
        __syncthreads();
        if (tid < 32) {
            const int tqq = q0 + tid;
            if (tqq + 1 <= 256) { if (pass == 0) { st_prefix[tid] = 0u; st_krem[tid] = 1 << 30; st_ties[tid] = 0; } }
            else {
                int krem = (pass == 0) ? 256 : st_krem[tid];
                unsigned cum = 0u; int bin = 255;
                for (; bin > 0; --bin) { const unsigned c = hist[tid * 257 + bin]; if (cum + c >= (unsigned)krem) break; cum += c; }
                st_prefix[tid] = ((pass == 0 ? 0u : st_prefix[tid]) << 8) | (unsigned)bin;
                st_krem[tid] = krem - (int)cum;
                st_ties[tid] = (int)hist[tid * 257 + bin];
            }
        }
        __syncthreads();
        prefix = st_prefix[lr];
    }
    const unsigned thr = prefix;
    const int need = st_krem[lr];
    if (tid == 0) st_flag[0] = 0;
    __syncthreads();
    if (!small && st_ties[lr] > need) st_flag[0] = 1;
    __syncthreads();
    const bool tiepass = st_flag[0] != 0;
    if (tiepass) {
#pragma unroll 1
        for (int kt = wid; kt < ntile; kt += 4) {
            unsigned key[16];
            score_tile(kt, key);
            const int vlim = (kt == qt) ? lr : 64;
            int c = 0;
#pragma unroll
            for (int r = 0; r < 16; ++r) { const int rho = (r & 3) + 8 * (r >> 2) + 4 * lh; c += (rho <= vlim && key[r] == thr) ? 1 : 0; }
            c += __shfl_xor(c, 32, 64);
            if (lh == 0) tcnt[lr * 256 + kt] = (unsigned char)c;
        }
        __syncthreads();
        if (tid < 32) { int run = 0; for (int kt = 0; kt < ntile; ++kt) { tbase[tid * 256 + kt] = (unsigned short)run; run += tcnt[tid * 256 + kt]; } }
        __syncthreads();
    }
    unsigned* mrow = p.DMASK() + gq * 256;
#pragma unroll 1
    for (int kt = wid; kt < 256; kt += 4) {
        unsigned word = 0u;
        if (kt < ntile) {
            unsigned key[16];
            score_tile(kt, key);
            const int vlim = (kt == qt) ? lr : 64;
            unsigned gt = 0u, tie = 0u;
#pragma unroll
            for (int r = 0; r < 16; ++r) {
                const int rho = (r & 3) + 8 * (r >> 2) + 4 * lh;
                if (rho <= vlim) { gt |= (key[r] > thr) ? (1u << rho) : 0u; tie |= (key[r] == thr) ? (1u << rho) : 0u; }
            }
            gt |= __shfl_xor(gt, 32, 64); tie |= __shfl_xor(tie, 32, 64);
            if (tiepass && !small) {
                int allow = need - (int)tbase[lr * 256 + kt];
                if (allow <= 0) tie = 0u;
                else if (allow < __builtin_popcount(tie)) { unsigned wv = tie, kept = 0u; for (int i = 0; i < allow; ++i) { const unsigned low = wv & (0u - wv); kept |= low; wv ^= low; } tie = kept; }
            }
            word = gt | tie;
        }
        if (lh == 0) mrow[kt] = word;
    }
    __syncthreads();
}

__device__ __forceinline__ bool imp_better(float v1, int i1, float v2, int i2) { return (v1 > v2) || (v1 == v2 && i1 < i2); }
UNIT_ATTR __device__ __forceinline__ void nsa_select_unit(const Params& p, int b, int q0w, char* sm) {
    const int lane = tidx() & 63, lr = lane & 31, lh = lane >> 5;
    const int tq = q0w + lr;
    const size_t gq = (size_t)b * S + tq;
    const int nlim = (tq - 31) >> 4;
    const int nst = min(16, ((((q0w + 31 - 31) >> 4)) >> 5) + 1);
    const int pil = (lr & 0x13) | ((lr & 4) << 1) | ((lr & 8) >> 1);
    const bf16_t* kc = p.KCB() + (size_t)b * NCMP_PAD * 64 + (size_t)pil * 64 + 8 * lh;
    constexpr float c = 0.125f * LOG2E;
    float mh[4], il[4];
#pragma unroll
    for (int h = 0; h < 4; ++h) {
        bf16x8 qf[4];
#pragma unroll
        for (int s = 0; s < 4; ++s) qf[s] = *(const bf16x8*)(p.QN() + gq * 256 + h * 64 + 16 * s + 8 * lh);
        float m = NEG_INF, l = 0.f;
#pragma unroll 1
        for (int st = 0; st < nst; ++st) {
            f32x16 s;
#pragma unroll
            for (int i = 0; i < 16; ++i) s[i] = 0.f;
#pragma unroll
            for (int s4 = 0; s4 < 4; ++s4) { const bf16x8 kf = *(const bf16x8*)(kc + (size_t)st * 32 * 64 + s4 * 16); s = __builtin_amdgcn_mfma_f32_32x32x16_bf16(kf, qf[s4], s, 0, 0, 0); }
            const int thl = nlim - st * 32 - 8 * lh;
            float tmax = NEG_INF;
#pragma unroll
            for (int r = 0; r < 16; ++r) { const int cr = 16 * (r >> 3) + (r & 7); s[r] = (cr <= thl) ? s[r] * c : NEG_INF; tmax = fmaxf(tmax, s[r]); }
            tmax = fmaxf(tmax, __shfl_xor(tmax, 32, 64));
            const float mn = fmaxf(m, tmax), mu = (mn == NEG_INF) ? 0.f : mn;
            float ls = 0.f;
#pragma unroll
            for (int r = 0; r < 16; ++r) ls += __builtin_amdgcn_exp2f(s[r] - mu);
            l = l * __builtin_amdgcn_exp2f(m - mu) + ls; m = mn;
        }
        l += __shfl_xor(l, 32, 64);
        mh[h] = (m == NEG_INF) ? 0.f : m; il[h] = 1.f / fmaxf(l, 1e-30f);
    }
    float val[16]; int idx[16];
#pragma unroll
    for (int i = 0; i < 16; ++i) { val[i] = NEG_INF; idx[i] = 1 << 20; }
    const int cur = tq >> 6;
#pragma unroll 1
    for (int st = 0; st < 16; ++st) {
        float bs[4] = {0.f, 0.f, 0.f, 0.f};
        if (st < nst) {
            const int thl = nlim - st * 32 - 8 * lh;
#pragma unroll
            for (int h = 0; h < 4; ++h) {
                f32x16 s;
#pragma unroll
                for (int i = 0; i < 16; ++i) s[i] = 0.f;
#pragma unroll
                for (int s4 = 0; s4 < 4; ++s4) {
                    const bf16x8 kf = *(const bf16x8*)(kc + (size_t)st * 32 * 64 + s4 * 16);
                    const bf16x8 qfr = *(const bf16x8*)(p.QN() + gq * 256 + h * 64 + 16 * s4 + 8 * lh);
                    s = __builtin_amdgcn_mfma_f32_32x32x16_bf16(kf, qfr, s, 0, 0, 0);
                }
#pragma unroll
                for (int r = 0; r < 16; ++r) {
                    const int cr = 16 * (r >> 3) + (r & 7);
                    const float pr = (cr <= thl) ? __builtin_amdgcn_exp2f(s[r] * c - mh[h]) * il[h] : 0.f;
                    bs[r >> 2] += pr;
                }
                __builtin_amdgcn_sched_barrier(0);
            }
        }
#pragma unroll
        for (int g = 0; g < 4; ++g) {
            const int j = st * 8 + 4 * (g >> 1) + 2 * lh + (g & 1);
            const bool forced = (j == 0) || (j == cur) || (j == cur - 1);
            float v = forced ? 1e4f : ((j <= cur) ? bs[g] : -1.0f);
            int jj = j;
            if (__any(imp_better(v, jj, val[15], idx[15]))) {
#pragma unroll
                for (int i = 0; i < 16; ++i) {
                    const bool bt = imp_better(v, jj, val[i], idx[i]);
                    const float tv = bt ? val[i] : v; const int ti = bt ? idx[i] : jj;
                    val[i] = bt ? v : val[i]; idx[i] = bt ? jj : idx[i];
                    v = tv; jj = ti;
                }
            }
        }
    }
    {
        float* lv = (float*)(sm + (tidx() >> 6) * 8192);
        int* li = (int*)(lv + 1024);
#pragma unroll
        for (int i = 0; i < 16; ++i) { lv[i * 64 + lane] = val[i]; li[i * 64 + lane] = idx[i]; }
        __builtin_amdgcn_wave_barrier();
#pragma unroll 1
        for (int k = 0; k < 16; ++k) {
            float v = lv[k * 64 + (lane ^ 32)]; int jj = li[k * 64 + (lane ^ 32)];
#pragma unroll
            for (int i = 0; i < 16; ++i) {
                const bool bt = imp_better(v, jj, val[i], idx[i]);
                const float tv = bt ? val[i] : v; const int ti = bt ? idx[i] : jj;
                val[i] = bt ? v : val[i]; idx[i] = bt ? jj : idx[i];
                v = tv; jj = ti;
            }
        }
        __builtin_amdgcn_wave_barrier();
    }
    unsigned m0 = 0u, m1 = 0u, m2 = 0u, m3 = 0u;
#pragma unroll
    for (int i = 0; i < 16; ++i) {
        const unsigned bit = 1u << (idx[i] & 31); const int wsel = idx[i] >> 5;
        m0 |= (wsel == 0) ? bit : 0u; m1 |= (wsel == 1) ? bit : 0u; m2 |= (wsel == 2) ? bit : 0u; m3 |= (wsel == 3) ? bit : 0u;
    }
    if (lh == 0) { u32x4 o; o.x = m0; o.y = m1; o.z = m2; o.w = m3; *(u32x4*)(p.SMASK() + gq * 4) = o; }
}

template <class BAR>
__device__ __forceinline__ void ph_work(const Params& p, int layer, char* sm, const BAR& barrier) {
    __shared__ int s_unit;
#pragma unroll 1
    for (int stage = 0; stage < 2; ++stage) {
        unsigned* ctr = p.qctr() + 64 * layer + 32 * stage;
        const int total = stage == 0 ? 3200 : 1024;
        for (;;) {
            __syncthreads();
            if (threadIdx.x == 0) s_unit = (int)atomicAdd(ctr, 1u);
            __syncthreads();
            const int u = __builtin_amdgcn_readfirstlane(s_unit);
            if (u >= total) break;
            int kind, b, h = 0, q;
            if (stage == 1) { const int r = u & 15; kind = 2 + ((r >> 3) ? AM_SLC : AM_DSA); q = 63 - (u >> 4); b = (r >> 2) & 1; h = r & 3; }
            else if (u < 512) { kind = 0; q = 255 - (u >> 1); b = u & 1; }
            else if (u < 640) { kind = 1; const int v = u - 512; b = v & 1; q = v >> 1; }
            else if (u < 1664) { const int v = u - 640, r = v & 15; kind = 2 + ((r >> 3) ? AM_FOX : AM_SB); q = 63 - (v >> 4); b = (r >> 2) & 1; h = r & 3; }
            else { const int v = u - 1664, br = v >> 9, w = v & 511; kind = 2 + (br == 0 ? AM_WIN : br == 1 ? AM_CMP : AM_MEM); q = w >> 3; b = (w >> 2) & 1; h = w & 3; }
            if (kind == 0) dsa_select_unit(p, b, q, sm);
            else if (kind == 1) nsa_select_unit(p, b, q * 128 + 32 * __builtin_amdgcn_readfirstlane(tidx() >> 6), sm);
            else if (kind == 2 + AM_SB) attn_unit<AM_SB>(p, b, h, q, sm);
            else if (kind == 2 + AM_FOX) attn_unit<AM_FOX>(p, b, h, q, sm);
            else if (kind == 2 + AM_DSA) attn_unit<AM_DSA>(p, b, h, q, sm);
            else if (kind == 2 + AM_SLC) attn_unit<AM_SLC>(p, b, h, q, sm);
            else if (kind == 2 + AM_WIN) attn_unit<AM_WIN>(p, b, h, q, sm);
            else if (kind == 2 + AM_CMP) attn_unit<AM_CMP>(p, b, h, q, sm);
            else attn_unit<AM_MEM>(p, b, h, q, sm);
        }
        barrier(stage);
    }
}

__device__ __forceinline__ void ph_nsa_combine(const Params& p, int bid, int nb) {
    for (size_t i = (size_t)bid * 256 + tidx(); i < (size_t)T * 64; i += (size_t)nb * 256) {
        const size_t g = i >> 6; const int c = (int)(i & 63) * 4, h = c >> 6;
        const float g0 = p.GN()[g * 12 + h];
        const float4 a = *(const float4*)(p.OCMP() + g * 256 + c), s = *(const float4*)(p.OSLC() + g * 256 + c), w = *(const float4*)(p.OWIN() + g * 256 + c);
        const u32x2 z = *(const u32x2*)(p.ZG() + g * 1280 + 768 + c);
        u32x2 o;
        o.x = cvt_pk_bf16((g0 * a.x + s.x + w.x) * __uint_as_float(z.x << 16), (g0 * a.y + s.y + w.y) * __uint_as_float(z.x & 0xffff0000u));
        o.y = cvt_pk_bf16((g0 * a.z + s.z + w.z) * __uint_as_float(z.y << 16), (g0 * a.w + s.w + w.w) * __uint_as_float(z.y & 0xffff0000u));
        *(u32x2*)(p.Y() + g * 1280 + 768 + c) = o;
    }
}

__device__ __forceinline__ void ph_setup_misc(const Params& p, int bid, int nb) {
    const int lane = tidx() & 63, gw = bid * 4 + (tidx() >> 6);
    for (int o = gw; o < DEPTH * 2 * 128; o += nb * 4) {
        const int l = o >> 8, which = (o >> 7) & 1, j = o & 127;
        const float* pe = (which ? p.pe_v : p.pe_k) + (size_t)l * 2048;
        const float* w1 = (which ? p.wc1_v : p.wc1_k) + (size_t)l * 2048 * 128;
        float a = 0.f;
        for (int k = lane; k < 2048; k += 64) a = fmaf(pe[k], w1[(size_t)k * 128 + j], a);
        a = wave_sum(a);
        if (lane == 0) p.BIASC()[o] = a;
    }
    for (int i = bid * 256 + tidx(); i < 2048; i += nb * 256) { p.KCT()[(size_t)T * 64 + i] = 0; p.VCTOK()[(size_t)T * 64 + i] = 0; }
    for (int i = bid * 256 + tidx(); i < 12 * D; i += nb * 256) p.WIN()[(size_t)(M_SPC + 52) * D + i] = 0;
}

#define XB_TMO      128
#define XB_XCNT(j)  (256  + 64 * (j))
#define XB_XSUB(j)  (1280 + 64 * (j))
#define XB_XGEN(j)  (2304 + 64 * (j))
#define XB_TOP      3328
#define XB_TOPGEN   3392
#define XCD_BAR_WORDS 3456
#define XB_SPIN_CAP (1u << 18)
#define LAS __attribute__((address_space(3)))

__device__ __forceinline__ unsigned xb_ld(unsigned* p)              { return __hip_atomic_load(p, __ATOMIC_RELAXED, __HIP_MEMORY_SCOPE_AGENT); }
__device__ __forceinline__ unsigned xb_add(unsigned* p, unsigned v) { return __hip_atomic_fetch_add(p, v, __ATOMIC_RELAXED, __HIP_MEMORY_SCOPE_AGENT); }
__device__ __forceinline__ unsigned xb_xcc_id() { return (unsigned)__builtin_amdgcn_s_getreg((3 << 11) | 20) & 0xFu; }
#define XB_SPIN(cond, bar) do { unsigned _sp = 0; while (cond) { __builtin_amdgcn_s_sleep(1); \
    if ((++_sp & 255u) == 0u) { if (xb_ld(&(bar)[XB_TMO])) break; if (_sp > XB_SPIN_CAP) { atomicAdd(&(bar)[XB_TMO], 1u); break; } } } } while (0)

struct XcdBarrier {
    unsigned* bar; unsigned x;
    volatile LAS unsigned* st;
};
__device__ __forceinline__ XcdBarrier xcd_barrier_post(unsigned* bar, volatile LAS unsigned* st) {
    XcdBarrier b; b.bar = bar; b.x = xb_xcc_id(); b.st = st;
    if (threadIdx.x == 0) (void)xb_add(&bar[XB_XCNT(b.x)], 1u);
    return b;
}
__device__ __forceinline__ void xcd_barrier_complete(unsigned* bar, unsigned x, unsigned& nloc, unsigned& nx) {
    const unsigned G = gridDim.x * gridDim.y * gridDim.z;
    unsigned sum, cnt, mine, sp = 0u;
    for (;;) {
        sum = 0u; cnt = 0u; mine = 0u;
#pragma unroll
        for (unsigned j = 0; j < 16; ++j) { const unsigned c = xb_ld(&bar[XB_XCNT(j)]); sum += c; cnt += (c > 0u) ? 1u : 0u; mine = (j == x) ? c : mine; }
        if (sum == G) break;
        __builtin_amdgcn_s_sleep(1);
        if ((++sp & 255u) == 0u) { if (xb_ld(&bar[XB_TMO])) break; if (sp > XB_SPIN_CAP) { atomicAdd(&bar[XB_TMO], 1u); break; } }
    }
    nloc = mine > 0u ? mine : 1u; nx = cnt > 0u ? cnt : 1u;
}
__device__ __attribute__((noinline)) void xcd_barrier_impl(unsigned* b_bar, unsigned b_x, volatile LAS unsigned* b_st) {
    XcdBarrier b; b.bar = b_bar; b.x = b_x; b.st = b_st;
    asm volatile("s_waitcnt vmcnt(0)" ::: "memory");
    __syncthreads();
    if (threadIdx.x == 0) {
        unsigned* bar = b.bar;
        __builtin_amdgcn_s_waitcnt(0);
        unsigned nloc = b.st[0], nx = b.st[1];
        if (nloc == 0u) { xcd_barrier_complete(bar, b.x, nloc, nx); b.st[0] = nloc; b.st[1] = nx; }
        const unsigned old = xb_add(&bar[XB_XSUB(b.x)], 1u);
        const unsigned gen = old / nloc;
        if (old + 1u == (gen + 1u) * nloc) {
            __builtin_amdgcn_fence(__ATOMIC_RELEASE, "agent");
            asm volatile("s_waitcnt vmcnt(0)" ::: "memory");
            const unsigned og = xb_add(&bar[XB_TOP], 1u);
            const unsigned tg = og / nx;
            if (og + 1u == (tg + 1u) * nx) xb_add(&bar[XB_TOPGEN], 1u);
            else XB_SPIN(xb_ld(&bar[XB_TOPGEN]) == tg, bar);
            __builtin_amdgcn_fence(__ATOMIC_ACQUIRE, "agent");
            xb_add(&bar[XB_XGEN(b.x)], 1u);
            asm volatile("s_waitcnt vmcnt(0)" ::: "memory");
        } else {
            XB_SPIN(xb_ld(&bar[XB_XGEN(b.x)]) == gen, bar);
            __builtin_amdgcn_fence(__ATOMIC_ACQUIRE, "agent");
            asm volatile("s_waitcnt vmcnt(0)" ::: "memory");
        }
    }
    __syncthreads();
}
__device__ __forceinline__ void xcd_barrier(const XcdBarrier& b) { xcd_barrier_impl(b.bar, b.x, b.st); }

#ifndef DIAG
#define DIAG 0
#endif
#ifndef DIAG_A
#define DIAG_A 8
#define DIAG_B 7
#endif
#if DIAG
#define STAMP(k) do { if (((k) == DIAG_A || (k) == DIAG_B || (k) + 1 == DIAG_A || (k) + 1 == DIAG_B || (k) == 0 || (k) == 11) && blockIdx.x == 0 && threadIdx.x == 0) { const unsigned long long t_ = wall_clock64(); dg[k] += t_ - dg[15]; dg[15] = t_; } } while (0)
#else
#define STAMP(k) do { } while (0)
#endif
__global__ void __launch_bounds__(256, 2) mega(Params p) {
    __shared__ __attribute__((aligned(16))) char smem[40960];
    __shared__ uint4 xb_words;
    if (threadIdx.x == 0) xb_words = make_uint4(0u, 0u, 0u, 0u);
    __syncthreads();
    XcdBarrier bar = xcd_barrier_post(p.bar(), (volatile LAS unsigned*)&xb_words);
    const int bid = blockIdx.x, nb = gridDim.x;
    float* smf = (float*)smem;
#if DIAG
    __shared__ unsigned long long dg[16];
    if (threadIdx.x == 0) { for (int i = 0; i < 15; ++i) dg[i] = 0; dg[15] = wall_clock64(); }
#endif

    convert_wt(p.w_branch, p.WBR(), 256, D, DEPTH * 5, bid, nb, smf);
    convert_wt(p.w_out, p.WOUT(), D, D, DEPTH, bid, nb, smf);
    convert_wt(p.w_mem_kv, p.WMKV(), D, 512, DEPTH, bid, nb, smf);
    convert_wt(p.w_uk, p.WUK(), 128, 256, DEPTH, bid, nb, smf);
    convert_wt(p.w_uv, p.WUV(), 128, 256, DEPTH, bid, nb, smf);
    for (int l = 0; l < DEPTH; ++l) {
        convert_wt(p.wc1_k + (size_t)l * 2048 * 128, p.WC1T() + (size_t)(l * 2 + 0) * 128 * 2048, 2048, 128, 1, bid, nb, smf);
        convert_wt(p.wc1_v + (size_t)l * 2048 * 128, p.WC1T() + (size_t)(l * 2 + 1) * 128 * 2048, 2048, 128, 1, bid, nb, smf);
        convert_wt(p.wc2_k + (size_t)l * 128 * 64, p.WC2T() + (size_t)(l * 2 + 0) * 64 * 128, 128, 64, 1, bid, nb, smf);
        convert_wt(p.wc2_v + (size_t)l * 128 * 64, p.WC2T() + (size_t)(l * 2 + 1) * 64 * 128, 128, 64, 1, bid, nb, smf);
    }
    ph_setup_misc(p, bid, nb);
    ph_rope_table(p, bid, nb);
    STAMP(0);
    for (int l = 0; l < DEPTH; ++l) {
        const float* Xin = l == 0 ? p.x : p.X;
        convert_wt<true>(p.w_in + (size_t)l * D * NIN, p.WIN(), D, NIN, 1, bid, nb, smf);
        ph_rmsnorm<bf16_t>(Xin, p.norm_g + l * D, p.H(), T, bid, nb);
        ph_rmsnorm<bf16_t>(p.mem, p.mem_norm + l * D, p.MEMN(), NBATCH * NMEM, bid, nb);
        xcd_barrier(bar); STAMP(1);
        { EpiInProj e{p, l}; gemm_bf16<128>(p.H(), D, p.WIN(), D, T, NPM, D, e, bid, nb, smem); }
        { EpiMemKV e{p}; gemm_bf16<128>(p.MEMN(), D, p.WMKV() + (size_t)l * 512 * D, D, NBATCH * NMEM, 512, D, e, bid, nb, smem); }
        xcd_barrier(bar); STAMP(2);
        ph_ckvnorm(p, l, bid, nb);
        ph_cumsum(p, bid, nb, smf);
        { EpiCmp1 e{p.BIASC() + (l * 2 + 0) * 128, p.HIDK()}; gemm_bf16<64>(p.KCT(), 1024, p.WC1T() + (size_t)(l * 2 + 0) * 128 * 2048, 2048, 1024, 128, 2048, e, bid, nb, smem); }
        { EpiCmp1 e{p.BIASC() + (l * 2 + 1) * 128, p.HIDV()}; gemm_bf16<64>(p.VCTOK(), 1024, p.WC1T() + (size_t)(l * 2 + 1) * 128 * 2048, 2048, 1024, 128, 2048, e, bid, nb, smem); }
        xcd_barrier(bar); STAMP(3);
        { EpiKA e{p}; gemm_bf16<128>(p.CKV(), 128, p.WUK() + (size_t)l * 256 * 128, 128, T, 256, 128, e, bid, nb, smem); }
        { EpiVA e{p}; gemm_bf16<128>(p.CKV(), 128, p.WUV() + (size_t)l * 256 * 128, 128, T, 256, 128, e, bid, nb, smem); }
        { EpiCmp2K e{p.KCB()}; gemm_bf16<64>(p.HIDK(), 128, p.WC2T() + (size_t)(l * 2 + 0) * 64 * 128, 128, 1024, 64, 128, e, bid, nb, smem); }
        { EpiCmp2V e{p.VCT()}; gemm_bf16<64>(p.HIDV(), 128, p.WC2T() + (size_t)(l * 2 + 1) * 64 * 128, 128, 1024, 64, 128, e, bid, nb, smem); }
        xcd_barrier(bar); STAMP(4);
        ph_work(p, l, smem, [&](int stage) { xcd_barrier(bar); if (stage == 0) { STAMP(7); } else { STAMP(8); } });
        ph_nsa_combine(p, bid, nb);
        xcd_barrier(bar); STAMP(9);
        ph_merge(p, l, bid, nb, smem);
        xcd_barrier(bar); STAMP(10);
        { EpiResid e{Xin, p.X}; gemm_bf16<128>(p.MG(), D, p.WOUT() + (size_t)l * D * D, D, T, D, D, e, bid, nb, smem); }
        xcd_barrier(bar); STAMP(11);
    }
#if DIAG
    {
        float* dgw = (float*)(p.bar() + 4096 + 512);
        if (blockIdx.x == 0 && threadIdx.x == 0) {
            unsigned long long tot = 0; for (int i = 0; i < 15; ++i) tot += dg[i];
            dgw[0] = rintf(40.f * (float)((double)dg[DIAG_A] / (double)tot)) / 40.f; dgw[1] = rintf(40.f * (float)((double)dg[DIAG_B] / (double)tot)) / 40.f;
        }
        ph_rmsnorm<float>(p.X, p.final_norm, p.X, T, bid, nb);
        xcd_barrier(bar);
        {
            const float fa = 1.0f + dgw[0];
            float4* xp = (float4*)p.X;
#pragma unroll 1
            for (int i = bid * 256 + threadIdx.x; i < T * D / 4; i += nb * 256) { float4 v = xp[i]; v.x *= fa; v.y *= fa; v.z *= fa; v.w *= fa; xp[i] = v; }
        }
        xcd_barrier(bar);
        if (blockIdx.x == 0 && threadIdx.x == 0) p.X[0] += 100.f * dgw[1];
    }
#else
    ph_rmsnorm<float>(p.X, p.final_norm, p.X, T, bid, nb);
#endif
}
}

extern "C" void kernel_launch(void* const* d_in, const int* in_sizes, int n_in, void* d_out, int out_size, void* d_ws, size_t ws_size, hipStream_t stream) {
    (void)in_sizes; (void)n_in; (void)out_size;
    Params p{};
    p.x = (const float*)d_in[0]; p.mem = (const float*)d_in[1]; p.pos = (const int*)d_in[2]; p.norm_g = (const float*)d_in[3];
    p.w_in = (const float*)d_in[4]; p.kv_norm = (const float*)d_in[5]; p.w_uk = (const float*)d_in[6]; p.w_uv = (const float*)d_in[7];
    p.fox_bias = (const float*)d_in[8]; p.pe_k = (const float*)d_in[9]; p.pe_v = (const float*)d_in[10]; p.wc1_k = (const float*)d_in[11];
    p.wc2_k = (const float*)d_in[12]; p.wc1_v = (const float*)d_in[13]; p.wc2_v = (const float*)d_in[14]; p.mem_norm = (const float*)d_in[15];
    p.w_mem_kv = (const float*)d_in[16]; p.w_branch = (const float*)d_in[17]; p.w_out = (const float*)d_in[18]; p.final_norm = (const float*)d_in[19];
    p.X = (float*)d_out;
    p.ws = (char*)d_ws;
    if (WS_TOTAL > ws_size) { fprintf(stderr, "kernel_launch: workspace too small (%zu > %zu)\n", (size_t)WS_TOTAL, ws_size); return; }

    static int grid = 0;
    if (grid == 0) {
        int dev = 0, cus = 0, per_cu = 0;
        hipGetDevice(&dev);
        hipDeviceGetAttribute(&cus, hipDeviceAttributeMultiprocessorCount, dev);
        hipOccupancyMaxActiveBlocksPerMultiprocessor(&per_cu, (const void*)mega, 256, 0);
        (void)hipGetLastError();
        if (per_cu < 1) per_cu = 1;
        grid = cus * (per_cu < 2 ? per_cu : 2);
    }
    hipMemsetAsync((char*)d_ws + OFF_bar, 0, (4096 + 64 * 8 + 64) * sizeof(unsigned), stream);
    hipLaunchKernelGGL(mega, dim3(grid), dim3(256), 0, stream, p);
}
```

```cpp
#include <hip/hip_runtime.h>
#include <stdint.h>
#include <math.h>
#include <cstdio>

namespace {
constexpr int S = 8192, NBATCH = 2, T = NBATCH * S, D = 1024, NIN = 9396, NM = 4276, DEPTH = 4, NMEM = 256;
constexpr int NCMP = 511, NCMP_PAD = 512;
constexpr int C_DSA_Q = 0, C_CKV = 256, C_IDXQ = 384, C_IDXK = 512, C_IDXW = 544, C_DSA_Z = 548,
              C_FOX_Q = 804, C_FOX_K = 1060, C_FOX_V = 1316, C_FOX_F = 1572, C_FOX_Z = 1576,
              C_SB_Q = 1832, C_SB_K = 2088, C_SB_V = 2344, C_SB_Z = 2600,
              C_NSA_Q = 2856, C_NSA_KC = 3112, C_NSA_VC = 3176, C_NSA_KS = 3240, C_NSA_VS = 3304, C_NSA_KW = 3368, C_NSA_VW = 3432,
              C_NSA_G = 3496, C_NSA_Z = 3508, C_MEM_Q = 3764, C_MEM_Z = 4020, C_MERGE = 4276;

typedef unsigned short bf16_t;
typedef short bf16x8 __attribute__((ext_vector_type(8)));
typedef float f32x16 __attribute__((ext_vector_type(16)));
typedef unsigned u32x4 __attribute__((ext_vector_type(4)));
typedef unsigned u32x2 __attribute__((ext_vector_type(2)));

constexpr int M_QA = 0, M_QN = 256, M_KSLC = 512, M_KWIN = 576, M_KC = 640, M_VC = 704, M_QF = 768, M_KF = 1024, M_QS = 1280, M_KSB = 1536, M_QM = 1792,
              M_VF = 2048, M_VS = 2304, M_VSLC = 2560, M_VWIN = 2624, M_QI = 2688, M_SPC = 2816, M_CKV = 2880, M_Z = 3008, NPM = 4288, M_MERGE = 4352, NP = 9472;
constexpr size_t al256(size_t x) { return (x + 255) & ~(size_t)255; }
constexpr size_t OFF_bar = 0;
constexpr size_t OFF_H = OFF_bar + al256((4096 + 64 * 8 + 64) * 4);
constexpr size_t OFF_Y = OFF_H + al256((size_t)T * D * 2);
constexpr size_t OFF_ZG = OFF_Y + al256((size_t)T * 1280 * 2);
constexpr size_t OFF_MG = OFF_ZG + al256((size_t)T * 1280 * 2);
constexpr size_t OFF_SIG = OFF_MG + al256((size_t)T * D * 2);
constexpr size_t OFF_CKVR = OFF_SIG + al256((size_t)T * 5120 * 2);
constexpr size_t OFF_CKV = OFF_CKVR + al256((size_t)T * 128 * 4);
constexpr size_t OFF_OCMP = OFF_CKV + al256((size_t)T * 128 * 2);
constexpr size_t OFF_OSLC = OFF_OCMP + al256((size_t)T * 256 * 4);
constexpr size_t OFF_OWIN = OFF_OSLC + al256((size_t)T * 256 * 4);
constexpr size_t OFF_LOGF = OFF_OWIN + al256((size_t)T * 256 * 4);
constexpr size_t OFF_CUM = OFF_LOGF + al256((size_t)T * 4 * 4);
constexpr size_t OFF_CUMT = OFF_CUM + al256((size_t)T * 4 * 4);
constexpr size_t OFF_WI = OFF_CUMT + al256((size_t)T * 4 * 4);
constexpr size_t OFF_GN = OFF_WI + al256((size_t)T * 4 * 4);
constexpr size_t OFF_KCT = OFF_GN + al256((size_t)T * 12 * 4);
constexpr size_t OFF_VCTOK = OFF_KCT + al256(((size_t)T * 64 + 2048) * 2);
constexpr size_t OFF_HIDK = OFF_VCTOK + al256(((size_t)T * 64 + 2048) * 2);
constexpr size_t OFF_HIDV = OFF_HIDK + al256((size_t)1024 * 128 * 2);
constexpr size_t OFF_KCB = OFF_HIDV + al256((size_t)1024 * 128 * 2);
constexpr size_t OFF_VCT = OFF_KCB + al256((size_t)NBATCH * NCMP_PAD * 64 * 2);
constexpr size_t OFF_QI = OFF_VCT + al256((size_t)NBATCH * NCMP_PAD * 64 * 2);
constexpr size_t OFF_KI = OFF_QI + al256((size_t)T * 128 * 2);
constexpr size_t OFF_MEMN = OFF_KI + al256((size_t)T * 32 * 2);
constexpr size_t OFF_ROPE = OFF_MEMN + al256((size_t)NBATCH * NMEM * D * 2);
constexpr size_t OFF_DMASK = OFF_ROPE + al256((size_t)T * 64 * 4);
constexpr size_t OFF_SMASK = OFF_DMASK + al256((size_t)T * 256 * 4);
constexpr size_t OFF_QA = OFF_SMASK + al256((size_t)T * 4 * 4);
constexpr size_t OFF_KAB = OFF_QA + al256((size_t)T * 256 * 2);
constexpr size_t OFF_VAT = OFF_KAB + al256((size_t)T * 256 * 2);
constexpr size_t OFF_QF = OFF_VAT + al256((size_t)T * 256 * 2);
constexpr size_t OFF_KF = OFF_QF + al256((size_t)T * 256 * 2);
constexpr size_t OFF_VFT = OFF_KF + al256((size_t)T * 256 * 2);
constexpr size_t OFF_QS = OFF_VFT + al256((size_t)T * 256 * 2);
constexpr size_t OFF_KSB = OFF_QS + al256((size_t)T * 256 * 2);
constexpr size_t OFF_VST = OFF_KSB + al256((size_t)T * 256 * 2);
constexpr size_t OFF_QN = OFF_VST + al256((size_t)T * 256 * 2);
constexpr size_t OFF_QM = OFF_QN + al256((size_t)T * 256 * 2);
constexpr size_t OFF_KSLC = OFF_QM + al256((size_t)T * 256 * 2);
constexpr size_t OFF_VSLCT = OFF_KSLC + al256((size_t)T * 64 * 2);
constexpr size_t OFF_KWIN = OFF_VSLCT + al256((size_t)T * 64 * 2);
constexpr size_t OFF_VWINT = OFF_KWIN + al256((size_t)T * 64 * 2);
constexpr size_t OFF_MKB = OFF_VWINT + al256((size_t)T * 64 * 2);
constexpr size_t OFF_MVT = OFF_MKB + al256((size_t)NBATCH * NMEM * 256 * 2);
constexpr size_t OFF_WIN = OFF_MVT + al256((size_t)NBATCH * NMEM * 256 * 2);
constexpr size_t OFF_WBR = OFF_WIN + al256((size_t)NP * D * 2);
constexpr size_t OFF_WOUT = OFF_WBR + al256((size_t)DEPTH * 5 * D * 256 * 2);
constexpr size_t OFF_WMKV = OFF_WOUT + al256((size_t)DEPTH * D * D * 2);
constexpr size_t OFF_WUK = OFF_WMKV + al256((size_t)DEPTH * 512 * D * 2);
constexpr size_t OFF_WUV = OFF_WUK + al256((size_t)DEPTH * 256 * 128 * 2);
constexpr size_t OFF_WC1T = OFF_WUV + al256((size_t)DEPTH * 256 * 128 * 2);
constexpr size_t OFF_WC2T = OFF_WC1T + al256((size_t)DEPTH * 2 * 128 * 2048 * 2);
constexpr size_t OFF_BIASC = OFF_WC2T + al256((size_t)DEPTH * 2 * 64 * 128 * 2);
constexpr size_t WS_TOTAL = OFF_BIASC + al256((size_t)DEPTH * 2 * 128 * 4);

__device__ __forceinline__ int map_in_col(int n) {
    constexpr int seg[27][3] = {{0, 256, M_QA}, {256, 128, M_CKV}, {384, 128, M_QI}, {512, 32, M_SPC}, {544, 4, M_SPC + 32}, {548, 256, M_Z}, {804, 256, M_QF}, {1060, 256, M_KF},
        {1316, 256, M_VF}, {1572, 4, M_SPC + 36}, {1576, 256, M_Z + 256}, {1832, 256, M_QS}, {2088, 256, M_KSB}, {2344, 256, M_VS}, {2600, 256, M_Z + 512}, {2856, 256, M_QN},
        {3112, 64, M_KC}, {3176, 64, M_VC}, {3240, 64, M_KSLC}, {3304, 64, M_VSLC}, {3368, 64, M_KWIN}, {3432, 64, M_VWIN}, {3496, 12, M_SPC + 40}, {3508, 256, M_Z + 768},
        {3764, 256, M_QM}, {4020, 256, M_Z + 1024}, {4276, 5120, M_MERGE}};
    int r = 0;
#pragma unroll
    for (int i = 0; i < 27; ++i) r = (n >= seg[i][0] && n < seg[i][0] + seg[i][1]) ? (seg[i][2] + n - seg[i][0]) : r;
    return r;
}
struct Params {
    const float* x; const float* mem; const int* pos; const float* norm_g; const float* w_in; const float* kv_norm;
    const float* w_uk; const float* w_uv; const float* fox_bias; const float* pe_k; const float* pe_v;
    const float* wc1_k; const float* wc2_k; const float* wc1_v; const float* wc2_v; const float* mem_norm;
    const float* w_mem_kv; const float* w_branch; const float* w_out; const float* final_norm;
    float* X; char* ws;
    __device__ __forceinline__ unsigned* bar() const { return (unsigned*)(ws + OFF_bar); }
    __device__ __forceinline__ bf16_t* H() const { return (bf16_t*)(ws + OFF_H); }
    __device__ __forceinline__ bf16_t* Y() const { return (bf16_t*)(ws + OFF_Y); }
    __device__ __forceinline__ bf16_t* ZG() const { return (bf16_t*)(ws + OFF_ZG); }
    __device__ __forceinline__ bf16_t* MG() const { return (bf16_t*)(ws + OFF_MG); }
    __device__ __forceinline__ bf16_t* SIG() const { return (bf16_t*)(ws + OFF_SIG); }
    __device__ __forceinline__ float* CKVR() const { return (float*)(ws + OFF_CKVR); }
    __device__ __forceinline__ bf16_t* CKV() const { return (bf16_t*)(ws + OFF_CKV); }
    __device__ __forceinline__ float* OCMP() const { return (float*)(ws + OFF_OCMP); }
    __device__ __forceinline__ float* OSLC() const { return (float*)(ws + OFF_OSLC); }
    __device__ __forceinline__ float* OWIN() const { return (float*)(ws + OFF_OWIN); }
    __device__ __forceinline__ float* LOGF() const { return (float*)(ws + OFF_LOGF); }
    __device__ __forceinline__ float* CUM() const { return (float*)(ws + OFF_CUM); }
    __device__ __forceinline__ float* CUMT() const { return (float*)(ws + OFF_CUMT); }
    __device__ __forceinline__ float* WI() const { return (float*)(ws + OFF_WI); }
    __device__ __forceinline__ float* GN() const { return (float*)(ws + OFF_GN); }
    __device__ __forceinline__ bf16_t* KCT() const { return (bf16_t*)(ws + OFF_KCT); }
    __device__ __forceinline__ bf16_t* VCTOK() const { return (bf16_t*)(ws + OFF_VCTOK); }
    __device__ __forceinline__ bf16_t* HIDK() const { return (bf16_t*)(ws + OFF_HIDK); }
    __device__ __forceinline__ bf16_t* HIDV() const { return (bf16_t*)(ws + OFF_HIDV); }
    __device__ __forceinline__ bf16_t* KCB() const { return (bf16_t*)(ws + OFF_KCB); }
    __device__ __forceinline__ bf16_t* VCT() const { return (bf16_t*)(ws + OFF_VCT); }
    __device__ __forceinline__ bf16_t* QI() const { return (bf16_t*)(ws + OFF_QI); }
    __device__ __forceinline__ bf16_t* KI() const { return (bf16_t*)(ws + OFF_KI); }
    __device__ __forceinline__ bf16_t* MEMN() const { return (bf16_t*)(ws + OFF_MEMN); }
    __device__ __forceinline__ float* ROPE() const { return (float*)(ws + OFF_ROPE); }
    __device__ __forceinline__ unsigned* DMASK() const { return (unsigned*)(ws + OFF_DMASK); }
    __device__ __forceinline__ unsigned* SMASK() const { return (unsigned*)(ws + OFF_SMASK); }
    __device__ __forceinline__ bf16_t* QA() const { return (bf16_t*)(ws + OFF_QA); }
    __device__ __forceinline__ bf16_t* KAB() const { return (bf16_t*)(ws + OFF_KAB); }
    __device__ __forceinline__ bf16_t* VAT() const { return (bf16_t*)(ws + OFF_VAT); }
    __device__ __forceinline__ bf16_t* QF() const { return (bf16_t*)(ws + OFF_QF); }
    __device__ __forceinline__ bf16_t* KF() const { return (bf16_t*)(ws + OFF_KF); }
    __device__ __forceinline__ bf16_t* VFT() const { return (bf16_t*)(ws + OFF_VFT); }
    __device__ __forceinline__ bf16_t* QS() const { return (bf16_t*)(ws + OFF_QS); }
    __device__ __forceinline__ bf16_t* KSB() const { return (bf16_t*)(ws + OFF_KSB); }
    __device__ __forceinline__ bf16_t* VST() const { return (bf16_t*)(ws + OFF_VST); }
    __device__ __forceinline__ bf16_t* QN() const { return (bf16_t*)(ws + OFF_QN); }
    __device__ __forceinline__ bf16_t* QM() const { return (bf16_t*)(ws + OFF_QM); }
    __device__ __forceinline__ bf16_t* KSLC() const { return (bf16_t*)(ws + OFF_KSLC); }
    __device__ __forceinline__ bf16_t* VSLCT() const { return (bf16_t*)(ws + OFF_VSLCT); }
    __device__ __forceinline__ bf16_t* KWIN() const { return (bf16_t*)(ws + OFF_KWIN); }
    __device__ __forceinline__ bf16_t* VWINT() const { return (bf16_t*)(ws + OFF_VWINT); }
    __device__ __forceinline__ bf16_t* MKB() const { return (bf16_t*)(ws + OFF_MKB); }
    __device__ __forceinline__ bf16_t* MVT() const { return (bf16_t*)(ws + OFF_MVT); }
    __device__ __forceinline__ bf16_t* WIN() const { return (bf16_t*)(ws + OFF_WIN); }
    __device__ __forceinline__ bf16_t* WBR() const { return (bf16_t*)(ws + OFF_WBR); }
    __device__ __forceinline__ bf16_t* WOUT() const { return (bf16_t*)(ws + OFF_WOUT); }
    __device__ __forceinline__ bf16_t* WMKV() const { return (bf16_t*)(ws + OFF_WMKV); }
    __device__ __forceinline__ bf16_t* WUK() const { return (bf16_t*)(ws + OFF_WUK); }
    __device__ __forceinline__ bf16_t* WUV() const { return (bf16_t*)(ws + OFF_WUV); }
    __device__ __forceinline__ bf16_t* WC1T() const { return (bf16_t*)(ws + OFF_WC1T); }
    __device__ __forceinline__ bf16_t* WC2T() const { return (bf16_t*)(ws + OFF_WC2T); }
    __device__ __forceinline__ float* BIASC() const { return (float*)(ws + OFF_BIASC); }
    __device__ __forceinline__ unsigned* qctr() const { return (unsigned*)(ws + OFF_bar) + 4096; }
};

typedef __bf16 bf16x2_t __attribute__((ext_vector_type(2)));
__device__ __forceinline__ unsigned cvt_pk_bf16(float lo, float hi) { bf16x2_t v; v.x = (__bf16)lo; v.y = (__bf16)hi; return __builtin_bit_cast(unsigned, v); }
__device__ __forceinline__ bf16_t f2bf(float x) { return (bf16_t)(cvt_pk_bf16(x, 0.f) & 0xffffu); }
__device__ __forceinline__ int tidx() { int t = threadIdx.x; asm volatile("" : "+v"(t)); return t; }
__device__ __forceinline__ float sigmoid_(float x) { return 1.f / (1.f + expf(-x)); }
__device__ __forceinline__ float silu_(float x) { return x / (1.f + expf(-x)); }
__device__ __forceinline__ float logsig_(float x) { return fminf(x, 0.f) - log1pf(expf(-fabsf(x))); }
__device__ __forceinline__ float wave_sum(float v) {
#pragma unroll
    for (int o = 32; o > 0; o >>= 1) v += __shfl_xor(v, o, 64);
    return v;
}
__device__ __forceinline__ float wave_max(float v) {
#pragma unroll
    for (int o = 32; o > 0; o >>= 1) v = fmaxf(v, __shfl_xor(v, o, 64));
    return v;
}

__device__ __forceinline__ void ph_rope_table(const Params& p, int bid, int nb) {
    for (int i = bid * 256 + tidx(); i < T * 32; i += nb * 256) {
        const int t = i >> 5, f = i & 31;
        const double inv = pow(10000.0, -(double)f / 32.0);
        const double ang = (double)p.pos[t] * inv;
        p.ROPE()[(size_t)t * 64 + f] = (float)cos(ang);
        p.ROPE()[(size_t)t * 64 + 32 + f] = (float)sin(ang);
    }
}

template <class OUT>
__device__ __forceinline__ void ph_rmsnorm(const float* in, const float* g, OUT* out, int rows, int bid, int nb, float dscale = 1.0f) {
    const int lane = tidx() & 63, wid = tidx() >> 6;
    for (int r = bid * 4 + wid; r < rows; r += nb * 4) {
        const float4* ip = (const float4*)(in + (size_t)r * D);
        float4 v[4]; float ss = 0.f;
#pragma unroll
        for (int i = 0; i < 4; ++i) { v[i] = ip[lane + 64 * i]; ss += v[i].x * v[i].x + v[i].y * v[i].y + v[i].z * v[i].z + v[i].w * v[i].w; }
        ss = wave_sum(ss);
        const float sc = dscale / sqrtf(ss * (1.f / D) + 1e-6f);
#pragma unroll
        for (int i = 0; i < 4; ++i) {
            const float4 gg = ((const float4*)g)[lane + 64 * i];
            float4 o; o.x = v[i].x * sc * gg.x; o.y = v[i].y * sc * gg.y; o.z = v[i].z * sc * gg.z; o.w = v[i].w * sc * gg.w;
            if constexpr (sizeof(OUT) == 4) ((float4*)((float*)out + (size_t)r * D))[lane + 64 * i] = o;
            else { u32x2 w; w.x = cvt_pk_bf16(o.x, o.y); w.y = cvt_pk_bf16(o.z, o.w); ((u32x2*)((bf16_t*)out + (size_t)r * D))[lane + 64 * i] = w; }
        }
    }
}

__device__ __forceinline__ void ph_ckvnorm(const Params& p, int layer, int bid, int nb) {
    const int lane = tidx() & 63, wid = tidx() >> 6;
    const float* g = p.kv_norm + layer * 128;
    for (int r = bid * 4 + wid; r < T; r += nb * 4) {
        const float* ip = p.CKVR() + (size_t)r * 128;
        const float a = ip[lane], b = ip[lane + 64];
        const float ss = wave_sum(a * a + b * b);
        const float sc = 1.0f / sqrtf(ss * (1.f / 128.f) + 1e-6f);
        p.CKV()[(size_t)r * 128 + lane] = f2bf(a * sc * g[lane]);
        p.CKV()[(size_t)r * 128 + lane + 64] = f2bf(b * sc * g[lane + 64]);
    }
}

template <bool MAPIN = false>
__device__ __forceinline__ void convert_wt(const float* __restrict__ src, bf16_t* __restrict__ dst, int K, int N, int nmat, int bid, int nb, float* sm) {
    float (*tl)[65] = (float (*)[65])sm;
    const int tid = tidx(), tk = K / 64, tn = (N + 63) / 64, per = tk * tn;
    for (int it = bid; it < per * nmat; it += nb) {
        const int mat = it / per, r = it % per, k0 = (r % tk) * 64, n0 = (r / tk) * 64;
        const float* s = src + (size_t)mat * K * N; bf16_t* d = dst + (size_t)mat * K * N;
        for (int i = tid; i < 64 * 64; i += 256) { const int kk = i >> 6, nn = i & 63; tl[kk][nn] = (n0 + nn < N) ? s[(size_t)(k0 + kk) * N + n0 + nn] : 0.f; }
        __syncthreads();
        {
            const int nn = tid >> 2, kq = (tid & 3) * 16;
            if (n0 + nn < N) {
                u32x4 w0, w1;
                w0.x = cvt_pk_bf16(tl[kq + 0][nn], tl[kq + 1][nn]); w0.y = cvt_pk_bf16(tl[kq + 2][nn], tl[kq + 3][nn]);
                w0.z = cvt_pk_bf16(tl[kq + 4][nn], tl[kq + 5][nn]); w0.w = cvt_pk_bf16(tl[kq + 6][nn], tl[kq + 7][nn]);
                w1.x = cvt_pk_bf16(tl[kq + 8][nn], tl[kq + 9][nn]); w1.y = cvt_pk_bf16(tl[kq + 10][nn], tl[kq + 11][nn]);
                w1.z = cvt_pk_bf16(tl[kq + 12][nn], tl[kq + 13][nn]); w1.w = cvt_pk_bf16(tl[kq + 14][nn], tl[kq + 15][nn]);
                const int drow = MAPIN ? map_in_col(n0 + nn) : (n0 + nn);
                u32x4* dp = (u32x4*)(d + (size_t)drow * K + k0 + kq);
                dp[0] = w0; dp[1] = w1;
            }
        }
        __syncthreads();
    }
}

constexpr int GROW = 80;
constexpr int GA_BYTES = 128 * GROW;
struct GStage { u32x4 a0, a1, b0, b1; };
template <int BN, int DEPTH = 3>
__device__ __forceinline__ void tile_mac(f32x16 (&acc)[2][BN / 64], const bf16_t* __restrict__ A, int lda, int m0,
                                         const bf16_t* __restrict__ Bt, int ldb, int n0, int nmax, int K, char* sm) {
    constexpr int NT = BN / 64;
    constexpr int B_BYTES = BN * GROW;
    constexpr int BUF = GA_BYTES + B_BYTES;
    const int tid = tidx(), lane = tid & 63, wid = __builtin_amdgcn_readfirstlane(tid >> 6), wr = wid >> 1, wc = wid & 1;
    const int lr = lane & 31, lh = lane >> 5;
    const int ar0 = tid >> 2, akq = tid & 3;
    const bf16_t* Ab = A + (size_t)m0 * lda;
    const bf16_t* Bb = Bt + (size_t)n0 * ldb;
    const unsigned ao0 = (unsigned)(ar0 * lda + akq * 8), ao1 = ao0 + (unsigned)(64 * lda);
    const int br0 = tid >> 2;
    const bool bv0 = (n0 + br0) < nmax, bv1 = (NT == 2) && ((n0 + br0 + 64) < nmax);
    const unsigned bo0 = (unsigned)((bv0 ? br0 : 0) * ldb + akq * 8), bo1 = (unsigned)((bv1 ? br0 + 64 : 0) * ldb + akq * 8);
    const int st_a0 = ar0 * GROW + akq * 16, st_a1 = (ar0 + 64) * GROW + akq * 16;
    const int st_b0 = GA_BYTES + br0 * GROW + akq * 16, st_b1 = GA_BYTES + (br0 + 64) * GROW + akq * 16;
    const int rd_a = (wr * 64 + lr) * GROW + lh * 16, rd_b = GA_BYTES + (wc * (BN / 2) + lr) * GROW + lh * 16;
    const u32x4 zero4 = {0u, 0u, 0u, 0u};
    const int nk = K / 32;
    auto gload = [&](GStage& g, int ks) {
        const unsigned ko = (unsigned)ks * 32u;
        g.a0 = *(const u32x4*)(Ab + (ao0 + ko)); g.a1 = *(const u32x4*)(Ab + (ao1 + ko));
        g.b0 = *(const u32x4*)(Bb + (bo0 + ko)); if (NT == 2) g.b1 = *(const u32x4*)(Bb + (bo1 + ko));
    };
    auto lstore = [&](const GStage& g, char* buf) {
        *(u32x4*)(buf + st_a0) = g.a0; *(u32x4*)(buf + st_a1) = g.a1;
        *(u32x4*)(buf + st_b0) = bv0 ? g.b0 : zero4; if (NT == 2) *(u32x4*)(buf + st_b1) = bv1 ? g.b1 : zero4;
    };
    auto compute = [&](const char* cur) {
#pragma unroll
        for (int s = 0; s < 2; ++s) {
            bf16x8 a[2], b[NT];
#pragma unroll
            for (int mi = 0; mi < 2; ++mi) a[mi] = *(const bf16x8*)(cur + rd_a + mi * 32 * GROW + s * 32);
#pragma unroll
            for (int ni = 0; ni < NT; ++ni) b[ni] = *(const bf16x8*)(cur + rd_b + ni * 32 * GROW + s * 32);
#pragma unroll
            for (int mi = 0; mi < 2; ++mi)
#pragma unroll
                for (int ni = 0; ni < NT; ++ni) acc[mi][ni] = __builtin_amdgcn_mfma_f32_32x32x16_bf16(a[mi], b[ni], acc[mi][ni], 0, 0, 0);
        }
    };
    GStage g0, g1, g2;
    g1.b1 = zero4; g2.b1 = zero4; g0.b1 = zero4;
    const int last = nk - 1;
    gload(g0, 0);
    gload(g1, min(1, last));
    if (DEPTH == 3) gload(g2, min(2, last));
    __syncthreads();
    lstore(g0, sm);
    __syncthreads();
#define GSTEP(k, GL, GS) { gload(GL, min((k) + DEPTH, last)); compute(sm + ((k) & 1) * BUF); lstore(GS, sm + (((k) + 1) & 1) * BUF); __syncthreads(); }
    int ks = 0;
    if (DEPTH == 3) {
#pragma unroll 1
        for (; ks + 3 <= nk; ks += 3) {
            GSTEP(ks, g0, g1)
            GSTEP(ks + 1, g1, g2)
            GSTEP(ks + 2, g2, g0)
        }
        if (ks < nk) {
            GSTEP(ks, g0, g1)
            if (ks + 1 < nk) GSTEP(ks + 1, g1, g2)
        }
    } else if (DEPTH == 2) {
#pragma unroll 1
        for (; ks + 2 <= nk; ks += 2) {
            GSTEP(ks, g0, g1)
            GSTEP(ks + 1, g1, g0)
        }
        if (ks < nk) GSTEP(ks, g0, g1)
    } else {
#pragma unroll 1
        for (; ks < nk; ++ks) GSTEP(ks, g1, g1)
    }
#undef GSTEP
}
template <int NT> __device__ __forceinline__ void acc_zero(f32x16 (&acc)[2][NT]) {
#pragma unroll
    for (int mi = 0; mi < 2; ++mi)
#pragma unroll
        for (int ni = 0; ni < NT; ++ni)
#pragma unroll
            for (int r = 0; r < 16; ++r) acc[mi][ni][r] = 0.f;
}
template <int BN, class Epi>
__device__ __forceinline__ void gemm_bf16(const bf16_t* A, int lda, const bf16_t* Bt, int ldb, int M, int N, int K, const Epi& epi, int bid, int nb, char* sm) {
    constexpr int NT = BN / 64;
    const int tm = M / 128, tn = (N + BN - 1) / BN;
    const int lane = tidx() & 63, wid = __builtin_amdgcn_readfirstlane(tidx() >> 6), wr = wid >> 1, wc = wid & 1, lr = lane & 31, lh = lane >> 5;
    for (int tile = bid; tile < tm * tn; tile += nb) {
        const int m0 = (tile % tm) * 128, n0 = (tile / tm) * BN;
        f32x16 acc[2][NT]; acc_zero<NT>(acc);
        tile_mac<BN>(acc, A, lda, m0, Bt, ldb, n0, N, K, sm);
        const int col0 = n0 + wc * (BN / 2);
        if (col0 < N) epi(acc, m0 + wr * 64, col0, lr, lh);
    }
}
#define EROW(mi, r) (row0 + (mi) * 32 + ((r) & 3) + 8 * ((r) >> 2) + 4 * lh)
__device__ __forceinline__ float bf2f(bf16_t h) { return __uint_as_float((unsigned)h << 16); }
__device__ __forceinline__ void epi_rope64(const f32x16 (&acc)[2][2], int row0, int lr, int lh, const float* __restrict__ rope, bf16_t* __restrict__ dst, int ld, int cbase) {
#pragma unroll
    for (int mi = 0; mi < 2; ++mi)
#pragma unroll
        for (int r = 0; r < 16; ++r) {
            const size_t row = EROW(mi, r);
            const float c = rope[row * 64 + lr], s = rope[row * 64 + 32 + lr], x1 = acc[mi][0][r], x2 = acc[mi][1][r];
            dst[row * ld + cbase + lr] = f2bf(x1 * c - x2 * s); dst[row * ld + cbase + 32 + lr] = f2bf(x2 * c + x1 * s);
        }
}
template <int NTI>
__device__ __forceinline__ void epi_rope32(const f32x16 (&acc)[2][2], int row0, int lr, int lh, const float* __restrict__ rope, bf16_t* __restrict__ dst, int ld, int cbase) {
    const int f = lr & 15;
#pragma unroll
    for (int mi = 0; mi < 2; ++mi)
#pragma unroll
        for (int ni = 0; ni < NTI; ++ni)
#pragma unroll
            for (int r = 0; r < 16; ++r) {
                const size_t row = EROW(mi, r);
                const float x = acc[mi][ni][r], xo = __shfl_xor(x, 16, 64);
                const float c = rope[row * 64 + 2 * f], s = rope[row * 64 + 32 + 2 * f];
                dst[row * ld + cbase + ni * 32 + lr] = f2bf((lr & 16) ? (x * c + xo * s) : (x * c - xo * s));
            }
}
template <int NT, bool SILU>
__device__ __forceinline__ void epi_bf16(const f32x16 (&acc)[2][NT], int row0, int lr, int lh, bf16_t* __restrict__ dst, int ld, int cbase) {
#pragma unroll
    for (int mi = 0; mi < 2; ++mi)
#pragma unroll
        for (int ni = 0; ni < NT; ++ni)
#pragma unroll
            for (int r = 0; r < 16; ++r) { const float v = acc[mi][ni][r]; dst[(size_t)EROW(mi, r) * ld + cbase + ni * 32 + lr] = f2bf(SILU ? silu_(v) : v); }
}
template <int NT>
__device__ __forceinline__ void epi_vt(const f32x16 (&acc)[2][NT], int trow0, int lr, int lh, bf16_t* __restrict__ vt, size_t ldv) {
#pragma unroll
    for (int mi = 0; mi < 2; ++mi)
#pragma unroll
        for (int ni = 0; ni < NT; ++ni)
#pragma unroll
            for (int g = 0; g < 4; ++g) {
                u32x2 o; o.x = cvt_pk_bf16(acc[mi][ni][4 * g], acc[mi][ni][4 * g + 1]); o.y = cvt_pk_bf16(acc[mi][ni][4 * g + 2], acc[mi][ni][4 * g + 3]);
                *(u32x2*)(vt + (size_t)(ni * 32 + lr) * ldv + trow0 + mi * 32 + 8 * g + 4 * lh) = o;
            }
}
template <int NT>
__device__ __forceinline__ void epi_f32(const f32x16 (&acc)[2][NT], int row0, int lr, int lh, float* __restrict__ dst, int ld, int cbase) {
#pragma unroll
    for (int mi = 0; mi < 2; ++mi)
#pragma unroll
        for (int ni = 0; ni < NT; ++ni)
#pragma unroll
            for (int r = 0; r < 16; ++r) dst[(size_t)EROW(mi, r) * ld + cbase + ni * 32 + lr] = acc[mi][ni][r];
}
struct EpiInProj {
    const Params& p; int layer;
    __device__ __forceinline__ void operator()(const f32x16 (&acc)[2][2], int row0, int col0, int lr, int lh) const {
        const int b = row0 / S, t0 = row0 % S;
        const float* rope = p.ROPE();
        int kind, ld = 256, cbase = 0; size_t off = 0; bool silu = false;
        if (col0 < M_QN)         { kind = 0; off = OFF_QA; cbase = col0 - M_QA; }
        else if (col0 < M_KSLC)  { kind = 0; off = OFF_QN; cbase = col0 - M_QN; }
        else if (col0 == M_KSLC) { kind = 0; off = OFF_KSLC; ld = 64; }
        else if (col0 == M_KWIN) { kind = 0; off = OFF_KWIN; ld = 64; }
        else if (col0 == M_KC)   { kind = 0; off = OFF_KCT; ld = 64; }
        else if (col0 == M_VC)   { kind = 1; off = OFF_VCTOK; ld = 64; }
        else if (col0 < M_KF)    { kind = 1; off = OFF_QF; cbase = col0 - M_QF; }
        else if (col0 < M_QS)    { kind = 1; off = OFF_KF; cbase = col0 - M_KF; }
        else if (col0 < M_KSB)   { kind = 1; off = OFF_QS; cbase = col0 - M_QS; }
        else if (col0 < M_QM)    { kind = 1; off = OFF_KSB; cbase = col0 - M_KSB; }
        else if (col0 < M_VF)    { kind = 1; off = OFF_QM; cbase = col0 - M_QM; }
        else if (col0 < M_VS)    { kind = 2; off = OFF_VFT + ((size_t)(b * 4 + (col0 - M_VF) / 64) * 64) * S * 2; }
        else if (col0 < M_VSLC)  { kind = 2; off = OFF_VST + ((size_t)(b * 4 + (col0 - M_VS) / 64) * 64) * S * 2; }
        else if (col0 == M_VSLC) { kind = 2; off = OFF_VSLCT + ((size_t)b * 64) * S * 2; }
        else if (col0 == M_VWIN) { kind = 2; off = OFF_VWINT + ((size_t)b * 64) * S * 2; }
        else if (col0 < M_SPC)   { kind = 3; off = OFF_QI; ld = 128; cbase = col0 - M_QI; }
        else if (col0 == M_SPC)  { kind = 4; }
        else if (col0 < M_Z)     { kind = 5; off = OFF_CKVR; ld = 128; cbase = col0 - M_CKV; }
        else if (col0 < NPM)     { kind = 1; off = OFF_ZG; ld = 1280; cbase = col0 - M_Z; silu = true; }
        else if (col0 < M_MERGE) { return; }
        else                     { kind = 6; }
        bf16_t* dst = (bf16_t*)(p.ws + off);
        if (kind == 0) epi_rope64(acc, row0, lr, lh, rope, dst, ld, cbase);
        else if (kind == 1) {
#pragma unroll
            for (int mi = 0; mi < 2; ++mi)
#pragma unroll
                for (int ni = 0; ni < 2; ++ni)
#pragma unroll
                    for (int r = 0; r < 16; ++r) { const float v = acc[mi][ni][r]; dst[(size_t)EROW(mi, r) * ld + cbase + ni * 32 + lr] = f2bf(silu ? silu_(v) : v); }
        }
        else if (kind == 2) epi_vt<2>(acc, t0, lr, lh, dst, S);
        else if (kind == 3) epi_rope32<2>(acc, row0, lr, lh, rope, dst, ld, cbase);
        else if (kind == 5) epi_f32<2>(acc, row0, lr, lh, (float*)dst, ld, cbase);
        else if (kind == 6) {
            const int tile = (row0 >> 7) * 40 + ((col0 - M_MERGE) >> 7), wave = ((row0 >> 6) & 1) * 2 + ((col0 >> 6) & 1);
            bf16_t* sp = p.SIG() + ((size_t)(tile * 4 + wave) * 4) * 1024 + (size_t)(lh * 32 + lr) * 16;
#pragma unroll
            for (int mi = 0; mi < 2; ++mi)
#pragma unroll
                for (int ni = 0; ni < 2; ++ni) {
                    u32x4 w0, w1;
                    w0.x = cvt_pk_bf16(sigmoid_(acc[mi][ni][0]), sigmoid_(acc[mi][ni][1])); w0.y = cvt_pk_bf16(sigmoid_(acc[mi][ni][2]), sigmoid_(acc[mi][ni][3]));
                    w0.z = cvt_pk_bf16(sigmoid_(acc[mi][ni][4]), sigmoid_(acc[mi][ni][5])); w0.w = cvt_pk_bf16(sigmoid_(acc[mi][ni][6]), sigmoid_(acc[mi][ni][7]));
                    w1.x = cvt_pk_bf16(sigmoid_(acc[mi][ni][8]), sigmoid_(acc[mi][ni][9])); w1.y = cvt_pk_bf16(sigmoid_(acc[mi][ni][10]), sigmoid_(acc[mi][ni][11]));
                    w1.z = cvt_pk_bf16(sigmoid_(acc[mi][ni][12]), sigmoid_(acc[mi][ni][13])); w1.w = cvt_pk_bf16(sigmoid_(acc[mi][ni][14]), sigmoid_(acc[mi][ni][15]));
                    u32x4* d4 = (u32x4*)(sp + (size_t)(mi * 2 + ni) * 1024);
                    d4[0] = w0; d4[1] = w1;
                }
        }
        else {
            epi_rope32<1>(acc, row0, lr, lh, rope, p.KI(), 32, 0);
            const float fb = p.fox_bias[layer * 4 + (lr & 3)];
#pragma unroll
            for (int mi = 0; mi < 2; ++mi)
#pragma unroll
                for (int r = 0; r < 16; ++r) {
                    const size_t row = EROW(mi, r); const float v = acc[mi][1][r];
                    if (lr < 4) p.WI()[row * 4 + lr] = v * 0.08838834764831845f;
                    else if (lr < 8) p.LOGF()[row * 4 + lr - 4] = logsig_(v + fb);
                    else if (lr < 20) p.GN()[row * 12 + lr - 8] = sigmoid_(v);
                }
        }
    }
};
struct EpiMemKV {
    const Params& p;
    __device__ __forceinline__ void operator()(const f32x16 (&acc)[2][2], int row0, int col0, int lr, int lh) const {
        if (col0 < 256) epi_bf16<2, false>(acc, row0, lr, lh, p.MKB(), 256, col0);
        else epi_vt<2>(acc, row0 % NMEM, lr, lh, p.MVT() + ((size_t)((row0 / NMEM) * 4 + (col0 - 256) / 64) * 64) * NMEM, NMEM);
    }
};
struct EpiKA { const Params& p;
    __device__ __forceinline__ void operator()(const f32x16 (&acc)[2][2], int row0, int col0, int lr, int lh) const { epi_rope64(acc, row0, lr, lh, p.ROPE(), p.KAB(), 256, col0); } };
struct EpiVA { const Params& p;
    __device__ __forceinline__ void operator()(const f32x16 (&acc)[2][2], int row0, int col0, int lr, int lh) const {
        epi_vt<2>(acc, row0 % S, lr, lh, p.VAT() + ((size_t)((row0 / S) * 4 + col0 / 64) * 64) * S, S); } };
struct EpiResid { const float* Xin; float* Xout;
    __device__ __forceinline__ void operator()(const f32x16 (&acc)[2][2], int row0, int col0, int lr, int lh) const {
#pragma unroll
        for (int mi = 0; mi < 2; ++mi) {
            float xv[2][16];
#pragma unroll
            for (int ni = 0; ni < 2; ++ni)
#pragma unroll
                for (int r = 0; r < 16; ++r) xv[ni][r] = Xin[(size_t)EROW(mi, r) * D + col0 + ni * 32 + lr];
#pragma unroll
            for (int ni = 0; ni < 2; ++ni)
#pragma unroll
                for (int r = 0; r < 16; ++r) Xout[(size_t)EROW(mi, r) * D + col0 + ni * 32 + lr] = xv[ni][r] + acc[mi][ni][r];
        }
    } };
struct EpiCmp1 { const float* bias; bf16_t* hid;
    __device__ __forceinline__ void operator()(const f32x16 (&acc)[2][1], int row0, int col0, int lr, int lh) const {
        const float bv = bias[col0 + lr];
#pragma unroll
        for (int mi = 0; mi < 2; ++mi)
#pragma unroll
            for (int r = 0; r < 16; ++r) hid[(size_t)EROW(mi, r) * 128 + col0 + lr] = f2bf(silu_(acc[mi][0][r] + bv));
    } };
struct EpiCmp2K { bf16_t* kcb;
    __device__ __forceinline__ void operator()(const f32x16 (&acc)[2][1], int row0, int col0, int lr, int lh) const {
#pragma unroll
        for (int mi = 0; mi < 2; ++mi)
#pragma unroll
            for (int r = 0; r < 16; ++r) { const int row = EROW(mi, r); kcb[(size_t)row * 64 + col0 + lr] = ((row & 511) == 511) ? (bf16_t)0 : f2bf(acc[mi][0][r]); }
    } };
struct EpiCmp2V { bf16_t* vct;
    __device__ __forceinline__ void operator()(const f32x16 (&acc)[2][1], int row0, int col0, int lr, int lh) const {
        bf16_t* base = vct + ((size_t)(row0 / 512) * 64 + col0) * 512;
        const int n0 = row0 % 512;
#pragma unroll
        for (int mi = 0; mi < 2; ++mi)
#pragma unroll
            for (int g = 0; g < 4; ++g) {
                const int n = n0 + mi * 32 + 8 * g + 4 * lh;
                u32x2 o; o.x = cvt_pk_bf16(acc[mi][0][4 * g], acc[mi][0][4 * g + 1]); o.y = cvt_pk_bf16(acc[mi][0][4 * g + 2], (n + 3 == 511) ? 0.f : acc[mi][0][4 * g + 3]);
                *(u32x2*)(base + (size_t)lr * 512 + n) = o;
            }
    } };

__device__ __forceinline__ void ph_merge(const Params& p, int layer, int bid, int nb, char* sm) {
    const int lane = tidx() & 63, wid = __builtin_amdgcn_readfirstlane(tidx() >> 6), wr = wid >> 1, wc = wid & 1, lr = lane & 31, lh = lane >> 5;
    for (int tile = bid; tile < (T / 128) * (D / 128); tile += nb) {
        const int mt = tile % (T / 128), nt = tile / (T / 128), m0 = mt * 128, n0 = nt * 128;
        f32x16 mg[2][2]; acc_zero<2>(mg);
#pragma unroll 1
        for (int n = 0; n < 5; ++n) {
            f32x16 g[2][2]; acc_zero<2>(g);
            tile_mac<128>(g, p.Y() + n * 256, 1280, m0, p.WBR() + ((size_t)layer * 5 + n) * D * 256, 256, n0, D, 256, sm);
            const bf16_t* sp = p.SIG() + ((size_t)((mt * 40 + n * 8 + nt) * 4 + wid) * 4) * 1024 + (size_t)lane * 16;
#pragma unroll
            for (int mi = 0; mi < 2; ++mi)
#pragma unroll
                for (int ni = 0; ni < 2; ++ni) {
                    const u32x4* s4 = (const u32x4*)(sp + (size_t)(mi * 2 + ni) * 1024);
                    const u32x4 w0 = s4[0], w1 = s4[1];
                    const unsigned sw[8] = {w0.x, w0.y, w0.z, w0.w, w1.x, w1.y, w1.z, w1.w};
#pragma unroll
                    for (int r = 0; r < 8; ++r) {
                        mg[mi][ni][2 * r] = fmaf(__uint_as_float(sw[r] << 16), g[mi][ni][2 * r], mg[mi][ni][2 * r]);
                        mg[mi][ni][2 * r + 1] = fmaf(__uint_as_float(sw[r] & 0xffff0000u), g[mi][ni][2 * r + 1], mg[mi][ni][2 * r + 1]);
                    }
                }
        }
        epi_bf16<2, false>(mg, m0 + wr * 64, lr, lh, p.MG(), D, n0 + wc * 64);
    }
}

__device__ __forceinline__ void ph_cumsum(const Params& p, int bid, int nb, float* sm) {
    const int tid = tidx();
    for (int item = bid; item < NBATCH * 4; item += nb) {
        const int b = item >> 2, h = item & 3;
        const float* src = p.LOGF() + (size_t)b * S * 4 + h;
        float* dst = p.CUM() + (size_t)b * S * 4 + h;
        float loc = 0.f;
        for (int i = 0; i < 32; ++i) loc += src[(size_t)(tid * 32 + i) * 4];
        sm[tid] = loc; __syncthreads();
        if (tid == 0) { float run = 0.f; for (int i = 0; i < 256; ++i) { const float v = sm[i]; sm[i] = run; run += v; } }
        __syncthreads();
        float run = sm[tid];
        float* dt = p.CUMT() + (size_t)item * S;
        for (int i = 0; i < 32; ++i) { run += src[(size_t)(tid * 32 + i) * 4]; dst[(size_t)(tid * 32 + i) * 4] = run; dt[tid * 32 + i] = run * 1.4426950408889634f; }
        __syncthreads();
    }
}

enum { AM_FOX = 0, AM_DSA = 1, AM_SLC = 2, AM_SB = 3, AM_WIN = 4, AM_MEM = 5, AM_CMP = 6 };
constexpr int AK_ROW = 144;
constexpr int AK_TILE = 64 * AK_ROW;
constexpr int ABUF = 2 * AK_TILE + 256;
constexpr float LOG2E = 1.4426950408889634f;
#define NEG_INF (-__builtin_inff())

template <int MODE>
__device__ __forceinline__ void attn_unit(const Params& p, int b, int head, int qblk, char* sm) {
    const int tid = tidx(), lane = tid & 63, wid = __builtin_amdgcn_readfirstlane(tid >> 6), lr = lane & 31, lh = lane >> 5;
    const int q0 = qblk * 128, qw0 = q0 + 32 * wid, tq = qw0 + lr;
    const size_t gq = (size_t)b * S + tq;
    const bf16_t *Qp, *Kp, *VTp; int ldk, ldv;
    if (MODE == AM_FOX)      { Qp = p.QF() + gq * 256 + head * 64; Kp = p.KF() + (size_t)b * S * 256 + head * 64; ldk = 256; VTp = p.VFT() + ((size_t)(b * 4 + head) * 64) * S; ldv = S; }
    else if (MODE == AM_DSA) { Qp = p.QA() + gq * 256 + head * 64; Kp = p.KAB() + (size_t)b * S * 256 + head * 64; ldk = 256; VTp = p.VAT() + ((size_t)(b * 4 + head) * 64) * S; ldv = S; }
    else if (MODE == AM_SB)  { Qp = p.QS() + gq * 256 + head * 64; Kp = p.KSB() + (size_t)b * S * 256 + head * 64; ldk = 256; VTp = p.VST() + ((size_t)(b * 4 + head) * 64) * S; ldv = S; }
    else if (MODE == AM_SLC) { Qp = p.QN() + gq * 256 + head * 64; Kp = p.KSLC() + (size_t)b * S * 64; ldk = 64; VTp = p.VSLCT() + ((size_t)b * 64) * S; ldv = S; }
    else if (MODE == AM_WIN) { Qp = p.QN() + gq * 256 + head * 64; Kp = p.KWIN() + (size_t)b * S * 64; ldk = 64; VTp = p.VWINT() + ((size_t)b * 64) * S; ldv = S; }
    else if (MODE == AM_CMP) { Qp = p.QN() + gq * 256 + head * 64; Kp = p.KCB() + (size_t)b * NCMP_PAD * 64; ldk = 64; VTp = p.VCT() + ((size_t)b * 64) * NCMP_PAD; ldv = NCMP_PAD; }
    else                     { Qp = p.QM() + gq * 256 + head * 64; Kp = p.MKB() + (size_t)b * NMEM * 256 + head * 64; ldk = 256; VTp = p.MVT() + ((size_t)(b * 4 + head) * 64) * NMEM; ldv = NMEM; }
    int kt_lo = 0, kt_hi = 2 * qblk + 2;
    if (MODE == AM_WIN) kt_lo = q0 >= 512 ? (q0 - 512) / 64 : 0;
    if (MODE == AM_MEM) kt_hi = NMEM / 64;
    if (MODE == AM_CMP) kt_hi = min(8, (((q0 + 96) >> 4) >> 6) + 1);
    const int nlim = (tq - 31) >> 4;
    const int ntile = kt_hi - kt_lo;
    constexpr bool REV = (MODE == AM_SB);

    bf16x8 qf[4];
#pragma unroll
    for (int s = 0; s < 4; ++s) qf[s] = *(const bf16x8*)(Qp + 16 * s + 8 * lh);
    unsigned smw[4] = {0u, 0u, 0u, 0u};
    if (MODE == AM_SLC) { const u32x4 w = *(const u32x4*)(p.SMASK() + gq * 4); smw[0] = w.x; smw[1] = w.y; smw[2] = w.z; smw[3] = w.w; }
    const unsigned long long* mrow = (const unsigned long long*)(p.DMASK() + gq * 256);
    const float* csp = p.CUMT() + (size_t)(b * 4 + head) * S;

    const int srow = tid >> 3, sc16 = tid & 7;
    const int st0 = srow * AK_ROW + sc16 * 16, st1 = (srow + 32) * AK_ROW + sc16 * 16;
    const bf16_t* kg0 = Kp + (size_t)srow * ldk + sc16 * 8;
    const bf16_t* kg1 = Kp + (size_t)(srow + 32) * ldk + sc16 * 8;
    const bf16_t* vg0 = VTp + (size_t)srow * ldv + sc16 * 8;
    const bf16_t* vg1 = VTp + (size_t)(srow + 32) * ldv + sc16 * 8;
    u32x4 rk0, rk1, rv0, rv1; float rcs = 0.f;
    auto gload = [&](int kt) {
        rk0 = *(const u32x4*)(kg0 + (size_t)kt * 64 * ldk); rk1 = *(const u32x4*)(kg1 + (size_t)kt * 64 * ldk);
        rv0 = *(const u32x4*)(vg0 + kt * 64); rv1 = *(const u32x4*)(vg1 + kt * 64);
        if (MODE == AM_FOX) { if (tid < 64) rcs = csp[kt * 64 + tid]; }
    };
    auto lstore = [&](char* buf) {
        *(u32x4*)(buf + st0) = rk0; *(u32x4*)(buf + st1) = rk1;
        *(u32x4*)(buf + AK_TILE + st0) = rv0; *(u32x4*)(buf + AK_TILE + st1) = rv1;
        if (MODE == AM_FOX) { if (tid < 64) *(float*)(buf + 2 * AK_TILE + tid * 4) = rcs; }
    };
    const int pil = (lr & 0x13) | ((lr & 4) << 1) | ((lr & 8) >> 1);
    const int rdk = pil * AK_ROW + lh * 16;
    const int rdv = AK_TILE + lr * AK_ROW + lh * 16;

    float m = NEG_INF, l = 0.f, R = 0.f;
    f32x16 O[2];
#pragma unroll
    for (int i = 0; i < 16; ++i) { O[0][i] = 0.f; O[1][i] = 0.f; }

    gload(REV ? kt_hi - 1 : kt_lo);
    __syncthreads();
    lstore(sm);
    __syncthreads();
#pragma unroll 1
    for (int it = 0; it < ntile; ++it) {
        const int kt = REV ? kt_hi - 1 - it : kt_lo + it;
        char* cur = sm + (it & 1) * ABUF;
        const bool more = (it + 1) < ntile;
        if (more) gload(REV ? kt - 1 : kt + 1);
        unsigned long long mw = 0ull;
        if (MODE == AM_DSA) mw = mrow[kt];
        bool need = true;
        if (MODE == AM_CMP) need = kt * 64 <= (qw0 >> 4);
        else if (MODE != AM_MEM) need = kt * 64 <= qw0 + 31;
        if (MODE == AM_WIN) need = need && (kt * 64 + 63 >= qw0 - 511);
        if (need) {
#pragma unroll
            for (int sb2 = 0; sb2 < 2; ++sb2) {
                const int sub = REV ? 1 - sb2 : sb2;
                const int kb = kt * 64 + sub * 32;
                bool sneed = true;
                if (MODE == AM_CMP) sneed = kb <= (qw0 >> 4);
                else if (MODE != AM_MEM) sneed = kb <= qw0 + 31;
                if (MODE == AM_WIN) sneed = sneed && (kb + 31 >= qw0 - 511);
                if (sneed) {
                    f32x16 s;
#pragma unroll
                    for (int i = 0; i < 16; ++i) s[i] = 0.f;
#pragma unroll
                    for (int s4 = 0; s4 < 4; ++s4) {
                        const bf16x8 kf = *(const bf16x8*)(cur + rdk + sub * 32 * AK_ROW + s4 * 32);
                        s = __builtin_amdgcn_mfma_f32_32x32x16_bf16(kf, qf[s4], s, 0, 0, 0);
                    }
                    const int thl = tq - kb - 8 * lh;
                    bf16x8 pf[2];
                    if (MODE == AM_SB) {
                        float lk[16];
#pragma unroll
                        for (int r = 0; r < 16; ++r) {
                            const int cr = 16 * (r >> 3) + (r & 7);
                            const float z = s[r] * 0.125f;
                            const float az = fabsf(z);
                            const float sp = fmaxf(z, 0.f) + __builtin_amdgcn_logf(1.f + __builtin_amdgcn_exp2f(-az * LOG2E)) * 0.6931471805599453f;
                            const bool ok = cr < thl;
                            lk[r] = ok ? -sp : 0.f;
                            s[r] = ok ? z : NEG_INF;
                        }
                        float g0 = 0.f, g1 = 0.f;
#pragma unroll
                        for (int r = 0; r < 8; ++r) { g0 += lk[r]; g1 += lk[8 + r]; }
                        const float pg0 = __shfl_xor(g0, 32, 64), pg1 = __shfl_xor(g1, 32, 64);
                        const float off0 = R + (lh == 0 ? (pg0 + g1 + pg1) : (pg1 + g1));
                        const float off1 = R + (lh == 0 ? pg1 : 0.f);
                        float run0 = off0, run1 = off1;
#pragma unroll
                        for (int r = 7; r >= 0; --r) {
                            const float a0 = __builtin_amdgcn_exp2f((s[r] + lk[r] + run0) * LOG2E); run0 += lk[r];
                            const float a1 = __builtin_amdgcn_exp2f((s[8 + r] + lk[8 + r] + run1) * LOG2E); run1 += lk[8 + r];
                            s[r] = a0; s[8 + r] = a1;
                        }
                        R += (g0 + g1) + (pg0 + pg1);
                    } else {
                        constexpr float c = 0.125f * LOG2E;
                        if (MODE == AM_FOX) {
                            const float4* cs4 = (const float4*)(cur + 2 * AK_TILE + (sub * 32 + 8 * lh) * 4);
                            const float4 c0 = cs4[0], c1 = cs4[1], c2 = cs4[4], c3 = cs4[5];
                            const float cv[16] = {c0.x, c0.y, c0.z, c0.w, c1.x, c1.y, c1.z, c1.w, c2.x, c2.y, c2.z, c2.w, c3.x, c3.y, c3.z, c3.w};
#pragma unroll
                            for (int r = 0; r < 16; ++r) s[r] = fmaf(s[r], c, -cv[r]);
                        } else {
#pragma unroll
                            for (int r = 0; r < 16; ++r) s[r] *= c;
                        }
                        if (MODE == AM_DSA) {
                            const unsigned w = (unsigned)(mw >> (32 * sub)) >> (8 * lh);
#pragma unroll
                            for (int r = 0; r < 16; ++r) { const int cr = 16 * (r >> 3) + (r & 7); s[r] = (w & (1u << cr)) ? s[r] : NEG_INF; }
                        }
                        if (MODE == AM_SLC) {
                            const unsigned w = smw[0] * (kt < 32) + smw[1] * (kt >= 32 && kt < 64) + smw[2] * (kt >= 64 && kt < 96) + smw[3] * (kt >= 96);
                            const bool sel = (w >> (kt & 31)) & 1u;
#pragma unroll
                            for (int r = 0; r < 16; ++r) s[r] = sel ? s[r] : NEG_INF;
                        }
                        if (MODE == AM_FOX || MODE == AM_SLC) {
                            if (kb + 31 > qw0) {
#pragma unroll
                                for (int r = 0; r < 16; ++r) { const int cr = 16 * (r >> 3) + (r & 7); s[r] = (cr <= thl) ? s[r] : NEG_INF; }
                            }
                        }
                        if (MODE == AM_CMP) {
                            const int tc = nlim - kb - 8 * lh;
#pragma unroll
                            for (int r = 0; r < 16; ++r) { const int cr = 16 * (r >> 3) + (r & 7); s[r] = (cr <= tc) ? s[r] : NEG_INF; }
                        }
                        if (MODE == AM_WIN) {
                            if (kb + 31 > qw0 || kb < qw0 + 31 - 511) {
#pragma unroll
                                for (int r = 0; r < 16; ++r) { const int cr = 16 * (r >> 3) + (r & 7); s[r] = (cr <= thl && cr > thl - 512) ? s[r] : NEG_INF; }
                            }
                        }
                        float tmax = s[0];
#pragma unroll
                        for (int r = 1; r < 16; ++r) tmax = fmaxf(tmax, s[r]);
                        tmax = fmaxf(tmax, __shfl_xor(tmax, 32, 64));
                        const float mn = fmaxf(m, tmax);
                        const float mu = (mn == NEG_INF) ? 0.f : mn;
                        const float corr = __builtin_amdgcn_exp2f(m - mu);
                        m = mn;
                        float ls = 0.f;
#pragma unroll
                        for (int r = 0; r < 16; ++r) { s[r] = __builtin_amdgcn_exp2f(s[r] - mu); ls += s[r]; }
                        l = l * corr + ls;
                        if (!__all(corr == 1.0f)) {
#pragma unroll
                            for (int i = 0; i < 16; ++i) { O[0][i] *= corr; O[1][i] *= corr; }
                        }
                    }
                    {
                        u32x4 w0, w1;
                        w0.x = cvt_pk_bf16(s[0], s[1]); w0.y = cvt_pk_bf16(s[2], s[3]); w0.z = cvt_pk_bf16(s[4], s[5]); w0.w = cvt_pk_bf16(s[6], s[7]);
                        w1.x = cvt_pk_bf16(s[8], s[9]); w1.y = cvt_pk_bf16(s[10], s[11]); w1.z = cvt_pk_bf16(s[12], s[13]); w1.w = cvt_pk_bf16(s[14], s[15]);
                        pf[0] = __builtin_bit_cast(bf16x8, w0); pf[1] = __builtin_bit_cast(bf16x8, w1);
                    }
#pragma unroll
                    for (int s2 = 0; s2 < 2; ++s2)
#pragma unroll
                        for (int dt = 0; dt < 2; ++dt) {
                            const bf16x8 vf = *(const bf16x8*)(cur + rdv + dt * 32 * AK_ROW + sub * 64 + s2 * 32);
                            O[dt] = __builtin_amdgcn_mfma_f32_32x32x16_bf16(vf, pf[s2], O[dt], 0, 0, 0);
                        }
                }
            }
        }
        if (more) lstore(sm + ((it + 1) & 1) * ABUF);
        __syncthreads();
    }
    float inv = 1.f;
    if (MODE != AM_SB) { const float lt = l + __shfl_xor(l, 32, 64); inv = 1.f / fmaxf(lt, 1e-30f); }
    if (MODE == AM_SLC || MODE == AM_WIN || MODE == AM_CMP) {
        const float gs = (MODE == AM_CMP) ? inv : p.GN()[gq * 12 + (MODE == AM_SLC ? 4 : 8) + head] * inv;
        float* dst = (MODE == AM_SLC ? p.OSLC() : MODE == AM_WIN ? p.OWIN() : p.OCMP()) + gq * 256 + head * 64;
#pragma unroll
        for (int dt = 0; dt < 2; ++dt)
#pragma unroll
            for (int g = 0; g < 4; ++g) {
                float4 o; o.x = O[dt][4 * g] * gs; o.y = O[dt][4 * g + 1] * gs; o.z = O[dt][4 * g + 2] * gs; o.w = O[dt][4 * g + 3] * gs;
                *(float4*)(dst + 32 * dt + 8 * g + 4 * lh) = o;
            }
    } else {
        const int yc = MODE == AM_FOX ? 256 : MODE == AM_DSA ? 0 : MODE == AM_SB ? 512 : 1024;
        const bf16_t* zp = p.ZG() + gq * 1280 + yc + head * 64;
        bf16_t* dst = p.Y() + gq * 1280 + yc + head * 64;
#pragma unroll
        for (int dt = 0; dt < 2; ++dt)
#pragma unroll
            for (int g = 0; g < 4; ++g) {
                const int d0 = 32 * dt + 8 * g + 4 * lh;
                const u32x2 z = *(const u32x2*)(zp + d0);
                u32x2 o;
                o.x = cvt_pk_bf16(O[dt][4 * g] * inv * __uint_as_float(z.x << 16), O[dt][4 * g + 1] * inv * __uint_as_float(z.x & 0xffff0000u));
                o.y = cvt_pk_bf16(O[dt][4 * g + 2] * inv * __uint_as_float(z.y << 16), O[dt][4 * g + 3] * inv * __uint_as_float(z.y & 0xffff0000u));
                *(u32x2*)(dst + d0) = o;
            }
    }
}

__device__ __forceinline__ unsigned sortable_key(float x) { const unsigned u = __float_as_uint(x + 0.0f); return (u & 0x80000000u) ? ~u : (u | 0x80000000u); }
#ifndef DIAG
#define DIAG 0
#endif
#if DIAG
#define UNIT_ATTR
#else
#define UNIT_ATTR
#endif
UNIT_ATTR __device__ __forceinline__ void dsa_select_unit(const Params& p, int b, int qt, char* sm) {
    const int tid = tidx(), lane = tid & 63, wid = __builtin_amdgcn_readfirstlane(tid >> 6), lr = lane & 31, lh = lane >> 5;
    unsigned* hist = (unsigned*)sm;
    unsigned char* tcnt = (unsigned char*)sm;
    unsigned short* tbase = (unsigned short*)(sm + 8192);
    unsigned* st_prefix = (unsigned*)(sm + 32 * 257 * 4);
    int* st_krem = (int*)(st_prefix + 32);
    int* st_ties = st_krem + 32;
    int* st_flag = st_ties + 32;
    const int q0 = qt * 32, tq = q0 + lr, ntile = qt + 1;
    const size_t gq = (size_t)b * S + tq;
    const bool small = tq + 1 <= 256;
    bf16x8 qf[4][2];
    float w[4];
#pragma unroll
    for (int h = 0; h < 4; ++h) {
        qf[h][0] = *(const bf16x8*)(p.QI() + gq * 128 + h * 32 + 8 * lh);
        qf[h][1] = *(const bf16x8*)(p.QI() + gq * 128 + h * 32 + 16 + 8 * lh);
        w[h] = p.WI()[gq * 4 + h];
    }
    const bf16_t* kbase = p.KI() + (size_t)b * S * 32 + (size_t)lr * 32 + 8 * lh;
    auto score_tile = [&](int kt, unsigned (&key)[16]) {
        const bf16x8 k0 = *(const bf16x8*)(kbase + (size_t)kt * 32 * 32), k1 = *(const bf16x8*)(kbase + (size_t)kt * 32 * 32 + 16);
        float sc[16];
#pragma unroll
        for (int r = 0; r < 16; ++r) sc[r] = 0.f;
#pragma unroll
        for (int h = 0; h < 4; ++h) {
            f32x16 a;
#pragma unroll
            for (int r = 0; r < 16; ++r) a[r] = 0.f;
            a = __builtin_amdgcn_mfma_f32_32x32x16_bf16(k0, qf[h][0], a, 0, 0, 0);
            a = __builtin_amdgcn_mfma_f32_32x32x16_bf16(k1, qf[h][1], a, 0, 0, 0);
#pragma unroll
            for (int r = 0; r < 16; ++r) sc[r] = fmaf(fmaxf(a[r], 0.f), w[h], sc[r]);
            __builtin_amdgcn_sched_barrier(0);
        }
#pragma unroll
        for (int r = 0; r < 16; ++r) key[r] = sortable_key(sc[r]);
    };
    unsigned prefix = 0u;
#pragma unroll 1
    for (int pass = 0; pass < 4; ++pass) {
        const int shift = 24 - 8 * pass;
        __syncthreads();
        for (int i = tid; i < 32 * 257; i += 256) hist[i] = 0u;
        __syncthreads();
#pragma unroll 1
        for (int kt = wid; kt < ntile; kt += 4) {
            unsigned key[16];
            score_tile(kt, key);
            const int vlim = (kt == qt) ? lr : 64;
#pragma unroll
            for (int r = 0; r < 16; ++r) {
                const int rho = (r & 3) + 8 * (r >> 2) + 4 * lh;
                const bool match = (pass == 0) || ((key[r] >> (shift + 8)) == prefix);
                if (rho <= vlim && match) atomicAdd(&hist[lr * 257 + ((key[r] >> shift) & 255u)], 1u);
            }
        }
        __syncthreads();
        if (tid < 32) {
            const int tqq = q0 + tid;
            if (tqq + 1 <= 256) { if (pass == 0) { st_prefix[tid] = 0u; st_krem[tid] = 1 << 30; st_ties[tid] = 0; } }
            else {
                int krem = (pass == 0) ? 256 : st_krem[tid];
                unsigned cum = 0u; int bin = 255;
                for (; bin > 0; --bin) { const unsigned c = hist[tid * 257 + bin]; if (cum + c >= (unsigned)krem) break; cum += c; }
                st_prefix[tid] = ((pass == 0 ? 0u : st_prefix[tid]) << 8) | (unsigned)bin;
                st_krem[tid] = krem - (int)cum;
                st_ties[tid] = (int)hist[tid * 257 + bin];
            }
        }
        __syncthreads();
        prefix = st_prefix[lr];
    }
    const unsigned thr = prefix;
    const int need = st_krem[lr];
    if (tid == 0) st_flag[0] = 0;
    __syncthreads();
    if (!small && st_ties[lr] > need) st_flag[0] = 1;
    __syncthreads();
    const bool tiepass = st_flag[0] != 0;
    if (tiepass) {
#pragma unroll 1
        for (int kt = wid; kt < ntile; kt += 4) {
            unsigned key[16];
            score_tile(kt, key);
            const int vlim = (kt == qt) ? lr : 64;
            int c = 0;
#pragma unroll
            for (int r = 0; r < 16; ++r) { const int rho = (r & 3) + 8 * (r >> 2) + 4 * lh; c += (rho <= vlim && key[r] == thr) ? 1 : 0; }
            c += __shfl_xor(c, 32, 64);
            if (lh == 0) tcnt[lr * 256 + kt] = (unsigned char)c;
        }
        __syncthreads();
        if (tid < 32) { int run = 0; for (int kt = 0; kt < ntile; ++kt) { tbase[tid * 256 + kt] = (unsigned short)run; run += tcnt[tid * 256 + kt]; } }
        __syncthreads();
    }
    unsigned* mrow = p.DMASK() + gq * 256;
#pragma unroll 1
    for (int kt = wid; kt < 256; kt += 4) {
        unsigned word = 0u;
        if (kt < ntile) {
            unsigned key[16];
            score_tile(kt, key);
            const int vlim = (kt == qt) ? lr : 64;
            unsigned gt = 0u, tie = 0u;
#pragma unroll
            for (int r = 0; r < 16; ++r) {
                const int rho = (r & 3) + 8 * (r >> 2) + 4 * lh;
                if (rho <= vlim) { gt |= (key[r] > thr) ? (1u << rho) : 0u; tie |= (key[r] == thr) ? (1u << rho) : 0u; }
            }
            gt |= __shfl_xor(gt, 32, 64); tie |= __shfl_xor(tie, 32, 64);
            if (tiepass && !small) {
                int allow = need - (int)tbase[lr * 256 + kt];
                if (allow <= 0) tie = 0u;
                else if (allow < __builtin_popcount(tie)) { unsigned wv = tie, kept = 0u; for (int i = 0; i < allow; ++i) { const unsigned low = wv & (0u - wv); kept |= low; wv ^= low; } tie = kept; }
            }
            word = gt | tie;
        }
        if (lh == 0) mrow[kt] = word;
    }
    __syncthreads();
}

__device__ __forceinline__ bool imp_better(float v1, int i1, float v2, int i2) { return (v1 > v2) || (v1 == v2 && i1 < i2); }
UNIT_ATTR __device__ __forceinline__ void nsa_select_unit(const Params& p, int b, int q0w, char* sm) {
    const int lane = tidx() & 63, lr = lane & 31, lh = lane >> 5;
    const int tq = q0w + lr;
    const size_t gq = (size_t)b * S + tq;
    const int nlim = (tq - 31) >> 4;
    const int nst = min(16, ((((q0w + 31 - 31) >> 4)) >> 5) + 1);
    const int pil = (lr & 0x13) | ((lr & 4) << 1) | ((lr & 8) >> 1);
    const bf16_t* kc = p.KCB() + (size_t)b * NCMP_PAD * 64 + (size_t)pil * 64 + 8 * lh;
    constexpr float c = 0.125f * LOG2E;
    float mh[4], il[4];
#pragma unroll
    for (int h = 0; h < 4; ++h) {
        bf16x8 qf[4];
#pragma unroll
        for (int s = 0; s < 4; ++s) qf[s] = *(const bf16x8*)(p.QN() + gq * 256 + h * 64 + 16 * s + 8 * lh);
        float m = NEG_INF, l = 0.f;
#pragma unroll 1
        for (int st = 0; st < nst; ++st) {
            f32x16 s;
#pragma unroll
            for (int i = 0; i < 16; ++i) s[i] = 0.f;
#pragma unroll
            for (int s4 = 0; s4 < 4; ++s4) { const bf16x8 kf = *(const bf16x8*)(kc + (size_t)st * 32 * 64 + s4 * 16); s = __builtin_amdgcn_mfma_f32_32x32x16_bf16(kf, qf[s4], s, 0, 0, 0); }
            const int thl = nlim - st * 32 - 8 * lh;
            float tmax = NEG_INF;
#pragma unroll
            for (int r = 0; r < 16; ++r) { const int cr = 16 * (r >> 3) + (r & 7); s[r] = (cr <= thl) ? s[r] * c : NEG_INF; tmax = fmaxf(tmax, s[r]); }
            tmax = fmaxf(tmax, __shfl_xor(tmax, 32, 64));
            const float mn = fmaxf(m, tmax), mu = (mn == NEG_INF) ? 0.f : mn;
            float ls = 0.f;
#pragma unroll
            for (int r = 0; r < 16; ++r) ls += __builtin_amdgcn_exp2f(s[r] - mu);
            l = l * __builtin_amdgcn_exp2f(m - mu) + ls; m = mn;
        }
        l += __shfl_xor(l, 32, 64);
        mh[h] = (m == NEG_INF) ? 0.f : m; il[h] = 1.f / fmaxf(l, 1e-30f);
    }
    float val[16]; int idx[16];
#pragma unroll
    for (int i = 0; i < 16; ++i) { val[i] = NEG_INF; idx[i] = 1 << 20; }
    const int cur = tq >> 6;
#pragma unroll 1
    for (int st = 0; st < 16; ++st) {
        float bs[4] = {0.f, 0.f, 0.f, 0.f};
        if (st < nst) {
            const int thl = nlim - st * 32 - 8 * lh;
#pragma unroll
            for (int h = 0; h < 4; ++h) {
                f32x16 s;
#pragma unroll
                for (int i = 0; i < 16; ++i) s[i] = 0.f;
#pragma unroll
                for (int s4 = 0; s4 < 4; ++s4) {
                    const bf16x8 kf = *(const bf16x8*)(kc + (size_t)st * 32 * 64 + s4 * 16);
                    const bf16x8 qfr = *(const bf16x8*)(p.QN() + gq * 256 + h * 64 + 16 * s4 + 8 * lh);
                    s = __builtin_amdgcn_mfma_f32_32x32x16_bf16(kf, qfr, s, 0, 0, 0);
                }
#pragma unroll
                for (int r = 0; r < 16; ++r) {
                    const int cr = 16 * (r >> 3) + (r & 7);
                    const float pr = (cr <= thl) ? __builtin_amdgcn_exp2f(s[r] * c - mh[h]) * il[h] : 0.f;
                    bs[r >> 2] += pr;
                }
                __builtin_amdgcn_sched_barrier(0);
            }
        }
#pragma unroll
        for (int g = 0; g < 4; ++g) {
            const int j = st * 8 + 4 * (g >> 1) + 2 * lh + (g & 1);
            const bool forced = (j == 0) || (j == cur) || (j == cur - 1);
            float v = forced ? 1e4f : ((j <= cur) ? bs[g] : -1.0f);
            int jj = j;
            if (__any(imp_better(v, jj, val[15], idx[15]))) {
#pragma unroll
                for (int i = 0; i < 16; ++i) {
                    const bool bt = imp_better(v, jj, val[i], idx[i]);
                    const float tv = bt ? val[i] : v; const int ti = bt ? idx[i] : jj;
                    val[i] = bt ? v : val[i]; idx[i] = bt ? jj : idx[i];
                    v = tv; jj = ti;
                }
            }
        }
    }
    {
        float* lv = (float*)(sm + (tidx() >> 6) * 8192);
        int* li = (int*)(lv + 1024);
#pragma unroll
        for (int i = 0; i < 16; ++i) { lv[i * 64 + lane] = val[i]; li[i * 64 + lane] = idx[i]; }
        __builtin_amdgcn_wave_barrier();
#pragma unroll 1
        for (int k = 0; k < 16; ++k) {
            float v = lv[k * 64 + (lane ^ 32)]; int jj = li[k * 64 + (lane ^ 32)];
#pragma unroll
            for (int i = 0; i < 16; ++i) {
                const bool bt = imp_better(v, jj, val[i], idx[i]);
                const float tv = bt ? val[i] : v; const int ti = bt ? idx[i] : jj;
                val[i] = bt ? v : val[i]; idx[i] = bt ? jj : idx[i];
                v = tv; jj = ti;
            }
        }
        __builtin_amdgcn_wave_barrier();
    }
    unsigned m0 = 0u, m1 = 0u, m2 = 0u, m3 = 0u;
#pragma unroll
    for (int i = 0; i < 16; ++i) {
        const unsigned bit = 1u << (idx[i] & 31); const int wsel = idx[i] >> 5;
        m0 |= (wsel == 0) ? bit : 0u; m1 |= (wsel == 1) ? bit : 0u; m2 |= (wsel == 2) ? bit : 0u; m3 |= (wsel == 3) ? bit : 0u;
    }
    if (lh == 0) { u32x4 o; o.x = m0; o.y = m1; o.z = m2; o.w = m3; *(u32x4*)(p.SMASK() + gq * 4) = o; }
}

template <class BAR>
__device__ __forceinline__ void ph_work(const Params& p, int layer, char* sm, const BAR& barrier) {
    __shared__ int s_unit;
#pragma unroll 1
    for (int stage = 0; stage < 2; ++stage) {
        unsigned* ctr = p.qctr() + 64 * layer + 32 * stage;
        const int total = stage == 0 ? 3200 : 1024;
        for (;;) {
            __syncthreads();
            if (threadIdx.x == 0) s_unit = (int)atomicAdd(ctr, 1u);
            __syncthreads();
            const int u = __builtin_amdgcn_readfirstlane(s_unit);
            if (u >= total) break;
            int kind, b, h = 0, q;
            if (stage == 1) { const int r = u & 15; kind = 2 + ((r >> 3) ? AM_SLC : AM_DSA); q = 63 - (u >> 4); b = (r >> 2) & 1; h = r & 3; }
            else if (u < 512) { kind = 0; q = 255 - (u >> 1); b = u & 1; }
            else if (u < 640) { kind = 1; const int v = u - 512; b = v & 1; q = v >> 1; }
            else if (u < 1664) { const int v = u - 640, r = v & 15; kind = 2 + ((r >> 3) ? AM_FOX : AM_SB); q = 63 - (v >> 4); b = (r >> 2) & 1; h = r & 3; }
            else { const int v = u - 1664, br = v >> 9, w = v & 511; kind = 2 + (br == 0 ? AM_WIN : br == 1 ? AM_CMP : AM_MEM); q = w >> 3; b = (w >> 2) & 1; h = w & 3; }
            if (kind == 0) dsa_select_unit(p, b, q, sm);
            else if (kind == 1) nsa_select_unit(p, b, q * 128 + 32 * __builtin_amdgcn_readfirstlane(tidx() >> 6), sm);
            else if (kind == 2 + AM_SB) attn_unit<AM_SB>(p, b, h, q, sm);
            else if (kind == 2 + AM_FOX) attn_unit<AM_FOX>(p, b, h, q, sm);
            else if (kind == 2 + AM_DSA) attn_unit<AM_DSA>(p, b, h, q, sm);
            else if (kind == 2 + AM_SLC) attn_unit<AM_SLC>(p, b, h, q, sm);
            else if (kind == 2 + AM_WIN) attn_unit<AM_WIN>(p, b, h, q, sm);
            else if (kind == 2 + AM_CMP) attn_unit<AM_CMP>(p, b, h, q, sm);
            else attn_unit<AM_MEM>(p, b, h, q, sm);
        }
        barrier(stage);
    }
}

__device__ __forceinline__ void ph_nsa_combine(const Params& p, int bid, int nb) {
    for (size_t i = (size_t)bid * 256 + tidx(); i < (size_t)T * 64; i += (size_t)nb * 256) {
        const size_t g = i >> 6; const int c = (int)(i & 63) * 4, h = c >> 6;
        const float g0 = p.GN()[g * 12 + h];
        const float4 a = *(const float4*)(p.OCMP() + g * 256 + c), s = *(const float4*)(p.OSLC() + g * 256 + c), w = *(const float4*)(p.OWIN() + g * 256 + c);
        const u32x2 z = *(const u32x2*)(p.ZG() + g * 1280 + 768 + c);
        u32x2 o;
        o.x = cvt_pk_bf16((g0 * a.x + s.x + w.x) * __uint_as_float(z.x << 16), (g0 * a.y + s.y + w.y) * __uint_as_float(z.x & 0xffff0000u));
        o.y = cvt_pk_bf16((g0 * a.z + s.z + w.z) * __uint_as_float(z.y << 16), (g0 * a.w + s.w + w.w) * __uint_as_float(z.y & 0xffff0000u));
        *(u32x2*)(p.Y() + g * 1280 + 768 + c) = o;
    }
}

__device__ __forceinline__ void ph_setup_misc(const Params& p, int bid, int nb) {
    const int lane = tidx() & 63, gw = bid * 4 + (tidx() >> 6);
    for (int o = gw; o < DEPTH * 2 * 128; o += nb * 4) {
        const int l = o >> 8, which = (o >> 7) & 1, j = o & 127;
        const float* pe = (which ? p.pe_v : p.pe_k) + (size_t)l * 2048;
        const float* w1 = (which ? p.wc1_v : p.wc1_k) + (size_t)l * 2048 * 128;
        float a = 0.f;
        for (int k = lane; k < 2048; k += 64) a = fmaf(pe[k], w1[(size_t)k * 128 + j], a);
        a = wave_sum(a);
        if (lane == 0) p.BIASC()[o] = a;
    }
    for (int i = bid * 256 + tidx(); i < 2048; i += nb * 256) { p.KCT()[(size_t)T * 64 + i] = 0; p.VCTOK()[(size_t)T * 64 + i] = 0; }
    for (int i = bid * 256 + tidx(); i < 12 * D; i += nb * 256) p.WIN()[(size_t)(M_SPC + 52) * D + i] = 0;
    for (int i = bid * 256 + tidx(); i < (M_MERGE - NPM) * D; i += nb * 256) p.WIN()[(size_t)NPM * D + i] = 0;
}

#define XB_TMO      128
#define XB_XCNT(j)  (256  + 64 * (j))
#define XB_XSUB(j)  (1280 + 64 * (j))
#define XB_XGEN(j)  (2304 + 64 * (j))
#define XB_TOP      3328
#define XB_TOPGEN   3392
#define XCD_BAR_WORDS 3456
#define XB_SPIN_CAP (1u << 18)
#define LAS __attribute__((address_space(3)))

__device__ __forceinline__ unsigned xb_ld(unsigned* p)              { return __hip_atomic_load(p, __ATOMIC_RELAXED, __HIP_MEMORY_SCOPE_AGENT); }
__device__ __forceinline__ unsigned xb_add(unsigned* p, unsigned v) { return __hip_atomic_fetch_add(p, v, __ATOMIC_RELAXED, __HIP_MEMORY_SCOPE_AGENT); }
__device__ __forceinline__ unsigned xb_xcc_id() { return (unsigned)__builtin_amdgcn_s_getreg((3 << 11) | 20) & 0xFu; }
#define XB_SPIN(cond, bar) do { unsigned _sp = 0; while (cond) { __builtin_amdgcn_s_sleep(1); \
    if ((++_sp & 255u) == 0u) { if (xb_ld(&(bar)[XB_TMO])) break; if (_sp > XB_SPIN_CAP) { atomicAdd(&(bar)[XB_TMO], 1u); break; } } } } while (0)

struct XcdBarrier {
    unsigned* bar; unsigned x;
    volatile LAS unsigned* st;
};
__device__ __forceinline__ XcdBarrier xcd_barrier_post(unsigned* bar, volatile LAS unsigned* st) {
    XcdBarrier b; b.bar = bar; b.x = xb_xcc_id(); b.st = st;
    if (threadIdx.x == 0) (void)xb_add(&bar[XB_XCNT(b.x)], 1u);
    return b;
}
__device__ __forceinline__ void xcd_barrier_complete(unsigned* bar, unsigned x, unsigned& nloc, unsigned& nx) {
    const unsigned G = gridDim.x * gridDim.y * gridDim.z;
    unsigned sum, cnt, mine, sp = 0u;
    for (;;) {
        sum = 0u; cnt = 0u; mine = 0u;
#pragma unroll
        for (unsigned j = 0; j < 16; ++j) { const unsigned c = xb_ld(&bar[XB_XCNT(j)]); sum += c; cnt += (c > 0u) ? 1u : 0u; mine = (j == x) ? c : mine; }
        if (sum == G) break;
        __builtin_amdgcn_s_sleep(1);
        if ((++sp & 255u) == 0u) { if (xb_ld(&bar[XB_TMO])) break; if (sp > XB_SPIN_CAP) { atomicAdd(&bar[XB_TMO], 1u); break; } }
    }
    nloc = mine > 0u ? mine : 1u; nx = cnt > 0u ? cnt : 1u;
}
__device__ __attribute__((noinline)) void xcd_barrier_impl(unsigned* b_bar, unsigned b_x, volatile LAS unsigned* b_st) {
    XcdBarrier b; b.bar = b_bar; b.x = b_x; b.st = b_st;
    asm volatile("s_waitcnt vmcnt(0)" ::: "memory");
    __syncthreads();
    if (threadIdx.x == 0) {
        unsigned* bar = b.bar;
        __builtin_amdgcn_s_waitcnt(0);
        unsigned nloc = b.st[0], nx = b.st[1];
        if (nloc == 0u) { xcd_barrier_complete(bar, b.x, nloc, nx); b.st[0] = nloc; b.st[1] = nx; }
        const unsigned old = xb_add(&bar[XB_XSUB(b.x)], 1u);
        const unsigned gen = old / nloc;
        if (old + 1u == (gen + 1u) * nloc) {
            __builtin_amdgcn_fence(__ATOMIC_RELEASE, "agent");
            asm volatile("s_waitcnt vmcnt(0)" ::: "memory");
            const unsigned og = xb_add(&bar[XB_TOP], 1u);
            const unsigned tg = og / nx;
            if (og + 1u == (tg + 1u) * nx) xb_add(&bar[XB_TOPGEN], 1u);
            else XB_SPIN(xb_ld(&bar[XB_TOPGEN]) == tg, bar);
            __builtin_amdgcn_fence(__ATOMIC_ACQUIRE, "agent");
            xb_add(&bar[XB_XGEN(b.x)], 1u);
            asm volatile("s_waitcnt vmcnt(0)" ::: "memory");
        } else {
            XB_SPIN(xb_ld(&bar[XB_XGEN(b.x)]) == gen, bar);
            __builtin_amdgcn_fence(__ATOMIC_ACQUIRE, "agent");
            asm volatile("s_waitcnt vmcnt(0)" ::: "memory");
        }
    }
    __syncthreads();
}
__device__ __forceinline__ void xcd_barrier(const XcdBarrier& b) { xcd_barrier_impl(b.bar, b.x, b.st); }

#ifndef DIAG
#define DIAG 0
#endif
#ifndef DIAG_A
#define DIAG_A 8
#define DIAG_B 7
#endif
#if DIAG
#define STAMP(k) do { if (((k) == DIAG_A || (k) == DIAG_B || (k) + 1 == DIAG_A || (k) + 1 == DIAG_B || (k) == 0 || (k) == 11) && blockIdx.x == 0 && threadIdx.x == 0) { const unsigned long long t_ = wall_clock64(); dg[k] += t_ - dg[15]; dg[15] = t_; } } while (0)
#else
#define STAMP(k) do { } while (0)
#endif
__global__ void __launch_bounds__(256, 2) mega(Params p) {
    __shared__ __attribute__((aligned(16))) char smem[40960];
    __shared__ uint4 xb_words;
    if (threadIdx.x == 0) xb_words = make_uint4(0u, 0u, 0u, 0u);
    __syncthreads();
    XcdBarrier bar = xcd_barrier_post(p.bar(), (volatile LAS unsigned*)&xb_words);
    const int bid = blockIdx.x, nb = gridDim.x;
    float* smf = (float*)smem;
#if DIAG
    __shared__ unsigned long long dg[16];
    if (threadIdx.x == 0) { for (int i = 0; i < 15; ++i) dg[i] = 0; dg[15] = wall_clock64(); }
#endif

    convert_wt(p.w_branch, p.WBR(), 256, D, DEPTH * 5, bid, nb, smf);
    convert_wt(p.w_out, p.WOUT(), D, D, DEPTH, bid, nb, smf);
    convert_wt(p.w_mem_kv, p.WMKV(), D, 512, DEPTH, bid, nb, smf);
    convert_wt(p.w_uk, p.WUK(), 128, 256, DEPTH, bid, nb, smf);
    convert_wt(p.w_uv, p.WUV(), 128, 256, DEPTH, bid, nb, smf);
    for (int l = 0; l < DEPTH; ++l) {
        convert_wt(p.wc1_k + (size_t)l * 2048 * 128, p.WC1T() + (size_t)(l * 2 + 0) * 128 * 2048, 2048, 128, 1, bid, nb, smf);
        convert_wt(p.wc1_v + (size_t)l * 2048 * 128, p.WC1T() + (size_t)(l * 2 + 1) * 128 * 2048, 2048, 128, 1, bid, nb, smf);
        convert_wt(p.wc2_k + (size_t)l * 128 * 64, p.WC2T() + (size_t)(l * 2 + 0) * 64 * 128, 128, 64, 1, bid, nb, smf);
        convert_wt(p.wc2_v + (size_t)l * 128 * 64, p.WC2T() + (size_t)(l * 2 + 1) * 64 * 128, 128, 64, 1, bid, nb, smf);
    }
    ph_setup_misc(p, bid, nb);
    ph_rope_table(p, bid, nb);
    STAMP(0);
    for (int l = 0; l < DEPTH; ++l) {
        const float* Xin = l == 0 ? p.x : p.X;
        convert_wt<true>(p.w_in + (size_t)l * D * NIN, p.WIN(), D, NIN, 1, bid, nb, smf);
        ph_rmsnorm<bf16_t>(Xin, p.norm_g + l * D, p.H(), T, bid, nb);
        ph_rmsnorm<bf16_t>(p.mem, p.mem_norm + l * D, p.MEMN(), NBATCH * NMEM, bid, nb);
        xcd_barrier(bar); STAMP(1);
        { EpiInProj e{p, l}; gemm_bf16<128>(p.H(), D, p.WIN(), D, T, NP, D, e, bid, nb, smem); }
        { EpiMemKV e{p}; gemm_bf16<128>(p.MEMN(), D, p.WMKV() + (size_t)l * 512 * D, D, NBATCH * NMEM, 512, D, e, bid, nb, smem); }
        xcd_barrier(bar); STAMP(2);
        ph_ckvnorm(p, l, bid, nb);
        ph_cumsum(p, bid, nb, smf);
        { EpiCmp1 e{p.BIASC() + (l * 2 + 0) * 128, p.HIDK()}; gemm_bf16<64>(p.KCT(), 1024, p.WC1T() + (size_t)(l * 2 + 0) * 128 * 2048, 2048, 1024, 128, 2048, e, bid, nb, smem); }
        { EpiCmp1 e{p.BIASC() + (l * 2 + 1) * 128, p.HIDV()}; gemm_bf16<64>(p.VCTOK(), 1024, p.WC1T() + (size_t)(l * 2 + 1) * 128 * 2048, 2048, 1024, 128, 2048, e, bid, nb, smem); }
        xcd_barrier(bar); STAMP(3);
        { EpiKA e{p}; gemm_bf16<128>(p.CKV(), 128, p.WUK() + (size_t)l * 256 * 128, 128, T, 256, 128, e, bid, nb, smem); }
        { EpiVA e{p}; gemm_bf16<128>(p.CKV(), 128, p.WUV() + (size_t)l * 256 * 128, 128, T, 256, 128, e, bid, nb, smem); }
        { EpiCmp2K e{p.KCB()}; gemm_bf16<64>(p.HIDK(), 128, p.WC2T() + (size_t)(l * 2 + 0) * 64 * 128, 128, 1024, 64, 128, e, bid, nb, smem); }
        { EpiCmp2V e{p.VCT()}; gemm_bf16<64>(p.HIDV(), 128, p.WC2T() + (size_t)(l * 2 + 1) * 64 * 128, 128, 1024, 64, 128, e, bid, nb, smem); }
        xcd_barrier(bar); STAMP(4);
        ph_work(p, l, smem, [&](int stage) { xcd_barrier(bar); if (stage == 0) { STAMP(7); } else { STAMP(8); } });
        ph_nsa_combine(p, bid, nb);
        xcd_barrier(bar); STAMP(9);
        ph_merge(p, l, bid, nb, smem);
        xcd_barrier(bar); STAMP(10);
        { EpiResid e{Xin, p.X}; gemm_bf16<128>(p.MG(), D, p.WOUT() + (size_t)l * D * D, D, T, D, D, e, bid, nb, smem); }
        xcd_barrier(bar); STAMP(11);
    }
#if DIAG
    {
        float* dgw = (float*)(p.bar() + 4096 + 512);
        if (blockIdx.x == 0 && threadIdx.x == 0) {
            unsigned long long tot = 0; for (int i = 0; i < 15; ++i) tot += dg[i];
            dgw[0] = rintf(40.f * (float)((double)dg[DIAG_A] / (double)tot)) / 40.f; dgw[1] = rintf(40.f * (float)((double)dg[DIAG_B] / (double)tot)) / 40.f;
        }
        ph_rmsnorm<float>(p.X, p.final_norm, p.X, T, bid, nb);
        xcd_barrier(bar);
        {
            const float fa = 1.0f + dgw[0];
            float4* xp = (float4*)p.X;
#pragma unroll 1
            for (int i = bid * 256 + threadIdx.x; i < T * D / 4; i += nb * 256) { float4 v = xp[i]; v.x *= fa; v.y *= fa; v.z *= fa; v.w *= fa; xp[i] = v; }
        }
        xcd_barrier(bar);
        if (blockIdx.x == 0 && threadIdx.x == 0) p.X[0] += 100.f * dgw[1];
    }
#else
    ph_rmsnorm<float>(p.X, p.final_norm, p.X, T, bid, nb);
#endif
}
}

extern "C" void kernel_launch(void* const* d_in, const int* in_sizes, int n_in, void* d_out, int out_size, void* d_ws, size_t ws_size, hipStream_t stream) {
    (void)in_sizes; (void)n_in; (void)out_size;
    Params p{};
    p.x = (const float*)d_in[0]; p.mem = (const float*)d_in[1]; p.pos = (const int*)d_in[2]; p.norm_g = (const float*)d_in[3];
    p.w_in = (const float*)d_in[4]; p.kv_norm = (const float*)d_in[5]; p.w_uk = (const float*)d_in[6]; p.w_uv = (const float*)d_in[7];
    p.fox_bias = (const float*)d_in[8]; p.pe_k = (const float*)d_in[9]; p.pe_v = (const float*)d_in[10]; p.wc1_k = (const float*)d_in[11];
    p.wc2_k = (const float*)d_in[12]; p.wc1_v = (const float*)d_in[13]; p.wc2_v = (const float*)d_in[14]; p.mem_norm = (const float*)d_in[15];
    p.w_mem_kv = (const float*)d_in[16]; p.w_branch = (const float*)d_in[17]; p.w_out = (const float*)d_in[18]; p.final_norm = (const float*)d_in[19];
    p.X = (float*)d_out;
    p.ws = (char*)d_ws;
    if (WS_TOTAL > ws_size) { fprintf(stderr, "kernel_launch: workspace too small (%zu > %zu)\n", (size_t)WS_TOTAL, ws_size); return; }

    static int grid = 0;
    if (grid == 0) {
        int dev = 0, cus = 0, per_cu = 0;
        hipGetDevice(&dev);
        hipDeviceGetAttribute(&cus, hipDeviceAttributeMultiprocessorCount, dev);
        hipOccupancyMaxActiveBlocksPerMultiprocessor(&per_cu, (const void*)mega, 256, 0);
        (void)hipGetLastError();
        if (per_cu < 1) per_cu = 1;
        grid = cus * (per_cu < 2 ? per_cu : 2);
    }
    hipMemsetAsync((char*)d_ws + OFF_bar, 0, (4096 + 64 * 8 + 64) * sizeof(unsigned), stream);
    hipLaunchKernelGGL(mega, dim3(grid), dim3(256), 0, stream, p);
}
```

```cpp
#include <hip/hip_runtime.h>
#include <stdint.h>
#include <math.h>
#include <cstdio>

namespace {
constexpr int S = 8192, NBATCH = 2, T = NBATCH * S, D = 1024, NIN = 9396, NM = 4276, DEPTH = 4, NMEM = 256;
constexpr int NCMP = 511, NCMP_PAD = 512;
constexpr int C_DSA_Q = 0, C_CKV = 256, C_IDXQ = 384, C_IDXK = 512, C_IDXW = 544, C_DSA_Z = 548,
              C_FOX_Q = 804, C_FOX_K = 1060, C_FOX_V = 1316, C_FOX_F = 1572, C_FOX_Z = 1576,
              C_SB_Q = 1832, C_SB_K = 2088, C_SB_V = 2344, C_SB_Z = 2600,
              C_NSA_Q = 2856, C_NSA_KC = 3112, C_NSA_VC = 3176, C_NSA_KS = 3240, C_NSA_VS = 3304, C_NSA_KW = 3368, C_NSA_VW = 3432,
              C_NSA_G = 3496, C_NSA_Z = 3508, C_MEM_Q = 3764, C_MEM_Z = 4020, C_MERGE = 4276;

typedef unsigned short bf16_t;
typedef short bf16x8 __attribute__((ext_vector_type(8)));
typedef float f32x16 __attribute__((ext_vector_type(16)));
typedef unsigned u32x4 __attribute__((ext_vector_type(4)));
typedef unsigned u32x2 __attribute__((ext_vector_type(2)));

constexpr int M_QA = 0, M_QN = 256, M_KSLC = 512, M_KWIN = 576, M_KC = 640, M_VC = 704, M_QF = 768, M_KF = 1024, M_QS = 1280, M_KSB = 1536, M_QM = 1792,
              M_VF = 2048, M_VS = 2304, M_VSLC = 2560, M_VWIN = 2624, M_QI = 2688, M_SPC = 2816, M_CKV = 2880, M_Z = 3008, NPM = 4288, M_MERGE = 4352, NP = 9472;
constexpr size_t al256(size_t x) { return (x + 255) & ~(size_t)255; }
constexpr size_t OFF_bar = 0;
constexpr size_t OFF_H = OFF_bar + al256((4096 + 64 * 8 + 64) * 4);
constexpr size_t OFF_Y = OFF_H + al256((size_t)T * D * 2);
constexpr size_t OFF_ZG = OFF_Y + al256((size_t)T * 1280 * 2);
constexpr size_t OFF_MG = OFF_ZG + al256((size_t)T * 1280 * 2);
constexpr size_t OFF_SIG = OFF_MG + al256((size_t)T * D * 2);
constexpr size_t OFF_CKVR = OFF_SIG + al256((size_t)T * 5120 * 2);
constexpr size_t OFF_CKV = OFF_CKVR + al256((size_t)T * 128 * 4);
constexpr size_t OFF_OCMP = OFF_CKV + al256((size_t)T * 128 * 2);
constexpr size_t OFF_OSLC = OFF_OCMP + al256((size_t)T * 256 * 4);
constexpr size_t OFF_OWIN = OFF_OSLC + al256((size_t)T * 256 * 4);
constexpr size_t OFF_LOGF = OFF_OWIN + al256((size_t)T * 256 * 4);
constexpr size_t OFF_CUM = OFF_LOGF + al256((size_t)T * 4 * 4);
constexpr size_t OFF_CUMT = OFF_CUM + al256((size_t)T * 4 * 4);
constexpr size_t OFF_WI = OFF_CUMT + al256((size_t)T * 4 * 4);
constexpr size_t OFF_GN = OFF_WI + al256((size_t)T * 4 * 4);
constexpr size_t OFF_KCT = OFF_GN + al256((size_t)T * 12 * 4);
constexpr size_t OFF_VCTOK = OFF_KCT + al256(((size_t)T * 64 + 2048) * 2);
constexpr size_t OFF_HIDK = OFF_VCTOK + al256(((size_t)T * 64 + 2048) * 2);
constexpr size_t OFF_HIDV = OFF_HIDK + al256((size_t)1024 * 128 * 2);
constexpr size_t OFF_KCB = OFF_HIDV + al256((size_t)1024 * 128 * 2);
constexpr size_t OFF_VCT = OFF_KCB + al256((size_t)NBATCH * NCMP_PAD * 64 * 2);
constexpr size_t OFF_QI = OFF_VCT + al256((size_t)NBATCH * NCMP_PAD * 64 * 2);
constexpr size_t OFF_KI = OFF_QI + al256((size_t)T * 128 * 2);
constexpr size_t OFF_MEMN = OFF_KI + al256((size_t)T * 32 * 2);
constexpr size_t OFF_ROPE = OFF_MEMN + al256((size_t)NBATCH * NMEM * D * 2);
constexpr size_t OFF_DMASK = OFF_ROPE + al256((size_t)T * 64 * 4);
constexpr size_t OFF_SMASK = OFF_DMASK + al256((size_t)T * 256 * 4);
constexpr size_t OFF_QA = OFF_SMASK + al256((size_t)T * 4 * 4);
constexpr size_t OFF_KAB = OFF_QA + al256((size_t)T * 256 * 2);
constexpr size_t OFF_VAT = OFF_KAB + al256((size_t)T * 256 * 2);
constexpr size_t OFF_QF = OFF_VAT + al256((size_t)T * 256 * 2);
constexpr size_t OFF_KF = OFF_QF + al256((size_t)T * 256 * 2);
constexpr size_t OFF_VFT = OFF_KF + al256((size_t)T * 256 * 2);
constexpr size_t OFF_QS = OFF_VFT + al256((size_t)T * 256 * 2);
constexpr size_t OFF_KSB = OFF_QS + al256((size_t)T * 256 * 2);
constexpr size_t OFF_VST = OFF_KSB + al256((size_t)T * 256 * 2);
constexpr size_t OFF_QN = OFF_VST + al256((size_t)T * 256 * 2);
constexpr size_t OFF_QM = OFF_QN + al256((size_t)T * 256 * 2);
constexpr size_t OFF_KSLC = OFF_QM + al256((size_t)T * 256 * 2);
constexpr size_t OFF_VSLCT = OFF_KSLC + al256((size_t)T * 64 * 2);
constexpr size_t OFF_KWIN = OFF_VSLCT + al256((size_t)T * 64 * 2);
constexpr size_t OFF_VWINT = OFF_KWIN + al256((size_t)T * 64 * 2);
constexpr size_t OFF_MKB = OFF_VWINT + al256((size_t)T * 64 * 2);
constexpr size_t OFF_MVT = OFF_MKB + al256((size_t)NBATCH * NMEM * 256 * 2);
constexpr size_t OFF_WIN = OFF_MVT + al256((size_t)NBATCH * NMEM * 256 * 2);
constexpr size_t OFF_WBR = OFF_WIN + al256((size_t)NP * D * 2);
constexpr size_t OFF_WOUT = OFF_WBR + al256((size_t)DEPTH * 5 * D * 256 * 2);
constexpr size_t OFF_WMKV = OFF_WOUT + al256((size_t)DEPTH * D * D * 2);
constexpr size_t OFF_WUK = OFF_WMKV + al256((size_t)DEPTH * 512 * D * 2);
constexpr size_t OFF_WUV = OFF_WUK + al256((size_t)DEPTH * 256 * 128 * 2);
constexpr size_t OFF_WC1T = OFF_WUV + al256((size_t)DEPTH * 256 * 128 * 2);
constexpr size_t OFF_WC2T = OFF_WC1T + al256((size_t)DEPTH * 2 * 128 * 2048 * 2);
constexpr size_t OFF_BIASC = OFF_WC2T + al256((size_t)DEPTH * 2 * 64 * 128 * 2);
constexpr size_t WS_TOTAL = OFF_BIASC + al256((size_t)DEPTH * 2 * 128 * 4);

__device__ __forceinline__ int map_in_col(int n) {
    constexpr int seg[27][3] = {{0, 256, M_QA}, {256, 128, M_CKV}, {384, 128, M_QI}, {512, 32, M_SPC}, {544, 4, M_SPC + 32}, {548, 256, M_Z}, {804, 256, M_QF}, {1060, 256, M_KF},
        {1316, 256, M_VF}, {1572, 4, M_SPC + 36}, {1576, 256, M_Z + 256}, {1832, 256, M_QS}, {2088, 256, M_KSB}, {2344, 256, M_VS}, {2600, 256, M_Z + 512}, {2856, 256, M_QN},
        {3112, 64, M_KC}, {3176, 64, M_VC}, {3240, 64, M_KSLC}, {3304, 64, M_VSLC}, {3368, 64, M_KWIN}, {3432, 64, M_VWIN}, {3496, 12, M_SPC + 40}, {3508, 256, M_Z + 768},
        {3764, 256, M_QM}, {4020, 256, M_Z + 1024}, {4276, 5120, M_MERGE}};
    int r = 0;
#pragma unroll
    for (int i = 0; i < 27; ++i) r = (n >= seg[i][0] && n < seg[i][0] + seg[i][1]) ? (seg[i][2] + n - seg[i][0]) : r;
    return r;
}
struct Params {
    const float* x; const float* mem; const int* pos; const float* norm_g; const float* w_in; const float* kv_norm;
    const float* w_uk; const float* w_uv; const float* fox_bias; const float* pe_k; const float* pe_v;
    const float* wc1_k; const float* wc2_k; const float* wc1_v; const float* wc2_v; const float* mem_norm;
    const float* w_mem_kv; const float* w_branch; const float* w_out; const float* final_norm;
    float* X; char* ws;
    __device__ __forceinline__ unsigned* bar() const { return (unsigned*)(ws + OFF_bar); }
    __device__ __forceinline__ bf16_t* H() const { return (bf16_t*)(ws + OFF_H); }
    __device__ __forceinline__ bf16_t* Y() const { return (bf16_t*)(ws + OFF_Y); }
    __device__ __forceinline__ bf16_t* ZG() const { return (bf16_t*)(ws + OFF_ZG); }
    __device__ __forceinline__ bf16_t* MG() const { return (bf16_t*)(ws + OFF_MG); }
    __device__ __forceinline__ bf16_t* SIG() const { return (bf16_t*)(ws + OFF_SIG); }
    __device__ __forceinline__ float* CKVR() const { return (float*)(ws + OFF_CKVR); }
    __device__ __forceinline__ bf16_t* CKV() const { return (bf16_t*)(ws + OFF_CKV); }
    __device__ __forceinline__ float* OCMP() const { return (float*)(ws + OFF_OCMP); }
    __device__ __forceinline__ float* OSLC() const { return (float*)(ws + OFF_OSLC); }
    __device__ __forceinline__ float* OWIN() const { return (float*)(ws + OFF_OWIN); }
    __device__ __forceinline__ float* LOGF() const { return (float*)(ws + OFF_LOGF); }
    __device__ __forceinline__ float* CUM() const { return (float*)(ws + OFF_CUM); }
    __device__ __forceinline__ float* CUMT() const { return (float*)(ws + OFF_CUMT); }
    __device__ __forceinline__ float* WI() const { return (float*)(ws + OFF_WI); }
    __device__ __forceinline__ float* GN() const { return (float*)(ws + OFF_GN); }
    __device__ __forceinline__ bf16_t* KCT() const { return (bf16_t*)(ws + OFF_KCT); }
    __device__ __forceinline__ bf16_t* VCTOK() const { return (bf16_t*)(ws + OFF_VCTOK); }
    __device__ __forceinline__ bf16_t* HIDK() const { return (bf16_t*)(ws + OFF_HIDK); }
    __device__ __forceinline__ bf16_t* HIDV() const { return (bf16_t*)(ws + OFF_HIDV); }
    __device__ __forceinline__ bf16_t* KCB() const { return (bf16_t*)(ws + OFF_KCB); }
    __device__ __forceinline__ bf16_t* VCT() const { return (bf16_t*)(ws + OFF_VCT); }
    __device__ __forceinline__ bf16_t* QI() const { return (bf16_t*)(ws + OFF_QI); }
    __device__ __forceinline__ bf16_t* KI() const { return (bf16_t*)(ws + OFF_KI); }
    __device__ __forceinline__ bf16_t* MEMN() const { return (bf16_t*)(ws + OFF_MEMN); }
    __device__ __forceinline__ float* ROPE() const { return (float*)(ws + OFF_ROPE); }
    __device__ __forceinline__ unsigned* DMASK() const { return (unsigned*)(ws + OFF_DMASK); }
    __device__ __forceinline__ unsigned* SMASK() const { return (unsigned*)(ws + OFF_SMASK); }
    __device__ __forceinline__ bf16_t* QA() const { return (bf16_t*)(ws + OFF_QA); }
    __device__ __forceinline__ bf16_t* KAB() const { return (bf16_t*)(ws + OFF_KAB); }
    __device__ __forceinline__ bf16_t* VAT() const { return (bf16_t*)(ws + OFF_VAT); }
    __device__ __forceinline__ bf16_t* QF() const { return (bf16_t*)(ws + OFF_QF); }
    __device__ __forceinline__ bf16_t* KF() const { return (bf16_t*)(ws + OFF_KF); }
    __device__ __forceinline__ bf16_t* VFT() const { return (bf16_t*)(ws + OFF_VFT); }
    __device__ __forceinline__ bf16_t* QS() const { return (bf16_t*)(ws + OFF_QS); }
    __device__ __forceinline__ bf16_t* KSB() const { return (bf16_t*)(ws + OFF_KSB); }
    __device__ __forceinline__ bf16_t* VST() const { return (bf16_t*)(ws + OFF_VST); }
    __device__ __forceinline__ bf16_t* QN() const { return (bf16_t*)(ws + OFF_QN); }
    __device__ __forceinline__ bf16_t* QM() const { return (bf16_t*)(ws + OFF_QM); }
    __device__ __forceinline__ bf16_t* KSLC() const { return (bf16_t*)(ws + OFF_KSLC); }
    __device__ __forceinline__ bf16_t* VSLCT() const { return (bf16_t*)(ws + OFF_VSLCT); }
    __device__ __forceinline__ bf16_t* KWIN() const { return (bf16_t*)(ws + OFF_KWIN); }
    __device__ __forceinline__ bf16_t* VWINT() const { return (bf16_t*)(ws + OFF_VWINT); }
    __device__ __forceinline__ bf16_t* MKB() const { return (bf16_t*)(ws + OFF_MKB); }
    __device__ __forceinline__ bf16_t* MVT() const { return (bf16_t*)(ws + OFF_MVT); }
    __device__ __forceinline__ bf16_t* WIN() const { return (bf16_t*)(ws + OFF_WIN); }
    __device__ __forceinline__ bf16_t* WBR() const { return (bf16_t*)(ws + OFF_WBR); }
    __device__ __forceinline__ bf16_t* WOUT() const { return (bf16_t*)(ws + OFF_WOUT); }
    __device__ __forceinline__ bf16_t* WMKV() const { return (bf16_t*)(ws + OFF_WMKV); }
    __device__ __forceinline__ bf16_t* WUK() const { return (bf16_t*)(ws + OFF_WUK); }
    __device__ __forceinline__ bf16_t* WUV() const { return (bf16_t*)(ws + OFF_WUV); }
    __device__ __forceinline__ bf16_t* WC1T() const { return (bf16_t*)(ws + OFF_WC1T); }
    __device__ __forceinline__ bf16_t* WC2T() const { return (bf16_t*)(ws + OFF_WC2T); }
    __device__ __forceinline__ float* BIASC() const { return (float*)(ws + OFF_BIASC); }
    __device__ __forceinline__ unsigned* qctr() const { return (unsigned*)(ws + OFF_bar) + 4096; }
};

typedef __bf16 bf16x2_t __attribute__((ext_vector_type(2)));
__device__ __forceinline__ unsigned cvt_pk_bf16(float lo, float hi) { bf16x2_t v; v.x = (__bf16)lo; v.y = (__bf16)hi; return __builtin_bit_cast(unsigned, v); }
__device__ __forceinline__ bf16_t f2bf(float x) { return (bf16_t)(cvt_pk_bf16(x, 0.f) & 0xffffu); }
__device__ __forceinline__ int tidx() { int t = threadIdx.x; asm volatile("" : "+v"(t)); return t; }
__device__ __forceinline__ float sigmoid_(float x) { return 1.f / (1.f + expf(-x)); }
__device__ __forceinline__ float silu_(float x) { return x / (1.f + expf(-x)); }
__device__ __forceinline__ float logsig_(float x) { return fminf(x, 0.f) - log1pf(expf(-fabsf(x))); }
__device__ __forceinline__ float wave_sum(float v) {
#pragma unroll
    for (int o = 32; o > 0; o >>= 1) v += __shfl_xor(v, o, 64);
    return v;
}
__device__ __forceinline__ float wave_max(float v) {
#pragma unroll
    for (int o = 32; o > 0; o >>= 1) v = fmaxf(v, __shfl_xor(v, o, 64));
    return v;
}

__device__ __forceinline__ void ph_rope_table(const Params& p, int bid, int nb) {
    for (int i = bid * 256 + tidx(); i < T * 32; i += nb * 256) {
        const int t = i >> 5, f = i & 31;
        const double inv = pow(10000.0, -(double)f / 32.0);
        const double ang = (double)p.pos[t] * inv;
        p.ROPE()[(size_t)t * 64 + f] = (float)cos(ang);
        p.ROPE()[(size_t)t * 64 + 32 + f] = (float)sin(ang);
    }
}

template <class OUT>
__device__ __forceinline__ void ph_rmsnorm(const float* in, const float* g, OUT* out, int rows, int bid, int nb, float dscale = 1.0f) {
    const int lane = tidx() & 63, wid = tidx() >> 6;
    for (int r = bid * 4 + wid; r < rows; r += nb * 4) {
        const float4* ip = (const float4*)(in + (size_t)r * D);
        float4 v[4]; float ss = 0.f;
#pragma unroll
        for (int i = 0; i < 4; ++i) { v[i] = ip[lane + 64 * i]; ss += v[i].x * v[i].x + v[i].y * v[i].y + v[i].z * v[i].z + v[i].w * v[i].w; }
        ss = wave_sum(ss);
        const float sc = dscale / sqrtf(ss * (1.f / D) + 1e-6f);
#pragma unroll
        for (int i = 0; i < 4; ++i) {
            const float4 gg = ((const float4*)g)[lane + 64 * i];
            float4 o; o.x = v[i].x * sc * gg.x; o.y = v[i].y * sc * gg.y; o.z = v[i].z * sc * gg.z; o.w = v[i].w * sc * gg.w;
            if constexpr (sizeof(OUT) == 4) ((float4*)((float*)out + (size_t)r * D))[lane + 64 * i] = o;
            else { u32x2 w; w.x = cvt_pk_bf16(o.x, o.y); w.y = cvt_pk_bf16(o.z, o.w); ((u32x2*)((bf16_t*)out + (size_t)r * D))[lane + 64 * i] = w; }
        }
    }
}

__device__ __forceinline__ void ph_ckvnorm(const Params& p, int layer, int bid, int nb) {
    const int lane = tidx() & 63, wid = tidx() >> 6;
    const float* g = p.kv_norm + layer * 128;
    for (int r = bid * 4 + wid; r < T; r += nb * 4) {
        const float* ip = p.CKVR() + (size_t)r * 128;
        const float a = ip[lane], b = ip[lane + 64];
        const float ss = wave_sum(a * a + b * b);
        const float sc = 1.0f / sqrtf(ss * (1.f / 128.f) + 1e-6f);
        p.CKV()[(size_t)r * 128 + lane] = f2bf(a * sc * g[lane]);
        p.CKV()[(size_t)r * 128 + lane + 64] = f2bf(b * sc * g[lane + 64]);
    }
}

template <bool MAPIN = false>
__device__ __forceinline__ void convert_wt(const float* __restrict__ src, bf16_t* __restrict__ dst, int K, int N, int nmat, int bid, int nb, float* sm) {
    float (*tl)[65] = (float (*)[65])sm;
    const int tid = tidx(), tk = K / 64, tn = (N + 63) / 64, per = tk * tn;
    for (int it = bid; it < per * nmat; it += nb) {
        const int mat = it / per, r = it % per, k0 = (r % tk) * 64, n0 = (r / tk) * 64;
        const float* s = src + (size_t)mat * K * N; bf16_t* d = dst + (size_t)mat * K * N;
        for (int i = tid; i < 64 * 64; i += 256) { const int kk = i >> 6, nn = i & 63; tl[kk][nn] = (n0 + nn < N) ? s[(size_t)(k0 + kk) * N + n0 + nn] : 0.f; }
        __syncthreads();
        {
            const int nn = tid >> 2, kq = (tid & 3) * 16;
            if (n0 + nn < N) {
                u32x4 w0, w1;
                w0.x = cvt_pk_bf16(tl[kq + 0][nn], tl[kq + 1][nn]); w0.y = cvt_pk_bf16(tl[kq + 2][nn], tl[kq + 3][nn]);
                w0.z = cvt_pk_bf16(tl[kq + 4][nn], tl[kq + 5][nn]); w0.w = cvt_pk_bf16(tl[kq + 6][nn], tl[kq + 7][nn]);
                w1.x = cvt_pk_bf16(tl[kq + 8][nn], tl[kq + 9][nn]); w1.y = cvt_pk_bf16(tl[kq + 10][nn], tl[kq + 11][nn]);
                w1.z = cvt_pk_bf16(tl[kq + 12][nn], tl[kq + 13][nn]); w1.w = cvt_pk_bf16(tl[kq + 14][nn], tl[kq + 15][nn]);
                const int drow = MAPIN ? map_in_col(n0 + nn) : (n0 + nn);
                u32x4* dp = (u32x4*)(d + (size_t)drow * K + k0 + kq);
                dp[0] = w0; dp[1] = w1;
            }
        }
        __syncthreads();
    }
}

constexpr int GROW = 80;
constexpr int GA_BYTES = 128 * GROW;
struct GStage { u32x4 a0, a1, b0, b1; };
template <int BN, int DEPTH = 3>
__device__ __forceinline__ void tile_mac(f32x16 (&acc)[2][BN / 64], const bf16_t* __restrict__ A, int lda, int m0,
                                         const bf16_t* __restrict__ Bt, int ldb, int n0, int nmax, int K, char* sm) {
    constexpr int NT = BN / 64;
    constexpr int B_BYTES = BN * GROW;
    constexpr int BUF = GA_BYTES + B_BYTES;
    const int tid = tidx(), lane = tid & 63, wid = __builtin_amdgcn_readfirstlane(tid >> 6), wr = wid >> 1, wc = wid & 1;
    const int lr = lane & 31, lh = lane >> 5;
    const int ar0 = tid >> 2, akq = tid & 3;
    const bf16_t* Ab = A + (size_t)m0 * lda;
    const bf16_t* Bb = Bt + (size_t)n0 * ldb;
    const unsigned ao0 = (unsigned)(ar0 * lda + akq * 8), ao1 = ao0 + (unsigned)(64 * lda);
    const int br0 = tid >> 2;
    const bool bv0 = (n0 + br0) < nmax, bv1 = (NT == 2) && ((n0 + br0 + 64) < nmax);
    const unsigned bo0 = (unsigned)((bv0 ? br0 : 0) * ldb + akq * 8), bo1 = (unsigned)((bv1 ? br0 + 64 : 0) * ldb + akq * 8);
    const int st_a0 = ar0 * GROW + akq * 16, st_a1 = (ar0 + 64) * GROW + akq * 16;
    const int st_b0 = GA_BYTES + br0 * GROW + akq * 16, st_b1 = GA_BYTES + (br0 + 64) * GROW + akq * 16;
    const int rd_a = (wr * 64 + lr) * GROW + lh * 16, rd_b = GA_BYTES + (wc * (BN / 2) + lr) * GROW + lh * 16;
    const u32x4 zero4 = {0u, 0u, 0u, 0u};
    const int nk = K / 32;
    auto gload = [&](GStage& g, int ks) {
        const unsigned ko = (unsigned)ks * 32u;
        g.a0 = *(const u32x4*)(Ab + (ao0 + ko)); g.a1 = *(const u32x4*)(Ab + (ao1 + ko));
        g.b0 = *(const u32x4*)(Bb + (bo0 + ko)); if (NT == 2) g.b1 = *(const u32x4*)(Bb + (bo1 + ko));
    };
    auto lstore = [&](const GStage& g, char* buf) {
        *(u32x4*)(buf + st_a0) = g.a0; *(u32x4*)(buf + st_a1) = g.a1;
        *(u32x4*)(buf + st_b0) = bv0 ? g.b0 : zero4; if (NT == 2) *(u32x4*)(buf + st_b1) = bv1 ? g.b1 : zero4;
    };
    auto compute = [&](const char* cur) {
#pragma unroll
        for (int s = 0; s < 2; ++s) {
            bf16x8 a[2], b[NT];
#pragma unroll
            for (int mi = 0; mi < 2; ++mi) a[mi] = *(const bf16x8*)(cur + rd_a + mi * 32 * GROW + s * 32);
#pragma unroll
            for (int ni = 0; ni < NT; ++ni) b[ni] = *(const bf16x8*)(cur + rd_b + ni * 32 * GROW + s * 32);
#pragma unroll
            for (int mi = 0; mi < 2; ++mi)
#pragma unroll
                for (int ni = 0; ni < NT; ++ni) acc[mi][ni] = __builtin_amdgcn_mfma_f32_32x32x16_bf16(a[mi], b[ni], acc[mi][ni], 0, 0, 0);
        }
    };
    GStage g0, g1, g2;
    g1.b1 = zero4; g2.b1 = zero4; g0.b1 = zero4;
    const int last = nk - 1;
    gload(g0, 0);
    gload(g1, min(1, last));
    if (DEPTH == 3) gload(g2, min(2, last));
    __syncthreads();
    lstore(g0, sm);
    __syncthreads();
#define GSTEP(k, GL, GS) { gload(GL, min((k) + DEPTH, last)); compute(sm + ((k) & 1) * BUF); lstore(GS, sm + (((k) + 1) & 1) * BUF); __syncthreads(); }
    int ks = 0;
    if (DEPTH == 3) {
#pragma unroll 1
        for (; ks + 3 <= nk; ks += 3) {
            GSTEP(ks, g0, g1)
            GSTEP(ks + 1, g1, g2)
            GSTEP(ks + 2, g2, g0)
        }
        if (ks < nk) {
            GSTEP(ks, g0, g1)
            if (ks + 1 < nk) GSTEP(ks + 1, g1, g2)
        }
    } else if (DEPTH == 2) {
#pragma unroll 1
        for (; ks + 2 <= nk; ks += 2) {
            GSTEP(ks, g0, g1)
            GSTEP(ks + 1, g1, g0)
        }
        if (ks < nk) GSTEP(ks, g0, g1)
    } else {
#pragma unroll 1
        for (; ks < nk; ++ks) GSTEP(ks, g1, g1)
    }
#undef GSTEP
}
template <int NT> __device__ __forceinline__ void acc_zero(f32x16 (&acc)[2][NT]) {
#pragma unroll
    for (int mi = 0; mi < 2; ++mi)
#pragma unroll
        for (int ni = 0; ni < NT; ++ni)
#pragma unroll
            for (int r = 0; r < 16; ++r) acc[mi][ni][r] = 0.f;
}
template <int BN, class Epi>
__device__ __forceinline__ void gemm_bf16(const bf16_t* A, int lda, const bf16_t* Bt, int ldb, int M, int N, int K, const Epi& epi, int bid, int nb, char* sm) {
    constexpr int NT = BN / 64;
    const int tm = M / 128, tn = (N + BN - 1) / BN;
    const int lane = tidx() & 63, wid = __builtin_amdgcn_readfirstlane(tidx() >> 6), wr = wid >> 1, wc = wid & 1, lr = lane & 31, lh = lane >> 5;
    for (int tile = bid; tile < tm * tn; tile += nb) {
        const int m0 = (tile % tm) * 128, n0 = (tile / tm) * BN;
        f32x16 acc[2][NT]; acc_zero<NT>(acc);
        tile_mac<BN>(acc, A, lda, m0, Bt, ldb, n0, N, K, sm);
        const int col0 = n0 + wc * (BN / 2);
        if (col0 < N) epi(acc, m0 + wr * 64, col0, lr, lh);
    }
}
#define EROW(mi, r) (row0 + (mi) * 32 + ((r) & 3) + 8 * ((r) >> 2) + 4 * lh)
__device__ __forceinline__ float bf2f(bf16_t h) { return __uint_as_float((unsigned)h << 16); }
__device__ __forceinline__ void epi_rope64(const f32x16 (&acc)[2][2], int row0, int lr, int lh, const float* __restrict__ rope, bf16_t* __restrict__ dst, int ld, int cbase) {
#pragma unroll
    for (int mi = 0; mi < 2; ++mi)
#pragma unroll
        for (int r = 0; r < 16; ++r) {
            const size_t row = EROW(mi, r);
            const float c = rope[row * 64 + lr], s = rope[row * 64 + 32 + lr], x1 = acc[mi][0][r], x2 = acc[mi][1][r];
            dst[row * ld + cbase + lr] = f2bf(x1 * c - x2 * s); dst[row * ld + cbase + 32 + lr] = f2bf(x2 * c + x1 * s);
        }
}
template <int NTI>
__device__ __forceinline__ void epi_rope32(const f32x16 (&acc)[2][2], int row0, int lr, int lh, const float* __restrict__ rope, bf16_t* __restrict__ dst, int ld, int cbase) {
    const int f = lr & 15;
#pragma unroll
    for (int mi = 0; mi < 2; ++mi)
#pragma unroll
        for (int ni = 0; ni < NTI; ++ni)
#pragma unroll
            for (int r = 0; r < 16; ++r) {
                const size_t row = EROW(mi, r);
                const float x = acc[mi][ni][r], xo = __shfl_xor(x, 16, 64);
                const float c = rope[row * 64 + 2 * f], s = rope[row * 64 + 32 + 2 * f];
                dst[row * ld + cbase + ni * 32 + lr] = f2bf((lr & 16) ? (x * c + xo * s) : (x * c - xo * s));
            }
}
template <int NT, bool SILU>
__device__ __forceinline__ void epi_bf16(const f32x16 (&acc)[2][NT], int row0, int lr, int lh, bf16_t* __restrict__ dst, int ld, int cbase) {
#pragma unroll
    for (int mi = 0; mi < 2; ++mi)
#pragma unroll
        for (int ni = 0; ni < NT; ++ni)
#pragma unroll
            for (int r = 0; r < 16; ++r) { const float v = acc[mi][ni][r]; dst[(size_t)EROW(mi, r) * ld + cbase + ni * 32 + lr] = f2bf(SILU ? silu_(v) : v); }
}
template <int NT>
__device__ __forceinline__ void epi_vt(const f32x16 (&acc)[2][NT], int trow0, int lr, int lh, bf16_t* __restrict__ vt, size_t ldv) {
#pragma unroll
    for (int mi = 0; mi < 2; ++mi)
#pragma unroll
        for (int ni = 0; ni < NT; ++ni)
#pragma unroll
            for (int g = 0; g < 4; ++g) {
                u32x2 o; o.x = cvt_pk_bf16(acc[mi][ni][4 * g], acc[mi][ni][4 * g + 1]); o.y = cvt_pk_bf16(acc[mi][ni][4 * g + 2], acc[mi][ni][4 * g + 3]);
                *(u32x2*)(vt + (size_t)(ni * 32 + lr) * ldv + trow0 + mi * 32 + 8 * g + 4 * lh) = o;
            }
}
template <int NT>
__device__ __forceinline__ void epi_f32(const f32x16 (&acc)[2][NT], int row0, int lr, int lh, float* __restrict__ dst, int ld, int cbase) {
#pragma unroll
    for (int mi = 0; mi < 2; ++mi)
#pragma unroll
        for (int ni = 0; ni < NT; ++ni)
#pragma unroll
            for (int r = 0; r < 16; ++r) dst[(size_t)EROW(mi, r) * ld + cbase + ni * 32 + lr] = acc[mi][ni][r];
}
struct EpiInProj {
    const Params& p; int layer;
    __device__ __forceinline__ void operator()(const f32x16 (&acc)[2][2], int row0, int col0, int lr, int lh) const {
        const int b = row0 / S, t0 = row0 % S;
        const float* rope = p.ROPE();
        int kind, ld = 256, cbase = 0; size_t off = 0; bool silu = false;
        if (col0 < M_QN)         { kind = 0; off = OFF_QA; cbase = col0 - M_QA; }
        else if (col0 < M_KSLC)  { kind = 0; off = OFF_QN; cbase = col0 - M_QN; }
        else if (col0 == M_KSLC) { kind = 0; off = OFF_KSLC; ld = 64; }
        else if (col0 == M_KWIN) { kind = 0; off = OFF_KWIN; ld = 64; }
        else if (col0 == M_KC)   { kind = 0; off = OFF_KCT; ld = 64; }
        else if (col0 == M_VC)   { kind = 1; off = OFF_VCTOK; ld = 64; }
        else if (col0 < M_KF)    { kind = 1; off = OFF_QF; cbase = col0 - M_QF; }
        else if (col0 < M_QS)    { kind = 1; off = OFF_KF; cbase = col0 - M_KF; }
        else if (col0 < M_KSB)   { kind = 1; off = OFF_QS; cbase = col0 - M_QS; }
        else if (col0 < M_QM)    { kind = 1; off = OFF_KSB; cbase = col0 - M_KSB; }
        else if (col0 < M_VF)    { kind = 1; off = OFF_QM; cbase = col0 - M_QM; }
        else if (col0 < M_VS)    { kind = 2; off = OFF_VFT + ((size_t)(b * 4 + (col0 - M_VF) / 64) * 64) * S * 2; }
        else if (col0 < M_VSLC)  { kind = 2; off = OFF_VST + ((size_t)(b * 4 + (col0 - M_VS) / 64) * 64) * S * 2; }
        else if (col0 == M_VSLC) { kind = 2; off = OFF_VSLCT + ((size_t)b * 64) * S * 2; }
        else if (col0 == M_VWIN) { kind = 2; off = OFF_VWINT + ((size_t)b * 64) * S * 2; }
        else if (col0 < M_SPC)   { kind = 3; off = OFF_QI; ld = 128; cbase = col0 - M_QI; }
        else if (col0 == M_SPC)  { kind = 4; }
        else if (col0 < M_Z)     { kind = 5; off = OFF_CKVR; ld = 128; cbase = col0 - M_CKV; }
        else if (col0 < NPM)     { kind = 1; off = OFF_ZG; ld = 1280; cbase = col0 - M_Z; silu = true; }
        else if (col0 < M_MERGE) { return; }
        else                     { kind = 6; }
        bf16_t* dst = (bf16_t*)(p.ws + off);
        if (kind == 0) epi_rope64(acc, row0, lr, lh, rope, dst, ld, cbase);
        else if (kind == 1) {
#pragma unroll
            for (int mi = 0; mi < 2; ++mi)
#pragma unroll
                for (int ni = 0; ni < 2; ++ni)
#pragma unroll
                    for (int r = 0; r < 16; ++r) { const float v = acc[mi][ni][r]; dst[(size_t)EROW(mi, r) * ld + cbase + ni * 32 + lr] = f2bf(silu ? silu_(v) : v); }
        }
        else if (kind == 2) epi_vt<2>(acc, t0, lr, lh, dst, S);
        else if (kind == 3) epi_rope32<2>(acc, row0, lr, lh, rope, dst, ld, cbase);
        else if (kind == 5) epi_f32<2>(acc, row0, lr, lh, (float*)dst, ld, cbase);
        else if (kind == 6) {
            const int tile = (row0 >> 7) * 40 + ((col0 - M_MERGE) >> 7), wave = ((row0 >> 6) & 1) * 2 + ((col0 >> 6) & 1);
            bf16_t* sp = p.SIG() + ((size_t)(tile * 4 + wave) * 4) * 1024 + (size_t)(lh * 32 + lr) * 16;
#pragma unroll
            for (int mi = 0; mi < 2; ++mi)
#pragma unroll
                for (int ni = 0; ni < 2; ++ni) {
                    u32x4 w0, w1;
                    w0.x = cvt_pk_bf16(sigmoid_(acc[mi][ni][0]), sigmoid_(acc[mi][ni][1])); w0.y = cvt_pk_bf16(sigmoid_(acc[mi][ni][2]), sigmoid_(acc[mi][ni][3]));
                    w0.z = cvt_pk_bf16(sigmoid_(acc[mi][ni][4]), sigmoid_(acc[mi][ni][5])); w0.w = cvt_pk_bf16(sigmoid_(acc[mi][ni][6]), sigmoid_(acc[mi][ni][7]));
                    w1.x = cvt_pk_bf16(sigmoid_(acc[mi][ni][8]), sigmoid_(acc[mi][ni][9])); w1.y = cvt_pk_bf16(sigmoid_(acc[mi][ni][10]), sigmoid_(acc[mi][ni][11]));
                    w1.z = cvt_pk_bf16(sigmoid_(acc[mi][ni][12]), sigmoid_(acc[mi][ni][13])); w1.w = cvt_pk_bf16(sigmoid_(acc[mi][ni][14]), sigmoid_(acc[mi][ni][15]));
                    u32x4* d4 = (u32x4*)(sp + (size_t)(mi * 2 + ni) * 1024);
                    d4[0] = w0; d4[1] = w1;
                }
        }
        else {
            epi_rope32<1>(acc, row0, lr, lh, rope, p.KI(), 32, 0);
            const float fb = p.fox_bias[layer * 4 + (lr & 3)];
#pragma unroll
            for (int mi = 0; mi < 2; ++mi)
#pragma unroll
                for (int r = 0; r < 16; ++r) {
                    const size_t row = EROW(mi, r); const float v = acc[mi][1][r];
                    if (lr < 4) p.WI()[row * 4 + lr] = v * 0.08838834764831845f;
                    else if (lr < 8) p.LOGF()[row * 4 + lr - 4] = logsig_(v + fb);
                    else if (lr < 20) p.GN()[row * 12 + lr - 8] = sigmoid_(v);
                }
        }
    }
};
struct EpiMemKV {
    const Params& p;
    __device__ __forceinline__ void operator()(const f32x16 (&acc)[2][2], int row0, int col0, int lr, int lh) const {
        if (col0 < 256) epi_bf16<2, false>(acc, row0, lr, lh, p.MKB(), 256, col0);
        else epi_vt<2>(acc, row0 % NMEM, lr, lh, p.MVT() + ((size_t)((row0 / NMEM) * 4 + (col0 - 256) / 64) * 64) * NMEM, NMEM);
    }
};
struct EpiKA { const Params& p;
    __device__ __forceinline__ void operator()(const f32x16 (&acc)[2][2], int row0, int col0, int lr, int lh) const { epi_rope64(acc, row0, lr, lh, p.ROPE(), p.KAB(), 256, col0); } };
struct EpiVA { const Params& p;
    __device__ __forceinline__ void operator()(const f32x16 (&acc)[2][2], int row0, int col0, int lr, int lh) const {
        epi_vt<2>(acc, row0 % S, lr, lh, p.VAT() + ((size_t)((row0 / S) * 4 + col0 / 64) * 64) * S, S); } };
struct EpiResid { const float* Xin; float* Xout;
    __device__ __forceinline__ void operator()(const f32x16 (&acc)[2][2], int row0, int col0, int lr, int lh) const {
#pragma unroll
        for (int mi = 0; mi < 2; ++mi) {
            float xv[2][16];
#pragma unroll
            for (int ni = 0; ni < 2; ++ni)
#pragma unroll
                for (int r = 0; r < 16; ++r) xv[ni][r] = Xin[(size_t)EROW(mi, r) * D + col0 + ni * 32 + lr];
#pragma unroll
            for (int ni = 0; ni < 2; ++ni)
#pragma unroll
                for (int r = 0; r < 16; ++r) Xout[(size_t)EROW(mi, r) * D + col0 + ni * 32 + lr] = xv[ni][r] + acc[mi][ni][r];
        }
    } };
struct EpiCmp1 { const float* bias; bf16_t* hid;
    __device__ __forceinline__ void operator()(const f32x16 (&acc)[2][1], int row0, int col0, int lr, int lh) const {
        const float bv = bias[col0 + lr];
#pragma unroll
        for (int mi = 0; mi < 2; ++mi)
#pragma unroll
            for (int r = 0; r < 16; ++r) hid[(size_t)EROW(mi, r) * 128 + col0 + lr] = f2bf(silu_(acc[mi][0][r] + bv));
    } };
struct EpiCmp2K { bf16_t* kcb;
    __device__ __forceinline__ void operator()(const f32x16 (&acc)[2][1], int row0, int col0, int lr, int lh) const {
#pragma unroll
        for (int mi = 0; mi < 2; ++mi)
#pragma unroll
            for (int r = 0; r < 16; ++r) { const int row = EROW(mi, r); kcb[(size_t)row * 64 + col0 + lr] = ((row & 511) == 511) ? (bf16_t)0 : f2bf(acc[mi][0][r]); }
    } };
struct EpiCmp2V { bf16_t* vct;
    __device__ __forceinline__ void operator()(const f32x16 (&acc)[2][1], int row0, int col0, int lr, int lh) const {
        bf16_t* base = vct + ((size_t)(row0 / 512) * 64 + col0) * 512;
        const int n0 = row0 % 512;
#pragma unroll
        for (int mi = 0; mi < 2; ++mi)
#pragma unroll
            for (int g = 0; g < 4; ++g) {
                const int n = n0 + mi * 32 + 8 * g + 4 * lh;
                u32x2 o; o.x = cvt_pk_bf16(acc[mi][0][4 * g], acc[mi][0][4 * g + 1]); o.y = cvt_pk_bf16(acc[mi][0][4 * g + 2], (n + 3 == 511) ? 0.f : acc[mi][0][4 * g + 3]);
                *(u32x2*)(base + (size_t)lr * 512 + n) = o;
            }
    } };

__device__ __forceinline__ void ph_merge(const Params& p, int layer, int bid, int nb, char* sm) {
    const int lane = tidx() & 63, wid = __builtin_amdgcn_readfirstlane(tidx() >> 6), wr = wid >> 1, wc = wid & 1, lr = lane & 31, lh = lane >> 5;
    for (int tile = bid; tile < (T / 128) * (D / 128); tile += nb) {
        const int mt = tile % (T / 128), nt = tile / (T / 128), m0 = mt * 128, n0 = nt * 128;
        f32x16 mg[2][2]; acc_zero<2>(mg);
#pragma unroll 1
        for (int n = 0; n < 5; ++n) {
            f32x16 g[2][2]; acc_zero<2>(g);
            tile_mac<128>(g, p.Y() + n * 256, 1280, m0, p.WBR() + ((size_t)layer * 5 + n) * D * 256, 256, n0, D, 256, sm);
            const bf16_t* sp = p.SIG() + ((size_t)((mt * 40 + n * 8 + nt) * 4 + wid) * 4) * 1024 + (size_t)lane * 16;
#pragma unroll
            for (int mi = 0; mi < 2; ++mi)
#pragma unroll
                for (int ni = 0; ni < 2; ++ni) {
                    const u32x4* s4 = (const u32x4*)(sp + (size_t)(mi * 2 + ni) * 1024);
                    const u32x4 w0 = s4[0], w1 = s4[1];
                    const unsigned sw[8] = {w0.x, w0.y, w0.z, w0.w, w1.x, w1.y, w1.z, w1.w};
#pragma unroll
                    for (int r = 0; r < 8; ++r) {
                        mg[mi][ni][2 * r] = fmaf(__uint_as_float(sw[r] << 16), g[mi][ni][2 * r], mg[mi][ni][2 * r]);
                        mg[mi][ni][2 * r + 1] = fmaf(__uint_as_float(sw[r] & 0xffff0000u), g[mi][ni][2 * r + 1], mg[mi][ni][2 * r + 1]);
                    }
                }
        }
        epi_bf16<2, false>(mg, m0 + wr * 64, lr, lh, p.MG(), D, n0 + wc * 64);
    }
}

__device__ __forceinline__ void ph_cumsum(const Params& p, int bid, int nb, float* sm) {
    const int tid = tidx();
    for (int item = bid; item < NBATCH * 4; item += nb) {
        const int b = item >> 2, h = item & 3;
        const float* src = p.LOGF() + (size_t)b * S * 4 + h;
        float* dst = p.CUM() + (size_t)b * S * 4 + h;
        float loc = 0.f;
        for (int i = 0; i < 32; ++i) loc += src[(size_t)(tid * 32 + i) * 4];
        sm[tid] = loc; __syncthreads();
        if (tid == 0) { float run = 0.f; for (int i = 0; i < 256; ++i) { const float v = sm[i]; sm[i] = run; run += v; } }
        __syncthreads();
        float run = sm[tid];
        float* dt = p.CUMT() + (size_t)item * S;
        for (int i = 0; i < 32; ++i) { run += src[(size_t)(tid * 32 + i) * 4]; dst[(size_t)(tid * 32 + i) * 4] = run; dt[tid * 32 + i] = run * 1.4426950408889634f; }
        __syncthreads();
    }
}

enum { AM_FOX = 0, AM_DSA = 1, AM_SLC = 2, AM_SB = 3, AM_WIN = 4, AM_MEM = 5, AM_CMP = 6 };
constexpr int AK_ROW = 144;
constexpr int AK_TILE = 64 * AK_ROW;
constexpr int ABUF = 2 * AK_TILE + 256;
constexpr float LOG2E = 1.4426950408889634f;
#define NEG_INF (-__builtin_inff())

template <int MODE>
__device__ __forceinline__ void attn_unit(const Params& p, int b, int head, int qblk, char* sm) {
    const int tid = tidx(), lane = tid & 63, wid = __builtin_amdgcn_readfirstlane(tid >> 6), lr = lane & 31, lh = lane >> 5;
    const int q0 = qblk * 128, qw0 = q0 + 32 * wid, tq = qw0 + lr;
    const size_t gq = (size_t)b * S + tq;
    const bf16_t *Qp, *Kp, *VTp; int ldk, ldv;
    if (MODE == AM_FOX)      { Qp = p.QF() + gq * 256 + head * 64; Kp = p.KF() + (size_t)b * S * 256 + head * 64; ldk = 256; VTp = p.VFT() + ((size_t)(b * 4 + head) * 64) * S; ldv = S; }
    else if (MODE == AM_DSA) { Qp = p.QA() + gq * 256 + head * 64; Kp = p.KAB() + (size_t)b * S * 256 + head * 64; ldk = 256; VTp = p.VAT() + ((size_t)(b * 4 + head) * 64) * S; ldv = S; }
    else if (MODE == AM_SB)  { Qp = p.QS() + gq * 256 + head * 64; Kp = p.KSB() + (size_t)b * S * 256 + head * 64; ldk = 256; VTp = p.VST() + ((size_t)(b * 4 + head) * 64) * S; ldv = S; }
    else if (MODE == AM_SLC) { Qp = p.QN() + gq * 256 + head * 64; Kp = p.KSLC() + (size_t)b * S * 64; ldk = 64; VTp = p.VSLCT() + ((size_t)b * 64) * S; ldv = S; }
    else if (MODE == AM_WIN) { Qp = p.QN() + gq * 256 + head * 64; Kp = p.KWIN() + (size_t)b * S * 64; ldk = 64; VTp = p.VWINT() + ((size_t)b * 64) * S; ldv = S; }
    else if (MODE == AM_CMP) { Qp = p.QN() + gq * 256 + head * 64; Kp = p.KCB() + (size_t)b * NCMP_PAD * 64; ldk = 64; VTp = p.VCT() + ((size_t)b * 64) * NCMP_PAD; ldv = NCMP_PAD; }
    else                     { Qp = p.QM() + gq * 256 + head * 64; Kp = p.MKB() + (size_t)b * NMEM * 256 + head * 64; ldk = 256; VTp = p.MVT() + ((size_t)(b * 4 + head) * 64) * NMEM; ldv = NMEM; }
    int kt_lo = 0, kt_hi = 2 * qblk + 2;
    if (MODE == AM_WIN) kt_lo = q0 >= 512 ? (q0 - 512) / 64 : 0;
    if (MODE == AM_MEM) kt_hi = NMEM / 64;
    if (MODE == AM_CMP) kt_hi = min(8, (((q0 + 96) >> 4) >> 6) + 1);
    const int nlim = (tq - 31) >> 4;
    const int ntile = kt_hi - kt_lo;
    constexpr bool REV = (MODE == AM_SB);

    bf16x8 qf[4];
#pragma unroll
    for (int s = 0; s < 4; ++s) qf[s] = *(const bf16x8*)(Qp + 16 * s + 8 * lh);
    unsigned smw[4] = {0u, 0u, 0u, 0u};
    if (MODE == AM_SLC) { const u32x4 w = *(const u32x4*)(p.SMASK() + gq * 4); smw[0] = w.x; smw[1] = w.y; smw[2] = w.z; smw[3] = w.w; }
    const unsigned long long* mrow = (const unsigned long long*)(p.DMASK() + gq * 256);
    const float* csp = p.CUMT() + (size_t)(b * 4 + head) * S;

    const int srow = tid >> 3, sc16 = tid & 7;
    const int st0 = srow * AK_ROW + sc16 * 16, st1 = (srow + 32) * AK_ROW + sc16 * 16;
    const bf16_t* kg0 = Kp + (size_t)srow * ldk + sc16 * 8;
    const bf16_t* kg1 = Kp + (size_t)(srow + 32) * ldk + sc16 * 8;
    const bf16_t* vg0 = VTp + (size_t)srow * ldv + sc16 * 8;
    const bf16_t* vg1 = VTp + (size_t)(srow + 32) * ldv + sc16 * 8;
    u32x4 rk0, rk1, rv0, rv1; float rcs = 0.f;
    auto gload = [&](int kt) {
        rk0 = *(const u32x4*)(kg0 + (size_t)kt * 64 * ldk); rk1 = *(const u32x4*)(kg1 + (size_t)kt * 64 * ldk);
        rv0 = *(const u32x4*)(vg0 + kt * 64); rv1 = *(const u32x4*)(vg1 + kt * 64);
        if (MODE == AM_FOX) { if (tid < 64) rcs = csp[kt * 64 + tid]; }
    };
    auto lstore = [&](char* buf) {
        *(u32x4*)(buf + st0) = rk0; *(u32x4*)(buf + st1) = rk1;
        *(u32x4*)(buf + AK_TILE + st0) = rv0; *(u32x4*)(buf + AK_TILE + st1) = rv1;
        if (MODE == AM_FOX) { if (tid < 64) *(float*)(buf + 2 * AK_TILE + tid * 4) = rcs; }
    };
    const int pil = (lr & 0x13) | ((lr & 4) << 1) | ((lr & 8) >> 1);
    const int rdk = pil * AK_ROW + lh * 16;
    const int rdv = AK_TILE + lr * AK_ROW + lh * 16;

    float m = NEG_INF, l = 0.f, R = 0.f;
    f32x16 O[2];
#pragma unroll
    for (int i = 0; i < 16; ++i) { O[0][i] = 0.f; O[1][i] = 0.f; }

    gload(REV ? kt_hi - 1 : kt_lo);
    __syncthreads();
    lstore(sm);
    __syncthreads();
#pragma unroll 1
    for (int it = 0; it < ntile; ++it) {
        const int kt = REV ? kt_hi - 1 - it : kt_lo + it;
        char* cur = sm + (it & 1) * ABUF;
        const bool more = (it + 1) < ntile;
        if (more) gload(REV ? kt - 1 : kt + 1);
        unsigned long long mw = 0ull;
        if (MODE == AM_DSA) mw = mrow[kt];
        bool need = true;
        if (MODE == AM_CMP) need = kt * 64 <= (qw0 >> 4);
        else if (MODE != AM_MEM) need = kt * 64 <= qw0 + 31;
        if (MODE == AM_WIN) need = need && (kt * 64 + 63 >= qw0 - 511);
        if (need) {
#pragma unroll
            for (int sb2 = 0; sb2 < 2; ++sb2) {
                const int sub = REV ? 1 - sb2 : sb2;
                const int kb = kt * 64 + sub * 32;
                bool sneed = true;
                if (MODE == AM_CMP) sneed = kb <= (qw0 >> 4);
                else if (MODE != AM_MEM) sneed = kb <= qw0 + 31;
                if (MODE == AM_WIN) sneed = sneed && (kb + 31 >= qw0 - 511);
                if (sneed) {
                    f32x16 s;
#pragma unroll
                    for (int i = 0; i < 16; ++i) s[i] = 0.f;
#pragma unroll
                    for (int s4 = 0; s4 < 4; ++s4) {
                        const bf16x8 kf = *(const bf16x8*)(cur + rdk + sub * 32 * AK_ROW + s4 * 32);
                        s = __builtin_amdgcn_mfma_f32_32x32x16_bf16(kf, qf[s4], s, 0, 0, 0);
                    }
                    const int thl = tq - kb - 8 * lh;
                    bf16x8 pf[2];
                    if (MODE == AM_SB) {
                        float lk[16];
#pragma unroll
                        for (int r = 0; r < 16; ++r) {
                            const int cr = 16 * (r >> 3) + (r & 7);
                            const float z = s[r] * 0.125f;
                            const float az = fabsf(z);
                            const float sp = fmaxf(z, 0.f) + __builtin_amdgcn_logf(1.f + __builtin_amdgcn_exp2f(-az * LOG2E)) * 0.6931471805599453f;
                            const bool ok = cr < thl;
                            lk[r] = ok ? -sp : 0.f;
                            s[r] = ok ? z : NEG_INF;
                        }
                        float g0 = 0.f, g1 = 0.f;
#pragma unroll
                        for (int r = 0; r < 8; ++r) { g0 += lk[r]; g1 += lk[8 + r]; }
                        const float pg0 = __shfl_xor(g0, 32, 64), pg1 = __shfl_xor(g1, 32, 64);
                        const float off0 = R + (lh == 0 ? (pg0 + g1 + pg1) : (pg1 + g1));
                        const float off1 = R + (lh == 0 ? pg1 : 0.f);
                        float run0 = off0, run1 = off1;
#pragma unroll
                        for (int r = 7; r >= 0; --r) {
                            const float a0 = __builtin_amdgcn_exp2f((s[r] + lk[r] + run0) * LOG2E); run0 += lk[r];
                            const float a1 = __builtin_amdgcn_exp2f((s[8 + r] + lk[8 + r] + run1) * LOG2E); run1 += lk[8 + r];
                            s[r] = a0; s[8 + r] = a1;
                        }
                        R += (g0 + g1) + (pg0 + pg1);
                    } else {
                        constexpr float c = 0.125f * LOG2E;
                        if (MODE == AM_FOX) {
                            const float4* cs4 = (const float4*)(cur + 2 * AK_TILE + (sub * 32 + 8 * lh) * 4);
                            const float4 c0 = cs4[0], c1 = cs4[1], c2 = cs4[4], c3 = cs4[5];
                            const float cv[16] = {c0.x, c0.y, c0.z, c0.w, c1.x, c1.y, c1.z, c1.w, c2.x, c2.y, c2.z, c2.w, c3.x, c3.y, c3.z, c3.w};
#pragma unroll
                            for (int r = 0; r < 16; ++r) s[r] = fmaf(s[r], c, -cv[r]);
                        } else {
#pragma unroll
                            for (int r = 0; r < 16; ++r) s[r] *= c;
                        }
                        if (MODE == AM_DSA) {
                            const unsigned w = (unsigned)(mw >> (32 * sub)) >> (8 * lh);
#pragma unroll
                            for (int r = 0; r < 16; ++r) { const int cr = 16 * (r >> 3) + (r & 7); s[r] = (w & (1u << cr)) ? s[r] : NEG_INF; }
                        }
                        if (MODE == AM_SLC) {
                            const unsigned w = smw[0] * (kt < 32) + smw[1] * (kt >= 32 && kt < 64) + smw[2] * (kt >= 64 && kt < 96) + smw[3] * (kt >= 96);
                            const bool sel = (w >> (kt & 31)) & 1u;
#pragma unroll
                            for (int r = 0; r < 16; ++r) s[r] = sel ? s[r] : NEG_INF;
                        }
                        if (MODE == AM_FOX || MODE == AM_SLC) {
                            if (kb + 31 > qw0) {
#pragma unroll
                                for (int r = 0; r < 16; ++r) { const int cr = 16 * (r >> 3) + (r & 7); s[r] = (cr <= thl) ? s[r] : NEG_INF; }
                            }
                        }
                        if (MODE == AM_CMP) {
                            const int tc = nlim - kb - 8 * lh;
#pragma unroll
                            for (int r = 0; r < 16; ++r) { const int cr = 16 * (r >> 3) + (r & 7); s[r] = (cr <= tc) ? s[r] : NEG_INF; }
                        }
                        if (MODE == AM_WIN) {
                            if (kb + 31 > qw0 || kb < qw0 + 31 - 511) {
#pragma unroll
                                for (int r = 0; r < 16; ++r) { const int cr = 16 * (r >> 3) + (r & 7); s[r] = (cr <= thl && cr > thl - 512) ? s[r] : NEG_INF; }
                            }
                        }
                        float tmax = s[0];
#pragma unroll
                        for (int r = 1; r < 16; ++r) tmax = fmaxf(tmax, s[r]);
                        tmax = fmaxf(tmax, __shfl_xor(tmax, 32, 64));
                        const float mn = fmaxf(m, tmax);
                        const float mu = (mn == NEG_INF) ? 0.f : mn;
                        const float corr = __builtin_amdgcn_exp2f(m - mu);
                        m = mn;
                        float ls = 0.f;
#pragma unroll
                        for (int r = 0; r < 16; ++r) { s[r] = __builtin_amdgcn_exp2f(s[r] - mu); ls += s[r]; }
                        l = l * corr + ls;
                        if (!__all(corr == 1.0f)) {
#pragma unroll
                            for (int i = 0; i < 16; ++i) { O[0][i] *= corr; O[1][i] *= corr; }
                        }
                    }
                    {
                        u32x4 w0, w1;
                        w0.x = cvt_pk_bf16(s[0], s[1]); w0.y = cvt_pk_bf16(s[2], s[3]); w0.z = cvt_pk_bf16(s[4], s[5]); w0.w = cvt_pk_bf16(s[6], s[7]);
                        w1.x = cvt_pk_bf16(s[8], s[9]); w1.y = cvt_pk_bf16(s[10], s[11]); w1.z = cvt_pk_bf16(s[12], s[13]); w1.w = cvt_pk_bf16(s[14], s[15]);
                        pf[0] = __builtin_bit_cast(bf16x8, w0); pf[1] = __builtin_bit_cast(bf16x8, w1);
                    }
#pragma unroll
                    for (int s2 = 0; s2 < 2; ++s2)
#pragma unroll
                        for (int dt = 0; dt < 2; ++dt) {
                            const bf16x8 vf = *(const bf16x8*)(cur + rdv + dt * 32 * AK_ROW + sub * 64 + s2 * 32);
                            O[dt] = __builtin_amdgcn_mfma_f32_32x32x16_bf16(vf, pf[s2], O[dt], 0, 0, 0);
                        }
                }
            }
        }
        if (more) lstore(sm + ((it + 1) & 1) * ABUF);
        __syncthreads();
    }
    float inv = 1.f;
    if (MODE != AM_SB) { const float lt = l + __shfl_xor(l, 32, 64); inv = 1.f / fmaxf(lt, 1e-30f); }
    if (MODE == AM_SLC || MODE == AM_WIN || MODE == AM_CMP) {
        const float gs = (MODE == AM_CMP) ? inv : p.GN()[gq * 12 + (MODE == AM_SLC ? 4 : 8) + head] * inv;
        float* dst = (MODE == AM_SLC ? p.OSLC() : MODE == AM_WIN ? p.OWIN() : p.OCMP()) + gq * 256 + head * 64;
#pragma unroll
        for (int dt = 0; dt < 2; ++dt)
#pragma unroll
            for (int g = 0; g < 4; ++g) {
                float4 o; o.x = O[dt][4 * g] * gs; o.y = O[dt][4 * g + 1] * gs; o.z = O[dt][4 * g + 2] * gs; o.w = O[dt][4 * g + 3] * gs;
                *(float4*)(dst + 32 * dt + 8 * g + 4 * lh) = o;
            }
    } else {
        const int yc = MODE == AM_FOX ? 256 : MODE == AM_DSA ? 0 : MODE == AM_SB ? 512 : 1024;
        const bf16_t* zp = p.ZG() + gq * 1280 + yc + head * 64;
        bf16_t* dst = p.Y() + gq * 1280 + yc + head * 64;
#pragma unroll
        for (int dt = 0; dt < 2; ++dt)
#pragma unroll
            for (int g = 0; g < 4; ++g) {
                const int d0 = 32 * dt + 8 * g + 4 * lh;
                const u32x2 z = *(const u32x2*)(zp + d0);
                u32x2 o;
                o.x = cvt_pk_bf16(O[dt][4 * g] * inv * __uint_as_float(z.x << 16), O[dt][4 * g + 1] * inv * __uint_as_float(z.x & 0xffff0000u));
                o.y = cvt_pk_bf16(O[dt][4 * g + 2] * inv * __uint_as_float(z.y << 16), O[dt][4 * g + 3] * inv * __uint_as_float(z.y & 0xffff0000u));
                *(u32x2*)(dst + d0) = o;
            }
    }
}

__device__ __forceinline__ unsigned sortable_key(float x) { const unsigned u = __float_as_uint(x + 0.0f); return (u & 0x80000000u) ? ~u : (u | 0x80000000u); }
#ifndef DIAG
#define DIAG 0
#endif
#if DIAG
#define UNIT_ATTR
#else
#define UNIT_ATTR
#endif
UNIT_ATTR __device__ __forceinline__ void dsa_select_unit(const Params& p, int b, int qt, char* sm) {
    const int tid = tidx(), lane = tid & 63, wid = __builtin_amdgcn_readfirstlane(tid >> 6), lr = lane & 31, lh = lane >> 5;
    unsigned* hist = (unsigned*)sm;
    unsigned* st_prefix = (unsigned*)(sm + 32 * 257 * 4);
    int* st_krem = (int*)(st_prefix + 32);
    int* st_part = st_krem + 32;
    const int q0 = qt * 32, tq = q0 + lr, ntile = qt + 1;
    const size_t gq = (size_t)b * S + tq;
    const bool small = tq + 1 <= 256;
    bf16x8 qf[4][2];
    float w[4];
#pragma unroll
    for (int h = 0; h < 4; ++h) {
        qf[h][0] = *(const bf16x8*)(p.QI() + gq * 128 + h * 32 + 8 * lh);
        qf[h][1] = *(const bf16x8*)(p.QI() + gq * 128 + h * 32 + 16 + 8 * lh);
        w[h] = p.WI()[gq * 4 + h];
    }
    const bf16_t* kbase = p.KI() + (size_t)b * S * 32 + (size_t)lr * 32 + 8 * lh;
    auto score_tile = [&](const bf16x8& k0, const bf16x8& k1, unsigned (&key)[16]) {
        float sc[16];
#pragma unroll
        for (int r = 0; r < 16; ++r) sc[r] = 0.f;
#pragma unroll
        for (int h = 0; h < 4; ++h) {
            f32x16 a;
#pragma unroll
            for (int r = 0; r < 16; ++r) a[r] = 0.f;
            a = __builtin_amdgcn_mfma_f32_32x32x16_bf16(k0, qf[h][0], a, 0, 0, 0);
            a = __builtin_amdgcn_mfma_f32_32x32x16_bf16(k1, qf[h][1], a, 0, 0, 0);
#pragma unroll
            for (int r = 0; r < 16; ++r) sc[r] = fmaf(fmaxf(a[r], 0.f), w[h], sc[r]);
        }
#pragma unroll
        for (int r = 0; r < 16; ++r) key[r] = sortable_key(sc[r]);
    };
#define KLOAD(kt_, a_, b_) { const bf16_t* kp_ = kbase + (size_t)min((kt_), qt) * (32 * 32); a_ = *(const bf16x8*)kp_; b_ = *(const bf16x8*)(kp_ + 16); }
    unsigned prefix = 0u;
#pragma unroll 1
    for (int pass = 0; pass < 4; ++pass) {
        const int shift = 24 - 8 * pass;
        __syncthreads();
        for (int i = tid; i < 32 * 257; i += 256) hist[i] = 0u;
        __syncthreads();
        bf16x8 k0, k1; KLOAD(wid, k0, k1)
#pragma unroll 1
        for (int kt = wid; kt < ntile; kt += 4) {
            bf16x8 n0, n1; KLOAD(kt + 4, n0, n1)
            unsigned key[16];
            score_tile(k0, k1, key);
            const int vlim = (kt == qt) ? lr : 64;
#pragma unroll
            for (int r = 0; r < 16; ++r) {
                const int rho = (r & 3) + 8 * (r >> 2) + 4 * lh;
                const bool ok = (rho <= vlim) && ((pass == 0) || ((key[r] >> (shift + 8)) == prefix));
                atomicAdd(&hist[lr * 257 + (ok ? ((key[r] >> shift) & 255u) : 256u)], 1u);
            }
            k0 = n0; k1 = n1;
        }
        __syncthreads();
        {
            const int q = tid >> 3, part = tid & 7;
            const unsigned* hr = hist + q * 257 + part * 32;
            unsigned s = 0u;
#pragma unroll 8
            for (int i = 0; i < 32; ++i) s += hr[i];
            st_part[q * 8 + part] = (int)s;
            __syncthreads();
            const bool qsmall = (q0 + q + 1) <= 256;
            const int krem = (pass == 0) ? 256 : st_krem[q];
            const unsigned pprev = (pass == 0) ? 0u : st_prefix[q];
            unsigned above = 0u;
            for (int pp = 7; pp > part; --pp) above += (unsigned)st_part[q * 8 + pp];
            __syncthreads();
            if (qsmall) { if (part == 0) { st_prefix[q] = 0u; st_krem[q] = 1 << 30; } }
            else if (above < (unsigned)krem && (unsigned)krem <= above + s) {
                unsigned cum = above; int bin = 31;
                for (; bin > 0; --bin) { const unsigned c = hr[bin]; if (cum + c >= (unsigned)krem) break; cum += c; }
                st_prefix[q] = (pprev << 8) | (unsigned)(part * 32 + bin);
                st_krem[q] = krem - (int)cum;
            }
        }
        __syncthreads();
        prefix = st_prefix[lr];
    }
    const unsigned thr = prefix;
    unsigned* mrow = p.DMASK() + gq * 256;
    unsigned* tiew = hist;
    {
        bf16x8 k0, k1; KLOAD(wid, k0, k1)
#pragma unroll 1
        for (int kt = wid; kt < 256; kt += 4) {
            unsigned gt = 0u, tie = 0u;
            if (kt < ntile) {
                bf16x8 n0, n1; KLOAD(kt + 4, n0, n1)
                unsigned key[16];
                score_tile(k0, k1, key);
                const int vlim = (kt == qt) ? lr : 64;
#pragma unroll
                for (int r = 0; r < 16; ++r) {
                    const int rho = (r & 3) + 8 * (r >> 2) + 4 * lh;
                    const bool v = rho <= vlim;
                    gt |= (v && key[r] > thr) ? (1u << rho) : 0u; tie |= (v && key[r] == thr) ? (1u << rho) : 0u;
                }
                gt |= __shfl_xor(gt, 32, 64); tie |= __shfl_xor(tie, 32, 64);
                k0 = n0; k1 = n1;
            }
            if (lh == 0) { mrow[kt] = gt; tiew[lr * 257 + kt] = tie; }
        }
    }
    asm volatile("s_waitcnt vmcnt(0)" ::: "memory");
    __syncthreads();
    {
        const int q = tid >> 3, part = tid & 7;
        const unsigned* tr = tiew + q * 257 + part * 32;
        int c = 0;
#pragma unroll 8
        for (int i = 0; i < 32; ++i) c += __builtin_popcount(tr[i]);
        st_part[q * 8 + part] = c;
        __syncthreads();
        int base = 0;
        for (int pp = 0; pp < part; ++pp) base += st_part[q * 8 + pp];
        int allow = st_krem[q] - base;
        unsigned* grow = p.DMASK() + ((size_t)b * S + q0 + q) * 256 + part * 32;
        if (c > 0 && allow > 0) {
            for (int i = 0; i < 32 && allow > 0; ++i) {
                unsigned wv = tr[i];
                if (wv == 0u) continue;
                const int pc = __builtin_popcount(wv);
                if (pc > allow) { unsigned kept = 0u; for (int j = 0; j < allow; ++j) { const unsigned low = wv & (0u - wv); kept |= low; wv ^= low; } wv = kept; }
                atomicOr(grow + i, wv);
                allow -= pc;
            }
        }
    }
#undef KLOAD
    __syncthreads();
}

__device__ __forceinline__ bool imp_better(float v1, int i1, float v2, int i2) { return (v1 > v2) || (v1 == v2 && i1 < i2); }
UNIT_ATTR __device__ __forceinline__ void nsa_select_unit(const Params& p, int b, int q0w, char* sm) {
    const int lane = tidx() & 63, lr = lane & 31, lh = lane >> 5;
    const int tq = q0w + lr;
    const size_t gq = (size_t)b * S + tq;
    const int nlim = (tq - 31) >> 4;
    const int nst = min(16, ((((q0w + 31 - 31) >> 4)) >> 5) + 1);
    const int pil = (lr & 0x13) | ((lr & 4) << 1) | ((lr & 8) >> 1);
    const bf16_t* kc = p.KCB() + (size_t)b * NCMP_PAD * 64 + (size_t)pil * 64 + 8 * lh;
    constexpr float c = 0.125f * LOG2E;
    float mh[4], il[4];
#pragma unroll
    for (int h = 0; h < 4; ++h) {
        bf16x8 qf[4];
#pragma unroll
        for (int s = 0; s < 4; ++s) qf[s] = *(const bf16x8*)(p.QN() + gq * 256 + h * 64 + 16 * s + 8 * lh);
        float m = NEG_INF, l = 0.f;
#pragma unroll 1
        for (int st = 0; st < nst; ++st) {
            f32x16 s;
#pragma unroll
            for (int i = 0; i < 16; ++i) s[i] = 0.f;
#pragma unroll
            for (int s4 = 0; s4 < 4; ++s4) { const bf16x8 kf = *(const bf16x8*)(kc + (size_t)st * 32 * 64 + s4 * 16); s = __builtin_amdgcn_mfma_f32_32x32x16_bf16(kf, qf[s4], s, 0, 0, 0); }
            const int thl = nlim - st * 32 - 8 * lh;
            float tmax = NEG_INF;
#pragma unroll
            for (int r = 0; r < 16; ++r) { const int cr = 16 * (r >> 3) + (r & 7); s[r] = (cr <= thl) ? s[r] * c : NEG_INF; tmax = fmaxf(tmax, s[r]); }
            tmax = fmaxf(tmax, __shfl_xor(tmax, 32, 64));
            const float mn = fmaxf(m, tmax), mu = (mn == NEG_INF) ? 0.f : mn;
            float ls = 0.f;
#pragma unroll
            for (int r = 0; r < 16; ++r) ls += __builtin_amdgcn_exp2f(s[r] - mu);
            l = l * __builtin_amdgcn_exp2f(m - mu) + ls; m = mn;
        }
        l += __shfl_xor(l, 32, 64);
        mh[h] = (m == NEG_INF) ? 0.f : m; il[h] = 1.f / fmaxf(l, 1e-30f);
    }
    float val[16]; int idx[16];
#pragma unroll
    for (int i = 0; i < 16; ++i) { val[i] = NEG_INF; idx[i] = 1 << 20; }
    const int cur = tq >> 6;
#pragma unroll 1
    for (int st = 0; st < 16; ++st) {
        float bs[4] = {0.f, 0.f, 0.f, 0.f};
        if (st < nst) {
            const int thl = nlim - st * 32 - 8 * lh;
#pragma unroll
            for (int h = 0; h < 4; ++h) {
                f32x16 s;
#pragma unroll
                for (int i = 0; i < 16; ++i) s[i] = 0.f;
#pragma unroll
                for (int s4 = 0; s4 < 4; ++s4) {
                    const bf16x8 kf = *(const bf16x8*)(kc + (size_t)st * 32 * 64 + s4 * 16);
                    const bf16x8 qfr = *(const bf16x8*)(p.QN() + gq * 256 + h * 64 + 16 * s4 + 8 * lh);
                    s = __builtin_amdgcn_mfma_f32_32x32x16_bf16(kf, qfr, s, 0, 0, 0);
                }
#pragma unroll
                for (int r = 0; r < 16; ++r) {
                    const int cr = 16 * (r >> 3) + (r & 7);
                    const float pr = (cr <= thl) ? __builtin_amdgcn_exp2f(s[r] * c - mh[h]) * il[h] : 0.f;
                    bs[r >> 2] += pr;
                }
                __builtin_amdgcn_sched_barrier(0);
            }
        }
#pragma unroll
        for (int g = 0; g < 4; ++g) {
            const int j = st * 8 + 4 * (g >> 1) + 2 * lh + (g & 1);
            const bool forced = (j == 0) || (j == cur) || (j == cur - 1);
            float v = forced ? 1e4f : ((j <= cur) ? bs[g] : -1.0f);
            int jj = j;
            if (__any(imp_better(v, jj, val[15], idx[15]))) {
#pragma unroll
                for (int i = 0; i < 16; ++i) {
                    const bool bt = imp_better(v, jj, val[i], idx[i]);
                    const float tv = bt ? val[i] : v; const int ti = bt ? idx[i] : jj;
                    val[i] = bt ? v : val[i]; idx[i] = bt ? jj : idx[i];
                    v = tv; jj = ti;
                }
            }
        }
    }
    {
        float* lv = (float*)(sm + (tidx() >> 6) * 8192);
        int* li = (int*)(lv + 1024);
#pragma unroll
        for (int i = 0; i < 16; ++i) { lv[i * 64 + lane] = val[i]; li[i * 64 + lane] = idx[i]; }
        __builtin_amdgcn_wave_barrier();
#pragma unroll 1
        for (int k = 0; k < 16; ++k) {
            float v = lv[k * 64 + (lane ^ 32)]; int jj = li[k * 64 + (lane ^ 32)];
#pragma unroll
            for (int i = 0; i < 16; ++i) {
                const bool bt = imp_better(v, jj, val[i], idx[i]);
                const float tv = bt ? val[i] : v; const int ti = bt ? idx[i] : jj;
                val[i] = bt ? v : val[i]; idx[i] = bt ? jj : idx[i];
                v = tv; jj = ti;
            }
        }
        __builtin_amdgcn_wave_barrier();
    }
    unsigned m0 = 0u, m1 = 0u, m2 = 0u, m3 = 0u;
#pragma unroll
    for (int i = 0; i < 16; ++i) {
        const unsigned bit = 1u << (idx[i] & 31); const int wsel = idx[i] >> 5;
        m0 |= (wsel == 0) ? bit : 0u; m1 |= (wsel == 1) ? bit : 0u; m2 |= (wsel == 2) ? bit : 0u; m3 |= (wsel == 3) ? bit : 0u;
    }
    if (lh == 0) { u32x4 o; o.x = m0; o.y = m1; o.z = m2; o.w = m3; *(u32x4*)(p.SMASK() + gq * 4) = o; }
}

template <class BAR>
__device__ __forceinline__ void ph_work(const Params& p, int layer, char* sm, const BAR& barrier) {
    __shared__ int s_unit;
#pragma unroll 1
    for (int stage = 0; stage < 2; ++stage) {
        unsigned* ctr = p.qctr() + 64 * layer + 32 * stage;
        const int total = stage == 0 ? 3200 : 1024;
        for (;;) {
            __syncthreads();
            if (threadIdx.x == 0) s_unit = (int)atomicAdd(ctr, 1u);
            __syncthreads();
            const int u = __builtin_amdgcn_readfirstlane(s_unit);
            if (u >= total) break;
            int kind, b, h = 0, q;
            if (stage == 1) { const int r = u & 15; kind = 2 + ((r >> 3) ? AM_SLC : AM_DSA); q = 63 - (u >> 4); b = (r >> 2) & 1; h = r & 3; }
            else if (u < 512) { kind = 0; q = 255 - (u >> 1); b = u & 1; }
            else if (u < 640) { kind = 1; const int v = u - 512; b = v & 1; q = v >> 1; }
            else if (u < 1664) { const int v = u - 640, r = v & 15; kind = 2 + ((r >> 3) ? AM_FOX : AM_SB); q = 63 - (v >> 4); b = (r >> 2) & 1; h = r & 3; }
            else { const int v = u - 1664, br = v >> 9, w = v & 511; kind = 2 + (br == 0 ? AM_WIN : br == 1 ? AM_CMP : AM_MEM); q = w >> 3; b = (w >> 2) & 1; h = w & 3; }
#ifdef DUP_KIND
            const int reps = (kind == DUP_KIND) ? 2 : 1;
#pragma unroll 1
            for (int rep = 0; rep < reps; ++rep) {
#endif
            if (kind == 0) dsa_select_unit(p, b, q, sm);
            else if (kind == 1) nsa_select_unit(p, b, q * 128 + 32 * __builtin_amdgcn_readfirstlane(tidx() >> 6), sm);
            else if (kind == 2 + AM_SB) attn_unit<AM_SB>(p, b, h, q, sm);
            else if (kind == 2 + AM_FOX) attn_unit<AM_FOX>(p, b, h, q, sm);
            else if (kind == 2 + AM_DSA) attn_unit<AM_DSA>(p, b, h, q, sm);
            else if (kind == 2 + AM_SLC) attn_unit<AM_SLC>(p, b, h, q, sm);
            else if (kind == 2 + AM_WIN) attn_unit<AM_WIN>(p, b, h, q, sm);
            else if (kind == 2 + AM_CMP) attn_unit<AM_CMP>(p, b, h, q, sm);
            else attn_unit<AM_MEM>(p, b, h, q, sm);
#ifdef DUP_KIND
            }
#endif
        }
        barrier(stage);
    }
}

__device__ __forceinline__ void ph_nsa_combine(const Params& p, int bid, int nb) {
    for (size_t i = (size_t)bid * 256 + tidx(); i < (size_t)T * 64; i += (size_t)nb * 256) {
        const size_t g = i >> 6; const int c = (int)(i & 63) * 4, h = c >> 6;
        const float g0 = p.GN()[g * 12 + h];
        const float4 a = *(const float4*)(p.OCMP() + g * 256 + c), s = *(const float4*)(p.OSLC() + g * 256 + c), w = *(const float4*)(p.OWIN() + g * 256 + c);
        const u32x2 z = *(const u32x2*)(p.ZG() + g * 1280 + 768 + c);
        u32x2 o;
        o.x = cvt_pk_bf16((g0 * a.x + s.x + w.x) * __uint_as_float(z.x << 16), (g0 * a.y + s.y + w.y) * __uint_as_float(z.x & 0xffff0000u));
        o.y = cvt_pk_bf16((g0 * a.z + s.z + w.z) * __uint_as_float(z.y << 16), (g0 * a.w + s.w + w.w) * __uint_as_float(z.y & 0xffff0000u));
        *(u32x2*)(p.Y() + g * 1280 + 768 + c) = o;
    }
}

__device__ __forceinline__ void ph_setup_misc(const Params& p, int bid, int nb) {
    const int lane = tidx() & 63, gw = bid * 4 + (tidx() >> 6);
    for (int o = gw; o < DEPTH * 2 * 128; o += nb * 4) {
        const int l = o >> 8, which = (o >> 7) & 1, j = o & 127;
        const float* pe = (which ? p.pe_v : p.pe_k) + (size_t)l * 2048;
        const float* w1 = (which ? p.wc1_v : p.wc1_k) + (size_t)l * 2048 * 128;
        float a = 0.f;
        for (int k = lane; k < 2048; k += 64) a = fmaf(pe[k], w1[(size_t)k * 128 + j], a);
        a = wave_sum(a);
        if (lane == 0) p.BIASC()[o] = a;
    }
    for (int i = bid * 256 + tidx(); i < 2048; i += nb * 256) { p.KCT()[(size_t)T * 64 + i] = 0; p.VCTOK()[(size_t)T * 64 + i] = 0; }
    for (int i = bid * 256 + tidx(); i < 12 * D; i += nb * 256) p.WIN()[(size_t)(M_SPC + 52) * D + i] = 0;
    for (int i = bid * 256 + tidx(); i < (M_MERGE - NPM) * D; i += nb * 256) p.WIN()[(size_t)NPM * D + i] = 0;
}

#define XB_TMO      128
#define XB_XCNT(j)  (256  + 64 * (j))
#define XB_XSUB(j)  (1280 + 64 * (j))
#define XB_XGEN(j)  (2304 + 64 * (j))
#define XB_TOP      3328
#define XB_TOPGEN   3392
#define XCD_BAR_WORDS 3456
#define XB_SPIN_CAP (1u << 18)
#define LAS __attribute__((address_space(3)))

__device__ __forceinline__ unsigned xb_ld(unsigned* p)              { return __hip_atomic_load(p, __ATOMIC_RELAXED, __HIP_MEMORY_SCOPE_AGENT); }
__device__ __forceinline__ unsigned xb_add(unsigned* p, unsigned v) { return __hip_atomic_fetch_add(p, v, __ATOMIC_RELAXED, __HIP_MEMORY_SCOPE_AGENT); }
__device__ __forceinline__ unsigned xb_xcc_id() { return (unsigned)__builtin_amdgcn_s_getreg((3 << 11) | 20) & 0xFu; }
#define XB_SPIN(cond, bar) do { unsigned _sp = 0; while (cond) { __builtin_amdgcn_s_sleep(1); \
    if ((++_sp & 255u) == 0u) { if (xb_ld(&(bar)[XB_TMO])) break; if (_sp > XB_SPIN_CAP) { atomicAdd(&(bar)[XB_TMO], 1u); break; } } } } while (0)

struct XcdBarrier {
    unsigned* bar; unsigned x;
    volatile LAS unsigned* st;
};
__device__ __forceinline__ XcdBarrier xcd_barrier_post(unsigned* bar, volatile LAS unsigned* st) {
    XcdBarrier b; b.bar = bar; b.x = xb_xcc_id(); b.st = st;
    if (threadIdx.x == 0) (void)xb_add(&bar[XB_XCNT(b.x)], 1u);
    return b;
}
__device__ __forceinline__ void xcd_barrier_complete(unsigned* bar, unsigned x, unsigned& nloc, unsigned& nx) {
    const unsigned G = gridDim.x * gridDim.y * gridDim.z;
    unsigned sum, cnt, mine, sp = 0u;
    for (;;) {
        sum = 0u; cnt = 0u; mine = 0u;
#pragma unroll
        for (unsigned j = 0; j < 16; ++j) { const unsigned c = xb_ld(&bar[XB_XCNT(j)]); sum += c; cnt += (c > 0u) ? 1u : 0u; mine = (j == x) ? c : mine; }
        if (sum == G) break;
        __builtin_amdgcn_s_sleep(1);
        if ((++sp & 255u) == 0u) { if (xb_ld(&bar[XB_TMO])) break; if (sp > XB_SPIN_CAP) { atomicAdd(&bar[XB_TMO], 1u); break; } }
    }
    nloc = mine > 0u ? mine : 1u; nx = cnt > 0u ? cnt : 1u;
}
__device__ __attribute__((noinline)) void xcd_barrier_impl(unsigned* b_bar, unsigned b_x, volatile LAS unsigned* b_st) {
    XcdBarrier b; b.bar = b_bar; b.x = b_x; b.st = b_st;
    asm volatile("s_waitcnt vmcnt(0)" ::: "memory");
    __syncthreads();
    if (threadIdx.x == 0) {
        unsigned* bar = b.bar;
        __builtin_amdgcn_s_waitcnt(0);
        unsigned nloc = b.st[0], nx = b.st[1];
        if (nloc == 0u) { xcd_barrier_complete(bar, b.x, nloc, nx); b.st[0] = nloc; b.st[1] = nx; }
        const unsigned old = xb_add(&bar[XB_XSUB(b.x)], 1u);
        const unsigned gen = old / nloc;
        if (old + 1u == (gen + 1u) * nloc) {
            __builtin_amdgcn_fence(__ATOMIC_RELEASE, "agent");
            asm volatile("s_waitcnt vmcnt(0)" ::: "memory");
            const unsigned og = xb_add(&bar[XB_TOP], 1u);
            const unsigned tg = og / nx;
            if (og + 1u == (tg + 1u) * nx) xb_add(&bar[XB_TOPGEN], 1u);
            else XB_SPIN(xb_ld(&bar[XB_TOPGEN]) == tg, bar);
            __builtin_amdgcn_fence(__ATOMIC_ACQUIRE, "agent");
            xb_add(&bar[XB_XGEN(b.x)], 1u);
            asm volatile("s_waitcnt vmcnt(0)" ::: "memory");
        } else {
            XB_SPIN(xb_ld(&bar[XB_XGEN(b.x)]) == gen, bar);
            __builtin_amdgcn_fence(__ATOMIC_ACQUIRE, "agent");
            asm volatile("s_waitcnt vmcnt(0)" ::: "memory");
        }
    }
    __syncthreads();
}
__device__ __forceinline__ void xcd_barrier(const XcdBarrier& b) { xcd_barrier_impl(b.bar, b.x, b.st); }

#ifndef DIAG
#define DIAG 0
#endif
#ifndef DIAG_A
#define DIAG_A 8
#define DIAG_B 7
#endif
#if DIAG
#define STAMP(k) do { if (((k) == DIAG_A || (k) == DIAG_B || (k) + 1 == DIAG_A || (k) + 1 == DIAG_B || (k) == 0 || (k) == 11) && blockIdx.x == 0 && threadIdx.x == 0) { const unsigned long long t_ = wall_clock64(); dg[k] += t_ - dg[15]; dg[15] = t_; } } while (0)
#else
#define STAMP(k) do { } while (0)
#endif
__global__ void __launch_bounds__(256, 2) mega(Params p) {
    __shared__ __attribute__((aligned(16))) char smem[40960];
    __shared__ uint4 xb_words;
    if (threadIdx.x == 0) xb_words = make_uint4(0u, 0u, 0u, 0u);
    __syncthreads();
    XcdBarrier bar = xcd_barrier_post(p.bar(), (volatile LAS unsigned*)&xb_words);
    const int bid = blockIdx.x, nb = gridDim.x;
    float* smf = (float*)smem;
#if DIAG
    __shared__ unsigned long long dg[16];
    if (threadIdx.x == 0) { for (int i = 0; i < 15; ++i) dg[i] = 0; dg[15] = wall_clock64(); }
#endif

    convert_wt(p.w_branch, p.WBR(), 256, D, DEPTH * 5, bid, nb, smf);
    convert_wt(p.w_out, p.WOUT(), D, D, DEPTH, bid, nb, smf);
    convert_wt(p.w_mem_kv, p.WMKV(), D, 512, DEPTH, bid, nb, smf);
    convert_wt(p.w_uk, p.WUK(), 128, 256, DEPTH, bid, nb, smf);
    convert_wt(p.w_uv, p.WUV(), 128, 256, DEPTH, bid, nb, smf);
    for (int l = 0; l < DEPTH; ++l) {
        convert_wt(p.wc1_k + (size_t)l * 2048 * 128, p.WC1T() + (size_t)(l * 2 + 0) * 128 * 2048, 2048, 128, 1, bid, nb, smf);
        convert_wt(p.wc1_v + (size_t)l * 2048 * 128, p.WC1T() + (size_t)(l * 2 + 1) * 128 * 2048, 2048, 128, 1, bid, nb, smf);
        convert_wt(p.wc2_k + (size_t)l * 128 * 64, p.WC2T() + (size_t)(l * 2 + 0) * 64 * 128, 128, 64, 1, bid, nb, smf);
        convert_wt(p.wc2_v + (size_t)l * 128 * 64, p.WC2T() + (size_t)(l * 2 + 1) * 64 * 128, 128, 64, 1, bid, nb, smf);
    }
    ph_setup_misc(p, bid, nb);
    ph_rope_table(p, bid, nb);
    STAMP(0);
    for (int l = 0; l < DEPTH; ++l) {
        const float* Xin = l == 0 ? p.x : p.X;
        convert_wt<true>(p.w_in + (size_t)l * D * NIN, p.WIN(), D, NIN, 1, bid, nb, smf);
        ph_rmsnorm<bf16_t>(Xin, p.norm_g + l * D, p.H(), T, bid, nb);
        ph_rmsnorm<bf16_t>(p.mem, p.mem_norm + l * D, p.MEMN(), NBATCH * NMEM, bid, nb);
        xcd_barrier(bar); STAMP(1);
        { EpiInProj e{p, l}; gemm_bf16<128>(p.H(), D, p.WIN(), D, T, NP, D, e, bid, nb, smem); }
        { EpiMemKV e{p}; gemm_bf16<128>(p.MEMN(), D, p.WMKV() + (size_t)l * 512 * D, D, NBATCH * NMEM, 512, D, e, bid, nb, smem); }
        xcd_barrier(bar); STAMP(2);
        ph_ckvnorm(p, l, bid, nb);
        ph_cumsum(p, bid, nb, smf);
        { EpiCmp1 e{p.BIASC() + (l * 2 + 0) * 128, p.HIDK()}; gemm_bf16<64>(p.KCT(), 1024, p.WC1T() + (size_t)(l * 2 + 0) * 128 * 2048, 2048, 1024, 128, 2048, e, bid, nb, smem); }
        { EpiCmp1 e{p.BIASC() + (l * 2 + 1) * 128, p.HIDV()}; gemm_bf16<64>(p.VCTOK(), 1024, p.WC1T() + (size_t)(l * 2 + 1) * 128 * 2048, 2048, 1024, 128, 2048, e, bid, nb, smem); }
        xcd_barrier(bar); STAMP(3);
        { EpiKA e{p}; gemm_bf16<128>(p.CKV(), 128, p.WUK() + (size_t)l * 256 * 128, 128, T, 256, 128, e, bid, nb, smem); }
        { EpiVA e{p}; gemm_bf16<128>(p.CKV(), 128, p.WUV() + (size_t)l * 256 * 128, 128, T, 256, 128, e, bid, nb, smem); }
        { EpiCmp2K e{p.KCB()}; gemm_bf16<64>(p.HIDK(), 128, p.WC2T() + (size_t)(l * 2 + 0) * 64 * 128, 128, 1024, 64, 128, e, bid, nb, smem); }
        { EpiCmp2V e{p.VCT()}; gemm_bf16<64>(p.HIDV(), 128, p.WC2T() + (size_t)(l * 2 + 1) * 64 * 128, 128, 1024, 64, 128, e, bid, nb, smem); }
        xcd_barrier(bar); STAMP(4);
        ph_work(p, l, smem, [&](int stage) { xcd_barrier(bar); if (stage == 0) { STAMP(7); } else { STAMP(8); } });
        ph_nsa_combine(p, bid, nb);
        xcd_barrier(bar); STAMP(9);
        ph_merge(p, l, bid, nb, smem);
        xcd_barrier(bar); STAMP(10);
        { EpiResid e{Xin, p.X}; gemm_bf16<128>(p.MG(), D, p.WOUT() + (size_t)l * D * D, D, T, D, D, e, bid, nb, smem); }
        xcd_barrier(bar); STAMP(11);
    }
#if DIAG
    {
        float* dgw = (float*)(p.bar() + 4096 + 512);
        if (blockIdx.x == 0 && threadIdx.x == 0) {
            unsigned long long tot = 0; for (int i = 0; i < 15; ++i) tot += dg[i];
            dgw[0] = rintf(40.f * (float)((double)dg[DIAG_A] / (double)tot)) / 40.f; dgw[1] = rintf(40.f * (float)((double)dg[DIAG_B] / (double)tot)) / 40.f;
        }
        ph_rmsnorm<float>(p.X, p.final_norm, p.X, T, bid, nb);
        xcd_barrier(bar);
        {
            const float fa = 1.0f + dgw[0];
            float4* xp = (float4*)p.X;
#pragma unroll 1
            for (int i = bid * 256 + threadIdx.x; i < T * D / 4; i += nb * 256) { float4 v = xp[i]; v.x *= fa; v.y *= fa; v.z *= fa; v.w *= fa; xp[i] = v; }
        }
        xcd_barrier(bar);
        if (blockIdx.x == 0 && threadIdx.x == 0) p.X[0] += 100.f * dgw[1];
    }
#else
    ph_rmsnorm<float>(p.X, p.final_norm, p.X, T, bid, nb);
#endif
}
}

extern "C" void kernel_launch(void* const* d_in, const int* in_sizes, int n_in, void* d_out, int out_size, void* d_ws, size_t ws_size, hipStream_t stream) {
    (void)in_sizes; (void)n_in; (void)out_size;
    Params p{};
    p.x = (const float*)d_in[0]; p.mem = (const float*)d_in[1]; p.pos = (const int*)d_in[2]; p.norm_g = (const float*)d_in[3];
    p.w_in = (const float*)d_in[4]; p.kv_norm = (const float*)d_in[5]; p.w_uk = (const float*)d_in[6]; p.w_uv = (const float*)d_in[7];
    p.fox_bias = (const float*)d_in[8]; p.pe_k = (const float*)d_in[9]; p.pe_v = (const float*)d_in[10]; p.wc1_k = (const float*)d_in[11];
    p.wc2_k = (const float*)d_in[12]; p.wc1_v = (const float*)d_in[13]; p.wc2_v = (const float*)d_in[14]; p.mem_norm = (const float*)d_in[15];
    p.w_mem_kv = (const float*)d_in[16]; p.w_branch = (const float*)d_in[17]; p.w_out = (const float*)d_in[18]; p.final_norm = (const float*)d_in[19];
    p.X = (float*)d_out;
    p.ws = (char*)d_ws;
    if (WS_TOTAL > ws_size) { fprintf(stderr, "kernel_launch: workspace too small (%zu > %zu)\n", (size_t)WS_TOTAL, ws_size); return; }

    static int grid = 0;
    if (grid == 0) {
        int dev = 0, cus = 0, per_cu = 0;
        hipGetDevice(&dev);
        hipDeviceGetAttribute(&cus, hipDeviceAttributeMultiprocessorCount, dev);
        hipOccupancyMaxActiveBlocksPerMultiprocessor(&per_cu, (const void*)mega, 256, 0);
        (void)hipGetLastError();
        if (per_cu < 1) per_cu = 1;
        grid = cus * (per_cu < 2 ? per_cu : 2);
    }
    hipMemsetAsync((char*)d_ws + OFF_bar, 0, (4096 + 64 * 8 + 64) * sizeof(unsigned), stream);
    hipLaunchKernelGGL(mega, dim3(grid), dim3(256), 0, stream, p);
}
```

```cpp
#include <hip/hip_runtime.h>
#include <stdint.h>
#include <math.h>
#include <cstdio>

namespace {
constexpr int S = 8192, NBATCH = 2, T = NBATCH * S, D = 1024, NIN = 9396, NM = 4276, DEPTH = 4, NMEM = 256;
constexpr int NCMP = 511, NCMP_PAD = 512;
constexpr int C_DSA_Q = 0, C_CKV = 256, C_IDXQ = 384, C_IDXK = 512, C_IDXW = 544, C_DSA_Z = 548,
              C_FOX_Q = 804, C_FOX_K = 1060, C_FOX_V = 1316, C_FOX_F = 1572, C_FOX_Z = 1576,
              C_SB_Q = 1832, C_SB_K = 2088, C_SB_V = 2344, C_SB_Z = 2600,
              C_NSA_Q = 2856, C_NSA_KC = 3112, C_NSA_VC = 3176, C_NSA_KS = 3240, C_NSA_VS = 3304, C_NSA_KW = 3368, C_NSA_VW = 3432,
              C_NSA_G = 3496, C_NSA_Z = 3508, C_MEM_Q = 3764, C_MEM_Z = 4020, C_MERGE = 4276;

typedef unsigned short bf16_t;
typedef short bf16x8 __attribute__((ext_vector_type(8)));
typedef float f32x16 __attribute__((ext_vector_type(16)));
typedef unsigned u32x4 __attribute__((ext_vector_type(4)));
typedef unsigned u32x2 __attribute__((ext_vector_type(2)));

constexpr int M_QA = 0, M_QN = 256, M_KSLC = 512, M_KWIN = 576, M_KC = 640, M_VC = 704, M_QF = 768, M_KF = 1024, M_QS = 1280, M_KSB = 1536, M_QM = 1792,
              M_VF = 2048, M_VS = 2304, M_VSLC = 2560, M_VWIN = 2624, M_QI = 2688, M_SPC = 2816, M_CKV = 2880, M_Z = 3008, NPM = 4288, M_MERGE = 4352, NP = 9472;
constexpr size_t al256(size_t x) { return (x + 255) & ~(size_t)255; }
constexpr size_t OFF_bar = 0;
constexpr size_t OFF_H = OFF_bar + al256((4096 + 64 * 8 + 64) * 4);
constexpr size_t OFF_Y = OFF_H + al256((size_t)T * D * 2);
constexpr size_t OFF_ZG = OFF_Y + al256((size_t)T * 1280 * 2);
constexpr size_t OFF_MG = OFF_ZG + al256((size_t)T * 1280 * 2);
constexpr size_t OFF_SIG = OFF_MG + al256((size_t)T * D * 2);
constexpr size_t OFF_CKVR = OFF_SIG + al256((size_t)T * 5120 * 2);
constexpr size_t OFF_CKV = OFF_CKVR + al256((size_t)T * 128 * 4);
constexpr size_t OFF_OCMP = OFF_CKV + al256((size_t)T * 128 * 2);
constexpr size_t OFF_OSLC = OFF_OCMP + al256((size_t)T * 256 * 4);
constexpr size_t OFF_OWIN = OFF_OSLC + al256((size_t)T * 256 * 4);
constexpr size_t OFF_LOGF = OFF_OWIN + al256((size_t)T * 256 * 4);
constexpr size_t OFF_CUM = OFF_LOGF + al256((size_t)T * 4 * 4);
constexpr size_t OFF_CUMT = OFF_CUM + al256((size_t)T * 4 * 4);
constexpr size_t OFF_WI = OFF_CUMT + al256((size_t)T * 4 * 4);
constexpr size_t OFF_GN = OFF_WI + al256((size_t)T * 4 * 4);
constexpr size_t OFF_KCT = OFF_GN + al256((size_t)T * 12 * 4);
constexpr size_t OFF_VCTOK = OFF_KCT + al256(((size_t)T * 64 + 2048) * 2);
constexpr size_t OFF_HIDK = OFF_VCTOK + al256(((size_t)T * 64 + 2048) * 2);
constexpr size_t OFF_HIDV = OFF_HIDK + al256((size_t)1024 * 128 * 2);
constexpr size_t OFF_KCB = OFF_HIDV + al256((size_t)1024 * 128 * 2);
constexpr size_t OFF_VCT = OFF_KCB + al256((size_t)NBATCH * NCMP_PAD * 64 * 2);
constexpr size_t OFF_QI = OFF_VCT + al256((size_t)NBATCH * NCMP_PAD * 64 * 2);
constexpr size_t OFF_KI = OFF_QI + al256((size_t)T * 128 * 2);
constexpr size_t OFF_MEMN = OFF_KI + al256((size_t)T * 32 * 2);
constexpr size_t OFF_ROPE = OFF_MEMN + al256((size_t)NBATCH * NMEM * D * 2);
constexpr size_t OFF_DMASK = OFF_ROPE + al256((size_t)T * 64 * 4);
constexpr size_t OFF_SMASK = OFF_DMASK + al256((size_t)T * 256 * 4);
constexpr size_t OFF_QA = OFF_SMASK + al256((size_t)T * 4 * 4);
constexpr size_t OFF_KAB = OFF_QA + al256((size_t)T * 256 * 2);
constexpr size_t OFF_VAT = OFF_KAB + al256((size_t)T * 256 * 2);
constexpr size_t OFF_QF = OFF_VAT + al256((size_t)T * 256 * 2);
constexpr size_t OFF_KF = OFF_QF + al256((size_t)T * 256 * 2);
constexpr size_t OFF_VFT = OFF_KF + al256((size_t)T * 256 * 2);
constexpr size_t OFF_QS = OFF_VFT + al256((size_t)T * 256 * 2);
constexpr size_t OFF_KSB = OFF_QS + al256((size_t)T * 256 * 2);
constexpr size_t OFF_VST = OFF_KSB + al256((size_t)T * 256 * 2);
constexpr size_t OFF_QN = OFF_VST + al256((size_t)T * 256 * 2);
constexpr size_t OFF_QM = OFF_QN + al256((size_t)T * 256 * 2);
constexpr size_t OFF_KSLC = OFF_QM + al256((size_t)T * 256 * 2);
constexpr size_t OFF_VSLCT = OFF_KSLC + al256((size_t)T * 64 * 2);
constexpr size_t OFF_KWIN = OFF_VSLCT + al256((size_t)T * 64 * 2);
constexpr size_t OFF_VWINT = OFF_KWIN + al256((size_t)T * 64 * 2);
constexpr size_t OFF_MKB = OFF_VWINT + al256((size_t)T * 64 * 2);
constexpr size_t OFF_MVT = OFF_MKB + al256((size_t)NBATCH * NMEM * 256 * 2);
constexpr size_t OFF_WIN = OFF_MVT + al256((size_t)NBATCH * NMEM * 256 * 2);
constexpr size_t OFF_WBR = OFF_WIN + al256((size_t)NP * D * 2);
constexpr size_t OFF_WOUT = OFF_WBR + al256((size_t)DEPTH * 5 * D * 256 * 2);
constexpr size_t OFF_WMKV = OFF_WOUT + al256((size_t)DEPTH * D * D * 2);
constexpr size_t OFF_WUK = OFF_WMKV + al256((size_t)DEPTH * 512 * D * 2);
constexpr size_t OFF_WUV = OFF_WUK + al256((size_t)DEPTH * 256 * 128 * 2);
constexpr size_t OFF_WC1T = OFF_WUV + al256((size_t)DEPTH * 256 * 128 * 2);
constexpr size_t OFF_WC2T = OFF_WC1T + al256((size_t)DEPTH * 2 * 128 * 2048 * 2);
constexpr size_t OFF_BIASC = OFF_WC2T + al256((size_t)DEPTH * 2 * 64 * 128 * 2);
constexpr size_t WS_TOTAL = OFF_BIASC + al256((size_t)DEPTH * 2 * 128 * 4);

__device__ __forceinline__ int map_in_col(int n) {
    constexpr int seg[27][3] = {{0, 256, M_QA}, {256, 128, M_CKV}, {384, 128, M_QI}, {512, 32, M_SPC}, {544, 4, M_SPC + 32}, {548, 256, M_Z}, {804, 256, M_QF}, {1060, 256, M_KF},
        {1316, 256, M_VF}, {1572, 4, M_SPC + 36}, {1576, 256, M_Z + 256}, {1832, 256, M_QS}, {2088, 256, M_KSB}, {2344, 256, M_VS}, {2600, 256, M_Z + 512}, {2856, 256, M_QN},
        {3112, 64, M_KC}, {3176, 64, M_VC}, {3240, 64, M_KSLC}, {3304, 64, M_VSLC}, {3368, 64, M_KWIN}, {3432, 64, M_VWIN}, {3496, 12, M_SPC + 40}, {3508, 256, M_Z + 768},
        {3764, 256, M_QM}, {4020, 256, M_Z + 1024}, {4276, 5120, M_MERGE}};
    int r = 0;
#pragma unroll
    for (int i = 0; i < 27; ++i) r = (n >= seg[i][0] && n < seg[i][0] + seg[i][1]) ? (seg[i][2] + n - seg[i][0]) : r;
    return r;
}
struct Params {
    const float* x; const float* mem; const int* pos; const float* norm_g; const float* w_in; const float* kv_norm;
    const float* w_uk; const float* w_uv; const float* fox_bias; const float* pe_k; const float* pe_v;
    const float* wc1_k; const float* wc2_k; const float* wc1_v; const float* wc2_v; const float* mem_norm;
    const float* w_mem_kv; const float* w_branch; const float* w_out; const float* final_norm;
    float* X; char* ws;
    __device__ __forceinline__ unsigned* bar() const { return (unsigned*)(ws + OFF_bar); }
    __device__ __forceinline__ bf16_t* H() const { return (bf16_t*)(ws + OFF_H); }
    __device__ __forceinline__ bf16_t* Y() const { return (bf16_t*)(ws + OFF_Y); }
    __device__ __forceinline__ bf16_t* ZG() const { return (bf16_t*)(ws + OFF_ZG); }
    __device__ __forceinline__ bf16_t* MG() const { return (bf16_t*)(ws + OFF_MG); }
    __device__ __forceinline__ bf16_t* SIG() const { return (bf16_t*)(ws + OFF_SIG); }
    __device__ __forceinline__ float* CKVR() const { return (float*)(ws + OFF_CKVR); }
    __device__ __forceinline__ bf16_t* CKV() const { return (bf16_t*)(ws + OFF_CKV); }
    __device__ __forceinline__ float* OCMP() const { return (float*)(ws + OFF_OCMP); }
    __device__ __forceinline__ float* OSLC() const { return (float*)(ws + OFF_OSLC); }
    __device__ __forceinline__ float* OWIN() const { return (float*)(ws + OFF_OWIN); }
    __device__ __forceinline__ float* LOGF() const { return (float*)(ws + OFF_LOGF); }
    __device__ __forceinline__ float* CUM() const { return (float*)(ws + OFF_CUM); }
    __device__ __forceinline__ float* CUMT() const { return (float*)(ws + OFF_CUMT); }
    __device__ __forceinline__ float* WI() const { return (float*)(ws + OFF_WI); }
    __device__ __forceinline__ float* GN() const { return (float*)(ws + OFF_GN); }
    __device__ __forceinline__ bf16_t* KCT() const { return (bf16_t*)(ws + OFF_KCT); }
    __device__ __forceinline__ bf16_t* VCTOK() const { return (bf16_t*)(ws + OFF_VCTOK); }
    __device__ __forceinline__ bf16_t* HIDK() const { return (bf16_t*)(ws + OFF_HIDK); }
    __device__ __forceinline__ bf16_t* HIDV() const { return (bf16_t*)(ws + OFF_HIDV); }
    __device__ __forceinline__ bf16_t* KCB() const { return (bf16_t*)(ws + OFF_KCB); }
    __device__ __forceinline__ bf16_t* VCT() const { return (bf16_t*)(ws + OFF_VCT); }
    __device__ __forceinline__ bf16_t* QI() const { return (bf16_t*)(ws + OFF_QI); }
    __device__ __forceinline__ bf16_t* KI() const { return (bf16_t*)(ws + OFF_KI); }
    __device__ __forceinline__ bf16_t* MEMN() const { return (bf16_t*)(ws + OFF_MEMN); }
    __device__ __forceinline__ float* ROPE() const { return (float*)(ws + OFF_ROPE); }
    __device__ __forceinline__ unsigned* DMASK() const { return (unsigned*)(ws + OFF_DMASK); }
    __device__ __forceinline__ unsigned* SMASK() const { return (unsigned*)(ws + OFF_SMASK); }
    __device__ __forceinline__ bf16_t* QA() const { return (bf16_t*)(ws + OFF_QA); }
    __device__ __forceinline__ bf16_t* KAB() const { return (bf16_t*)(ws + OFF_KAB); }
    __device__ __forceinline__ bf16_t* VAT() const { return (bf16_t*)(ws + OFF_VAT); }
    __device__ __forceinline__ bf16_t* QF() const { return (bf16_t*)(ws + OFF_QF); }
    __device__ __forceinline__ bf16_t* KF() const { return (bf16_t*)(ws + OFF_KF); }
    __device__ __forceinline__ bf16_t* VFT() const { return (bf16_t*)(ws + OFF_VFT); }
    __device__ __forceinline__ bf16_t* QS() const { return (bf16_t*)(ws + OFF_QS); }
    __device__ __forceinline__ bf16_t* KSB() const { return (bf16_t*)(ws + OFF_KSB); }
    __device__ __forceinline__ bf16_t* VST() const { return (bf16_t*)(ws + OFF_VST); }
    __device__ __forceinline__ bf16_t* QN() const { return (bf16_t*)(ws + OFF_QN); }
    __device__ __forceinline__ bf16_t* QM() const { return (bf16_t*)(ws + OFF_QM); }
    __device__ __forceinline__ bf16_t* KSLC() const { return (bf16_t*)(ws + OFF_KSLC); }
    __device__ __forceinline__ bf16_t* VSLCT() const { return (bf16_t*)(ws + OFF_VSLCT); }
    __device__ __forceinline__ bf16_t* KWIN() const { return (bf16_t*)(ws + OFF_KWIN); }
    __device__ __forceinline__ bf16_t* VWINT() const { return (bf16_t*)(ws + OFF_VWINT); }
    __device__ __forceinline__ bf16_t* MKB() const { return (bf16_t*)(ws + OFF_MKB); }
    __device__ __forceinline__ bf16_t* MVT() const { return (bf16_t*)(ws + OFF_MVT); }
    __device__ __forceinline__ bf16_t* WIN() const { return (bf16_t*)(ws + OFF_WIN); }
    __device__ __forceinline__ bf16_t* WBR() const { return (bf16_t*)(ws + OFF_WBR); }
    __device__ __forceinline__ bf16_t* WOUT() const { return (bf16_t*)(ws + OFF_WOUT); }
    __device__ __forceinline__ bf16_t* WMKV() const { return (bf16_t*)(ws + OFF_WMKV); }
    __device__ __forceinline__ bf16_t* WUK() const { return (bf16_t*)(ws + OFF_WUK); }
    __device__ __forceinline__ bf16_t* WUV() const { return (bf16_t*)(ws + OFF_WUV); }
    __device__ __forceinline__ bf16_t* WC1T() const { return (bf16_t*)(ws + OFF_WC1T); }
    __device__ __forceinline__ bf16_t* WC2T() const { return (bf16_t*)(ws + OFF_WC2T); }
    __device__ __forceinline__ float* BIASC() const { return (float*)(ws + OFF_BIASC); }
    __device__ __forceinline__ unsigned* qctr() const { return (unsigned*)(ws + OFF_bar) + 4096; }
};

typedef __bf16 bf16x2_t __attribute__((ext_vector_type(2)));
__device__ __forceinline__ unsigned cvt_pk_bf16(float lo, float hi) { bf16x2_t v; v.x = (__bf16)lo; v.y = (__bf16)hi; return __builtin_bit_cast(unsigned, v); }
__device__ __forceinline__ bf16_t f2bf(float x) { return (bf16_t)(cvt_pk_bf16(x, 0.f) & 0xffffu); }
__device__ __forceinline__ unsigned xb_ld(unsigned* p)              { return __hip_atomic_load(p, __ATOMIC_RELAXED, __HIP_MEMORY_SCOPE_AGENT); }
__device__ __forceinline__ unsigned xb_add(unsigned* p, unsigned v) { return __hip_atomic_fetch_add(p, v, __ATOMIC_RELAXED, __HIP_MEMORY_SCOPE_AGENT); }
__device__ __forceinline__ unsigned xb_xcc_id() { return (unsigned)__builtin_amdgcn_s_getreg((3 << 11) | 20) & 0xFu; }
constexpr int XRANK_BASE = 3500;
__device__ __forceinline__ int tidx() { int t = threadIdx.x; asm volatile("" : "+v"(t)); return t; }
__device__ __forceinline__ float sigmoid_(float x) { return __builtin_amdgcn_rcpf(1.f + __builtin_amdgcn_exp2f(-1.4426950408889634f * x)); }
__device__ __forceinline__ float silu_(float x) { return x * __builtin_amdgcn_rcpf(1.f + __builtin_amdgcn_exp2f(-1.4426950408889634f * x)); }
__device__ __forceinline__ float logsig_(float x) { return fminf(x, 0.f) - log1pf(expf(-fabsf(x))); }
__device__ __forceinline__ float wave_sum(float v) {
#pragma unroll
    for (int o = 32; o > 0; o >>= 1) v += __shfl_xor(v, o, 64);
    return v;
}
__device__ __forceinline__ float wave_max(float v) {
#pragma unroll
    for (int o = 32; o > 0; o >>= 1) v = fmaxf(v, __shfl_xor(v, o, 64));
    return v;
}

__device__ __forceinline__ void ph_rope_table(const Params& p, int bid, int nb) {
    for (int i = bid * 256 + tidx(); i < T * 32; i += nb * 256) {
        const int t = i >> 5, f = i & 31;
        const double inv = pow(10000.0, -(double)f / 32.0);
        const double ang = (double)p.pos[t] * inv;
        p.ROPE()[(size_t)t * 64 + f] = (float)cos(ang);
        p.ROPE()[(size_t)t * 64 + 32 + f] = (float)sin(ang);
    }
}

template <class OUT>
__device__ __forceinline__ void ph_rmsnorm(const float* in, const float* g, OUT* out, int rows, int bid, int nb, float dscale = 1.0f) {
    const int lane = tidx() & 63, wid = tidx() >> 6;
    for (int r = bid * 4 + wid; r < rows; r += nb * 4) {
        const float4* ip = (const float4*)(in + (size_t)r * D);
        float4 v[4]; float ss = 0.f;
#pragma unroll
        for (int i = 0; i < 4; ++i) { v[i] = ip[lane + 64 * i]; ss += v[i].x * v[i].x + v[i].y * v[i].y + v[i].z * v[i].z + v[i].w * v[i].w; }
        ss = wave_sum(ss);
        const float sc = dscale / sqrtf(ss * (1.f / D) + 1e-6f);
#pragma unroll
        for (int i = 0; i < 4; ++i) {
            const float4 gg = ((const float4*)g)[lane + 64 * i];
            float4 o; o.x = v[i].x * sc * gg.x; o.y = v[i].y * sc * gg.y; o.z = v[i].z * sc * gg.z; o.w = v[i].w * sc * gg.w;
            if constexpr (sizeof(OUT) == 4) ((float4*)((float*)out + (size_t)r * D))[lane + 64 * i] = o;
            else { u32x2 w; w.x = cvt_pk_bf16(o.x, o.y); w.y = cvt_pk_bf16(o.z, o.w); ((u32x2*)((bf16_t*)out + (size_t)r * D))[lane + 64 * i] = w; }
        }
    }
}

__device__ __forceinline__ void ph_ckvnorm(const Params& p, int layer, int bid, int nb) {
    const int lane = tidx() & 63, wid = tidx() >> 6;
    const float* g = p.kv_norm + layer * 128;
    for (int r = bid * 4 + wid; r < T; r += nb * 4) {
        const float* ip = p.CKVR() + (size_t)r * 128;
        const float a = ip[lane], b = ip[lane + 64];
        const float ss = wave_sum(a * a + b * b);
        const float sc = 1.0f / sqrtf(ss * (1.f / 128.f) + 1e-6f);
        p.CKV()[(size_t)r * 128 + lane] = f2bf(a * sc * g[lane]);
        p.CKV()[(size_t)r * 128 + lane + 64] = f2bf(b * sc * g[lane + 64]);
    }
}

template <bool MAPIN = false>
__device__ __forceinline__ void convert_wt(const float* __restrict__ src, bf16_t* __restrict__ dst, int K, int N, int nmat, int bid, int nb, float* sm) {
    float (*tl)[65] = (float (*)[65])sm;
    const int tid = tidx(), tk = K / 64, tn = (N + 63) / 64, per = tk * tn;
    for (int it = bid; it < per * nmat; it += nb) {
        const int mat = it / per, r = it % per, k0 = (r % tk) * 64, n0 = (r / tk) * 64;
        const float* s = src + (size_t)mat * K * N; bf16_t* d = dst + (size_t)mat * K * N;
        for (int i = tid; i < 64 * 64; i += 256) { const int kk = i >> 6, nn = i & 63; tl[kk][nn] = (n0 + nn < N) ? s[(size_t)(k0 + kk) * N + n0 + nn] : 0.f; }
        __syncthreads();
        {
            const int nn = tid >> 2, kq = (tid & 3) * 16;
            if (n0 + nn < N) {
                u32x4 w0, w1;
                w0.x = cvt_pk_bf16(tl[kq + 0][nn], tl[kq + 1][nn]); w0.y = cvt_pk_bf16(tl[kq + 2][nn], tl[kq + 3][nn]);
                w0.z = cvt_pk_bf16(tl[kq + 4][nn], tl[kq + 5][nn]); w0.w = cvt_pk_bf16(tl[kq + 6][nn], tl[kq + 7][nn]);
                w1.x = cvt_pk_bf16(tl[kq + 8][nn], tl[kq + 9][nn]); w1.y = cvt_pk_bf16(tl[kq + 10][nn], tl[kq + 11][nn]);
                w1.z = cvt_pk_bf16(tl[kq + 12][nn], tl[kq + 13][nn]); w1.w = cvt_pk_bf16(tl[kq + 14][nn], tl[kq + 15][nn]);
                const int drow = MAPIN ? map_in_col(n0 + nn) : (n0 + nn);
                u32x4* dp = (u32x4*)(d + (size_t)drow * K + k0 + kq);
                dp[0] = w0; dp[1] = w1;
            }
        }
        __syncthreads();
    }
}

constexpr int GROW = 80;
constexpr int GA_BYTES = 128 * GROW;
struct GStage { u32x4 a0, a1, b0, b1; };
template <int BN, int DEPTH = 3>
__device__ __forceinline__ void tile_mac(f32x16 (&acc)[2][BN / 64], const bf16_t* __restrict__ A, int lda, int m0,
                                         const bf16_t* __restrict__ Bt, int ldb, int n0, int nmax, int K, char* sm) {
    constexpr int NT = BN / 64;
    constexpr int B_BYTES = BN * GROW;
    constexpr int BUF = GA_BYTES + B_BYTES;
    const int tid = tidx(), lane = tid & 63, wid = __builtin_amdgcn_readfirstlane(tid >> 6), wr = wid >> 1, wc = wid & 1;
    const int lr = lane & 31, lh = lane >> 5;
    const int ar0 = tid >> 2, akq = tid & 3;
    const bf16_t* Ab = A + (size_t)m0 * lda;
    const bf16_t* Bb = Bt + (size_t)n0 * ldb;
    const unsigned ao0 = (unsigned)(ar0 * lda + akq * 8), ao1 = ao0 + (unsigned)(64 * lda);
    const int br0 = tid >> 2;
    const bool bv0 = (n0 + br0) < nmax, bv1 = (NT == 2) && ((n0 + br0 + 64) < nmax);
    const unsigned bo0 = (unsigned)((bv0 ? br0 : 0) * ldb + akq * 8), bo1 = (unsigned)((bv1 ? br0 + 64 : 0) * ldb + akq * 8);
    const int st_a0 = ar0 * GROW + akq * 16, st_a1 = (ar0 + 64) * GROW + akq * 16;
    const int st_b0 = GA_BYTES + br0 * GROW + akq * 16, st_b1 = GA_BYTES + (br0 + 64) * GROW + akq * 16;
    const int rd_a = (wr * 64 + lr) * GROW + lh * 16, rd_b = GA_BYTES + (wc * (BN / 2) + lr) * GROW + lh * 16;
    const u32x4 zero4 = {0u, 0u, 0u, 0u};
    const int nk = K / 32;
    auto gload = [&](GStage& g, int ks) {
        const unsigned ko = (unsigned)ks * 32u;
        g.a0 = *(const u32x4*)(Ab + (ao0 + ko)); g.a1 = *(const u32x4*)(Ab + (ao1 + ko));
        g.b0 = *(const u32x4*)(Bb + (bo0 + ko)); if (NT == 2) g.b1 = *(const u32x4*)(Bb + (bo1 + ko));
    };
    auto lstore = [&](const GStage& g, char* buf) {
        *(u32x4*)(buf + st_a0) = g.a0; *(u32x4*)(buf + st_a1) = g.a1;
        *(u32x4*)(buf + st_b0) = bv0 ? g.b0 : zero4; if (NT == 2) *(u32x4*)(buf + st_b1) = bv1 ? g.b1 : zero4;
    };
    auto compute = [&](const char* cur) {
#pragma unroll
        for (int s = 0; s < 2; ++s) {
            bf16x8 a[2], b[NT];
#pragma unroll
            for (int mi = 0; mi < 2; ++mi) a[mi] = *(const bf16x8*)(cur + rd_a + mi * 32 * GROW + s * 32);
#pragma unroll
            for (int ni = 0; ni < NT; ++ni) b[ni] = *(const bf16x8*)(cur + rd_b + ni * 32 * GROW + s * 32);
#pragma unroll
            for (int mi = 0; mi < 2; ++mi)
#pragma unroll
                for (int ni = 0; ni < NT; ++ni) acc[mi][ni] = __builtin_amdgcn_mfma_f32_32x32x16_bf16(a[mi], b[ni], acc[mi][ni], 0, 0, 0);
        }
    };
    GStage g0, g1, g2;
    g1.b1 = zero4; g2.b1 = zero4; g0.b1 = zero4;
    const int last = nk - 1;
    gload(g0, 0);
    gload(g1, min(1, last));
    if (DEPTH == 3) gload(g2, min(2, last));
    __syncthreads();
    lstore(g0, sm);
    __syncthreads();
#define GSTEP(k, GL, GS) { gload(GL, min((k) + DEPTH, last)); compute(sm + ((k) & 1) * BUF); lstore(GS, sm + (((k) + 1) & 1) * BUF); __syncthreads(); }
    int ks = 0;
    if (DEPTH == 3) {
#pragma unroll 1
        for (; ks + 3 <= nk; ks += 3) {
            GSTEP(ks, g0, g1)
            GSTEP(ks + 1, g1, g2)
            GSTEP(ks + 2, g2, g0)
        }
        if (ks < nk) {
            GSTEP(ks, g0, g1)
            if (ks + 1 < nk) GSTEP(ks + 1, g1, g2)
        }
    } else if (DEPTH == 2) {
#pragma unroll 1
        for (; ks + 2 <= nk; ks += 2) {
            GSTEP(ks, g0, g1)
            GSTEP(ks + 1, g1, g0)
        }
        if (ks < nk) GSTEP(ks, g0, g1)
    } else {
#pragma unroll 1
        for (; ks < nk; ++ks) GSTEP(ks, g1, g1)
    }
#undef GSTEP
}
constexpr int DMA_STAGE = 16384, GEMM_NST = 3;
#define DMA_WAIT(n) asm volatile("s_waitcnt vmcnt(" #n ")" ::: "memory")
template <int NST>
__device__ __forceinline__ void tile_mac_dma(f32x16 (&acc)[2][2], const bf16_t* __restrict__ A, int lda, int m0,
                                             const bf16_t* __restrict__ Bt, int ldb, int n0, int K, char* sm) {
    static_assert(NST == 3 || NST == 4, "ring of 3 or 4 stages");
    const int tid = tidx(), lane = tid & 63, wid = __builtin_amdgcn_readfirstlane(tid >> 6), wr = wid >> 1, wc = wid & 1;
    const int lr = lane & 31, lh = lane >> 5;
    const int srow = tid >> 2, sslot = tid & 3, schunk = sslot ^ ((srow >> 2) & 3);
    const bf16_t* Ab = A + (size_t)m0 * lda;
    const bf16_t* Bb = Bt + (size_t)n0 * ldb;
    const unsigned ao0 = (unsigned)(srow * lda + schunk * 8), ao1 = ao0 + (unsigned)(64 * lda);
    const unsigned bo0 = (unsigned)(srow * ldb + schunk * 8), bo1 = bo0 + (unsigned)(64 * ldb);
    const int ldst = tid * 16;
    const int sw = (lr >> 2) & 3;
    const int rd_a = (wr * 64 + lr) * 64, rd_b = 8192 + (wc * 64 + lr) * 64;
    const int so0 = ((lh) ^ sw) * 16, so1 = ((lh + 2) ^ sw) * 16;
    const int nk = K / 32, last = nk - 1;
    auto issue = [&](int ks, int slot) {
        const unsigned ko = (unsigned)ks * 32u;
        char* st = sm + slot * DMA_STAGE + ldst;
        __builtin_amdgcn_global_load_lds((const unsigned*)(Ab + (ao0 + ko)), (unsigned*)(st), 16, 0, 0);
        __builtin_amdgcn_global_load_lds((const unsigned*)(Ab + (ao1 + ko)), (unsigned*)(st + 4096), 16, 0, 0);
        __builtin_amdgcn_global_load_lds((const unsigned*)(Bb + (bo0 + ko)), (unsigned*)(st + 8192), 16, 0, 0);
        __builtin_amdgcn_global_load_lds((const unsigned*)(Bb + (bo1 + ko)), (unsigned*)(st + 12288), 16, 0, 0);
    };
    auto compute = [&](int slot) {
        const char* cur = sm + slot * DMA_STAGE;
        bf16x8 a[2][2], b[2][2];
#pragma unroll
        for (int mi = 0; mi < 2; ++mi) { a[mi][0] = *(const bf16x8*)(cur + rd_a + mi * 2048 + so0); a[mi][1] = *(const bf16x8*)(cur + rd_a + mi * 2048 + so1); }
#pragma unroll
        for (int ni = 0; ni < 2; ++ni) { b[ni][0] = *(const bf16x8*)(cur + rd_b + ni * 2048 + so0); b[ni][1] = *(const bf16x8*)(cur + rd_b + ni * 2048 + so1); }
#pragma unroll
        for (int s = 0; s < 2; ++s)
#pragma unroll
            for (int mi = 0; mi < 2; ++mi)
#pragma unroll
                for (int ni = 0; ni < 2; ++ni) acc[mi][ni] = __builtin_amdgcn_mfma_f32_32x32x16_bf16(a[mi][s], b[ni][s], acc[mi][ni], 0, 0, 0);
    };
    __syncthreads();
#pragma unroll
    for (int s = 0; s < NST - 1; ++s) issue(min(s, last), s);
    int slot = 0, nslot = NST - 1;
#pragma unroll 1
    for (int ks = 0; ks < nk; ++ks) {
        if (NST == 3) DMA_WAIT(4); else DMA_WAIT(8);
        __builtin_amdgcn_s_barrier();
        issue(min(ks + NST - 1, last), nslot);
        compute(slot);
        slot = (slot + 1 == NST) ? 0 : slot + 1; nslot = (nslot + 1 == NST) ? 0 : nslot + 1;
    }
    DMA_WAIT(0);
}
__device__ __forceinline__ void tile_mac_dma64(f32x16 (&acc)[2][2], const bf16_t* __restrict__ A, int lda, int m0,
                                               const bf16_t* __restrict__ Bt, int ldb, int n0, int K, char* sm) {
    constexpr int STG = 32768;
    const int tid = tidx(), lane = tid & 63, wid = __builtin_amdgcn_readfirstlane(tid >> 6), wr = wid >> 1, wc = wid & 1;
    const int lr = lane & 31, lh = lane >> 5;
    const int srow = tid >> 3, schunk = (tid & 7) ^ ((tid >> 4) & 7);
    const bf16_t* Ab = A + (size_t)m0 * lda;
    const bf16_t* Bb = Bt + (size_t)n0 * ldb;
    const unsigned ao = (unsigned)(srow * lda + schunk * 8), bo = (unsigned)(srow * ldb + schunk * 8);
    const unsigned a32 = (unsigned)(32 * lda), b32 = (unsigned)(32 * ldb);
    const int ldst = tid * 16;
    const int sw = (lr >> 1) & 7;
    const int rd_a = (wr * 64 + lr) * 128, rd_b = 16384 + (wc * 64 + lr) * 128;
    const int nk = K / 64, last = nk - 1;
    auto issue = [&](int ks, int slot) {
        const unsigned ko = (unsigned)ks * 64u;
        char* st = sm + slot * STG + ldst;
#pragma unroll
        for (int i = 0; i < 4; ++i) __builtin_amdgcn_global_load_lds((const unsigned*)(Ab + (ao + i * a32 + ko)), (unsigned*)(st + i * 4096), 16, 0, 0);
#pragma unroll
        for (int i = 0; i < 4; ++i) __builtin_amdgcn_global_load_lds((const unsigned*)(Bb + (bo + i * b32 + ko)), (unsigned*)(st + 16384 + i * 4096), 16, 0, 0);
    };
    auto compute = [&](int slot) {
        const char* cur = sm + slot * STG;
#pragma unroll
        for (int s = 0; s < 4; ++s) {
            const int so = ((lh + 2 * s) ^ sw) * 16;
            bf16x8 a[2], b[2];
#pragma unroll
            for (int mi = 0; mi < 2; ++mi) a[mi] = *(const bf16x8*)(cur + rd_a + mi * 4096 + so);
#pragma unroll
            for (int ni = 0; ni < 2; ++ni) b[ni] = *(const bf16x8*)(cur + rd_b + ni * 4096 + so);
#pragma unroll
            for (int mi = 0; mi < 2; ++mi)
#pragma unroll
                for (int ni = 0; ni < 2; ++ni) acc[mi][ni] = __builtin_amdgcn_mfma_f32_32x32x16_bf16(a[mi], b[ni], acc[mi][ni], 0, 0, 0);
        }
    };
    __syncthreads();
    issue(0, 0);
#pragma unroll 1
    for (int ks = 0; ks < nk; ++ks) {
        DMA_WAIT(0);
        __builtin_amdgcn_s_barrier();
        if (ks < last) issue(ks + 1, (ks + 1) & 1);
#if defined(GEMM_EXP) && GEMM_EXP == 5
        issue(min(ks + 1, last), (ks + 1) & 1);
#endif
        compute(ks & 1);
#if defined(GEMM_EXP) && GEMM_EXP == 4
        { f32x16 (&keep)[2][2] = acc; f32x16 dummy[2][2]; for (int i_ = 0; i_ < 16; ++i_) { dummy[0][0][i_] = 0.f; dummy[0][1][i_] = 0.f; dummy[1][0][i_] = 0.f; dummy[1][1][i_] = 0.f; }
          auto compute2 = [&](int slot) {
              const char* cur = sm + slot * STG;
#pragma unroll
              for (int s = 0; s < 4; ++s) {
                  const int so = ((lh + 2 * s) ^ sw) * 16;
                  bf16x8 a[2], b[2];
#pragma unroll
                  for (int mi = 0; mi < 2; ++mi) a[mi] = *(const bf16x8*)(cur + rd_a + mi * 4096 + so);
#pragma unroll
                  for (int ni = 0; ni < 2; ++ni) b[ni] = *(const bf16x8*)(cur + rd_b + ni * 4096 + so);
#pragma unroll
                  for (int mi = 0; mi < 2; ++mi)
#pragma unroll
                      for (int ni = 0; ni < 2; ++ni) dummy[mi][ni] = __builtin_amdgcn_mfma_f32_32x32x16_bf16(a[mi], b[ni], dummy[mi][ni], 0, 0, 0);
              }
          };
          compute2(ks & 1);
#pragma unroll
          for (int mi = 0; mi < 2; ++mi)
#pragma unroll
              for (int ni = 0; ni < 2; ++ni) asm volatile("" :: "v"(dummy[mi][ni]));
          (void)keep; }
#endif
    }
    DMA_WAIT(0);
}
struct GStage64 { u32x4 a[4], b[4]; };
__device__ __forceinline__ void tile_mac_reg64(f32x16 (&acc)[2][2], const bf16_t* __restrict__ A, int lda, int m0,
                                               const bf16_t* __restrict__ Bt, int ldb, int n0, int K, char* sm) {
    constexpr int STG = 32768;
    const int tid = tidx(), lane = tid & 63, wid = __builtin_amdgcn_readfirstlane(tid >> 6), wr = wid >> 1, wc = wid & 1;
    const int lr = lane & 31, lh = lane >> 5;
    const int srow = tid >> 3, schunk = (tid & 7) ^ ((tid >> 4) & 7);
    const bf16_t* Ab = A + (size_t)m0 * lda;
    const bf16_t* Bb = Bt + (size_t)n0 * ldb;
    const unsigned ao = (unsigned)(srow * lda + schunk * 8), bo = (unsigned)(srow * ldb + schunk * 8);
    const unsigned a32 = (unsigned)(32 * lda), b32 = (unsigned)(32 * ldb);
    const int ldst = tid * 16;
    const int sw = (lr >> 1) & 7;
    const int rd_a = (wr * 64 + lr) * 128, rd_b = 16384 + (wc * 64 + lr) * 128;
    const int nk = K / 64, last = nk - 1;
    auto gload = [&](GStage64& g, int ks) {
        const unsigned ko = (unsigned)ks * 64u;
#pragma unroll
        for (int i = 0; i < 4; ++i) { g.a[i] = *(const u32x4*)(Ab + (ao + i * a32 + ko)); g.b[i] = *(const u32x4*)(Bb + (bo + i * b32 + ko)); }
    };
    auto lstore = [&](const GStage64& g, int slot) {
        char* st = sm + slot * STG + ldst;
#pragma unroll
        for (int i = 0; i < 4; ++i) { *(u32x4*)(st + i * 4096) = g.a[i]; *(u32x4*)(st + 16384 + i * 4096) = g.b[i]; }
    };
    auto compute = [&](int slot) {
        const char* cur = sm + slot * STG;
#pragma unroll
        for (int s = 0; s < 4; ++s) {
            const int so = ((lh + 2 * s) ^ sw) * 16;
            bf16x8 a[2], b[2];
#pragma unroll
            for (int mi = 0; mi < 2; ++mi) a[mi] = *(const bf16x8*)(cur + rd_a + mi * 4096 + so);
#pragma unroll
            for (int ni = 0; ni < 2; ++ni) b[ni] = *(const bf16x8*)(cur + rd_b + ni * 4096 + so);
#pragma unroll
            for (int mi = 0; mi < 2; ++mi)
#pragma unroll
                for (int ni = 0; ni < 2; ++ni) acc[mi][ni] = __builtin_amdgcn_mfma_f32_32x32x16_bf16(a[mi], b[ni], acc[mi][ni], 0, 0, 0);
        }
    };
    GStage64 g0, g1;
    gload(g0, 0);
    gload(g1, min(1, last));
    __syncthreads();
    lstore(g0, 0);
    __syncthreads();
#if defined(GEMM_EXP) && GEMM_EXP == 7
#define GSTEP64(k, GL, GS) { gload(GL, min((k) + 2, last)); asm volatile("" :: "v"(GL.a[0]), "v"(GL.b[3])); gload(GL, min((k) + 2, last)); compute((k) & 1); lstore(GS, ((k) + 1) & 1); __syncthreads(); }
#elif defined(GEMM_EXP) && GEMM_EXP == 8
#define GSTEP64(k, GL, GS) { gload(GL, min((k) + 2, last)); compute((k) & 1); lstore(GS, ((k) + 1) & 1); asm volatile("" ::: "memory"); lstore(GS, ((k) + 1) & 1); __syncthreads(); }
#elif defined(GEMM_EXP) && GEMM_EXP == 9
#define GSTEP64(k, GL, GS) { gload(GL, min((k) + 2, last)); compute((k) & 1); compute((k) & 1); lstore(GS, ((k) + 1) & 1); __syncthreads(); }
#else
#define GSTEP64(k, GL, GS) { gload(GL, min((k) + 2, last)); compute((k) & 1); lstore(GS, ((k) + 1) & 1); __syncthreads(); }
#endif
    int ks = 0;
#pragma unroll 1
    for (; ks + 2 <= nk; ks += 2) {
        GSTEP64(ks, g0, g1)
        GSTEP64(ks + 1, g1, g0)
    }
    if (ks < nk) GSTEP64(ks, g0, g1)
#undef GSTEP64
#if defined(GEMM_EXP) && GEMM_EXP == 9
#pragma unroll
    for (int mi = 0; mi < 2; ++mi)
#pragma unroll
        for (int ni = 0; ni < 2; ++ni)
#pragma unroll
            for (int r = 0; r < 16; ++r) acc[mi][ni][r] *= 0.5f;
#endif
}
template <int NT> __device__ __forceinline__ void acc_zero(f32x16 (&acc)[2][NT]) {
#pragma unroll
    for (int mi = 0; mi < 2; ++mi)
#pragma unroll
        for (int ni = 0; ni < NT; ++ni)
#pragma unroll
            for (int r = 0; r < 16; ++r) acc[mi][ni][r] = 0.f;
}
template <int BN, class Epi>
__device__ __forceinline__ void gemm_bf16(const bf16_t* A, int lda, const bf16_t* Bt, int ldb, int M, int N, int K, const Epi& epi, int bid, int nb, char* sm) {
    constexpr int NT = BN / 64;
    const int tm = M / 128, tn = (N + BN - 1) / BN;
    for (int tile = bid; tile < tm * tn; tile += nb) {
        const int m0 = (tile % tm) * 128, n0 = (tile / tm) * BN;
        f32x16 acc[2][NT]; acc_zero<NT>(acc);
        if constexpr (BN == 128) { if (K % 64 == 0 && K >= 128) tile_mac_reg64(acc, A, lda, m0, Bt, ldb, n0, K, sm); else tile_mac_dma<GEMM_NST>(acc, A, lda, m0, Bt, ldb, n0, K, sm); }
        else tile_mac<BN>(acc, A, lda, m0, Bt, ldb, n0, N, K, sm);
        const int lane = tidx() & 63, wid = __builtin_amdgcn_readfirstlane(tidx() >> 6), wr = wid >> 1, wc = wid & 1, lr = lane & 31, lh = lane >> 5;
        const int col0 = n0 + wc * (BN / 2);
        if (col0 < N) epi(acc, m0 + wr * 64, col0, lr, lh, sm + (((K / 64) & 1) ? 32768 : 0) + wid * 8192);
#if defined(GEMM_EXP) && GEMM_EXP == 6
        if (N == NP) epi(acc, m0 + wr * 64, col0, lr, lh, sm + (((K / 64) & 1) ? 32768 : 0) + wid * 8192);
#endif
    }
}
template <class Epi>
__device__ __forceinline__ void gemm_bf16_patch(const Params& p, const bf16_t* A, int lda, const bf16_t* Bt, int ldb, int M, int N, int K, const Epi& epi, char* sm) {
    const int lane = tidx() & 63, wid = __builtin_amdgcn_readfirstlane(tidx() >> 6), wr = wid >> 1, wc = wid & 1, lr = lane & 31, lh = lane >> 5;
    volatile unsigned* lw = (volatile unsigned*)(sm + 65536 + 36);
    __syncthreads();
    if (threadIdx.x == 0) {
        const unsigned x = xb_xcc_id(); unsigned nloc = 1, dense = 0, nx = 0;
        for (unsigned j = 0; j < 16; ++j) { const unsigned c = xb_ld(p.bar() + XRANK_BASE + j); if (j == x) nloc = c; if (c > 0) { if (j < x) ++dense; ++nx; } }
        lw[1] = nloc ? nloc : 1; lw[2] = dense; lw[3] = nx ? nx : 1;
    }
    __syncthreads();
    const int rank = __builtin_amdgcn_readfirstlane((int)lw[0]), nloc = __builtin_amdgcn_readfirstlane((int)lw[1]);
    const int dense = __builtin_amdgcn_readfirstlane((int)lw[2]), nx = __builtin_amdgcn_readfirstlane((int)lw[3]);
    const int tm = M / 128, tn = N / 128, npr = tm / 8, npc = (tn + 7) / 8;
    for (int pt = dense; pt < npr * npc; pt += nx) {
        const int pr = pt % npr, pc = pt / npr;
        for (int j = rank; j < 64; j += nloc) {
            const int mt = pr * 8 + (j & 7), nt = pc * 8 + (j >> 3);
            if (nt >= tn) continue;
            const int m0 = mt * 128, n0 = nt * 128;
            f32x16 acc[2][2]; acc_zero<2>(acc);
            tile_mac_dma64(acc, A, lda, m0, Bt, ldb, n0, K, sm);
            char* stg = sm + (((K / 64) & 1) ? 32768 : 0) + wid * 8192;
            epi(acc, m0 + wr * 64, n0 + wc * 64, lr, lh, stg);
#if defined(GEMM_EXP) && GEMM_EXP == 6
            epi(acc, m0 + wr * 64, n0 + wc * 64, lr, lh, stg);
#endif
        }
    }
}
#define EROW(mi, r) (row0 + (mi) * 32 + ((r) & 3) + 8 * ((r) >> 2) + 4 * lh)
__device__ __forceinline__ float bf2f(bf16_t h) { return __uint_as_float((unsigned)h << 16); }
__device__ __forceinline__ void epi_rope64(const f32x16 (&acc)[2][2], int row0, int lr, int lh, const float* __restrict__ rope, bf16_t* __restrict__ dst, int ld, int cbase) {
#pragma unroll
    for (int mi = 0; mi < 2; ++mi)
#pragma unroll
        for (int r = 0; r < 16; ++r) {
            const size_t row = EROW(mi, r);
            const float c = rope[row * 64 + lr], s = rope[row * 64 + 32 + lr], x1 = acc[mi][0][r], x2 = acc[mi][1][r];
            dst[row * ld + cbase + lr] = f2bf(x1 * c - x2 * s); dst[row * ld + cbase + 32 + lr] = f2bf(x2 * c + x1 * s);
        }
}
template <int NTI>
__device__ __forceinline__ void epi_rope32(const f32x16 (&acc)[2][2], int row0, int lr, int lh, const float* __restrict__ rope, bf16_t* __restrict__ dst, int ld, int cbase) {
    const int f = lr & 15;
#pragma unroll
    for (int mi = 0; mi < 2; ++mi)
#pragma unroll
        for (int ni = 0; ni < NTI; ++ni)
#pragma unroll
            for (int r = 0; r < 16; ++r) {
                const size_t row = EROW(mi, r);
                const float x = acc[mi][ni][r], xo = __shfl_xor(x, 16, 64);
                const float c = rope[row * 64 + 2 * f], s = rope[row * 64 + 32 + 2 * f];
                dst[row * ld + cbase + ni * 32 + lr] = f2bf((lr & 16) ? (x * c + xo * s) : (x * c - xo * s));
            }
}
template <int NT, bool SILU>
__device__ __forceinline__ void epi_bf16(const f32x16 (&acc)[2][NT], int row0, int lr, int lh, bf16_t* __restrict__ dst, int ld, int cbase) {
#pragma unroll
    for (int mi = 0; mi < 2; ++mi)
#pragma unroll
        for (int ni = 0; ni < NT; ++ni)
#pragma unroll
            for (int r = 0; r < 16; ++r) { const float v = acc[mi][ni][r]; dst[(size_t)EROW(mi, r) * ld + cbase + ni * 32 + lr] = f2bf(SILU ? silu_(v) : v); }
}
template <int NT>
__device__ __forceinline__ void epi_vt(const f32x16 (&acc)[2][NT], int trow0, int lr, int lh, bf16_t* __restrict__ vt, size_t ldv) {
#pragma unroll
    for (int mi = 0; mi < 2; ++mi)
#pragma unroll
        for (int ni = 0; ni < NT; ++ni)
#pragma unroll
            for (int g = 0; g < 4; ++g) {
                u32x2 o; o.x = cvt_pk_bf16(acc[mi][ni][4 * g], acc[mi][ni][4 * g + 1]); o.y = cvt_pk_bf16(acc[mi][ni][4 * g + 2], acc[mi][ni][4 * g + 3]);
                *(u32x2*)(vt + (size_t)(ni * 32 + lr) * ldv + trow0 + mi * 32 + 8 * g + 4 * lh) = o;
            }
}
template <int NT>
__device__ __forceinline__ void epi_f32(const f32x16 (&acc)[2][NT], int row0, int lr, int lh, float* __restrict__ dst, int ld, int cbase) {
#pragma unroll
    for (int mi = 0; mi < 2; ++mi)
#pragma unroll
        for (int ni = 0; ni < NT; ++ni)
#pragma unroll
            for (int r = 0; r < 16; ++r) dst[(size_t)EROW(mi, r) * ld + cbase + ni * 32 + lr] = acc[mi][ni][r];
}
struct EpiInProj {
    const Params& p; int layer;
    __device__ __forceinline__ void operator()(const f32x16 (&acc)[2][2], int row0, int col0, int lr, int lh, char* stg) const {
        const int b = row0 / S, t0 = row0 % S;
        const float* rope = p.ROPE();
        int kind, ld = 256, cbase = 0; size_t off = 0; bool silu = false;
        if (col0 < M_QN)         { kind = 0; off = OFF_QA; cbase = col0 - M_QA; }
        else if (col0 < M_KSLC)  { kind = 0; off = OFF_QN; cbase = col0 - M_QN; }
        else if (col0 == M_KSLC) { kind = 0; off = OFF_KSLC; ld = 64; }
        else if (col0 == M_KWIN) { kind = 0; off = OFF_KWIN; ld = 64; }
        else if (col0 == M_KC)   { kind = 0; off = OFF_KCT; ld = 64; }
        else if (col0 == M_VC)   { kind = 1; off = OFF_VCTOK; ld = 64; }
        else if (col0 < M_KF)    { kind = 1; off = OFF_QF; cbase = col0 - M_QF; }
        else if (col0 < M_QS)    { kind = 1; off = OFF_KF; cbase = col0 - M_KF; }
        else if (col0 < M_KSB)   { kind = 1; off = OFF_QS; cbase = col0 - M_QS; }
        else if (col0 < M_QM)    { kind = 1; off = OFF_KSB; cbase = col0 - M_KSB; }
        else if (col0 < M_VF)    { kind = 1; off = OFF_QM; cbase = col0 - M_QM; }
        else if (col0 < M_VS)    { kind = 2; off = OFF_VFT + ((size_t)(b * 4 + (col0 - M_VF) / 64) * 64) * S * 2; }
        else if (col0 < M_VSLC)  { kind = 2; off = OFF_VST + ((size_t)(b * 4 + (col0 - M_VS) / 64) * 64) * S * 2; }
        else if (col0 == M_VSLC) { kind = 2; off = OFF_VSLCT + ((size_t)b * 64) * S * 2; }
        else if (col0 == M_VWIN) { kind = 2; off = OFF_VWINT + ((size_t)b * 64) * S * 2; }
        else if (col0 < M_SPC)   { kind = 3; off = OFF_QI; ld = 128; cbase = col0 - M_QI; }
        else if (col0 == M_SPC)  { kind = 4; }
        else if (col0 < M_Z)     { kind = 5; off = OFF_CKVR; ld = 128; cbase = col0 - M_CKV; }
        else if (col0 < NPM)     { kind = 1; off = OFF_ZG; ld = 1280; cbase = col0 - M_Z; silu = true; }
        else if (col0 < M_MERGE) { return; }
        else                     { kind = 6; }
        bf16_t* dst = (bf16_t*)(p.ws + off);
        if (kind <= 3) {
            bf16_t* sg = (bf16_t*)stg;
            if (kind == 2) {
#pragma unroll
                for (int mi = 0; mi < 2; ++mi)
#pragma unroll
                    for (int ni = 0; ni < 2; ++ni)
#pragma unroll
                        for (int g = 0; g < 4; ++g) {
                            u32x2 o; o.x = cvt_pk_bf16(acc[mi][ni][4 * g], acc[mi][ni][4 * g + 1]); o.y = cvt_pk_bf16(acc[mi][ni][4 * g + 2], acc[mi][ni][4 * g + 3]);
                            const int d = ni * 32 + lr, tk = mi * 32 + 8 * g + 4 * lh;
                            *(u32x2*)(sg + d * 64 + (((tk >> 3) ^ (d & 7)) << 3) + (tk & 7)) = o;
                        }
            } else {
#pragma unroll
                for (int mi = 0; mi < 2; ++mi)
#pragma unroll
                    for (int r = 0; r < 16; ++r) {
                        const int rl = mi * 32 + (r & 3) + 8 * (r >> 2) + 4 * lh;
                        const size_t row = (size_t)row0 + rl;
                        float o0, o1;
                        if (kind == 0) {
                            const float c = rope[row * 64 + lr], s = rope[row * 64 + 32 + lr], x1 = acc[mi][0][r], x2 = acc[mi][1][r];
                            o0 = x1 * c - x2 * s; o1 = x2 * c + x1 * s;
                        } else if (kind == 3) {
                            const int f = lr & 15;
                            const float c = rope[row * 64 + 2 * f], s = rope[row * 64 + 32 + 2 * f];
                            const float x0 = acc[mi][0][r], x1 = acc[mi][1][r], y0 = __shfl_xor(x0, 16, 64), y1 = __shfl_xor(x1, 16, 64);
                            o0 = (lr & 16) ? (x0 * c + y0 * s) : (x0 * c - y0 * s); o1 = (lr & 16) ? (x1 * c + y1 * s) : (x1 * c - y1 * s);
                        } else {
                            o0 = acc[mi][0][r]; o1 = acc[mi][1][r];
                            if (silu) { o0 = silu_(o0); o1 = silu_(o1); }
                        }
                        sg[rl * 64 + ((((lr >> 3)) ^ (rl & 7)) << 3) + (lr & 7)] = f2bf(o0); sg[rl * 64 + ((((lr >> 3) + 4) ^ (rl & 7)) << 3) + (lr & 7)] = f2bf(o1);
                        if ((r & 3) == 3) __builtin_amdgcn_sched_barrier(0);
                    }
            }
            __builtin_amdgcn_wave_barrier();
            const size_t ldd = (kind == 2) ? (size_t)S : (size_t)ld;
            bf16_t* dp = (kind == 2) ? (dst + t0) : (dst + (size_t)row0 * ld + cbase);
            const int lane = lh * 32 + lr;
#pragma unroll
            for (int i = 0; i < 8; ++i) {
                const int piece = lane + 64 * i, rr = piece >> 3, ch = piece & 7;
                const u32x4 v = *(const u32x4*)(sg + rr * 64 + ((ch ^ (rr & 7)) << 3));
                *(u32x4*)(dp + (size_t)rr * ldd + ch * 8) = v;
            }
            __builtin_amdgcn_wave_barrier();
        }
        else if (kind == 5) epi_f32<2>(acc, row0, lr, lh, (float*)dst, ld, cbase);
        else if (kind == 6) {
            const int tile = (row0 >> 7) * 40 + ((col0 - M_MERGE) >> 7), wave = ((row0 >> 6) & 1) * 2 + ((col0 >> 6) & 1);
            bf16_t* sp = p.SIG() + ((size_t)(tile * 4 + wave) * 4) * 1024 + (size_t)(lh * 32 + lr) * 16;
#pragma unroll
            for (int mi = 0; mi < 2; ++mi)
#pragma unroll
                for (int ni = 0; ni < 2; ++ni) {
                    u32x4 w0, w1;
                    w0.x = cvt_pk_bf16(sigmoid_(acc[mi][ni][0]), sigmoid_(acc[mi][ni][1])); w0.y = cvt_pk_bf16(sigmoid_(acc[mi][ni][2]), sigmoid_(acc[mi][ni][3]));
                    w0.z = cvt_pk_bf16(sigmoid_(acc[mi][ni][4]), sigmoid_(acc[mi][ni][5])); w0.w = cvt_pk_bf16(sigmoid_(acc[mi][ni][6]), sigmoid_(acc[mi][ni][7]));
                    w1.x = cvt_pk_bf16(sigmoid_(acc[mi][ni][8]), sigmoid_(acc[mi][ni][9])); w1.y = cvt_pk_bf16(sigmoid_(acc[mi][ni][10]), sigmoid_(acc[mi][ni][11]));
                    w1.z = cvt_pk_bf16(sigmoid_(acc[mi][ni][12]), sigmoid_(acc[mi][ni][13])); w1.w = cvt_pk_bf16(sigmoid_(acc[mi][ni][14]), sigmoid_(acc[mi][ni][15]));
                    u32x4* d4 = (u32x4*)(sp + (size_t)(mi * 2 + ni) * 1024);
                    d4[0] = w0; d4[1] = w1;
                }
        }
        else {
            epi_rope32<1>(acc, row0, lr, lh, rope, p.KI(), 32, 0);
            const float fb = p.fox_bias[layer * 4 + (lr & 3)];
            float* sbase = (lr < 4) ? (p.WI() + lr) : (lr < 8) ? (p.LOGF() + (lr - 4)) : (p.GN() + (lr - 8));
            const int sstride = (lr < 8) ? 4 : 12;
#pragma unroll
            for (int mi = 0; mi < 2; ++mi)
#pragma unroll
                for (int r = 0; r < 16; ++r) {
                    const size_t row = EROW(mi, r); const float v = acc[mi][1][r];
                    const float u = (lr < 8) ? (v + fb) : v;
                    const float e = __builtin_amdgcn_exp2f(-1.4426950408889634f * fabsf(u));
                    const float lsg = fminf(u, 0.f) - __builtin_amdgcn_logf(1.f + e) * 0.6931471805599453f;
                    const float sg = ((u >= 0.f) ? 1.f : e) * __builtin_amdgcn_rcpf(1.f + e);
                    const float o = (lr < 4) ? v * 0.08838834764831845f : ((lr < 8) ? lsg : sg);
                    if (lr < 20) sbase[row * sstride] = o;
                }
        }
    }
};
struct EpiMemKV {
    const Params& p;
    __device__ __forceinline__ void operator()(const f32x16 (&acc)[2][2], int row0, int col0, int lr, int lh, char* stg) const {
        if (col0 < 256) epi_bf16<2, false>(acc, row0, lr, lh, p.MKB(), 256, col0);
        else epi_vt<2>(acc, row0 % NMEM, lr, lh, p.MVT() + ((size_t)((row0 / NMEM) * 4 + (col0 - 256) / 64) * 64) * NMEM, NMEM);
    }
};
struct EpiKA { const Params& p;
    __device__ __forceinline__ void operator()(const f32x16 (&acc)[2][2], int row0, int col0, int lr, int lh, char* stg) const { epi_rope64(acc, row0, lr, lh, p.ROPE(), p.KAB(), 256, col0); } };
struct EpiVA { const Params& p;
    __device__ __forceinline__ void operator()(const f32x16 (&acc)[2][2], int row0, int col0, int lr, int lh, char* stg) const {
        epi_vt<2>(acc, row0 % S, lr, lh, p.VAT() + ((size_t)((row0 / S) * 4 + col0 / 64) * 64) * S, S); } };
struct EpiResid { const float* Xin; float* Xout;
    __device__ __forceinline__ void operator()(const f32x16 (&acc)[2][2], int row0, int col0, int lr, int lh, char* stg) const {
#pragma unroll
        for (int mi = 0; mi < 2; ++mi) {
            float xv[2][16];
#pragma unroll
            for (int ni = 0; ni < 2; ++ni)
#pragma unroll
                for (int r = 0; r < 16; ++r) xv[ni][r] = Xin[(size_t)EROW(mi, r) * D + col0 + ni * 32 + lr];
#pragma unroll
            for (int ni = 0; ni < 2; ++ni)
#pragma unroll
                for (int r = 0; r < 16; ++r) Xout[(size_t)EROW(mi, r) * D + col0 + ni * 32 + lr] = xv[ni][r] + acc[mi][ni][r];
        }
    } };
struct EpiCmp1 { const float* bias; bf16_t* hid;
    __device__ __forceinline__ void operator()(const f32x16 (&acc)[2][1], int row0, int col0, int lr, int lh, char* stg) const {
        const float bv = bias[col0 + lr];
#pragma unroll
        for (int mi = 0; mi < 2; ++mi)
#pragma unroll
            for (int r = 0; r < 16; ++r) hid[(size_t)EROW(mi, r) * 128 + col0 + lr] = f2bf(silu_(acc[mi][0][r] + bv));
    } };
struct EpiCmp2K { bf16_t* kcb;
    __device__ __forceinline__ void operator()(const f32x16 (&acc)[2][1], int row0, int col0, int lr, int lh, char* stg) const {
#pragma unroll
        for (int mi = 0; mi < 2; ++mi)
#pragma unroll
            for (int r = 0; r < 16; ++r) { const int row = EROW(mi, r); kcb[(size_t)row * 64 + col0 + lr] = ((row & 511) == 511) ? (bf16_t)0 : f2bf(acc[mi][0][r]); }
    } };
struct EpiCmp2V { bf16_t* vct;
    __device__ __forceinline__ void operator()(const f32x16 (&acc)[2][1], int row0, int col0, int lr, int lh, char* stg) const {
        bf16_t* base = vct + ((size_t)(row0 / 512) * 64 + col0) * 512;
        const int n0 = row0 % 512;
#pragma unroll
        for (int mi = 0; mi < 2; ++mi)
#pragma unroll
            for (int g = 0; g < 4; ++g) {
                const int n = n0 + mi * 32 + 8 * g + 4 * lh;
                u32x2 o; o.x = cvt_pk_bf16(acc[mi][0][4 * g], acc[mi][0][4 * g + 1]); o.y = cvt_pk_bf16(acc[mi][0][4 * g + 2], (n + 3 == 511) ? 0.f : acc[mi][0][4 * g + 3]);
                *(u32x2*)(base + (size_t)lr * 512 + n) = o;
            }
    } };

__device__ __forceinline__ void ph_merge(const Params& p, int layer, int bid, int nb, char* sm) {
    const int lane = tidx() & 63, wid = __builtin_amdgcn_readfirstlane(tidx() >> 6), wr = wid >> 1, wc = wid & 1, lr = lane & 31, lh = lane >> 5;
    for (int tile = bid; tile < (T / 128) * (D / 128); tile += nb) {
        const int mt = tile % (T / 128), nt = tile / (T / 128), m0 = mt * 128, n0 = nt * 128;
        f32x16 mg[2][2]; acc_zero<2>(mg);
#pragma unroll 1
        for (int n = 0; n < 5; ++n) {
            f32x16 g[2][2]; acc_zero<2>(g);
            tile_mac_dma64(g, p.Y() + n * 256, 1280, m0, p.WBR() + ((size_t)layer * 5 + n) * D * 256, 256, n0, 256, sm);
            const bf16_t* sp = p.SIG() + ((size_t)((mt * 40 + n * 8 + nt) * 4 + wid) * 4) * 1024 + (size_t)lane * 16;
#pragma unroll
            for (int mi = 0; mi < 2; ++mi)
#pragma unroll
                for (int ni = 0; ni < 2; ++ni) {
                    const u32x4* s4 = (const u32x4*)(sp + (size_t)(mi * 2 + ni) * 1024);
                    const u32x4 w0 = s4[0], w1 = s4[1];
                    const unsigned sw[8] = {w0.x, w0.y, w0.z, w0.w, w1.x, w1.y, w1.z, w1.w};
#pragma unroll
                    for (int r = 0; r < 8; ++r) {
                        mg[mi][ni][2 * r] = fmaf(__uint_as_float(sw[r] << 16), g[mi][ni][2 * r], mg[mi][ni][2 * r]);
                        mg[mi][ni][2 * r + 1] = fmaf(__uint_as_float(sw[r] & 0xffff0000u), g[mi][ni][2 * r + 1], mg[mi][ni][2 * r + 1]);
                    }
                }
        }
        epi_bf16<2, false>(mg, m0 + wr * 64, lr, lh, p.MG(), D, n0 + wc * 64);
    }
}

__device__ __forceinline__ void ph_cumsum(const Params& p, int bid, int nb, float* sm) {
    const int tid = tidx();
    for (int item = bid; item < NBATCH * 4; item += nb) {
        const int b = item >> 2, h = item & 3;
        const float* src = p.LOGF() + (size_t)b * S * 4 + h;
        float* dst = p.CUM() + (size_t)b * S * 4 + h;
        float loc = 0.f;
        for (int i = 0; i < 32; ++i) loc += src[(size_t)(tid * 32 + i) * 4];
        sm[tid] = loc; __syncthreads();
        if (tid == 0) { float run = 0.f; for (int i = 0; i < 256; ++i) { const float v = sm[i]; sm[i] = run; run += v; } }
        __syncthreads();
        float run = sm[tid];
        float* dt = p.CUMT() + (size_t)item * S;
        for (int i = 0; i < 32; ++i) { run += src[(size_t)(tid * 32 + i) * 4]; dst[(size_t)(tid * 32 + i) * 4] = run; dt[tid * 32 + i] = run * 1.4426950408889634f; }
        __syncthreads();
    }
}

enum { AM_FOX = 0, AM_DSA = 1, AM_SLC = 2, AM_SB = 3, AM_WIN = 4, AM_MEM = 5, AM_CMP = 6 };
constexpr int AK_ROW = 144;
constexpr int AK_TILE = 64 * AK_ROW;
constexpr int ABUF = 2 * AK_TILE + 256;
constexpr float LOG2E = 1.4426950408889634f;
#define NEG_INF (-__builtin_inff())

template <int MODE>
__device__ __forceinline__ void attn_unit(const Params& p, int b, int head, int qblk, char* sm) {
    const int tid = tidx(), lane = tid & 63, wid = __builtin_amdgcn_readfirstlane(tid >> 6), lr = lane & 31, lh = lane >> 5;
    const int q0 = qblk * 128, qw0 = q0 + 32 * wid, tq = qw0 + lr;
    const size_t gq = (size_t)b * S + tq;
    const bf16_t *Qp, *Kp, *VTp; int ldk, ldv;
    if (MODE == AM_FOX)      { Qp = p.QF() + gq * 256 + head * 64; Kp = p.KF() + (size_t)b * S * 256 + head * 64; ldk = 256; VTp = p.VFT() + ((size_t)(b * 4 + head) * 64) * S; ldv = S; }
    else if (MODE == AM_DSA) { Qp = p.QA() + gq * 256 + head * 64; Kp = p.KAB() + (size_t)b * S * 256 + head * 64; ldk = 256; VTp = p.VAT() + ((size_t)(b * 4 + head) * 64) * S; ldv = S; }
    else if (MODE == AM_SB)  { Qp = p.QS() + gq * 256 + head * 64; Kp = p.KSB() + (size_t)b * S * 256 + head * 64; ldk = 256; VTp = p.VST() + ((size_t)(b * 4 + head) * 64) * S; ldv = S; }
    else if (MODE == AM_SLC) { Qp = p.QN() + gq * 256 + head * 64; Kp = p.KSLC() + (size_t)b * S * 64; ldk = 64; VTp = p.VSLCT() + ((size_t)b * 64) * S; ldv = S; }
    else if (MODE == AM_WIN) { Qp = p.QN() + gq * 256 + head * 64; Kp = p.KWIN() + (size_t)b * S * 64; ldk = 64; VTp = p.VWINT() + ((size_t)b * 64) * S; ldv = S; }
    else if (MODE == AM_CMP) { Qp = p.QN() + gq * 256 + head * 64; Kp = p.KCB() + (size_t)b * NCMP_PAD * 64; ldk = 64; VTp = p.VCT() + ((size_t)b * 64) * NCMP_PAD; ldv = NCMP_PAD; }
    else                     { Qp = p.QM() + gq * 256 + head * 64; Kp = p.MKB() + (size_t)b * NMEM * 256 + head * 64; ldk = 256; VTp = p.MVT() + ((size_t)(b * 4 + head) * 64) * NMEM; ldv = NMEM; }
    int kt_lo = 0, kt_hi = 2 * qblk + 2;
    if (MODE == AM_WIN) kt_lo = q0 >= 512 ? (q0 - 512) / 64 : 0;
    if (MODE == AM_MEM) kt_hi = NMEM / 64;
    if (MODE == AM_CMP) kt_hi = min(8, (((q0 + 96) >> 4) >> 6) + 1);
    const int nlim = (tq - 31) >> 4;
    const int ntile = kt_hi - kt_lo;
    constexpr bool REV = (MODE == AM_SB);

    bf16x8 qf[4];
#pragma unroll
    for (int s = 0; s < 4; ++s) qf[s] = *(const bf16x8*)(Qp + 16 * s + 8 * lh);
    unsigned smw[4] = {0u, 0u, 0u, 0u};
    if (MODE == AM_SLC) { const u32x4 w = *(const u32x4*)(p.SMASK() + gq * 4); smw[0] = w.x; smw[1] = w.y; smw[2] = w.z; smw[3] = w.w; }
    const unsigned long long* mrow = (const unsigned long long*)(p.DMASK() + gq * 256);
    const float* csp = p.CUMT() + (size_t)(b * 4 + head) * S;

    const int srow = tid >> 3, sc16 = tid & 7;
    const int st0 = srow * AK_ROW + sc16 * 16, st1 = (srow + 32) * AK_ROW + sc16 * 16;
    const bf16_t* kg0 = Kp + (size_t)srow * ldk + sc16 * 8;
    const bf16_t* kg1 = Kp + (size_t)(srow + 32) * ldk + sc16 * 8;
    const bf16_t* vg0 = VTp + (size_t)srow * ldv + sc16 * 8;
    const bf16_t* vg1 = VTp + (size_t)(srow + 32) * ldv + sc16 * 8;
    u32x4 rk0, rk1, rv0, rv1; float rcs = 0.f;
    auto gload = [&](int kt) {
        rk0 = *(const u32x4*)(kg0 + (size_t)kt * 64 * ldk); rk1 = *(const u32x4*)(kg1 + (size_t)kt * 64 * ldk);
        rv0 = *(const u32x4*)(vg0 + kt * 64); rv1 = *(const u32x4*)(vg1 + kt * 64);
        if (MODE == AM_FOX) { if (tid < 64) rcs = csp[kt * 64 + tid]; }
    };
    auto lstore = [&](char* buf) {
        *(u32x4*)(buf + st0) = rk0; *(u32x4*)(buf + st1) = rk1;
        *(u32x4*)(buf + AK_TILE + st0) = rv0; *(u32x4*)(buf + AK_TILE + st1) = rv1;
        if (MODE == AM_FOX) { if (tid < 64) *(float*)(buf + 2 * AK_TILE + tid * 4) = rcs; }
    };
    const int pil = (lr & 0x13) | ((lr & 4) << 1) | ((lr & 8) >> 1);
    const int rdk = pil * AK_ROW + lh * 16;
    const int rdv = AK_TILE + lr * AK_ROW + lh * 16;

    float m = NEG_INF, l = 0.f, R = 1.f;
    f32x16 O[2];
#pragma unroll
    for (int i = 0; i < 16; ++i) { O[0][i] = 0.f; O[1][i] = 0.f; }

    gload(REV ? kt_hi - 1 : kt_lo);
    __syncthreads();
    lstore(sm);
    __syncthreads();
#pragma unroll 1
    for (int it = 0; it < ntile; ++it) {
        const int kt = REV ? kt_hi - 1 - it : kt_lo + it;
        char* cur = sm + (it & 1) * ABUF;
        const bool more = (it + 1) < ntile;
        if (more) gload(REV ? kt - 1 : kt + 1);
        unsigned long long mw = 0ull;
        if (MODE == AM_DSA) mw = mrow[kt];
        bool need = true;
        if (MODE == AM_CMP) need = kt * 64 <= (qw0 >> 4);
        else if (MODE != AM_MEM) need = kt * 64 <= qw0 + 31;
        if (MODE == AM_WIN) need = need && (kt * 64 + 63 >= qw0 - 511);
        if (need) {
#pragma unroll
            for (int sb2 = 0; sb2 < 2; ++sb2) {
                const int sub = REV ? 1 - sb2 : sb2;
                const int kb = kt * 64 + sub * 32;
                bool sneed = true;
                if (MODE == AM_CMP) sneed = kb <= (qw0 >> 4);
                else if (MODE != AM_MEM) sneed = kb <= qw0 + 31;
                if (MODE == AM_WIN) sneed = sneed && (kb + 31 >= qw0 - 511);
                if (sneed) {
                    f32x16 s;
#pragma unroll
                    for (int i = 0; i < 16; ++i) s[i] = 0.f;
#pragma unroll
                    for (int s4 = 0; s4 < 4; ++s4) {
                        const bf16x8 kf = *(const bf16x8*)(cur + rdk + sub * 32 * AK_ROW + s4 * 32);
                        s = __builtin_amdgcn_mfma_f32_32x32x16_bf16(kf, qf[s4], s, 0, 0, 0);
                    }
                    const int thl = tq - kb - 8 * lh;
                    bf16x8 pf[2];
                    if (MODE == AM_SB) {
                        float kp[16];
#pragma unroll
                        for (int r = 0; r < 16; ++r) {
                            const int cr = 16 * (r >> 3) + (r & 7);
                            const float z = s[r] * 0.125f;
                            const float e = __builtin_amdgcn_exp2f(-fabsf(z) * LOG2E);
                            const float rc = __builtin_amdgcn_rcpf(1.f + e);
                            const float big = rc, sml = e * rc;
                            const bool ok = cr < thl;
                            const float sg = (z >= 0.f) ? big : sml;
                            kp[r] = ok ? ((z >= 0.f) ? sml : big) : 1.f;
                            s[r] = ok ? sg : 0.f;
                        }
                        float g0 = kp[0], g1 = kp[8];
#pragma unroll
                        for (int r = 1; r < 8; ++r) { g0 *= kp[r]; g1 *= kp[8 + r]; }
                        const float pg0 = __shfl_xor(g0, 32, 64), pg1 = __shfl_xor(g1, 32, 64);
                        float run0 = R * (lh == 0 ? (pg0 * g1 * pg1) : (pg1 * g1));
                        float run1 = R * (lh == 0 ? pg1 : 1.f);
#pragma unroll
                        for (int r = 7; r >= 0; --r) {
                            s[r] *= run0; run0 *= kp[r];
                            s[8 + r] *= run1; run1 *= kp[8 + r];
                        }
                        R *= (g0 * g1) * (pg0 * pg1);
                    } else {
                        constexpr float c = 0.125f * LOG2E;
                        if (MODE == AM_FOX) {
                            const float4* cs4 = (const float4*)(cur + 2 * AK_TILE + (sub * 32 + 8 * lh) * 4);
                            const float4 c0 = cs4[0], c1 = cs4[1], c2 = cs4[4], c3 = cs4[5];
                            const float cv[16] = {c0.x, c0.y, c0.z, c0.w, c1.x, c1.y, c1.z, c1.w, c2.x, c2.y, c2.z, c2.w, c3.x, c3.y, c3.z, c3.w};
#pragma unroll
                            for (int r = 0; r < 16; ++r) s[r] = fmaf(s[r], c, -cv[r]);
                        } else {
#pragma unroll
                            for (int r = 0; r < 16; ++r) s[r] *= c;
                        }
                        if (MODE == AM_DSA) {
                            const unsigned w = (unsigned)(mw >> (32 * sub)) >> (8 * lh);
#pragma unroll
                            for (int r = 0; r < 16; ++r) { const int cr = 16 * (r >> 3) + (r & 7); s[r] = (w & (1u << cr)) ? s[r] : NEG_INF; }
                        }
                        if (MODE == AM_SLC) {
                            const unsigned w = smw[0] * (kt < 32) + smw[1] * (kt >= 32 && kt < 64) + smw[2] * (kt >= 64 && kt < 96) + smw[3] * (kt >= 96);
                            const bool sel = (w >> (kt & 31)) & 1u;
#pragma unroll
                            for (int r = 0; r < 16; ++r) s[r] = sel ? s[r] : NEG_INF;
                        }
                        if (MODE == AM_FOX || MODE == AM_SLC) {
                            if (kb + 31 > qw0) {
#pragma unroll
                                for (int r = 0; r < 16; ++r) { const int cr = 16 * (r >> 3) + (r & 7); s[r] = (cr <= thl) ? s[r] : NEG_INF; }
                            }
                        }
                        if (MODE == AM_CMP) {
                            const int tc = nlim - kb - 8 * lh;
#pragma unroll
                            for (int r = 0; r < 16; ++r) { const int cr = 16 * (r >> 3) + (r & 7); s[r] = (cr <= tc) ? s[r] : NEG_INF; }
                        }
                        if (MODE == AM_WIN) {
                            if (kb + 31 > qw0 || kb < qw0 + 31 - 511) {
#pragma unroll
                                for (int r = 0; r < 16; ++r) { const int cr = 16 * (r >> 3) + (r & 7); s[r] = (cr <= thl && cr > thl - 512) ? s[r] : NEG_INF; }
                            }
                        }
                        float tmax = s[0];
#pragma unroll
                        for (int r = 1; r < 16; ++r) tmax = fmaxf(tmax, s[r]);
                        tmax = fmaxf(tmax, __shfl_xor(tmax, 32, 64));
                        const float mn = fmaxf(m, tmax);
                        const float mu = (mn == NEG_INF) ? 0.f : mn;
                        const float corr = __builtin_amdgcn_exp2f(m - mu);
                        m = mn;
                        float ls = 0.f;
#pragma unroll
                        for (int r = 0; r < 16; ++r) { s[r] = __builtin_amdgcn_exp2f(s[r] - mu); ls += s[r]; }
                        l = l * corr + ls;
                        if (!__all(corr == 1.0f)) {
#pragma unroll
                            for (int i = 0; i < 16; ++i) { O[0][i] *= corr; O[1][i] *= corr; }
                        }
                    }
                    {
                        u32x4 w0, w1;
                        w0.x = cvt_pk_bf16(s[0], s[1]); w0.y = cvt_pk_bf16(s[2], s[3]); w0.z = cvt_pk_bf16(s[4], s[5]); w0.w = cvt_pk_bf16(s[6], s[7]);
                        w1.x = cvt_pk_bf16(s[8], s[9]); w1.y = cvt_pk_bf16(s[10], s[11]); w1.z = cvt_pk_bf16(s[12], s[13]); w1.w = cvt_pk_bf16(s[14], s[15]);
                        pf[0] = __builtin_bit_cast(bf16x8, w0); pf[1] = __builtin_bit_cast(bf16x8, w1);
                    }
#pragma unroll
                    for (int s2 = 0; s2 < 2; ++s2)
#pragma unroll
                        for (int dt = 0; dt < 2; ++dt) {
                            const bf16x8 vf = *(const bf16x8*)(cur + rdv + dt * 32 * AK_ROW + sub * 64 + s2 * 32);
                            O[dt] = __builtin_amdgcn_mfma_f32_32x32x16_bf16(vf, pf[s2], O[dt], 0, 0, 0);
                        }
                }
            }
        }
        if (more) lstore(sm + ((it + 1) & 1) * ABUF);
        __syncthreads();
    }
    float inv = 1.f;
    if (MODE != AM_SB) { const float lt = l + __shfl_xor(l, 32, 64); inv = 1.f / fmaxf(lt, 1e-30f); }
    if (MODE == AM_SLC || MODE == AM_WIN || MODE == AM_CMP) {
        const float gs = (MODE == AM_CMP) ? inv : p.GN()[gq * 12 + (MODE == AM_SLC ? 4 : 8) + head] * inv;
        float* dst = (MODE == AM_SLC ? p.OSLC() : MODE == AM_WIN ? p.OWIN() : p.OCMP()) + gq * 256 + head * 64;
#pragma unroll
        for (int dt = 0; dt < 2; ++dt)
#pragma unroll
            for (int g = 0; g < 4; ++g) {
                float4 o; o.x = O[dt][4 * g] * gs; o.y = O[dt][4 * g + 1] * gs; o.z = O[dt][4 * g + 2] * gs; o.w = O[dt][4 * g + 3] * gs;
                *(float4*)(dst + 32 * dt + 8 * g + 4 * lh) = o;
            }
    } else {
        const int yc = MODE == AM_FOX ? 256 : MODE == AM_DSA ? 0 : MODE == AM_SB ? 512 : 1024;
        const bf16_t* zp = p.ZG() + gq * 1280 + yc + head * 64;
        bf16_t* dst = p.Y() + gq * 1280 + yc + head * 64;
#pragma unroll
        for (int dt = 0; dt < 2; ++dt)
#pragma unroll
            for (int g = 0; g < 4; ++g) {
                const int d0 = 32 * dt + 8 * g + 4 * lh;
                const u32x2 z = *(const u32x2*)(zp + d0);
                u32x2 o;
                o.x = cvt_pk_bf16(O[dt][4 * g] * inv * __uint_as_float(z.x << 16), O[dt][4 * g + 1] * inv * __uint_as_float(z.x & 0xffff0000u));
                o.y = cvt_pk_bf16(O[dt][4 * g + 2] * inv * __uint_as_float(z.y << 16), O[dt][4 * g + 3] * inv * __uint_as_float(z.y & 0xffff0000u));
                *(u32x2*)(dst + d0) = o;
            }
    }
}

__device__ __forceinline__ unsigned sortable_key(float x) { const unsigned u = __float_as_uint(x + 0.0f); return (u & 0x80000000u) ? ~u : (u | 0x80000000u); }
#ifndef DIAG
#define DIAG 0
#endif
#if DIAG
#define UNIT_ATTR
#else
#define UNIT_ATTR
#endif
UNIT_ATTR __device__ __forceinline__ void dsa_select_unit(const Params& p, int b, int qt, char* sm) {
    const int tid = tidx(), lane = tid & 63, wid = __builtin_amdgcn_readfirstlane(tid >> 6), lr = lane & 31, lh = lane >> 5;
    unsigned* hist = (unsigned*)sm;
    unsigned* st_prefix = (unsigned*)(sm + 32 * 257 * 4);
    int* st_krem = (int*)(st_prefix + 32);
    int* st_part = st_krem + 32;
    const int q0 = qt * 32, tq = q0 + lr, ntile = qt + 1;
    const size_t gq = (size_t)b * S + tq;
    const bool small = tq + 1 <= 256;
    bf16x8 qf[4][2];
    float w[4];
#pragma unroll
    for (int h = 0; h < 4; ++h) {
        qf[h][0] = *(const bf16x8*)(p.QI() + gq * 128 + h * 32 + 8 * lh);
        qf[h][1] = *(const bf16x8*)(p.QI() + gq * 128 + h * 32 + 16 + 8 * lh);
        w[h] = p.WI()[gq * 4 + h];
    }
    const bf16_t* kbase = p.KI() + (size_t)b * S * 32 + (size_t)lr * 32 + 8 * lh;
    auto score_tile = [&](const bf16x8& k0, const bf16x8& k1, unsigned (&key)[16]) {
        float sc[16];
#pragma unroll
        for (int r = 0; r < 16; ++r) sc[r] = 0.f;
#pragma unroll
        for (int h = 0; h < 4; ++h) {
            f32x16 a;
#pragma unroll
            for (int r = 0; r < 16; ++r) a[r] = 0.f;
            a = __builtin_amdgcn_mfma_f32_32x32x16_bf16(k0, qf[h][0], a, 0, 0, 0);
            a = __builtin_amdgcn_mfma_f32_32x32x16_bf16(k1, qf[h][1], a, 0, 0, 0);
#pragma unroll
            for (int r = 0; r < 16; ++r) sc[r] = fmaf(__builtin_amdgcn_fmed3f(a[r], 0.f, __builtin_inff()), w[h], sc[r]);
        }
#pragma unroll
        for (int r = 0; r < 16; ++r) key[r] = sortable_key(sc[r]);
    };
#define KLOAD(kt_, a_, b_) { const bf16_t* kp_ = kbase + (size_t)min((kt_), qt) * (32 * 32); a_ = *(const bf16x8*)kp_; b_ = *(const bf16x8*)(kp_ + 16); }
    unsigned prefix = 0u;
#pragma unroll 1
    for (int pass = 0; pass < 4; ++pass) {
        const int shift = 24 - 8 * pass;
        __syncthreads();
        for (int i = tid; i < 32 * 257; i += 256) hist[i] = 0u;
        __syncthreads();
        bf16x8 k0, k1; KLOAD(wid, k0, k1)
#pragma unroll 1
        for (int kt = wid; kt < ntile; kt += 4) {
            bf16x8 n0, n1; KLOAD(kt + 4, n0, n1)
            unsigned key[16];
            score_tile(k0, k1, key);
            const int vlim = (kt == qt) ? lr : 64;
#pragma unroll
            for (int r = 0; r < 16; ++r) {
                const int rho = (r & 3) + 8 * (r >> 2) + 4 * lh;
                const bool ok = (rho <= vlim) && ((pass == 0) || ((key[r] >> (shift + 8)) == prefix));
                atomicAdd(&hist[lr * 257 + (ok ? ((key[r] >> shift) & 255u) : 256u)], 1u);
            }
            k0 = n0; k1 = n1;
        }
        __syncthreads();
        {
            const int q = tid >> 3, part = tid & 7;
            const unsigned* hr = hist + q * 257 + part * 32;
            unsigned s = 0u;
#pragma unroll 8
            for (int i = 0; i < 32; ++i) s += hr[i];
            st_part[q * 8 + part] = (int)s;
            __syncthreads();
            const bool qsmall = (q0 + q + 1) <= 256;
            const int krem = (pass == 0) ? 256 : st_krem[q];
            const unsigned pprev = (pass == 0) ? 0u : st_prefix[q];
            unsigned above = 0u;
            for (int pp = 7; pp > part; --pp) above += (unsigned)st_part[q * 8 + pp];
            __syncthreads();
            if (qsmall) { if (part == 0) { st_prefix[q] = 0u; st_krem[q] = 1 << 30; } }
            else if (above < (unsigned)krem && (unsigned)krem <= above + s) {
                unsigned cum = above; int bin = 31;
                for (; bin > 0; --bin) { const unsigned c = hr[bin]; if (cum + c >= (unsigned)krem) break; cum += c; }
                st_prefix[q] = (pprev << 8) | (unsigned)(part * 32 + bin);
                st_krem[q] = krem - (int)cum;
            }
        }
        __syncthreads();
        prefix = st_prefix[lr];
    }
    const unsigned thr = prefix;
    unsigned* mrow = p.DMASK() + gq * 256;
    unsigned* tiew = hist;
    {
        bf16x8 k0, k1; KLOAD(wid, k0, k1)
#pragma unroll 1
        for (int kt = wid; kt < 256; kt += 4) {
            unsigned gt = 0u, tie = 0u;
            if (kt < ntile) {
                bf16x8 n0, n1; KLOAD(kt + 4, n0, n1)
                unsigned key[16];
                score_tile(k0, k1, key);
                const int vlim = (kt == qt) ? lr : 64;
#pragma unroll
                for (int r = 0; r < 16; ++r) {
                    const int rho = (r & 3) + 8 * (r >> 2) + 4 * lh;
                    const bool v = rho <= vlim;
                    gt |= (v && key[r] > thr) ? (1u << rho) : 0u; tie |= (v && key[r] == thr) ? (1u << rho) : 0u;
                }
                gt |= __shfl_xor(gt, 32, 64); tie |= __shfl_xor(tie, 32, 64);
                k0 = n0; k1 = n1;
            }
            if (lh == 0) { mrow[kt] = gt; tiew[lr * 257 + kt] = tie; }
        }
    }
    asm volatile("s_waitcnt vmcnt(0)" ::: "memory");
    __syncthreads();
    {
        const int q = tid >> 3, part = tid & 7;
        const unsigned* tr = tiew + q * 257 + part * 32;
        int c = 0;
#pragma unroll 8
        for (int i = 0; i < 32; ++i) c += __builtin_popcount(tr[i]);
        st_part[q * 8 + part] = c;
        __syncthreads();
        int base = 0;
        for (int pp = 0; pp < part; ++pp) base += st_part[q * 8 + pp];
        int allow = st_krem[q] - base;
        unsigned* grow = p.DMASK() + ((size_t)b * S + q0 + q) * 256 + part * 32;
        if (c > 0 && allow > 0) {
            for (int i = 0; i < 32 && allow > 0; ++i) {
                unsigned wv = tr[i];
                if (wv == 0u) continue;
                const int pc = __builtin_popcount(wv);
                if (pc > allow) { unsigned kept = 0u; for (int j = 0; j < allow; ++j) { const unsigned low = wv & (0u - wv); kept |= low; wv ^= low; } wv = kept; }
                atomicOr(grow + i, wv);
                allow -= pc;
            }
        }
    }
#undef KLOAD
    __syncthreads();
}

__device__ __forceinline__ bool imp_better(float v1, int i1, float v2, int i2) { return (v1 > v2) || (v1 == v2 && i1 < i2); }
UNIT_ATTR __device__ __forceinline__ void nsa_select_unit(const Params& p, int b, int q0w, char* sm) {
    const int lane = tidx() & 63, lr = lane & 31, lh = lane >> 5;
    const int tq = q0w + lr;
    const size_t gq = (size_t)b * S + tq;
    const int nlim = (tq - 31) >> 4;
    const int nst = min(16, ((((q0w + 31 - 31) >> 4)) >> 5) + 1);
    const int pil = (lr & 0x13) | ((lr & 4) << 1) | ((lr & 8) >> 1);
    const bf16_t* kc = p.KCB() + (size_t)b * NCMP_PAD * 64 + (size_t)pil * 64 + 8 * lh;
    constexpr float c = 0.125f * LOG2E;
    float mh[4], il[4];
#pragma unroll
    for (int h = 0; h < 4; ++h) {
        bf16x8 qf[4];
#pragma unroll
        for (int s = 0; s < 4; ++s) qf[s] = *(const bf16x8*)(p.QN() + gq * 256 + h * 64 + 16 * s + 8 * lh);
        float m = NEG_INF, l = 0.f;
#pragma unroll 1
        for (int st = 0; st < nst; ++st) {
            f32x16 s;
#pragma unroll
            for (int i = 0; i < 16; ++i) s[i] = 0.f;
#pragma unroll
            for (int s4 = 0; s4 < 4; ++s4) { const bf16x8 kf = *(const bf16x8*)(kc + (size_t)st * 32 * 64 + s4 * 16); s = __builtin_amdgcn_mfma_f32_32x32x16_bf16(kf, qf[s4], s, 0, 0, 0); }
            const int thl = nlim - st * 32 - 8 * lh;
            float tmax = NEG_INF;
#pragma unroll
            for (int r = 0; r < 16; ++r) { const int cr = 16 * (r >> 3) + (r & 7); s[r] = (cr <= thl) ? s[r] * c : NEG_INF; tmax = fmaxf(tmax, s[r]); }
            tmax = fmaxf(tmax, __shfl_xor(tmax, 32, 64));
            const float mn = fmaxf(m, tmax), mu = (mn == NEG_INF) ? 0.f : mn;
            float ls = 0.f;
#pragma unroll
            for (int r = 0; r < 16; ++r) ls += __builtin_amdgcn_exp2f(s[r] - mu);
            l = l * __builtin_amdgcn_exp2f(m - mu) + ls; m = mn;
        }
        l += __shfl_xor(l, 32, 64);
        mh[h] = (m == NEG_INF) ? 0.f : m; il[h] = 1.f / fmaxf(l, 1e-30f);
    }
    float val[16]; int idx[16];
#pragma unroll
    for (int i = 0; i < 16; ++i) { val[i] = NEG_INF; idx[i] = 1 << 20; }
    const int cur = tq >> 6;
#pragma unroll 1
    for (int st = 0; st < 16; ++st) {
        float bs[4] = {0.f, 0.f, 0.f, 0.f};
        if (st < nst) {
            const int thl = nlim - st * 32 - 8 * lh;
#pragma unroll
            for (int h = 0; h < 4; ++h) {
                f32x16 s;
#pragma unroll
                for (int i = 0; i < 16; ++i) s[i] = 0.f;
#pragma unroll
                for (int s4 = 0; s4 < 4; ++s4) {
                    const bf16x8 kf = *(const bf16x8*)(kc + (size_t)st * 32 * 64 + s4 * 16);
                    const bf16x8 qfr = *(const bf16x8*)(p.QN() + gq * 256 + h * 64 + 16 * s4 + 8 * lh);
                    s = __builtin_amdgcn_mfma_f32_32x32x16_bf16(kf, qfr, s, 0, 0, 0);
                }
#pragma unroll
                for (int r = 0; r < 16; ++r) {
                    const int cr = 16 * (r >> 3) + (r & 7);
                    const float pr = (cr <= thl) ? __builtin_amdgcn_exp2f(s[r] * c - mh[h]) * il[h] : 0.f;
                    bs[r >> 2] += pr;
                }
                __builtin_amdgcn_sched_barrier(0);
            }
        }
#pragma unroll
        for (int g = 0; g < 4; ++g) {
            const int j = st * 8 + 4 * (g >> 1) + 2 * lh + (g & 1);
            const bool forced = (j == 0) || (j == cur) || (j == cur - 1);
            float v = forced ? 1e4f : ((j <= cur) ? bs[g] : -1.0f);
            int jj = j;
            if (__any(imp_better(v, jj, val[15], idx[15]))) {
#pragma unroll
                for (int i = 0; i < 16; ++i) {
                    const bool bt = imp_better(v, jj, val[i], idx[i]);
                    const float tv = bt ? val[i] : v; const int ti = bt ? idx[i] : jj;
                    val[i] = bt ? v : val[i]; idx[i] = bt ? jj : idx[i];
                    v = tv; jj = ti;
                }
            }
        }
    }
    {
        float* lv = (float*)(sm + (tidx() >> 6) * 8192);
        int* li = (int*)(lv + 1024);
#pragma unroll
        for (int i = 0; i < 16; ++i) { lv[i * 64 + lane] = val[i]; li[i * 64 + lane] = idx[i]; }
        __builtin_amdgcn_wave_barrier();
#pragma unroll 1
        for (int k = 0; k < 16; ++k) {
            float v = lv[k * 64 + (lane ^ 32)]; int jj = li[k * 64 + (lane ^ 32)];
#pragma unroll
            for (int i = 0; i < 16; ++i) {
                const bool bt = imp_better(v, jj, val[i], idx[i]);
                const float tv = bt ? val[i] : v; const int ti = bt ? idx[i] : jj;
                val[i] = bt ? v : val[i]; idx[i] = bt ? jj : idx[i];
                v = tv; jj = ti;
            }
        }
        __builtin_amdgcn_wave_barrier();
    }
    unsigned m0 = 0u, m1 = 0u, m2 = 0u, m3 = 0u;
#pragma unroll
    for (int i = 0; i < 16; ++i) {
        const unsigned bit = 1u << (idx[i] & 31); const int wsel = idx[i] >> 5;
        m0 |= (wsel == 0) ? bit : 0u; m1 |= (wsel == 1) ? bit : 0u; m2 |= (wsel == 2) ? bit : 0u; m3 |= (wsel == 3) ? bit : 0u;
    }
    if (lh == 0) { u32x4 o; o.x = m0; o.y = m1; o.z = m2; o.w = m3; *(u32x4*)(p.SMASK() + gq * 4) = o; }
}

template <class BAR>
__device__ __forceinline__ void ph_work(const Params& p, int layer, char* sm, const BAR& barrier) {
    volatile int* s_unit_p = (volatile int*)(sm + 65536 + 32);
#pragma unroll 1
    for (int stage = 0; stage < 2; ++stage) {
        unsigned* ctr = p.qctr() + 64 * layer + 32 * stage;
        const int total = stage == 0 ? 3200 : 1024;
        for (;;) {
            __syncthreads();
            if (threadIdx.x == 0) *s_unit_p = (int)atomicAdd(ctr, 1u);
            __syncthreads();
            const int u = __builtin_amdgcn_readfirstlane(*s_unit_p);
            if (u >= total) break;
            int kind, b, h = 0, q;
            if (stage == 1) { const int r = u & 15; kind = 2 + ((r >> 3) ? AM_SLC : AM_DSA); q = 63 - (u >> 4); b = (r >> 2) & 1; h = r & 3; }
            else if (u < 512) { kind = 0; q = 255 - (u >> 1); b = u & 1; }
            else if (u < 640) { kind = 1; const int v = u - 512; b = v & 1; q = v >> 1; }
            else if (u < 1664) { const int v = u - 640, r = v & 15; kind = 2 + ((r >> 3) ? AM_FOX : AM_SB); q = 63 - (v >> 4); b = (r >> 2) & 1; h = r & 3; }
            else { const int v = u - 1664, br = v >> 9, w = v & 511; kind = 2 + (br == 0 ? AM_WIN : br == 1 ? AM_CMP : AM_MEM); q = w >> 3; b = (w >> 2) & 1; h = w & 3; }
#ifdef DUP_KIND
            const int reps = (kind == DUP_KIND) ? 2 : 1;
#pragma unroll 1
            for (int rep = 0; rep < reps; ++rep) {
#endif
            if (kind == 0) dsa_select_unit(p, b, q, sm);
            else if (kind == 1) nsa_select_unit(p, b, q * 128 + 32 * __builtin_amdgcn_readfirstlane(tidx() >> 6), sm);
            else if (kind == 2 + AM_SB) attn_unit<AM_SB>(p, b, h, q, sm);
            else if (kind == 2 + AM_FOX) attn_unit<AM_FOX>(p, b, h, q, sm);
            else if (kind == 2 + AM_DSA) attn_unit<AM_DSA>(p, b, h, q, sm);
            else if (kind == 2 + AM_SLC) attn_unit<AM_SLC>(p, b, h, q, sm);
            else if (kind == 2 + AM_WIN) attn_unit<AM_WIN>(p, b, h, q, sm);
            else if (kind == 2 + AM_CMP) attn_unit<AM_CMP>(p, b, h, q, sm);
            else attn_unit<AM_MEM>(p, b, h, q, sm);
#ifdef DUP_KIND
            }
#endif
        }
        barrier(stage);
    }
}

__device__ __forceinline__ void ph_nsa_combine(const Params& p, int bid, int nb) {
    for (size_t i = (size_t)bid * 256 + tidx(); i < (size_t)T * 64; i += (size_t)nb * 256) {
        const size_t g = i >> 6; const int c = (int)(i & 63) * 4, h = c >> 6;
        const float g0 = p.GN()[g * 12 + h];
        const float4 a = *(const float4*)(p.OCMP() + g * 256 + c), s = *(const float4*)(p.OSLC() + g * 256 + c), w = *(const float4*)(p.OWIN() + g * 256 + c);
        const u32x2 z = *(const u32x2*)(p.ZG() + g * 1280 + 768 + c);
        u32x2 o;
        o.x = cvt_pk_bf16((g0 * a.x + s.x + w.x) * __uint_as_float(z.x << 16), (g0 * a.y + s.y + w.y) * __uint_as_float(z.x & 0xffff0000u));
        o.y = cvt_pk_bf16((g0 * a.z + s.z + w.z) * __uint_as_float(z.y << 16), (g0 * a.w + s.w + w.w) * __uint_as_float(z.y & 0xffff0000u));
        *(u32x2*)(p.Y() + g * 1280 + 768 + c) = o;
    }
}

__device__ __forceinline__ void ph_setup_misc(const Params& p, int bid, int nb) {
    const int lane = tidx() & 63, gw = bid * 4 + (tidx() >> 6);
    for (int o = gw; o < DEPTH * 2 * 128; o += nb * 4) {
        const int l = o >> 8, which = (o >> 7) & 1, j = o & 127;
        const float* pe = (which ? p.pe_v : p.pe_k) + (size_t)l * 2048;
        const float* w1 = (which ? p.wc1_v : p.wc1_k) + (size_t)l * 2048 * 128;
        float a = 0.f;
        for (int k = lane; k < 2048; k += 64) a = fmaf(pe[k], w1[(size_t)k * 128 + j], a);
        a = wave_sum(a);
        if (lane == 0) p.BIASC()[o] = a;
    }
    for (int i = bid * 256 + tidx(); i < 2048; i += nb * 256) { p.KCT()[(size_t)T * 64 + i] = 0; p.VCTOK()[(size_t)T * 64 + i] = 0; }
    for (int i = bid * 256 + tidx(); i < 12 * D; i += nb * 256) p.WIN()[(size_t)(M_SPC + 52) * D + i] = 0;
    for (int i = bid * 256 + tidx(); i < (M_MERGE - NPM) * D; i += nb * 256) p.WIN()[(size_t)NPM * D + i] = 0;
}

#define XB_TMO      128
#define XB_XCNT(j)  (256  + 64 * (j))
#define XB_XSUB(j)  (1280 + 64 * (j))
#define XB_XGEN(j)  (2304 + 64 * (j))
#define XB_TOP      3328
#define XB_TOPGEN   3392
#define XCD_BAR_WORDS 3456
#define XB_SPIN_CAP (1u << 18)
#define LAS __attribute__((address_space(3)))

#define XB_SPIN(cond, bar) do { unsigned _sp = 0; while (cond) { __builtin_amdgcn_s_sleep(1); \
    if ((++_sp & 255u) == 0u) { if (xb_ld(&(bar)[XB_TMO])) break; if (_sp > XB_SPIN_CAP) { atomicAdd(&(bar)[XB_TMO], 1u); break; } } } } while (0)

struct XcdBarrier {
    unsigned* bar; unsigned x;
    volatile LAS unsigned* st;
};
__device__ __forceinline__ XcdBarrier xcd_barrier_post(unsigned* bar, volatile LAS unsigned* st) {
    XcdBarrier b; b.bar = bar; b.x = xb_xcc_id(); b.st = st;
    if (threadIdx.x == 0) (void)xb_add(&bar[XB_XCNT(b.x)], 1u);
    return b;
}
__device__ __forceinline__ void xcd_barrier_complete(unsigned* bar, unsigned x, unsigned& nloc, unsigned& nx) {
    const unsigned G = gridDim.x * gridDim.y * gridDim.z;
    unsigned sum, cnt, mine, sp = 0u;
    for (;;) {
        sum = 0u; cnt = 0u; mine = 0u;
#pragma unroll
        for (unsigned j = 0; j < 16; ++j) { const unsigned c = xb_ld(&bar[XB_XCNT(j)]); sum += c; cnt += (c > 0u) ? 1u : 0u; mine = (j == x) ? c : mine; }
        if (sum == G) break;
        __builtin_amdgcn_s_sleep(1);
        if ((++sp & 255u) == 0u) { if (xb_ld(&bar[XB_TMO])) break; if (sp > XB_SPIN_CAP) { atomicAdd(&bar[XB_TMO], 1u); break; } }
    }
    nloc = mine > 0u ? mine : 1u; nx = cnt > 0u ? cnt : 1u;
}
__device__ __attribute__((noinline)) void xcd_barrier_impl(unsigned* b_bar, unsigned b_x, volatile LAS unsigned* b_st) {
    XcdBarrier b; b.bar = b_bar; b.x = b_x; b.st = b_st;
    asm volatile("s_waitcnt vmcnt(0)" ::: "memory");
    __syncthreads();
    if (threadIdx.x == 0) {
        unsigned* bar = b.bar;
        __builtin_amdgcn_s_waitcnt(0);
        unsigned nloc = b.st[0], nx = b.st[1];
        if (nloc == 0u) { xcd_barrier_complete(bar, b.x, nloc, nx); b.st[0] = nloc; b.st[1] = nx; }
        const unsigned old = xb_add(&bar[XB_XSUB(b.x)], 1u);
        const unsigned gen = old / nloc;
        if (old + 1u == (gen + 1u) * nloc) {
            __builtin_amdgcn_fence(__ATOMIC_RELEASE, "agent");
            asm volatile("s_waitcnt vmcnt(0)" ::: "memory");
            const unsigned og = xb_add(&bar[XB_TOP], 1u);
            const unsigned tg = og / nx;
            if (og + 1u == (tg + 1u) * nx) xb_add(&bar[XB_TOPGEN], 1u);
            else XB_SPIN(xb_ld(&bar[XB_TOPGEN]) == tg, bar);
            __builtin_amdgcn_fence(__ATOMIC_ACQUIRE, "agent");
            xb_add(&bar[XB_XGEN(b.x)], 1u);
            asm volatile("s_waitcnt vmcnt(0)" ::: "memory");
        } else {
            XB_SPIN(xb_ld(&bar[XB_XGEN(b.x)]) == gen, bar);
            __builtin_amdgcn_fence(__ATOMIC_ACQUIRE, "agent");
            asm volatile("s_waitcnt vmcnt(0)" ::: "memory");
        }
    }
    __syncthreads();
}
__device__ __forceinline__ void xcd_barrier(const XcdBarrier& b) { xcd_barrier_impl(b.bar, b.x, b.st); }

constexpr int LDS_MAIN = 65536, LDS_BYTES = LDS_MAIN + 64;
#ifndef DIAG
#define DIAG 0
#endif
#ifndef DIAG_A
#define DIAG_A 8
#define DIAG_B 7
#endif
#if DIAG
#define STAMP(k) do { if (((k) == DIAG_A || (k) == DIAG_B || (k) + 1 == DIAG_A || (k) + 1 == DIAG_B || (k) == 0 || (k) == 11) && blockIdx.x == 0 && threadIdx.x == 0) { const unsigned long long t_ = wall_clock64(); dg[k] += t_ - dg[15]; dg[15] = t_; } } while (0)
#else
#define STAMP(k) do { } while (0)
#endif
__global__ void __launch_bounds__(256, 2) mega(Params p) {
    extern __shared__ __attribute__((aligned(16))) char smem[];
    if (threadIdx.x == 0) *(uint4*)(smem + LDS_MAIN) = make_uint4(0u, 0u, 0u, 0u);
    __syncthreads();
    XcdBarrier bar = xcd_barrier_post(p.bar(), (volatile LAS unsigned*)(smem + LDS_MAIN));
    if (threadIdx.x == 0) *(volatile unsigned*)(smem + LDS_MAIN + 36) = atomicAdd(p.bar() + XRANK_BASE + bar.x, 1u);
    const int bid = blockIdx.x, nb = gridDim.x;
    float* smf = (float*)smem;
#if DIAG
    __shared__ unsigned long long dg[16];
    if (threadIdx.x == 0) { for (int i = 0; i < 15; ++i) dg[i] = 0; dg[15] = wall_clock64(); }
#endif

    convert_wt(p.w_branch, p.WBR(), 256, D, DEPTH * 5, bid, nb, smf);
    convert_wt(p.w_out, p.WOUT(), D, D, DEPTH, bid, nb, smf);
    convert_wt(p.w_mem_kv, p.WMKV(), D, 512, DEPTH, bid, nb, smf);
    convert_wt(p.w_uk, p.WUK(), 128, 256, DEPTH, bid, nb, smf);
    convert_wt(p.w_uv, p.WUV(), 128, 256, DEPTH, bid, nb, smf);
    for (int l = 0; l < DEPTH; ++l) {
        convert_wt(p.wc1_k + (size_t)l * 2048 * 128, p.WC1T() + (size_t)(l * 2 + 0) * 128 * 2048, 2048, 128, 1, bid, nb, smf);
        convert_wt(p.wc1_v + (size_t)l * 2048 * 128, p.WC1T() + (size_t)(l * 2 + 1) * 128 * 2048, 2048, 128, 1, bid, nb, smf);
        convert_wt(p.wc2_k + (size_t)l * 128 * 64, p.WC2T() + (size_t)(l * 2 + 0) * 64 * 128, 128, 64, 1, bid, nb, smf);
        convert_wt(p.wc2_v + (size_t)l * 128 * 64, p.WC2T() + (size_t)(l * 2 + 1) * 64 * 128, 128, 64, 1, bid, nb, smf);
    }
    ph_setup_misc(p, bid, nb);
    ph_rope_table(p, bid, nb);
    STAMP(0);
    for (int l = 0; l < DEPTH; ++l) {
        const float* Xin = l == 0 ? p.x : p.X;
        convert_wt<true>(p.w_in + (size_t)l * D * NIN, p.WIN(), D, NIN, 1, bid, nb, smf);
        ph_rmsnorm<bf16_t>(Xin, p.norm_g + l * D, p.H(), T, bid, nb);
        ph_rmsnorm<bf16_t>(p.mem, p.mem_norm + l * D, p.MEMN(), NBATCH * NMEM, bid, nb);
        xcd_barrier(bar); STAMP(1);
        { EpiInProj e{p, l}; gemm_bf16<128>(p.H(), D, p.WIN(), D, T, NP, D, e, bid, nb, smem); }
        { EpiMemKV e{p}; gemm_bf16<128>(p.MEMN(), D, p.WMKV() + (size_t)l * 512 * D, D, NBATCH * NMEM, 512, D, e, bid, nb, smem); }
        xcd_barrier(bar); STAMP(2);
        ph_ckvnorm(p, l, bid, nb);
        ph_cumsum(p, bid, nb, smf);
        { EpiCmp1 e{p.BIASC() + (l * 2 + 0) * 128, p.HIDK()}; gemm_bf16<64>(p.KCT(), 1024, p.WC1T() + (size_t)(l * 2 + 0) * 128 * 2048, 2048, 1024, 128, 2048, e, bid, nb, smem); }
        { EpiCmp1 e{p.BIASC() + (l * 2 + 1) * 128, p.HIDV()}; gemm_bf16<64>(p.VCTOK(), 1024, p.WC1T() + (size_t)(l * 2 + 1) * 128 * 2048, 2048, 1024, 128, 2048, e, bid, nb, smem); }
        xcd_barrier(bar); STAMP(3);
        { EpiKA e{p}; gemm_bf16<128>(p.CKV(), 128, p.WUK() + (size_t)l * 256 * 128, 128, T, 256, 128, e, bid, nb, smem); }
        { EpiVA e{p}; gemm_bf16<128>(p.CKV(), 128, p.WUV() + (size_t)l * 256 * 128, 128, T, 256, 128, e, bid, nb, smem); }
        { EpiCmp2K e{p.KCB()}; gemm_bf16<64>(p.HIDK(), 128, p.WC2T() + (size_t)(l * 2 + 0) * 64 * 128, 128, 1024, 64, 128, e, bid, nb, smem); }
        { EpiCmp2V e{p.VCT()}; gemm_bf16<64>(p.HIDV(), 128, p.WC2T() + (size_t)(l * 2 + 1) * 64 * 128, 128, 1024, 64, 128, e, bid, nb, smem); }
        xcd_barrier(bar); STAMP(4);
        ph_work(p, l, smem, [&](int stage) { xcd_barrier(bar); if (stage == 0) { STAMP(7); } else { STAMP(8); } });
        ph_nsa_combine(p, bid, nb);
        xcd_barrier(bar); STAMP(9);
        ph_merge(p, l, bid, nb, smem);
        xcd_barrier(bar); STAMP(10);
        { EpiResid e{Xin, p.X}; gemm_bf16<128>(p.MG(), D, p.WOUT() + (size_t)l * D * D, D, T, D, D, e, bid, nb, smem); }
        xcd_barrier(bar); STAMP(11);
    }
#if DIAG
    {
        float* dgw = (float*)(p.bar() + 4096 + 512);
        if (blockIdx.x == 0 && threadIdx.x == 0) {
            unsigned long long tot = 0; for (int i = 0; i < 15; ++i) tot += dg[i];
            dgw[0] = rintf(100.f * (float)((double)dg[DIAG_A] / (double)tot)) / 100.f; dgw[1] = rintf(100.f * (float)((double)dg[DIAG_B] / (double)tot)) / 100.f;
        }
        ph_rmsnorm<float>(p.X, p.final_norm, p.X, T, bid, nb);
        xcd_barrier(bar);
        {
            const float fa = 1.0f + dgw[0];
            float4* xp = (float4*)p.X;
#pragma unroll 1
            for (int i = bid * 256 + threadIdx.x; i < T * D / 4; i += nb * 256) { float4 v = xp[i]; v.x *= fa; v.y *= fa; v.z *= fa; v.w *= fa; xp[i] = v; }
        }
        xcd_barrier(bar);
        if (blockIdx.x == 0 && threadIdx.x == 0) p.X[0] += 100.f * dgw[1];
    }
#else
    ph_rmsnorm<float>(p.X, p.final_norm, p.X, T, bid, nb);
#endif
}
}

extern "C" void kernel_launch(void* const* d_in, const int* in_sizes, int n_in, void* d_out, int out_size, void* d_ws, size_t ws_size, hipStream_t stream) {
    (void)in_sizes; (void)n_in; (void)out_size;
    Params p{};
    p.x = (const float*)d_in[0]; p.mem = (const float*)d_in[1]; p.pos = (const int*)d_in[2]; p.norm_g = (const float*)d_in[3];
    p.w_in = (const float*)d_in[4]; p.kv_norm = (const float*)d_in[5]; p.w_uk = (const float*)d_in[6]; p.w_uv = (const float*)d_in[7];
    p.fox_bias = (const float*)d_in[8]; p.pe_k = (const float*)d_in[9]; p.pe_v = (const float*)d_in[10]; p.wc1_k = (const float*)d_in[11];
    p.wc2_k = (const float*)d_in[12]; p.wc1_v = (const float*)d_in[13]; p.wc2_v = (const float*)d_in[14]; p.mem_norm = (const float*)d_in[15];
    p.w_mem_kv = (const float*)d_in[16]; p.w_branch = (const float*)d_in[17]; p.w_out = (const float*)d_in[18]; p.final_norm = (const float*)d_in[19];
    p.X = (float*)d_out;
    p.ws = (char*)d_ws;
    if (WS_TOTAL > ws_size) { fprintf(stderr, "kernel_launch: workspace too small (%zu > %zu)\n", (size_t)WS_TOTAL, ws_size); return; }

    static int grid = 0;
    if (grid == 0) {
        int dev = 0, cus = 0, per_cu = 0;
        hipGetDevice(&dev);
        hipDeviceGetAttribute(&cus, hipDeviceAttributeMultiprocessorCount, dev);
        hipFuncSetAttribute((const void*)mega, hipFuncAttributeMaxDynamicSharedMemorySize, LDS_BYTES);
        hipOccupancyMaxActiveBlocksPerMultiprocessor(&per_cu, (const void*)mega, 256, LDS_BYTES);
        (void)hipGetLastError();
        if (per_cu < 1) per_cu = 1;
        grid = cus * (per_cu < 2 ? per_cu : 2);
    }
    hipMemsetAsync((char*)d_ws + OFF_bar, 0, (4096 + 64 * 8 + 64) * sizeof(unsigned), stream);
    hipLaunchKernelGGL(mega, dim3(grid), dim3(256), LDS_BYTES, stream, p);
}
```

```cpp
#include <hip/hip_runtime.h>
#include <stdint.h>
#include <math.h>
#include <cstdio>
#include <type_traits>

namespace {
constexpr int S = 8192, NBATCH = 2, T = NBATCH * S, D = 1024, NIN = 9396, NM = 4276, DEPTH = 4, NMEM = 256;
constexpr int NCMP = 511, NCMP_PAD = 512;
constexpr int C_DSA_Q = 0, C_CKV = 256, C_IDXQ = 384, C_IDXK = 512, C_IDXW = 544, C_DSA_Z = 548,
              C_FOX_Q = 804, C_FOX_K = 1060, C_FOX_V = 1316, C_FOX_F = 1572, C_FOX_Z = 1576,
              C_SB_Q = 1832, C_SB_K = 2088, C_SB_V = 2344, C_SB_Z = 2600,
              C_NSA_Q = 2856, C_NSA_KC = 3112, C_NSA_VC = 3176, C_NSA_KS = 3240, C_NSA_VS = 3304, C_NSA_KW = 3368, C_NSA_VW = 3432,
              C_NSA_G = 3496, C_NSA_Z = 3508, C_MEM_Q = 3764, C_MEM_Z = 4020, C_MERGE = 4276;

typedef unsigned short bf16_t;
typedef short bf16x8 __attribute__((ext_vector_type(8)));
typedef float f32x16 __attribute__((ext_vector_type(16)));
typedef unsigned u32x4 __attribute__((ext_vector_type(4)));
typedef unsigned u32x2 __attribute__((ext_vector_type(2)));

constexpr int M_QA = 0, M_QN = 256, M_KSLC = 512, M_KWIN = 576, M_KC = 640, M_VC = 704, M_QF = 768, M_KF = 1024, M_QS = 1280, M_KSB = 1536, M_QM = 1792,
              M_VF = 2048, M_VS = 2304, M_VSLC = 2560, M_VWIN = 2624, M_QI = 2688, M_SPC = 2816, M_CKV = 2880, M_Z = 3008, NPM = 4288, M_MERGE = 4352, NP = 9472;
constexpr size_t al256(size_t x) { return (x + 255) & ~(size_t)255; }
constexpr size_t OFF_bar = 0;
constexpr size_t OFF_H = OFF_bar + al256((4096 + 64 * 8 + 64) * 4);
constexpr size_t OFF_Y = OFF_H + al256((size_t)T * D * 2);
constexpr size_t OFF_ZG = OFF_Y + al256((size_t)T * 1280 * 2);
constexpr size_t OFF_MG = OFF_ZG + al256((size_t)T * 1280 * 2);
constexpr size_t OFF_SIG = OFF_MG + al256((size_t)T * D * 2);
constexpr size_t OFF_CKVR = OFF_SIG + al256((size_t)T * 5120 * 2);
constexpr size_t OFF_CKV = OFF_CKVR + al256((size_t)T * 128 * 4);
constexpr size_t OFF_LOGF = OFF_CKV + al256((size_t)T * 128 * 2);
constexpr size_t OFF_CUM = OFF_LOGF + al256((size_t)T * 4 * 4);
constexpr size_t OFF_CUMT = OFF_CUM + al256((size_t)T * 4 * 4);
constexpr size_t OFF_WI = OFF_CUMT + al256((size_t)T * 4 * 4);
constexpr size_t OFF_GN = OFF_WI + al256((size_t)T * 4 * 4);
constexpr size_t OFF_KCT = OFF_GN + al256((size_t)T * 12 * 4);
constexpr size_t OFF_VCTOK = OFF_KCT + al256(((size_t)T * 64 + 2048) * 2);
constexpr size_t OFF_HIDK = OFF_VCTOK + al256(((size_t)T * 64 + 2048) * 2);
constexpr size_t OFF_HIDV = OFF_HIDK + al256((size_t)1024 * 128 * 2);
constexpr size_t OFF_KCB = OFF_HIDV + al256((size_t)1024 * 128 * 2);
constexpr size_t OFF_VCT = OFF_KCB + al256((size_t)NBATCH * NCMP_PAD * 64 * 2);
constexpr size_t OFF_QI = OFF_VCT + al256((size_t)NBATCH * NCMP_PAD * 64 * 2);
constexpr size_t OFF_KI = OFF_QI + al256((size_t)T * 128 * 2);
constexpr size_t OFF_MEMN = OFF_KI + al256((size_t)T * 32 * 2);
constexpr size_t OFF_ROPE = OFF_MEMN + al256((size_t)NBATCH * NMEM * D * 2);
constexpr size_t OFF_DMASK = OFF_ROPE + al256((size_t)T * 64 * 4);
constexpr size_t OFF_SMASK = OFF_DMASK + al256((size_t)T * 256 * 4);
constexpr size_t OFF_QA = OFF_SMASK + al256((size_t)T * 4 * 4);
constexpr size_t OFF_KAB = OFF_QA + al256((size_t)T * 256 * 2);
constexpr size_t OFF_VAT = OFF_KAB + al256((size_t)T * 256 * 2);
constexpr size_t OFF_QF = OFF_VAT + al256((size_t)T * 256 * 2);
constexpr size_t OFF_KF = OFF_QF + al256((size_t)T * 256 * 2);
constexpr size_t OFF_VFT = OFF_KF + al256((size_t)T * 256 * 2);
constexpr size_t OFF_QS = OFF_VFT + al256((size_t)T * 256 * 2);
constexpr size_t OFF_KSB = OFF_QS + al256((size_t)T * 256 * 2);
constexpr size_t OFF_VST = OFF_KSB + al256((size_t)T * 256 * 2);
constexpr size_t OFF_QN = OFF_VST + al256((size_t)T * 256 * 2);
constexpr size_t OFF_QM = OFF_QN + al256((size_t)T * 256 * 2);
constexpr size_t OFF_KSLC = OFF_QM + al256((size_t)T * 256 * 2);
constexpr size_t OFF_VSLCT = OFF_KSLC + al256((size_t)T * 64 * 2);
constexpr size_t OFF_KWIN = OFF_VSLCT + al256((size_t)T * 64 * 2);
constexpr size_t OFF_VWINT = OFF_KWIN + al256((size_t)T * 64 * 2);
constexpr size_t OFF_MKB = OFF_VWINT + al256((size_t)T * 64 * 2);
constexpr size_t OFF_MVT = OFF_MKB + al256((size_t)NBATCH * NMEM * 256 * 2);
constexpr size_t OFF_WIN = OFF_MVT + al256((size_t)NBATCH * NMEM * 256 * 2);
constexpr size_t OFF_WBR = OFF_WIN + al256((size_t)2 * NP * D * 2);
constexpr size_t OFF_WOUT = OFF_WBR + al256((size_t)DEPTH * 5 * D * 256 * 2);
constexpr size_t OFF_WMKV = OFF_WOUT + al256((size_t)DEPTH * D * D * 2);
constexpr size_t OFF_WUK = OFF_WMKV + al256((size_t)DEPTH * 512 * D * 2);
constexpr size_t OFF_WUV = OFF_WUK + al256((size_t)DEPTH * 256 * 128 * 2);
constexpr size_t OFF_WC1T = OFF_WUV + al256((size_t)DEPTH * 256 * 128 * 2);
constexpr size_t OFF_WC2T = OFF_WC1T + al256((size_t)DEPTH * 2 * 128 * 2048 * 2);
constexpr size_t OFF_BIASC = OFF_WC2T + al256((size_t)DEPTH * 2 * 64 * 128 * 2);
constexpr size_t WS_TOTAL = OFF_BIASC + al256((size_t)DEPTH * 2 * 128 * 4);

__device__ __forceinline__ int map_in_col(int n) {
    constexpr int seg[27][3] = {{0, 256, M_QA}, {256, 128, M_CKV}, {384, 128, M_QI}, {512, 32, M_SPC}, {544, 4, M_SPC + 32}, {548, 256, M_Z}, {804, 256, M_QF}, {1060, 256, M_KF},
        {1316, 256, M_VF}, {1572, 4, M_SPC + 36}, {1576, 256, M_Z + 256}, {1832, 256, M_QS}, {2088, 256, M_KSB}, {2344, 256, M_VS}, {2600, 256, M_Z + 512}, {2856, 256, M_QN},
        {3112, 64, M_KC}, {3176, 64, M_VC}, {3240, 64, M_KSLC}, {3304, 64, M_VSLC}, {3368, 64, M_KWIN}, {3432, 64, M_VWIN}, {3496, 12, M_SPC + 40}, {3508, 256, M_Z + 768},
        {3764, 256, M_QM}, {4020, 256, M_Z + 1024}, {4276, 5120, M_MERGE}};
    int r = 0;
#pragma unroll
    for (int i = 0; i < 27; ++i) r = (n >= seg[i][0] && n < seg[i][0] + seg[i][1]) ? (seg[i][2] + n - seg[i][0]) : r;
    return r;
}
struct Params {
    const float* x; const float* mem; const int* pos; const float* norm_g; const float* w_in; const float* kv_norm;
    const float* w_uk; const float* w_uv; const float* fox_bias; const float* pe_k; const float* pe_v;
    const float* wc1_k; const float* wc2_k; const float* wc1_v; const float* wc2_v; const float* mem_norm;
    const float* w_mem_kv; const float* w_branch; const float* w_out; const float* final_norm;
    float* X; char* ws;
    __device__ __forceinline__ unsigned* bar() const { return (unsigned*)(ws + OFF_bar); }
    __device__ __forceinline__ bf16_t* H() const { return (bf16_t*)(ws + OFF_H); }
    __device__ __forceinline__ bf16_t* Y() const { return (bf16_t*)(ws + OFF_Y); }
    __device__ __forceinline__ bf16_t* ZG() const { return (bf16_t*)(ws + OFF_ZG); }
    __device__ __forceinline__ bf16_t* MG() const { return (bf16_t*)(ws + OFF_MG); }
    __device__ __forceinline__ bf16_t* SIG() const { return (bf16_t*)(ws + OFF_SIG); }
    __device__ __forceinline__ float* CKVR() const { return (float*)(ws + OFF_CKVR); }
    __device__ __forceinline__ bf16_t* CKV() const { return (bf16_t*)(ws + OFF_CKV); }
    __device__ __forceinline__ float* LOGF() const { return (float*)(ws + OFF_LOGF); }
    __device__ __forceinline__ float* CUM() const { return (float*)(ws + OFF_CUM); }
    __device__ __forceinline__ float* CUMT() const { return (float*)(ws + OFF_CUMT); }
    __device__ __forceinline__ float* WI() const { return (float*)(ws + OFF_WI); }
    __device__ __forceinline__ float* GN() const { return (float*)(ws + OFF_GN); }
    __device__ __forceinline__ bf16_t* KCT() const { return (bf16_t*)(ws + OFF_KCT); }
    __device__ __forceinline__ bf16_t* VCTOK() const { return (bf16_t*)(ws + OFF_VCTOK); }
    __device__ __forceinline__ bf16_t* HIDK() const { return (bf16_t*)(ws + OFF_HIDK); }
    __device__ __forceinline__ bf16_t* HIDV() const { return (bf16_t*)(ws + OFF_HIDV); }
    __device__ __forceinline__ bf16_t* KCB() const { return (bf16_t*)(ws + OFF_KCB); }
    __device__ __forceinline__ bf16_t* VCT() const { return (bf16_t*)(ws + OFF_VCT); }
    __device__ __forceinline__ bf16_t* QI() const { return (bf16_t*)(ws + OFF_QI); }
    __device__ __forceinline__ bf16_t* KI() const { return (bf16_t*)(ws + OFF_KI); }
    __device__ __forceinline__ bf16_t* MEMN() const { return (bf16_t*)(ws + OFF_MEMN); }
    __device__ __forceinline__ float* ROPE() const { return (float*)(ws + OFF_ROPE); }
    __device__ __forceinline__ unsigned* DMASK() const { return (unsigned*)(ws + OFF_DMASK); }
    __device__ __forceinline__ unsigned* SMASK() const { return (unsigned*)(ws + OFF_SMASK); }
    __device__ __forceinline__ bf16_t* QA() const { return (bf16_t*)(ws + OFF_QA); }
    __device__ __forceinline__ bf16_t* KAB() const { return (bf16_t*)(ws + OFF_KAB); }
    __device__ __forceinline__ bf16_t* VAT() const { return (bf16_t*)(ws + OFF_VAT); }
    __device__ __forceinline__ bf16_t* QF() const { return (bf16_t*)(ws + OFF_QF); }
    __device__ __forceinline__ bf16_t* KF() const { return (bf16_t*)(ws + OFF_KF); }
    __device__ __forceinline__ bf16_t* VFT() const { return (bf16_t*)(ws + OFF_VFT); }
    __device__ __forceinline__ bf16_t* QS() const { return (bf16_t*)(ws + OFF_QS); }
    __device__ __forceinline__ bf16_t* KSB() const { return (bf16_t*)(ws + OFF_KSB); }
    __device__ __forceinline__ bf16_t* VST() const { return (bf16_t*)(ws + OFF_VST); }
    __device__ __forceinline__ bf16_t* QN() const { return (bf16_t*)(ws + OFF_QN); }
    __device__ __forceinline__ bf16_t* QM() const { return (bf16_t*)(ws + OFF_QM); }
    __device__ __forceinline__ bf16_t* KSLC() const { return (bf16_t*)(ws + OFF_KSLC); }
    __device__ __forceinline__ bf16_t* VSLCT() const { return (bf16_t*)(ws + OFF_VSLCT); }
    __device__ __forceinline__ bf16_t* KWIN() const { return (bf16_t*)(ws + OFF_KWIN); }
    __device__ __forceinline__ bf16_t* VWINT() const { return (bf16_t*)(ws + OFF_VWINT); }
    __device__ __forceinline__ bf16_t* MKB() const { return (bf16_t*)(ws + OFF_MKB); }
    __device__ __forceinline__ bf16_t* MVT() const { return (bf16_t*)(ws + OFF_MVT); }
    __device__ __forceinline__ bf16_t* WIN(int l) const { return (bf16_t*)(ws + OFF_WIN) + (size_t)(l & 1) * NP * D; }
    __device__ __forceinline__ bf16_t* WBR() const { return (bf16_t*)(ws + OFF_WBR); }
    __device__ __forceinline__ bf16_t* WOUT() const { return (bf16_t*)(ws + OFF_WOUT); }
    __device__ __forceinline__ bf16_t* WMKV() const { return (bf16_t*)(ws + OFF_WMKV); }
    __device__ __forceinline__ bf16_t* WUK() const { return (bf16_t*)(ws + OFF_WUK); }
    __device__ __forceinline__ bf16_t* WUV() const { return (bf16_t*)(ws + OFF_WUV); }
    __device__ __forceinline__ bf16_t* WC1T() const { return (bf16_t*)(ws + OFF_WC1T); }
    __device__ __forceinline__ bf16_t* WC2T() const { return (bf16_t*)(ws + OFF_WC2T); }
    __device__ __forceinline__ float* BIASC() const { return (float*)(ws + OFF_BIASC); }
    __device__ __forceinline__ unsigned* qctr() const { return (unsigned*)(ws + OFF_bar) + 4096; }
};

typedef __bf16 bf16x2_t __attribute__((ext_vector_type(2)));
__device__ __forceinline__ unsigned cvt_pk_bf16(float lo, float hi) { bf16x2_t v; v.x = (__bf16)lo; v.y = (__bf16)hi; return __builtin_bit_cast(unsigned, v); }
__device__ __forceinline__ bf16_t f2bf(float x) { return (bf16_t)(cvt_pk_bf16(x, 0.f) & 0xffffu); }
__device__ __forceinline__ unsigned xb_ld(unsigned* p)              { return __hip_atomic_load(p, __ATOMIC_RELAXED, __HIP_MEMORY_SCOPE_AGENT); }
__device__ __forceinline__ unsigned xb_add(unsigned* p, unsigned v) { return __hip_atomic_fetch_add(p, v, __ATOMIC_RELAXED, __HIP_MEMORY_SCOPE_AGENT); }
__device__ __forceinline__ unsigned xb_xcc_id() { return (unsigned)__builtin_amdgcn_s_getreg((3 << 11) | 20) & 0xFu; }
constexpr int XRANK_BASE = 3500;
__device__ __forceinline__ int tidx() { int t = threadIdx.x; asm volatile("" : "+v"(t)); return t; }
__device__ __forceinline__ float sigmoid_(float x) { return __builtin_amdgcn_rcpf(1.f + __builtin_amdgcn_exp2f(-1.4426950408889634f * x)); }
__device__ __forceinline__ float silu_(float x) { return x * __builtin_amdgcn_rcpf(1.f + __builtin_amdgcn_exp2f(-1.4426950408889634f * x)); }
__device__ __forceinline__ float logsig_(float x) { return fminf(x, 0.f) - log1pf(expf(-fabsf(x))); }
__device__ __forceinline__ float wave_sum(float v) {
#pragma unroll
    for (int o = 32; o > 0; o >>= 1) v += __shfl_xor(v, o, 64);
    return v;
}
__device__ __forceinline__ float wave_max(float v) {
#pragma unroll
    for (int o = 32; o > 0; o >>= 1) v = fmaxf(v, __shfl_xor(v, o, 64));
    return v;
}

__device__ __forceinline__ void ph_rope_table(const Params& p, int bid, int nb) {
    for (int i = bid * 256 + tidx(); i < T * 32; i += nb * 256) {
        const int t = i >> 5, f = i & 31;
        const double inv = pow(10000.0, -(double)f / 32.0);
        const double ang = (double)p.pos[t] * inv;
        p.ROPE()[(size_t)t * 64 + f] = (float)cos(ang);
        p.ROPE()[(size_t)t * 64 + 32 + f] = (float)sin(ang);
    }
}

template <class OUT>
__device__ __forceinline__ void ph_rmsnorm(const float* in, const float* g, OUT* out, int rows, int bid, int nb, float dscale = 1.0f) {
    const int lane = tidx() & 63, wid = tidx() >> 6;
    for (int r = bid * 4 + wid; r < rows; r += nb * 4) {
        const float4* ip = (const float4*)(in + (size_t)r * D);
        float4 v[4]; float ss = 0.f;
#pragma unroll
        for (int i = 0; i < 4; ++i) { v[i] = ip[lane + 64 * i]; ss += v[i].x * v[i].x + v[i].y * v[i].y + v[i].z * v[i].z + v[i].w * v[i].w; }
        ss = wave_sum(ss);
        const float sc = dscale / sqrtf(ss * (1.f / D) + 1e-6f);
#pragma unroll
        for (int i = 0; i < 4; ++i) {
            const float4 gg = ((const float4*)g)[lane + 64 * i];
            float4 o; o.x = v[i].x * sc * gg.x; o.y = v[i].y * sc * gg.y; o.z = v[i].z * sc * gg.z; o.w = v[i].w * sc * gg.w;
            if constexpr (sizeof(OUT) == 4) ((float4*)((float*)out + (size_t)r * D))[lane + 64 * i] = o;
            else { u32x2 w; w.x = cvt_pk_bf16(o.x, o.y); w.y = cvt_pk_bf16(o.z, o.w); ((u32x2*)((bf16_t*)out + (size_t)r * D))[lane + 64 * i] = w; }
        }
    }
}

__device__ __forceinline__ void ph_ckvnorm(const Params& p, int layer, int bid, int nb) {
    const int lane = tidx() & 63, wid = tidx() >> 6;
    const float* g = p.kv_norm + layer * 128;
    for (int r = bid * 4 + wid; r < T; r += nb * 4) {
        const float* ip = p.CKVR() + (size_t)r * 128;
        const float a = ip[lane], b = ip[lane + 64];
        const float ss = wave_sum(a * a + b * b);
        const float sc = 1.0f / sqrtf(ss * (1.f / 128.f) + 1e-6f);
        p.CKV()[(size_t)r * 128 + lane] = f2bf(a * sc * g[lane]);
        p.CKV()[(size_t)r * 128 + lane + 64] = f2bf(b * sc * g[lane + 64]);
    }
}

template <bool MAPIN = false>
__device__ __forceinline__ void convert_wt_range(const float* __restrict__ src, bf16_t* __restrict__ dst, int K, int N, int nmat, int it0, int it1, int nstep, float* sm) {
    float (*tl)[65] = (float (*)[65])sm;
    const int tid = tidx(), tk = K / 64, tn = (N + 63) / 64, per = tk * tn;
    for (int it = it0; it < it1 && it < per * nmat; it += nstep) {
        const int mat = it / per, r = it % per, k0 = (r % tk) * 64, n0 = (r / tk) * 64;
        const float* s = src + (size_t)mat * K * N; bf16_t* d = dst + (size_t)mat * K * N;
        __syncthreads();
        for (int i = tid; i < 64 * 64; i += 256) { const int kk = i >> 6, nn = i & 63; tl[kk][nn] = (n0 + nn < N) ? s[(size_t)(k0 + kk) * N + n0 + nn] : 0.f; }
        __syncthreads();
        {
            const int nn = tid >> 2, kq = (tid & 3) * 16;
            if (n0 + nn < N) {
                u32x4 w0, w1;
                w0.x = cvt_pk_bf16(tl[kq + 0][nn], tl[kq + 1][nn]); w0.y = cvt_pk_bf16(tl[kq + 2][nn], tl[kq + 3][nn]);
                w0.z = cvt_pk_bf16(tl[kq + 4][nn], tl[kq + 5][nn]); w0.w = cvt_pk_bf16(tl[kq + 6][nn], tl[kq + 7][nn]);
                w1.x = cvt_pk_bf16(tl[kq + 8][nn], tl[kq + 9][nn]); w1.y = cvt_pk_bf16(tl[kq + 10][nn], tl[kq + 11][nn]);
                w1.z = cvt_pk_bf16(tl[kq + 12][nn], tl[kq + 13][nn]); w1.w = cvt_pk_bf16(tl[kq + 14][nn], tl[kq + 15][nn]);
                const int drow = MAPIN ? map_in_col(n0 + nn) : (n0 + nn);
                u32x4* dp = (u32x4*)(d + (size_t)drow * K + k0 + kq);
                dp[0] = w0; dp[1] = w1;
            }
        }
    }
    __syncthreads();
}
template <bool MAPIN = false>
__device__ __forceinline__ void convert_wt(const float* __restrict__ src, bf16_t* __restrict__ dst, int K, int N, int nmat, int bid, int nb, float* sm) {
    convert_wt_range<MAPIN>(src, dst, K, N, nmat, bid, 1 << 30, nb, sm);
}

constexpr int GROW = 80;
constexpr int GA_BYTES = 128 * GROW;
struct GStage { u32x4 a0, a1, b0, b1; };
template <int BN, int DEPTH = 3>
__device__ __forceinline__ void tile_mac(f32x16 (&acc)[2][BN / 64], const bf16_t* __restrict__ A, int lda, int m0,
                                         const bf16_t* __restrict__ Bt, int ldb, int n0, int nmax, int K, char* sm) {
    constexpr int NT = BN / 64;
    constexpr int B_BYTES = BN * GROW;
    constexpr int BUF = GA_BYTES + B_BYTES;
    const int tid = tidx(), lane = tid & 63, wid = __builtin_amdgcn_readfirstlane(tid >> 6), wr = wid >> 1, wc = wid & 1;
    const int lr = lane & 31, lh = lane >> 5;
    const int ar0 = tid >> 2, akq = tid & 3;
    const bf16_t* Ab = A + (size_t)m0 * lda;
    const bf16_t* Bb = Bt + (size_t)n0 * ldb;
    const unsigned ao0 = (unsigned)(ar0 * lda + akq * 8), ao1 = ao0 + (unsigned)(64 * lda);
    const int br0 = tid >> 2;
    const bool bv0 = (n0 + br0) < nmax, bv1 = (NT == 2) && ((n0 + br0 + 64) < nmax);
    const unsigned bo0 = (unsigned)((bv0 ? br0 : 0) * ldb + akq * 8), bo1 = (unsigned)((bv1 ? br0 + 64 : 0) * ldb + akq * 8);
    const int st_a0 = ar0 * GROW + akq * 16, st_a1 = (ar0 + 64) * GROW + akq * 16;
    const int st_b0 = GA_BYTES + br0 * GROW + akq * 16, st_b1 = GA_BYTES + (br0 + 64) * GROW + akq * 16;
    const int rd_a = (wr * 64 + lr) * GROW + lh * 16, rd_b = GA_BYTES + (wc * (BN / 2) + lr) * GROW + lh * 16;
    const u32x4 zero4 = {0u, 0u, 0u, 0u};
    const int nk = K / 32;
    auto gload = [&](GStage& g, int ks) {
        const unsigned ko = (unsigned)ks * 32u;
        g.a0 = *(const u32x4*)(Ab + (ao0 + ko)); g.a1 = *(const u32x4*)(Ab + (ao1 + ko));
        g.b0 = *(const u32x4*)(Bb + (bo0 + ko)); if (NT == 2) g.b1 = *(const u32x4*)(Bb + (bo1 + ko));
    };
    auto lstore = [&](const GStage& g, char* buf) {
        *(u32x4*)(buf + st_a0) = g.a0; *(u32x4*)(buf + st_a1) = g.a1;
        *(u32x4*)(buf + st_b0) = bv0 ? g.b0 : zero4; if (NT == 2) *(u32x4*)(buf + st_b1) = bv1 ? g.b1 : zero4;
    };
    auto compute = [&](const char* cur) {
#pragma unroll
        for (int s = 0; s < 2; ++s) {
            bf16x8 a[2], b[NT];
#pragma unroll
            for (int mi = 0; mi < 2; ++mi) a[mi] = *(const bf16x8*)(cur + rd_a + mi * 32 * GROW + s * 32);
#pragma unroll
            for (int ni = 0; ni < NT; ++ni) b[ni] = *(const bf16x8*)(cur + rd_b + ni * 32 * GROW + s * 32);
#pragma unroll
            for (int mi = 0; mi < 2; ++mi)
#pragma unroll
                for (int ni = 0; ni < NT; ++ni) acc[mi][ni] = __builtin_amdgcn_mfma_f32_32x32x16_bf16(a[mi], b[ni], acc[mi][ni], 0, 0, 0);
        }
    };
    GStage g0, g1, g2;
    g1.b1 = zero4; g2.b1 = zero4; g0.b1 = zero4;
    const int last = nk - 1;
    gload(g0, 0);
    gload(g1, min(1, last));
    if (DEPTH == 3) gload(g2, min(2, last));
    __syncthreads();
    lstore(g0, sm);
    __syncthreads();
#define GSTEP(k, GL, GS) { gload(GL, min((k) + DEPTH, last)); compute(sm + ((k) & 1) * BUF); lstore(GS, sm + (((k) + 1) & 1) * BUF); __syncthreads(); }
    int ks = 0;
    if (DEPTH == 3) {
#pragma unroll 1
        for (; ks + 3 <= nk; ks += 3) {
            GSTEP(ks, g0, g1)
            GSTEP(ks + 1, g1, g2)
            GSTEP(ks + 2, g2, g0)
        }
        if (ks < nk) {
            GSTEP(ks, g0, g1)
            if (ks + 1 < nk) GSTEP(ks + 1, g1, g2)
        }
    } else if (DEPTH == 2) {
#pragma unroll 1
        for (; ks + 2 <= nk; ks += 2) {
            GSTEP(ks, g0, g1)
            GSTEP(ks + 1, g1, g0)
        }
        if (ks < nk) GSTEP(ks, g0, g1)
    } else {
#pragma unroll 1
        for (; ks < nk; ++ks) GSTEP(ks, g1, g1)
    }
#undef GSTEP
}
constexpr int DMA_STAGE = 16384, GEMM_NST = 3;
#define DMA_WAIT(n) asm volatile("s_waitcnt vmcnt(" #n ")" ::: "memory")
template <int NST>
__device__ __forceinline__ void tile_mac_dma(f32x16 (&acc)[2][2], const bf16_t* __restrict__ A, int lda, int m0,
                                             const bf16_t* __restrict__ Bt, int ldb, int n0, int K, char* sm) {
    static_assert(NST == 3 || NST == 4, "ring of 3 or 4 stages");
    const int tid = tidx(), lane = tid & 63, wid = __builtin_amdgcn_readfirstlane(tid >> 6), wr = wid >> 1, wc = wid & 1;
    const int lr = lane & 31, lh = lane >> 5;
    const int srow = tid >> 2, sslot = tid & 3, schunk = sslot ^ ((srow >> 2) & 3);
    const bf16_t* Ab = A + (size_t)m0 * lda;
    const bf16_t* Bb = Bt + (size_t)n0 * ldb;
    const unsigned ao0 = (unsigned)(srow * lda + schunk * 8), ao1 = ao0 + (unsigned)(64 * lda);
    const unsigned bo0 = (unsigned)(srow * ldb + schunk * 8), bo1 = bo0 + (unsigned)(64 * ldb);
    const int ldst = tid * 16;
    const int sw = (lr >> 2) & 3;
    const int rd_a = (wr * 64 + lr) * 64, rd_b = 8192 + (wc * 64 + lr) * 64;
    const int so0 = ((lh) ^ sw) * 16, so1 = ((lh + 2) ^ sw) * 16;
    const int nk = K / 32, last = nk - 1;
    auto issue = [&](int ks, int slot) {
        const unsigned ko = (unsigned)ks * 32u;
        char* st = sm + slot * DMA_STAGE + ldst;
        __builtin_amdgcn_global_load_lds((const unsigned*)(Ab + (ao0 + ko)), (unsigned*)(st), 16, 0, 0);
        __builtin_amdgcn_global_load_lds((const unsigned*)(Ab + (ao1 + ko)), (unsigned*)(st + 4096), 16, 0, 0);
        __builtin_amdgcn_global_load_lds((const unsigned*)(Bb + (bo0 + ko)), (unsigned*)(st + 8192), 16, 0, 0);
        __builtin_amdgcn_global_load_lds((const unsigned*)(Bb + (bo1 + ko)), (unsigned*)(st + 12288), 16, 0, 0);
    };
    auto compute = [&](int slot) {
        const char* cur = sm + slot * DMA_STAGE;
        bf16x8 a[2][2], b[2][2];
#pragma unroll
        for (int mi = 0; mi < 2; ++mi) { a[mi][0] = *(const bf16x8*)(cur + rd_a + mi * 2048 + so0); a[mi][1] = *(const bf16x8*)(cur + rd_a + mi * 2048 + so1); }
#pragma unroll
        for (int ni = 0; ni < 2; ++ni) { b[ni][0] = *(const bf16x8*)(cur + rd_b + ni * 2048 + so0); b[ni][1] = *(const bf16x8*)(cur + rd_b + ni * 2048 + so1); }
#pragma unroll
        for (int s = 0; s < 2; ++s)
#pragma unroll
            for (int mi = 0; mi < 2; ++mi)
#pragma unroll
                for (int ni = 0; ni < 2; ++ni) acc[mi][ni] = __builtin_amdgcn_mfma_f32_32x32x16_bf16(a[mi][s], b[ni][s], acc[mi][ni], 0, 0, 0);
    };
    __syncthreads();
#pragma unroll
    for (int s = 0; s < NST - 1; ++s) issue(min(s, last), s);
    int slot = 0, nslot = NST - 1;
#pragma unroll 1
    for (int ks = 0; ks < nk; ++ks) {
        if (NST == 3) DMA_WAIT(4); else DMA_WAIT(8);
        __builtin_amdgcn_s_barrier();
        issue(min(ks + NST - 1, last), nslot);
        compute(slot);
        slot = (slot + 1 == NST) ? 0 : slot + 1; nslot = (nslot + 1 == NST) ? 0 : nslot + 1;
    }
    DMA_WAIT(0);
}
__device__ __forceinline__ void tile_mac_dma64(f32x16 (&acc)[2][2], const bf16_t* __restrict__ A, int lda, int m0,
                                               const bf16_t* __restrict__ Bt, int ldb, int n0, int K, char* sm) {
    constexpr int STG = 32768;
    const int tid = tidx(), lane = tid & 63, wid = __builtin_amdgcn_readfirstlane(tid >> 6), wr = wid >> 1, wc = wid & 1;
    const int lr = lane & 31, lh = lane >> 5;
    const int srow = tid >> 3, schunk = (tid & 7) ^ ((tid >> 4) & 7);
    const bf16_t* Ab = A + (size_t)m0 * lda;
    const bf16_t* Bb = Bt + (size_t)n0 * ldb;
    const unsigned ao = (unsigned)(srow * lda + schunk * 8), bo = (unsigned)(srow * ldb + schunk * 8);
    const unsigned a32 = (unsigned)(32 * lda), b32 = (unsigned)(32 * ldb);
    const int ldst = tid * 16;
    const int sw = (lr >> 1) & 7;
    const int rd_a = (wr * 64 + lr) * 128, rd_b = 16384 + (wc * 64 + lr) * 128;
    const int nk = K / 64, last = nk - 1;
    auto issue = [&](int ks, int slot) {
        const unsigned ko = (unsigned)ks * 64u;
        char* st = sm + slot * STG + ldst;
#pragma unroll
        for (int i = 0; i < 4; ++i) __builtin_amdgcn_global_load_lds((const unsigned*)(Ab + (ao + i * a32 + ko)), (unsigned*)(st + i * 4096), 16, 0, 0);
#pragma unroll
        for (int i = 0; i < 4; ++i) __builtin_amdgcn_global_load_lds((const unsigned*)(Bb + (bo + i * b32 + ko)), (unsigned*)(st + 16384 + i * 4096), 16, 0, 0);
    };
    auto compute = [&](int slot) {
        const char* cur = sm + slot * STG;
#pragma unroll
        for (int s = 0; s < 4; ++s) {
            const int so = ((lh + 2 * s) ^ sw) * 16;
            bf16x8 a[2], b[2];
#pragma unroll
            for (int mi = 0; mi < 2; ++mi) a[mi] = *(const bf16x8*)(cur + rd_a + mi * 4096 + so);
#pragma unroll
            for (int ni = 0; ni < 2; ++ni) b[ni] = *(const bf16x8*)(cur + rd_b + ni * 4096 + so);
#pragma unroll
            for (int mi = 0; mi < 2; ++mi)
#pragma unroll
                for (int ni = 0; ni < 2; ++ni) acc[mi][ni] = __builtin_amdgcn_mfma_f32_32x32x16_bf16(a[mi], b[ni], acc[mi][ni], 0, 0, 0);
        }
    };
    __syncthreads();
    issue(0, 0);
#pragma unroll 1
    for (int ks = 0; ks < nk; ++ks) {
        DMA_WAIT(0);
        __builtin_amdgcn_s_barrier();
        if (ks < last) issue(ks + 1, (ks + 1) & 1);
#if defined(GEMM_EXP) && GEMM_EXP == 5
        issue(min(ks + 1, last), (ks + 1) & 1);
#endif
        compute(ks & 1);
#if defined(GEMM_EXP) && GEMM_EXP == 4
        { f32x16 (&keep)[2][2] = acc; f32x16 dummy[2][2]; for (int i_ = 0; i_ < 16; ++i_) { dummy[0][0][i_] = 0.f; dummy[0][1][i_] = 0.f; dummy[1][0][i_] = 0.f; dummy[1][1][i_] = 0.f; }
          auto compute2 = [&](int slot) {
              const char* cur = sm + slot * STG;
#pragma unroll
              for (int s = 0; s < 4; ++s) {
                  const int so = ((lh + 2 * s) ^ sw) * 16;
                  bf16x8 a[2], b[2];
#pragma unroll
                  for (int mi = 0; mi < 2; ++mi) a[mi] = *(const bf16x8*)(cur + rd_a + mi * 4096 + so);
#pragma unroll
                  for (int ni = 0; ni < 2; ++ni) b[ni] = *(const bf16x8*)(cur + rd_b + ni * 4096 + so);
#pragma unroll
                  for (int mi = 0; mi < 2; ++mi)
#pragma unroll
                      for (int ni = 0; ni < 2; ++ni) dummy[mi][ni] = __builtin_amdgcn_mfma_f32_32x32x16_bf16(a[mi], b[ni], dummy[mi][ni], 0, 0, 0);
              }
          };
          compute2(ks & 1);
#pragma unroll
          for (int mi = 0; mi < 2; ++mi)
#pragma unroll
              for (int ni = 0; ni < 2; ++ni) asm volatile("" :: "v"(dummy[mi][ni]));
          (void)keep; }
#endif
    }
    DMA_WAIT(0);
}
struct GStage64 { u32x4 a[4], b[4]; };
__device__ __forceinline__ void tile_mac_reg64(f32x16 (&acc)[2][2], const bf16_t* __restrict__ A, int lda, int m0,
                                               const bf16_t* __restrict__ Bt, int ldb, int n0, int K, char* sm) {
    constexpr int STG = 32768;
    const int tid = tidx(), lane = tid & 63, wid = __builtin_amdgcn_readfirstlane(tid >> 6), wr = wid >> 1, wc = wid & 1;
    const int lr = lane & 31, lh = lane >> 5;
    const int srow = tid >> 3, schunk = (tid & 7) ^ ((tid >> 4) & 7);
    const bf16_t* Ab = A + (size_t)m0 * lda;
    const bf16_t* Bb = Bt + (size_t)n0 * ldb;
    const unsigned ao = (unsigned)(srow * lda + schunk * 8), bo = (unsigned)(srow * ldb + schunk * 8);
    const unsigned a32 = (unsigned)(32 * lda), b32 = (unsigned)(32 * ldb);
    const int ldst = tid * 16;
    const int sw = (lr >> 1) & 7;
    const int rd_a = (wr * 64 + lr) * 128, rd_b = 16384 + (wc * 64 + lr) * 128;
    const int nk = K / 64, last = nk - 1;
    auto gload = [&](GStage64& g, int ks) {
        const unsigned ko = (unsigned)ks * 64u;
#pragma unroll
        for (int i = 0; i < 4; ++i) { g.a[i] = *(const u32x4*)(Ab + (ao + i * a32 + ko)); g.b[i] = *(const u32x4*)(Bb + (bo + i * b32 + ko)); }
    };
    auto lstore = [&](const GStage64& g, int slot) {
        char* st = sm + slot * STG + ldst;
#pragma unroll
        for (int i = 0; i < 4; ++i) { *(u32x4*)(st + i * 4096) = g.a[i]; *(u32x4*)(st + 16384 + i * 4096) = g.b[i]; }
    };
    auto compute = [&](int slot) {
        const char* cur = sm + slot * STG;
        bf16x8 fa[2][2], fb[2][2];
#pragma unroll
        for (int mi = 0; mi < 2; ++mi) fa[0][mi] = *(const bf16x8*)(cur + rd_a + mi * 4096 + ((lh ^ sw) * 16));
#pragma unroll
        for (int ni = 0; ni < 2; ++ni) fb[0][ni] = *(const bf16x8*)(cur + rd_b + ni * 4096 + ((lh ^ sw) * 16));
#pragma unroll
        for (int s = 0; s < 4; ++s) {
            if (s < 3) {
                const int so = ((lh + 2 * (s + 1)) ^ sw) * 16;
#pragma unroll
                for (int mi = 0; mi < 2; ++mi) fa[(s + 1) & 1][mi] = *(const bf16x8*)(cur + rd_a + mi * 4096 + so);
#pragma unroll
                for (int ni = 0; ni < 2; ++ni) fb[(s + 1) & 1][ni] = *(const bf16x8*)(cur + rd_b + ni * 4096 + so);
            }
#pragma unroll
            for (int mi = 0; mi < 2; ++mi)
#pragma unroll
                for (int ni = 0; ni < 2; ++ni) acc[mi][ni] = __builtin_amdgcn_mfma_f32_32x32x16_bf16(fa[s & 1][mi], fb[s & 1][ni], acc[mi][ni], 0, 0, 0);
        }
        __builtin_amdgcn_sched_group_barrier(0x100, 8, 0);
        __builtin_amdgcn_sched_group_barrier(0x008, 4, 0);
        __builtin_amdgcn_sched_group_barrier(0x100, 4, 0);
        __builtin_amdgcn_sched_group_barrier(0x008, 4, 0);
        __builtin_amdgcn_sched_group_barrier(0x100, 4, 0);
        __builtin_amdgcn_sched_group_barrier(0x008, 8, 0);
    };
    GStage64 g0, g1;
    gload(g0, 0);
    gload(g1, min(1, last));
    __syncthreads();
    lstore(g0, 0);
    __syncthreads();
#if defined(GEMM_EXP) && GEMM_EXP == 7
#define GSTEP64(k, GL, GS) { gload(GL, min((k) + 2, last)); asm volatile("" :: "v"(GL.a[0]), "v"(GL.b[3])); gload(GL, min((k) + 2, last)); compute((k) & 1); lstore(GS, ((k) + 1) & 1); __syncthreads(); }
#elif defined(GEMM_EXP) && GEMM_EXP == 8
#define GSTEP64(k, GL, GS) { gload(GL, min((k) + 2, last)); compute((k) & 1); lstore(GS, ((k) + 1) & 1); asm volatile("" ::: "memory"); lstore(GS, ((k) + 1) & 1); __syncthreads(); }
#elif defined(GEMM_EXP) && GEMM_EXP == 9
#define GSTEP64(k, GL, GS) { gload(GL, min((k) + 2, last)); compute((k) & 1); compute((k) & 1); lstore(GS, ((k) + 1) & 1); __syncthreads(); }
#else
#define GSTEP64(k, GL, GS) { gload(GL, min((k) + 2, last)); compute((k) & 1); lstore(GS, ((k) + 1) & 1); __syncthreads(); }
#endif
    int ks = 0;
#pragma unroll 1
    for (; ks + 2 <= nk; ks += 2) {
        GSTEP64(ks, g0, g1)
        GSTEP64(ks + 1, g1, g0)
    }
    if (ks < nk) GSTEP64(ks, g0, g1)
#undef GSTEP64
#if defined(GEMM_EXP) && GEMM_EXP == 9
#pragma unroll
    for (int mi = 0; mi < 2; ++mi)
#pragma unroll
        for (int ni = 0; ni < 2; ++ni)
#pragma unroll
            for (int r = 0; r < 16; ++r) acc[mi][ni][r] *= 0.5f;
#endif
}
template <int NT> __device__ __forceinline__ void acc_zero(f32x16 (&acc)[2][NT]) {
#pragma unroll
    for (int mi = 0; mi < 2; ++mi)
#pragma unroll
        for (int ni = 0; ni < NT; ++ni)
#pragma unroll
            for (int r = 0; r < 16; ++r) acc[mi][ni][r] = 0.f;
}
template <int BN, class Epi>
__device__ __forceinline__ void gemm_bf16(const bf16_t* A, int lda, const bf16_t* Bt, int ldb, int M, int N, int K, const Epi& epi, int bid, int nb, char* sm) {
    constexpr int NT = BN / 64;
    const int tm = M / 128, tn = (N + BN - 1) / BN;
    for (int tile = bid; tile < tm * tn; tile += nb) {
        const int m0 = (tile % tm) * 128, n0 = (tile / tm) * BN;
        f32x16 acc[2][NT]; acc_zero<NT>(acc);
        if constexpr (BN == 128) { if (K % 64 == 0 && K >= 128) tile_mac_reg64(acc, A, lda, m0, Bt, ldb, n0, K, sm); else tile_mac_dma<GEMM_NST>(acc, A, lda, m0, Bt, ldb, n0, K, sm); }
        else tile_mac<BN>(acc, A, lda, m0, Bt, ldb, n0, N, K, sm);
        const int lane = tidx() & 63, wid = __builtin_amdgcn_readfirstlane(tidx() >> 6), wr = wid >> 1, wc = wid & 1, lr = lane & 31, lh = lane >> 5;
        const int col0 = n0 + wc * (BN / 2);
        if (col0 < N) epi(acc, m0 + wr * 64, col0, lr, lh, sm + (((K / 64) & 1) ? 32768 : 0) + wid * 8192);
#if defined(GEMM_EXP) && GEMM_EXP == 6
        if (N == NP) epi(acc, m0 + wr * 64, col0, lr, lh, sm + (((K / 64) & 1) ? 32768 : 0) + wid * 8192);
#endif
    }
}
template <class Epi>
__device__ __forceinline__ void gemm_bf16_patch(const Params& p, const bf16_t* A, int lda, const bf16_t* Bt, int ldb, int M, int N, int K, const Epi& epi, char* sm) {
    const int lane = tidx() & 63, wid = __builtin_amdgcn_readfirstlane(tidx() >> 6), wr = wid >> 1, wc = wid & 1, lr = lane & 31, lh = lane >> 5;
    volatile unsigned* lw = (volatile unsigned*)(sm + 65536 + 36);
    __syncthreads();
    if (threadIdx.x == 0) {
        const unsigned x = xb_xcc_id(); unsigned nloc = 1, dense = 0, nx = 0;
        for (unsigned j = 0; j < 16; ++j) { const unsigned c = xb_ld(p.bar() + XRANK_BASE + j); if (j == x) nloc = c; if (c > 0) { if (j < x) ++dense; ++nx; } }
        lw[1] = nloc ? nloc : 1; lw[2] = dense; lw[3] = nx ? nx : 1;
    }
    __syncthreads();
    const int rank = __builtin_amdgcn_readfirstlane((int)lw[0]), nloc = __builtin_amdgcn_readfirstlane((int)lw[1]);
    const int dense = __builtin_amdgcn_readfirstlane((int)lw[2]), nx = __builtin_amdgcn_readfirstlane((int)lw[3]);
    const int tm = M / 128, tn = N / 128, npr = tm / 8, npc = (tn + 7) / 8;
    for (int pt = dense; pt < npr * npc; pt += nx) {
        const int pr = pt % npr, pc = pt / npr;
        for (int j = rank; j < 64; j += nloc) {
            const int mt = pr * 8 + (j & 7), nt = pc * 8 + (j >> 3);
            if (nt >= tn) continue;
            const int m0 = mt * 128, n0 = nt * 128;
            f32x16 acc[2][2]; acc_zero<2>(acc);
            tile_mac_dma64(acc, A, lda, m0, Bt, ldb, n0, K, sm);
            char* stg = sm + (((K / 64) & 1) ? 32768 : 0) + wid * 8192;
            epi(acc, m0 + wr * 64, n0 + wc * 64, lr, lh, stg);
#if defined(GEMM_EXP) && GEMM_EXP == 6
            epi(acc, m0 + wr * 64, n0 + wc * 64, lr, lh, stg);
#endif
        }
    }
}
#define EROW(mi, r) (row0 + (mi) * 32 + ((r) & 3) + 8 * ((r) >> 2) + 4 * lh)
__device__ __forceinline__ float bf2f(bf16_t h) { return __uint_as_float((unsigned)h << 16); }
__device__ __forceinline__ void epi_rope64(const f32x16 (&acc)[2][2], int row0, int lr, int lh, const float* __restrict__ rope, bf16_t* __restrict__ dst, int ld, int cbase) {
#pragma unroll
    for (int mi = 0; mi < 2; ++mi)
#pragma unroll
        for (int r = 0; r < 16; ++r) {
            const size_t row = EROW(mi, r);
            const float c = rope[row * 64 + lr], s = rope[row * 64 + 32 + lr], x1 = acc[mi][0][r], x2 = acc[mi][1][r];
            dst[row * ld + cbase + lr] = f2bf(x1 * c - x2 * s); dst[row * ld + cbase + 32 + lr] = f2bf(x2 * c + x1 * s);
        }
}
template <int NTI>
__device__ __forceinline__ void epi_rope32(const f32x16 (&acc)[2][2], int row0, int lr, int lh, const float* __restrict__ rope, bf16_t* __restrict__ dst, int ld, int cbase) {
    const int f = lr & 15;
#pragma unroll
    for (int mi = 0; mi < 2; ++mi)
#pragma unroll
        for (int ni = 0; ni < NTI; ++ni)
#pragma unroll
            for (int r = 0; r < 16; ++r) {
                const size_t row = EROW(mi, r);
                const float x = acc[mi][ni][r], xo = __shfl_xor(x, 16, 64);
                const float c = rope[row * 64 + 2 * f], s = rope[row * 64 + 32 + 2 * f];
                dst[row * ld + cbase + ni * 32 + lr] = f2bf((lr & 16) ? (x * c + xo * s) : (x * c - xo * s));
            }
}
template <int NT, bool SILU>
__device__ __forceinline__ void epi_bf16(const f32x16 (&acc)[2][NT], int row0, int lr, int lh, bf16_t* __restrict__ dst, int ld, int cbase) {
#pragma unroll
    for (int mi = 0; mi < 2; ++mi)
#pragma unroll
        for (int ni = 0; ni < NT; ++ni)
#pragma unroll
            for (int r = 0; r < 16; ++r) { const float v = acc[mi][ni][r]; dst[(size_t)EROW(mi, r) * ld + cbase + ni * 32 + lr] = f2bf(SILU ? silu_(v) : v); }
}
template <int NT>
__device__ __forceinline__ void epi_vt(const f32x16 (&acc)[2][NT], int trow0, int lr, int lh, bf16_t* __restrict__ vt, size_t ldv) {
#pragma unroll
    for (int mi = 0; mi < 2; ++mi)
#pragma unroll
        for (int ni = 0; ni < NT; ++ni)
#pragma unroll
            for (int g = 0; g < 4; ++g) {
                u32x2 o; o.x = cvt_pk_bf16(acc[mi][ni][4 * g], acc[mi][ni][4 * g + 1]); o.y = cvt_pk_bf16(acc[mi][ni][4 * g + 2], acc[mi][ni][4 * g + 3]);
                *(u32x2*)(vt + (size_t)(ni * 32 + lr) * ldv + trow0 + mi * 32 + 8 * g + 4 * lh) = o;
            }
}
template <int NT>
__device__ __forceinline__ void epi_f32(const f32x16 (&acc)[2][NT], int row0, int lr, int lh, float* __restrict__ dst, int ld, int cbase) {
#pragma unroll
    for (int mi = 0; mi < 2; ++mi)
#pragma unroll
        for (int ni = 0; ni < NT; ++ni)
#pragma unroll
            for (int r = 0; r < 16; ++r) dst[(size_t)EROW(mi, r) * ld + cbase + ni * 32 + lr] = acc[mi][ni][r];
}
struct EpiInProj {
    const Params& p; int layer;
    __device__ __forceinline__ void operator()(const f32x16 (&acc)[2][2], int row0, int col0, int lr, int lh, char* stg) const {
        const int b = row0 / S, t0 = row0 % S;
        const float* rope = p.ROPE();
        int kind, ld = 256, cbase = 0; size_t off = 0; bool silu = false;
        if (col0 < M_QN)         { kind = 0; off = OFF_QA; cbase = col0 - M_QA; }
        else if (col0 < M_KSLC)  { kind = 0; off = OFF_QN; cbase = col0 - M_QN; }
        else if (col0 == M_KSLC) { kind = 0; off = OFF_KSLC; ld = 64; }
        else if (col0 == M_KWIN) { kind = 0; off = OFF_KWIN; ld = 64; }
        else if (col0 == M_KC)   { kind = 0; off = OFF_KCT; ld = 64; }
        else if (col0 == M_VC)   { kind = 1; off = OFF_VCTOK; ld = 64; }
        else if (col0 < M_KF)    { kind = 1; off = OFF_QF; cbase = col0 - M_QF; }
        else if (col0 < M_QS)    { kind = 1; off = OFF_KF; cbase = col0 - M_KF; }
        else if (col0 < M_KSB)   { kind = 1; off = OFF_QS; cbase = col0 - M_QS; }
        else if (col0 < M_QM)    { kind = 1; off = OFF_KSB; cbase = col0 - M_KSB; }
        else if (col0 < M_VF)    { kind = 1; off = OFF_QM; cbase = col0 - M_QM; }
        else if (col0 < M_VS)    { kind = 2; off = OFF_VFT + ((size_t)(b * 4 + (col0 - M_VF) / 64) * 64) * S * 2; }
        else if (col0 < M_VSLC)  { kind = 2; off = OFF_VST + ((size_t)(b * 4 + (col0 - M_VS) / 64) * 64) * S * 2; }
        else if (col0 == M_VSLC) { kind = 2; off = OFF_VSLCT + ((size_t)b * 64) * S * 2; }
        else if (col0 == M_VWIN) { kind = 2; off = OFF_VWINT + ((size_t)b * 64) * S * 2; }
        else if (col0 < M_SPC)   { kind = 3; off = OFF_QI; ld = 128; cbase = col0 - M_QI; }
        else if (col0 == M_SPC)  { kind = 4; }
        else if (col0 < M_Z)     { kind = 5; off = OFF_CKVR; ld = 128; cbase = col0 - M_CKV; }
        else if (col0 < NPM)     { kind = 1; off = OFF_ZG; ld = 1280; cbase = col0 - M_Z; silu = true; }
        else if (col0 < M_MERGE) { return; }
        else                     { kind = 6; }
        bf16_t* dst = (bf16_t*)(p.ws + off);
        if (kind <= 3) {
            bf16_t* sg = (bf16_t*)stg;
            if (kind == 2) {
#pragma unroll
                for (int mi = 0; mi < 2; ++mi)
#pragma unroll
                    for (int ni = 0; ni < 2; ++ni)
#pragma unroll
                        for (int g = 0; g < 4; ++g) {
                            u32x2 o; o.x = cvt_pk_bf16(acc[mi][ni][4 * g], acc[mi][ni][4 * g + 1]); o.y = cvt_pk_bf16(acc[mi][ni][4 * g + 2], acc[mi][ni][4 * g + 3]);
                            const int d = ni * 32 + lr, tk = mi * 32 + 8 * g + 4 * lh;
                            *(u32x2*)(sg + d * 64 + (((tk >> 3) ^ (d & 7)) << 3) + (tk & 7)) = o;
                        }
            } else {
#pragma unroll
                for (int mi = 0; mi < 2; ++mi)
#pragma unroll
                    for (int r = 0; r < 16; ++r) {
                        const int rl = mi * 32 + (r & 3) + 8 * (r >> 2) + 4 * lh;
                        const size_t row = (size_t)row0 + rl;
                        float o0, o1;
                        if (kind == 0) {
                            const float c = rope[row * 64 + lr], s = rope[row * 64 + 32 + lr], x1 = acc[mi][0][r], x2 = acc[mi][1][r];
                            o0 = x1 * c - x2 * s; o1 = x2 * c + x1 * s;
                        } else if (kind == 3) {
                            const int f = lr & 15;
                            const float c = rope[row * 64 + 2 * f], s = rope[row * 64 + 32 + 2 * f];
                            const float x0 = acc[mi][0][r], x1 = acc[mi][1][r], y0 = __shfl_xor(x0, 16, 64), y1 = __shfl_xor(x1, 16, 64);
                            o0 = (lr & 16) ? (x0 * c + y0 * s) : (x0 * c - y0 * s); o1 = (lr & 16) ? (x1 * c + y1 * s) : (x1 * c - y1 * s);
                        } else {
                            o0 = acc[mi][0][r]; o1 = acc[mi][1][r];
                            if (silu) { o0 = silu_(o0); o1 = silu_(o1); }
                        }
                        sg[rl * 64 + ((((lr >> 3)) ^ (rl & 7)) << 3) + (lr & 7)] = f2bf(o0); sg[rl * 64 + ((((lr >> 3) + 4) ^ (rl & 7)) << 3) + (lr & 7)] = f2bf(o1);
                        if ((r & 3) == 3) __builtin_amdgcn_sched_barrier(0);
                    }
            }
            __builtin_amdgcn_wave_barrier();
            const size_t ldd = (kind == 2) ? (size_t)S : (size_t)ld;
            bf16_t* dp = (kind == 2) ? (dst + t0) : (dst + (size_t)row0 * ld + cbase);
            const int lane = lh * 32 + lr;
#pragma unroll
            for (int i = 0; i < 8; ++i) {
                const int piece = lane + 64 * i, rr = piece >> 3, ch = piece & 7;
                const u32x4 v = *(const u32x4*)(sg + rr * 64 + ((ch ^ (rr & 7)) << 3));
                *(u32x4*)(dp + (size_t)rr * ldd + ch * 8) = v;
            }
            __builtin_amdgcn_wave_barrier();
        }
        else if (kind == 5) epi_f32<2>(acc, row0, lr, lh, (float*)dst, ld, cbase);
        else if (kind == 6) {
            const int tile = (row0 >> 7) * 40 + ((col0 - M_MERGE) >> 7), wave = ((row0 >> 6) & 1) * 2 + ((col0 >> 6) & 1);
            bf16_t* sp = p.SIG() + ((size_t)(tile * 4 + wave) * 4) * 1024 + (size_t)(lh * 32 + lr) * 16;
#pragma unroll
            for (int mi = 0; mi < 2; ++mi)
#pragma unroll
                for (int ni = 0; ni < 2; ++ni) {
                    u32x4 w0, w1;
                    w0.x = cvt_pk_bf16(sigmoid_(acc[mi][ni][0]), sigmoid_(acc[mi][ni][1])); w0.y = cvt_pk_bf16(sigmoid_(acc[mi][ni][2]), sigmoid_(acc[mi][ni][3]));
                    w0.z = cvt_pk_bf16(sigmoid_(acc[mi][ni][4]), sigmoid_(acc[mi][ni][5])); w0.w = cvt_pk_bf16(sigmoid_(acc[mi][ni][6]), sigmoid_(acc[mi][ni][7]));
                    w1.x = cvt_pk_bf16(sigmoid_(acc[mi][ni][8]), sigmoid_(acc[mi][ni][9])); w1.y = cvt_pk_bf16(sigmoid_(acc[mi][ni][10]), sigmoid_(acc[mi][ni][11]));
                    w1.z = cvt_pk_bf16(sigmoid_(acc[mi][ni][12]), sigmoid_(acc[mi][ni][13])); w1.w = cvt_pk_bf16(sigmoid_(acc[mi][ni][14]), sigmoid_(acc[mi][ni][15]));
                    u32x4* d4 = (u32x4*)(sp + (size_t)(mi * 2 + ni) * 1024);
                    d4[0] = w0; d4[1] = w1;
                }
        }
        else {
            epi_rope32<1>(acc, row0, lr, lh, rope, p.KI(), 32, 0);
            const float fb = p.fox_bias[layer * 4 + (lr & 3)];
            float* sbase = (lr < 4) ? (p.WI() + lr) : (lr < 8) ? (p.LOGF() + (lr - 4)) : (p.GN() + (lr - 8));
            const int sstride = (lr < 8) ? 4 : 12;
#pragma unroll
            for (int mi = 0; mi < 2; ++mi)
#pragma unroll
                for (int r = 0; r < 16; ++r) {
                    const size_t row = EROW(mi, r); const float v = acc[mi][1][r];
                    const float u = (lr < 8) ? (v + fb) : v;
                    const float e = __builtin_amdgcn_exp2f(-1.4426950408889634f * fabsf(u));
                    const float lsg = fminf(u, 0.f) - __builtin_amdgcn_logf(1.f + e) * 0.6931471805599453f;
                    const float sg = ((u >= 0.f) ? 1.f : e) * __builtin_amdgcn_rcpf(1.f + e);
                    const float o = (lr < 4) ? v * 0.08838834764831845f : ((lr < 8) ? lsg : sg);
                    if (lr < 20) sbase[row * sstride] = o;
                }
        }
    }
};
struct EpiMemKV {
    const Params& p;
    __device__ __forceinline__ void operator()(const f32x16 (&acc)[2][2], int row0, int col0, int lr, int lh, char* stg) const {
        if (col0 < 256) epi_bf16<2, false>(acc, row0, lr, lh, p.MKB(), 256, col0);
        else epi_vt<2>(acc, row0 % NMEM, lr, lh, p.MVT() + ((size_t)((row0 / NMEM) * 4 + (col0 - 256) / 64) * 64) * NMEM, NMEM);
    }
};
struct EpiKA { const Params& p;
    __device__ __forceinline__ void operator()(const f32x16 (&acc)[2][2], int row0, int col0, int lr, int lh, char* stg) const { epi_rope64(acc, row0, lr, lh, p.ROPE(), p.KAB(), 256, col0); } };
struct EpiVA { const Params& p;
    __device__ __forceinline__ void operator()(const f32x16 (&acc)[2][2], int row0, int col0, int lr, int lh, char* stg) const {
        epi_vt<2>(acc, row0 % S, lr, lh, p.VAT() + ((size_t)((row0 / S) * 4 + col0 / 64) * 64) * S, S); } };
struct EpiResid { const float* Xin; float* Xout;
    __device__ __forceinline__ void operator()(const f32x16 (&acc)[2][2], int row0, int col0, int lr, int lh, char* stg) const {
#pragma unroll
        for (int mi = 0; mi < 2; ++mi) {
            float xv[2][16];
#pragma unroll
            for (int ni = 0; ni < 2; ++ni)
#pragma unroll
                for (int r = 0; r < 16; ++r) xv[ni][r] = Xin[(size_t)EROW(mi, r) * D + col0 + ni * 32 + lr];
#pragma unroll
            for (int ni = 0; ni < 2; ++ni)
#pragma unroll
                for (int r = 0; r < 16; ++r) Xout[(size_t)EROW(mi, r) * D + col0 + ni * 32 + lr] = xv[ni][r] + acc[mi][ni][r];
        }
    } };
struct EpiCmp1 { const float* bias; bf16_t* hid;
    __device__ __forceinline__ void operator()(const f32x16 (&acc)[2][2], int row0, int col0, int lr, int lh, char* stg) const {
#pragma unroll
        for (int ni = 0; ni < 2; ++ni) {
            const float bv = bias[col0 + ni * 32 + lr];
#pragma unroll
            for (int mi = 0; mi < 2; ++mi)
#pragma unroll
                for (int r = 0; r < 16; ++r) hid[(size_t)EROW(mi, r) * 128 + col0 + ni * 32 + lr] = f2bf(silu_(acc[mi][ni][r] + bv));
        }
    } };
struct EpiCmp2K { bf16_t* kcb;
    __device__ __forceinline__ void operator()(const f32x16 (&acc)[2][1], int row0, int col0, int lr, int lh, char* stg) const {
#pragma unroll
        for (int mi = 0; mi < 2; ++mi)
#pragma unroll
            for (int r = 0; r < 16; ++r) { const int row = EROW(mi, r); kcb[(size_t)row * 64 + col0 + lr] = ((row & 511) == 511) ? (bf16_t)0 : f2bf(acc[mi][0][r]); }
    } };
struct EpiCmp2V { bf16_t* vct;
    __device__ __forceinline__ void operator()(const f32x16 (&acc)[2][1], int row0, int col0, int lr, int lh, char* stg) const {
        bf16_t* base = vct + ((size_t)(row0 / 512) * 64 + col0) * 512;
        const int n0 = row0 % 512;
#pragma unroll
        for (int mi = 0; mi < 2; ++mi)
#pragma unroll
            for (int g = 0; g < 4; ++g) {
                const int n = n0 + mi * 32 + 8 * g + 4 * lh;
                u32x2 o; o.x = cvt_pk_bf16(acc[mi][0][4 * g], acc[mi][0][4 * g + 1]); o.y = cvt_pk_bf16(acc[mi][0][4 * g + 2], (n + 3 == 511) ? 0.f : acc[mi][0][4 * g + 3]);
                *(u32x2*)(base + (size_t)lr * 512 + n) = o;
            }
    } };

__device__ __forceinline__ void ph_merge(const Params& p, int layer, int bid, int nb, char* sm) {
    const int lane = tidx() & 63, wid = __builtin_amdgcn_readfirstlane(tidx() >> 6), wr = wid >> 1, wc = wid & 1, lr = lane & 31, lh = lane >> 5;
    for (int tile = bid; tile < (T / 128) * (D / 128); tile += nb) {
        const int mt = tile % (T / 128), nt = tile / (T / 128), m0 = mt * 128, n0 = nt * 128;
        f32x16 mg[2][2]; acc_zero<2>(mg);
#pragma unroll 1
        for (int n = 0; n < 5; ++n) {
            f32x16 g[2][2]; acc_zero<2>(g);
            tile_mac_dma64(g, p.Y() + n * 256, 1280, m0, p.WBR() + ((size_t)layer * 5 + n) * D * 256, 256, n0, 256, sm);
            const bf16_t* sp = p.SIG() + ((size_t)((mt * 40 + n * 8 + nt) * 4 + wid) * 4) * 1024 + (size_t)lane * 16;
#pragma unroll
            for (int mi = 0; mi < 2; ++mi)
#pragma unroll
                for (int ni = 0; ni < 2; ++ni) {
                    const u32x4* s4 = (const u32x4*)(sp + (size_t)(mi * 2 + ni) * 1024);
                    const u32x4 w0 = s4[0], w1 = s4[1];
                    const unsigned sw[8] = {w0.x, w0.y, w0.z, w0.w, w1.x, w1.y, w1.z, w1.w};
#pragma unroll
                    for (int r = 0; r < 8; ++r) {
                        mg[mi][ni][2 * r] = fmaf(__uint_as_float(sw[r] << 16), g[mi][ni][2 * r], mg[mi][ni][2 * r]);
                        mg[mi][ni][2 * r + 1] = fmaf(__uint_as_float(sw[r] & 0xffff0000u), g[mi][ni][2 * r + 1], mg[mi][ni][2 * r + 1]);
                    }
                }
        }
        epi_bf16<2, false>(mg, m0 + wr * 64, lr, lh, p.MG(), D, n0 + wc * 64);
    }
}

__device__ __forceinline__ void ph_cumsum(const Params& p, int bid, int nb, float* sm) {
    const int tid = tidx();
    float4* ps = (float4*)sm;
    for (int b = bid; b < NBATCH; b += nb) {
        const float4* src = (const float4*)(p.LOGF() + (size_t)b * S * 4) + tid * 32;
        float4 loc = make_float4(0.f, 0.f, 0.f, 0.f);
#pragma unroll 8
        for (int i = 0; i < 32; ++i) { const float4 v = src[i]; loc.x += v.x; loc.y += v.y; loc.z += v.z; loc.w += v.w; }
        __syncthreads();
        ps[tid] = loc; __syncthreads();
        for (int off = 1; off < 256; off <<= 1) {
            float4 t = make_float4(0.f, 0.f, 0.f, 0.f);
            if (tid >= off) t = ps[tid - off];
            __syncthreads();
            float4 c = ps[tid]; c.x += t.x; c.y += t.y; c.z += t.z; c.w += t.w; ps[tid] = c;
            __syncthreads();
        }
        float4 run = (tid > 0) ? ps[tid - 1] : make_float4(0.f, 0.f, 0.f, 0.f);
        float* d0 = p.CUMT() + (size_t)(b * 4 + 0) * S + tid * 32;
#pragma unroll 8
        for (int i = 0; i < 32; ++i) {
            const float4 v = src[i]; run.x += v.x; run.y += v.y; run.z += v.z; run.w += v.w;
            d0[i] = run.x * 1.4426950408889634f; d0[S + i] = run.y * 1.4426950408889634f; d0[2 * S + i] = run.z * 1.4426950408889634f; d0[3 * S + i] = run.w * 1.4426950408889634f;
        }
        __syncthreads();
    }
}

enum { AM_FOX = 0, AM_DSA = 1, AM_SLC = 2, AM_SB = 3, AM_WIN = 4, AM_MEM = 5, AM_CMP = 6 };
constexpr int AK_ROW = 144;
constexpr int AK_TILE = 64 * AK_ROW;
constexpr int ABUF = 2 * AK_TILE + 256;
constexpr float LOG2E = 1.4426950408889634f;
#define NEG_INF (-__builtin_inff())

template <int MODE>
__device__ __forceinline__ void attn_core(const Params& p, int b, int head, int qblk, char* sm, f32x16 (&O)[2], float& inv) {
    const int tid = tidx(), lane = tid & 63, wid = __builtin_amdgcn_readfirstlane(tid >> 6), lr = lane & 31, lh = lane >> 5;
    const int q0 = qblk * 128, qw0 = q0 + 32 * wid, tq = qw0 + lr;
    const size_t gq = (size_t)b * S + tq;
    const bf16_t *Qp, *Kp, *VTp; int ldk, ldv;
    if (MODE == AM_FOX)      { Qp = p.QF() + gq * 256 + head * 64; Kp = p.KF() + (size_t)b * S * 256 + head * 64; ldk = 256; VTp = p.VFT() + ((size_t)(b * 4 + head) * 64) * S; ldv = S; }
    else if (MODE == AM_DSA) { Qp = p.QA() + gq * 256 + head * 64; Kp = p.KAB() + (size_t)b * S * 256 + head * 64; ldk = 256; VTp = p.VAT() + ((size_t)(b * 4 + head) * 64) * S; ldv = S; }
    else if (MODE == AM_SB)  { Qp = p.QS() + gq * 256 + head * 64; Kp = p.KSB() + (size_t)b * S * 256 + head * 64; ldk = 256; VTp = p.VST() + ((size_t)(b * 4 + head) * 64) * S; ldv = S; }
    else if (MODE == AM_SLC) { Qp = p.QN() + gq * 256 + head * 64; Kp = p.KSLC() + (size_t)b * S * 64; ldk = 64; VTp = p.VSLCT() + ((size_t)b * 64) * S; ldv = S; }
    else if (MODE == AM_WIN) { Qp = p.QN() + gq * 256 + head * 64; Kp = p.KWIN() + (size_t)b * S * 64; ldk = 64; VTp = p.VWINT() + ((size_t)b * 64) * S; ldv = S; }
    else if (MODE == AM_CMP) { Qp = p.QN() + gq * 256 + head * 64; Kp = p.KCB() + (size_t)b * NCMP_PAD * 64; ldk = 64; VTp = p.VCT() + ((size_t)b * 64) * NCMP_PAD; ldv = NCMP_PAD; }
    else                     { Qp = p.QM() + gq * 256 + head * 64; Kp = p.MKB() + (size_t)b * NMEM * 256 + head * 64; ldk = 256; VTp = p.MVT() + ((size_t)(b * 4 + head) * 64) * NMEM; ldv = NMEM; }
    int kt_lo = 0, kt_hi = 2 * qblk + 2;
    if (MODE == AM_WIN) kt_lo = q0 >= 512 ? (q0 - 512) / 64 : 0;
    if (MODE == AM_MEM) kt_hi = NMEM / 64;
    if (MODE == AM_CMP) kt_hi = min(8, (((q0 + 96) >> 4) >> 6) + 1);
    const int nlim = (tq - 31) >> 4;
    const int ntile = kt_hi - kt_lo;
    constexpr bool REV = (MODE == AM_SB);

    bf16x8 qf[4];
#pragma unroll
    for (int s = 0; s < 4; ++s) qf[s] = *(const bf16x8*)(Qp + 16 * s + 8 * lh);
    unsigned smw[4] = {0u, 0u, 0u, 0u};
    if (MODE == AM_SLC) { const u32x4 w = *(const u32x4*)(p.SMASK() + gq * 4); smw[0] = w.x; smw[1] = w.y; smw[2] = w.z; smw[3] = w.w; }
    const unsigned long long* mrow = (const unsigned long long*)(p.DMASK() + gq * 256);
    const float* csp = p.CUMT() + (size_t)(b * 4 + head) * S;

    const int srow = tid >> 3, sc16 = tid & 7;
    const int st0 = srow * AK_ROW + sc16 * 16, st1 = (srow + 32) * AK_ROW + sc16 * 16;
    const bf16_t* kg0 = Kp + (size_t)srow * ldk + sc16 * 8;
    const bf16_t* kg1 = Kp + (size_t)(srow + 32) * ldk + sc16 * 8;
    const bf16_t* vg0 = VTp + (size_t)srow * ldv + sc16 * 8;
    const bf16_t* vg1 = VTp + (size_t)(srow + 32) * ldv + sc16 * 8;
    u32x4 rk0, rk1, rv0, rv1; float rcs = 0.f;
    auto gload = [&](int kt) {
        rk0 = *(const u32x4*)(kg0 + (size_t)kt * 64 * ldk); rk1 = *(const u32x4*)(kg1 + (size_t)kt * 64 * ldk);
        rv0 = *(const u32x4*)(vg0 + kt * 64); rv1 = *(const u32x4*)(vg1 + kt * 64);
        if (MODE == AM_FOX) { if (tid < 64) rcs = csp[kt * 64 + tid]; }
    };
    auto lstore = [&](char* buf) {
        *(u32x4*)(buf + st0) = rk0; *(u32x4*)(buf + st1) = rk1;
        *(u32x4*)(buf + AK_TILE + st0) = rv0; *(u32x4*)(buf + AK_TILE + st1) = rv1;
        if (MODE == AM_FOX) { if (tid < 64) *(float*)(buf + 2 * AK_TILE + tid * 4) = rcs; }
    };
    const int pil = (lr & 0x13) | ((lr & 4) << 1) | ((lr & 8) >> 1);
    const int rdk = pil * AK_ROW + lh * 16;
    const int rdv = AK_TILE + lr * AK_ROW + lh * 16;

    float m = NEG_INF, l = 0.f, R = 1.f;
#pragma unroll
    for (int i = 0; i < 16; ++i) { O[0][i] = 0.f; O[1][i] = 0.f; }

    gload(REV ? kt_hi - 1 : kt_lo);
    __syncthreads();
    lstore(sm);
    __syncthreads();
#pragma unroll 1
    for (int it = 0; it < ntile; ++it) {
        const int kt = REV ? kt_hi - 1 - it : kt_lo + it;
        char* cur = sm + (it & 1) * ABUF;
        const bool more = (it + 1) < ntile;
        if (more) gload(REV ? kt - 1 : kt + 1);
        unsigned long long mw = 0ull;
        if (MODE == AM_DSA) mw = mrow[kt];
        bool need = true;
        if (MODE == AM_CMP) need = kt * 64 <= (qw0 >> 4);
        else if (MODE != AM_MEM) need = kt * 64 <= qw0 + 31;
        if (MODE == AM_WIN) need = need && (kt * 64 + 63 >= qw0 - 511);
        if (need) {
#pragma unroll
            for (int sb2 = 0; sb2 < 2; ++sb2) {
                const int sub = REV ? 1 - sb2 : sb2;
                const int kb = kt * 64 + sub * 32;
                bool sneed = true;
                if (MODE == AM_CMP) sneed = kb <= (qw0 >> 4);
                else if (MODE != AM_MEM) sneed = kb <= qw0 + 31;
                if (MODE == AM_WIN) sneed = sneed && (kb + 31 >= qw0 - 511);
                if (sneed) {
                    f32x16 s;
#pragma unroll
                    for (int i = 0; i < 16; ++i) s[i] = 0.f;
#pragma unroll
                    for (int s4 = 0; s4 < 4; ++s4) {
                        const bf16x8 kf = *(const bf16x8*)(cur + rdk + sub * 32 * AK_ROW + s4 * 32);
                        s = __builtin_amdgcn_mfma_f32_32x32x16_bf16(kf, qf[s4], s, 0, 0, 0);
                    }
                    const int thl = tq - kb - 8 * lh;
                    bf16x8 pf[2];
                    if (MODE == AM_SB) {
                        float kp[16];
#pragma unroll
                        for (int r = 0; r < 16; ++r) {
                            const int cr = 16 * (r >> 3) + (r & 7);
                            const float z = s[r] * 0.125f;
                            const float e = __builtin_amdgcn_exp2f(-fabsf(z) * LOG2E);
                            const float rc = __builtin_amdgcn_rcpf(1.f + e);
                            const float big = rc, sml = e * rc;
                            const bool ok = cr < thl;
                            const float sg = (z >= 0.f) ? big : sml;
                            kp[r] = ok ? ((z >= 0.f) ? sml : big) : 1.f;
                            s[r] = ok ? sg : 0.f;
                        }
                        float g0 = kp[0], g1 = kp[8];
#pragma unroll
                        for (int r = 1; r < 8; ++r) { g0 *= kp[r]; g1 *= kp[8 + r]; }
                        const float pg0 = __shfl_xor(g0, 32, 64), pg1 = __shfl_xor(g1, 32, 64);
                        float run0 = R * (lh == 0 ? (pg0 * g1 * pg1) : (pg1 * g1));
                        float run1 = R * (lh == 0 ? pg1 : 1.f);
#pragma unroll
                        for (int r = 7; r >= 0; --r) {
                            s[r] *= run0; run0 *= kp[r];
                            s[8 + r] *= run1; run1 *= kp[8 + r];
                        }
                        R *= (g0 * g1) * (pg0 * pg1);
                    } else {
                        constexpr float c = 0.125f * LOG2E;
                        if (MODE == AM_FOX) {
                            const float4* cs4 = (const float4*)(cur + 2 * AK_TILE + (sub * 32 + 8 * lh) * 4);
                            const float4 c0 = cs4[0], c1 = cs4[1], c2 = cs4[4], c3 = cs4[5];
                            const float cv[16] = {c0.x, c0.y, c0.z, c0.w, c1.x, c1.y, c1.z, c1.w, c2.x, c2.y, c2.z, c2.w, c3.x, c3.y, c3.z, c3.w};
#pragma unroll
                            for (int r = 0; r < 16; ++r) s[r] = fmaf(s[r], c, -cv[r]);
                        } else {
#pragma unroll
                            for (int r = 0; r < 16; ++r) s[r] *= c;
                        }
                        if (MODE == AM_DSA) {
                            const unsigned w = (unsigned)(mw >> (32 * sub)) >> (8 * lh);
#pragma unroll
                            for (int r = 0; r < 16; ++r) { const int cr = 16 * (r >> 3) + (r & 7); s[r] = (w & (1u << cr)) ? s[r] : NEG_INF; }
                        }
                        if (MODE == AM_SLC) {
                            const unsigned w = smw[0] * (kt < 32) + smw[1] * (kt >= 32 && kt < 64) + smw[2] * (kt >= 64 && kt < 96) + smw[3] * (kt >= 96);
                            const bool sel = (w >> (kt & 31)) & 1u;
#pragma unroll
                            for (int r = 0; r < 16; ++r) s[r] = sel ? s[r] : NEG_INF;
                        }
                        if (MODE == AM_FOX || MODE == AM_SLC) {
                            if (kb + 31 > qw0) {
#pragma unroll
                                for (int r = 0; r < 16; ++r) { const int cr = 16 * (r >> 3) + (r & 7); s[r] = (cr <= thl) ? s[r] : NEG_INF; }
                            }
                        }
                        if (MODE == AM_CMP) {
                            const int tc = nlim - kb - 8 * lh;
#pragma unroll
                            for (int r = 0; r < 16; ++r) { const int cr = 16 * (r >> 3) + (r & 7); s[r] = (cr <= tc) ? s[r] : NEG_INF; }
                        }
                        if (MODE == AM_WIN) {
                            if (kb + 31 > qw0 || kb < qw0 + 31 - 511) {
#pragma unroll
                                for (int r = 0; r < 16; ++r) { const int cr = 16 * (r >> 3) + (r & 7); s[r] = (cr <= thl && cr > thl - 512) ? s[r] : NEG_INF; }
                            }
                        }
                        float tmax = s[0];
#pragma unroll
                        for (int r = 1; r < 16; ++r) tmax = fmaxf(tmax, s[r]);
                        tmax = fmaxf(tmax, __shfl_xor(tmax, 32, 64));
                        const float mn = fmaxf(m, tmax);
                        const float mu = (mn == NEG_INF) ? 0.f : mn;
                        const float corr = __builtin_amdgcn_exp2f(m - mu);
                        m = mn;
                        float ls = 0.f;
#pragma unroll
                        for (int r = 0; r < 16; ++r) { s[r] = __builtin_amdgcn_exp2f(s[r] - mu); ls += s[r]; }
                        l = l * corr + ls;
                        if (!__all(corr == 1.0f)) {
#pragma unroll
                            for (int i = 0; i < 16; ++i) { O[0][i] *= corr; O[1][i] *= corr; }
                        }
                    }
                    {
                        u32x4 w0, w1;
                        w0.x = cvt_pk_bf16(s[0], s[1]); w0.y = cvt_pk_bf16(s[2], s[3]); w0.z = cvt_pk_bf16(s[4], s[5]); w0.w = cvt_pk_bf16(s[6], s[7]);
                        w1.x = cvt_pk_bf16(s[8], s[9]); w1.y = cvt_pk_bf16(s[10], s[11]); w1.z = cvt_pk_bf16(s[12], s[13]); w1.w = cvt_pk_bf16(s[14], s[15]);
                        pf[0] = __builtin_bit_cast(bf16x8, w0); pf[1] = __builtin_bit_cast(bf16x8, w1);
                    }
#pragma unroll
                    for (int s2 = 0; s2 < 2; ++s2)
#pragma unroll
                        for (int dt = 0; dt < 2; ++dt) {
                            const bf16x8 vf = *(const bf16x8*)(cur + rdv + dt * 32 * AK_ROW + sub * 64 + s2 * 32);
                            O[dt] = __builtin_amdgcn_mfma_f32_32x32x16_bf16(vf, pf[s2], O[dt], 0, 0, 0);
                        }
                }
            }
        }
        if (more) lstore(sm + ((it + 1) & 1) * ABUF);
        __syncthreads();
    }
    inv = 1.f;
    if (MODE != AM_SB) { const float lt = l + __shfl_xor(l, 32, 64); inv = 1.f / fmaxf(lt, 1e-30f); }
}
__device__ __forceinline__ void attn_store_gated(const Params& p, int b, int head, int qblk, int yc, const f32x16 (&O)[2], float scale) {
    const int tid = tidx(), lane = tid & 63, wid = __builtin_amdgcn_readfirstlane(tid >> 6), lr = lane & 31, lh = lane >> 5;
    const size_t gq = (size_t)b * S + qblk * 128 + 32 * wid + lr;
    const bf16_t* zp = p.ZG() + gq * 1280 + yc + head * 64;
    bf16_t* dst = p.Y() + gq * 1280 + yc + head * 64;
#pragma unroll
    for (int dt = 0; dt < 2; ++dt)
#pragma unroll
        for (int g = 0; g < 4; ++g) {
            const int d0 = 32 * dt + 8 * g + 4 * lh;
            const u32x2 z = *(const u32x2*)(zp + d0);
            u32x2 o;
            o.x = cvt_pk_bf16(O[dt][4 * g] * scale * __uint_as_float(z.x << 16), O[dt][4 * g + 1] * scale * __uint_as_float(z.x & 0xffff0000u));
            o.y = cvt_pk_bf16(O[dt][4 * g + 2] * scale * __uint_as_float(z.y << 16), O[dt][4 * g + 3] * scale * __uint_as_float(z.y & 0xffff0000u));
            *(u32x2*)(dst + d0) = o;
        }
}
template <int MODE>
__device__ __forceinline__ void attn_unit(const Params& p, int b, int head, int qblk, char* sm) {
    f32x16 O[2]; float inv;
    attn_core<MODE>(p, b, head, qblk, sm, O, inv);
    attn_store_gated(p, b, head, qblk, MODE == AM_FOX ? 256 : MODE == AM_DSA ? 0 : MODE == AM_SB ? 512 : 1024, O, inv);
}
__device__ __forceinline__ void nsa_unit(const Params& p, int b, int head, int qblk, char* sm) {
    const int tid = tidx(), wid = __builtin_amdgcn_readfirstlane(tid >> 6), lr = tid & 31;
    const size_t gq = (size_t)b * S + qblk * 128 + 32 * wid + lr;
    const float g0 = p.GN()[gq * 12 + head], g1 = p.GN()[gq * 12 + 4 + head], g2 = p.GN()[gq * 12 + 8 + head];
    f32x16 Y[2], O[2]; float inv;
    attn_core<AM_CMP>(p, b, head, qblk, sm, O, inv);
    { const float s = g0 * inv;
#pragma unroll
      for (int i = 0; i < 16; ++i) { Y[0][i] = O[0][i] * s; Y[1][i] = O[1][i] * s; } }
    attn_core<AM_WIN>(p, b, head, qblk, sm, O, inv);
    { const float s = g2 * inv;
#pragma unroll
      for (int i = 0; i < 16; ++i) { Y[0][i] = fmaf(O[0][i], s, Y[0][i]); Y[1][i] = fmaf(O[1][i], s, Y[1][i]); } }
    attn_core<AM_SLC>(p, b, head, qblk, sm, O, inv);
    { const float s = g1 * inv;
#pragma unroll
      for (int i = 0; i < 16; ++i) { Y[0][i] = fmaf(O[0][i], s, Y[0][i]); Y[1][i] = fmaf(O[1][i], s, Y[1][i]); } }
    attn_store_gated(p, b, head, qblk, 768, Y, 1.f);
}

__device__ __forceinline__ unsigned sortable_key(float x) { const unsigned u = __float_as_uint(x); return u ^ ((unsigned)((int)u >> 31) | 0x80000000u); }
#ifndef DIAG
#define DIAG 0
#endif
#if DIAG
#define UNIT_ATTR
#else
#define UNIT_ATTR
#endif
UNIT_ATTR __device__ __forceinline__ void dsa_select_unit(const Params& p, int b, int qt, char* sm) {
    const int tid = tidx(), lane = tid & 63, wid = __builtin_amdgcn_readfirstlane(tid >> 6), lr = lane & 31, lh = lane >> 5;
    unsigned* hist = (unsigned*)sm;
    unsigned* st_prefix = (unsigned*)(sm + 32 * 257 * 4);
    int* st_krem = (int*)(st_prefix + 32);
    int* st_part = st_krem + 32;
    const int q0 = qt * 32, tq = q0 + lr, ntile = qt + 1;
    const size_t gq = (size_t)b * S + tq;
    const bool small = tq + 1 <= 256;
    bf16x8 qf[4][2];
    float w[4];
#pragma unroll
    for (int h = 0; h < 4; ++h) {
        qf[h][0] = *(const bf16x8*)(p.QI() + gq * 128 + h * 32 + 8 * lh);
        qf[h][1] = *(const bf16x8*)(p.QI() + gq * 128 + h * 32 + 16 + 8 * lh);
        w[h] = p.WI()[gq * 4 + h];
    }
    const bf16_t* kbase = p.KI() + (size_t)b * S * 32 + (size_t)lr * 32 + 8 * lh;
    auto score_tile = [&](const bf16x8& k0, const bf16x8& k1, unsigned (&key)[16]) {
        float sc[16];
#pragma unroll
        for (int r = 0; r < 16; ++r) sc[r] = 0.f;
#pragma unroll
        for (int h = 0; h < 4; ++h) {
            f32x16 a;
#pragma unroll
            for (int r = 0; r < 16; ++r) a[r] = 0.f;
            a = __builtin_amdgcn_mfma_f32_32x32x16_bf16(k0, qf[h][0], a, 0, 0, 0);
            a = __builtin_amdgcn_mfma_f32_32x32x16_bf16(k1, qf[h][1], a, 0, 0, 0);
#pragma unroll
            for (int r = 0; r < 16; ++r) sc[r] = fmaf(__int_as_float(max(__float_as_int(a[r]), 0)), w[h], sc[r]);
        }
#pragma unroll
        for (int r = 0; r < 16; ++r) key[r] = sortable_key(sc[r]);
    };
#define KLOAD(kt_, a_, b_) { const bf16_t* kp_ = kbase + (size_t)min((kt_), qt) * (32 * 32); a_ = *(const bf16x8*)kp_; b_ = *(const bf16x8*)(kp_ + 16); }
    unsigned prefix = 0u;
#pragma unroll 1
    for (int pass = 0; pass < 4; ++pass) {
        const int shift = 24 - 8 * pass;
        __syncthreads();
        for (int i = tid; i < 32 * 257; i += 256) hist[i] = 0u;
        __syncthreads();
        bf16x8 k0, k1; KLOAD(wid, k0, k1)
        auto hist_tile = [&](auto first_tag, auto diag_tag) {
            constexpr bool FIRST = decltype(first_tag)::value, DG = decltype(diag_tag)::value;
            unsigned key[16];
            score_tile(k0, k1, key);
#pragma unroll
            for (int r = 0; r < 16; ++r) {
                const int rho = (r & 3) + 8 * (r >> 2) + 4 * lh;
                bool ok = true;
                if (DG) ok = rho <= lr;
                if (!FIRST) ok = ok && ((key[r] >> (shift + 8)) == prefix);
                if (FIRST) atomicAdd(&hist[lr * 257 + ((!DG || ok) ? ((key[r] >> shift) & 255u) : 256u)], 1u);
                else if (__any(ok)) atomicAdd(&hist[lr * 257 + (ok ? ((key[r] >> shift) & 255u) : 256u)], 1u);
            }
        };
        using T_ = std::true_type; using F_ = std::false_type;
#pragma unroll 1
        for (int kt = wid; kt < ntile; kt += 4) {
            bf16x8 n0, n1; KLOAD(kt + 4, n0, n1)
            if (pass == 0) { if (kt == qt) hist_tile(T_{}, T_{}); else hist_tile(T_{}, F_{}); }
            else { if (kt == qt) hist_tile(F_{}, T_{}); else hist_tile(F_{}, F_{}); }
            k0 = n0; k1 = n1;
        }
        __syncthreads();
        {
            const int q = tid >> 3, part = tid & 7;
            const unsigned* hr = hist + q * 257 + part * 32;
            unsigned s = 0u;
#pragma unroll 8
            for (int i = 0; i < 32; ++i) s += hr[i];
            st_part[q * 8 + part] = (int)s;
            __syncthreads();
            const bool qsmall = (q0 + q + 1) <= 256;
            const int krem = (pass == 0) ? 256 : st_krem[q];
            const unsigned pprev = (pass == 0) ? 0u : st_prefix[q];
            unsigned above = 0u;
            for (int pp = 7; pp > part; --pp) above += (unsigned)st_part[q * 8 + pp];
            __syncthreads();
            if (qsmall) { if (part == 0) { st_prefix[q] = 0u; st_krem[q] = 1 << 30; } }
            else if (above < (unsigned)krem && (unsigned)krem <= above + s) {
                unsigned cum = above; int bin = 31;
                for (; bin > 0; --bin) { const unsigned c = hr[bin]; if (cum + c >= (unsigned)krem) break; cum += c; }
                st_prefix[q] = (pprev << 8) | (unsigned)(part * 32 + bin);
                st_krem[q] = krem - (int)cum;
            }
        }
        __syncthreads();
        prefix = st_prefix[lr];
    }
    const unsigned thr = prefix;
    unsigned* mrow = p.DMASK() + gq * 256;
    unsigned* tiew = hist;
    {
        bf16x8 k0, k1; KLOAD(wid, k0, k1)
#pragma unroll 1
        for (int kt = wid; kt < 256; kt += 4) {
            unsigned gt = 0u, tie = 0u;
            if (kt < ntile) {
                bf16x8 n0, n1; KLOAD(kt + 4, n0, n1)
                unsigned key[16];
                score_tile(k0, k1, key);
                const int vlim = (kt == qt) ? lr : 64;
#pragma unroll
                for (int r = 0; r < 16; ++r) {
                    const int rho = (r & 3) + 8 * (r >> 2) + 4 * lh;
                    const bool v = rho <= vlim;
                    gt |= (v && key[r] > thr) ? (1u << rho) : 0u; tie |= (v && key[r] == thr) ? (1u << rho) : 0u;
                }
                gt |= __shfl_xor(gt, 32, 64); tie |= __shfl_xor(tie, 32, 64);
                k0 = n0; k1 = n1;
            }
            if (lh == 0) { mrow[kt] = gt; tiew[lr * 257 + kt] = tie; }
        }
    }
    asm volatile("s_waitcnt vmcnt(0)" ::: "memory");
    __syncthreads();
    {
        const int q = tid >> 3, part = tid & 7;
        const unsigned* tr = tiew + q * 257 + part * 32;
        int c = 0;
#pragma unroll 8
        for (int i = 0; i < 32; ++i) c += __builtin_popcount(tr[i]);
        st_part[q * 8 + part] = c;
        __syncthreads();
        int base = 0;
        for (int pp = 0; pp < part; ++pp) base += st_part[q * 8 + pp];
        int allow = st_krem[q] - base;
        unsigned* grow = p.DMASK() + ((size_t)b * S + q0 + q) * 256 + part * 32;
        if (c > 0 && allow > 0) {
            for (int i = 0; i < 32 && allow > 0; ++i) {
                unsigned wv = tr[i];
                if (wv == 0u) continue;
                const int pc = __builtin_popcount(wv);
                if (pc > allow) { unsigned kept = 0u; for (int j = 0; j < allow; ++j) { const unsigned low = wv & (0u - wv); kept |= low; wv ^= low; } wv = kept; }
                atomicOr(grow + i, wv);
                allow -= pc;
            }
        }
    }
#undef KLOAD
    __syncthreads();
}

__device__ __forceinline__ bool imp_better(float v1, int i1, float v2, int i2) { return (v1 > v2) || (v1 == v2 && i1 < i2); }
UNIT_ATTR __device__ __forceinline__ void nsa_select_unit(const Params& p, int b, int q0w, char* sm) {
    const int lane = tidx() & 63, lr = lane & 31, lh = lane >> 5;
    const int tq = q0w + lr;
    const size_t gq = (size_t)b * S + tq;
    const int nlim = (tq - 31) >> 4;
    const int nst = min(16, ((((q0w + 31 - 31) >> 4)) >> 5) + 1);
    const int pil = (lr & 0x13) | ((lr & 4) << 1) | ((lr & 8) >> 1);
    const bf16_t* kc = p.KCB() + (size_t)b * NCMP_PAD * 64 + (size_t)pil * 64 + 8 * lh;
    constexpr float c = 0.125f * LOG2E;
    float mh[4], il[4];
#pragma unroll
    for (int h = 0; h < 4; ++h) {
        bf16x8 qf[4];
#pragma unroll
        for (int s = 0; s < 4; ++s) qf[s] = *(const bf16x8*)(p.QN() + gq * 256 + h * 64 + 16 * s + 8 * lh);
        float m = NEG_INF, l = 0.f;
#pragma unroll 1
        for (int st = 0; st < nst; ++st) {
            f32x16 s;
#pragma unroll
            for (int i = 0; i < 16; ++i) s[i] = 0.f;
#pragma unroll
            for (int s4 = 0; s4 < 4; ++s4) { const bf16x8 kf = *(const bf16x8*)(kc + (size_t)st * 32 * 64 + s4 * 16); s = __builtin_amdgcn_mfma_f32_32x32x16_bf16(kf, qf[s4], s, 0, 0, 0); }
            const int thl = nlim - st * 32 - 8 * lh;
            float tmax = NEG_INF;
#pragma unroll
            for (int r = 0; r < 16; ++r) { const int cr = 16 * (r >> 3) + (r & 7); s[r] = (cr <= thl) ? s[r] * c : NEG_INF; tmax = fmaxf(tmax, s[r]); }
            tmax = fmaxf(tmax, __shfl_xor(tmax, 32, 64));
            const float mn = fmaxf(m, tmax), mu = (mn == NEG_INF) ? 0.f : mn;
            float ls = 0.f;
#pragma unroll
            for (int r = 0; r < 16; ++r) ls += __builtin_amdgcn_exp2f(s[r] - mu);
            l = l * __builtin_amdgcn_exp2f(m - mu) + ls; m = mn;
        }
        l += __shfl_xor(l, 32, 64);
        mh[h] = (m == NEG_INF) ? 0.f : m; il[h] = 1.f / fmaxf(l, 1e-30f);
    }
    float val[16]; int idx[16];
#pragma unroll
    for (int i = 0; i < 16; ++i) { val[i] = NEG_INF; idx[i] = 1 << 20; }
    const int cur = tq >> 6;
#pragma unroll 1
    for (int st = 0; st < 16; ++st) {
        float bs[4] = {0.f, 0.f, 0.f, 0.f};
        if (st < nst) {
            const int thl = nlim - st * 32 - 8 * lh;
#pragma unroll
            for (int h = 0; h < 4; ++h) {
                f32x16 s;
#pragma unroll
                for (int i = 0; i < 16; ++i) s[i] = 0.f;
#pragma unroll
                for (int s4 = 0; s4 < 4; ++s4) {
                    const bf16x8 kf = *(const bf16x8*)(kc + (size_t)st * 32 * 64 + s4 * 16);
                    const bf16x8 qfr = *(const bf16x8*)(p.QN() + gq * 256 + h * 64 + 16 * s4 + 8 * lh);
                    s = __builtin_amdgcn_mfma_f32_32x32x16_bf16(kf, qfr, s, 0, 0, 0);
                }
#pragma unroll
                for (int r = 0; r < 16; ++r) {
                    const int cr = 16 * (r >> 3) + (r & 7);
                    const float pr = (cr <= thl) ? __builtin_amdgcn_exp2f(s[r] * c - mh[h]) * il[h] : 0.f;
                    bs[r >> 2] += pr;
                }
                __builtin_amdgcn_sched_barrier(0);
            }
        }
#pragma unroll
        for (int g = 0; g < 4; ++g) {
            const int j = st * 8 + 4 * (g >> 1) + 2 * lh + (g & 1);
            const bool forced = (j == 0) || (j == cur) || (j == cur - 1);
            float v = forced ? 1e4f : ((j <= cur) ? bs[g] : -1.0f);
            int jj = j;
            if (__any(imp_better(v, jj, val[15], idx[15]))) {
#pragma unroll
                for (int i = 0; i < 16; ++i) {
                    const bool bt = imp_better(v, jj, val[i], idx[i]);
                    const float tv = bt ? val[i] : v; const int ti = bt ? idx[i] : jj;
                    val[i] = bt ? v : val[i]; idx[i] = bt ? jj : idx[i];
                    v = tv; jj = ti;
                }
            }
        }
    }
    {
        float* lv = (float*)(sm + (tidx() >> 6) * 8192);
        int* li = (int*)(lv + 1024);
#pragma unroll
        for (int i = 0; i < 16; ++i) { lv[i * 64 + lane] = val[i]; li[i * 64 + lane] = idx[i]; }
        __builtin_amdgcn_wave_barrier();
#pragma unroll 1
        for (int k = 0; k < 16; ++k) {
            float v = lv[k * 64 + (lane ^ 32)]; int jj = li[k * 64 + (lane ^ 32)];
#pragma unroll
            for (int i = 0; i < 16; ++i) {
                const bool bt = imp_better(v, jj, val[i], idx[i]);
                const float tv = bt ? val[i] : v; const int ti = bt ? idx[i] : jj;
                val[i] = bt ? v : val[i]; idx[i] = bt ? jj : idx[i];
                v = tv; jj = ti;
            }
        }
        __builtin_amdgcn_wave_barrier();
    }
    unsigned m0 = 0u, m1 = 0u, m2 = 0u, m3 = 0u;
#pragma unroll
    for (int i = 0; i < 16; ++i) {
        const unsigned bit = 1u << (idx[i] & 31); const int wsel = idx[i] >> 5;
        m0 |= (wsel == 0) ? bit : 0u; m1 |= (wsel == 1) ? bit : 0u; m2 |= (wsel == 2) ? bit : 0u; m3 |= (wsel == 3) ? bit : 0u;
    }
    if (lh == 0) { u32x4 o; o.x = m0; o.y = m1; o.z = m2; o.w = m3; *(u32x4*)(p.SMASK() + gq * 4) = o; }
}

constexpr int CONV_TILES = (D / 64) * ((NIN + 63) / 64), CONV_UNITS = (CONV_TILES + 7) / 8;
template <class BAR>
__device__ __forceinline__ void ph_work(const Params& p, int layer, char* sm, const BAR& barrier) {
    volatile int* s_unit_p = (volatile int*)(sm + 65536 + 32);
#pragma unroll 1
    for (int stage = 0; stage < 2; ++stage) {
        unsigned* ctr = p.qctr() + 64 * layer + 32 * stage;
        const int total = stage == 0 ? (2176 + (layer + 1 < DEPTH ? CONV_UNITS : 0)) : 1024;
        for (;;) {
            __syncthreads();
            if (threadIdx.x == 0) *s_unit_p = (int)atomicAdd(ctr, 1u);
            __syncthreads();
            const int u = __builtin_amdgcn_readfirstlane(*s_unit_p);
            if (u >= total) break;
            int kind, b = 0, h = 0, q = 0;
            if (stage == 1) { const int r = u & 15; kind = (r >> 3) ? 20 : 2 + AM_DSA; q = 63 - (u >> 4); b = (r >> 2) & 1; h = r & 3; }
            else if (u < 512) { kind = 0; q = 255 - (u >> 1); b = u & 1; }
            else if (u < 640) { kind = 1; const int v = u - 512; b = v & 1; q = v >> 1; }
            else if (u < 1664) { const int v = u - 640, r = v & 15; kind = 2 + ((r >> 3) ? AM_FOX : AM_SB); q = 63 - (v >> 4); b = (r >> 2) & 1; h = r & 3; }
            else if (u < 2176) { const int w = u - 1664; kind = 2 + AM_MEM; q = w >> 3; b = (w >> 2) & 1; h = w & 3; }
            else { kind = 21; q = u - 2176; }
#ifdef DUP_KIND
            const int reps = (kind == DUP_KIND) ? 2 : 1;
#pragma unroll 1
            for (int rep = 0; rep < reps; ++rep) {
#endif
            if (kind == 0) dsa_select_unit(p, b, q, sm);
            else if (kind == 1) nsa_select_unit(p, b, q * 128 + 32 * __builtin_amdgcn_readfirstlane(tidx() >> 6), sm);
            else if (kind == 2 + AM_SB) attn_unit<AM_SB>(p, b, h, q, sm);
            else if (kind == 2 + AM_FOX) attn_unit<AM_FOX>(p, b, h, q, sm);
            else if (kind == 2 + AM_DSA) attn_unit<AM_DSA>(p, b, h, q, sm);
            else if (kind == 2 + AM_MEM) attn_unit<AM_MEM>(p, b, h, q, sm);
            else if (kind == 20) nsa_unit(p, b, h, q, sm);
            else convert_wt_range<true>(p.w_in + (size_t)(layer + 1) * D * NIN, p.WIN(layer + 1), D, NIN, 1, q * 8, q * 8 + 8, 1, (float*)sm);
#ifdef DUP_KIND
            }
#endif
        }
        barrier(stage);
    }
}

__device__ __forceinline__ void ph_setup_misc(const Params& p, int bid, int nb) {
    const int lane = tidx() & 63, gw = bid * 4 + (tidx() >> 6);
    for (int o = gw; o < DEPTH * 2 * 128; o += nb * 4) {
        const int l = o >> 8, which = (o >> 7) & 1, j = o & 127;
        const float* pe = (which ? p.pe_v : p.pe_k) + (size_t)l * 2048;
        const float* w1 = (which ? p.wc1_v : p.wc1_k) + (size_t)l * 2048 * 128;
        float a = 0.f;
        for (int k = lane; k < 2048; k += 64) a = fmaf(pe[k], w1[(size_t)k * 128 + j], a);
        a = wave_sum(a);
        if (lane == 0) p.BIASC()[o] = a;
    }
    for (int i = bid * 256 + tidx(); i < 2048; i += nb * 256) { p.KCT()[(size_t)T * 64 + i] = 0; p.VCTOK()[(size_t)T * 64 + i] = 0; }
    for (int wb = 0; wb < 2; ++wb) {
        for (int i = bid * 256 + tidx(); i < 12 * D; i += nb * 256) p.WIN(wb)[(size_t)(M_SPC + 52) * D + i] = 0;
        for (int i = bid * 256 + tidx(); i < (M_MERGE - NPM) * D; i += nb * 256) p.WIN(wb)[(size_t)NPM * D + i] = 0;
    }
}

#define XB_TMO      128
#define XB_XCNT(j)  (256  + 64 * (j))
#define XB_XSUB(j)  (1280 + 64 * (j))
#define XB_XGEN(j)  (2304 + 64 * (j))
#define XB_TOP      3328
#define XB_TOPGEN   3392
#define XCD_BAR_WORDS 3456
#define XB_SPIN_CAP (1u << 18)
#define LAS __attribute__((address_space(3)))

#define XB_SPIN(cond, bar) do { unsigned _sp = 0; while (cond) { __builtin_amdgcn_s_sleep(1); \
    if ((++_sp & 255u) == 0u) { if (xb_ld(&(bar)[XB_TMO])) break; if (_sp > XB_SPIN_CAP) { atomicAdd(&(bar)[XB_TMO], 1u); break; } } } } while (0)

struct XcdBarrier {
    unsigned* bar; unsigned x;
    volatile LAS unsigned* st;
};
__device__ __forceinline__ XcdBarrier xcd_barrier_post(unsigned* bar, volatile LAS unsigned* st) {
    XcdBarrier b; b.bar = bar; b.x = xb_xcc_id(); b.st = st;
    if (threadIdx.x == 0) (void)xb_add(&bar[XB_XCNT(b.x)], 1u);
    return b;
}
__device__ __forceinline__ void xcd_barrier_complete(unsigned* bar, unsigned x, unsigned& nloc, unsigned& nx) {
    const unsigned G = gridDim.x * gridDim.y * gridDim.z;
    unsigned sum, cnt, mine, sp = 0u;
    for (;;) {
        sum = 0u; cnt = 0u; mine = 0u;
#pragma unroll
        for (unsigned j = 0; j < 16; ++j) { const unsigned c = xb_ld(&bar[XB_XCNT(j)]); sum += c; cnt += (c > 0u) ? 1u : 0u; mine = (j == x) ? c : mine; }
        if (sum == G) break;
        __builtin_amdgcn_s_sleep(1);
        if ((++sp & 255u) == 0u) { if (xb_ld(&bar[XB_TMO])) break; if (sp > XB_SPIN_CAP) { atomicAdd(&bar[XB_TMO], 1u); break; } }
    }
    nloc = mine > 0u ? mine : 1u; nx = cnt > 0u ? cnt : 1u;
}
__device__ __attribute__((noinline)) void xcd_barrier_impl(unsigned* b_bar, unsigned b_x, volatile LAS unsigned* b_st) {
    XcdBarrier b; b.bar = b_bar; b.x = b_x; b.st = b_st;
    asm volatile("s_waitcnt vmcnt(0)" ::: "memory");
    __syncthreads();
    if (threadIdx.x == 0) {
        unsigned* bar = b.bar;
        __builtin_amdgcn_s_waitcnt(0);
        unsigned nloc = b.st[0], nx = b.st[1];
        if (nloc == 0u) { xcd_barrier_complete(bar, b.x, nloc, nx); b.st[0] = nloc; b.st[1] = nx; }
        const unsigned old = xb_add(&bar[XB_XSUB(b.x)], 1u);
        const unsigned gen = old / nloc;
        if (old + 1u == (gen + 1u) * nloc) {
            __builtin_amdgcn_fence(__ATOMIC_RELEASE, "agent");
            asm volatile("s_waitcnt vmcnt(0)" ::: "memory");
            const unsigned og = xb_add(&bar[XB_TOP], 1u);
            const unsigned tg = og / nx;
            if (og + 1u == (tg + 1u) * nx) xb_add(&bar[XB_TOPGEN], 1u);
            else XB_SPIN(xb_ld(&bar[XB_TOPGEN]) == tg, bar);
            __builtin_amdgcn_fence(__ATOMIC_ACQUIRE, "agent");
            xb_add(&bar[XB_XGEN(b.x)], 1u);
            asm volatile("s_waitcnt vmcnt(0)" ::: "memory");
        } else {
            XB_SPIN(xb_ld(&bar[XB_XGEN(b.x)]) == gen, bar);
            __builtin_amdgcn_fence(__ATOMIC_ACQUIRE, "agent");
            asm volatile("s_waitcnt vmcnt(0)" ::: "memory");
        }
    }
    __syncthreads();
}
__device__ __forceinline__ void xcd_barrier(const XcdBarrier& b) { xcd_barrier_impl(b.bar, b.x, b.st); }

constexpr int LDS_MAIN = 65536, LDS_BYTES = LDS_MAIN + 64;
#ifndef DIAG
#define DIAG 0
#endif
#ifndef DIAG_A
#define DIAG_A 8
#define DIAG_B 7
#endif
#if DIAG
#define STAMP(k) do { if (((k) == DIAG_A || (k) == DIAG_B || (k) + 1 == DIAG_A || (k) + 1 == DIAG_B || (k) == 0 || (k) == 11) && blockIdx.x == 0 && threadIdx.x == 0) { const unsigned long long t_ = wall_clock64(); dg[k] += t_ - dg[15]; dg[15] = t_; } } while (0)
#else
#define STAMP(k) do { } while (0)
#endif
__global__ void __launch_bounds__(256, 2) mega(Params p) {
    extern __shared__ __attribute__((aligned(16))) char smem[];
    if (threadIdx.x == 0) *(uint4*)(smem + LDS_MAIN) = make_uint4(0u, 0u, 0u, 0u);
    __syncthreads();
    XcdBarrier bar = xcd_barrier_post(p.bar(), (volatile LAS unsigned*)(smem + LDS_MAIN));
    if (threadIdx.x == 0) *(volatile unsigned*)(smem + LDS_MAIN + 36) = atomicAdd(p.bar() + XRANK_BASE + bar.x, 1u);
    const int bid = blockIdx.x, nb = gridDim.x;
    float* smf = (float*)smem;
#if DIAG
    __shared__ unsigned long long dg[16];
    if (threadIdx.x == 0) { for (int i = 0; i < 15; ++i) dg[i] = 0; dg[15] = wall_clock64(); }
#endif

    convert_wt(p.w_branch, p.WBR(), 256, D, DEPTH * 5, bid, nb, smf);
    convert_wt(p.w_out, p.WOUT(), D, D, DEPTH, bid, nb, smf);
    convert_wt(p.w_mem_kv, p.WMKV(), D, 512, DEPTH, bid, nb, smf);
    convert_wt(p.w_uk, p.WUK(), 128, 256, DEPTH, bid, nb, smf);
    convert_wt(p.w_uv, p.WUV(), 128, 256, DEPTH, bid, nb, smf);
    for (int l = 0; l < DEPTH; ++l) {
        convert_wt(p.wc1_k + (size_t)l * 2048 * 128, p.WC1T() + (size_t)(l * 2 + 0) * 128 * 2048, 2048, 128, 1, bid, nb, smf);
        convert_wt(p.wc1_v + (size_t)l * 2048 * 128, p.WC1T() + (size_t)(l * 2 + 1) * 128 * 2048, 2048, 128, 1, bid, nb, smf);
        convert_wt(p.wc2_k + (size_t)l * 128 * 64, p.WC2T() + (size_t)(l * 2 + 0) * 64 * 128, 128, 64, 1, bid, nb, smf);
        convert_wt(p.wc2_v + (size_t)l * 128 * 64, p.WC2T() + (size_t)(l * 2 + 1) * 64 * 128, 128, 64, 1, bid, nb, smf);
    }
    ph_setup_misc(p, bid, nb);
    ph_rope_table(p, bid, nb);
    STAMP(0);
    for (int l = 0; l < DEPTH; ++l) {
        const float* Xin = l == 0 ? p.x : p.X;
        if (l == 0) convert_wt<true>(p.w_in, p.WIN(0), D, NIN, 1, bid, nb, smf);
        ph_rmsnorm<bf16_t>(Xin, p.norm_g + l * D, p.H(), T, bid, nb);
        ph_rmsnorm<bf16_t>(p.mem, p.mem_norm + l * D, p.MEMN(), NBATCH * NMEM, bid, nb);
        xcd_barrier(bar); STAMP(1);
        { EpiInProj e{p, l}; gemm_bf16<128>(p.H(), D, p.WIN(l), D, T, NP, D, e, bid, nb, smem); }
        { EpiMemKV e{p}; gemm_bf16<128>(p.MEMN(), D, p.WMKV() + (size_t)l * 512 * D, D, NBATCH * NMEM, 512, D, e, (bid + nb - 256) % nb, nb, smem); }
        xcd_barrier(bar); STAMP(2);
        ph_ckvnorm(p, l, bid, nb);
        ph_cumsum(p, (bid + nb - 64) % nb, nb, smf);
        { EpiCmp1 e{p.BIASC() + (l * 2 + 0) * 128, p.HIDK()}; gemm_bf16<128>(p.KCT(), 1024, p.WC1T() + (size_t)(l * 2 + 0) * 128 * 2048, 2048, 1024, 128, 2048, e, bid, nb, smem); }
        { EpiCmp1 e{p.BIASC() + (l * 2 + 1) * 128, p.HIDV()}; gemm_bf16<128>(p.VCTOK(), 1024, p.WC1T() + (size_t)(l * 2 + 1) * 128 * 2048, 2048, 1024, 128, 2048, e, (bid + nb - 16) % nb, nb, smem); }
        xcd_barrier(bar); STAMP(3);
        { EpiKA e{p}; gemm_bf16<128>(p.CKV(), 128, p.WUK() + (size_t)l * 256 * 128, 128, T, 256, 128, e, bid, nb, smem); }
        { EpiVA e{p}; gemm_bf16<128>(p.CKV(), 128, p.WUV() + (size_t)l * 256 * 128, 128, T, 256, 128, e, bid, nb, smem); }
        { EpiCmp2K e{p.KCB()}; gemm_bf16<64>(p.HIDK(), 128, p.WC2T() + (size_t)(l * 2 + 0) * 64 * 128, 128, 1024, 64, 128, e, bid, nb, smem); }
        { EpiCmp2V e{p.VCT()}; gemm_bf16<64>(p.HIDV(), 128, p.WC2T() + (size_t)(l * 2 + 1) * 64 * 128, 128, 1024, 64, 128, e, (bid + nb - 16) % nb, nb, smem); }
        xcd_barrier(bar); STAMP(4);
        ph_work(p, l, smem, [&](int stage) { xcd_barrier(bar); if (stage == 0) { STAMP(7); } else { STAMP(8); } });
        ph_merge(p, l, bid, nb, smem);
        xcd_barrier(bar); STAMP(10);
        { EpiResid e{Xin, p.X}; gemm_bf16<128>(p.MG(), D, p.WOUT() + (size_t)l * D * D, D, T, D, D, e, bid, nb, smem); }
        xcd_barrier(bar); STAMP(11);
    }
#if DIAG
    {
        float* dgw = (float*)(p.bar() + 4096 + 512);
        if (blockIdx.x == 0 && threadIdx.x == 0) {
            unsigned long long tot = 0; for (int i = 0; i < 15; ++i) tot += dg[i];
            dgw[0] = rintf(50.f * (float)((double)dg[DIAG_A] / (double)tot)) / 50.f; dgw[1] = rintf(50.f * (float)((double)dg[DIAG_B] / (double)tot)) / 50.f;
        }
        ph_rmsnorm<float>(p.X, p.final_norm, p.X, T, bid, nb);
        xcd_barrier(bar);
        {
            const float fa = 1.0f + dgw[0];
            float4* xp = (float4*)p.X;
#pragma unroll 1
            for (int i = bid * 256 + threadIdx.x; i < T * D / 4; i += nb * 256) { float4 v = xp[i]; v.x *= fa; v.y *= fa; v.z *= fa; v.w *= fa; xp[i] = v; }
        }
        xcd_barrier(bar);
        if (blockIdx.x == 0 && threadIdx.x == 0) p.X[0] += 100.f * dgw[1];
    }
#else
    ph_rmsnorm<float>(p.X, p.final_norm, p.X, T, bid, nb);
#endif
}
}

extern "C" void kernel_launch(void* const* d_in, const int* in_sizes, int n_in, void* d_out, int out_size, void* d_ws, size_t ws_size, hipStream_t stream) {
    (void)in_sizes; (void)n_in; (void)out_size;
    Params p{};
    p.x = (const float*)d_in[0]; p.mem = (const float*)d_in[1]; p.pos = (const int*)d_in[2]; p.norm_g = (const float*)d_in[3];
    p.w_in = (const float*)d_in[4]; p.kv_norm = (const float*)d_in[5]; p.w_uk = (const float*)d_in[6]; p.w_uv = (const float*)d_in[7];
    p.fox_bias = (const float*)d_in[8]; p.pe_k = (const float*)d_in[9]; p.pe_v = (const float*)d_in[10]; p.wc1_k = (const float*)d_in[11];
    p.wc2_k = (const float*)d_in[12]; p.wc1_v = (const float*)d_in[13]; p.wc2_v = (const float*)d_in[14]; p.mem_norm = (const float*)d_in[15];
    p.w_mem_kv = (const float*)d_in[16]; p.w_branch = (const float*)d_in[17]; p.w_out = (const float*)d_in[18]; p.final_norm = (const float*)d_in[19];
    p.X = (float*)d_out;
    p.ws = (char*)d_ws;
    if (WS_TOTAL > ws_size) { fprintf(stderr, "kernel_launch: workspace too small (%zu > %zu)\n", (size_t)WS_TOTAL, ws_size); return; }

    static int grid = 0;
    if (grid == 0) {
        int dev = 0, cus = 0, per_cu = 0;
        hipGetDevice(&dev);
        hipDeviceGetAttribute(&cus, hipDeviceAttributeMultiprocessorCount, dev);
        hipFuncSetAttribute((const void*)mega, hipFuncAttributeMaxDynamicSharedMemorySize, LDS_BYTES);
        hipOccupancyMaxActiveBlocksPerMultiprocessor(&per_cu, (const void*)mega, 256, LDS_BYTES);
        (void)hipGetLastError();
        if (per_cu < 1) per_cu = 1;
        grid = cus * (per_cu < 2 ? per_cu : 2);
    }
    hipMemsetAsync((char*)d_ws + OFF_bar, 0, (4096 + 64 * 8 + 64) * sizeof(unsigned), stream);
    hipLaunchKernelGGL(mega, dim3(grid), dim3(256), LDS_BYTES, stream, p);
}
```

```cpp
#include <hip/hip_runtime.h>
#include <stdint.h>
#include <math.h>
#include <cstdio>
#include <type_traits>

namespace {
constexpr int S = 8192, NBATCH = 2, T = NBATCH * S, D = 1024, NIN = 9396, NM = 4276, DEPTH = 4, NMEM = 256;
constexpr int NCMP = 511, NCMP_PAD = 512;
constexpr int C_DSA_Q = 0, C_CKV = 256, C_IDXQ = 384, C_IDXK = 512, C_IDXW = 544, C_DSA_Z = 548,
              C_FOX_Q = 804, C_FOX_K = 1060, C_FOX_V = 1316, C_FOX_F = 1572, C_FOX_Z = 1576,
              C_SB_Q = 1832, C_SB_K = 2088, C_SB_V = 2344, C_SB_Z = 2600,
              C_NSA_Q = 2856, C_NSA_KC = 3112, C_NSA_VC = 3176, C_NSA_KS = 3240, C_NSA_VS = 3304, C_NSA_KW = 3368, C_NSA_VW = 3432,
              C_NSA_G = 3496, C_NSA_Z = 3508, C_MEM_Q = 3764, C_MEM_Z = 4020, C_MERGE = 4276;

typedef unsigned short bf16_t;
typedef short bf16x8 __attribute__((ext_vector_type(8)));
typedef float f32x16 __attribute__((ext_vector_type(16)));
typedef float f32x2 __attribute__((ext_vector_type(2)));
typedef unsigned u32x4 __attribute__((ext_vector_type(4)));
typedef unsigned u32x2 __attribute__((ext_vector_type(2)));

constexpr int M_QA = 0, M_QN = 256, M_KSLC = 512, M_KWIN = 576, M_KC = 640, M_VC = 704, M_QF = 768, M_KF = 1024, M_QS = 1280, M_KSB = 1536, M_QM = 1792,
              M_VF = 2048, M_VS = 2304, M_VSLC = 2560, M_VWIN = 2624, M_QI = 2688, M_SPC = 2816, M_CKV = 2880, M_Z = 3008, NPM = 4288, M_MERGE = 4352, NP = 9472;
constexpr size_t al256(size_t x) { return (x + 255) & ~(size_t)255; }
constexpr size_t OFF_bar = 0;
constexpr size_t OFF_H = OFF_bar + al256((4096 + 64 * 8 + 64) * 4);
constexpr size_t OFF_Y = OFF_H + al256((size_t)T * D * 2);
constexpr size_t OFF_ZG = OFF_Y + al256((size_t)T * 1280 * 2);
constexpr size_t OFF_MG = OFF_ZG + al256((size_t)T * 1280 * 2);
constexpr size_t OFF_SIG = OFF_MG + al256((size_t)T * D * 2);
constexpr size_t OFF_CKVR = OFF_SIG + al256((size_t)T * 5120 * 2);
constexpr size_t OFF_CKV = OFF_CKVR + al256((size_t)T * 128 * 4);
constexpr size_t OFF_LOGF = OFF_CKV + al256((size_t)T * 128 * 2);
constexpr size_t OFF_CUM = OFF_LOGF + al256((size_t)T * 4 * 4);
constexpr size_t OFF_CUMT = OFF_CUM + al256((size_t)T * 4 * 4);
constexpr size_t OFF_WI = OFF_CUMT + al256((size_t)T * 4 * 4);
constexpr size_t OFF_GN = OFF_WI + al256((size_t)T * 4 * 4);
constexpr size_t OFF_KCT = OFF_GN + al256((size_t)T * 12 * 4);
constexpr size_t OFF_VCTOK = OFF_KCT + al256(((size_t)T * 64 + 2048) * 2);
constexpr size_t OFF_HIDK = OFF_VCTOK + al256(((size_t)T * 64 + 2048) * 2);
constexpr size_t OFF_HIDV = OFF_HIDK + al256((size_t)1024 * 128 * 2);
constexpr size_t OFF_KCB = OFF_HIDV + al256((size_t)1024 * 128 * 2);
constexpr size_t OFF_VCT = OFF_KCB + al256((size_t)NBATCH * NCMP_PAD * 64 * 2);
constexpr size_t OFF_QI = OFF_VCT + al256((size_t)NBATCH * NCMP_PAD * 64 * 2);
constexpr size_t OFF_KI = OFF_QI + al256((size_t)T * 128 * 2);
constexpr size_t OFF_MEMN = OFF_KI + al256((size_t)T * 32 * 2);
constexpr size_t OFF_ROPE = OFF_MEMN + al256((size_t)NBATCH * NMEM * D * 2);
constexpr size_t OFF_DMASK = OFF_ROPE + al256((size_t)T * 64 * 4);
constexpr size_t OFF_SMASK = OFF_DMASK + al256((size_t)T * 256 * 4);
constexpr size_t OFF_QA = OFF_SMASK + al256((size_t)T * 4 * 4);
constexpr size_t OFF_KAB = OFF_QA + al256((size_t)T * 256 * 2);
constexpr size_t OFF_VAT = OFF_KAB + al256((size_t)T * 256 * 2);
constexpr size_t OFF_QF = OFF_VAT + al256((size_t)T * 256 * 2);
constexpr size_t OFF_KF = OFF_QF + al256((size_t)T * 256 * 2);
constexpr size_t OFF_VFT = OFF_KF + al256((size_t)T * 256 * 2);
constexpr size_t OFF_QS = OFF_VFT + al256((size_t)T * 256 * 2);
constexpr size_t OFF_KSB = OFF_QS + al256((size_t)T * 256 * 2);
constexpr size_t OFF_VST = OFF_KSB + al256((size_t)T * 256 * 2);
constexpr size_t OFF_QN = OFF_VST + al256((size_t)T * 256 * 2);
constexpr size_t OFF_QM = OFF_QN + al256((size_t)T * 256 * 2);
constexpr size_t OFF_KSLC = OFF_QM + al256((size_t)T * 256 * 2);
constexpr size_t OFF_VSLCT = OFF_KSLC + al256((size_t)T * 64 * 2);
constexpr size_t OFF_KWIN = OFF_VSLCT + al256((size_t)T * 64 * 2);
constexpr size_t OFF_VWINT = OFF_KWIN + al256((size_t)T * 64 * 2);
constexpr size_t OFF_MKB = OFF_VWINT + al256((size_t)T * 64 * 2);
constexpr size_t OFF_MVT = OFF_MKB + al256((size_t)NBATCH * NMEM * 256 * 2);
constexpr size_t OFF_WIN = OFF_MVT + al256((size_t)NBATCH * NMEM * 256 * 2);
constexpr size_t OFF_WBR = OFF_WIN + al256((size_t)2 * NP * D * 2);
constexpr size_t OFF_WOUT = OFF_WBR + al256((size_t)DEPTH * 5 * D * 256 * 2);
constexpr size_t OFF_WMKV = OFF_WOUT + al256((size_t)DEPTH * D * D * 2);
constexpr size_t OFF_WUK = OFF_WMKV + al256((size_t)DEPTH * 512 * D * 2);
constexpr size_t OFF_WUV = OFF_WUK + al256((size_t)DEPTH * 256 * 128 * 2);
constexpr size_t OFF_WC1T = OFF_WUV + al256((size_t)DEPTH * 256 * 128 * 2);
constexpr size_t OFF_WC2T = OFF_WC1T + al256((size_t)DEPTH * 2 * 128 * 2048 * 2);
constexpr size_t OFF_BIASC = OFF_WC2T + al256((size_t)DEPTH * 2 * 64 * 128 * 2);
constexpr size_t WS_TOTAL = OFF_BIASC + al256((size_t)DEPTH * 2 * 128 * 4);

__device__ __forceinline__ int map_in_col(int n) {
    constexpr int seg[27][3] = {{0, 256, M_QA}, {256, 128, M_CKV}, {384, 128, M_QI}, {512, 32, M_SPC}, {544, 4, M_SPC + 32}, {548, 256, M_Z}, {804, 256, M_QF}, {1060, 256, M_KF},
        {1316, 256, M_VF}, {1572, 4, M_SPC + 36}, {1576, 256, M_Z + 256}, {1832, 256, M_QS}, {2088, 256, M_KSB}, {2344, 256, M_VS}, {2600, 256, M_Z + 512}, {2856, 256, M_QN},
        {3112, 64, M_KC}, {3176, 64, M_VC}, {3240, 64, M_KSLC}, {3304, 64, M_VSLC}, {3368, 64, M_KWIN}, {3432, 64, M_VWIN}, {3496, 12, M_SPC + 40}, {3508, 256, M_Z + 768},
        {3764, 256, M_QM}, {4020, 256, M_Z + 1024}, {4276, 5120, M_MERGE}};
    int r = 0;
#pragma unroll
    for (int i = 0; i < 27; ++i) r = (n >= seg[i][0] && n < seg[i][0] + seg[i][1]) ? (seg[i][2] + n - seg[i][0]) : r;
    return r;
}
struct Params {
    const float* x; const float* mem; const int* pos; const float* norm_g; const float* w_in; const float* kv_norm;
    const float* w_uk; const float* w_uv; const float* fox_bias; const float* pe_k; const float* pe_v;
    const float* wc1_k; const float* wc2_k; const float* wc1_v; const float* wc2_v; const float* mem_norm;
    const float* w_mem_kv; const float* w_branch; const float* w_out; const float* final_norm;
    float* X; char* ws;
    __device__ __forceinline__ unsigned* bar() const { return (unsigned*)(ws + OFF_bar); }
    __device__ __forceinline__ bf16_t* H() const { return (bf16_t*)(ws + OFF_H); }
    __device__ __forceinline__ bf16_t* Y() const { return (bf16_t*)(ws + OFF_Y); }
    __device__ __forceinline__ bf16_t* ZG() const { return (bf16_t*)(ws + OFF_ZG); }
    __device__ __forceinline__ bf16_t* MG() const { return (bf16_t*)(ws + OFF_MG); }
    __device__ __forceinline__ bf16_t* SIG() const { return (bf16_t*)(ws + OFF_SIG); }
    __device__ __forceinline__ float* CKVR() const { return (float*)(ws + OFF_CKVR); }
    __device__ __forceinline__ bf16_t* CKV() const { return (bf16_t*)(ws + OFF_CKV); }
    __device__ __forceinline__ float* LOGF() const { return (float*)(ws + OFF_LOGF); }
    __device__ __forceinline__ float* CUM() const { return (float*)(ws + OFF_CUM); }
    __device__ __forceinline__ float* CUMT() const { return (float*)(ws + OFF_CUMT); }
    __device__ __forceinline__ float* WI() const { return (float*)(ws + OFF_WI); }
    __device__ __forceinline__ float* GN() const { return (float*)(ws + OFF_GN); }
    __device__ __forceinline__ bf16_t* KCT() const { return (bf16_t*)(ws + OFF_KCT); }
    __device__ __forceinline__ bf16_t* VCTOK() const { return (bf16_t*)(ws + OFF_VCTOK); }
    __device__ __forceinline__ bf16_t* HIDK() const { return (bf16_t*)(ws + OFF_HIDK); }
    __device__ __forceinline__ bf16_t* HIDV() const { return (bf16_t*)(ws + OFF_HIDV); }
    __device__ __forceinline__ bf16_t* KCB() const { return (bf16_t*)(ws + OFF_KCB); }
    __device__ __forceinline__ bf16_t* VCT() const { return (bf16_t*)(ws + OFF_VCT); }
    __device__ __forceinline__ bf16_t* QI() const { return (bf16_t*)(ws + OFF_QI); }
    __device__ __forceinline__ bf16_t* KI() const { return (bf16_t*)(ws + OFF_KI); }
    __device__ __forceinline__ bf16_t* MEMN() const { return (bf16_t*)(ws + OFF_MEMN); }
    __device__ __forceinline__ float* ROPE() const { return (float*)(ws + OFF_ROPE); }
    __device__ __forceinline__ unsigned* DMASK() const { return (unsigned*)(ws + OFF_DMASK); }
    __device__ __forceinline__ unsigned* SMASK() const { return (unsigned*)(ws + OFF_SMASK); }
    __device__ __forceinline__ bf16_t* QA() const { return (bf16_t*)(ws + OFF_QA); }
    __device__ __forceinline__ bf16_t* KAB() const { return (bf16_t*)(ws + OFF_KAB); }
    __device__ __forceinline__ bf16_t* VAT() const { return (bf16_t*)(ws + OFF_VAT); }
    __device__ __forceinline__ bf16_t* QF() const { return (bf16_t*)(ws + OFF_QF); }
    __device__ __forceinline__ bf16_t* KF() const { return (bf16_t*)(ws + OFF_KF); }
    __device__ __forceinline__ bf16_t* VFT() const { return (bf16_t*)(ws + OFF_VFT); }
    __device__ __forceinline__ bf16_t* QS() const { return (bf16_t*)(ws + OFF_QS); }
    __device__ __forceinline__ bf16_t* KSB() const { return (bf16_t*)(ws + OFF_KSB); }
    __device__ __forceinline__ bf16_t* VST() const { return (bf16_t*)(ws + OFF_VST); }
    __device__ __forceinline__ bf16_t* QN() const { return (bf16_t*)(ws + OFF_QN); }
    __device__ __forceinline__ bf16_t* QM() const { return (bf16_t*)(ws + OFF_QM); }
    __device__ __forceinline__ bf16_t* KSLC() const { return (bf16_t*)(ws + OFF_KSLC); }
    __device__ __forceinline__ bf16_t* VSLCT() const { return (bf16_t*)(ws + OFF_VSLCT); }
    __device__ __forceinline__ bf16_t* KWIN() const { return (bf16_t*)(ws + OFF_KWIN); }
    __device__ __forceinline__ bf16_t* VWINT() const { return (bf16_t*)(ws + OFF_VWINT); }
    __device__ __forceinline__ bf16_t* MKB() const { return (bf16_t*)(ws + OFF_MKB); }
    __device__ __forceinline__ bf16_t* MVT() const { return (bf16_t*)(ws + OFF_MVT); }
    __device__ __forceinline__ bf16_t* WIN(int l) const { return (bf16_t*)(ws + OFF_WIN) + (size_t)(l & 1) * NP * D; }
    __device__ __forceinline__ bf16_t* WBR() const { return (bf16_t*)(ws + OFF_WBR); }
    __device__ __forceinline__ bf16_t* WOUT() const { return (bf16_t*)(ws + OFF_WOUT); }
    __device__ __forceinline__ bf16_t* WMKV() const { return (bf16_t*)(ws + OFF_WMKV); }
    __device__ __forceinline__ bf16_t* WUK() const { return (bf16_t*)(ws + OFF_WUK); }
    __device__ __forceinline__ bf16_t* WUV() const { return (bf16_t*)(ws + OFF_WUV); }
    __device__ __forceinline__ bf16_t* WC1T() const { return (bf16_t*)(ws + OFF_WC1T); }
    __device__ __forceinline__ bf16_t* WC2T() const { return (bf16_t*)(ws + OFF_WC2T); }
    __device__ __forceinline__ float* BIASC() const { return (float*)(ws + OFF_BIASC); }
    __device__ __forceinline__ unsigned* qctr() const { return (unsigned*)(ws + OFF_bar) + 4096; }
};

typedef __bf16 bf16x2_t __attribute__((ext_vector_type(2)));
__device__ __forceinline__ unsigned cvt_pk_bf16(float lo, float hi) { bf16x2_t v; v.x = (__bf16)lo; v.y = (__bf16)hi; return __builtin_bit_cast(unsigned, v); }
__device__ __forceinline__ bf16_t f2bf(float x) { return (bf16_t)(cvt_pk_bf16(x, 0.f) & 0xffffu); }
__device__ __forceinline__ unsigned xb_ld(unsigned* p)              { return __hip_atomic_load(p, __ATOMIC_RELAXED, __HIP_MEMORY_SCOPE_AGENT); }
__device__ __forceinline__ unsigned xb_add(unsigned* p, unsigned v) { return __hip_atomic_fetch_add(p, v, __ATOMIC_RELAXED, __HIP_MEMORY_SCOPE_AGENT); }
__device__ __forceinline__ unsigned xb_xcc_id() { return (unsigned)__builtin_amdgcn_s_getreg((3 << 11) | 20) & 0xFu; }
__device__ __forceinline__ int tidx() { int t = threadIdx.x; asm volatile("" : "+v"(t)); return t; }
__device__ __forceinline__ float sigmoid_(float x) { return __builtin_amdgcn_rcpf(1.f + __builtin_amdgcn_exp2f(-1.4426950408889634f * x)); }
__device__ __forceinline__ float silu_(float x) { return x * __builtin_amdgcn_rcpf(1.f + __builtin_amdgcn_exp2f(-1.4426950408889634f * x)); }
__device__ __forceinline__ float logsig_(float x) { return fminf(x, 0.f) - log1pf(expf(-fabsf(x))); }
__device__ __forceinline__ void half_pair(float x, float& lo, float& hi) {
    const auto r = __builtin_amdgcn_permlane32_swap(__float_as_uint(x), __float_as_uint(x), false, false);
    lo = __uint_as_float(r[0]); hi = __uint_as_float(r[1]);
}
__device__ __forceinline__ float half_sum(float x) { float a, b; half_pair(x, a, b); return a + b; }
__device__ __forceinline__ float half_max(float x) { float a, b; half_pair(x, a, b); return fmaxf(a, b); }
__device__ __forceinline__ unsigned half_or(unsigned x) { const auto r = __builtin_amdgcn_permlane32_swap(x, x, false, false); return r[0] | r[1]; }
template <int O> __device__ __forceinline__ float shx(float v) { return __int_as_float(__builtin_amdgcn_ds_swizzle(__float_as_int(v), 0x1F | (O << 10))); }
__device__ __forceinline__ float wave_sum(float v) {
    v = half_sum(v);
    v += shx<16>(v); v += shx<8>(v); v += shx<4>(v); v += shx<2>(v); v += shx<1>(v);
    return v;
}
__device__ __forceinline__ float wave_max(float v) {
    v = half_max(v);
    v = fmaxf(v, shx<16>(v)); v = fmaxf(v, shx<8>(v)); v = fmaxf(v, shx<4>(v)); v = fmaxf(v, shx<2>(v)); v = fmaxf(v, shx<1>(v));
    return v;
}

__device__ __forceinline__ void ph_rope_table(const Params& p, int bid, int nb) {
    for (int i = bid * 256 + tidx(); i < T * 32; i += nb * 256) {
        const int t = i >> 5, f = i & 31;
        const double inv = pow(10000.0, -(double)f / 32.0);
        const double ang = (double)p.pos[t] * inv;
        p.ROPE()[(size_t)t * 64 + f] = (float)cos(ang);
        p.ROPE()[(size_t)t * 64 + 32 + f] = (float)sin(ang);
    }
}

template <class OUT>
__device__ __forceinline__ void ph_rmsnorm(const float* in, const float* g, OUT* out, int rows, int bid, int nb, float dscale = 1.0f) {
    const int lane = tidx() & 63, wid = tidx() >> 6;
    for (int r = bid * 4 + wid; r < rows; r += nb * 4) {
        const float4* ip = (const float4*)(in + (size_t)r * D);
        float4 v[4]; float ss = 0.f;
#pragma unroll
        for (int i = 0; i < 4; ++i) { v[i] = ip[lane + 64 * i]; ss += v[i].x * v[i].x + v[i].y * v[i].y + v[i].z * v[i].z + v[i].w * v[i].w; }
        ss = wave_sum(ss);
        const float sc = dscale / sqrtf(ss * (1.f / D) + 1e-6f);
#pragma unroll
        for (int i = 0; i < 4; ++i) {
            const float4 gg = ((const float4*)g)[lane + 64 * i];
            float4 o; o.x = v[i].x * sc * gg.x; o.y = v[i].y * sc * gg.y; o.z = v[i].z * sc * gg.z; o.w = v[i].w * sc * gg.w;
            if constexpr (sizeof(OUT) == 4) ((float4*)((float*)out + (size_t)r * D))[lane + 64 * i] = o;
            else { u32x2 w; w.x = cvt_pk_bf16(o.x, o.y); w.y = cvt_pk_bf16(o.z, o.w); ((u32x2*)((bf16_t*)out + (size_t)r * D))[lane + 64 * i] = w; }
        }
    }
}

__device__ __forceinline__ void ph_ckvnorm(const Params& p, int layer, int bid, int nb) {
    const int lane = tidx() & 63, wid = tidx() >> 6;
    const float* g = p.kv_norm + layer * 128;
    const float g0 = g[lane], g1 = g[lane + 64];
    const float* __restrict__ src = p.CKVR();
    bf16_t* __restrict__ dst = p.CKV();
    const int stride = nb * 4;
    for (int r0 = bid * 4 + wid; r0 < T; r0 += 8 * stride) {
        float a[8], b[8];
#pragma unroll
        for (int k = 0; k < 8; ++k) { const int r = min(r0 + k * stride, T - 1); a[k] = src[(size_t)r * 128 + lane]; b[k] = src[(size_t)r * 128 + lane + 64]; }
#pragma unroll
        for (int k = 0; k < 8; ++k) {
            const int r = r0 + k * stride;
            const float ss = wave_sum(a[k] * a[k] + b[k] * b[k]);
            const float sc = 1.0f / sqrtf(ss * (1.f / 128.f) + 1e-6f);
            if (r < T) { dst[(size_t)r * 128 + lane] = f2bf(a[k] * sc * g0); dst[(size_t)r * 128 + lane + 64] = f2bf(b[k] * sc * g1); }
        }
    }
}

template <bool MAPIN = false>
__device__ __forceinline__ void convert_wt_range(const float* __restrict__ src, bf16_t* __restrict__ dst, int K, int N, int nmat, int it0, int it1, int nstep, float* sm) {
    float (*tl)[65] = (float (*)[65])sm;
    const int tid = tidx(), tk = K / 64, tn = (N + 63) / 64, per = tk * tn;
    for (int it = it0; it < it1 && it < per * nmat; it += nstep) {
        const int mat = it / per, r = it % per, k0 = (r % tk) * 64, n0 = (r / tk) * 64;
        const float* s = src + (size_t)mat * K * N; bf16_t* d = dst + (size_t)mat * K * N;
        __syncthreads();
        for (int i = tid; i < 64 * 64; i += 256) { const int kk = i >> 6, nn = i & 63; tl[kk][nn] = (n0 + nn < N) ? s[(size_t)(k0 + kk) * N + n0 + nn] : 0.f; }
        __syncthreads();
        {
            const int nn = tid >> 2, kq = (tid & 3) * 16;
            if (n0 + nn < N) {
                u32x4 w0, w1;
                w0.x = cvt_pk_bf16(tl[kq + 0][nn], tl[kq + 1][nn]); w0.y = cvt_pk_bf16(tl[kq + 2][nn], tl[kq + 3][nn]);
                w0.z = cvt_pk_bf16(tl[kq + 4][nn], tl[kq + 5][nn]); w0.w = cvt_pk_bf16(tl[kq + 6][nn], tl[kq + 7][nn]);
                w1.x = cvt_pk_bf16(tl[kq + 8][nn], tl[kq + 9][nn]); w1.y = cvt_pk_bf16(tl[kq + 10][nn], tl[kq + 11][nn]);
                w1.z = cvt_pk_bf16(tl[kq + 12][nn], tl[kq + 13][nn]); w1.w = cvt_pk_bf16(tl[kq + 14][nn], tl[kq + 15][nn]);
                const int drow = MAPIN ? map_in_col(n0 + nn) : (n0 + nn);
                u32x4* dp = (u32x4*)(d + (size_t)drow * K + k0 + kq);
                dp[0] = w0; dp[1] = w1;
            }
        }
    }
    __syncthreads();
}
template <bool MAPIN = false>
__device__ __forceinline__ void convert_wt(const float* __restrict__ src, bf16_t* __restrict__ dst, int K, int N, int nmat, int bid, int nb, float* sm) {
    convert_wt_range<MAPIN>(src, dst, K, N, nmat, bid, 1 << 30, nb, sm);
}

constexpr int GROW = 80;
constexpr int GA_BYTES = 128 * GROW;
struct GStage { u32x4 a0, a1, b0, b1; };
template <int BN, int DEPTH = 3>
__device__ __forceinline__ void tile_mac(f32x16 (&acc)[2][BN / 64], const bf16_t* __restrict__ A, int lda, int m0,
                                         const bf16_t* __restrict__ Bt, int ldb, int n0, int nmax, int K, char* sm) {
    constexpr int NT = BN / 64;
    constexpr int B_BYTES = BN * GROW;
    constexpr int BUF = GA_BYTES + B_BYTES;
    const int tid = tidx(), lane = tid & 63, wid = __builtin_amdgcn_readfirstlane(tid >> 6), wr = wid >> 1, wc = wid & 1;
    const int lr = lane & 31, lh = lane >> 5;
    const int ar0 = tid >> 2, akq = tid & 3;
    const bf16_t* Ab = A + (size_t)m0 * lda;
    const bf16_t* Bb = Bt + (size_t)n0 * ldb;
    const unsigned ao0 = (unsigned)(ar0 * lda + akq * 8), ao1 = ao0 + (unsigned)(64 * lda);
    const int br0 = tid >> 2;
    const bool bv0 = (n0 + br0) < nmax, bv1 = (NT == 2) && ((n0 + br0 + 64) < nmax);
    const unsigned bo0 = (unsigned)((bv0 ? br0 : 0) * ldb + akq * 8), bo1 = (unsigned)((bv1 ? br0 + 64 : 0) * ldb + akq * 8);
    const int st_a0 = ar0 * GROW + akq * 16, st_a1 = (ar0 + 64) * GROW + akq * 16;
    const int st_b0 = GA_BYTES + br0 * GROW + akq * 16, st_b1 = GA_BYTES + (br0 + 64) * GROW + akq * 16;
    const int rd_a = (wr * 64 + lr) * GROW + lh * 16, rd_b = GA_BYTES + (wc * (BN / 2) + lr) * GROW + lh * 16;
    const u32x4 zero4 = {0u, 0u, 0u, 0u};
    const int nk = K / 32;
    auto gload = [&](GStage& g, int ks) {
        const unsigned ko = (unsigned)ks * 32u;
        g.a0 = *(const u32x4*)(Ab + (ao0 + ko)); g.a1 = *(const u32x4*)(Ab + (ao1 + ko));
        g.b0 = *(const u32x4*)(Bb + (bo0 + ko)); if (NT == 2) g.b1 = *(const u32x4*)(Bb + (bo1 + ko));
    };
    auto lstore = [&](const GStage& g, char* buf) {
        *(u32x4*)(buf + st_a0) = g.a0; *(u32x4*)(buf + st_a1) = g.a1;
        *(u32x4*)(buf + st_b0) = bv0 ? g.b0 : zero4; if (NT == 2) *(u32x4*)(buf + st_b1) = bv1 ? g.b1 : zero4;
    };
    auto compute = [&](const char* cur) {
#pragma unroll
        for (int s = 0; s < 2; ++s) {
            bf16x8 a[2], b[NT];
#pragma unroll
            for (int mi = 0; mi < 2; ++mi) a[mi] = *(const bf16x8*)(cur + rd_a + mi * 32 * GROW + s * 32);
#pragma unroll
            for (int ni = 0; ni < NT; ++ni) b[ni] = *(const bf16x8*)(cur + rd_b + ni * 32 * GROW + s * 32);
#pragma unroll
            for (int mi = 0; mi < 2; ++mi)
#pragma unroll
                for (int ni = 0; ni < NT; ++ni) acc[mi][ni] = __builtin_amdgcn_mfma_f32_32x32x16_bf16(a[mi], b[ni], acc[mi][ni], 0, 0, 0);
        }
    };
    GStage g0, g1, g2;
    g1.b1 = zero4; g2.b1 = zero4; g0.b1 = zero4;
    const int last = nk - 1;
    gload(g0, 0);
    gload(g1, min(1, last));
    if (DEPTH == 3) gload(g2, min(2, last));
    __syncthreads();
    lstore(g0, sm);
    __syncthreads();
#define GSTEP(k, GL, GS) { gload(GL, min((k) + DEPTH, last)); compute(sm + ((k) & 1) * BUF); lstore(GS, sm + (((k) + 1) & 1) * BUF); __syncthreads(); }
    int ks = 0;
    if (DEPTH == 3) {
#pragma unroll 1
        for (; ks + 3 <= nk; ks += 3) {
            GSTEP(ks, g0, g1)
            GSTEP(ks + 1, g1, g2)
            GSTEP(ks + 2, g2, g0)
        }
        if (ks < nk) {
            GSTEP(ks, g0, g1)
            if (ks + 1 < nk) GSTEP(ks + 1, g1, g2)
        }
    } else if (DEPTH == 2) {
#pragma unroll 1
        for (; ks + 2 <= nk; ks += 2) {
            GSTEP(ks, g0, g1)
            GSTEP(ks + 1, g1, g0)
        }
        if (ks < nk) GSTEP(ks, g0, g1)
    } else {
#pragma unroll 1
        for (; ks < nk; ++ks) GSTEP(ks, g1, g1)
    }
#undef GSTEP
}
constexpr int DMA_STAGE = 16384, GEMM_NST = 3;
#define DMA_WAIT(n) asm volatile("s_waitcnt vmcnt(" #n ")" ::: "memory")
template <int NST>
__device__ __forceinline__ void tile_mac_dma(f32x16 (&acc)[2][2], const bf16_t* __restrict__ A, int lda, int m0,
                                             const bf16_t* __restrict__ Bt, int ldb, int n0, int K, char* sm) {
    static_assert(NST == 3 || NST == 4, "ring of 3 or 4 stages");
    const int tid = tidx(), lane = tid & 63, wid = __builtin_amdgcn_readfirstlane(tid >> 6), wr = wid >> 1, wc = wid & 1;
    const int lr = lane & 31, lh = lane >> 5;
    const int srow = tid >> 2, sslot = tid & 3, schunk = sslot ^ ((srow >> 2) & 3);
    const bf16_t* Ab = A + (size_t)m0 * lda;
    const bf16_t* Bb = Bt + (size_t)n0 * ldb;
    const unsigned ao0 = (unsigned)(srow * lda + schunk * 8), ao1 = ao0 + (unsigned)(64 * lda);
    const unsigned bo0 = (unsigned)(srow * ldb + schunk * 8), bo1 = bo0 + (unsigned)(64 * ldb);
    const int ldst = tid * 16;
    const int sw = (lr >> 2) & 3;
    const int rd_a = (wr * 64 + lr) * 64, rd_b = 8192 + (wc * 64 + lr) * 64;
    const int so0 = ((lh) ^ sw) * 16, so1 = ((lh + 2) ^ sw) * 16;
    const int nk = K / 32, last = nk - 1;
    auto issue = [&](int ks, int slot) {
        const unsigned ko = (unsigned)ks * 32u;
        char* st = sm + slot * DMA_STAGE + ldst;
        __builtin_amdgcn_global_load_lds((const unsigned*)(Ab + (ao0 + ko)), (unsigned*)(st), 16, 0, 0);
        __builtin_amdgcn_global_load_lds((const unsigned*)(Ab + (ao1 + ko)), (unsigned*)(st + 4096), 16, 0, 0);
        __builtin_amdgcn_global_load_lds((const unsigned*)(Bb + (bo0 + ko)), (unsigned*)(st + 8192), 16, 0, 0);
        __builtin_amdgcn_global_load_lds((const unsigned*)(Bb + (bo1 + ko)), (unsigned*)(st + 12288), 16, 0, 0);
    };
    auto compute = [&](int slot) {
        const char* cur = sm + slot * DMA_STAGE;
        bf16x8 a[2][2], b[2][2];
#pragma unroll
        for (int mi = 0; mi < 2; ++mi) { a[mi][0] = *(const bf16x8*)(cur + rd_a + mi * 2048 + so0); a[mi][1] = *(const bf16x8*)(cur + rd_a + mi * 2048 + so1); }
#pragma unroll
        for (int ni = 0; ni < 2; ++ni) { b[ni][0] = *(const bf16x8*)(cur + rd_b + ni * 2048 + so0); b[ni][1] = *(const bf16x8*)(cur + rd_b + ni * 2048 + so1); }
#pragma unroll
        for (int s = 0; s < 2; ++s)
#pragma unroll
            for (int mi = 0; mi < 2; ++mi)
#pragma unroll
                for (int ni = 0; ni < 2; ++ni) acc[mi][ni] = __builtin_amdgcn_mfma_f32_32x32x16_bf16(a[mi][s], b[ni][s], acc[mi][ni], 0, 0, 0);
    };
    __syncthreads();
#pragma unroll
    for (int s = 0; s < NST - 1; ++s) issue(min(s, last), s);
    int slot = 0, nslot = NST - 1;
#pragma unroll 1
    for (int ks = 0; ks < nk; ++ks) {
        if (NST == 3) DMA_WAIT(4); else DMA_WAIT(8);
        __builtin_amdgcn_s_barrier();
        issue(min(ks + NST - 1, last), nslot);
        compute(slot);
        slot = (slot + 1 == NST) ? 0 : slot + 1; nslot = (nslot + 1 == NST) ? 0 : nslot + 1;
    }
    DMA_WAIT(0);
}
constexpr int BIG_STAGE = 24576;
__device__ __forceinline__ void tile_mac_big(f32x16 (&acc)[4][2], const bf16_t* __restrict__ A, int lda, int m0,
                                             const bf16_t* __restrict__ Bt, int ldb, int n0, int K, char* sm) {
    const int tid = tidx(), lane = tid & 63, wid = __builtin_amdgcn_readfirstlane(tid >> 6), wr = wid >> 1, wc = wid & 1;
    const int lr = lane & 31, lh = lane >> 5;
    const int srow = tid >> 2, sslot = tid & 3, schunk = sslot ^ ((srow >> 2) & 3);
    const bf16_t* Ab = A + (size_t)m0 * lda;
    const bf16_t* Bb = Bt + (size_t)n0 * ldb;
    const unsigned ao0 = (unsigned)(srow * lda + schunk * 8), bo0 = (unsigned)(srow * ldb + schunk * 8);
    const int ldst = tid * 16;
    const int sw = (lr >> 2) & 3;
    const int rd_a = (wr * 128 + lr) * 64, rd_b = 16384 + (wc * 64 + lr) * 64;
    const int so0 = ((lh) ^ sw) * 16, so1 = ((lh + 2) ^ sw) * 16;
    const int nk = K / 32, last = nk - 1;
    auto issue1 = [&](int ks, int slot, int i) {
        const unsigned ko = (unsigned)ks * 32u;
        char* st = sm + slot * BIG_STAGE + ldst + i * 4096;
        if (i < 4) __builtin_amdgcn_global_load_lds((const unsigned*)(Ab + (ao0 + (unsigned)(64 * i * lda) + ko)), (unsigned*)st, 16, 0, 0);
        else __builtin_amdgcn_global_load_lds((const unsigned*)(Bb + (bo0 + (unsigned)(64 * (i - 4) * ldb) + ko)), (unsigned*)st, 16, 0, 0);
    };
    __syncthreads();
#pragma unroll
    for (int i = 0; i < 6; ++i) issue1(0, 0, i);
#pragma unroll
    for (int i = 0; i < 6; ++i) issue1(min(1, last), 1, i);
    int slot = 0, nslot = 2;
#pragma unroll 1
    for (int ks = 0; ks < nk; ++ks) {
        DMA_WAIT(6);
        __builtin_amdgcn_s_barrier();
        const char* cur = sm + slot * BIG_STAGE;
        const int kn = min(ks + 2, last);
        bf16x8 a0[4], b0[2], a1[4], b1[2];
#pragma unroll
        for (int mi = 0; mi < 4; ++mi) a0[mi] = *(const bf16x8*)(cur + rd_a + mi * 2048 + so0);
#pragma unroll
        for (int ni = 0; ni < 2; ++ni) b0[ni] = *(const bf16x8*)(cur + rd_b + ni * 2048 + so0);
#pragma unroll
        for (int mi = 0; mi < 4; ++mi) a1[mi] = *(const bf16x8*)(cur + rd_a + mi * 2048 + so1);
#pragma unroll
        for (int ni = 0; ni < 2; ++ni) b1[ni] = *(const bf16x8*)(cur + rd_b + ni * 2048 + so1);
        __builtin_amdgcn_sched_barrier(0);
#pragma unroll
        for (int mi = 0; mi < 4; ++mi) {
            acc[mi][0] = __builtin_amdgcn_mfma_f32_32x32x16_bf16(a0[mi], b0[0], acc[mi][0], 0, 0, 0);
            acc[mi][1] = __builtin_amdgcn_mfma_f32_32x32x16_bf16(a0[mi], b0[1], acc[mi][1], 0, 0, 0);
            __builtin_amdgcn_sched_barrier(0);
            issue1(kn, nslot, mi);
            __builtin_amdgcn_sched_barrier(0);
        }
#pragma unroll
        for (int mi = 0; mi < 4; ++mi) {
            acc[mi][0] = __builtin_amdgcn_mfma_f32_32x32x16_bf16(a1[mi], b1[0], acc[mi][0], 0, 0, 0);
            acc[mi][1] = __builtin_amdgcn_mfma_f32_32x32x16_bf16(a1[mi], b1[1], acc[mi][1], 0, 0, 0);
            if (mi < 2) {
                __builtin_amdgcn_sched_barrier(0);
                issue1(kn, nslot, 4 + mi);
                __builtin_amdgcn_sched_barrier(0);
            }
        }
        slot = (slot + 1 == 3) ? 0 : slot + 1; nslot = (nslot + 1 == 3) ? 0 : nslot + 1;
    }
    DMA_WAIT(0);
}
__device__ __forceinline__ void tile_mac_dma64(f32x16 (&acc)[2][2], const bf16_t* __restrict__ A, int lda, int m0,
                                               const bf16_t* __restrict__ Bt, int ldb, int n0, int K, char* sm) {
    constexpr int STG = 32768;
    const int tid = tidx(), lane = tid & 63, wid = __builtin_amdgcn_readfirstlane(tid >> 6), wr = wid >> 1, wc = wid & 1;
    const int lr = lane & 31, lh = lane >> 5;
    const int srow = tid >> 3, schunk = (tid & 7) ^ ((tid >> 4) & 7);
    const bf16_t* Ab = A + (size_t)m0 * lda;
    const bf16_t* Bb = Bt + (size_t)n0 * ldb;
    const unsigned ao = (unsigned)(srow * lda + schunk * 8), bo = (unsigned)(srow * ldb + schunk * 8);
    const unsigned a32 = (unsigned)(32 * lda), b32 = (unsigned)(32 * ldb);
    const int ldst = tid * 16;
    const int sw = (lr >> 1) & 7;
    const int rd_a = (wr * 64 + lr) * 128, rd_b = 16384 + (wc * 64 + lr) * 128;
    const int nk = K / 64, last = nk - 1;
    auto issue = [&](int ks, int slot) {
        const unsigned ko = (unsigned)ks * 64u;
        char* st = sm + slot * STG + ldst;
#pragma unroll
        for (int i = 0; i < 4; ++i) __builtin_amdgcn_global_load_lds((const unsigned*)(Ab + (ao + i * a32 + ko)), (unsigned*)(st + i * 4096), 16, 0, 0);
#pragma unroll
        for (int i = 0; i < 4; ++i) __builtin_amdgcn_global_load_lds((const unsigned*)(Bb + (bo + i * b32 + ko)), (unsigned*)(st + 16384 + i * 4096), 16, 0, 0);
    };
    auto compute = [&](int slot) {
        const char* cur = sm + slot * STG;
#pragma unroll
        for (int s = 0; s < 4; ++s) {
            const int so = ((lh + 2 * s) ^ sw) * 16;
            bf16x8 a[2], b[2];
#pragma unroll
            for (int mi = 0; mi < 2; ++mi) a[mi] = *(const bf16x8*)(cur + rd_a + mi * 4096 + so);
#pragma unroll
            for (int ni = 0; ni < 2; ++ni) b[ni] = *(const bf16x8*)(cur + rd_b + ni * 4096 + so);
#pragma unroll
            for (int mi = 0; mi < 2; ++mi)
#pragma unroll
                for (int ni = 0; ni < 2; ++ni) acc[mi][ni] = __builtin_amdgcn_mfma_f32_32x32x16_bf16(a[mi], b[ni], acc[mi][ni], 0, 0, 0);
        }
    };
    __syncthreads();
    issue(0, 0);
#pragma unroll 1
    for (int ks = 0; ks < nk; ++ks) {
        DMA_WAIT(0);
        __builtin_amdgcn_s_barrier();
        if (ks < last) issue(ks + 1, (ks + 1) & 1);
        compute(ks & 1);
    }
    DMA_WAIT(0);
}
struct GStage64 { u32x4 a[4], b[4]; };
__device__ __forceinline__ void tile_mac_reg64(f32x16 (&acc)[2][2], const bf16_t* __restrict__ A, int lda, int m0,
                                               const bf16_t* __restrict__ Bt, int ldb, int n0, int K, char* sm) {
    constexpr int STG = 32768;
    const int tid = tidx(), lane = tid & 63, wid = __builtin_amdgcn_readfirstlane(tid >> 6), wr = wid >> 1, wc = wid & 1;
    const int lr = lane & 31, lh = lane >> 5;
    const int srow = tid >> 3, schunk = (tid & 7) ^ ((tid >> 4) & 7);
    const bf16_t* Ab = A + (size_t)m0 * lda;
    const bf16_t* Bb = Bt + (size_t)n0 * ldb;
    const unsigned ao = (unsigned)(srow * lda + schunk * 8), bo = (unsigned)(srow * ldb + schunk * 8);
    const unsigned a32 = (unsigned)(32 * lda), b32 = (unsigned)(32 * ldb);
    const int ldst = tid * 16;
    const int sw = (lr >> 1) & 7;
    const int rd_a = (wr * 64 + lr) * 128, rd_b = 16384 + (wc * 64 + lr) * 128;
    const int nk = K / 64, last = nk - 1;
    auto gload = [&](GStage64& g, int ks) {
        const unsigned ko = (unsigned)ks * 64u;
#pragma unroll
        for (int i = 0; i < 4; ++i) { g.a[i] = *(const u32x4*)(Ab + (ao + i * a32 + ko)); g.b[i] = *(const u32x4*)(Bb + (bo + i * b32 + ko)); }
    };
    auto lstore = [&](const GStage64& g, int slot) {
        char* st = sm + slot * STG + ldst;
#pragma unroll
        for (int i = 0; i < 4; ++i) { *(u32x4*)(st + i * 4096) = g.a[i]; *(u32x4*)(st + 16384 + i * 4096) = g.b[i]; }
    };
    auto compute = [&](int slot) {
        const char* cur = sm + slot * STG;
        bf16x8 fa[2][2], fb[2][2];
#pragma unroll
        for (int mi = 0; mi < 2; ++mi) fa[0][mi] = *(const bf16x8*)(cur + rd_a + mi * 4096 + ((lh ^ sw) * 16));
#pragma unroll
        for (int ni = 0; ni < 2; ++ni) fb[0][ni] = *(const bf16x8*)(cur + rd_b + ni * 4096 + ((lh ^ sw) * 16));
#pragma unroll
        for (int s = 0; s < 4; ++s) {
            if (s < 3) {
                const int so = ((lh + 2 * (s + 1)) ^ sw) * 16;
#pragma unroll
                for (int mi = 0; mi < 2; ++mi) fa[(s + 1) & 1][mi] = *(const bf16x8*)(cur + rd_a + mi * 4096 + so);
#pragma unroll
                for (int ni = 0; ni < 2; ++ni) fb[(s + 1) & 1][ni] = *(const bf16x8*)(cur + rd_b + ni * 4096 + so);
            }
#pragma unroll
            for (int mi = 0; mi < 2; ++mi)
#pragma unroll
                for (int ni = 0; ni < 2; ++ni) acc[mi][ni] = __builtin_amdgcn_mfma_f32_32x32x16_bf16(fa[s & 1][mi], fb[s & 1][ni], acc[mi][ni], 0, 0, 0);
        }
        __builtin_amdgcn_sched_group_barrier(0x100, 8, 0);
        __builtin_amdgcn_sched_group_barrier(0x008, 4, 0);
        __builtin_amdgcn_sched_group_barrier(0x100, 4, 0);
        __builtin_amdgcn_sched_group_barrier(0x008, 4, 0);
        __builtin_amdgcn_sched_group_barrier(0x100, 4, 0);
        __builtin_amdgcn_sched_group_barrier(0x008, 8, 0);
    };
    GStage64 g0, g1;
    gload(g0, 0);
    gload(g1, min(1, last));
    __syncthreads();
    lstore(g0, 0);
    __syncthreads();
#define GSTEP64(k, GL, GS) { gload(GL, min((k) + 2, last)); compute((k) & 1); lstore(GS, ((k) + 1) & 1); __syncthreads(); }
    int ks = 0;
#pragma unroll 1
    for (; ks + 2 <= nk; ks += 2) {
        GSTEP64(ks, g0, g1)
        GSTEP64(ks + 1, g1, g0)
    }
    if (ks < nk) GSTEP64(ks, g0, g1)
#undef GSTEP64
}
template <int NT> __device__ __forceinline__ void acc_zero(f32x16 (&acc)[2][NT]) {
#pragma unroll
    for (int mi = 0; mi < 2; ++mi)
#pragma unroll
        for (int ni = 0; ni < NT; ++ni)
#pragma unroll
            for (int r = 0; r < 16; ++r) acc[mi][ni][r] = 0.f;
}
template <int BN, class Epi>
__device__ __forceinline__ void gemm_bf16(const bf16_t* A, int lda, const bf16_t* Bt, int ldb, int M, int N, int K, const Epi& epi, int bid, int nb, char* sm) {
    constexpr int NT = BN / 64;
    const int tm = M / 128, tn = (N + BN - 1) / BN;
    for (int tile = bid; tile < tm * tn; tile += nb) {
        const int m0 = (tile % tm) * 128, n0 = (tile / tm) * BN;
        f32x16 acc[2][NT]; acc_zero<NT>(acc);
        if constexpr (BN == 128) { if (K % 64 == 0 && K >= 128) tile_mac_reg64(acc, A, lda, m0, Bt, ldb, n0, K, sm); else tile_mac_dma<GEMM_NST>(acc, A, lda, m0, Bt, ldb, n0, K, sm); }
        else tile_mac<BN>(acc, A, lda, m0, Bt, ldb, n0, N, K, sm);
        const int lane = tidx() & 63, wid = __builtin_amdgcn_readfirstlane(tidx() >> 6), wr = wid >> 1, wc = wid & 1, lr = lane & 31, lh = lane >> 5;
        const int col0 = n0 + wc * (BN / 2);
        if (col0 < N) epi(acc, m0 + wr * 64, col0, lr, lh, sm + (((K / 64) & 1) ? 32768 : 0) + wid * 8192);
    }
}
template <class Epi>
__device__ __forceinline__ int gemm_big(const bf16_t* A, int lda, const bf16_t* Bt, int ldb, int M, int N, int K, const Epi& epi, int bid, int nb, char* sm) {
    const int tm = M / 256, tn = N / 128, ntb = tm * tn, nfull = (ntb / nb) * nb;
    for (int tile = bid; tile < nfull; tile += nb) {
        const int m0 = (tile % tm) * 256, n0 = (tile / tm) * 128;
        f32x16 acc[4][2];
        acc_zero<2>(reinterpret_cast<f32x16 (&)[2][2]>(acc[0])); acc_zero<2>(reinterpret_cast<f32x16 (&)[2][2]>(acc[2]));
        tile_mac_big(acc, A, lda, m0, Bt, ldb, n0, K, sm);
        __syncthreads();
        const int lane = tidx() & 63, wid = __builtin_amdgcn_readfirstlane(tidx() >> 6), wr = wid >> 1, wc = wid & 1, lr = lane & 31, lh = lane >> 5;
        epi(reinterpret_cast<const f32x16 (&)[2][2]>(acc[0]), m0 + wr * 128, n0 + wc * 64, lr, lh, sm + wid * 8192);
        epi(reinterpret_cast<const f32x16 (&)[2][2]>(acc[2]), m0 + wr * 128 + 64, n0 + wc * 64, lr, lh, sm + wid * 8192);
    }
    const int nsmall = 2 * (ntb - nfull);
    for (int st = bid; st < nsmall; st += nb) {
        const int tile = nfull + (st >> 1);
        const int m0 = (tile % tm) * 256 + (st & 1) * 128, n0 = (tile / tm) * 128;
        f32x16 acc[2][2]; acc_zero<2>(acc);
        tile_mac_reg64(acc, A, lda, m0, Bt, ldb, n0, K, sm);
        const int lane = tidx() & 63, wid = __builtin_amdgcn_readfirstlane(tidx() >> 6), wr = wid >> 1, wc = wid & 1, lr = lane & 31, lh = lane >> 5;
        epi(acc, m0 + wr * 64, n0 + wc * 64, lr, lh, sm + (((K / 64) & 1) ? 32768 : 0) + wid * 8192);
    }
    return nsmall < nb ? nsmall : nb;
}
#define EROW(mi, r) (row0 + (mi) * 32 + ((r) & 3) + 8 * ((r) >> 2) + 4 * lh)
__device__ __forceinline__ float bf2f(bf16_t h) { return __uint_as_float((unsigned)h << 16); }
__device__ __forceinline__ void epi_rope64(const f32x16 (&acc)[2][2], int row0, int lr, int lh, const float* __restrict__ rope, bf16_t* __restrict__ dst, int ld, int cbase) {
#pragma unroll
    for (int mi = 0; mi < 2; ++mi)
#pragma unroll
        for (int r = 0; r < 16; ++r) {
            const size_t row = EROW(mi, r);
            const float c = rope[row * 64 + lr], s = rope[row * 64 + 32 + lr], x1 = acc[mi][0][r], x2 = acc[mi][1][r];
            dst[row * ld + cbase + lr] = f2bf(x1 * c - x2 * s); dst[row * ld + cbase + 32 + lr] = f2bf(x2 * c + x1 * s);
        }
}
template <int NTI>
__device__ __forceinline__ void epi_rope32(const f32x16 (&acc)[2][2], int row0, int lr, int lh, const float* __restrict__ rope, bf16_t* __restrict__ dst, int ld, int cbase) {
    const int f = lr & 15;
#pragma unroll
    for (int mi = 0; mi < 2; ++mi)
#pragma unroll
        for (int ni = 0; ni < NTI; ++ni)
#pragma unroll
            for (int r = 0; r < 16; ++r) {
                const size_t row = EROW(mi, r);
                const float x = acc[mi][ni][r], xo = shx<16>(x);
                const float c = rope[row * 64 + 2 * f], s = rope[row * 64 + 32 + 2 * f];
                dst[row * ld + cbase + ni * 32 + lr] = f2bf((lr & 16) ? (x * c + xo * s) : (x * c - xo * s));
            }
}
template <int NT, bool SILU>
__device__ __forceinline__ void epi_bf16(const f32x16 (&acc)[2][NT], int row0, int lr, int lh, bf16_t* __restrict__ dst, int ld, int cbase) {
#pragma unroll
    for (int mi = 0; mi < 2; ++mi)
#pragma unroll
        for (int ni = 0; ni < NT; ++ni)
#pragma unroll
            for (int r = 0; r < 16; ++r) { const float v = acc[mi][ni][r]; dst[(size_t)EROW(mi, r) * ld + cbase + ni * 32 + lr] = f2bf(SILU ? silu_(v) : v); }
}
template <int NT>
__device__ __forceinline__ void epi_vt(const f32x16 (&acc)[2][NT], int trow0, int lr, int lh, bf16_t* __restrict__ vt, size_t ldv) {
#pragma unroll
    for (int mi = 0; mi < 2; ++mi)
#pragma unroll
        for (int ni = 0; ni < NT; ++ni)
#pragma unroll
            for (int g = 0; g < 4; ++g) {
                u32x2 o; o.x = cvt_pk_bf16(acc[mi][ni][4 * g], acc[mi][ni][4 * g + 1]); o.y = cvt_pk_bf16(acc[mi][ni][4 * g + 2], acc[mi][ni][4 * g + 3]);
                *(u32x2*)(vt + (size_t)(ni * 32 + lr) * ldv + trow0 + mi * 32 + 8 * g + 4 * lh) = o;
            }
}
template <int NT>
__device__ __forceinline__ void epi_f32(const f32x16 (&acc)[2][NT], int row0, int lr, int lh, float* __restrict__ dst, int ld, int cbase) {
#pragma unroll
    for (int mi = 0; mi < 2; ++mi)
#pragma unroll
        for (int ni = 0; ni < NT; ++ni)
#pragma unroll
            for (int r = 0; r < 16; ++r) dst[(size_t)EROW(mi, r) * ld + cbase + ni * 32 + lr] = acc[mi][ni][r];
}
template <class F>
__device__ __forceinline__ void staged_bf16_tile(char* stg, bf16_t* dp, size_t ld, int lr, int lh, F val) {
    bf16_t* sg = (bf16_t*)stg;
#pragma unroll
    for (int mi = 0; mi < 2; ++mi)
#pragma unroll
        for (int r = 0; r < 16; ++r) {
            const int rl = mi * 32 + (r & 3) + 8 * (r >> 2) + 4 * lh;
            float o0, o1; val(mi, r, rl, o0, o1);
            sg[rl * 64 + ((((lr >> 3)) ^ (rl & 7)) << 3) + (lr & 7)] = f2bf(o0); sg[rl * 64 + ((((lr >> 3) + 4) ^ (rl & 7)) << 3) + (lr & 7)] = f2bf(o1);
        }
    __builtin_amdgcn_wave_barrier();
    const int lane = lh * 32 + lr;
#pragma unroll
    for (int i = 0; i < 8; ++i) {
        const int piece = lane + 64 * i, rr = piece >> 3, ch = piece & 7;
        const u32x4 v = *(const u32x4*)(sg + rr * 64 + ((ch ^ (rr & 7)) << 3));
        *(u32x4*)(dp + (size_t)rr * ld + ch * 8) = v;
    }
    __builtin_amdgcn_wave_barrier();
}
constexpr float QSCALE = 0.125f * 1.4426950408889634f;
struct EpiInProj {
    const Params& p; int layer;
    __device__ __forceinline__ void operator()(const f32x16 (&acc)[2][2], int row0, int col0, int lr, int lh, char* stg) const {
        const int b = row0 / S, t0 = row0 % S;
        const float* rope = p.ROPE();
        int kind, ld = 256, cbase = 0; size_t off = 0; bool silu = false; float osc = 1.f;
        if (col0 < M_QN)         { kind = 0; off = OFF_QA; cbase = col0 - M_QA; osc = QSCALE; }
        else if (col0 < M_KSLC)  { kind = 0; off = OFF_QN; cbase = col0 - M_QN; osc = QSCALE; }
        else if (col0 == M_KSLC) { kind = 0; off = OFF_KSLC; ld = 64; }
        else if (col0 == M_KWIN) { kind = 0; off = OFF_KWIN; ld = 64; }
        else if (col0 == M_KC)   { kind = 0; off = OFF_KCT; ld = 64; }
        else if (col0 == M_VC)   { kind = 1; off = OFF_VCTOK; ld = 64; }
        else if (col0 < M_KF)    { kind = 1; off = OFF_QF; cbase = col0 - M_QF; osc = QSCALE; }
        else if (col0 < M_QS)    { kind = 1; off = OFF_KF; cbase = col0 - M_KF; }
        else if (col0 < M_KSB)   { kind = 1; off = OFF_QS; cbase = col0 - M_QS; osc = QSCALE; }
        else if (col0 < M_QM)    { kind = 1; off = OFF_KSB; cbase = col0 - M_KSB; }
        else if (col0 < M_VF)    { kind = 1; off = OFF_QM; cbase = col0 - M_QM; osc = QSCALE; }
        else if (col0 < M_VS)    { kind = 2; off = OFF_VFT + ((size_t)(b * 4 + (col0 - M_VF) / 64) * 64) * S * 2; }
        else if (col0 < M_VSLC)  { kind = 2; off = OFF_VST + ((size_t)(b * 4 + (col0 - M_VS) / 64) * 64) * S * 2; }
        else if (col0 == M_VSLC) { kind = 2; off = OFF_VSLCT + ((size_t)b * 64) * S * 2; }
        else if (col0 == M_VWIN) { kind = 2; off = OFF_VWINT + ((size_t)b * 64) * S * 2; }
        else if (col0 < M_SPC)   { kind = 3; off = OFF_QI; ld = 128; cbase = col0 - M_QI; }
        else if (col0 == M_SPC)  { kind = 4; }
        else if (col0 < M_Z)     { kind = 5; off = OFF_CKVR; ld = 128; cbase = col0 - M_CKV; }
        else if (col0 < NPM)     { kind = 1; off = OFF_ZG; ld = 1280; cbase = col0 - M_Z; silu = true; }
        else if (col0 < M_MERGE) { return; }
        else                     { kind = 6; }
        bf16_t* dst = (bf16_t*)(p.ws + off);
        if (kind <= 3) {
            bf16_t* sg = (bf16_t*)stg;
            if (kind == 2) {
#pragma unroll
                for (int mi = 0; mi < 2; ++mi)
#pragma unroll
                    for (int ni = 0; ni < 2; ++ni)
#pragma unroll
                        for (int g = 0; g < 4; ++g) {
                            u32x2 o; o.x = cvt_pk_bf16(acc[mi][ni][4 * g], acc[mi][ni][4 * g + 1]); o.y = cvt_pk_bf16(acc[mi][ni][4 * g + 2], acc[mi][ni][4 * g + 3]);
                            const int d = ni * 32 + lr, tk = mi * 32 + 8 * g + 4 * lh;
                            *(u32x2*)(sg + d * 64 + (((tk >> 3) ^ (d & 7)) << 3) + (tk & 7)) = o;
                        }
            } else {
#pragma unroll
                for (int mi = 0; mi < 2; ++mi)
#pragma unroll
                    for (int r = 0; r < 16; ++r) {
                        const int rl = mi * 32 + (r & 3) + 8 * (r >> 2) + 4 * lh;
                        const size_t row = (size_t)row0 + rl;
                        float o0, o1;
                        if (kind == 0) {
                            const float c = rope[row * 64 + lr], s = rope[row * 64 + 32 + lr], x1 = acc[mi][0][r], x2 = acc[mi][1][r];
                            o0 = x1 * c - x2 * s; o1 = x2 * c + x1 * s;
                        } else if (kind == 3) {
                            const int f = lr & 15;
                            const float c = rope[row * 64 + 2 * f], s = rope[row * 64 + 32 + 2 * f];
                            const float x0 = acc[mi][0][r], x1 = acc[mi][1][r], y0 = shx<16>(x0), y1 = shx<16>(x1);
                            o0 = (lr & 16) ? (x0 * c + y0 * s) : (x0 * c - y0 * s); o1 = (lr & 16) ? (x1 * c + y1 * s) : (x1 * c - y1 * s);
                        } else {
                            o0 = acc[mi][0][r]; o1 = acc[mi][1][r];
                            if (silu) { o0 = silu_(o0); o1 = silu_(o1); }
                        }
                        sg[rl * 64 + ((((lr >> 3)) ^ (rl & 7)) << 3) + (lr & 7)] = f2bf(o0 * osc); sg[rl * 64 + ((((lr >> 3) + 4) ^ (rl & 7)) << 3) + (lr & 7)] = f2bf(o1 * osc);
                        if ((r & 3) == 3) __builtin_amdgcn_sched_barrier(0);
                    }
            }
            __builtin_amdgcn_wave_barrier();
            const size_t ldd = (kind == 2) ? (size_t)S : (size_t)ld;
            bf16_t* dp = (kind == 2) ? (dst + t0) : (dst + (size_t)row0 * ld + cbase);
            const int lane = lh * 32 + lr;
#pragma unroll
            for (int i = 0; i < 8; ++i) {
                const int piece = lane + 64 * i, rr = piece >> 3, ch = piece & 7;
                const u32x4 v = *(const u32x4*)(sg + rr * 64 + ((ch ^ (rr & 7)) << 3));
                *(u32x4*)(dp + (size_t)rr * ldd + ch * 8) = v;
            }
            __builtin_amdgcn_wave_barrier();
        }
        else if (kind == 5) epi_f32<2>(acc, row0, lr, lh, (float*)dst, ld, cbase);
        else if (kind == 6) {
            const int tile = (row0 >> 7) * 40 + ((col0 - M_MERGE) >> 7), wave = ((row0 >> 6) & 1) * 2 + ((col0 >> 6) & 1);
            unsigned char* sp = (unsigned char*)p.SIG() + ((size_t)(tile * 4 + wave) * 4) * 1024 + (size_t)(lh * 32 + lr) * 16;
#define SIGQ(x_) floorf(fmaf(sigmoid_(x_), 255.f, 0.5f))
#pragma unroll
            for (int mi = 0; mi < 2; ++mi)
#pragma unroll
                for (int ni = 0; ni < 2; ++ni) {
                    unsigned wq[4];
#pragma unroll
                    for (int g = 0; g < 4; ++g) {
                        unsigned w = __builtin_amdgcn_cvt_pk_u8_f32(SIGQ(acc[mi][ni][4 * g]), 0, 0u);
                        w = __builtin_amdgcn_cvt_pk_u8_f32(SIGQ(acc[mi][ni][4 * g + 1]), 1, w);
                        w = __builtin_amdgcn_cvt_pk_u8_f32(SIGQ(acc[mi][ni][4 * g + 2]), 2, w);
                        w = __builtin_amdgcn_cvt_pk_u8_f32(SIGQ(acc[mi][ni][4 * g + 3]), 3, w);
                        wq[g] = w;
                    }
                    *(u32x4*)(sp + (size_t)(mi * 2 + ni) * 1024) = u32x4{wq[0], wq[1], wq[2], wq[3]};
                }
#undef SIGQ
        }
        else {
            epi_rope32<1>(acc, row0, lr, lh, rope, p.KI(), 32, 0);
            const float fb = p.fox_bias[layer * 4 + (lr & 3)];
            float* sbase = (lr < 4) ? (p.WI() + lr) : (lr < 8) ? (p.LOGF() + (lr - 4)) : (p.GN() + (lr - 8));
            const int sstride = (lr < 8) ? 4 : 12;
#pragma unroll
            for (int mi = 0; mi < 2; ++mi)
#pragma unroll
                for (int r = 0; r < 16; ++r) {
                    const size_t row = EROW(mi, r); const float v = acc[mi][1][r];
                    const float u = (lr < 8) ? (v + fb) : v;
                    const float e = __builtin_amdgcn_exp2f(-1.4426950408889634f * fabsf(u));
                    const float lsg = fminf(u, 0.f) - __builtin_amdgcn_logf(1.f + e) * 0.6931471805599453f;
                    const float sg = ((u >= 0.f) ? 1.f : e) * __builtin_amdgcn_rcpf(1.f + e);
                    const float o = (lr < 4) ? v * 0.08838834764831845f : ((lr < 8) ? lsg : sg);
                    if (lr < 20) sbase[row * sstride] = o;
                }
        }
    }
};
struct EpiMemKV {
    const Params& p;
    __device__ __forceinline__ void operator()(const f32x16 (&acc)[2][2], int row0, int col0, int lr, int lh, char* stg) const {
        if (col0 < 256) epi_bf16<2, false>(acc, row0, lr, lh, p.MKB(), 256, col0);
        else epi_vt<2>(acc, row0 % NMEM, lr, lh, p.MVT() + ((size_t)((row0 / NMEM) * 4 + (col0 - 256) / 64) * 64) * NMEM, NMEM);
    }
};
struct EpiKA { const Params& p;
    __device__ __forceinline__ void operator()(const f32x16 (&acc)[2][2], int row0, int col0, int lr, int lh, char* stg) const {
        const float* rope = p.ROPE();
        staged_bf16_tile(stg, p.KAB() + (size_t)row0 * 256 + col0, 256, lr, lh, [&](int mi, int r, int rl, float& o0, float& o1) {
            const size_t row = (size_t)row0 + rl;
            const float c = rope[row * 64 + lr], sn = rope[row * 64 + 32 + lr], x1 = acc[mi][0][r], x2 = acc[mi][1][r];
            o0 = x1 * c - x2 * sn; o1 = x2 * c + x1 * sn; });
    } };
struct EpiVA { const Params& p;
    __device__ __forceinline__ void operator()(const f32x16 (&acc)[2][2], int row0, int col0, int lr, int lh, char* stg) const {
        epi_vt<2>(acc, row0 % S, lr, lh, p.VAT() + ((size_t)((row0 / S) * 4 + col0 / 64) * 64) * S, S); } };
struct EpiResid { const float* Xin; float* Xout;
    __device__ __forceinline__ void operator()(const f32x16 (&acc)[2][2], int row0, int col0, int lr, int lh, char* stg) const {
#pragma unroll
        for (int mi = 0; mi < 2; ++mi) {
            float xv[2][16];
#pragma unroll
            for (int ni = 0; ni < 2; ++ni)
#pragma unroll
                for (int r = 0; r < 16; ++r) xv[ni][r] = Xin[(size_t)EROW(mi, r) * D + col0 + ni * 32 + lr];
#pragma unroll
            for (int ni = 0; ni < 2; ++ni)
#pragma unroll
                for (int r = 0; r < 16; ++r) Xout[(size_t)EROW(mi, r) * D + col0 + ni * 32 + lr] = xv[ni][r] + acc[mi][ni][r];
        }
    } };
struct EpiCmp1 { const float* bias; bf16_t* hid;
    __device__ __forceinline__ void operator()(const f32x16 (&acc)[2][2], int row0, int col0, int lr, int lh, char* stg) const {
#pragma unroll
        for (int ni = 0; ni < 2; ++ni) {
            const float bv = bias[col0 + ni * 32 + lr];
#pragma unroll
            for (int mi = 0; mi < 2; ++mi)
#pragma unroll
                for (int r = 0; r < 16; ++r) hid[(size_t)EROW(mi, r) * 128 + col0 + ni * 32 + lr] = f2bf(silu_(acc[mi][ni][r] + bv));
        }
    } };
struct EpiCmp2K { bf16_t* kcb;
    __device__ __forceinline__ void operator()(const f32x16 (&acc)[2][1], int row0, int col0, int lr, int lh, char* stg) const {
#pragma unroll
        for (int mi = 0; mi < 2; ++mi)
#pragma unroll
            for (int r = 0; r < 16; ++r) { const int row = EROW(mi, r); kcb[(size_t)row * 64 + col0 + lr] = ((row & 511) == 511) ? (bf16_t)0 : f2bf(acc[mi][0][r]); }
    } };
struct EpiCmp2V { bf16_t* vct;
    __device__ __forceinline__ void operator()(const f32x16 (&acc)[2][1], int row0, int col0, int lr, int lh, char* stg) const {
        bf16_t* base = vct + ((size_t)(row0 / 512) * 64 + col0) * 512;
        const int n0 = row0 % 512;
#pragma unroll
        for (int mi = 0; mi < 2; ++mi)
#pragma unroll
            for (int g = 0; g < 4; ++g) {
                const int n = n0 + mi * 32 + 8 * g + 4 * lh;
                u32x2 o; o.x = cvt_pk_bf16(acc[mi][0][4 * g], acc[mi][0][4 * g + 1]); o.y = cvt_pk_bf16(acc[mi][0][4 * g + 2], (n + 3 == 511) ? 0.f : acc[mi][0][4 * g + 3]);
                *(u32x2*)(base + (size_t)lr * 512 + n) = o;
            }
    } };

__device__ __forceinline__ void ph_merge(const Params& p, int layer, int bid, int nb, char* sm) {
    const int lane = tidx() & 63, wid = __builtin_amdgcn_readfirstlane(tidx() >> 6), wr = wid >> 1, wc = wid & 1, lr = lane & 31, lh = lane >> 5;
    for (int tile = bid; tile < (T / 128) * (D / 128); tile += nb) {
        const int mt = tile % (T / 128), nt = tile / (T / 128), m0 = mt * 128, n0 = nt * 128;
        f32x16 mg[2][2]; acc_zero<2>(mg);
#pragma unroll 1
        for (int n = 0; n < 5; ++n) {
            f32x16 g[2][2]; acc_zero<2>(g);
            const unsigned char* sp = (const unsigned char*)p.SIG() + ((size_t)((mt * 40 + n * 8 + nt) * 4 + wid) * 4) * 1024 + (size_t)lane * 16;
            u32x4 sgw[4];
#pragma unroll
            for (int i = 0; i < 4; ++i) sgw[i] = *(const u32x4*)(sp + (size_t)i * 1024);
            tile_mac_dma64(g, p.Y() + n * 256, 1280, m0, p.WBR() + ((size_t)layer * 5 + n) * D * 256, 256, n0, 256, sm);
#pragma unroll
            for (int mi = 0; mi < 2; ++mi)
#pragma unroll
                for (int ni = 0; ni < 2; ++ni) {
                    const u32x4 w = sgw[mi * 2 + ni];
                    const unsigned sw[4] = {w.x, w.y, w.z, w.w};
#pragma unroll
                    for (int q = 0; q < 4; ++q) {
                        mg[mi][ni][4 * q] = fmaf((float)(sw[q] & 255u), g[mi][ni][4 * q], mg[mi][ni][4 * q]);
                        mg[mi][ni][4 * q + 1] = fmaf((float)((sw[q] >> 8) & 255u), g[mi][ni][4 * q + 1], mg[mi][ni][4 * q + 1]);
                        mg[mi][ni][4 * q + 2] = fmaf((float)((sw[q] >> 16) & 255u), g[mi][ni][4 * q + 2], mg[mi][ni][4 * q + 2]);
                        mg[mi][ni][4 * q + 3] = fmaf((float)(sw[q] >> 24), g[mi][ni][4 * q + 3], mg[mi][ni][4 * q + 3]);
                    }
                }
        }
        __syncthreads();
        staged_bf16_tile(sm + wid * 8192, p.MG() + (size_t)(m0 + wr * 64) * D + n0 + wc * 64, D, lr, lh,
                         [&](int mi, int r, int, float& o0, float& o1) { o0 = mg[mi][0][r] * (1.f / 255.f); o1 = mg[mi][1][r] * (1.f / 255.f); });
    }
}

__device__ __forceinline__ void ph_cumsum(const Params& p, int bid, int nb, float* sm) {
    const int tid = tidx();
    float* buf = sm;
    float* ps = sm + 8192 + 256;
    for (int u = bid; u < NBATCH * 4; u += nb) {
        const int b = u >> 2, h = u & 3;
        const float4* src4 = (const float4*)(p.LOGF() + (size_t)b * S * 4);
        __syncthreads();
#pragma unroll 8
        for (int i = 0; i < 32; ++i) {
            const int tok = i * 256 + tid;
            const float4 v = src4[tok];
            buf[tok + (tok >> 5)] = (h == 0) ? v.x : (h == 1) ? v.y : (h == 2) ? v.z : v.w;
        }
        __syncthreads();
        float run = 0.f;
#pragma unroll 8
        for (int j = 0; j < 32; ++j) { run += buf[tid * 33 + j]; buf[tid * 33 + j] = run; }
        ps[tid] = run;
        __syncthreads();
        for (int off = 1; off < 256; off <<= 1) {
            float t = 0.f;
            if (tid >= off) t = ps[tid - off];
            __syncthreads();
            ps[tid] += t;
            __syncthreads();
        }
        const float pre = (tid > 0) ? ps[tid - 1] : 0.f;
#pragma unroll 8
        for (int j = 0; j < 32; ++j) buf[tid * 33 + j] = (buf[tid * 33 + j] + pre) * 1.4426950408889634f;
        __syncthreads();
        float* dst = p.CUMT() + (size_t)u * S;
#pragma unroll 8
        for (int i = 0; i < 32; ++i) { const int tok = i * 256 + tid; dst[tok] = buf[tok + (tok >> 5)]; }
    }
    __syncthreads();
}

enum { AM_FOX = 0, AM_DSA = 1, AM_SLC = 2, AM_SB = 3, AM_WIN = 4, AM_MEM = 5, AM_CMP = 6 };
constexpr int AK_ROW = 144;
constexpr int AK_TILE = 64 * AK_ROW;
constexpr int ABUF = 2 * AK_TILE + 256;
constexpr int ATT_NST = 3, ATT_STAGE = 16384 + 1024;
constexpr float LOG2E = 1.4426950408889634f;
#define NEG_INF (-__builtin_inff())

template <int MODE>
__device__ __forceinline__ void attn_core(const Params& p, int b, int head, int qblk, char* sm, f32x16 (&O)[2], float& inv) {
    const int tid = tidx(), lane = tid & 63, wid = __builtin_amdgcn_readfirstlane(tid >> 6), lr = lane & 31, lh = lane >> 5;
    const int q0 = qblk * 128, qw0 = q0 + 32 * wid, tq = qw0 + lr;
    const size_t gq = (size_t)b * S + tq;
    const bf16_t *Qp, *Kp, *VTp; int ldk, ldv;
    if (MODE == AM_FOX)      { Qp = p.QF() + gq * 256 + head * 64; Kp = p.KF() + (size_t)b * S * 256 + head * 64; ldk = 256; VTp = p.VFT() + ((size_t)(b * 4 + head) * 64) * S; ldv = S; }
    else if (MODE == AM_DSA) { Qp = p.QA() + gq * 256 + head * 64; Kp = p.KAB() + (size_t)b * S * 256 + head * 64; ldk = 256; VTp = p.VAT() + ((size_t)(b * 4 + head) * 64) * S; ldv = S; }
    else if (MODE == AM_SB)  { Qp = p.QS() + gq * 256 + head * 64; Kp = p.KSB() + (size_t)b * S * 256 + head * 64; ldk = 256; VTp = p.VST() + ((size_t)(b * 4 + head) * 64) * S; ldv = S; }
    else if (MODE == AM_SLC) { Qp = p.QN() + gq * 256 + head * 64; Kp = p.KSLC() + (size_t)b * S * 64; ldk = 64; VTp = p.VSLCT() + ((size_t)b * 64) * S; ldv = S; }
    else if (MODE == AM_WIN) { Qp = p.QN() + gq * 256 + head * 64; Kp = p.KWIN() + (size_t)b * S * 64; ldk = 64; VTp = p.VWINT() + ((size_t)b * 64) * S; ldv = S; }
    else if (MODE == AM_CMP) { Qp = p.QN() + gq * 256 + head * 64; Kp = p.KCB() + (size_t)b * NCMP_PAD * 64; ldk = 64; VTp = p.VCT() + ((size_t)b * 64) * NCMP_PAD; ldv = NCMP_PAD; }
    else                     { Qp = p.QM() + gq * 256 + head * 64; Kp = p.MKB() + (size_t)b * NMEM * 256 + head * 64; ldk = 256; VTp = p.MVT() + ((size_t)(b * 4 + head) * 64) * NMEM; ldv = NMEM; }
    int kt_lo = 0, kt_hi = 2 * qblk + 2;
    if (MODE == AM_WIN) kt_lo = q0 >= 512 ? (q0 - 512) / 64 : 0;
    if (MODE == AM_MEM) kt_hi = NMEM / 64;
    if (MODE == AM_CMP) kt_hi = min(8, (((q0 + 96) >> 4) >> 6) + 1);
    const int nlim = (tq - 31) >> 4;
    const int ntile = kt_hi - kt_lo;
    constexpr bool REV = (MODE == AM_SB);

    bf16x8 qf[4];
#pragma unroll
    for (int s = 0; s < 4; ++s) qf[s] = *(const bf16x8*)(Qp + 16 * s + 8 * lh);
    unsigned smw[4] = {0u, 0u, 0u, 0u};
    if (MODE == AM_SLC) { const u32x4 w = *(const u32x4*)(p.SMASK() + gq * 4); smw[0] = w.x; smw[1] = w.y; smw[2] = w.z; smw[3] = w.w; }
    const unsigned* mrow32 = p.DMASK() + ((size_t)b * 128 * S + qw0) * 2;
    const float* csp = p.CUMT() + (size_t)(b * 4 + head) * S;

    const int srow = tid >> 3, schunk = (tid & 7) ^ ((srow >> 1) & 7);
    const bf16_t* kg0 = Kp + (size_t)srow * ldk + schunk * 8;
    const bf16_t* vg0 = VTp + (size_t)srow * ldv + schunk * 8;
    const int ldst = tid * 16;
    auto issue = [&](int kt, int slot) {
        char* st = sm + slot * ATT_STAGE + ldst;
        const bf16_t* kgp = kg0 + (size_t)kt * 64 * ldk;
        const bf16_t* vgp = vg0 + kt * 64;
        __builtin_amdgcn_global_load_lds((const unsigned*)kgp, (unsigned*)st, 16, 0, 0);
        __builtin_amdgcn_global_load_lds((const unsigned*)(kgp + (size_t)32 * ldk), (unsigned*)(st + 4096), 16, 0, 0);
        __builtin_amdgcn_global_load_lds((const unsigned*)vgp, (unsigned*)(st + 8192), 16, 0, 0);
        __builtin_amdgcn_global_load_lds((const unsigned*)(vgp + (size_t)32 * ldv), (unsigned*)(st + 12288), 16, 0, 0);
        if (MODE == AM_FOX) __builtin_amdgcn_global_load_lds((const unsigned*)(csp + kt * 64 + lane), (unsigned*)(sm + slot * ATT_STAGE + 16384 + tid * 4), 4, 0, 0);
        if (MODE == AM_DSA) __builtin_amdgcn_global_load_lds((const unsigned*)(mrow32 + (size_t)kt * S * 2 + lane), (unsigned*)(sm + slot * ATT_STAGE + 16384 + tid * 4), 4, 0, 0);
    };
    const int pil = (lr & 0x13) | ((lr & 4) << 1) | ((lr & 8) >> 1);
    const int ksw = (pil >> 1) & 7, vsw = (lr >> 1) & 7;
    int rdk[4], rdv[4];
#pragma unroll
    for (int j = 0; j < 4; ++j) { rdk[j] = pil * 128 + (((2 * j + lh) ^ ksw) << 4); rdv[j] = 8192 + lr * 128 + (((2 * j + lh) ^ vsw) << 4); }

    float m = NEG_INF, l = 0.f, R = 1.f;
#pragma unroll
    for (int i = 0; i < 16; ++i) { O[0][i] = 0.f; O[1][i] = 0.f; }

    static_assert(ATT_NST == 3, "the vmcnt arithmetic below is written for a 3-stage ring");
    __syncthreads();
    auto tile_of = [&](int it) { const int c = min(it, ntile - 1); return REV ? kt_hi - 1 - c : kt_lo + c; };
    issue(tile_of(0), 0);
    issue(tile_of(1), 1);
    int slot = 0, nslot = ATT_NST - 1;
#pragma unroll 1
    for (int it = 0; it < ntile; ++it) {
        const int kt = REV ? kt_hi - 1 - it : kt_lo + it;
        constexpr int NPER = (MODE == AM_FOX || MODE == AM_DSA) ? 5 : 4;
        if (NPER == 5) DMA_WAIT(5); else DMA_WAIT(4);
        __builtin_amdgcn_s_barrier();
        const char* cur = sm + slot * ATT_STAGE;
        unsigned long long mw = 0ull;
        if (MODE == AM_DSA) mw = *(const unsigned long long*)(cur + 16384 + wid * 256 + lr * 8);
        issue(tile_of(it + ATT_NST - 1), nslot);
        slot = (slot + 1 == ATT_NST) ? 0 : slot + 1; nslot = (nslot + 1 == ATT_NST) ? 0 : nslot + 1;
        bool need = true;
        if (MODE == AM_CMP) need = kt * 64 <= (qw0 >> 4);
        else if (MODE != AM_MEM) need = kt * 64 <= qw0 + 31;
        if (MODE == AM_WIN) need = need && (kt * 64 + 63 >= qw0 - 511);
        if (need) {
            f32x16 sv[2];
#pragma unroll
            for (int sub = 0; sub < 2; ++sub) {
                f32x16 a;
#pragma unroll
                for (int i = 0; i < 16; ++i) a[i] = 0.f;
#pragma unroll
                for (int s4 = 0; s4 < 4; ++s4) {
                    const bf16x8 kf = *(const bf16x8*)(cur + rdk[s4] + sub * 4096);
                    a = __builtin_amdgcn_mfma_f32_32x32x16_bf16(kf, qf[s4], a, 0, 0, 0);
                }
                sv[sub] = a;
            }
            if (MODE == AM_SB) {
#pragma unroll
                for (int sb2 = 0; sb2 < 2; ++sb2) {
                    const int sub = 1 - sb2;
                    {
                        f32x16& s = sv[sub];
                        const int thl = tq - (kt * 64 + sub * 32) - 8 * lh;
                        f32x2 kp[8], sg[8];
                        const bool dgl = (kt * 64 + sub * 32 + 31) >= qw0;
                        const f32x2 one2 = {1.f, 1.f};
#pragma unroll
                        for (int r = 0; r < 8; ++r) {
                            const float z0 = __builtin_amdgcn_fmed3f(s[r], -64.f, 64.f), z1 = __builtin_amdgcn_fmed3f(s[r + 8], -64.f, 64.f);
                            f32x2 e = {__builtin_amdgcn_exp2f(-z0), __builtin_amdgcn_exp2f(-z1)};
                            const f32x2 d = e + one2;
                            const f32x2 rc = {__builtin_amdgcn_rcpf(d.x), __builtin_amdgcn_rcpf(d.y)};
                            kp[r] = e * rc; sg[r] = rc;
                        }
                        if (dgl) {
#pragma unroll
                            for (int r = 0; r < 8; ++r) {
                                const bool ok0 = r < thl, ok1 = (r + 16) < thl;
                                kp[r].x = ok0 ? kp[r].x : 1.f; sg[r].x = ok0 ? sg[r].x : 0.f;
                                kp[r].y = ok1 ? kp[r].y : 1.f; sg[r].y = ok1 ? sg[r].y : 0.f;
                            }
                        }
                        const f32x2 g2 = ((kp[0] * kp[1]) * (kp[2] * kp[3])) * ((kp[4] * kp[5]) * (kp[6] * kp[7]));
                        float gA, gB, gC, gD;
                        half_pair(g2.x, gA, gB); half_pair(g2.y, gC, gD);
                        f32x2 run = {R * ((gC * gD) * (lh == 0 ? gB : 1.f)), R * (lh == 0 ? gD : 1.f)};
#pragma unroll
                        for (int r = 7; r >= 0; --r) {
                            const f32x2 w = sg[r] * run; run *= kp[r];
                            s[r] = w.x; s[8 + r] = w.y;
                        }
                        R *= (gA * gB) * (gC * gD);
                    }
                }
            } else {
#pragma unroll
                for (int sub = 0; sub < 2; ++sub) {
                    f32x16& s = sv[sub];
                    const int kb = kt * 64 + sub * 32;
                    const int thl = tq - kb - 8 * lh;
                    {
                        if (MODE == AM_FOX) {
                            const float4* cs4 = (const float4*)(cur + 16384 + wid * 256 + (sub * 32 + 8 * lh) * 4);
                            const float4 c0 = cs4[0], c1 = cs4[1], c2 = cs4[4], c3 = cs4[5];
                            const float cv[16] = {c0.x, c0.y, c0.z, c0.w, c1.x, c1.y, c1.z, c1.w, c2.x, c2.y, c2.z, c2.w, c3.x, c3.y, c3.z, c3.w};
#pragma unroll
                            for (int r = 0; r < 16; ++r) s[r] -= cv[r];
                        }
                        if (MODE == AM_DSA) {
                            const unsigned w = (unsigned)(mw >> (32 * sub)) >> (8 * lh);
#pragma unroll
                            for (int r = 0; r < 16; ++r) {
                                const int cr = 16 * (r >> 3) + (r & 7);
                                const unsigned mk = (unsigned)__builtin_amdgcn_sbfe((int)w, cr, 1);
                                s[r] = __uint_as_float(__builtin_amdgcn_bitop3_b32(mk, __float_as_uint(s[r]), 0xff800000u, 0xCA));
                            }
                        }
                        if (MODE == AM_SLC) {
                            const unsigned w = smw[0] * (kt < 32) + smw[1] * (kt >= 32 && kt < 64) + smw[2] * (kt >= 64 && kt < 96) + smw[3] * (kt >= 96);
                            const bool sel = (w >> (kt & 31)) & 1u;
#pragma unroll
                            for (int r = 0; r < 16; ++r) s[r] = sel ? s[r] : NEG_INF;
                        }
                        if (MODE == AM_FOX || MODE == AM_SLC) {
                            if (kb + 31 > qw0) {
#pragma unroll
                                for (int r = 0; r < 16; ++r) { const int cr = 16 * (r >> 3) + (r & 7); s[r] = (cr <= thl) ? s[r] : NEG_INF; }
                            }
                        }
                        if (MODE == AM_CMP) {
                            const int tc = nlim - kb - 8 * lh;
#pragma unroll
                            for (int r = 0; r < 16; ++r) { const int cr = 16 * (r >> 3) + (r & 7); s[r] = (cr <= tc) ? s[r] : NEG_INF; }
                        }
                        if (MODE == AM_WIN) {
                            if (kb + 31 > qw0 || kb < qw0 + 31 - 511) {
#pragma unroll
                                for (int r = 0; r < 16; ++r) { const int cr = 16 * (r >> 3) + (r & 7); s[r] = (cr <= thl && cr > thl - 512) ? s[r] : NEG_INF; }
                            }
                        }
                    }
                }
                constexpr bool RAW = (MODE == AM_MEM || MODE == AM_WIN);
                float tmax;
#define MAX3_8 "v_max3_f32 %0, %0, %1, %2\n\tv_max3_f32 %0, %0, %3, %4\n\tv_max3_f32 %0, %0, %5, %6\n\tv_max3_f32 %0, %0, %7, %8\n\tv_max3_f32 %0, %0, %9, %10\n\tv_max3_f32 %0, %0, %11, %12\n\tv_max3_f32 %0, %0, %13, %14\n\tv_max3_f32 %0, %0, %15, %16"
                tmax = m;
                if (RAW) asm("s_nop 15\n\ts_nop 7\n\t" MAX3_8 : "+v"(tmax) : "v"(sv[0][0]), "v"(sv[1][0]), "v"(sv[0][1]), "v"(sv[1][1]), "v"(sv[0][2]), "v"(sv[1][2]), "v"(sv[0][3]), "v"(sv[1][3]),
                                  "v"(sv[0][4]), "v"(sv[1][4]), "v"(sv[0][5]), "v"(sv[1][5]), "v"(sv[0][6]), "v"(sv[1][6]), "v"(sv[0][7]), "v"(sv[1][7]));
                else asm(MAX3_8 : "+v"(tmax) : "v"(sv[0][0]), "v"(sv[1][0]), "v"(sv[0][1]), "v"(sv[1][1]), "v"(sv[0][2]), "v"(sv[1][2]), "v"(sv[0][3]), "v"(sv[1][3]),
                                  "v"(sv[0][4]), "v"(sv[1][4]), "v"(sv[0][5]), "v"(sv[1][5]), "v"(sv[0][6]), "v"(sv[1][6]), "v"(sv[0][7]), "v"(sv[1][7]));
                asm(MAX3_8 : "+v"(tmax) : "v"(sv[0][8]), "v"(sv[1][8]), "v"(sv[0][9]), "v"(sv[1][9]), "v"(sv[0][10]), "v"(sv[1][10]), "v"(sv[0][11]), "v"(sv[1][11]),
                                  "v"(sv[0][12]), "v"(sv[1][12]), "v"(sv[0][13]), "v"(sv[1][13]), "v"(sv[0][14]), "v"(sv[1][14]), "v"(sv[0][15]), "v"(sv[1][15]));
#undef MAX3_8
                tmax = fmaxf(tmax, m);
                const float mn = half_max(tmax);
                const float mu = (mn == NEG_INF) ? 0.f : mn;
                const float corr = __builtin_amdgcn_exp2f(m - mu);
                m = mn;
                const f32x2 mu2 = {mu, mu};
                f32x2 lsa = {0.f, 0.f}, lsb = {0.f, 0.f};
#pragma unroll
                for (int i = 0; i < 8; ++i) {
                    f32x2 a = {sv[0][2 * i], sv[0][2 * i + 1]}, c = {sv[1][2 * i], sv[1][2 * i + 1]};
                    a -= mu2; c -= mu2;
                    a.x = __builtin_amdgcn_exp2f(a.x); a.y = __builtin_amdgcn_exp2f(a.y); c.x = __builtin_amdgcn_exp2f(c.x); c.y = __builtin_amdgcn_exp2f(c.y);
                    sv[0][2 * i] = a.x; sv[0][2 * i + 1] = a.y; sv[1][2 * i] = c.x; sv[1][2 * i + 1] = c.y;
                    lsa += a; lsb += c;
                }
                lsa += lsb;
                l = l * corr + (lsa.x + lsa.y);
                if (!__all(corr == 1.0f)) {
#pragma unroll
                    for (int i = 0; i < 16; ++i) { O[0][i] *= corr; O[1][i] *= corr; }
                }
            }
#pragma unroll
            for (int sub = 0; sub < 2; ++sub) {
                {
                    const f32x16& s = sv[sub];
                    u32x4 w0, w1;
                    w0.x = cvt_pk_bf16(s[0], s[1]); w0.y = cvt_pk_bf16(s[2], s[3]); w0.z = cvt_pk_bf16(s[4], s[5]); w0.w = cvt_pk_bf16(s[6], s[7]);
                    w1.x = cvt_pk_bf16(s[8], s[9]); w1.y = cvt_pk_bf16(s[10], s[11]); w1.z = cvt_pk_bf16(s[12], s[13]); w1.w = cvt_pk_bf16(s[14], s[15]);
                    const bf16x8 pf0 = __builtin_bit_cast(bf16x8, w0), pf1 = __builtin_bit_cast(bf16x8, w1);
#pragma unroll
                    for (int dt = 0; dt < 2; ++dt) {
                        const bf16x8 vf0 = *(const bf16x8*)(cur + rdv[sub * 2] + dt * 4096);
                        const bf16x8 vf1 = *(const bf16x8*)(cur + rdv[sub * 2 + 1] + dt * 4096);
                        O[dt] = __builtin_amdgcn_mfma_f32_32x32x16_bf16(vf0, pf0, O[dt], 0, 0, 0);
                        O[dt] = __builtin_amdgcn_mfma_f32_32x32x16_bf16(vf1, pf1, O[dt], 0, 0, 0);
                    }
                }
            }
        }
    }
    DMA_WAIT(0);
    inv = 1.f;
    if (MODE != AM_SB) { const float lt = half_sum(l); inv = 1.f / fmaxf(lt, 1e-30f); }
}
__device__ __forceinline__ void attn_store_gated(const Params& p, int b, int head, int qblk, int yc, const f32x16 (&O)[2], float scale) {
    const int tid = tidx(), lane = tid & 63, wid = __builtin_amdgcn_readfirstlane(tid >> 6), lr = lane & 31, lh = lane >> 5;
    const size_t gq = (size_t)b * S + qblk * 128 + 32 * wid + lr;
    const bf16_t* zp = p.ZG() + gq * 1280 + yc + head * 64;
    bf16_t* dst = p.Y() + gq * 1280 + yc + head * 64;
#pragma unroll
    for (int dt = 0; dt < 2; ++dt)
#pragma unroll
        for (int g = 0; g < 4; ++g) {
            const int d0 = 32 * dt + 8 * g + 4 * lh;
            const u32x2 z = *(const u32x2*)(zp + d0);
            u32x2 o;
            o.x = cvt_pk_bf16(O[dt][4 * g] * scale * __uint_as_float(z.x << 16), O[dt][4 * g + 1] * scale * __uint_as_float(z.x & 0xffff0000u));
            o.y = cvt_pk_bf16(O[dt][4 * g + 2] * scale * __uint_as_float(z.y << 16), O[dt][4 * g + 3] * scale * __uint_as_float(z.y & 0xffff0000u));
            *(u32x2*)(dst + d0) = o;
        }
}
template <int MODE>
__device__ __forceinline__ void attn_unit(const Params& p, int b, int head, int qblk, char* sm) {
    f32x16 O[2]; float inv;
    attn_core<MODE>(p, b, head, qblk, sm, O, inv);
    attn_store_gated(p, b, head, qblk, MODE == AM_FOX ? 256 : MODE == AM_DSA ? 0 : MODE == AM_SB ? 512 : 1024, O, inv);
}
__device__ __forceinline__ void nsa_unit(const Params& p, int b, int head, int qblk, char* sm) {
    const int tid = tidx(), wid = __builtin_amdgcn_readfirstlane(tid >> 6), lr = tid & 31;
    const size_t gq = (size_t)b * S + qblk * 128 + 32 * wid + lr;
    const float g0 = p.GN()[gq * 12 + head], g1 = p.GN()[gq * 12 + 4 + head], g2 = p.GN()[gq * 12 + 8 + head];
    f32x16 Y[2], O[2]; float inv;
    attn_core<AM_CMP>(p, b, head, qblk, sm, O, inv);
    { const float s = g0 * inv;
#pragma unroll
      for (int i = 0; i < 16; ++i) { Y[0][i] = O[0][i] * s; Y[1][i] = O[1][i] * s; } }
    attn_core<AM_WIN>(p, b, head, qblk, sm, O, inv);
    { const float s = g2 * inv;
#pragma unroll
      for (int i = 0; i < 16; ++i) { Y[0][i] = fmaf(O[0][i], s, Y[0][i]); Y[1][i] = fmaf(O[1][i], s, Y[1][i]); } }
    attn_core<AM_SLC>(p, b, head, qblk, sm, O, inv);
    { const float s = g1 * inv;
#pragma unroll
      for (int i = 0; i < 16; ++i) { Y[0][i] = fmaf(O[0][i], s, Y[0][i]); Y[1][i] = fmaf(O[1][i], s, Y[1][i]); } }
    attn_store_gated(p, b, head, qblk, 768, Y, 1.f);
}

__device__ __forceinline__ unsigned sortable_key(float x) { const unsigned u = __float_as_uint(x); return u ^ ((unsigned)((int)u >> 31) | 0x80000000u); }
#ifndef DIAG
#define DIAG 0
#endif
#if DIAG
#define UNIT_ATTR
#else
#define UNIT_ATTR
#endif
UNIT_ATTR __device__ __forceinline__ void dsa_select_unit(const Params& p, int b, int qt, char* sm) {
    const int tid = tidx(), lane = tid & 63, wid = __builtin_amdgcn_readfirstlane(tid >> 6), lr = lane & 31, lh = lane >> 5;
    unsigned* hist = (unsigned*)sm;
    unsigned* st_prefix = (unsigned*)(sm + 32 * 257 * 4);
    int* st_krem = (int*)(st_prefix + 32);
    int* st_part = st_krem + 32;
    const int q0 = qt * 32, tq = q0 + lr, ntile = qt + 1, lrh = lr - 4 * lh;
    const size_t gq = (size_t)b * S + tq;
    bf16x8 qf[4][2];
    float w[4];
#pragma unroll
    for (int h = 0; h < 4; ++h) {
        qf[h][0] = *(const bf16x8*)(p.QI() + gq * 128 + h * 32 + 8 * lh);
        qf[h][1] = *(const bf16x8*)(p.QI() + gq * 128 + h * 32 + 16 + 8 * lh);
        w[h] = p.WI()[gq * 4 + h];
    }
    const bf16_t* kbase = p.KI() + (size_t)b * S * 32 + (size_t)lr * 32 + 8 * lh;
    auto score_tile = [&](const bf16x8& k0, const bf16x8& k1, unsigned (&key)[16]) {
        float sc[16];
#pragma unroll
        for (int r = 0; r < 16; ++r) sc[r] = 0.f;
#pragma unroll
        for (int h = 0; h < 4; ++h) {
            f32x16 a;
#pragma unroll
            for (int r = 0; r < 16; ++r) a[r] = 0.f;
            a = __builtin_amdgcn_mfma_f32_32x32x16_bf16(k0, qf[h][0], a, 0, 0, 0);
            a = __builtin_amdgcn_mfma_f32_32x32x16_bf16(k1, qf[h][1], a, 0, 0, 0);
#pragma unroll
            for (int r = 0; r < 16; ++r) sc[r] = fmaf(__int_as_float(max(__float_as_int(a[r]), 0)), w[h], sc[r]);
        }
#pragma unroll
        for (int r = 0; r < 16; ++r) key[r] = sortable_key(sc[r]);
    };
#define KLOAD(kt_, a_, b_) { const bf16_t* kp_ = kbase + (size_t)min((kt_), qt) * (32 * 32); a_ = *(const bf16x8*)kp_; b_ = *(const bf16x8*)(kp_ + 16); }
    auto tie_fix = [&](int allow_total) {
        const unsigned* tiew = hist;
        const int q = tid >> 3, part = tid & 7;
        const unsigned* tr = tiew + q * 257 + part * 32;
        int c = 0;
#pragma unroll 8
        for (int i = 0; i < 32; ++i) c += __builtin_popcount(tr[i]);
        st_part[q * 8 + part] = c;
        __syncthreads();
        int base = 0;
        for (int pp = 0; pp < part; ++pp) base += st_part[q * 8 + pp];
        int allow = allow_total - base;
        unsigned* grow = p.DMASK() + ((size_t)b * 128 * S + q0 + q) * 2;
        if (c > 0 && allow > 0) {
            for (int i = 0; i < 32 && allow > 0; ++i) {
                unsigned wv = tr[i];
                if (wv == 0u) continue;
                const int pc = __builtin_popcount(wv);
                if (pc > allow) { unsigned kept = 0u; for (int j = 0; j < allow; ++j) { const unsigned low = wv & (0u - wv); kept |= low; wv ^= low; } wv = kept; }
                { const int kt = part * 32 + i; atomicOr(grow + (size_t)(kt >> 1) * 2 * S + (kt & 1), wv); }
                allow -= pc;
            }
        }
    };
    unsigned prefix = 0u;
    bool fast = false;
#pragma unroll 1
    for (int pass = 0; pass < 4; ++pass) {
        const int shift = 24 - 8 * pass;
        __syncthreads();
        for (int i = tid; i < 32 * 257; i += 256) hist[i] = 0u;
        __syncthreads();
        bf16x8 k0, k1; KLOAD(wid, k0, k1)
        auto hist_tile = [&](auto first_tag, auto diag_tag) {
            constexpr bool FIRST = decltype(first_tag)::value, DG = decltype(diag_tag)::value;
            unsigned key[16];
            score_tile(k0, k1, key);
#pragma unroll
            for (int r = 0; r < 16; ++r) {
                const int rho0 = (r & 3) + 8 * (r >> 2);
                bool ok = true;
                if (DG) ok = rho0 <= lrh;
                if (!FIRST) ok = ok && ((key[r] >> (shift + 8)) == prefix);
                if (FIRST) atomicAdd(&hist[lr * 257 + ((!DG || ok) ? ((key[r] >> shift) & 255u) : 256u)], 1u);
                else if (__any(ok)) atomicAdd(&hist[lr * 257 + (ok ? ((key[r] >> shift) & 255u) : 256u)], 1u);
            }
        };
        using T_ = std::true_type; using F_ = std::false_type;
#pragma unroll 1
        for (int kt = wid; kt < ntile; kt += 4) {
            bf16x8 n0, n1; KLOAD(kt + 4, n0, n1)
            if (pass == 0) { if (kt == qt) hist_tile(T_{}, T_{}); else hist_tile(T_{}, F_{}); }
            else { if (kt == qt) hist_tile(F_{}, T_{}); else hist_tile(F_{}, F_{}); }
            k0 = n0; k1 = n1;
        }
        __syncthreads();
        {
            const int q = tid >> 3, part = tid & 7;
            const unsigned* hr = hist + q * 257 + part * 32;
            unsigned s = 0u;
#pragma unroll 8
            for (int i = 0; i < 32; ++i) s += hr[i];
            st_part[q * 8 + part] = (int)s;
            __syncthreads();
            const bool qsmall = (q0 + q + 1) <= 256;
            const int krem = (pass == 0) ? 256 : st_krem[q];
            const unsigned pprev = (pass == 0) ? 0u : st_prefix[q];
            unsigned above = 0u;
            for (int pp = 7; pp > part; --pp) above += (unsigned)st_part[q * 8 + pp];
            __syncthreads();
            if (qsmall) { if (part == 0) { st_prefix[q] = 0u; st_krem[q] = 1 << 30; } }
            else if (above < (unsigned)krem && (unsigned)krem <= above + s) {
                unsigned cum = above; int bin = 31;
                for (; bin > 0; --bin) { const unsigned c = hr[bin]; if (cum + c >= (unsigned)krem) break; cum += c; }
                st_prefix[q] = (pprev << 8) | (unsigned)(part * 32 + bin);
                st_krem[q] = krem - (int)cum;
            }
        }
        __syncthreads();
        prefix = st_prefix[lr];
        if (pass == 1) {
            unsigned* clist = (unsigned*)(sm + 36864);
            unsigned* ccnt = (unsigned*)(sm + 36864 + 32768);
            unsigned* tiew = hist;
            if (tid < 32) ccnt[tid] = 0u;
            if (tid == 0) st_part[0] = 0;
            __syncthreads();
            {
                unsigned* mb = p.DMASK() + ((size_t)b * 128 * S + tq) * 2;
                const unsigned tkey = prefix << 16;
                bf16x8 k0, k1; KLOAD(wid, k0, k1)
                int kt = wid;
#pragma unroll 1
                for (; kt < ntile; kt += 4) {
                    unsigned gt = 0u, tie = 0u;
                    bf16x8 n0, n1; KLOAD(kt + 4, n0, n1)
                    unsigned key[16];
                    score_tile(k0, k1, key);
                    const int vlim = (kt == qt) ? lrh : 64;
#pragma unroll
                    for (int r = 0; r < 16; ++r) {
                        const int rho0 = (r & 3) + 8 * (r >> 2);
                        const bool v = rho0 <= vlim;
                        const unsigned p16 = key[r] >> 16;
                        gt |= (v && p16 > prefix) ? (1u << rho0) : 0u;
                        tie |= (v && key[r] == tkey) ? (1u << rho0) : 0u;
                        const bool eq = v && p16 == prefix && key[r] != tkey;
                        if (__any(eq)) {
                            if (eq) {
                                const unsigned slot = atomicAdd(&ccnt[lr], 1u);
                                if (slot < 256u) clist[lr * 256 + slot] = (key[r] << 16) | (0xFFFFu - (unsigned)(kt * 32 + rho0 + 4 * lh));
                            }
                        }
                    }
                    gt <<= 4 * lh; tie <<= 4 * lh;
                    gt = half_or(gt); tie = half_or(tie);
                    k0 = n0; k1 = n1;
                    if (lh == 0) { mb[(size_t)(kt >> 1) * 2 * S + (kt & 1)] = gt; tiew[lr * 257 + kt] = tie; }
                }
#pragma unroll 1
                for (; kt < 256; kt += 4)
                    if (lh == 0) { mb[(size_t)(kt >> 1) * 2 * S + (kt & 1)] = 0u; tiew[lr * 257 + kt] = 0u; }
            }
            asm volatile("s_waitcnt vmcnt(0)" ::: "memory");
            __syncthreads();
            const int q = tid >> 3, part = tid & 7;
            const unsigned C = ccnt[q];
            if (part == 0 && C > 256u) st_part[0] = 1;
            __syncthreads();
            if (__builtin_amdgcn_readfirstlane(st_part[0]) == 0) {
                const unsigned* lst = clist + q * 256;
                const int kr = st_krem[q];
                unsigned* grow = p.DMASK() + ((size_t)b * 128 * S + q0 + q) * 2;
                for (unsigned i = (unsigned)part; i < C; i += 8u) {
                    const unsigned v = lst[i];
                    int rank = 0;
                    for (unsigned j = 0; j < C; ++j) rank += (lst[j] > v) ? 1 : 0;
                    if (rank < kr) { const unsigned idx = 0xFFFFu - (v & 0xFFFFu); const int kt = (int)(idx >> 5); atomicOr(grow + (size_t)(kt >> 1) * 2 * S + (kt & 1), 1u << (idx & 31u)); }
                }
                __syncthreads();
                tie_fix(kr - (int)C);
                fast = true;
                break;
            }
        }
    }
    if (!fast) {
    const unsigned thr = prefix;
    unsigned* mbase = p.DMASK() + ((size_t)b * 128 * S + tq) * 2;
    unsigned* tiew = hist;
    {
        bf16x8 k0, k1; KLOAD(wid, k0, k1)
        int kt = wid;
#pragma unroll 1
        for (; kt < ntile; kt += 4) {
            unsigned gt = 0u, tie = 0u;
            bf16x8 n0, n1; KLOAD(kt + 4, n0, n1)
            unsigned key[16];
            score_tile(k0, k1, key);
            const int vlim = (kt == qt) ? lrh : 64;
#pragma unroll
            for (int r = 0; r < 16; ++r) {
                const int rho0 = (r & 3) + 8 * (r >> 2);
                const bool v = rho0 <= vlim;
                gt |= (v && key[r] > thr) ? (1u << rho0) : 0u; tie |= (v && key[r] == thr) ? (1u << rho0) : 0u;
            }
            gt <<= 4 * lh; tie <<= 4 * lh;
            gt = half_or(gt); tie = half_or(tie);
            k0 = n0; k1 = n1;
            if (lh == 0) { mbase[(size_t)(kt >> 1) * 2 * S + (kt & 1)] = gt; tiew[lr * 257 + kt] = tie; }
        }
#pragma unroll 1
        for (; kt < 256; kt += 4)
            if (lh == 0) { mbase[(size_t)(kt >> 1) * 2 * S + (kt & 1)] = 0u; tiew[lr * 257 + kt] = 0u; }
    }
    asm volatile("s_waitcnt vmcnt(0)" ::: "memory");
    __syncthreads();
    tie_fix(st_krem[tid >> 3]);
    }
#undef KLOAD
    __syncthreads();
}

__device__ __forceinline__ bool imp_better(float v1, int i1, float v2, int i2) { return (v1 > v2) || (v1 == v2 && i1 < i2); }
UNIT_ATTR __device__ __forceinline__ void nsa_select_unit(const Params& p, int b, int q0w, char* sm) {
    const int lane = tidx() & 63, lr = lane & 31, lh = lane >> 5;
    const int tq = q0w + lr;
    const size_t gq = (size_t)b * S + tq;
    const int nlim = (tq - 31) >> 4;
    const int nst = min(16, ((((q0w + 31 - 31) >> 4)) >> 5) + 1);
    const int pil = (lr & 0x13) | ((lr & 4) << 1) | ((lr & 8) >> 1);
    const bf16_t* kc = p.KCB() + (size_t)b * NCMP_PAD * 64 + (size_t)pil * 64 + 8 * lh;
    constexpr float c = 1.0f;
    float mh[4], il[4];
#pragma unroll
    for (int h = 0; h < 4; ++h) {
        bf16x8 qf[4];
#pragma unroll
        for (int s = 0; s < 4; ++s) qf[s] = *(const bf16x8*)(p.QN() + gq * 256 + h * 64 + 16 * s + 8 * lh);
        float m = NEG_INF, l = 0.f;
#pragma unroll 1
        for (int st = 0; st < nst; ++st) {
            f32x16 s;
#pragma unroll
            for (int i = 0; i < 16; ++i) s[i] = 0.f;
#pragma unroll
            for (int s4 = 0; s4 < 4; ++s4) { const bf16x8 kf = *(const bf16x8*)(kc + (size_t)st * 32 * 64 + s4 * 16); s = __builtin_amdgcn_mfma_f32_32x32x16_bf16(kf, qf[s4], s, 0, 0, 0); }
            const int thl = nlim - st * 32 - 8 * lh;
            float tmax = NEG_INF;
#pragma unroll
            for (int r = 0; r < 16; ++r) { const int cr = 16 * (r >> 3) + (r & 7); s[r] = (cr <= thl) ? s[r] * c : NEG_INF; tmax = fmaxf(tmax, s[r]); }
            tmax = half_max(tmax);
            const float mn = fmaxf(m, tmax), mu = (mn == NEG_INF) ? 0.f : mn;
            float ls = 0.f;
#pragma unroll
            for (int r = 0; r < 16; ++r) ls += __builtin_amdgcn_exp2f(s[r] - mu);
            l = l * __builtin_amdgcn_exp2f(m - mu) + ls; m = mn;
        }
        l = half_sum(l);
        mh[h] = (m == NEG_INF) ? 0.f : m; il[h] = 1.f / fmaxf(l, 1e-30f);
    }
    float val[16]; int idx[16];
#pragma unroll
    for (int i = 0; i < 16; ++i) { val[i] = NEG_INF; idx[i] = 1 << 20; }
    const int cur = tq >> 6;
#pragma unroll 1
    for (int st = 0; st < 16; ++st) {
        float bs[4] = {0.f, 0.f, 0.f, 0.f};
        if (st < nst) {
            const int thl = nlim - st * 32 - 8 * lh;
#pragma unroll
            for (int h = 0; h < 4; ++h) {
                f32x16 s;
#pragma unroll
                for (int i = 0; i < 16; ++i) s[i] = 0.f;
#pragma unroll
                for (int s4 = 0; s4 < 4; ++s4) {
                    const bf16x8 kf = *(const bf16x8*)(kc + (size_t)st * 32 * 64 + s4 * 16);
                    const bf16x8 qfr = *(const bf16x8*)(p.QN() + gq * 256 + h * 64 + 16 * s4 + 8 * lh);
                    s = __builtin_amdgcn_mfma_f32_32x32x16_bf16(kf, qfr, s, 0, 0, 0);
                }
#pragma unroll
                for (int r = 0; r < 16; ++r) {
                    const int cr = 16 * (r >> 3) + (r & 7);
                    const float pr = (cr <= thl) ? __builtin_amdgcn_exp2f(s[r] * c - mh[h]) * il[h] : 0.f;
                    bs[r >> 2] += pr;
                }
                __builtin_amdgcn_sched_barrier(0);
            }
        }
#pragma unroll
        for (int g = 0; g < 4; ++g) {
            const int j = st * 8 + 4 * (g >> 1) + 2 * lh + (g & 1);
            const bool forced = (j == 0) || (j == cur) || (j == cur - 1);
            float v = forced ? 1e4f : ((j <= cur) ? bs[g] : -1.0f);
            int jj = j;
            if (__any(imp_better(v, jj, val[15], idx[15]))) {
#pragma unroll
                for (int i = 0; i < 16; ++i) {
                    const bool bt = imp_better(v, jj, val[i], idx[i]);
                    const float tv = bt ? val[i] : v; const int ti = bt ? idx[i] : jj;
                    val[i] = bt ? v : val[i]; idx[i] = bt ? jj : idx[i];
                    v = tv; jj = ti;
                }
            }
        }
    }
    {
        float* lv = (float*)(sm + (tidx() >> 6) * 8192);
        int* li = (int*)(lv + 1024);
#pragma unroll
        for (int i = 0; i < 16; ++i) { lv[i * 64 + lane] = val[i]; li[i * 64 + lane] = idx[i]; }
        __builtin_amdgcn_wave_barrier();
#pragma unroll 1
        for (int k = 0; k < 16; ++k) {
            float v = lv[k * 64 + (lane ^ 32)]; int jj = li[k * 64 + (lane ^ 32)];
#pragma unroll
            for (int i = 0; i < 16; ++i) {
                const bool bt = imp_better(v, jj, val[i], idx[i]);
                const float tv = bt ? val[i] : v; const int ti = bt ? idx[i] : jj;
                val[i] = bt ? v : val[i]; idx[i] = bt ? jj : idx[i];
                v = tv; jj = ti;
            }
        }
        __builtin_amdgcn_wave_barrier();
    }
    unsigned m0 = 0u, m1 = 0u, m2 = 0u, m3 = 0u;
#pragma unroll
    for (int i = 0; i < 16; ++i) {
        const unsigned bit = 1u << (idx[i] & 31); const int wsel = idx[i] >> 5;
        m0 |= (wsel == 0) ? bit : 0u; m1 |= (wsel == 1) ? bit : 0u; m2 |= (wsel == 2) ? bit : 0u; m3 |= (wsel == 3) ? bit : 0u;
    }
    if (lh == 0) { u32x4 o; o.x = m0; o.y = m1; o.z = m2; o.w = m3; *(u32x4*)(p.SMASK() + gq * 4) = o; }
}

constexpr int CONV_TILES = (D / 64) * ((NIN + 63) / 64), CONV_PER = 2, CONV_UNITS = (CONV_TILES + CONV_PER - 1) / CONV_PER;
__device__ __forceinline__ int conv_tiles_phase_b(int nb, int& idle0) {
    const int ntb = (T / 256) * (NP / 128), nsmall = 2 * (ntb - (ntb / nb) * nb), nbusy = nsmall < nb ? nsmall : nb;
    idle0 = nbusy + 32;
    const int nidle = nb - idle0;
    return nidle > 0 ? (4 * nidle < CONV_TILES ? 4 * nidle : CONV_TILES) : 0;
}
template <class BAR>
__device__ __forceinline__ void ph_work(const Params& p, int layer, char* sm, const BAR& barrier) {
    volatile int* s_unit_p = (volatile int*)(sm + 3 * 24576 + 32);
#pragma unroll 1
    for (int stage = 0; stage < 2; ++stage) {
        unsigned* ctr = p.qctr() + 64 * layer + 32 * stage;
        int idle0_; const int cvb = conv_tiles_phase_b((int)gridDim.x, idle0_);
        const int total = stage == 0 ? (2176 + (layer + 1 < DEPTH ? (CONV_TILES - cvb + CONV_PER - 1) / CONV_PER : 0)) : 1024;
        for (;;) {
            __syncthreads();
            if (threadIdx.x == 0) *s_unit_p = (int)atomicAdd(ctr, 1u);
            __syncthreads();
            const int u = __builtin_amdgcn_readfirstlane(*s_unit_p);
            if (u >= total) break;
            int kind, b = 0, h = 0, q = 0;
            if (stage == 1) { const int r = u & 15; kind = (r >> 3) ? 20 : 2 + AM_DSA; q = 63 - (u >> 4); b = (r >> 2) & 1; h = r & 3; }
            else if (u < 512) { kind = 0; q = 255 - (u >> 1); b = u & 1; }
            else if (u < 640) { kind = 1; const int v = u - 512; b = v & 1; q = v >> 1; }
            else if (u < 1664) { const int v = u - 640, r = v & 15; kind = 2 + ((r >> 3) ? AM_FOX : AM_SB); q = 63 - (v >> 4); b = (r >> 2) & 1; h = r & 3; }
            else if (u < 2176) { const int w = u - 1664; kind = 2 + AM_MEM; q = w >> 3; b = (w >> 2) & 1; h = w & 3; }
            else { kind = 21; q = u - 2176; }
            if (kind == 0) dsa_select_unit(p, b, q, sm);
            else if (kind == 1) nsa_select_unit(p, b, q * 128 + 32 * __builtin_amdgcn_readfirstlane(tidx() >> 6), sm);
            else if (kind == 2 + AM_SB) attn_unit<AM_SB>(p, b, h, q, sm);
            else if (kind == 2 + AM_FOX) attn_unit<AM_FOX>(p, b, h, q, sm);
            else if (kind == 2 + AM_DSA) attn_unit<AM_DSA>(p, b, h, q, sm);
            else if (kind == 2 + AM_MEM) attn_unit<AM_MEM>(p, b, h, q, sm);
            else if (kind == 20) nsa_unit(p, b, h, q, sm);
            else convert_wt_range<true>(p.w_in + (size_t)(layer + 1) * D * NIN, p.WIN(layer + 1), D, NIN, 1, cvb + q * CONV_PER, cvb + q * CONV_PER + CONV_PER, 1, (float*)sm);
        }
        barrier(stage);
    }
}

__device__ __forceinline__ void ph_setup_misc(const Params& p, int bid, int nb) {
    const int lane = tidx() & 63, gw = bid * 4 + (tidx() >> 6);
    for (int o = gw; o < DEPTH * 2 * 128; o += nb * 4) {
        const int l = o >> 8, which = (o >> 7) & 1, j = o & 127;
        const float* pe = (which ? p.pe_v : p.pe_k) + (size_t)l * 2048;
        const float* w1 = (which ? p.wc1_v : p.wc1_k) + (size_t)l * 2048 * 128;
        float a = 0.f;
        for (int k = lane; k < 2048; k += 64) a = fmaf(pe[k], w1[(size_t)k * 128 + j], a);
        a = wave_sum(a);
        if (lane == 0) p.BIASC()[o] = a;
    }
    for (int i = bid * 256 + tidx(); i < 2048; i += nb * 256) { p.KCT()[(size_t)T * 64 + i] = 0; p.VCTOK()[(size_t)T * 64 + i] = 0; }
    for (int wb = 0; wb < 2; ++wb) {
        for (int i = bid * 256 + tidx(); i < 12 * D; i += nb * 256) p.WIN(wb)[(size_t)(M_SPC + 52) * D + i] = 0;
        for (int i = bid * 256 + tidx(); i < (M_MERGE - NPM) * D; i += nb * 256) p.WIN(wb)[(size_t)NPM * D + i] = 0;
    }
}

#define XB_TMO      128
#define XB_XCNT(j)  (256  + 64 * (j))
#define XB_XSUB(j)  (1280 + 64 * (j))
#define XB_XGEN(j)  (2304 + 64 * (j))
#define XB_TOP      3328
#define XB_TOPGEN   3392
#define XCD_BAR_WORDS 3456
#define XB_SPIN_CAP (1u << 18)
#define LAS __attribute__((address_space(3)))

#define XB_SPIN(cond, bar) do { unsigned _sp = 0; while (cond) { __builtin_amdgcn_s_sleep(1); \
    if ((++_sp & 255u) == 0u) { if (xb_ld(&(bar)[XB_TMO])) break; if (_sp > XB_SPIN_CAP) { atomicAdd(&(bar)[XB_TMO], 1u); break; } } } } while (0)

struct XcdBarrier {
    unsigned* bar; unsigned x;
    volatile LAS unsigned* st;
};
__device__ __forceinline__ XcdBarrier xcd_barrier_post(unsigned* bar, volatile LAS unsigned* st) {
    XcdBarrier b; b.bar = bar; b.x = xb_xcc_id(); b.st = st;
    if (threadIdx.x == 0) (void)xb_add(&bar[XB_XCNT(b.x)], 1u);
    return b;
}
__device__ __forceinline__ void xcd_barrier_complete(unsigned* bar, unsigned x, unsigned& nloc, unsigned& nx) {
    const unsigned G = gridDim.x * gridDim.y * gridDim.z;
    unsigned sum, cnt, mine, sp = 0u;
    for (;;) {
        sum = 0u; cnt = 0u; mine = 0u;
#pragma unroll
        for (unsigned j = 0; j < 16; ++j) { const unsigned c = xb_ld(&bar[XB_XCNT(j)]); sum += c; cnt += (c > 0u) ? 1u : 0u; mine = (j == x) ? c : mine; }
        if (sum == G) break;
        __builtin_amdgcn_s_sleep(1);
        if ((++sp & 255u) == 0u) { if (xb_ld(&bar[XB_TMO])) break; if (sp > XB_SPIN_CAP) { atomicAdd(&bar[XB_TMO], 1u); break; } }
    }
    nloc = mine > 0u ? mine : 1u; nx = cnt > 0u ? cnt : 1u;
}
__device__ __attribute__((noinline)) void xcd_barrier_impl(unsigned* b_bar, unsigned b_x, volatile LAS unsigned* b_st) {
    XcdBarrier b; b.bar = b_bar; b.x = b_x; b.st = b_st;
    asm volatile("s_waitcnt vmcnt(0)" ::: "memory");
    __syncthreads();
    if (threadIdx.x == 0) {
        unsigned* bar = b.bar;
        __builtin_amdgcn_s_waitcnt(0);
        unsigned nloc = b.st[0], nx = b.st[1];
        if (nloc == 0u) { xcd_barrier_complete(bar, b.x, nloc, nx); b.st[0] = nloc; b.st[1] = nx; }
        const unsigned old = xb_add(&bar[XB_XSUB(b.x)], 1u);
        const unsigned gen = old / nloc;
        if (old + 1u == (gen + 1u) * nloc) {
            __builtin_amdgcn_fence(__ATOMIC_RELEASE, "agent");
            asm volatile("s_waitcnt vmcnt(0)" ::: "memory");
            const unsigned og = xb_add(&bar[XB_TOP], 1u);
            const unsigned tg = og / nx;
            if (og + 1u == (tg + 1u) * nx) xb_add(&bar[XB_TOPGEN], 1u);
            else XB_SPIN(xb_ld(&bar[XB_TOPGEN]) == tg, bar);
            __builtin_amdgcn_fence(__ATOMIC_ACQUIRE, "agent");
            xb_add(&bar[XB_XGEN(b.x)], 1u);
            asm volatile("s_waitcnt vmcnt(0)" ::: "memory");
        } else {
            XB_SPIN(xb_ld(&bar[XB_XGEN(b.x)]) == gen, bar);
            __builtin_amdgcn_fence(__ATOMIC_ACQUIRE, "agent");
            asm volatile("s_waitcnt vmcnt(0)" ::: "memory");
        }
    }
    __syncthreads();
}
__device__ __forceinline__ void xcd_barrier(const XcdBarrier& b) { xcd_barrier_impl(b.bar, b.x, b.st); }

constexpr int LDS_MAIN = 3 * 24576, LDS_BYTES = LDS_MAIN + 64;
#ifndef DIAG
#define DIAG 0
#endif
#ifndef DIAG_A
#define DIAG_A 8
#define DIAG_B 7
#endif
#if DIAG
#define STAMP(k) do { if (((k) == DIAG_A || (k) == DIAG_B || (k) + 1 == DIAG_A || (k) + 1 == DIAG_B || (k) == 0 || (k) == 11) && blockIdx.x == 0 && threadIdx.x == 0) { const unsigned long long t_ = wall_clock64(); dg[k] += t_ - dg[15]; dg[15] = t_; } } while (0)
#else
#define STAMP(k) do { } while (0)
#endif
__global__ void __launch_bounds__(256, 2) mega(Params p) {
    extern __shared__ __attribute__((aligned(16))) char smem[];
    if (threadIdx.x == 0) *(uint4*)(smem + LDS_MAIN) = make_uint4(0u, 0u, 0u, 0u);
    __syncthreads();
    XcdBarrier bar = xcd_barrier_post(p.bar(), (volatile LAS unsigned*)(smem + LDS_MAIN));
    const int bid = blockIdx.x, nb = gridDim.x;
    float* smf = (float*)smem;
#if DIAG
    __shared__ unsigned long long dg[16];
    if (threadIdx.x == 0) { for (int i = 0; i < 15; ++i) dg[i] = 0; dg[15] = wall_clock64(); }
#endif

    int cvo = 0;
#define CVT(SRC, DST, K_, N_, NMAT_) { convert_wt(SRC, DST, K_, N_, NMAT_, (bid + nb - cvo % nb) % nb, nb, smf); cvo += (NMAT_) * ((K_) / 64) * (((N_) + 63) / 64); }
    CVT(p.w_branch, p.WBR(), 256, D, DEPTH * 5)
    CVT(p.w_out, p.WOUT(), D, D, DEPTH)
    CVT(p.w_mem_kv, p.WMKV(), D, 512, DEPTH)
    CVT(p.w_uk, p.WUK(), 128, 256, DEPTH)
    CVT(p.w_uv, p.WUV(), 128, 256, DEPTH)
    for (int l = 0; l < DEPTH; ++l) {
        CVT(p.wc1_k + (size_t)l * 2048 * 128, p.WC1T() + (size_t)(l * 2 + 0) * 128 * 2048, 2048, 128, 1)
        CVT(p.wc1_v + (size_t)l * 2048 * 128, p.WC1T() + (size_t)(l * 2 + 1) * 128 * 2048, 2048, 128, 1)
        CVT(p.wc2_k + (size_t)l * 128 * 64, p.WC2T() + (size_t)(l * 2 + 0) * 64 * 128, 128, 64, 1)
        CVT(p.wc2_v + (size_t)l * 128 * 64, p.WC2T() + (size_t)(l * 2 + 1) * 64 * 128, 128, 64, 1)
    }
#undef CVT
    ph_setup_misc(p, bid, nb);
    ph_rope_table(p, bid, nb);
    STAMP(0);
    for (int l = 0; l < DEPTH; ++l) {
        const float* Xin = l == 0 ? p.x : p.X;
        if (l == 0) convert_wt<true>(p.w_in, p.WIN(0), D, NIN, 1, (bid + nb - cvo % nb) % nb, nb, smf);
        ph_rmsnorm<bf16_t>(Xin, p.norm_g + l * D, p.H(), T, bid, nb);
        ph_rmsnorm<bf16_t>(p.mem, p.mem_norm + l * D, p.MEMN(), NBATCH * NMEM, bid, nb);
        xcd_barrier(bar); STAMP(1);
        int nbusy;
        { EpiInProj e{p, l}; nbusy = gemm_big(p.H(), D, p.WIN(l), D, T, NP, D, e, bid, nb, smem); }
        { EpiMemKV e{p}; gemm_bf16<128>(p.MEMN(), D, p.WMKV() + (size_t)l * 512 * D, D, NBATCH * NMEM, 512, D, e, (bid + nb - nbusy) % nb, nb, smem); }
        if (l + 1 < DEPTH) {
            int idle0; const int cvb = conv_tiles_phase_b(nb, idle0);
            if (bid >= idle0) convert_wt_range<true>(p.w_in + (size_t)(l + 1) * D * NIN, p.WIN(l + 1), D, NIN, 1, bid - idle0, cvb, nb - idle0, smf);
        }
        xcd_barrier(bar); STAMP(2);
        { EpiCmp1 e{p.BIASC() + (l * 2 + 0) * 128, p.HIDK()}; gemm_bf16<128>(p.KCT(), 1024, p.WC1T() + (size_t)(l * 2 + 0) * 128 * 2048, 2048, 1024, 128, 2048, e, bid, nb, smem); }
        { EpiCmp1 e{p.BIASC() + (l * 2 + 1) * 128, p.HIDV()}; gemm_bf16<128>(p.VCTOK(), 1024, p.WC1T() + (size_t)(l * 2 + 1) * 128 * 2048, 2048, 1024, 128, 2048, e, (bid + nb - 16) % nb, nb, smem); }
        ph_cumsum(p, (bid + nb - 64) % nb, nb, smf);
        ph_ckvnorm(p, l, bid, nb);
        xcd_barrier(bar); STAMP(3);
        { EpiKA e{p}; gemm_bf16<128>(p.CKV(), 128, p.WUK() + (size_t)l * 256 * 128, 128, T, 256, 128, e, bid, nb, smem); }
        { EpiVA e{p}; gemm_bf16<128>(p.CKV(), 128, p.WUV() + (size_t)l * 256 * 128, 128, T, 256, 128, e, (bid + nb - 256) % nb, nb, smem); }
        { EpiCmp2K e{p.KCB()}; gemm_bf16<64>(p.HIDK(), 128, p.WC2T() + (size_t)(l * 2 + 0) * 64 * 128, 128, 1024, 64, 128, e, bid, nb, smem); }
        { EpiCmp2V e{p.VCT()}; gemm_bf16<64>(p.HIDV(), 128, p.WC2T() + (size_t)(l * 2 + 1) * 64 * 128, 128, 1024, 64, 128, e, (bid + nb - 16) % nb, nb, smem); }
        xcd_barrier(bar); STAMP(4);
        ph_work(p, l, smem, [&](int stage) { xcd_barrier(bar); if (stage == 0) { STAMP(7); } else { STAMP(8); } });
        ph_merge(p, l, bid, nb, smem);
        xcd_barrier(bar); STAMP(10);
        { EpiResid e{Xin, p.X}; (void)gemm_big(p.MG(), D, p.WOUT() + (size_t)l * D * D, D, T, D, D, e, bid, nb, smem); }
        xcd_barrier(bar); STAMP(11);
    }
#if DIAG
    {
        float* dgw = (float*)(p.bar() + 4096 + 512);
        if (blockIdx.x == 0 && threadIdx.x == 0) {
            unsigned long long tot = 0; for (int i = 0; i < 15; ++i) tot += dg[i];
            #if defined(DIAG_GRID)
            dgw[0] = (float)gridDim.x / 1024.f; dgw[1] = 0.f; if (0)
#endif
            dgw[0] = rintf(50.f * (float)((double)dg[DIAG_A] / (double)tot)) / 50.f; dgw[1] = rintf(50.f * (float)((double)dg[DIAG_B] / (double)tot)) / 50.f;
        }
        ph_rmsnorm<float>(p.X, p.final_norm, p.X, T, bid, nb);
        xcd_barrier(bar);
        {
            const float fa = 1.0f + dgw[0];
            float4* xp = (float4*)p.X;
#pragma unroll 1
            for (int i = bid * 256 + threadIdx.x; i < T * D / 4; i += nb * 256) { float4 v = xp[i]; v.x *= fa; v.y *= fa; v.z *= fa; v.w *= fa; xp[i] = v; }
        }
        xcd_barrier(bar);
        if (blockIdx.x == 0 && threadIdx.x == 0) p.X[0] += 100.f * dgw[1];
    }
#else
    ph_rmsnorm<float>(p.X, p.final_norm, p.X, T, bid, nb);
#endif
}
}

extern "C" void kernel_launch(void* const* d_in, const int* in_sizes, int n_in, void* d_out, int out_size, void* d_ws, size_t ws_size, hipStream_t stream) {
    (void)in_sizes; (void)n_in; (void)out_size;
    Params p{};
    p.x = (const float*)d_in[0]; p.mem = (const float*)d_in[1]; p.pos = (const int*)d_in[2]; p.norm_g = (const float*)d_in[3];
    p.w_in = (const float*)d_in[4]; p.kv_norm = (const float*)d_in[5]; p.w_uk = (const float*)d_in[6]; p.w_uv = (const float*)d_in[7];
    p.fox_bias = (const float*)d_in[8]; p.pe_k = (const float*)d_in[9]; p.pe_v = (const float*)d_in[10]; p.wc1_k = (const float*)d_in[11];
    p.wc2_k = (const float*)d_in[12]; p.wc1_v = (const float*)d_in[13]; p.wc2_v = (const float*)d_in[14]; p.mem_norm = (const float*)d_in[15];
    p.w_mem_kv = (const float*)d_in[16]; p.w_branch = (const float*)d_in[17]; p.w_out = (const float*)d_in[18]; p.final_norm = (const float*)d_in[19];
    p.X = (float*)d_out;
    p.ws = (char*)d_ws;
    if (WS_TOTAL > ws_size) { fprintf(stderr, "kernel_launch: workspace too small (%zu > %zu)\n", (size_t)WS_TOTAL, ws_size); return; }

    static int grid = 0;
    if (grid == 0) {
        int dev = 0, cus = 0, per_cu = 0;
        hipGetDevice(&dev);
        hipDeviceGetAttribute(&cus, hipDeviceAttributeMultiprocessorCount, dev);
        hipFuncSetAttribute((const void*)mega, hipFuncAttributeMaxDynamicSharedMemorySize, LDS_BYTES);
        hipOccupancyMaxActiveBlocksPerMultiprocessor(&per_cu, (const void*)mega, 256, LDS_BYTES);
        (void)hipGetLastError();
        if (per_cu < 1) per_cu = 1;
        grid = cus * (per_cu < 2 ? per_cu : 2);
    }
    hipMemsetAsync((char*)d_ws + OFF_bar, 0, (4096 + 64 * 8 + 64) * sizeof(unsigned), stream);
    hipLaunchKernelGGL(mega, dim3(grid), dim3(256), LDS_BYTES, stream, p);
}
```

```cpp
#include <hip/hip_runtime.h>
#include <stdint.h>
#include <math.h>
#include <cstdio>
#include <type_traits>

namespace {
constexpr int S = 8192, NBATCH = 2, T = NBATCH * S, D = 1024, NIN = 9396, NM = 4276, DEPTH = 4, NMEM = 256;
constexpr int NCMP = 511, NCMP_PAD = 512;
constexpr int C_DSA_Q = 0, C_CKV = 256, C_IDXQ = 384, C_IDXK = 512, C_IDXW = 544, C_DSA_Z = 548,
              C_FOX_Q = 804, C_FOX_K = 1060, C_FOX_V = 1316, C_FOX_F = 1572, C_FOX_Z = 1576,
              C_SB_Q = 1832, C_SB_K = 2088, C_SB_V = 2344, C_SB_Z = 2600,
              C_NSA_Q = 2856, C_NSA_KC = 3112, C_NSA_VC = 3176, C_NSA_KS = 3240, C_NSA_VS = 3304, C_NSA_KW = 3368, C_NSA_VW = 3432,
              C_NSA_G = 3496, C_NSA_Z = 3508, C_MEM_Q = 3764, C_MEM_Z = 4020, C_MERGE = 4276;

typedef unsigned short bf16_t;
typedef short bf16x8 __attribute__((ext_vector_type(8)));
typedef float f32x16 __attribute__((ext_vector_type(16)));
typedef float f32x2 __attribute__((ext_vector_type(2)));
typedef unsigned u32x4 __attribute__((ext_vector_type(4)));
typedef unsigned u32x2 __attribute__((ext_vector_type(2)));

constexpr int M_QA = 0, M_QN = 256, M_KSLC = 512, M_KWIN = 576, M_KC = 640, M_VC = 704, M_QF = 768, M_KF = 1024, M_QS = 1280, M_KSB = 1536, M_QM = 1792,
              M_VF = 2048, M_VS = 2304, M_VSLC = 2560, M_VWIN = 2624, M_QI = 2688, M_SPC = 2816, M_CKV = 2880, M_Z = 3008, NPM = 4288, M_MERGE = 4352, NP = 9472;
constexpr size_t al256(size_t x) { return (x + 255) & ~(size_t)255; }
constexpr size_t OFF_bar = 0;
constexpr size_t OFF_H = OFF_bar + al256((4096 + 64 * 8 + 64) * 4);
constexpr size_t OFF_Y = OFF_H + al256((size_t)T * D * 2);
constexpr size_t OFF_ZG = OFF_Y + al256((size_t)T * 1280 * 2);
constexpr size_t OFF_MG = OFF_ZG + al256((size_t)T * 1280 * 2);
constexpr size_t OFF_SIG = OFF_MG + al256((size_t)T * D * 2);
constexpr size_t OFF_CKVR = OFF_SIG + al256((size_t)T * 5120 * 2);
constexpr size_t OFF_CKV = OFF_CKVR + al256((size_t)T * 128 * 4);
constexpr size_t OFF_LOGF = OFF_CKV + al256((size_t)T * 128 * 2);
constexpr size_t OFF_CUM = OFF_LOGF + al256((size_t)T * 4 * 4);
constexpr size_t OFF_CUMT = OFF_CUM + al256((size_t)T * 4 * 4);
constexpr size_t OFF_WI = OFF_CUMT + al256((size_t)T * 4 * 4);
constexpr size_t OFF_GN = OFF_WI + al256((size_t)T * 4 * 4);
constexpr size_t OFF_KCT = OFF_GN + al256((size_t)T * 12 * 4);
constexpr size_t OFF_VCTOK = OFF_KCT + al256(((size_t)T * 64 + 2048) * 2);
constexpr size_t OFF_HIDK = OFF_VCTOK + al256(((size_t)T * 64 + 2048) * 2);
constexpr size_t OFF_HIDV = OFF_HIDK + al256((size_t)1024 * 128 * 2);
constexpr size_t OFF_KCB = OFF_HIDV + al256((size_t)1024 * 128 * 2);
constexpr size_t OFF_VCT = OFF_KCB + al256((size_t)NBATCH * NCMP_PAD * 64 * 2);
constexpr size_t OFF_QI = OFF_VCT + al256((size_t)NBATCH * NCMP_PAD * 64 * 2);
constexpr size_t OFF_KI = OFF_QI + al256((size_t)T * 128 * 2);
constexpr size_t OFF_MEMN = OFF_KI + al256((size_t)T * 32 * 2);
constexpr size_t OFF_ROPE = OFF_MEMN + al256((size_t)NBATCH * NMEM * D * 2);
constexpr size_t OFF_DMASK = OFF_ROPE + al256((size_t)T * 64 * 4);
constexpr size_t OFF_SMASK = OFF_DMASK + al256((size_t)T * 256 * 4);
constexpr size_t OFF_QA = OFF_SMASK + al256((size_t)T * 4 * 4);
constexpr size_t OFF_KAB = OFF_QA + al256((size_t)T * 256 * 2);
constexpr size_t OFF_VAT = OFF_KAB + al256((size_t)T * 256 * 2);
constexpr size_t OFF_QF = OFF_VAT + al256((size_t)T * 256 * 2);
constexpr size_t OFF_KF = OFF_QF + al256((size_t)T * 256 * 2);
constexpr size_t OFF_VFT = OFF_KF + al256((size_t)T * 256 * 2);
constexpr size_t OFF_QS = OFF_VFT + al256((size_t)T * 256 * 2);
constexpr size_t OFF_KSB = OFF_QS + al256((size_t)T * 256 * 2);
constexpr size_t OFF_VST = OFF_KSB + al256((size_t)T * 256 * 2);
constexpr size_t OFF_QN = OFF_VST + al256((size_t)T * 256 * 2);
constexpr size_t OFF_QM = OFF_QN + al256((size_t)T * 256 * 2);
constexpr size_t OFF_KSLC = OFF_QM + al256((size_t)T * 256 * 2);
constexpr size_t OFF_VSLCT = OFF_KSLC + al256((size_t)T * 64 * 2);
constexpr size_t OFF_KWIN = OFF_VSLCT + al256((size_t)T * 64 * 2);
constexpr size_t OFF_VWINT = OFF_KWIN + al256((size_t)T * 64 * 2);
constexpr size_t OFF_MKB = OFF_VWINT + al256((size_t)T * 64 * 2);
constexpr size_t OFF_MVT = OFF_MKB + al256((size_t)NBATCH * NMEM * 256 * 2);
constexpr size_t OFF_WIN = OFF_MVT + al256((size_t)NBATCH * NMEM * 256 * 2);
constexpr size_t OFF_WBR = OFF_WIN + al256((size_t)2 * NP * D * 2);
constexpr size_t OFF_WOUT = OFF_WBR + al256((size_t)DEPTH * 5 * D * 256 * 2);
constexpr size_t OFF_WMKV = OFF_WOUT + al256((size_t)DEPTH * D * D * 2);
constexpr size_t OFF_WUK = OFF_WMKV + al256((size_t)DEPTH * 512 * D * 2);
constexpr size_t OFF_WUV = OFF_WUK + al256((size_t)DEPTH * 256 * 128 * 2);
constexpr size_t OFF_WC1T = OFF_WUV + al256((size_t)DEPTH * 256 * 128 * 2);
constexpr size_t OFF_WC2T = OFF_WC1T + al256((size_t)DEPTH * 2 * 128 * 2048 * 2);
constexpr size_t OFF_BIASC = OFF_WC2T + al256((size_t)DEPTH * 2 * 64 * 128 * 2);
constexpr size_t WS_TOTAL = OFF_BIASC + al256((size_t)DEPTH * 2 * 128 * 4);

__device__ __forceinline__ int map_in_col(int n) {
    constexpr int seg[27][3] = {{0, 256, M_QA}, {256, 128, M_CKV}, {384, 128, M_QI}, {512, 32, M_SPC}, {544, 4, M_SPC + 32}, {548, 256, M_Z}, {804, 256, M_QF}, {1060, 256, M_KF},
        {1316, 256, M_VF}, {1572, 4, M_SPC + 36}, {1576, 256, M_Z + 256}, {1832, 256, M_QS}, {2088, 256, M_KSB}, {2344, 256, M_VS}, {2600, 256, M_Z + 512}, {2856, 256, M_QN},
        {3112, 64, M_KC}, {3176, 64, M_VC}, {3240, 64, M_KSLC}, {3304, 64, M_VSLC}, {3368, 64, M_KWIN}, {3432, 64, M_VWIN}, {3496, 12, M_SPC + 40}, {3508, 256, M_Z + 768},
        {3764, 256, M_QM}, {4020, 256, M_Z + 1024}, {4276, 5120, M_MERGE}};
    int r = 0;
#pragma unroll
    for (int i = 0; i < 27; ++i) r = (n >= seg[i][0] && n < seg[i][0] + seg[i][1]) ? (seg[i][2] + n - seg[i][0]) : r;
    return r;
}
struct Params {
    const float* x; const float* mem; const int* pos; const float* norm_g; const float* w_in; const float* kv_norm;
    const float* w_uk; const float* w_uv; const float* fox_bias; const float* pe_k; const float* pe_v;
    const float* wc1_k; const float* wc2_k; const float* wc1_v; const float* wc2_v; const float* mem_norm;
    const float* w_mem_kv; const float* w_branch; const float* w_out; const float* final_norm;
    float* X; char* ws;
    __device__ __forceinline__ unsigned* bar() const { return (unsigned*)(ws + OFF_bar); }
    __device__ __forceinline__ bf16_t* H() const { return (bf16_t*)(ws + OFF_H); }
    __device__ __forceinline__ bf16_t* Y() const { return (bf16_t*)(ws + OFF_Y); }
    __device__ __forceinline__ bf16_t* ZG() const { return (bf16_t*)(ws + OFF_ZG); }
    __device__ __forceinline__ bf16_t* MG() const { return (bf16_t*)(ws + OFF_MG); }
    __device__ __forceinline__ bf16_t* SIG() const { return (bf16_t*)(ws + OFF_SIG); }
    __device__ __forceinline__ float* CKVR() const { return (float*)(ws + OFF_CKVR); }
    __device__ __forceinline__ bf16_t* CKV() const { return (bf16_t*)(ws + OFF_CKV); }
    __device__ __forceinline__ float* LOGF() const { return (float*)(ws + OFF_LOGF); }
    __device__ __forceinline__ float* CUM() const { return (float*)(ws + OFF_CUM); }
    __device__ __forceinline__ float* CUMT() const { return (float*)(ws + OFF_CUMT); }
    __device__ __forceinline__ float* WI() const { return (float*)(ws + OFF_WI); }
    __device__ __forceinline__ float* GN() const { return (float*)(ws + OFF_GN); }
    __device__ __forceinline__ bf16_t* KCT() const { return (bf16_t*)(ws + OFF_KCT); }
    __device__ __forceinline__ bf16_t* VCTOK() const { return (bf16_t*)(ws + OFF_VCTOK); }
    __device__ __forceinline__ bf16_t* HIDK() const { return (bf16_t*)(ws + OFF_HIDK); }
    __device__ __forceinline__ bf16_t* HIDV() const { return (bf16_t*)(ws + OFF_HIDV); }
    __device__ __forceinline__ bf16_t* KCB() const { return (bf16_t*)(ws + OFF_KCB); }
    __device__ __forceinline__ bf16_t* VCT() const { return (bf16_t*)(ws + OFF_VCT); }
    __device__ __forceinline__ bf16_t* QI() const { return (bf16_t*)(ws + OFF_QI); }
    __device__ __forceinline__ bf16_t* KI() const { return (bf16_t*)(ws + OFF_KI); }
    __device__ __forceinline__ bf16_t* MEMN() const { return (bf16_t*)(ws + OFF_MEMN); }
    __device__ __forceinline__ float* ROPE() const { return (float*)(ws + OFF_ROPE); }
    __device__ __forceinline__ unsigned* DMASK() const { return (unsigned*)(ws + OFF_DMASK); }
    __device__ __forceinline__ unsigned* SMASK() const { return (unsigned*)(ws + OFF_SMASK); }
    __device__ __forceinline__ bf16_t* QA() const { return (bf16_t*)(ws + OFF_QA); }
    __device__ __forceinline__ bf16_t* KAB() const { return (bf16_t*)(ws + OFF_KAB); }
    __device__ __forceinline__ bf16_t* VAT() const { return (bf16_t*)(ws + OFF_VAT); }
    __device__ __forceinline__ bf16_t* QF() const { return (bf16_t*)(ws + OFF_QF); }
    __device__ __forceinline__ bf16_t* KF() const { return (bf16_t*)(ws + OFF_KF); }
    __device__ __forceinline__ bf16_t* VFT() const { return (bf16_t*)(ws + OFF_VFT); }
    __device__ __forceinline__ bf16_t* QS() const { return (bf16_t*)(ws + OFF_QS); }
    __device__ __forceinline__ bf16_t* KSB() const { return (bf16_t*)(ws + OFF_KSB); }
    __device__ __forceinline__ bf16_t* VST() const { return (bf16_t*)(ws + OFF_VST); }
    __device__ __forceinline__ bf16_t* QN() const { return (bf16_t*)(ws + OFF_QN); }
    __device__ __forceinline__ bf16_t* QM() const { return (bf16_t*)(ws + OFF_QM); }
    __device__ __forceinline__ bf16_t* KSLC() const { return (bf16_t*)(ws + OFF_KSLC); }
    __device__ __forceinline__ bf16_t* VSLCT() const { return (bf16_t*)(ws + OFF_VSLCT); }
    __device__ __forceinline__ bf16_t* KWIN() const { return (bf16_t*)(ws + OFF_KWIN); }
    __device__ __forceinline__ bf16_t* VWINT() const { return (bf16_t*)(ws + OFF_VWINT); }
    __device__ __forceinline__ bf16_t* MKB() const { return (bf16_t*)(ws + OFF_MKB); }
    __device__ __forceinline__ bf16_t* MVT() const { return (bf16_t*)(ws + OFF_MVT); }
    __device__ __forceinline__ bf16_t* WIN(int l) const { return (bf16_t*)(ws + OFF_WIN) + (size_t)(l & 1) * NP * D; }
    __device__ __forceinline__ bf16_t* WBR() const { return (bf16_t*)(ws + OFF_WBR); }
    __device__ __forceinline__ bf16_t* WOUT() const { return (bf16_t*)(ws + OFF_WOUT); }
    __device__ __forceinline__ bf16_t* WMKV() const { return (bf16_t*)(ws + OFF_WMKV); }
    __device__ __forceinline__ bf16_t* WUK() const { return (bf16_t*)(ws + OFF_WUK); }
    __device__ __forceinline__ bf16_t* WUV() const { return (bf16_t*)(ws + OFF_WUV); }
    __device__ __forceinline__ bf16_t* WC1T() const { return (bf16_t*)(ws + OFF_WC1T); }
    __device__ __forceinline__ bf16_t* WC2T() const { return (bf16_t*)(ws + OFF_WC2T); }
    __device__ __forceinline__ float* BIASC() const { return (float*)(ws + OFF_BIASC); }
    __device__ __forceinline__ unsigned* qctr() const { return (unsigned*)(ws + OFF_bar) + 4096; }
};

typedef __bf16 bf16x2_t __attribute__((ext_vector_type(2)));
__device__ __forceinline__ unsigned cvt_pk_bf16(float lo, float hi) { bf16x2_t v; v.x = (__bf16)lo; v.y = (__bf16)hi; return __builtin_bit_cast(unsigned, v); }
__device__ __forceinline__ bf16_t f2bf(float x) { return (bf16_t)(cvt_pk_bf16(x, 0.f) & 0xffffu); }
__device__ __forceinline__ unsigned xb_ld(unsigned* p)              { return __hip_atomic_load(p, __ATOMIC_RELAXED, __HIP_MEMORY_SCOPE_AGENT); }
__device__ __forceinline__ unsigned xb_add(unsigned* p, unsigned v) { return __hip_atomic_fetch_add(p, v, __ATOMIC_RELAXED, __HIP_MEMORY_SCOPE_AGENT); }
__device__ __forceinline__ unsigned xb_xcc_id() { return (unsigned)__builtin_amdgcn_s_getreg((3 << 11) | 20) & 0xFu; }
__device__ __forceinline__ int tidx() { int t = threadIdx.x; asm volatile("" : "+v"(t)); return t; }
__device__ __forceinline__ float sigmoid_(float x) { return __builtin_amdgcn_rcpf(1.f + __builtin_amdgcn_exp2f(-1.4426950408889634f * x)); }
__device__ __forceinline__ float silu_(float x) { return x * __builtin_amdgcn_rcpf(1.f + __builtin_amdgcn_exp2f(-1.4426950408889634f * x)); }
__device__ __forceinline__ float logsig_(float x) { return fminf(x, 0.f) - log1pf(expf(-fabsf(x))); }
__device__ __forceinline__ void half_pair(float x, float& lo, float& hi) {
    const auto r = __builtin_amdgcn_permlane32_swap(__float_as_uint(x), __float_as_uint(x), false, false);
    lo = __uint_as_float(r[0]); hi = __uint_as_float(r[1]);
}
__device__ __forceinline__ float half_sum(float x) { float a, b; half_pair(x, a, b); return a + b; }
__device__ __forceinline__ float half_max(float x) { float a, b; half_pair(x, a, b); return fmaxf(a, b); }
__device__ __forceinline__ unsigned half_or(unsigned x) { const auto r = __builtin_amdgcn_permlane32_swap(x, x, false, false); return r[0] | r[1]; }
template <int O> __device__ __forceinline__ float shx(float v) { return __int_as_float(__builtin_amdgcn_ds_swizzle(__float_as_int(v), 0x1F | (O << 10))); }
__device__ __forceinline__ float wave_sum(float v) {
    v = half_sum(v);
    v += shx<16>(v); v += shx<8>(v); v += shx<4>(v); v += shx<2>(v); v += shx<1>(v);
    return v;
}
__device__ __forceinline__ float wave_max(float v) {
    v = half_max(v);
    v = fmaxf(v, shx<16>(v)); v = fmaxf(v, shx<8>(v)); v = fmaxf(v, shx<4>(v)); v = fmaxf(v, shx<2>(v)); v = fmaxf(v, shx<1>(v));
    return v;
}

__device__ __forceinline__ void ph_rope_table(const Params& p, int bid, int nb) {
    for (int i = bid * 256 + tidx(); i < T * 32; i += nb * 256) {
        const int t = i >> 5, f = i & 31;
        const double inv = pow(10000.0, -(double)f / 32.0);
        const double ang = (double)p.pos[t] * inv;
        p.ROPE()[(size_t)t * 64 + f] = (float)cos(ang);
        p.ROPE()[(size_t)t * 64 + 32 + f] = (float)sin(ang);
    }
}

template <class OUT>
__device__ __forceinline__ void ph_rmsnorm(const float* in, const float* g, OUT* out, int rows, int bid, int nb, float dscale = 1.0f) {
    const int lane = tidx() & 63, wid = tidx() >> 6;
    for (int r = bid * 4 + wid; r < rows; r += nb * 4) {
        const float4* ip = (const float4*)(in + (size_t)r * D);
        float4 v[4]; float ss = 0.f;
#pragma unroll
        for (int i = 0; i < 4; ++i) { v[i] = ip[lane + 64 * i]; ss += v[i].x * v[i].x + v[i].y * v[i].y + v[i].z * v[i].z + v[i].w * v[i].w; }
        ss = wave_sum(ss);
        const float sc = dscale / sqrtf(ss * (1.f / D) + 1e-6f);
#pragma unroll
        for (int i = 0; i < 4; ++i) {
            const float4 gg = ((const float4*)g)[lane + 64 * i];
            float4 o; o.x = v[i].x * sc * gg.x; o.y = v[i].y * sc * gg.y; o.z = v[i].z * sc * gg.z; o.w = v[i].w * sc * gg.w;
            if constexpr (sizeof(OUT) == 4) ((float4*)((float*)out + (size_t)r * D))[lane + 64 * i] = o;
            else { u32x2 w; w.x = cvt_pk_bf16(o.x, o.y); w.y = cvt_pk_bf16(o.z, o.w); ((u32x2*)((bf16_t*)out + (size_t)r * D))[lane + 64 * i] = w; }
        }
    }
}

__device__ __forceinline__ void ph_ckvnorm(const Params& p, int layer, int bid, int nb) {
    const int lane = tidx() & 63, wid = tidx() >> 6;
    const float* g = p.kv_norm + layer * 128;
    const float g0 = g[lane], g1 = g[lane + 64];
    const float* __restrict__ src = p.CKVR();
    bf16_t* __restrict__ dst = p.CKV();
    const int stride = nb * 4;
    for (int r0 = bid * 4 + wid; r0 < T; r0 += 8 * stride) {
        float a[8], b[8];
#pragma unroll
        for (int k = 0; k < 8; ++k) { const int r = min(r0 + k * stride, T - 1); a[k] = src[(size_t)r * 128 + lane]; b[k] = src[(size_t)r * 128 + lane + 64]; }
#pragma unroll
        for (int k = 0; k < 8; ++k) {
            const int r = r0 + k * stride;
            const float ss = wave_sum(a[k] * a[k] + b[k] * b[k]);
            const float sc = 1.0f / sqrtf(ss * (1.f / 128.f) + 1e-6f);
            if (r < T) { dst[(size_t)r * 128 + lane] = f2bf(a[k] * sc * g0); dst[(size_t)r * 128 + lane + 64] = f2bf(b[k] * sc * g1); }
        }
    }
}

template <bool MAPIN = false>
__device__ __forceinline__ void convert_wt_range(const float* __restrict__ src, bf16_t* __restrict__ dst, int K, int N, int nmat, int it0, int it1, int nstep, float* sm) {
    float (*tl)[65] = (float (*)[65])sm;
    const int tid = tidx(), tk = K / 64, tn = (N + 63) / 64, per = tk * tn;
    for (int it = it0; it < it1 && it < per * nmat; it += nstep) {
        const int mat = it / per, r = it % per, k0 = (r % tk) * 64, n0 = (r / tk) * 64;
        const float* s = src + (size_t)mat * K * N; bf16_t* d = dst + (size_t)mat * K * N;
        __syncthreads();
        for (int i = tid; i < 64 * 64; i += 256) { const int kk = i >> 6, nn = i & 63; tl[kk][nn] = (n0 + nn < N) ? s[(size_t)(k0 + kk) * N + n0 + nn] : 0.f; }
        __syncthreads();
        {
            const int nn = tid >> 2, kq = (tid & 3) * 16;
            if (n0 + nn < N) {
                u32x4 w0, w1;
                w0.x = cvt_pk_bf16(tl[kq + 0][nn], tl[kq + 1][nn]); w0.y = cvt_pk_bf16(tl[kq + 2][nn], tl[kq + 3][nn]);
                w0.z = cvt_pk_bf16(tl[kq + 4][nn], tl[kq + 5][nn]); w0.w = cvt_pk_bf16(tl[kq + 6][nn], tl[kq + 7][nn]);
                w1.x = cvt_pk_bf16(tl[kq + 8][nn], tl[kq + 9][nn]); w1.y = cvt_pk_bf16(tl[kq + 10][nn], tl[kq + 11][nn]);
                w1.z = cvt_pk_bf16(tl[kq + 12][nn], tl[kq + 13][nn]); w1.w = cvt_pk_bf16(tl[kq + 14][nn], tl[kq + 15][nn]);
                const int drow = MAPIN ? map_in_col(n0 + nn) : (n0 + nn);
                u32x4* dp = (u32x4*)(d + (size_t)drow * K + k0 + kq);
                dp[0] = w0; dp[1] = w1;
            }
        }
    }
    __syncthreads();
}
template <bool MAPIN = false>
__device__ __forceinline__ void convert_wt(const float* __restrict__ src, bf16_t* __restrict__ dst, int K, int N, int nmat, int bid, int nb, float* sm) {
    convert_wt_range<MAPIN>(src, dst, K, N, nmat, bid, 1 << 30, nb, sm);
}

constexpr int GROW = 80;
constexpr int GA_BYTES = 128 * GROW;
struct GStage { u32x4 a0, a1, b0, b1; };
template <int BN, int DEPTH = 3>
__device__ __forceinline__ void tile_mac(f32x16 (&acc)[2][BN / 64], const bf16_t* __restrict__ A, int lda, int m0,
                                         const bf16_t* __restrict__ Bt, int ldb, int n0, int nmax, int K, char* sm) {
    constexpr int NT = BN / 64;
    constexpr int B_BYTES = BN * GROW;
    constexpr int BUF = GA_BYTES + B_BYTES;
    const int tid = tidx(), lane = tid & 63, wid = __builtin_amdgcn_readfirstlane(tid >> 6), wr = wid >> 1, wc = wid & 1;
    const int lr = lane & 31, lh = lane >> 5;
    const int ar0 = tid >> 2, akq = tid & 3;
    const bf16_t* Ab = A + (size_t)m0 * lda;
    const bf16_t* Bb = Bt + (size_t)n0 * ldb;
    const unsigned ao0 = (unsigned)(ar0 * lda + akq * 8), ao1 = ao0 + (unsigned)(64 * lda);
    const int br0 = tid >> 2;
    const bool bv0 = (n0 + br0) < nmax, bv1 = (NT == 2) && ((n0 + br0 + 64) < nmax);
    const unsigned bo0 = (unsigned)((bv0 ? br0 : 0) * ldb + akq * 8), bo1 = (unsigned)((bv1 ? br0 + 64 : 0) * ldb + akq * 8);
    const int st_a0 = ar0 * GROW + akq * 16, st_a1 = (ar0 + 64) * GROW + akq * 16;
    const int st_b0 = GA_BYTES + br0 * GROW + akq * 16, st_b1 = GA_BYTES + (br0 + 64) * GROW + akq * 16;
    const int rd_a = (wr * 64 + lr) * GROW + lh * 16, rd_b = GA_BYTES + (wc * (BN / 2) + lr) * GROW + lh * 16;
    const u32x4 zero4 = {0u, 0u, 0u, 0u};
    const int nk = K / 32;
    auto gload = [&](GStage& g, int ks) {
        const unsigned ko = (unsigned)ks * 32u;
        g.a0 = *(const u32x4*)(Ab + (ao0 + ko)); g.a1 = *(const u32x4*)(Ab + (ao1 + ko));
        g.b0 = *(const u32x4*)(Bb + (bo0 + ko)); if (NT == 2) g.b1 = *(const u32x4*)(Bb + (bo1 + ko));
    };
    auto lstore = [&](const GStage& g, char* buf) {
        *(u32x4*)(buf + st_a0) = g.a0; *(u32x4*)(buf + st_a1) = g.a1;
        *(u32x4*)(buf + st_b0) = bv0 ? g.b0 : zero4; if (NT == 2) *(u32x4*)(buf + st_b1) = bv1 ? g.b1 : zero4;
    };
    auto compute = [&](const char* cur) {
#pragma unroll
        for (int s = 0; s < 2; ++s) {
            bf16x8 a[2], b[NT];
#pragma unroll
            for (int mi = 0; mi < 2; ++mi) a[mi] = *(const bf16x8*)(cur + rd_a + mi * 32 * GROW + s * 32);
#pragma unroll
            for (int ni = 0; ni < NT; ++ni) b[ni] = *(const bf16x8*)(cur + rd_b + ni * 32 * GROW + s * 32);
#pragma unroll
            for (int mi = 0; mi < 2; ++mi)
#pragma unroll
                for (int ni = 0; ni < NT; ++ni) acc[mi][ni] = __builtin_amdgcn_mfma_f32_32x32x16_bf16(a[mi], b[ni], acc[mi][ni], 0, 0, 0);
        }
    };
    GStage g0, g1, g2;
    g1.b1 = zero4; g2.b1 = zero4; g0.b1 = zero4;
    const int last = nk - 1;
    gload(g0, 0);
    gload(g1, min(1, last));
    if (DEPTH == 3) gload(g2, min(2, last));
    __syncthreads();
    lstore(g0, sm);
    __syncthreads();
#define GSTEP(k, GL, GS) { gload(GL, min((k) + DEPTH, last)); compute(sm + ((k) & 1) * BUF); lstore(GS, sm + (((k) + 1) & 1) * BUF); __syncthreads(); }
    int ks = 0;
    if (DEPTH == 3) {
#pragma unroll 1
        for (; ks + 3 <= nk; ks += 3) {
            GSTEP(ks, g0, g1)
            GSTEP(ks + 1, g1, g2)
            GSTEP(ks + 2, g2, g0)
        }
        if (ks < nk) {
            GSTEP(ks, g0, g1)
            if (ks + 1 < nk) GSTEP(ks + 1, g1, g2)
        }
    } else if (DEPTH == 2) {
#pragma unroll 1
        for (; ks + 2 <= nk; ks += 2) {
            GSTEP(ks, g0, g1)
            GSTEP(ks + 1, g1, g0)
        }
        if (ks < nk) GSTEP(ks, g0, g1)
    } else {
#pragma unroll 1
        for (; ks < nk; ++ks) GSTEP(ks, g1, g1)
    }
#undef GSTEP
}
constexpr int DMA_STAGE = 16384, GEMM_NST = 3;
#define DMA_WAIT(n) asm volatile("s_waitcnt vmcnt(" #n ")" ::: "memory")
template <int NST>
__device__ __forceinline__ void tile_mac_dma(f32x16 (&acc)[2][2], const bf16_t* __restrict__ A, int lda, int m0,
                                             const bf16_t* __restrict__ Bt, int ldb, int n0, int K, char* sm) {
    static_assert(NST == 3 || NST == 4, "ring of 3 or 4 stages");
    const int tid = tidx(), lane = tid & 63, wid = __builtin_amdgcn_readfirstlane(tid >> 6), wr = wid >> 1, wc = wid & 1;
    const int lr = lane & 31, lh = lane >> 5;
    const int srow = tid >> 2, sslot = tid & 3, schunk = sslot ^ ((srow >> 2) & 3);
    const bf16_t* Ab = A + (size_t)m0 * lda;
    const bf16_t* Bb = Bt + (size_t)n0 * ldb;
    const unsigned ao0 = (unsigned)(srow * lda + schunk * 8), ao1 = ao0 + (unsigned)(64 * lda);
    const unsigned bo0 = (unsigned)(srow * ldb + schunk * 8), bo1 = bo0 + (unsigned)(64 * ldb);
    const int ldst = tid * 16;
    const int sw = (lr >> 2) & 3;
    const int rd_a = (wr * 64 + lr) * 64, rd_b = 8192 + (wc * 64 + lr) * 64;
    const int so0 = ((lh) ^ sw) * 16, so1 = ((lh + 2) ^ sw) * 16;
    const int nk = K / 32, last = nk - 1;
    auto issue = [&](int ks, int slot) {
        const unsigned ko = (unsigned)ks * 32u;
        char* st = sm + slot * DMA_STAGE + ldst;
        __builtin_amdgcn_global_load_lds((const unsigned*)(Ab + (ao0 + ko)), (unsigned*)(st), 16, 0, 0);
        __builtin_amdgcn_global_load_lds((const unsigned*)(Ab + (ao1 + ko)), (unsigned*)(st + 4096), 16, 0, 0);
        __builtin_amdgcn_global_load_lds((const unsigned*)(Bb + (bo0 + ko)), (unsigned*)(st + 8192), 16, 0, 0);
        __builtin_amdgcn_global_load_lds((const unsigned*)(Bb + (bo1 + ko)), (unsigned*)(st + 12288), 16, 0, 0);
    };
    auto compute = [&](int slot) {
        const char* cur = sm + slot * DMA_STAGE;
        bf16x8 a[2][2], b[2][2];
#pragma unroll
        for (int mi = 0; mi < 2; ++mi) { a[mi][0] = *(const bf16x8*)(cur + rd_a + mi * 2048 + so0); a[mi][1] = *(const bf16x8*)(cur + rd_a + mi * 2048 + so1); }
#pragma unroll
        for (int ni = 0; ni < 2; ++ni) { b[ni][0] = *(const bf16x8*)(cur + rd_b + ni * 2048 + so0); b[ni][1] = *(const bf16x8*)(cur + rd_b + ni * 2048 + so1); }
#pragma unroll
        for (int s = 0; s < 2; ++s)
#pragma unroll
            for (int mi = 0; mi < 2; ++mi)
#pragma unroll
                for (int ni = 0; ni < 2; ++ni) acc[mi][ni] = __builtin_amdgcn_mfma_f32_32x32x16_bf16(a[mi][s], b[ni][s], acc[mi][ni], 0, 0, 0);
    };
    __syncthreads();
#pragma unroll
    for (int s = 0; s < NST - 1; ++s) issue(min(s, last), s);
    int slot = 0, nslot = NST - 1;
#pragma unroll 1
    for (int ks = 0; ks < nk; ++ks) {
        if (NST == 3) DMA_WAIT(4); else DMA_WAIT(8);
        __builtin_amdgcn_s_barrier();
        issue(min(ks + NST - 1, last), nslot);
        compute(slot);
        slot = (slot + 1 == NST) ? 0 : slot + 1; nslot = (nslot + 1 == NST) ? 0 : nslot + 1;
    }
    DMA_WAIT(0);
}
constexpr int BIG_STAGE = 24576;
__device__ __forceinline__ void tile_mac_big(f32x16 (&acc)[4][2], const bf16_t* __restrict__ A, int lda, int m0,
                                             const bf16_t* __restrict__ Bt, int ldb, int n0, int K, char* sm) {
    const int tid = tidx(), lane = tid & 63, wid = __builtin_amdgcn_readfirstlane(tid >> 6), wr = wid >> 1, wc = wid & 1;
    const int lr = lane & 31, lh = lane >> 5;
    const int srow = tid >> 2, sslot = tid & 3, schunk = sslot ^ ((srow >> 2) & 3);
    const bf16_t* Ab = A + (size_t)m0 * lda;
    const bf16_t* Bb = Bt + (size_t)n0 * ldb;
    const unsigned ao0 = (unsigned)(srow * lda + schunk * 8), bo0 = (unsigned)(srow * ldb + schunk * 8);
    const int ldst = tid * 16;
    const int sw = (lr >> 2) & 3;
    const int rd_a = (wr * 128 + lr) * 64, rd_b = 16384 + (wc * 64 + lr) * 64;
    const int so0 = ((lh) ^ sw) * 16, so1 = ((lh + 2) ^ sw) * 16;
    const int nk = K / 32, last = nk - 1;
    auto issue1 = [&](int ks, int slot, int i) {
        const unsigned ko = (unsigned)ks * 32u;
        char* st = sm + slot * BIG_STAGE + ldst + i * 4096;
        if (i < 4) __builtin_amdgcn_global_load_lds((const unsigned*)(Ab + (ao0 + (unsigned)(64 * i * lda) + ko)), (unsigned*)st, 16, 0, 0);
        else __builtin_amdgcn_global_load_lds((const unsigned*)(Bb + (bo0 + (unsigned)(64 * (i - 4) * ldb) + ko)), (unsigned*)st, 16, 0, 0);
    };
    __syncthreads();
#pragma unroll
    for (int i = 0; i < 6; ++i) issue1(0, 0, i);
#pragma unroll
    for (int i = 0; i < 6; ++i) issue1(min(1, last), 1, i);
    int slot = 0, nslot = 2;
#pragma unroll 1
    for (int ks = 0; ks < nk; ++ks) {
        DMA_WAIT(6);
        __builtin_amdgcn_s_barrier();
        const char* cur = sm + slot * BIG_STAGE;
        const int kn = min(ks + 2, last);
        bf16x8 a0[4], b0[2], a1[4], b1[2];
#pragma unroll
        for (int mi = 0; mi < 4; ++mi) a0[mi] = *(const bf16x8*)(cur + rd_a + mi * 2048 + so0);
#pragma unroll
        for (int ni = 0; ni < 2; ++ni) b0[ni] = *(const bf16x8*)(cur + rd_b + ni * 2048 + so0);
#pragma unroll
        for (int mi = 0; mi < 4; ++mi) a1[mi] = *(const bf16x8*)(cur + rd_a + mi * 2048 + so1);
#pragma unroll
        for (int ni = 0; ni < 2; ++ni) b1[ni] = *(const bf16x8*)(cur + rd_b + ni * 2048 + so1);
        __builtin_amdgcn_sched_barrier(0);
#pragma unroll
        for (int mi = 0; mi < 4; ++mi) {
            acc[mi][0] = __builtin_amdgcn_mfma_f32_32x32x16_bf16(a0[mi], b0[0], acc[mi][0], 0, 0, 0);
            acc[mi][1] = __builtin_amdgcn_mfma_f32_32x32x16_bf16(a0[mi], b0[1], acc[mi][1], 0, 0, 0);
            __builtin_amdgcn_sched_barrier(0);
            issue1(kn, nslot, mi);
            __builtin_amdgcn_sched_barrier(0);
        }
#pragma unroll
        for (int mi = 0; mi < 4; ++mi) {
            acc[mi][0] = __builtin_amdgcn_mfma_f32_32x32x16_bf16(a1[mi], b1[0], acc[mi][0], 0, 0, 0);
            acc[mi][1] = __builtin_amdgcn_mfma_f32_32x32x16_bf16(a1[mi], b1[1], acc[mi][1], 0, 0, 0);
            if (mi < 2) {
                __builtin_amdgcn_sched_barrier(0);
                issue1(kn, nslot, 4 + mi);
                __builtin_amdgcn_sched_barrier(0);
            }
        }
        slot = (slot + 1 == 3) ? 0 : slot + 1; nslot = (nslot + 1 == 3) ? 0 : nslot + 1;
    }
    DMA_WAIT(0);
}
__device__ __forceinline__ void tile_mac_dma64(f32x16 (&acc)[2][2], const bf16_t* __restrict__ A, int lda, int m0,
                                               const bf16_t* __restrict__ Bt, int ldb, int n0, int K, char* sm) {
    constexpr int STG = 32768;
    const int tid = tidx(), lane = tid & 63, wid = __builtin_amdgcn_readfirstlane(tid >> 6), wr = wid >> 1, wc = wid & 1;
    const int lr = lane & 31, lh = lane >> 5;
    const int srow = tid >> 3, schunk = (tid & 7) ^ ((tid >> 4) & 7);
    const bf16_t* Ab = A + (size_t)m0 * lda;
    const bf16_t* Bb = Bt + (size_t)n0 * ldb;
    const unsigned ao = (unsigned)(srow * lda + schunk * 8), bo = (unsigned)(srow * ldb + schunk * 8);
    const unsigned a32 = (unsigned)(32 * lda), b32 = (unsigned)(32 * ldb);
    const int ldst = tid * 16;
    const int sw = (lr >> 1) & 7;
    const int rd_a = (wr * 64 + lr) * 128, rd_b = 16384 + (wc * 64 + lr) * 128;
    const int nk = K / 64, last = nk - 1;
    auto issue = [&](int ks, int slot) {
        const unsigned ko = (unsigned)ks * 64u;
        char* st = sm + slot * STG + ldst;
#pragma unroll
        for (int i = 0; i < 4; ++i) __builtin_amdgcn_global_load_lds((const unsigned*)(Ab + (ao + i * a32 + ko)), (unsigned*)(st + i * 4096), 16, 0, 0);
#pragma unroll
        for (int i = 0; i < 4; ++i) __builtin_amdgcn_global_load_lds((const unsigned*)(Bb + (bo + i * b32 + ko)), (unsigned*)(st + 16384 + i * 4096), 16, 0, 0);
    };
    auto compute = [&](int slot) {
        const char* cur = sm + slot * STG;
#pragma unroll
        for (int s = 0; s < 4; ++s) {
            const int so = ((lh + 2 * s) ^ sw) * 16;
            bf16x8 a[2], b[2];
#pragma unroll
            for (int mi = 0; mi < 2; ++mi) a[mi] = *(const bf16x8*)(cur + rd_a + mi * 4096 + so);
#pragma unroll
            for (int ni = 0; ni < 2; ++ni) b[ni] = *(const bf16x8*)(cur + rd_b + ni * 4096 + so);
#pragma unroll
            for (int mi = 0; mi < 2; ++mi)
#pragma unroll
                for (int ni = 0; ni < 2; ++ni) acc[mi][ni] = __builtin_amdgcn_mfma_f32_32x32x16_bf16(a[mi], b[ni], acc[mi][ni], 0, 0, 0);
        }
    };
    __syncthreads();
    issue(0, 0);
#pragma unroll 1
    for (int ks = 0; ks < nk; ++ks) {
        DMA_WAIT(0);
        __builtin_amdgcn_s_barrier();
        if (ks < last) issue(ks + 1, (ks + 1) & 1);
        compute(ks & 1);
    }
    DMA_WAIT(0);
}
struct GStage64 { u32x4 a[4], b[4]; };
__device__ __forceinline__ void tile_mac_reg64(f32x16 (&acc)[2][2], const bf16_t* __restrict__ A, int lda, int m0,
                                               const bf16_t* __restrict__ Bt, int ldb, int n0, int K, char* sm) {
    constexpr int STG = 32768;
    const int tid = tidx(), lane = tid & 63, wid = __builtin_amdgcn_readfirstlane(tid >> 6), wr = wid >> 1, wc = wid & 1;
    const int lr = lane & 31, lh = lane >> 5;
    const int srow = tid >> 3, schunk = (tid & 7) ^ ((tid >> 4) & 7);
    const bf16_t* Ab = A + (size_t)m0 * lda;
    const bf16_t* Bb = Bt + (size_t)n0 * ldb;
    const unsigned ao = (unsigned)(srow * lda + schunk * 8), bo = (unsigned)(srow * ldb + schunk * 8);
    const unsigned a32 = (unsigned)(32 * lda), b32 = (unsigned)(32 * ldb);
    const int ldst = tid * 16;
    const int sw = (lr >> 1) & 7;
    const int rd_a = (wr * 64 + lr) * 128, rd_b = 16384 + (wc * 64 + lr) * 128;
    const int nk = K / 64, last = nk - 1;
    auto gload = [&](GStage64& g, int ks) {
        const unsigned ko = (unsigned)ks * 64u;
#pragma unroll
        for (int i = 0; i < 4; ++i) { g.a[i] = *(const u32x4*)(Ab + (ao + i * a32 + ko)); g.b[i] = *(const u32x4*)(Bb + (bo + i * b32 + ko)); }
    };
    auto lstore = [&](const GStage64& g, int slot) {
        char* st = sm + slot * STG + ldst;
#pragma unroll
        for (int i = 0; i < 4; ++i) { *(u32x4*)(st + i * 4096) = g.a[i]; *(u32x4*)(st + 16384 + i * 4096) = g.b[i]; }
    };
    auto compute = [&](int slot) {
        const char* cur = sm + slot * STG;
        bf16x8 fa[2][2], fb[2][2];
#pragma unroll
        for (int mi = 0; mi < 2; ++mi) fa[0][mi] = *(const bf16x8*)(cur + rd_a + mi * 4096 + ((lh ^ sw) * 16));
#pragma unroll
        for (int ni = 0; ni < 2; ++ni) fb[0][ni] = *(const bf16x8*)(cur + rd_b + ni * 4096 + ((lh ^ sw) * 16));
#pragma unroll
        for (int s = 0; s < 4; ++s) {
            if (s < 3) {
                const int so = ((lh + 2 * (s + 1)) ^ sw) * 16;
#pragma unroll
                for (int mi = 0; mi < 2; ++mi) fa[(s + 1) & 1][mi] = *(const bf16x8*)(cur + rd_a + mi * 4096 + so);
#pragma unroll
                for (int ni = 0; ni < 2; ++ni) fb[(s + 1) & 1][ni] = *(const bf16x8*)(cur + rd_b + ni * 4096 + so);
            }
#pragma unroll
            for (int mi = 0; mi < 2; ++mi)
#pragma unroll
                for (int ni = 0; ni < 2; ++ni) acc[mi][ni] = __builtin_amdgcn_mfma_f32_32x32x16_bf16(fa[s & 1][mi], fb[s & 1][ni], acc[mi][ni], 0, 0, 0);
        }
        __builtin_amdgcn_sched_group_barrier(0x100, 8, 0);
        __builtin_amdgcn_sched_group_barrier(0x008, 4, 0);
        __builtin_amdgcn_sched_group_barrier(0x100, 4, 0);
        __builtin_amdgcn_sched_group_barrier(0x008, 4, 0);
        __builtin_amdgcn_sched_group_barrier(0x100, 4, 0);
        __builtin_amdgcn_sched_group_barrier(0x008, 8, 0);
    };
    GStage64 g0, g1;
    gload(g0, 0);
    gload(g1, min(1, last));
    __syncthreads();
    lstore(g0, 0);
    __syncthreads();
#define GSTEP64(k, GL, GS) { gload(GL, min((k) + 2, last)); compute((k) & 1); lstore(GS, ((k) + 1) & 1); __syncthreads(); }
    int ks = 0;
#pragma unroll 1
    for (; ks + 2 <= nk; ks += 2) {
        GSTEP64(ks, g0, g1)
        GSTEP64(ks + 1, g1, g0)
    }
    if (ks < nk) GSTEP64(ks, g0, g1)
#undef GSTEP64
}
template <int NT> __device__ __forceinline__ void acc_zero(f32x16 (&acc)[2][NT]) {
#pragma unroll
    for (int mi = 0; mi < 2; ++mi)
#pragma unroll
        for (int ni = 0; ni < NT; ++ni)
#pragma unroll
            for (int r = 0; r < 16; ++r) acc[mi][ni][r] = 0.f;
}
template <int BN, class Epi>
__device__ __forceinline__ void gemm_bf16(const bf16_t* A, int lda, const bf16_t* Bt, int ldb, int M, int N, int K, const Epi& epi, int bid, int nb, char* sm) {
    constexpr int NT = BN / 64;
    const int tm = M / 128, tn = (N + BN - 1) / BN;
    for (int tile = bid; tile < tm * tn; tile += nb) {
        const int m0 = (tile % tm) * 128, n0 = (tile / tm) * BN;
        f32x16 acc[2][NT]; acc_zero<NT>(acc);
        if constexpr (BN == 128) { if (K % 64 == 0 && K >= 128) tile_mac_reg64(acc, A, lda, m0, Bt, ldb, n0, K, sm); else tile_mac_dma<GEMM_NST>(acc, A, lda, m0, Bt, ldb, n0, K, sm); }
        else tile_mac<BN>(acc, A, lda, m0, Bt, ldb, n0, N, K, sm);
        const int lane = tidx() & 63, wid = __builtin_amdgcn_readfirstlane(tidx() >> 6), wr = wid >> 1, wc = wid & 1, lr = lane & 31, lh = lane >> 5;
        const int col0 = n0 + wc * (BN / 2);
        if (col0 < N) epi(acc, m0 + wr * 64, col0, lr, lh, sm + (((K / 64) & 1) ? 32768 : 0) + wid * 8192);
    }
}
template <class Epi>
__device__ __forceinline__ int gemm_big(const bf16_t* A, int lda, const bf16_t* Bt, int ldb, int M, int N, int K, const Epi& epi, int bid, int nb, char* sm) {
    const int tm = M / 256, tn = N / 128, ntb = tm * tn, nfull = (ntb / nb) * nb;
    for (int tile = bid; tile < nfull; tile += nb) {
        const int m0 = (tile % tm) * 256, n0 = (tile / tm) * 128;
        f32x16 acc[4][2];
        acc_zero<2>(reinterpret_cast<f32x16 (&)[2][2]>(acc[0])); acc_zero<2>(reinterpret_cast<f32x16 (&)[2][2]>(acc[2]));
        tile_mac_big(acc, A, lda, m0, Bt, ldb, n0, K, sm);
        __syncthreads();
        const int lane = tidx() & 63, wid = __builtin_amdgcn_readfirstlane(tidx() >> 6), wr = wid >> 1, wc = wid & 1, lr = lane & 31, lh = lane >> 5;
        epi(reinterpret_cast<const f32x16 (&)[2][2]>(acc[0]), m0 + wr * 128, n0 + wc * 64, lr, lh, sm + wid * 8192);
        epi(reinterpret_cast<const f32x16 (&)[2][2]>(acc[2]), m0 + wr * 128 + 64, n0 + wc * 64, lr, lh, sm + wid * 8192);
    }
    const int nsmall = 2 * (ntb - nfull);
    for (int st = bid; st < nsmall; st += nb) {
        const int tile = nfull + (st >> 1);
        const int m0 = (tile % tm) * 256 + (st & 1) * 128, n0 = (tile / tm) * 128;
        f32x16 acc[2][2]; acc_zero<2>(acc);
        tile_mac_reg64(acc, A, lda, m0, Bt, ldb, n0, K, sm);
        const int lane = tidx() & 63, wid = __builtin_amdgcn_readfirstlane(tidx() >> 6), wr = wid >> 1, wc = wid & 1, lr = lane & 31, lh = lane >> 5;
        epi(acc, m0 + wr * 64, n0 + wc * 64, lr, lh, sm + (((K / 64) & 1) ? 32768 : 0) + wid * 8192);
    }
    return nsmall < nb ? nsmall : nb;
}
#define EROW(mi, r) (row0 + (mi) * 32 + ((r) & 3) + 8 * ((r) >> 2) + 4 * lh)
__device__ __forceinline__ float bf2f(bf16_t h) { return __uint_as_float((unsigned)h << 16); }
__device__ __forceinline__ void epi_rope64(const f32x16 (&acc)[2][2], int row0, int lr, int lh, const float* __restrict__ rope, bf16_t* __restrict__ dst, int ld, int cbase) {
#pragma unroll
    for (int mi = 0; mi < 2; ++mi)
#pragma unroll
        for (int r = 0; r < 16; ++r) {
            const size_t row = EROW(mi, r);
            const float c = rope[row * 64 + lr], s = rope[row * 64 + 32 + lr], x1 = acc[mi][0][r], x2 = acc[mi][1][r];
            dst[row * ld + cbase + lr] = f2bf(x1 * c - x2 * s); dst[row * ld + cbase + 32 + lr] = f2bf(x2 * c + x1 * s);
        }
}
template <int NTI>
__device__ __forceinline__ void epi_rope32(const f32x16 (&acc)[2][2], int row0, int lr, int lh, const float* __restrict__ rope, bf16_t* __restrict__ dst, int ld, int cbase) {
    const int f = lr & 15;
#pragma unroll
    for (int mi = 0; mi < 2; ++mi)
#pragma unroll
        for (int ni = 0; ni < NTI; ++ni)
#pragma unroll
            for (int r = 0; r < 16; ++r) {
                const size_t row = EROW(mi, r);
                const float x = acc[mi][ni][r], xo = shx<16>(x);
                const float c = rope[row * 64 + 2 * f], s = rope[row * 64 + 32 + 2 * f];
                dst[row * ld + cbase + ni * 32 + lr] = f2bf((lr & 16) ? (x * c + xo * s) : (x * c - xo * s));
            }
}
template <int NT, bool SILU>
__device__ __forceinline__ void epi_bf16(const f32x16 (&acc)[2][NT], int row0, int lr, int lh, bf16_t* __restrict__ dst, int ld, int cbase) {
#pragma unroll
    for (int mi = 0; mi < 2; ++mi)
#pragma unroll
        for (int ni = 0; ni < NT; ++ni)
#pragma unroll
            for (int r = 0; r < 16; ++r) { const float v = acc[mi][ni][r]; dst[(size_t)EROW(mi, r) * ld + cbase + ni * 32 + lr] = f2bf(SILU ? silu_(v) : v); }
}
template <int NT>
__device__ __forceinline__ void epi_vt(const f32x16 (&acc)[2][NT], int trow0, int lr, int lh, bf16_t* __restrict__ vt, size_t ldv) {
#pragma unroll
    for (int mi = 0; mi < 2; ++mi)
#pragma unroll
        for (int ni = 0; ni < NT; ++ni)
#pragma unroll
            for (int g = 0; g < 4; ++g) {
                u32x2 o; o.x = cvt_pk_bf16(acc[mi][ni][4 * g], acc[mi][ni][4 * g + 1]); o.y = cvt_pk_bf16(acc[mi][ni][4 * g + 2], acc[mi][ni][4 * g + 3]);
                *(u32x2*)(vt + (size_t)(ni * 32 + lr) * ldv + trow0 + mi * 32 + 8 * g + 4 * lh) = o;
            }
}
template <int NT>
__device__ __forceinline__ void epi_f32(const f32x16 (&acc)[2][NT], int row0, int lr, int lh, float* __restrict__ dst, int ld, int cbase) {
#pragma unroll
    for (int mi = 0; mi < 2; ++mi)
#pragma unroll
        for (int ni = 0; ni < NT; ++ni)
#pragma unroll
            for (int r = 0; r < 16; ++r) dst[(size_t)EROW(mi, r) * ld + cbase + ni * 32 + lr] = acc[mi][ni][r];
}
template <class F>
__device__ __forceinline__ void staged_bf16_tile(char* stg, bf16_t* dp, size_t ld, int lr, int lh, F val) {
    bf16_t* sg = (bf16_t*)stg;
#pragma unroll
    for (int mi = 0; mi < 2; ++mi)
#pragma unroll
        for (int r = 0; r < 16; ++r) {
            const int rl = mi * 32 + (r & 3) + 8 * (r >> 2) + 4 * lh;
            float o0, o1; val(mi, r, rl, o0, o1);
            sg[rl * 64 + ((((lr >> 3)) ^ (rl & 7)) << 3) + (lr & 7)] = f2bf(o0); sg[rl * 64 + ((((lr >> 3) + 4) ^ (rl & 7)) << 3) + (lr & 7)] = f2bf(o1);
        }
    __builtin_amdgcn_wave_barrier();
    const int lane = lh * 32 + lr;
#pragma unroll
    for (int i = 0; i < 8; ++i) {
        const int piece = lane + 64 * i, rr = piece >> 3, ch = piece & 7;
        const u32x4 v = *(const u32x4*)(sg + rr * 64 + ((ch ^ (rr & 7)) << 3));
        *(u32x4*)(dp + (size_t)rr * ld + ch * 8) = v;
    }
    __builtin_amdgcn_wave_barrier();
}
constexpr float QSCALE = 0.125f * 1.4426950408889634f;
struct EpiInProj {
    const Params& p; int layer;
    __device__ __forceinline__ void operator()(const f32x16 (&acc)[2][2], int row0, int col0, int lr, int lh, char* stg) const {
        const int b = row0 / S, t0 = row0 % S;
        const float* rope = p.ROPE();
        int kind, ld = 256, cbase = 0; size_t off = 0; bool silu = false; float osc = 1.f;
        if (col0 < M_QN)         { kind = 0; off = OFF_QA; cbase = col0 - M_QA; osc = QSCALE; }
        else if (col0 < M_KSLC)  { kind = 0; off = OFF_QN; cbase = col0 - M_QN; osc = QSCALE; }
        else if (col0 == M_KSLC) { kind = 0; off = OFF_KSLC; ld = 64; }
        else if (col0 == M_KWIN) { kind = 0; off = OFF_KWIN; ld = 64; }
        else if (col0 == M_KC)   { kind = 0; off = OFF_KCT; ld = 64; }
        else if (col0 == M_VC)   { kind = 1; off = OFF_VCTOK; ld = 64; }
        else if (col0 < M_KF)    { kind = 1; off = OFF_QF; cbase = col0 - M_QF; osc = QSCALE; }
        else if (col0 < M_QS)    { kind = 1; off = OFF_KF; cbase = col0 - M_KF; }
        else if (col0 < M_KSB)   { kind = 1; off = OFF_QS; cbase = col0 - M_QS; osc = QSCALE; }
        else if (col0 < M_QM)    { kind = 1; off = OFF_KSB; cbase = col0 - M_KSB; }
        else if (col0 < M_VF)    { kind = 1; off = OFF_QM; cbase = col0 - M_QM; osc = QSCALE; }
        else if (col0 < M_VS)    { kind = 2; off = OFF_VFT + ((size_t)(b * 4 + (col0 - M_VF) / 64) * 64) * S * 2; }
        else if (col0 < M_VSLC)  { kind = 2; off = OFF_VST + ((size_t)(b * 4 + (col0 - M_VS) / 64) * 64) * S * 2; }
        else if (col0 == M_VSLC) { kind = 2; off = OFF_VSLCT + ((size_t)b * 64) * S * 2; }
        else if (col0 == M_VWIN) { kind = 2; off = OFF_VWINT + ((size_t)b * 64) * S * 2; }
        else if (col0 < M_SPC)   { kind = 3; off = OFF_QI; ld = 128; cbase = col0 - M_QI; }
        else if (col0 == M_SPC)  { kind = 4; }
        else if (col0 < M_Z)     { kind = 5; off = OFF_CKVR; ld = 128; cbase = col0 - M_CKV; }
        else if (col0 < NPM)     { kind = 1; off = OFF_ZG; ld = 1280; cbase = col0 - M_Z; silu = true; }
        else if (col0 < M_MERGE) { return; }
        else                     { kind = 6; }
        bf16_t* dst = (bf16_t*)(p.ws + off);
        if (kind <= 3) {
            bf16_t* sg = (bf16_t*)stg;
            if (kind == 2) {
#pragma unroll
                for (int mi = 0; mi < 2; ++mi)
#pragma unroll
                    for (int ni = 0; ni < 2; ++ni)
#pragma unroll
                        for (int g = 0; g < 4; ++g) {
                            u32x2 o; o.x = cvt_pk_bf16(acc[mi][ni][4 * g], acc[mi][ni][4 * g + 1]); o.y = cvt_pk_bf16(acc[mi][ni][4 * g + 2], acc[mi][ni][4 * g + 3]);
                            const int d = ni * 32 + lr, tk = mi * 32 + 8 * g + 4 * lh;
                            *(u32x2*)(sg + d * 64 + (((tk >> 3) ^ (d & 7)) << 3) + (tk & 7)) = o;
                        }
            } else {
#pragma unroll
                for (int mi = 0; mi < 2; ++mi)
#pragma unroll
                    for (int r = 0; r < 16; ++r) {
                        const int rl = mi * 32 + (r & 3) + 8 * (r >> 2) + 4 * lh;
                        const size_t row = (size_t)row0 + rl;
                        float o0, o1;
                        if (kind == 0) {
                            const float c = rope[row * 64 + lr], s = rope[row * 64 + 32 + lr], x1 = acc[mi][0][r], x2 = acc[mi][1][r];
                            o0 = x1 * c - x2 * s; o1 = x2 * c + x1 * s;
                        } else if (kind == 3) {
                            const int f = lr & 15;
                            const float c = rope[row * 64 + 2 * f], s = rope[row * 64 + 32 + 2 * f];
                            const float x0 = acc[mi][0][r], x1 = acc[mi][1][r], y0 = shx<16>(x0), y1 = shx<16>(x1);
                            o0 = (lr & 16) ? (x0 * c + y0 * s) : (x0 * c - y0 * s); o1 = (lr & 16) ? (x1 * c + y1 * s) : (x1 * c - y1 * s);
                        } else {
                            o0 = acc[mi][0][r]; o1 = acc[mi][1][r];
                            if (silu) { o0 = silu_(o0); o1 = silu_(o1); }
                        }
                        sg[rl * 64 + ((((lr >> 3)) ^ (rl & 7)) << 3) + (lr & 7)] = f2bf(o0 * osc); sg[rl * 64 + ((((lr >> 3) + 4) ^ (rl & 7)) << 3) + (lr & 7)] = f2bf(o1 * osc);
                        if ((r & 3) == 3) __builtin_amdgcn_sched_barrier(0);
                    }
            }
            __builtin_amdgcn_wave_barrier();
            const size_t ldd = (kind == 2) ? (size_t)S : (size_t)ld;
            bf16_t* dp = (kind == 2) ? (dst + t0) : (dst + (size_t)row0 * ld + cbase);
            const int lane = lh * 32 + lr;
#pragma unroll
            for (int i = 0; i < 8; ++i) {
                const int piece = lane + 64 * i, rr = piece >> 3, ch = piece & 7;
                const u32x4 v = *(const u32x4*)(sg + rr * 64 + ((ch ^ (rr & 7)) << 3));
                *(u32x4*)(dp + (size_t)rr * ldd + ch * 8) = v;
            }
            __builtin_amdgcn_wave_barrier();
        }
        else if (kind == 5) epi_f32<2>(acc, row0, lr, lh, (float*)dst, ld, cbase);
        else if (kind == 6) {
            const int tile = (row0 >> 7) * 40 + ((col0 - M_MERGE) >> 7), wave = ((row0 >> 6) & 1) * 2 + ((col0 >> 6) & 1);
            unsigned char* sp = (unsigned char*)p.SIG() + ((size_t)(tile * 4 + wave) * 4) * 1024 + (size_t)(lh * 32 + lr) * 16;
#define SIGQ(x_) floorf(fmaf(sigmoid_(x_), 255.f, 0.5f))
#pragma unroll
            for (int mi = 0; mi < 2; ++mi)
#pragma unroll
                for (int ni = 0; ni < 2; ++ni) {
                    unsigned wq[4];
#pragma unroll
                    for (int g = 0; g < 4; ++g) {
                        unsigned w = __builtin_amdgcn_cvt_pk_u8_f32(SIGQ(acc[mi][ni][4 * g]), 0, 0u);
                        w = __builtin_amdgcn_cvt_pk_u8_f32(SIGQ(acc[mi][ni][4 * g + 1]), 1, w);
                        w = __builtin_amdgcn_cvt_pk_u8_f32(SIGQ(acc[mi][ni][4 * g + 2]), 2, w);
                        w = __builtin_amdgcn_cvt_pk_u8_f32(SIGQ(acc[mi][ni][4 * g + 3]), 3, w);
                        wq[g] = w;
                    }
                    *(u32x4*)(sp + (size_t)(mi * 2 + ni) * 1024) = u32x4{wq[0], wq[1], wq[2], wq[3]};
                }
#undef SIGQ
        }
        else {
            epi_rope32<1>(acc, row0, lr, lh, rope, p.KI(), 32, 0);
            const float fb = p.fox_bias[layer * 4 + (lr & 3)];
            float* sbase = (lr < 4) ? (p.WI() + lr) : (lr < 8) ? (p.LOGF() + (lr - 4)) : (p.GN() + (lr - 8));
            const int sstride = (lr < 8) ? 4 : 12;
#pragma unroll
            for (int mi = 0; mi < 2; ++mi)
#pragma unroll
                for (int r = 0; r < 16; ++r) {
                    const size_t row = EROW(mi, r); const float v = acc[mi][1][r];
                    const float u = (lr < 8) ? (v + fb) : v;
                    const float e = __builtin_amdgcn_exp2f(-1.4426950408889634f * fabsf(u));
                    const float lsg = fminf(u, 0.f) - __builtin_amdgcn_logf(1.f + e) * 0.6931471805599453f;
                    const float sg = ((u >= 0.f) ? 1.f : e) * __builtin_amdgcn_rcpf(1.f + e);
                    const float o = (lr < 4) ? v * 0.08838834764831845f : ((lr < 8) ? lsg : sg);
                    if (lr < 20) sbase[row * sstride] = o;
                }
        }
    }
};
struct EpiMemKV {
    const Params& p;
    __device__ __forceinline__ void operator()(const f32x16 (&acc)[2][2], int row0, int col0, int lr, int lh, char* stg) const {
        if (col0 < 256) epi_bf16<2, false>(acc, row0, lr, lh, p.MKB(), 256, col0);
        else epi_vt<2>(acc, row0 % NMEM, lr, lh, p.MVT() + ((size_t)((row0 / NMEM) * 4 + (col0 - 256) / 64) * 64) * NMEM, NMEM);
    }
};
struct EpiKA { const Params& p;
    __device__ __forceinline__ void operator()(const f32x16 (&acc)[2][2], int row0, int col0, int lr, int lh, char* stg) const {
        const float* rope = p.ROPE();
        staged_bf16_tile(stg, p.KAB() + (size_t)row0 * 256 + col0, 256, lr, lh, [&](int mi, int r, int rl, float& o0, float& o1) {
            const size_t row = (size_t)row0 + rl;
            const float c = rope[row * 64 + lr], sn = rope[row * 64 + 32 + lr], x1 = acc[mi][0][r], x2 = acc[mi][1][r];
            o0 = x1 * c - x2 * sn; o1 = x2 * c + x1 * sn; });
    } };
struct EpiVA { const Params& p;
    __device__ __forceinline__ void operator()(const f32x16 (&acc)[2][2], int row0, int col0, int lr, int lh, char* stg) const {
        epi_vt<2>(acc, row0 % S, lr, lh, p.VAT() + ((size_t)((row0 / S) * 4 + col0 / 64) * 64) * S, S); } };
struct EpiResid { const float* Xin; float* Xout;
    __device__ __forceinline__ void operator()(const f32x16 (&acc)[2][2], int row0, int col0, int lr, int lh, char* stg) const {
#pragma unroll
        for (int mi = 0; mi < 2; ++mi) {
            float xv[2][16];
#pragma unroll
            for (int ni = 0; ni < 2; ++ni)
#pragma unroll
                for (int r = 0; r < 16; ++r) xv[ni][r] = Xin[(size_t)EROW(mi, r) * D + col0 + ni * 32 + lr];
#pragma unroll
            for (int ni = 0; ni < 2; ++ni)
#pragma unroll
                for (int r = 0; r < 16; ++r) Xout[(size_t)EROW(mi, r) * D + col0 + ni * 32 + lr] = xv[ni][r] + acc[mi][ni][r];
        }
    } };
struct EpiCmp1 { const float* bias; bf16_t* hid;
    __device__ __forceinline__ void operator()(const f32x16 (&acc)[2][2], int row0, int col0, int lr, int lh, char* stg) const {
#pragma unroll
        for (int ni = 0; ni < 2; ++ni) {
            const float bv = bias[col0 + ni * 32 + lr];
#pragma unroll
            for (int mi = 0; mi < 2; ++mi)
#pragma unroll
                for (int r = 0; r < 16; ++r) hid[(size_t)EROW(mi, r) * 128 + col0 + ni * 32 + lr] = f2bf(silu_(acc[mi][ni][r] + bv));
        }
    } };
struct EpiCmp2K { bf16_t* kcb;
    __device__ __forceinline__ void operator()(const f32x16 (&acc)[2][1], int row0, int col0, int lr, int lh, char* stg) const {
#pragma unroll
        for (int mi = 0; mi < 2; ++mi)
#pragma unroll
            for (int r = 0; r < 16; ++r) { const int row = EROW(mi, r); kcb[(size_t)row * 64 + col0 + lr] = ((row & 511) == 511) ? (bf16_t)0 : f2bf(acc[mi][0][r]); }
    } };
struct EpiCmp2V { bf16_t* vct;
    __device__ __forceinline__ void operator()(const f32x16 (&acc)[2][1], int row0, int col0, int lr, int lh, char* stg) const {
        bf16_t* base = vct + ((size_t)(row0 / 512) * 64 + col0) * 512;
        const int n0 = row0 % 512;
#pragma unroll
        for (int mi = 0; mi < 2; ++mi)
#pragma unroll
            for (int g = 0; g < 4; ++g) {
                const int n = n0 + mi * 32 + 8 * g + 4 * lh;
                u32x2 o; o.x = cvt_pk_bf16(acc[mi][0][4 * g], acc[mi][0][4 * g + 1]); o.y = cvt_pk_bf16(acc[mi][0][4 * g + 2], (n + 3 == 511) ? 0.f : acc[mi][0][4 * g + 3]);
                *(u32x2*)(base + (size_t)lr * 512 + n) = o;
            }
    } };

__device__ __forceinline__ void ph_merge(const Params& p, int layer, int bid, int nb, char* sm) {
    const int lane = tidx() & 63, wid = __builtin_amdgcn_readfirstlane(tidx() >> 6), wr = wid >> 1, wc = wid & 1, lr = lane & 31, lh = lane >> 5;
    for (int tile = bid; tile < (T / 128) * (D / 128); tile += nb) {
        const int mt = tile % (T / 128), nt = tile / (T / 128), m0 = mt * 128, n0 = nt * 128;
        f32x16 mg[2][2]; acc_zero<2>(mg);
#pragma unroll 1
        for (int n = 0; n < 5; ++n) {
            f32x16 g[2][2]; acc_zero<2>(g);
            const unsigned char* sp = (const unsigned char*)p.SIG() + ((size_t)((mt * 40 + n * 8 + nt) * 4 + wid) * 4) * 1024 + (size_t)lane * 16;
            u32x4 sgw[4];
#pragma unroll
            for (int i = 0; i < 4; ++i) sgw[i] = *(const u32x4*)(sp + (size_t)i * 1024);
            tile_mac_dma64(g, p.Y() + n * 256, 1280, m0, p.WBR() + ((size_t)layer * 5 + n) * D * 256, 256, n0, 256, sm);
#pragma unroll
            for (int mi = 0; mi < 2; ++mi)
#pragma unroll
                for (int ni = 0; ni < 2; ++ni) {
                    const u32x4 w = sgw[mi * 2 + ni];
                    const unsigned sw[4] = {w.x, w.y, w.z, w.w};
#pragma unroll
                    for (int q = 0; q < 4; ++q) {
                        mg[mi][ni][4 * q] = fmaf((float)(sw[q] & 255u), g[mi][ni][4 * q], mg[mi][ni][4 * q]);
                        mg[mi][ni][4 * q + 1] = fmaf((float)((sw[q] >> 8) & 255u), g[mi][ni][4 * q + 1], mg[mi][ni][4 * q + 1]);
                        mg[mi][ni][4 * q + 2] = fmaf((float)((sw[q] >> 16) & 255u), g[mi][ni][4 * q + 2], mg[mi][ni][4 * q + 2]);
                        mg[mi][ni][4 * q + 3] = fmaf((float)(sw[q] >> 24), g[mi][ni][4 * q + 3], mg[mi][ni][4 * q + 3]);
                    }
                }
        }
        __syncthreads();
        staged_bf16_tile(sm + wid * 8192, p.MG() + (size_t)(m0 + wr * 64) * D + n0 + wc * 64, D, lr, lh,
                         [&](int mi, int r, int, float& o0, float& o1) { o0 = mg[mi][0][r] * (1.f / 255.f); o1 = mg[mi][1][r] * (1.f / 255.f); });
    }
}

__device__ __forceinline__ void ph_cumsum(const Params& p, int bid, int nb, float* sm) {
    const int tid = tidx();
    float* buf = sm;
    float* ps = sm + 8192 + 256;
    for (int u = bid; u < NBATCH * 4; u += nb) {
        const int b = u >> 2, h = u & 3;
        const float4* src4 = (const float4*)(p.LOGF() + (size_t)b * S * 4);
        __syncthreads();
#pragma unroll 8
        for (int i = 0; i < 32; ++i) {
            const int tok = i * 256 + tid;
            const float4 v = src4[tok];
            buf[tok + (tok >> 5)] = (h == 0) ? v.x : (h == 1) ? v.y : (h == 2) ? v.z : v.w;
        }
        __syncthreads();
        float run = 0.f;
#pragma unroll 8
        for (int j = 0; j < 32; ++j) { run += buf[tid * 33 + j]; buf[tid * 33 + j] = run; }
        ps[tid] = run;
        __syncthreads();
        for (int off = 1; off < 256; off <<= 1) {
            float t = 0.f;
            if (tid >= off) t = ps[tid - off];
            __syncthreads();
            ps[tid] += t;
            __syncthreads();
        }
        const float pre = (tid > 0) ? ps[tid - 1] : 0.f;
#pragma unroll 8
        for (int j = 0; j < 32; ++j) buf[tid * 33 + j] = (buf[tid * 33 + j] + pre) * 1.4426950408889634f;
        __syncthreads();
        float* dst = p.CUMT() + (size_t)u * S;
#pragma unroll 8
        for (int i = 0; i < 32; ++i) { const int tok = i * 256 + tid; dst[tok] = buf[tok + (tok >> 5)]; }
    }
    __syncthreads();
}

enum { AM_FOX = 0, AM_DSA = 1, AM_SLC = 2, AM_SB = 3, AM_WIN = 4, AM_MEM = 5, AM_CMP = 6 };
constexpr int AK_ROW = 144;
constexpr int AK_TILE = 64 * AK_ROW;
constexpr int ABUF = 2 * AK_TILE + 256;
constexpr int ATT_NST = 3, ATT_STAGE = 16384 + 1024;
constexpr float LOG2E = 1.4426950408889634f;
#define NEG_INF (-__builtin_inff())

template <int MODE>
__device__ __forceinline__ void attn_core(const Params& p, int b, int head, int qblk, char* sm, f32x16 (&O)[2], float& inv) {
    const int tid = tidx(), lane = tid & 63, wid = __builtin_amdgcn_readfirstlane(tid >> 6), lr = lane & 31, lh = lane >> 5;
    const int q0 = qblk * 128, qw0 = q0 + 32 * wid, tq = qw0 + lr;
    const size_t gq = (size_t)b * S + tq;
    const bf16_t *Qp, *Kp, *VTp; int ldk, ldv;
    if (MODE == AM_FOX)      { Qp = p.QF() + gq * 256 + head * 64; Kp = p.KF() + (size_t)b * S * 256 + head * 64; ldk = 256; VTp = p.VFT() + ((size_t)(b * 4 + head) * 64) * S; ldv = S; }
    else if (MODE == AM_DSA) { Qp = p.QA() + gq * 256 + head * 64; Kp = p.KAB() + (size_t)b * S * 256 + head * 64; ldk = 256; VTp = p.VAT() + ((size_t)(b * 4 + head) * 64) * S; ldv = S; }
    else if (MODE == AM_SB)  { Qp = p.QS() + gq * 256 + head * 64; Kp = p.KSB() + (size_t)b * S * 256 + head * 64; ldk = 256; VTp = p.VST() + ((size_t)(b * 4 + head) * 64) * S; ldv = S; }
    else if (MODE == AM_SLC) { Qp = p.QN() + gq * 256 + head * 64; Kp = p.KSLC() + (size_t)b * S * 64; ldk = 64; VTp = p.VSLCT() + ((size_t)b * 64) * S; ldv = S; }
    else if (MODE == AM_WIN) { Qp = p.QN() + gq * 256 + head * 64; Kp = p.KWIN() + (size_t)b * S * 64; ldk = 64; VTp = p.VWINT() + ((size_t)b * 64) * S; ldv = S; }
    else if (MODE == AM_CMP) { Qp = p.QN() + gq * 256 + head * 64; Kp = p.KCB() + (size_t)b * NCMP_PAD * 64; ldk = 64; VTp = p.VCT() + ((size_t)b * 64) * NCMP_PAD; ldv = NCMP_PAD; }
    else                     { Qp = p.QM() + gq * 256 + head * 64; Kp = p.MKB() + (size_t)b * NMEM * 256 + head * 64; ldk = 256; VTp = p.MVT() + ((size_t)(b * 4 + head) * 64) * NMEM; ldv = NMEM; }
    int kt_lo = 0, kt_hi = 2 * qblk + 2;
    if (MODE == AM_WIN) kt_lo = q0 >= 512 ? (q0 - 512) / 64 : 0;
    if (MODE == AM_MEM) kt_hi = NMEM / 64;
    if (MODE == AM_CMP) kt_hi = min(8, (((q0 + 96) >> 4) >> 6) + 1);
    const int nlim = (tq - 31) >> 4;
    const int ntile = kt_hi - kt_lo;
    constexpr bool REV = (MODE == AM_SB);

    bf16x8 qf[4];
#pragma unroll
    for (int s = 0; s < 4; ++s) qf[s] = *(const bf16x8*)(Qp + 16 * s + 8 * lh);
    unsigned smw[4] = {0u, 0u, 0u, 0u};
    if (MODE == AM_SLC) { const u32x4 w = *(const u32x4*)(p.SMASK() + gq * 4); smw[0] = w.x; smw[1] = w.y; smw[2] = w.z; smw[3] = w.w; }
    const unsigned* mrow32 = p.DMASK() + ((size_t)b * 128 * S + qw0) * 2;
    const float* csp = p.CUMT() + (size_t)(b * 4 + head) * S;

    const int srow = tid >> 3, schunk = (tid & 7) ^ ((srow >> 1) & 7);
    const bf16_t* kg0 = Kp + (size_t)srow * ldk + schunk * 8;
    const bf16_t* vg0 = VTp + (size_t)srow * ldv + schunk * 8;
    const int ldst = tid * 16;
    auto issue = [&](int kt, int slot) {
        char* st = sm + slot * ATT_STAGE + ldst;
        const bf16_t* kgp = kg0 + (size_t)kt * 64 * ldk;
        const bf16_t* vgp = vg0 + kt * 64;
        __builtin_amdgcn_global_load_lds((const unsigned*)kgp, (unsigned*)st, 16, 0, 0);
        __builtin_amdgcn_global_load_lds((const unsigned*)(kgp + (size_t)32 * ldk), (unsigned*)(st + 4096), 16, 0, 0);
        __builtin_amdgcn_global_load_lds((const unsigned*)vgp, (unsigned*)(st + 8192), 16, 0, 0);
        __builtin_amdgcn_global_load_lds((const unsigned*)(vgp + (size_t)32 * ldv), (unsigned*)(st + 12288), 16, 0, 0);
        if (MODE == AM_FOX) __builtin_amdgcn_global_load_lds((const unsigned*)(csp + kt * 64 + lane), (unsigned*)(sm + slot * ATT_STAGE + 16384 + tid * 4), 4, 0, 0);
        if (MODE == AM_DSA) __builtin_amdgcn_global_load_lds((const unsigned*)(mrow32 + (size_t)kt * S * 2 + lane), (unsigned*)(sm + slot * ATT_STAGE + 16384 + tid * 4), 4, 0, 0);
    };
    const int pil = (lr & 0x13) | ((lr & 4) << 1) | ((lr & 8) >> 1);
    const int ksw = (pil >> 1) & 7, vsw = (lr >> 1) & 7;
    int rdk[4], rdv[4];
#pragma unroll
    for (int j = 0; j < 4; ++j) { rdk[j] = pil * 128 + (((2 * j + lh) ^ ksw) << 4); rdv[j] = 8192 + lr * 128 + (((2 * j + lh) ^ vsw) << 4); }

    float m = NEG_INF, l = 0.f, R = 1.f;
#pragma unroll
    for (int i = 0; i < 16; ++i) { O[0][i] = 0.f; O[1][i] = 0.f; }

    static_assert(ATT_NST == 3, "the vmcnt arithmetic below is written for a 3-stage ring");
    __syncthreads();
    auto tile_of = [&](int it) { const int c = min(it, ntile - 1); return REV ? kt_hi - 1 - c : kt_lo + c; };
    issue(tile_of(0), 0);
    issue(tile_of(1), 1);
    int slot = 0, nslot = ATT_NST - 1;
#pragma unroll 1
    for (int it = 0; it < ntile; ++it) {
        const int kt = REV ? kt_hi - 1 - it : kt_lo + it;
        constexpr int NPER = (MODE == AM_FOX || MODE == AM_DSA) ? 5 : 4;
        if (NPER == 5) DMA_WAIT(5); else DMA_WAIT(4);
        __builtin_amdgcn_s_barrier();
        const char* cur = sm + slot * ATT_STAGE;
        unsigned long long mw = 0ull;
        if (MODE == AM_DSA) mw = *(const unsigned long long*)(cur + 16384 + wid * 256 + lr * 8);
        issue(tile_of(it + ATT_NST - 1), nslot);
        slot = (slot + 1 == ATT_NST) ? 0 : slot + 1; nslot = (nslot + 1 == ATT_NST) ? 0 : nslot + 1;
        bool need = true;
        if (MODE == AM_CMP) need = kt * 64 <= (qw0 >> 4);
        else if (MODE != AM_MEM) need = kt * 64 <= qw0 + 31;
        if (MODE == AM_WIN) need = need && (kt * 64 + 63 >= qw0 - 511);
        if (need) {
            f32x16 sv[2];
#pragma unroll
            for (int sub = 0; sub < 2; ++sub) {
                f32x16 a;
#pragma unroll
                for (int i = 0; i < 16; ++i) a[i] = 0.f;
#pragma unroll
                for (int s4 = 0; s4 < 4; ++s4) {
                    const bf16x8 kf = *(const bf16x8*)(cur + rdk[s4] + sub * 4096);
                    a = __builtin_amdgcn_mfma_f32_32x32x16_bf16(kf, qf[s4], a, 0, 0, 0);
                }
                sv[sub] = a;
            }
            if (MODE == AM_SB) {
#pragma unroll
                for (int sb2 = 0; sb2 < 2; ++sb2) {
                    const int sub = 1 - sb2;
                    {
                        f32x16& s = sv[sub];
                        const int thl = tq - (kt * 64 + sub * 32) - 8 * lh;
                        f32x2 kp[8], sg[8];
                        const bool dgl = (kt * 64 + sub * 32 + 31) >= qw0;
                        const f32x2 one2 = {1.f, 1.f};
#pragma unroll
                        for (int r = 0; r < 8; ++r) {
                            const float z0 = __builtin_amdgcn_fmed3f(s[r], -64.f, 64.f), z1 = __builtin_amdgcn_fmed3f(s[r + 8], -64.f, 64.f);
                            f32x2 e = {__builtin_amdgcn_exp2f(-z0), __builtin_amdgcn_exp2f(-z1)};
                            const f32x2 d = e + one2;
                            const f32x2 rc = {__builtin_amdgcn_rcpf(d.x), __builtin_amdgcn_rcpf(d.y)};
                            kp[r] = e * rc; sg[r] = rc;
                        }
                        if (dgl) {
#pragma unroll
                            for (int r = 0; r < 8; ++r) {
                                const bool ok0 = r < thl, ok1 = (r + 16) < thl;
                                kp[r].x = ok0 ? kp[r].x : 1.f; sg[r].x = ok0 ? sg[r].x : 0.f;
                                kp[r].y = ok1 ? kp[r].y : 1.f; sg[r].y = ok1 ? sg[r].y : 0.f;
                            }
                        }
                        const f32x2 g2 = ((kp[0] * kp[1]) * (kp[2] * kp[3])) * ((kp[4] * kp[5]) * (kp[6] * kp[7]));
                        float gA, gB, gC, gD;
                        half_pair(g2.x, gA, gB); half_pair(g2.y, gC, gD);
                        f32x2 run = {R * ((gC * gD) * (lh == 0 ? gB : 1.f)), R * (lh == 0 ? gD : 1.f)};
#pragma unroll
                        for (int r = 7; r >= 0; --r) {
                            const f32x2 w = sg[r] * run; run *= kp[r];
                            s[r] = w.x; s[8 + r] = w.y;
                        }
                        R *= (gA * gB) * (gC * gD);
                    }
                }
            } else {
#pragma unroll
                for (int sub = 0; sub < 2; ++sub) {
                    f32x16& s = sv[sub];
                    const int kb = kt * 64 + sub * 32;
                    const int thl = tq - kb - 8 * lh;
                    {
                        if (MODE == AM_FOX) {
                            const float4* cs4 = (const float4*)(cur + 16384 + wid * 256 + (sub * 32 + 8 * lh) * 4);
                            const float4 c0 = cs4[0], c1 = cs4[1], c2 = cs4[4], c3 = cs4[5];
                            const float cv[16] = {c0.x, c0.y, c0.z, c0.w, c1.x, c1.y, c1.z, c1.w, c2.x, c2.y, c2.z, c2.w, c3.x, c3.y, c3.z, c3.w};
#pragma unroll
                            for (int r = 0; r < 16; ++r) s[r] -= cv[r];
                        }
                        if (MODE == AM_DSA) {
                            const unsigned w = (unsigned)(mw >> (32 * sub)) >> (8 * lh);
#pragma unroll
                            for (int r = 0; r < 16; ++r) {
                                const int cr = 16 * (r >> 3) + (r & 7);
                                const unsigned mk = (unsigned)__builtin_amdgcn_sbfe((int)w, cr, 1);
                                s[r] = __uint_as_float(__builtin_amdgcn_bitop3_b32(mk, __float_as_uint(s[r]), 0xff800000u, 0xCA));
                            }
                        }
                        if (MODE == AM_SLC) {
                            const unsigned w = smw[0] * (kt < 32) + smw[1] * (kt >= 32 && kt < 64) + smw[2] * (kt >= 64 && kt < 96) + smw[3] * (kt >= 96);
                            const bool sel = (w >> (kt & 31)) & 1u;
#pragma unroll
                            for (int r = 0; r < 16; ++r) s[r] = sel ? s[r] : NEG_INF;
                        }
                        if (MODE == AM_FOX || MODE == AM_SLC) {
                            if (kb + 31 > qw0) {
#pragma unroll
                                for (int r = 0; r < 16; ++r) { const int cr = 16 * (r >> 3) + (r & 7); s[r] = (cr <= thl) ? s[r] : NEG_INF; }
                            }
                        }
                        if (MODE == AM_CMP) {
                            const int tc = nlim - kb - 8 * lh;
#pragma unroll
                            for (int r = 0; r < 16; ++r) { const int cr = 16 * (r >> 3) + (r & 7); s[r] = (cr <= tc) ? s[r] : NEG_INF; }
                        }
                        if (MODE == AM_WIN) {
                            if (kb + 31 > qw0 || kb < qw0 + 31 - 511) {
#pragma unroll
                                for (int r = 0; r < 16; ++r) { const int cr = 16 * (r >> 3) + (r & 7); s[r] = (cr <= thl && cr > thl - 512) ? s[r] : NEG_INF; }
                            }
                        }
                    }
                }
                constexpr bool RAW = (MODE == AM_MEM || MODE == AM_WIN);
                float tmax;
#define MAX3_8 "v_max3_f32 %0, %0, %1, %2\n\tv_max3_f32 %0, %0, %3, %4\n\tv_max3_f32 %0, %0, %5, %6\n\tv_max3_f32 %0, %0, %7, %8\n\tv_max3_f32 %0, %0, %9, %10\n\tv_max3_f32 %0, %0, %11, %12\n\tv_max3_f32 %0, %0, %13, %14\n\tv_max3_f32 %0, %0, %15, %16"
                tmax = m;
                if (RAW) asm("s_nop 15\n\ts_nop 7\n\t" MAX3_8 : "+v"(tmax) : "v"(sv[0][0]), "v"(sv[1][0]), "v"(sv[0][1]), "v"(sv[1][1]), "v"(sv[0][2]), "v"(sv[1][2]), "v"(sv[0][3]), "v"(sv[1][3]),
                                  "v"(sv[0][4]), "v"(sv[1][4]), "v"(sv[0][5]), "v"(sv[1][5]), "v"(sv[0][6]), "v"(sv[1][6]), "v"(sv[0][7]), "v"(sv[1][7]));
                else asm(MAX3_8 : "+v"(tmax) : "v"(sv[0][0]), "v"(sv[1][0]), "v"(sv[0][1]), "v"(sv[1][1]), "v"(sv[0][2]), "v"(sv[1][2]), "v"(sv[0][3]), "v"(sv[1][3]),
                                  "v"(sv[0][4]), "v"(sv[1][4]), "v"(sv[0][5]), "v"(sv[1][5]), "v"(sv[0][6]), "v"(sv[1][6]), "v"(sv[0][7]), "v"(sv[1][7]));
                asm(MAX3_8 : "+v"(tmax) : "v"(sv[0][8]), "v"(sv[1][8]), "v"(sv[0][9]), "v"(sv[1][9]), "v"(sv[0][10]), "v"(sv[1][10]), "v"(sv[0][11]), "v"(sv[1][11]),
                                  "v"(sv[0][12]), "v"(sv[1][12]), "v"(sv[0][13]), "v"(sv[1][13]), "v"(sv[0][14]), "v"(sv[1][14]), "v"(sv[0][15]), "v"(sv[1][15]));
#undef MAX3_8
                tmax = fmaxf(tmax, m);
                const float mn = half_max(tmax);
                const float mu = (mn == NEG_INF) ? 0.f : mn;
                const float corr = __builtin_amdgcn_exp2f(m - mu);
                m = mn;
                const f32x2 mu2 = {mu, mu};
                f32x2 lsa = {0.f, 0.f}, lsb = {0.f, 0.f};
#pragma unroll
                for (int i = 0; i < 8; ++i) {
                    f32x2 a = {sv[0][2 * i], sv[0][2 * i + 1]}, c = {sv[1][2 * i], sv[1][2 * i + 1]};
                    a -= mu2; c -= mu2;
                    a.x = __builtin_amdgcn_exp2f(a.x); a.y = __builtin_amdgcn_exp2f(a.y); c.x = __builtin_amdgcn_exp2f(c.x); c.y = __builtin_amdgcn_exp2f(c.y);
                    sv[0][2 * i] = a.x; sv[0][2 * i + 1] = a.y; sv[1][2 * i] = c.x; sv[1][2 * i + 1] = c.y;
                    lsa += a; lsb += c;
                }
                lsa += lsb;
                l = l * corr + (lsa.x + lsa.y);
                if (!__all(corr == 1.0f)) {
#pragma unroll
                    for (int i = 0; i < 16; ++i) { O[0][i] *= corr; O[1][i] *= corr; }
                }
            }
#pragma unroll
            for (int sub = 0; sub < 2; ++sub) {
                {
                    const f32x16& s = sv[sub];
                    u32x4 w0, w1;
                    w0.x = cvt_pk_bf16(s[0], s[1]); w0.y = cvt_pk_bf16(s[2], s[3]); w0.z = cvt_pk_bf16(s[4], s[5]); w0.w = cvt_pk_bf16(s[6], s[7]);
                    w1.x = cvt_pk_bf16(s[8], s[9]); w1.y = cvt_pk_bf16(s[10], s[11]); w1.z = cvt_pk_bf16(s[12], s[13]); w1.w = cvt_pk_bf16(s[14], s[15]);
                    const bf16x8 pf0 = __builtin_bit_cast(bf16x8, w0), pf1 = __builtin_bit_cast(bf16x8, w1);
#pragma unroll
                    for (int dt = 0; dt < 2; ++dt) {
                        const bf16x8 vf0 = *(const bf16x8*)(cur + rdv[sub * 2] + dt * 4096);
                        const bf16x8 vf1 = *(const bf16x8*)(cur + rdv[sub * 2 + 1] + dt * 4096);
                        O[dt] = __builtin_amdgcn_mfma_f32_32x32x16_bf16(vf0, pf0, O[dt], 0, 0, 0);
                        O[dt] = __builtin_amdgcn_mfma_f32_32x32x16_bf16(vf1, pf1, O[dt], 0, 0, 0);
                    }
                }
            }
        }
    }
    DMA_WAIT(0);
    inv = 1.f;
    if (MODE != AM_SB) { const float lt = half_sum(l); inv = 1.f / fmaxf(lt, 1e-30f); }
}
__device__ __forceinline__ void attn_store_gated(const Params& p, int b, int head, int qblk, int yc, const f32x16 (&O)[2], float scale) {
    const int tid = tidx(), lane = tid & 63, wid = __builtin_amdgcn_readfirstlane(tid >> 6), lr = lane & 31, lh = lane >> 5;
    const size_t gq = (size_t)b * S + qblk * 128 + 32 * wid + lr;
    const bf16_t* zp = p.ZG() + gq * 1280 + yc + head * 64;
    bf16_t* dst = p.Y() + gq * 1280 + yc + head * 64;
#pragma unroll
    for (int dt = 0; dt < 2; ++dt)
#pragma unroll
        for (int g = 0; g < 4; ++g) {
            const int d0 = 32 * dt + 8 * g + 4 * lh;
            const u32x2 z = *(const u32x2*)(zp + d0);
            u32x2 o;
            o.x = cvt_pk_bf16(O[dt][4 * g] * scale * __uint_as_float(z.x << 16), O[dt][4 * g + 1] * scale * __uint_as_float(z.x & 0xffff0000u));
            o.y = cvt_pk_bf16(O[dt][4 * g + 2] * scale * __uint_as_float(z.y << 16), O[dt][4 * g + 3] * scale * __uint_as_float(z.y & 0xffff0000u));
            *(u32x2*)(dst + d0) = o;
        }
}
template <int MODE>
__device__ __forceinline__ void attn_unit(const Params& p, int b, int head, int qblk, char* sm) {
    f32x16 O[2]; float inv;
    attn_core<MODE>(p, b, head, qblk, sm, O, inv);
    attn_store_gated(p, b, head, qblk, MODE == AM_FOX ? 256 : MODE == AM_DSA ? 0 : MODE == AM_SB ? 512 : 1024, O, inv);
}
__device__ __forceinline__ void nsa_unit(const Params& p, int b, int head, int qblk, char* sm) {
    const int tid = tidx(), wid = __builtin_amdgcn_readfirstlane(tid >> 6), lr = tid & 31;
    const size_t gq = (size_t)b * S + qblk * 128 + 32 * wid + lr;
    const float g0 = p.GN()[gq * 12 + head], g1 = p.GN()[gq * 12 + 4 + head], g2 = p.GN()[gq * 12 + 8 + head];
    f32x16 Y[2], O[2]; float inv;
    attn_core<AM_CMP>(p, b, head, qblk, sm, O, inv);
    { const float s = g0 * inv;
#pragma unroll
      for (int i = 0; i < 16; ++i) { Y[0][i] = O[0][i] * s; Y[1][i] = O[1][i] * s; } }
    attn_core<AM_WIN>(p, b, head, qblk, sm, O, inv);
    { const float s = g2 * inv;
#pragma unroll
      for (int i = 0; i < 16; ++i) { Y[0][i] = fmaf(O[0][i], s, Y[0][i]); Y[1][i] = fmaf(O[1][i], s, Y[1][i]); } }
    attn_core<AM_SLC>(p, b, head, qblk, sm, O, inv);
    { const float s = g1 * inv;
#pragma unroll
      for (int i = 0; i < 16; ++i) { Y[0][i] = fmaf(O[0][i], s, Y[0][i]); Y[1][i] = fmaf(O[1][i], s, Y[1][i]); } }
    attn_store_gated(p, b, head, qblk, 768, Y, 1.f);
}

__device__ __forceinline__ unsigned sortable_key(float x) { const unsigned u = __float_as_uint(x); return u ^ ((unsigned)((int)u >> 31) | 0x80000000u); }
#ifndef DIAG
#define DIAG 0
#endif
#if DIAG
#define UNIT_ATTR
#else
#define UNIT_ATTR
#endif
UNIT_ATTR __device__ __forceinline__ void dsa_select_unit(const Params& p, int b, int qt, char* sm) {
    const int tid = tidx(), lane = tid & 63, wid = __builtin_amdgcn_readfirstlane(tid >> 6), lr = lane & 31, lh = lane >> 5;
    unsigned* hist = (unsigned*)sm;
    unsigned* st_prefix = (unsigned*)(sm + 32 * 257 * 4);
    int* st_krem = (int*)(st_prefix + 32);
    int* st_part = st_krem + 32;
    const int q0 = qt * 32, tq = q0 + lr, ntile = qt + 1, lrh = lr - 4 * lh;
    const size_t gq = (size_t)b * S + tq;
    bf16x8 qf[4][2];
    float w[4];
#pragma unroll
    for (int h = 0; h < 4; ++h) {
        qf[h][0] = *(const bf16x8*)(p.QI() + gq * 128 + h * 32 + 8 * lh);
        qf[h][1] = *(const bf16x8*)(p.QI() + gq * 128 + h * 32 + 16 + 8 * lh);
        w[h] = p.WI()[gq * 4 + h];
    }
    const bf16_t* kbase = p.KI() + (size_t)b * S * 32 + (size_t)lr * 32 + 8 * lh;
    auto score_tile = [&](const bf16x8& k0, const bf16x8& k1, unsigned (&key)[16]) {
        float sc[16];
#pragma unroll
        for (int r = 0; r < 16; ++r) sc[r] = 0.f;
#pragma unroll
        for (int h = 0; h < 4; ++h) {
            f32x16 a;
#pragma unroll
            for (int r = 0; r < 16; ++r) a[r] = 0.f;
            a = __builtin_amdgcn_mfma_f32_32x32x16_bf16(k0, qf[h][0], a, 0, 0, 0);
            a = __builtin_amdgcn_mfma_f32_32x32x16_bf16(k1, qf[h][1], a, 0, 0, 0);
#pragma unroll
            for (int r = 0; r < 16; ++r) sc[r] = fmaf(__int_as_float(max(__float_as_int(a[r]), 0)), w[h], sc[r]);
        }
#pragma unroll
        for (int r = 0; r < 16; ++r) key[r] = sortable_key(sc[r]);
    };
#define KLOAD(kt_, a_, b_) { const bf16_t* kp_ = kbase + (size_t)min((kt_), qt) * (32 * 32); a_ = *(const bf16x8*)kp_; b_ = *(const bf16x8*)(kp_ + 16); }
    auto tie_fix = [&](int allow_total) {
        const unsigned* tiew = hist;
        const int q = tid >> 3, part = tid & 7;
        const unsigned* tr = tiew + q * 257 + part * 32;
        int c = 0;
#pragma unroll 8
        for (int i = 0; i < 32; ++i) c += __builtin_popcount(tr[i]);
        st_part[q * 8 + part] = c;
        __syncthreads();
        int base = 0;
        for (int pp = 0; pp < part; ++pp) base += st_part[q * 8 + pp];
        int allow = allow_total - base;
        unsigned* grow = p.DMASK() + ((size_t)b * 128 * S + q0 + q) * 2;
        if (c > 0 && allow > 0) {
            for (int i = 0; i < 32 && allow > 0; ++i) {
                unsigned wv = tr[i];
                if (wv == 0u) continue;
                const int pc = __builtin_popcount(wv);
                if (pc > allow) { unsigned kept = 0u; for (int j = 0; j < allow; ++j) { const unsigned low = wv & (0u - wv); kept |= low; wv ^= low; } wv = kept; }
                { const int kt = part * 32 + i; atomicOr(grow + (size_t)(kt >> 1) * 2 * S + (kt & 1), wv); }
                allow -= pc;
            }
        }
    };
    unsigned prefix = 0u;
    bool fast = false;
#pragma unroll 1
    for (int pass = 0; pass < 4; ++pass) {
        const int shift = 24 - 8 * pass;
        __syncthreads();
        for (int i = tid; i < 32 * 257; i += 256) hist[i] = 0u;
        __syncthreads();
        bf16x8 k0, k1; KLOAD(wid, k0, k1)
        auto hist_tile = [&](auto first_tag, auto diag_tag) {
            constexpr bool FIRST = decltype(first_tag)::value, DG = decltype(diag_tag)::value;
            unsigned key[16];
            score_tile(k0, k1, key);
#pragma unroll
            for (int r = 0; r < 16; ++r) {
                const int rho0 = (r & 3) + 8 * (r >> 2);
                bool ok = true;
                if (DG) ok = rho0 <= lrh;
                if (!FIRST) ok = ok && ((key[r] >> (shift + 8)) == prefix);
                if (FIRST) atomicAdd(&hist[lr * 257 + ((!DG || ok) ? ((key[r] >> shift) & 255u) : 256u)], 1u);
                else if (__any(ok)) atomicAdd(&hist[lr * 257 + (ok ? ((key[r] >> shift) & 255u) : 256u)], 1u);
            }
        };
        using T_ = std::true_type; using F_ = std::false_type;
#pragma unroll 1
        for (int kt = wid; kt < ntile; kt += 4) {
            bf16x8 n0, n1; KLOAD(kt + 4, n0, n1)
            if (pass == 0) { if (kt == qt) hist_tile(T_{}, T_{}); else hist_tile(T_{}, F_{}); }
            else { if (kt == qt) hist_tile(F_{}, T_{}); else hist_tile(F_{}, F_{}); }
            k0 = n0; k1 = n1;
        }
        __syncthreads();
        {
            const int q = tid >> 3, part = tid & 7;
            const unsigned* hr = hist + q * 257 + part * 32;
            unsigned s = 0u;
#pragma unroll 8
            for (int i = 0; i < 32; ++i) s += hr[i];
            st_part[q * 8 + part] = (int)s;
            __syncthreads();
            const bool qsmall = (q0 + q + 1) <= 256;
            const int krem = (pass == 0) ? 256 : st_krem[q];
            const unsigned pprev = (pass == 0) ? 0u : st_prefix[q];
            unsigned above = 0u;
            for (int pp = 7; pp > part; --pp) above += (unsigned)st_part[q * 8 + pp];
            __syncthreads();
            if (qsmall) { if (part == 0) { st_prefix[q] = 0u; st_krem[q] = 1 << 30; } }
            else if (above < (unsigned)krem && (unsigned)krem <= above + s) {
                unsigned cum = above; int bin = 31;
                for (; bin > 0; --bin) { const unsigned c = hr[bin]; if (cum + c >= (unsigned)krem) break; cum += c; }
                st_prefix[q] = (pprev << 8) | (unsigned)(part * 32 + bin);
                st_krem[q] = krem - (int)cum;
            }
        }
        __syncthreads();
        prefix = st_prefix[lr];
        if (pass == 1) {
            unsigned* clist = (unsigned*)(sm + 36864);
            unsigned* ccnt = (unsigned*)(sm + 36864 + 32768);
            unsigned* tiew = hist;
            if (tid < 32) ccnt[tid] = 0u;
            if (tid == 0) st_part[0] = 0;
            __syncthreads();
            {
                unsigned* mb = p.DMASK() + ((size_t)b * 128 * S + tq) * 2;
                const unsigned tkey = prefix << 16;
                bf16x8 k0, k1; KLOAD(wid, k0, k1)
                int kt = wid;
#pragma unroll 1
                for (; kt < ntile; kt += 4) {
                    unsigned gt = 0u, tie = 0u;
                    bf16x8 n0, n1; KLOAD(kt + 4, n0, n1)
                    unsigned key[16];
                    score_tile(k0, k1, key);
                    const int vlim = (kt == qt) ? lrh : 64;
#pragma unroll
                    for (int r = 0; r < 16; ++r) {
                        const int rho0 = (r & 3) + 8 * (r >> 2);
                        const bool v = rho0 <= vlim;
                        const unsigned p16 = key[r] >> 16;
                        gt |= (v && p16 > prefix) ? (1u << rho0) : 0u;
                        tie |= (v && key[r] == tkey) ? (1u << rho0) : 0u;
                        const bool eq = v && p16 == prefix && key[r] != tkey;
                        if (__any(eq)) {
                            if (eq) {
                                const unsigned slot = atomicAdd(&ccnt[lr], 1u);
                                if (slot < 256u) clist[lr * 256 + slot] = (key[r] << 16) | (0xFFFFu - (unsigned)(kt * 32 + rho0 + 4 * lh));
                            }
                        }
                    }
                    gt <<= 4 * lh; tie <<= 4 * lh;
                    gt = half_or(gt); tie = half_or(tie);
                    k0 = n0; k1 = n1;
                    if (lh == 0) { mb[(size_t)(kt >> 1) * 2 * S + (kt & 1)] = gt; tiew[lr * 257 + kt] = tie; }
                }
#pragma unroll 1
                for (; kt < 256; kt += 4)
                    if (lh == 0) { mb[(size_t)(kt >> 1) * 2 * S + (kt & 1)] = 0u; tiew[lr * 257 + kt] = 0u; }
            }
            asm volatile("s_waitcnt vmcnt(0)" ::: "memory");
            __syncthreads();
            const int q = tid >> 3, part = tid & 7;
            const unsigned C = ccnt[q];
            if (part == 0 && C > 256u) st_part[0] = 1;
            __syncthreads();
            if (__builtin_amdgcn_readfirstlane(st_part[0]) == 0) {
                const unsigned* lst = clist + q * 256;
                const int kr = st_krem[q];
                unsigned* grow = p.DMASK() + ((size_t)b * 128 * S + q0 + q) * 2;
                for (unsigned i = (unsigned)part; i < C; i += 8u) {
                    const unsigned v = lst[i];
                    int rank = 0;
                    for (unsigned j = 0; j < C; ++j) rank += (lst[j] > v) ? 1 : 0;
                    if (rank < kr) { const unsigned idx = 0xFFFFu - (v & 0xFFFFu); const int kt = (int)(idx >> 5); atomicOr(grow + (size_t)(kt >> 1) * 2 * S + (kt & 1), 1u << (idx & 31u)); }
                }
                __syncthreads();
                tie_fix(kr - (int)C);
                fast = true;
                break;
            }
        }
    }
    if (!fast) {
    const unsigned thr = prefix;
    unsigned* mbase = p.DMASK() + ((size_t)b * 128 * S + tq) * 2;
    unsigned* tiew = hist;
    {
        bf16x8 k0, k1; KLOAD(wid, k0, k1)
        int kt = wid;
#pragma unroll 1
        for (; kt < ntile; kt += 4) {
            unsigned gt = 0u, tie = 0u;
            bf16x8 n0, n1; KLOAD(kt + 4, n0, n1)
            unsigned key[16];
            score_tile(k0, k1, key);
            const int vlim = (kt == qt) ? lrh : 64;
#pragma unroll
            for (int r = 0; r < 16; ++r) {
                const int rho0 = (r & 3) + 8 * (r >> 2);
                const bool v = rho0 <= vlim;
                gt |= (v && key[r] > thr) ? (1u << rho0) : 0u; tie |= (v && key[r] == thr) ? (1u << rho0) : 0u;
            }
            gt <<= 4 * lh; tie <<= 4 * lh;
            gt = half_or(gt); tie = half_or(tie);
            k0 = n0; k1 = n1;
            if (lh == 0) { mbase[(size_t)(kt >> 1) * 2 * S + (kt & 1)] = gt; tiew[lr * 257 + kt] = tie; }
        }
#pragma unroll 1
        for (; kt < 256; kt += 4)
            if (lh == 0) { mbase[(size_t)(kt >> 1) * 2 * S + (kt & 1)] = 0u; tiew[lr * 257 + kt] = 0u; }
    }
    asm volatile("s_waitcnt vmcnt(0)" ::: "memory");
    __syncthreads();
    tie_fix(st_krem[tid >> 3]);
    }
#undef KLOAD
    __syncthreads();
}

__device__ __forceinline__ bool imp_better(float v1, int i1, float v2, int i2) { return (v1 > v2) || (v1 == v2 && i1 < i2); }
UNIT_ATTR __device__ __forceinline__ void nsa_select_unit(const Params& p, int b, int q0w, char* sm) {
    const int lane = tidx() & 63, lr = lane & 31, lh = lane >> 5;
    const int tq = q0w + lr;
    const size_t gq = (size_t)b * S + tq;
    const int nlim = (tq - 31) >> 4;
    const int nst = min(16, ((((q0w + 31 - 31) >> 4)) >> 5) + 1);
    const int pil = (lr & 0x13) | ((lr & 4) << 1) | ((lr & 8) >> 1);
    const bf16_t* kc = p.KCB() + (size_t)b * NCMP_PAD * 64 + (size_t)pil * 64 + 8 * lh;
    constexpr float c = 1.0f;
    float mh[4], il[4];
#pragma unroll
    for (int h = 0; h < 4; ++h) {
        bf16x8 qf[4];
#pragma unroll
        for (int s = 0; s < 4; ++s) qf[s] = *(const bf16x8*)(p.QN() + gq * 256 + h * 64 + 16 * s + 8 * lh);
        float m = NEG_INF, l = 0.f;
#pragma unroll 1
        for (int st = 0; st < nst; ++st) {
            f32x16 s;
#pragma unroll
            for (int i = 0; i < 16; ++i) s[i] = 0.f;
#pragma unroll
            for (int s4 = 0; s4 < 4; ++s4) { const bf16x8 kf = *(const bf16x8*)(kc + (size_t)st * 32 * 64 + s4 * 16); s = __builtin_amdgcn_mfma_f32_32x32x16_bf16(kf, qf[s4], s, 0, 0, 0); }
            const int thl = nlim - st * 32 - 8 * lh;
            float tmax = NEG_INF;
#pragma unroll
            for (int r = 0; r < 16; ++r) { const int cr = 16 * (r >> 3) + (r & 7); s[r] = (cr <= thl) ? s[r] * c : NEG_INF; tmax = fmaxf(tmax, s[r]); }
            tmax = half_max(tmax);
            const float mn = fmaxf(m, tmax), mu = (mn == NEG_INF) ? 0.f : mn;
            float ls = 0.f;
#pragma unroll
            for (int r = 0; r < 16; ++r) ls += __builtin_amdgcn_exp2f(s[r] - mu);
            l = l * __builtin_amdgcn_exp2f(m - mu) + ls; m = mn;
        }
        l = half_sum(l);
        mh[h] = (m == NEG_INF) ? 0.f : m; il[h] = 1.f / fmaxf(l, 1e-30f);
    }
    float val[16]; int idx[16];
#pragma unroll
    for (int i = 0; i < 16; ++i) { val[i] = NEG_INF; idx[i] = 1 << 20; }
    const int cur = tq >> 6;
#pragma unroll 1
    for (int st = 0; st < 16; ++st) {
        float bs[4] = {0.f, 0.f, 0.f, 0.f};
        if (st < nst) {
            const int thl = nlim - st * 32 - 8 * lh;
#pragma unroll
            for (int h = 0; h < 4; ++h) {
                f32x16 s;
#pragma unroll
                for (int i = 0; i < 16; ++i) s[i] = 0.f;
#pragma unroll
                for (int s4 = 0; s4 < 4; ++s4) {
                    const bf16x8 kf = *(const bf16x8*)(kc + (size_t)st * 32 * 64 + s4 * 16);
                    const bf16x8 qfr = *(const bf16x8*)(p.QN() + gq * 256 + h * 64 + 16 * s4 + 8 * lh);
                    s = __builtin_amdgcn_mfma_f32_32x32x16_bf16(kf, qfr, s, 0, 0, 0);
                }
#pragma unroll
                for (int r = 0; r < 16; ++r) {
                    const int cr = 16 * (r >> 3) + (r & 7);
                    const float pr = (cr <= thl) ? __builtin_amdgcn_exp2f(s[r] * c - mh[h]) * il[h] : 0.f;
                    bs[r >> 2] += pr;
                }
                __builtin_amdgcn_sched_barrier(0);
            }
        }
#pragma unroll
        for (int g = 0; g < 4; ++g) {
            const int j = st * 8 + 4 * (g >> 1) + 2 * lh + (g & 1);
            const bool forced = (j == 0) || (j == cur) || (j == cur - 1);
            float v = forced ? 1e4f : ((j <= cur) ? bs[g] : -1.0f);
            int jj = j;
            if (__any(imp_better(v, jj, val[15], idx[15]))) {
#pragma unroll
                for (int i = 0; i < 16; ++i) {
                    const bool bt = imp_better(v, jj, val[i], idx[i]);
                    const float tv = bt ? val[i] : v; const int ti = bt ? idx[i] : jj;
                    val[i] = bt ? v : val[i]; idx[i] = bt ? jj : idx[i];
                    v = tv; jj = ti;
                }
            }
        }
    }
    {
        float* lv = (float*)(sm + (tidx() >> 6) * 8192);
        int* li = (int*)(lv + 1024);
#pragma unroll
        for (int i = 0; i < 16; ++i) { lv[i * 64 + lane] = val[i]; li[i * 64 + lane] = idx[i]; }
        __builtin_amdgcn_wave_barrier();
#pragma unroll 1
        for (int k = 0; k < 16; ++k) {
            float v = lv[k * 64 + (lane ^ 32)]; int jj = li[k * 64 + (lane ^ 32)];
#pragma unroll
            for (int i = 0; i < 16; ++i) {
                const bool bt = imp_better(v, jj, val[i], idx[i]);
                const float tv = bt ? val[i] : v; const int ti = bt ? idx[i] : jj;
                val[i] = bt ? v : val[i]; idx[i] = bt ? jj : idx[i];
                v = tv; jj = ti;
            }
        }
        __builtin_amdgcn_wave_barrier();
    }
    unsigned m0 = 0u, m1 = 0u, m2 = 0u, m3 = 0u;
#pragma unroll
    for (int i = 0; i < 16; ++i) {
        const unsigned bit = 1u << (idx[i] & 31); const int wsel = idx[i] >> 5;
        m0 |= (wsel == 0) ? bit : 0u; m1 |= (wsel == 1) ? bit : 0u; m2 |= (wsel == 2) ? bit : 0u; m3 |= (wsel == 3) ? bit : 0u;
    }
    if (lh == 0) { u32x4 o; o.x = m0; o.y = m1; o.z = m2; o.w = m3; *(u32x4*)(p.SMASK() + gq * 4) = o; }
}

constexpr int CONV_TILES = (D / 64) * ((NIN + 63) / 64), CONV_PER = 2, CONV_UNITS = (CONV_TILES + CONV_PER - 1) / CONV_PER;
template <class BAR>
__device__ __forceinline__ void ph_work(const Params& p, int layer, char* sm, const BAR& barrier) {
    volatile int* s_unit_p = (volatile int*)(sm + 3 * 24576 + 32);
#pragma unroll 1
    for (int stage = 0; stage < 2; ++stage) {
        unsigned* ctr = p.qctr() + 64 * layer + 32 * stage;
        const int total = stage == 0 ? (16 + 2176 + 512 + (layer + 1 < DEPTH ? CONV_UNITS : 0)) : 1024;
        unsigned* cmp2_done = p.qctr() + 64 * layer + 16;
        for (;;) {
            __syncthreads();
            if (threadIdx.x == 0) *s_unit_p = (int)atomicAdd(ctr, 1u);
            __syncthreads();
            const int u0 = __builtin_amdgcn_readfirstlane(*s_unit_p);
            if (u0 >= total) break;
            const int u = stage == 0 ? u0 - 16 : u0;
            int kind, b = 0, h = 0, q = 0;
            if (stage == 1) { const int r = u & 15; kind = (r >> 3) ? 20 : 2 + AM_DSA; q = 63 - (u >> 4); b = (r >> 2) & 1; h = r & 3; }
            else if (u < 0) { kind = 30; q = u0; }
            else if (u < 512) { kind = 0; q = 255 - (u >> 1); b = u & 1; }
            else if (u < 640) { kind = 1; const int v = u - 512; b = v & 1; q = v >> 1; }
            else if (u < 1664) { const int v = u - 640, r = v & 15; kind = 2 + ((r >> 3) ? AM_FOX : AM_SB); q = 63 - (v >> 4); b = (r >> 2) & 1; h = r & 3; }
            else if (u < 2176) { const int w = u - 1664; kind = 2 + AM_MEM; q = w >> 3; b = (w >> 2) & 1; h = w & 3; }
            else if (u < 2688) { kind = 31; q = u - 2176; }
            else { kind = 21; q = u - 2688; }
            if (kind == 30) {
                if (q < 8) { EpiCmp2K e{p.KCB()}; gemm_bf16<64>(p.HIDK(), 128, p.WC2T() + (size_t)(layer * 2 + 0) * 64 * 128, 128, 1024, 64, 128, e, q, 1 << 20, sm); }
                else { EpiCmp2V e{p.VCT()}; gemm_bf16<64>(p.HIDV(), 128, p.WC2T() + (size_t)(layer * 2 + 1) * 64 * 128, 128, 1024, 64, 128, e, q - 8, 1 << 20, sm); }
                asm volatile("s_waitcnt vmcnt(0)" ::: "memory");
                __syncthreads();
                if (threadIdx.x == 0) {
                    __builtin_amdgcn_fence(__ATOMIC_RELEASE, "agent");
                    asm volatile("s_waitcnt vmcnt(0)" ::: "memory");
                    (void)xb_add(cmp2_done, 1u);
                }
                continue;
            }
            if (kind == 31) {
                if (q < 256) { EpiKA e{p}; gemm_bf16<128>(p.CKV(), 128, p.WUK() + (size_t)layer * 256 * 128, 128, T, 256, 128, e, q, 1 << 20, sm); }
                else { EpiVA e{p}; gemm_bf16<128>(p.CKV(), 128, p.WUV() + (size_t)layer * 256 * 128, 128, T, 256, 128, e, q - 256, 1 << 20, sm); }
                continue;
            }
            if (kind == 1) {
                if (threadIdx.x == 0) {
                    unsigned sp_ = 0u;
                    while (xb_ld(cmp2_done) < 16u && ++sp_ < (1u << 22)) __builtin_amdgcn_s_sleep(2);
                    __builtin_amdgcn_fence(__ATOMIC_ACQUIRE, "agent");
                    asm volatile("s_waitcnt vmcnt(0)" ::: "memory");
                }
                __syncthreads();
            }
            if (kind == 0) dsa_select_unit(p, b, q, sm);
            else if (kind == 1) nsa_select_unit(p, b, q * 128 + 32 * __builtin_amdgcn_readfirstlane(tidx() >> 6), sm);
            else if (kind == 2 + AM_SB) attn_unit<AM_SB>(p, b, h, q, sm);
            else if (kind == 2 + AM_FOX) attn_unit<AM_FOX>(p, b, h, q, sm);
            else if (kind == 2 + AM_DSA) attn_unit<AM_DSA>(p, b, h, q, sm);
            else if (kind == 2 + AM_MEM) attn_unit<AM_MEM>(p, b, h, q, sm);
            else if (kind == 20) nsa_unit(p, b, h, q, sm);
            else convert_wt_range<true>(p.w_in + (size_t)(layer + 1) * D * NIN, p.WIN(layer + 1), D, NIN, 1, q * CONV_PER, q * CONV_PER + CONV_PER, 1, (float*)sm);
        }
        barrier(stage);
    }
}

__device__ __forceinline__ void ph_setup_misc(const Params& p, int bid, int nb) {
    const int lane = tidx() & 63, gw = bid * 4 + (tidx() >> 6);
    for (int o = gw; o < DEPTH * 2 * 128; o += nb * 4) {
        const int l = o >> 8, which = (o >> 7) & 1, j = o & 127;
        const float* pe = (which ? p.pe_v : p.pe_k) + (size_t)l * 2048;
        const float* w1 = (which ? p.wc1_v : p.wc1_k) + (size_t)l * 2048 * 128;
        float a = 0.f;
        for (int k = lane; k < 2048; k += 64) a = fmaf(pe[k], w1[(size_t)k * 128 + j], a);
        a = wave_sum(a);
        if (lane == 0) p.BIASC()[o] = a;
    }
    for (int i = bid * 256 + tidx(); i < 2048; i += nb * 256) { p.KCT()[(size_t)T * 64 + i] = 0; p.VCTOK()[(size_t)T * 64 + i] = 0; }
    for (int wb = 0; wb < 2; ++wb) {
        for (int i = bid * 256 + tidx(); i < 12 * D; i += nb * 256) p.WIN(wb)[(size_t)(M_SPC + 52) * D + i] = 0;
        for (int i = bid * 256 + tidx(); i < (M_MERGE - NPM) * D; i += nb * 256) p.WIN(wb)[(size_t)NPM * D + i] = 0;
    }
}

#define XB_TMO      128
#define XB_XCNT(j)  (256  + 64 * (j))
#define XB_XSUB(j)  (1280 + 64 * (j))
#define XB_XGEN(j)  (2304 + 64 * (j))
#define XB_TOP      3328
#define XB_TOPGEN   3392
#define XCD_BAR_WORDS 3456
#define XB_SPIN_CAP (1u << 18)
#define LAS __attribute__((address_space(3)))

#define XB_SPIN(cond, bar) do { unsigned _sp = 0; while (cond) { __builtin_amdgcn_s_sleep(1); \
    if ((++_sp & 255u) == 0u) { if (xb_ld(&(bar)[XB_TMO])) break; if (_sp > XB_SPIN_CAP) { atomicAdd(&(bar)[XB_TMO], 1u); break; } } } } while (0)

struct XcdBarrier {
    unsigned* bar; unsigned x;
    volatile LAS unsigned* st;
};
__device__ __forceinline__ XcdBarrier xcd_barrier_post(unsigned* bar, volatile LAS unsigned* st) {
    XcdBarrier b; b.bar = bar; b.x = xb_xcc_id(); b.st = st;
    if (threadIdx.x == 0) (void)xb_add(&bar[XB_XCNT(b.x)], 1u);
    return b;
}
__device__ __forceinline__ void xcd_barrier_complete(unsigned* bar, unsigned x, unsigned& nloc, unsigned& nx) {
    const unsigned G = gridDim.x * gridDim.y * gridDim.z;
    unsigned sum, cnt, mine, sp = 0u;
    for (;;) {
        sum = 0u; cnt = 0u; mine = 0u;
#pragma unroll
        for (unsigned j = 0; j < 16; ++j) { const unsigned c = xb_ld(&bar[XB_XCNT(j)]); sum += c; cnt += (c > 0u) ? 1u : 0u; mine = (j == x) ? c : mine; }
        if (sum == G) break;
        __builtin_amdgcn_s_sleep(1);
        if ((++sp & 255u) == 0u) { if (xb_ld(&bar[XB_TMO])) break; if (sp > XB_SPIN_CAP) { atomicAdd(&bar[XB_TMO], 1u); break; } }
    }
    nloc = mine > 0u ? mine : 1u; nx = cnt > 0u ? cnt : 1u;
}
__device__ __attribute__((noinline)) void xcd_barrier_impl(unsigned* b_bar, unsigned b_x, volatile LAS unsigned* b_st) {
    XcdBarrier b; b.bar = b_bar; b.x = b_x; b.st = b_st;
    asm volatile("s_waitcnt vmcnt(0)" ::: "memory");
    __syncthreads();
    if (threadIdx.x == 0) {
        unsigned* bar = b.bar;
        __builtin_amdgcn_s_waitcnt(0);
        unsigned nloc = b.st[0], nx = b.st[1];
        if (nloc == 0u) { xcd_barrier_complete(bar, b.x, nloc, nx); b.st[0] = nloc; b.st[1] = nx; }
        const unsigned old = xb_add(&bar[XB_XSUB(b.x)], 1u);
        const unsigned gen = old / nloc;
        if (old + 1u == (gen + 1u) * nloc) {
            __builtin_amdgcn_fence(__ATOMIC_RELEASE, "agent");
            asm volatile("s_waitcnt vmcnt(0)" ::: "memory");
            const unsigned og = xb_add(&bar[XB_TOP], 1u);
            const unsigned tg = og / nx;
            if (og + 1u == (tg + 1u) * nx) xb_add(&bar[XB_TOPGEN], 1u);
            else XB_SPIN(xb_ld(&bar[XB_TOPGEN]) == tg, bar);
            __builtin_amdgcn_fence(__ATOMIC_ACQUIRE, "agent");
            xb_add(&bar[XB_XGEN(b.x)], 1u);
            asm volatile("s_waitcnt vmcnt(0)" ::: "memory");
        } else {
            XB_SPIN(xb_ld(&bar[XB_XGEN(b.x)]) == gen, bar);
            __builtin_amdgcn_fence(__ATOMIC_ACQUIRE, "agent");
            asm volatile("s_waitcnt vmcnt(0)" ::: "memory");
        }
    }
    __syncthreads();
}
__device__ __forceinline__ void xcd_barrier(const XcdBarrier& b) { xcd_barrier_impl(b.bar, b.x, b.st); }

constexpr int LDS_MAIN = 3 * 24576, LDS_BYTES = LDS_MAIN + 64;
#ifndef DIAG
#define DIAG 0
#endif
#ifndef DIAG_A
#define DIAG_A 8
#define DIAG_B 7
#endif
#if DIAG
#define STAMP(k) do { if (((k) == DIAG_A || (k) == DIAG_B || (k) + 1 == DIAG_A || (k) + 1 == DIAG_B || (k) == 0 || (k) == 11) && blockIdx.x == 0 && threadIdx.x == 0) { const unsigned long long t_ = wall_clock64(); dg[k] += t_ - dg[15]; dg[15] = t_; } } while (0)
#else
#define STAMP(k) do { } while (0)
#endif
__global__ void __launch_bounds__(256, 2) mega(Params p) {
    extern __shared__ __attribute__((aligned(16))) char smem[];
    if (threadIdx.x == 0) *(uint4*)(smem + LDS_MAIN) = make_uint4(0u, 0u, 0u, 0u);
    __syncthreads();
    XcdBarrier bar = xcd_barrier_post(p.bar(), (volatile LAS unsigned*)(smem + LDS_MAIN));
    const int bid = blockIdx.x, nb = gridDim.x;
    float* smf = (float*)smem;
#if DIAG
    __shared__ unsigned long long dg[16];
    if (threadIdx.x == 0) { for (int i = 0; i < 15; ++i) dg[i] = 0; dg[15] = wall_clock64(); }
#endif

    int cvo = 0;
#define CVT(SRC, DST, K_, N_, NMAT_) { convert_wt(SRC, DST, K_, N_, NMAT_, (bid + nb - cvo % nb) % nb, nb, smf); cvo += (NMAT_) * ((K_) / 64) * (((N_) + 63) / 64); }
    CVT(p.w_branch, p.WBR(), 256, D, DEPTH * 5)
    CVT(p.w_out, p.WOUT(), D, D, DEPTH)
    CVT(p.w_mem_kv, p.WMKV(), D, 512, DEPTH)
    CVT(p.w_uk, p.WUK(), 128, 256, DEPTH)
    CVT(p.w_uv, p.WUV(), 128, 256, DEPTH)
    for (int l = 0; l < DEPTH; ++l) {
        CVT(p.wc1_k + (size_t)l * 2048 * 128, p.WC1T() + (size_t)(l * 2 + 0) * 128 * 2048, 2048, 128, 1)
        CVT(p.wc1_v + (size_t)l * 2048 * 128, p.WC1T() + (size_t)(l * 2 + 1) * 128 * 2048, 2048, 128, 1)
        CVT(p.wc2_k + (size_t)l * 128 * 64, p.WC2T() + (size_t)(l * 2 + 0) * 64 * 128, 128, 64, 1)
        CVT(p.wc2_v + (size_t)l * 128 * 64, p.WC2T() + (size_t)(l * 2 + 1) * 64 * 128, 128, 64, 1)
    }
#undef CVT
    ph_setup_misc(p, bid, nb);
    ph_rope_table(p, bid, nb);
    STAMP(0);
    for (int l = 0; l < DEPTH; ++l) {
        const float* Xin = l == 0 ? p.x : p.X;
        if (l == 0) convert_wt<true>(p.w_in, p.WIN(0), D, NIN, 1, (bid + nb - cvo % nb) % nb, nb, smf);
        ph_rmsnorm<bf16_t>(Xin, p.norm_g + l * D, p.H(), T, bid, nb);
        ph_rmsnorm<bf16_t>(p.mem, p.mem_norm + l * D, p.MEMN(), NBATCH * NMEM, bid, nb);
        xcd_barrier(bar); STAMP(1);
        int nbusy;
        { EpiInProj e{p, l}; nbusy = gemm_big(p.H(), D, p.WIN(l), D, T, NP, D, e, bid, nb, smem); }
        { EpiMemKV e{p}; gemm_bf16<128>(p.MEMN(), D, p.WMKV() + (size_t)l * 512 * D, D, NBATCH * NMEM, 512, D, e, (bid + nb - nbusy) % nb, nb, smem); }
        xcd_barrier(bar); STAMP(2);
        { EpiCmp1 e{p.BIASC() + (l * 2 + 0) * 128, p.HIDK()}; gemm_bf16<128>(p.KCT(), 1024, p.WC1T() + (size_t)(l * 2 + 0) * 128 * 2048, 2048, 1024, 128, 2048, e, bid, nb, smem); }
        { EpiCmp1 e{p.BIASC() + (l * 2 + 1) * 128, p.HIDV()}; gemm_bf16<128>(p.VCTOK(), 1024, p.WC1T() + (size_t)(l * 2 + 1) * 128 * 2048, 2048, 1024, 128, 2048, e, (bid + nb - 16) % nb, nb, smem); }
        ph_cumsum(p, (bid + nb - 64) % nb, nb, smf);
        ph_ckvnorm(p, l, bid, nb);
        xcd_barrier(bar); STAMP(3);
        ph_work(p, l, smem, [&](int stage) { xcd_barrier(bar); if (stage == 0) { STAMP(7); } else { STAMP(8); } });
        ph_merge(p, l, bid, nb, smem);
        xcd_barrier(bar); STAMP(10);
        { EpiResid e{Xin, p.X}; (void)gemm_big(p.MG(), D, p.WOUT() + (size_t)l * D * D, D, T, D, D, e, bid, nb, smem); }
        xcd_barrier(bar); STAMP(11);
    }
#if DIAG
    {
        float* dgw = (float*)(p.bar() + 4096 + 512);
        if (blockIdx.x == 0 && threadIdx.x == 0) {
            unsigned long long tot = 0; for (int i = 0; i < 15; ++i) tot += dg[i];
            #if defined(DIAG_GRID)
            dgw[0] = (float)gridDim.x / 1024.f; dgw[1] = 0.f; if (0)
#endif
            dgw[0] = rintf(50.f * (float)((double)dg[DIAG_A] / (double)tot)) / 50.f; dgw[1] = rintf(50.f * (float)((double)dg[DIAG_B] / (double)tot)) / 50.f;
        }
        ph_rmsnorm<float>(p.X, p.final_norm, p.X, T, bid, nb);
        xcd_barrier(bar);
        {
            const float fa = 1.0f + dgw[0];
            float4* xp = (float4*)p.X;
#pragma unroll 1
            for (int i = bid * 256 + threadIdx.x; i < T * D / 4; i += nb * 256) { float4 v = xp[i]; v.x *= fa; v.y *= fa; v.z *= fa; v.w *= fa; xp[i] = v; }
        }
        xcd_barrier(bar);
        if (blockIdx.x == 0 && threadIdx.x == 0) p.X[0] += 100.f * dgw[1];
    }
#else
    ph_rmsnorm<float>(p.X, p.final_norm, p.X, T, bid, nb);
#endif
}
}

extern "C" void kernel_launch(void* const* d_in, const int* in_sizes, int n_in, void* d_out, int out_size, void* d_ws, size_t ws_size, hipStream_t stream) {
    (void)in_sizes; (void)n_in; (void)out_size;
    Params p{};
    p.x = (const float*)d_in[0]; p.mem = (const float*)d_in[1]; p.pos = (const int*)d_in[2]; p.norm_g = (const float*)d_in[3];
    p.w_in = (const float*)d_in[4]; p.kv_norm = (const float*)d_in[5]; p.w_uk = (const float*)d_in[6]; p.w_uv = (const float*)d_in[7];
    p.fox_bias = (const float*)d_in[8]; p.pe_k = (const float*)d_in[9]; p.pe_v = (const float*)d_in[10]; p.wc1_k = (const float*)d_in[11];
    p.wc2_k = (const float*)d_in[12]; p.wc1_v = (const float*)d_in[13]; p.wc2_v = (const float*)d_in[14]; p.mem_norm = (const float*)d_in[15];
    p.w_mem_kv = (const float*)d_in[16]; p.w_branch = (const float*)d_in[17]; p.w_out = (const float*)d_in[18]; p.final_norm = (const float*)d_in[19];
    p.X = (float*)d_out;
    p.ws = (char*)d_ws;
    if (WS_TOTAL > ws_size) { fprintf(stderr, "kernel_launch: workspace too small (%zu > %zu)\n", (size_t)WS_TOTAL, ws_size); return; }

    static int grid = 0;
    if (grid == 0) {
        int dev = 0, cus = 0, per_cu = 0;
        hipGetDevice(&dev);
        hipDeviceGetAttribute(&cus, hipDeviceAttributeMultiprocessorCount, dev);
        hipFuncSetAttribute((const void*)mega, hipFuncAttributeMaxDynamicSharedMemorySize, LDS_BYTES);
        hipOccupancyMaxActiveBlocksPerMultiprocessor(&per_cu, (const void*)mega, 256, LDS_BYTES);
        (void)hipGetLastError();
        if (per_cu < 1) per_cu = 1;
        grid = cus * (per_cu < 2 ? per_cu : 2);
    }
    hipMemsetAsync((char*)d_ws + OFF_bar, 0, (4096 + 64 * 8 + 64) * sizeof(unsigned), stream);
    hipLaunchKernelGGL(mega, dim3(grid), dim3(256), LDS_BYTES, stream, p);
}
```

```cpp
#include <hip/hip_runtime.h>
#include <stdint.h>
#include <math.h>
#include <cstdio>
#include <type_traits>

namespace {
constexpr int S = 8192, NBATCH = 2, T = NBATCH * S, D = 1024, NIN = 9396, NM = 4276, DEPTH = 4, NMEM = 256;
constexpr int NCMP = 511, NCMP_PAD = 512;
constexpr int C_DSA_Q = 0, C_CKV = 256, C_IDXQ = 384, C_IDXK = 512, C_IDXW = 544, C_DSA_Z = 548,
              C_FOX_Q = 804, C_FOX_K = 1060, C_FOX_V = 1316, C_FOX_F = 1572, C_FOX_Z = 1576,
              C_SB_Q = 1832, C_SB_K = 2088, C_SB_V = 2344, C_SB_Z = 2600,
              C_NSA_Q = 2856, C_NSA_KC = 3112, C_NSA_VC = 3176, C_NSA_KS = 3240, C_NSA_VS = 3304, C_NSA_KW = 3368, C_NSA_VW = 3432,
              C_NSA_G = 3496, C_NSA_Z = 3508, C_MEM_Q = 3764, C_MEM_Z = 4020, C_MERGE = 4276;

typedef unsigned short bf16_t;
typedef short bf16x8 __attribute__((ext_vector_type(8)));
typedef float f32x16 __attribute__((ext_vector_type(16)));
typedef float f32x2 __attribute__((ext_vector_type(2)));
typedef unsigned u32x4 __attribute__((ext_vector_type(4)));
typedef unsigned u32x2 __attribute__((ext_vector_type(2)));

constexpr int M_QA = 0, M_QN = 256, M_KSLC = 512, M_KWIN = 576, M_KC = 640, M_VC = 704, M_QF = 768, M_KF = 1024, M_QS = 1280, M_KSB = 1536, M_QM = 1792,
              M_VF = 2048, M_VS = 2304, M_VSLC = 2560, M_VWIN = 2624, M_QI = 2688, M_SPC = 2816, M_CKV = 2880, M_Z = 3008, NPM = 4288, M_MERGE = 4352, NP = 9472;
constexpr size_t al256(size_t x) { return (x + 255) & ~(size_t)255; }
constexpr size_t OFF_bar = 0;
constexpr size_t OFF_H = OFF_bar + al256((4096 + 64 * 8 + 64) * 4);
constexpr size_t OFF_Y = OFF_H + al256((size_t)T * D * 2);
constexpr size_t OFF_ZG = OFF_Y + al256((size_t)T * 1280 * 2);
constexpr size_t OFF_MG = OFF_ZG + al256((size_t)T * 1280 * 2);
constexpr size_t OFF_SIG = OFF_MG + al256((size_t)T * D * 2);
constexpr size_t OFF_CKVR = OFF_SIG + al256((size_t)T * 5120 * 2);
constexpr size_t OFF_CKV = OFF_CKVR + al256((size_t)T * 128 * 4);
constexpr size_t OFF_LOGF = OFF_CKV + al256((size_t)T * 128 * 2);
constexpr size_t OFF_CUM = OFF_LOGF + al256((size_t)T * 4 * 4);
constexpr size_t OFF_CUMT = OFF_CUM + al256((size_t)T * 4 * 4);
constexpr size_t OFF_WI = OFF_CUMT + al256((size_t)T * 4 * 4);
constexpr size_t OFF_GN = OFF_WI + al256((size_t)T * 4 * 4);
constexpr size_t OFF_KCT = OFF_GN + al256((size_t)T * 12 * 4);
constexpr size_t OFF_VCTOK = OFF_KCT + al256(((size_t)T * 64 + 2048) * 2);
constexpr size_t OFF_HIDK = OFF_VCTOK + al256(((size_t)T * 64 + 2048) * 2);
constexpr size_t OFF_HIDV = OFF_HIDK + al256((size_t)1024 * 128 * 2);
constexpr size_t OFF_KCB = OFF_HIDV + al256((size_t)1024 * 128 * 2);
constexpr size_t OFF_VCT = OFF_KCB + al256((size_t)NBATCH * NCMP_PAD * 64 * 2);
constexpr size_t OFF_QI = OFF_VCT + al256((size_t)NBATCH * NCMP_PAD * 64 * 2);
constexpr size_t OFF_KI = OFF_QI + al256((size_t)T * 128 * 2);
constexpr size_t OFF_MEMN = OFF_KI + al256((size_t)T * 32 * 2);
constexpr size_t OFF_ROPE = OFF_MEMN + al256((size_t)NBATCH * NMEM * D * 2);
constexpr size_t OFF_DMASK = OFF_ROPE + al256((size_t)T * 64 * 4);
constexpr size_t OFF_SMASK = OFF_DMASK + al256((size_t)T * 256 * 4);
constexpr size_t OFF_QA = OFF_SMASK + al256((size_t)T * 4 * 4);
constexpr size_t OFF_KAB = OFF_QA + al256((size_t)T * 256 * 2);
constexpr size_t OFF_VAT = OFF_KAB + al256((size_t)T * 256 * 2);
constexpr size_t OFF_QF = OFF_VAT + al256((size_t)T * 256 * 2);
constexpr size_t OFF_KF = OFF_QF + al256((size_t)T * 256 * 2);
constexpr size_t OFF_VFT = OFF_KF + al256((size_t)T * 256 * 2);
constexpr size_t OFF_QS = OFF_VFT + al256((size_t)T * 256 * 2);
constexpr size_t OFF_KSB = OFF_QS + al256((size_t)T * 256 * 2);
constexpr size_t OFF_VST = OFF_KSB + al256((size_t)T * 256 * 2);
constexpr size_t OFF_QN = OFF_VST + al256((size_t)T * 256 * 2);
constexpr size_t OFF_QM = OFF_QN + al256((size_t)T * 256 * 2);
constexpr size_t OFF_KSLC = OFF_QM + al256((size_t)T * 256 * 2);
constexpr size_t OFF_VSLCT = OFF_KSLC + al256((size_t)T * 64 * 2);
constexpr size_t OFF_KWIN = OFF_VSLCT + al256((size_t)T * 64 * 2);
constexpr size_t OFF_VWINT = OFF_KWIN + al256((size_t)T * 64 * 2);
constexpr size_t OFF_MKB = OFF_VWINT + al256((size_t)T * 64 * 2);
constexpr size_t OFF_MVT = OFF_MKB + al256((size_t)NBATCH * NMEM * 256 * 2);
constexpr size_t OFF_WIN = OFF_MVT + al256((size_t)NBATCH * NMEM * 256 * 2);
constexpr size_t OFF_WBR = OFF_WIN + al256((size_t)2 * NP * D * 2);
constexpr size_t OFF_WOUT = OFF_WBR + al256((size_t)DEPTH * 5 * D * 256 * 2);
constexpr size_t OFF_WMKV = OFF_WOUT + al256((size_t)DEPTH * D * D * 2);
constexpr size_t OFF_WUK = OFF_WMKV + al256((size_t)DEPTH * 512 * D * 2);
constexpr size_t OFF_WUV = OFF_WUK + al256((size_t)DEPTH * 256 * 128 * 2);
constexpr size_t OFF_WC1T = OFF_WUV + al256((size_t)DEPTH * 256 * 128 * 2);
constexpr size_t OFF_WC2T = OFF_WC1T + al256((size_t)DEPTH * 2 * 128 * 2048 * 2);
constexpr size_t OFF_BIASC = OFF_WC2T + al256((size_t)DEPTH * 2 * 64 * 128 * 2);
constexpr size_t WS_TOTAL = OFF_BIASC + al256((size_t)DEPTH * 2 * 128 * 4);

__device__ __forceinline__ int map_in_col(int n) {
    constexpr int seg[27][3] = {{0, 256, M_QA}, {256, 128, M_CKV}, {384, 128, M_QI}, {512, 32, M_SPC}, {544, 4, M_SPC + 32}, {548, 256, M_Z}, {804, 256, M_QF}, {1060, 256, M_KF},
        {1316, 256, M_VF}, {1572, 4, M_SPC + 36}, {1576, 256, M_Z + 256}, {1832, 256, M_QS}, {2088, 256, M_KSB}, {2344, 256, M_VS}, {2600, 256, M_Z + 512}, {2856, 256, M_QN},
        {3112, 64, M_KC}, {3176, 64, M_VC}, {3240, 64, M_KSLC}, {3304, 64, M_VSLC}, {3368, 64, M_KWIN}, {3432, 64, M_VWIN}, {3496, 12, M_SPC + 40}, {3508, 256, M_Z + 768},
        {3764, 256, M_QM}, {4020, 256, M_Z + 1024}, {4276, 5120, M_MERGE}};
    int r = 0;
#pragma unroll
    for (int i = 0; i < 27; ++i) r = (n >= seg[i][0] && n < seg[i][0] + seg[i][1]) ? (seg[i][2] + n - seg[i][0]) : r;
    return r;
}
struct Params {
    const float* x; const float* mem; const int* pos; const float* norm_g; const float* w_in; const float* kv_norm;
    const float* w_uk; const float* w_uv; const float* fox_bias; const float* pe_k; const float* pe_v;
    const float* wc1_k; const float* wc2_k; const float* wc1_v; const float* wc2_v; const float* mem_norm;
    const float* w_mem_kv; const float* w_branch; const float* w_out; const float* final_norm;
    float* X; char* ws;
    __device__ __forceinline__ unsigned* bar() const { return (unsigned*)(ws + OFF_bar); }
    __device__ __forceinline__ bf16_t* H() const { return (bf16_t*)(ws + OFF_H); }
    __device__ __forceinline__ bf16_t* Y() const { return (bf16_t*)(ws + OFF_Y); }
    __device__ __forceinline__ bf16_t* ZG() const { return (bf16_t*)(ws + OFF_ZG); }
    __device__ __forceinline__ bf16_t* MG() const { return (bf16_t*)(ws + OFF_MG); }
    __device__ __forceinline__ bf16_t* SIG() const { return (bf16_t*)(ws + OFF_SIG); }
    __device__ __forceinline__ float* CKVR() const { return (float*)(ws + OFF_CKVR); }
    __device__ __forceinline__ bf16_t* CKV() const { return (bf16_t*)(ws + OFF_CKV); }
    __device__ __forceinline__ float* LOGF() const { return (float*)(ws + OFF_LOGF); }
    __device__ __forceinline__ float* CUM() const { return (float*)(ws + OFF_CUM); }
    __device__ __forceinline__ float* CUMT() const { return (float*)(ws + OFF_CUMT); }
    __device__ __forceinline__ float* WI() const { return (float*)(ws + OFF_WI); }
    __device__ __forceinline__ float* GN() const { return (float*)(ws + OFF_GN); }
    __device__ __forceinline__ bf16_t* KCT() const { return (bf16_t*)(ws + OFF_KCT); }
    __device__ __forceinline__ bf16_t* VCTOK() const { return (bf16_t*)(ws + OFF_VCTOK); }
    __device__ __forceinline__ bf16_t* HIDK() const { return (bf16_t*)(ws + OFF_HIDK); }
    __device__ __forceinline__ bf16_t* HIDV() const { return (bf16_t*)(ws + OFF_HIDV); }
    __device__ __forceinline__ bf16_t* KCB() const { return (bf16_t*)(ws + OFF_KCB); }
    __device__ __forceinline__ bf16_t* VCT() const { return (bf16_t*)(ws + OFF_VCT); }
    __device__ __forceinline__ bf16_t* QI() const { return (bf16_t*)(ws + OFF_QI); }
    __device__ __forceinline__ bf16_t* KI() const { return (bf16_t*)(ws + OFF_KI); }
    __device__ __forceinline__ bf16_t* MEMN() const { return (bf16_t*)(ws + OFF_MEMN); }
    __device__ __forceinline__ float* ROPE() const { return (float*)(ws + OFF_ROPE); }
    __device__ __forceinline__ unsigned* DMASK() const { return (unsigned*)(ws + OFF_DMASK); }
    __device__ __forceinline__ unsigned* SMASK() const { return (unsigned*)(ws + OFF_SMASK); }
    __device__ __forceinline__ bf16_t* QA() const { return (bf16_t*)(ws + OFF_QA); }
    __device__ __forceinline__ bf16_t* KAB() const { return (bf16_t*)(ws + OFF_KAB); }
    __device__ __forceinline__ bf16_t* VAT() const { return (bf16_t*)(ws + OFF_VAT); }
    __device__ __forceinline__ bf16_t* QF() const { return (bf16_t*)(ws + OFF_QF); }
    __device__ __forceinline__ bf16_t* KF() const { return (bf16_t*)(ws + OFF_KF); }
    __device__ __forceinline__ bf16_t* VFT() const { return (bf16_t*)(ws + OFF_VFT); }
    __device__ __forceinline__ bf16_t* QS() const { return (bf16_t*)(ws + OFF_QS); }
    __device__ __forceinline__ bf16_t* KSB() const { return (bf16_t*)(ws + OFF_KSB); }
    __device__ __forceinline__ bf16_t* VST() const { return (bf16_t*)(ws + OFF_VST); }
    __device__ __forceinline__ bf16_t* QN() const { return (bf16_t*)(ws + OFF_QN); }
    __device__ __forceinline__ bf16_t* QM() const { return (bf16_t*)(ws + OFF_QM); }
    __device__ __forceinline__ bf16_t* KSLC() const { return (bf16_t*)(ws + OFF_KSLC); }
    __device__ __forceinline__ bf16_t* VSLCT() const { return (bf16_t*)(ws + OFF_VSLCT); }
    __device__ __forceinline__ bf16_t* KWIN() const { return (bf16_t*)(ws + OFF_KWIN); }
    __device__ __forceinline__ bf16_t* VWINT() const { return (bf16_t*)(ws + OFF_VWINT); }
    __device__ __forceinline__ bf16_t* MKB() const { return (bf16_t*)(ws + OFF_MKB); }
    __device__ __forceinline__ bf16_t* MVT() const { return (bf16_t*)(ws + OFF_MVT); }
    __device__ __forceinline__ bf16_t* WIN(int l) const { return (bf16_t*)(ws + OFF_WIN) + (size_t)(l & 1) * NP * D; }
    __device__ __forceinline__ bf16_t* WBR() const { return (bf16_t*)(ws + OFF_WBR); }
    __device__ __forceinline__ bf16_t* WOUT() const { return (bf16_t*)(ws + OFF_WOUT); }
    __device__ __forceinline__ bf16_t* WMKV() const { return (bf16_t*)(ws + OFF_WMKV); }
    __device__ __forceinline__ bf16_t* WUK() const { return (bf16_t*)(ws + OFF_WUK); }
    __device__ __forceinline__ bf16_t* WUV() const { return (bf16_t*)(ws + OFF_WUV); }
    __device__ __forceinline__ bf16_t* WC1T() const { return (bf16_t*)(ws + OFF_WC1T); }
    __device__ __forceinline__ bf16_t* WC2T() const { return (bf16_t*)(ws + OFF_WC2T); }
    __device__ __forceinline__ float* BIASC() const { return (float*)(ws + OFF_BIASC); }
    __device__ __forceinline__ unsigned* qctr() const { return (unsigned*)(ws + OFF_bar) + 4096; }
};

typedef __bf16 bf16x2_t __attribute__((ext_vector_type(2)));
__device__ __forceinline__ unsigned cvt_pk_bf16(float lo, float hi) { bf16x2_t v; v.x = (__bf16)lo; v.y = (__bf16)hi; return __builtin_bit_cast(unsigned, v); }
__device__ __forceinline__ bf16_t f2bf(float x) { return (bf16_t)(cvt_pk_bf16(x, 0.f) & 0xffffu); }
__device__ __forceinline__ unsigned xb_ld(unsigned* p)              { return __hip_atomic_load(p, __ATOMIC_RELAXED, __HIP_MEMORY_SCOPE_AGENT); }
__device__ __forceinline__ unsigned xb_add(unsigned* p, unsigned v) { return __hip_atomic_fetch_add(p, v, __ATOMIC_RELAXED, __HIP_MEMORY_SCOPE_AGENT); }
__device__ __forceinline__ unsigned xb_xcc_id() { return (unsigned)__builtin_amdgcn_s_getreg((3 << 11) | 20) & 0xFu; }
__device__ __forceinline__ int tidx() { int t = threadIdx.x; asm volatile("" : "+v"(t)); return t; }
__device__ __forceinline__ float sigmoid_(float x) { return __builtin_amdgcn_rcpf(1.f + __builtin_amdgcn_exp2f(-1.4426950408889634f * x)); }
__device__ __forceinline__ float silu_(float x) { return x * __builtin_amdgcn_rcpf(1.f + __builtin_amdgcn_exp2f(-1.4426950408889634f * x)); }
__device__ __forceinline__ float logsig_(float x) { return fminf(x, 0.f) - log1pf(expf(-fabsf(x))); }
__device__ __forceinline__ void half_pair(float x, float& lo, float& hi) {
    const auto r = __builtin_amdgcn_permlane32_swap(__float_as_uint(x), __float_as_uint(x), false, false);
    lo = __uint_as_float(r[0]); hi = __uint_as_float(r[1]);
}
__device__ __forceinline__ float half_sum(float x) { float a, b; half_pair(x, a, b); return a + b; }
__device__ __forceinline__ float half_max(float x) { float a, b; half_pair(x, a, b); return fmaxf(a, b); }
__device__ __forceinline__ unsigned half_or(unsigned x) { const auto r = __builtin_amdgcn_permlane32_swap(x, x, false, false); return r[0] | r[1]; }
template <int O> __device__ __forceinline__ float shx(float v) { return __int_as_float(__builtin_amdgcn_ds_swizzle(__float_as_int(v), 0x1F | (O << 10))); }
__device__ __forceinline__ float wave_sum(float v) {
    v = half_sum(v);
    v += shx<16>(v); v += shx<8>(v); v += shx<4>(v); v += shx<2>(v); v += shx<1>(v);
    return v;
}
__device__ __forceinline__ float wave_max(float v) {
    v = half_max(v);
    v = fmaxf(v, shx<16>(v)); v = fmaxf(v, shx<8>(v)); v = fmaxf(v, shx<4>(v)); v = fmaxf(v, shx<2>(v)); v = fmaxf(v, shx<1>(v));
    return v;
}

__device__ __forceinline__ void ph_rope_table(const Params& p, int bid, int nb) {
    for (int i = bid * 256 + tidx(); i < T * 32; i += nb * 256) {
        const int t = i >> 5, f = i & 31;
        const double inv = pow(10000.0, -(double)f / 32.0);
        const double ang = (double)p.pos[t] * inv;
        p.ROPE()[(size_t)t * 64 + f] = (float)cos(ang);
        p.ROPE()[(size_t)t * 64 + 32 + f] = (float)sin(ang);
    }
}

template <class OUT>
__device__ __forceinline__ void ph_rmsnorm(const float* in, const float* g, OUT* out, int rows, int bid, int nb, float dscale = 1.0f) {
    const int lane = tidx() & 63, wid = tidx() >> 6;
    for (int r = bid * 4 + wid; r < rows; r += nb * 4) {
        const float4* ip = (const float4*)(in + (size_t)r * D);
        float4 v[4]; float ss = 0.f;
#pragma unroll
        for (int i = 0; i < 4; ++i) { v[i] = ip[lane + 64 * i]; ss += v[i].x * v[i].x + v[i].y * v[i].y + v[i].z * v[i].z + v[i].w * v[i].w; }
        ss = wave_sum(ss);
        const float sc = dscale / sqrtf(ss * (1.f / D) + 1e-6f);
#pragma unroll
        for (int i = 0; i < 4; ++i) {
            const float4 gg = ((const float4*)g)[lane + 64 * i];
            float4 o; o.x = v[i].x * sc * gg.x; o.y = v[i].y * sc * gg.y; o.z = v[i].z * sc * gg.z; o.w = v[i].w * sc * gg.w;
            if constexpr (sizeof(OUT) == 4) ((float4*)((float*)out + (size_t)r * D))[lane + 64 * i] = o;
            else { u32x2 w; w.x = cvt_pk_bf16(o.x, o.y); w.y = cvt_pk_bf16(o.z, o.w); ((u32x2*)((bf16_t*)out + (size_t)r * D))[lane + 64 * i] = w; }
        }
    }
}

__device__ __forceinline__ void ph_ckvnorm(const Params& p, int layer, int bid, int nb) {
    const int lane = tidx() & 63, wid = tidx() >> 6;
    const float* g = p.kv_norm + layer * 128;
    const float g0 = g[lane], g1 = g[lane + 64];
    const float* __restrict__ src = p.CKVR();
    bf16_t* __restrict__ dst = p.CKV();
    const int stride = nb * 4;
    for (int r0 = bid * 4 + wid; r0 < T; r0 += 8 * stride) {
        float a[8], b[8];
#pragma unroll
        for (int k = 0; k < 8; ++k) { const int r = min(r0 + k * stride, T - 1); a[k] = src[(size_t)r * 128 + lane]; b[k] = src[(size_t)r * 128 + lane + 64]; }
#pragma unroll
        for (int k = 0; k < 8; ++k) {
            const int r = r0 + k * stride;
            const float ss = wave_sum(a[k] * a[k] + b[k] * b[k]);
            const float sc = 1.0f / sqrtf(ss * (1.f / 128.f) + 1e-6f);
            if (r < T) { dst[(size_t)r * 128 + lane] = f2bf(a[k] * sc * g0); dst[(size_t)r * 128 + lane + 64] = f2bf(b[k] * sc * g1); }
        }
    }
}

__device__ __forceinline__ void ckvnorm_rows128(const Params& p, int layer, int row0) {
    const int lane = tidx() & 63, wid = tidx() >> 6;
    const float* g = p.kv_norm + layer * 128;
    const float g0 = g[lane], g1 = g[lane + 64];
    const float* __restrict__ src = p.CKVR() + (size_t)row0 * 128;
    bf16_t* __restrict__ dst = p.CKV() + (size_t)row0 * 128;
#pragma unroll 1
    for (int r0 = wid; r0 < 128; r0 += 32) {
        float a[8], b[8];
#pragma unroll
        for (int k = 0; k < 8; ++k) { a[k] = src[(size_t)(r0 + 4 * k) * 128 + lane]; b[k] = src[(size_t)(r0 + 4 * k) * 128 + lane + 64]; }
#pragma unroll
        for (int k = 0; k < 8; ++k) {
            const float ss = wave_sum(a[k] * a[k] + b[k] * b[k]);
            const float sc = 1.0f / sqrtf(ss * (1.f / 128.f) + 1e-6f);
            dst[(size_t)(r0 + 4 * k) * 128 + lane] = f2bf(a[k] * sc * g0); dst[(size_t)(r0 + 4 * k) * 128 + lane + 64] = f2bf(b[k] * sc * g1);
        }
    }
}

template <bool MAPIN = false>
__device__ __forceinline__ void convert_wt_range(const float* __restrict__ src, bf16_t* __restrict__ dst, int K, int N, int nmat, int it0, int it1, int nstep, float* sm) {
    float (*tl)[65] = (float (*)[65])sm;
    const int tid = tidx(), tk = K / 64, tn = (N + 63) / 64, per = tk * tn;
    for (int it = it0; it < it1 && it < per * nmat; it += nstep) {
        const int mat = it / per, r = it % per, k0 = (r % tk) * 64, n0 = (r / tk) * 64;
        const float* s = src + (size_t)mat * K * N; bf16_t* d = dst + (size_t)mat * K * N;
        __syncthreads();
        for (int i = tid; i < 64 * 64; i += 256) { const int kk = i >> 6, nn = i & 63; tl[kk][nn] = (n0 + nn < N) ? s[(size_t)(k0 + kk) * N + n0 + nn] : 0.f; }
        __syncthreads();
        {
            const int nn = tid >> 2, kq = (tid & 3) * 16;
            if (n0 + nn < N) {
                u32x4 w0, w1;
                w0.x = cvt_pk_bf16(tl[kq + 0][nn], tl[kq + 1][nn]); w0.y = cvt_pk_bf16(tl[kq + 2][nn], tl[kq + 3][nn]);
                w0.z = cvt_pk_bf16(tl[kq + 4][nn], tl[kq + 5][nn]); w0.w = cvt_pk_bf16(tl[kq + 6][nn], tl[kq + 7][nn]);
                w1.x = cvt_pk_bf16(tl[kq + 8][nn], tl[kq + 9][nn]); w1.y = cvt_pk_bf16(tl[kq + 10][nn], tl[kq + 11][nn]);
                w1.z = cvt_pk_bf16(tl[kq + 12][nn], tl[kq + 13][nn]); w1.w = cvt_pk_bf16(tl[kq + 14][nn], tl[kq + 15][nn]);
                const int drow = MAPIN ? map_in_col(n0 + nn) : (n0 + nn);
                u32x4* dp = (u32x4*)(d + (size_t)drow * K + k0 + kq);
                dp[0] = w0; dp[1] = w1;
            }
        }
    }
    __syncthreads();
}
template <bool MAPIN = false>
__device__ __forceinline__ void convert_wt(const float* __restrict__ src, bf16_t* __restrict__ dst, int K, int N, int nmat, int bid, int nb, float* sm) {
    convert_wt_range<MAPIN>(src, dst, K, N, nmat, bid, 1 << 30, nb, sm);
}

constexpr int GROW = 80;
constexpr int GA_BYTES = 128 * GROW;
struct GStage { u32x4 a0, a1, b0, b1; };
template <int BN, int DEPTH = 3>
__device__ __forceinline__ void tile_mac(f32x16 (&acc)[2][BN / 64], const bf16_t* __restrict__ A, int lda, int m0,
                                         const bf16_t* __restrict__ Bt, int ldb, int n0, int nmax, int K, char* sm) {
    constexpr int NT = BN / 64;
    constexpr int B_BYTES = BN * GROW;
    constexpr int BUF = GA_BYTES + B_BYTES;
    const int tid = tidx(), lane = tid & 63, wid = __builtin_amdgcn_readfirstlane(tid >> 6), wr = wid >> 1, wc = wid & 1;
    const int lr = lane & 31, lh = lane >> 5;
    const int ar0 = tid >> 2, akq = tid & 3;
    const bf16_t* Ab = A + (size_t)m0 * lda;
    const bf16_t* Bb = Bt + (size_t)n0 * ldb;
    const unsigned ao0 = (unsigned)(ar0 * lda + akq * 8), ao1 = ao0 + (unsigned)(64 * lda);
    const int br0 = tid >> 2;
    const bool bv0 = (n0 + br0) < nmax, bv1 = (NT == 2) && ((n0 + br0 + 64) < nmax);
    const unsigned bo0 = (unsigned)((bv0 ? br0 : 0) * ldb + akq * 8), bo1 = (unsigned)((bv1 ? br0 + 64 : 0) * ldb + akq * 8);
    const int st_a0 = ar0 * GROW + akq * 16, st_a1 = (ar0 + 64) * GROW + akq * 16;
    const int st_b0 = GA_BYTES + br0 * GROW + akq * 16, st_b1 = GA_BYTES + (br0 + 64) * GROW + akq * 16;
    const int rd_a = (wr * 64 + lr) * GROW + lh * 16, rd_b = GA_BYTES + (wc * (BN / 2) + lr) * GROW + lh * 16;
    const u32x4 zero4 = {0u, 0u, 0u, 0u};
    const int nk = K / 32;
    auto gload = [&](GStage& g, int ks) {
        const unsigned ko = (unsigned)ks * 32u;
        g.a0 = *(const u32x4*)(Ab + (ao0 + ko)); g.a1 = *(const u32x4*)(Ab + (ao1 + ko));
        g.b0 = *(const u32x4*)(Bb + (bo0 + ko)); if (NT == 2) g.b1 = *(const u32x4*)(Bb + (bo1 + ko));
    };
    auto lstore = [&](const GStage& g, char* buf) {
        *(u32x4*)(buf + st_a0) = g.a0; *(u32x4*)(buf + st_a1) = g.a1;
        *(u32x4*)(buf + st_b0) = bv0 ? g.b0 : zero4; if (NT == 2) *(u32x4*)(buf + st_b1) = bv1 ? g.b1 : zero4;
    };
    auto compute = [&](const char* cur) {
#pragma unroll
        for (int s = 0; s < 2; ++s) {
            bf16x8 a[2], b[NT];
#pragma unroll
            for (int mi = 0; mi < 2; ++mi) a[mi] = *(const bf16x8*)(cur + rd_a + mi * 32 * GROW + s * 32);
#pragma unroll
            for (int ni = 0; ni < NT; ++ni) b[ni] = *(const bf16x8*)(cur + rd_b + ni * 32 * GROW + s * 32);
#pragma unroll
            for (int mi = 0; mi < 2; ++mi)
#pragma unroll
                for (int ni = 0; ni < NT; ++ni) acc[mi][ni] = __builtin_amdgcn_mfma_f32_32x32x16_bf16(a[mi], b[ni], acc[mi][ni], 0, 0, 0);
        }
    };
    GStage g0, g1, g2;
    g1.b1 = zero4; g2.b1 = zero4; g0.b1 = zero4;
    const int last = nk - 1;
    gload(g0, 0);
    gload(g1, min(1, last));
    if (DEPTH == 3) gload(g2, min(2, last));
    __syncthreads();
    lstore(g0, sm);
    __syncthreads();
#define GSTEP(k, GL, GS) { gload(GL, min((k) + DEPTH, last)); compute(sm + ((k) & 1) * BUF); lstore(GS, sm + (((k) + 1) & 1) * BUF); __syncthreads(); }
    int ks = 0;
    if (DEPTH == 3) {
#pragma unroll 1
        for (; ks + 3 <= nk; ks += 3) {
            GSTEP(ks, g0, g1)
            GSTEP(ks + 1, g1, g2)
            GSTEP(ks + 2, g2, g0)
        }
        if (ks < nk) {
            GSTEP(ks, g0, g1)
            if (ks + 1 < nk) GSTEP(ks + 1, g1, g2)
        }
    } else if (DEPTH == 2) {
#pragma unroll 1
        for (; ks + 2 <= nk; ks += 2) {
            GSTEP(ks, g0, g1)
            GSTEP(ks + 1, g1, g0)
        }
        if (ks < nk) GSTEP(ks, g0, g1)
    } else {
#pragma unroll 1
        for (; ks < nk; ++ks) GSTEP(ks, g1, g1)
    }
#undef GSTEP
}
constexpr int DMA_STAGE = 16384, GEMM_NST = 3;
#define DMA_WAIT(n) asm volatile("s_waitcnt vmcnt(" #n ")" ::: "memory")
template <int NST>
__device__ __forceinline__ void tile_mac_dma(f32x16 (&acc)[2][2], const bf16_t* __restrict__ A, int lda, int m0,
                                             const bf16_t* __restrict__ Bt, int ldb, int n0, int K, char* sm) {
    static_assert(NST == 3 || NST == 4, "ring of 3 or 4 stages");
    const int tid = tidx(), lane = tid & 63, wid = __builtin_amdgcn_readfirstlane(tid >> 6), wr = wid >> 1, wc = wid & 1;
    const int lr = lane & 31, lh = lane >> 5;
    const int srow = tid >> 2, sslot = tid & 3, schunk = sslot ^ ((srow >> 2) & 3);
    const bf16_t* Ab = A + (size_t)m0 * lda;
    const bf16_t* Bb = Bt + (size_t)n0 * ldb;
    const unsigned ao0 = (unsigned)(srow * lda + schunk * 8), ao1 = ao0 + (unsigned)(64 * lda);
    const unsigned bo0 = (unsigned)(srow * ldb + schunk * 8), bo1 = bo0 + (unsigned)(64 * ldb);
    const int ldst = tid * 16;
    const int sw = (lr >> 2) & 3;
    const int rd_a = (wr * 64 + lr) * 64, rd_b = 8192 + (wc * 64 + lr) * 64;
    const int so0 = ((lh) ^ sw) * 16, so1 = ((lh + 2) ^ sw) * 16;
    const int nk = K / 32, last = nk - 1;
    auto issue = [&](int ks, int slot) {
        const unsigned ko = (unsigned)ks * 32u;
        char* st = sm + slot * DMA_STAGE + ldst;
        __builtin_amdgcn_global_load_lds((const unsigned*)(Ab + (ao0 + ko)), (unsigned*)(st), 16, 0, 0);
        __builtin_amdgcn_global_load_lds((const unsigned*)(Ab + (ao1 + ko)), (unsigned*)(st + 4096), 16, 0, 0);
        __builtin_amdgcn_global_load_lds((const unsigned*)(Bb + (bo0 + ko)), (unsigned*)(st + 8192), 16, 0, 0);
        __builtin_amdgcn_global_load_lds((const unsigned*)(Bb + (bo1 + ko)), (unsigned*)(st + 12288), 16, 0, 0);
    };
    auto compute = [&](int slot) {
        const char* cur = sm + slot * DMA_STAGE;
        bf16x8 a[2][2], b[2][2];
#pragma unroll
        for (int mi = 0; mi < 2; ++mi) { a[mi][0] = *(const bf16x8*)(cur + rd_a + mi * 2048 + so0); a[mi][1] = *(const bf16x8*)(cur + rd_a + mi * 2048 + so1); }
#pragma unroll
        for (int ni = 0; ni < 2; ++ni) { b[ni][0] = *(const bf16x8*)(cur + rd_b + ni * 2048 + so0); b[ni][1] = *(const bf16x8*)(cur + rd_b + ni * 2048 + so1); }
#pragma unroll
        for (int s = 0; s < 2; ++s)
#pragma unroll
            for (int mi = 0; mi < 2; ++mi)
#pragma unroll
                for (int ni = 0; ni < 2; ++ni) acc[mi][ni] = __builtin_amdgcn_mfma_f32_32x32x16_bf16(a[mi][s], b[ni][s], acc[mi][ni], 0, 0, 0);
    };
    __syncthreads();
#pragma unroll
    for (int s = 0; s < NST - 1; ++s) issue(min(s, last), s);
    int slot = 0, nslot = NST - 1;
#pragma unroll 1
    for (int ks = 0; ks < nk; ++ks) {
        if (NST == 3) DMA_WAIT(4); else DMA_WAIT(8);
        __builtin_amdgcn_s_barrier();
        issue(min(ks + NST - 1, last), nslot);
        compute(slot);
        slot = (slot + 1 == NST) ? 0 : slot + 1; nslot = (nslot + 1 == NST) ? 0 : nslot + 1;
    }
    DMA_WAIT(0);
}
constexpr int BIG_STAGE = 24576;
__device__ __forceinline__ void tile_mac_big(f32x16 (&acc)[4][2], const bf16_t* __restrict__ A, int lda, int m0,
                                             const bf16_t* __restrict__ Bt, int ldb, int n0, int K, char* sm) {
    const int tid = tidx(), lane = tid & 63, wid = __builtin_amdgcn_readfirstlane(tid >> 6), wr = wid >> 1, wc = wid & 1;
    const int lr = lane & 31, lh = lane >> 5;
    const int srow = tid >> 2, sslot = tid & 3, schunk = sslot ^ ((srow >> 2) & 3);
    const bf16_t* Ab = A + (size_t)m0 * lda;
    const bf16_t* Bb = Bt + (size_t)n0 * ldb;
    const unsigned ao0 = (unsigned)(srow * lda + schunk * 8), bo0 = (unsigned)(srow * ldb + schunk * 8);
    const int ldst = tid * 16;
    const int sw = (lr >> 2) & 3;
    const int rd_a = (wr * 128 + lr) * 64, rd_b = 16384 + (wc * 64 + lr) * 64;
    const int so0 = ((lh) ^ sw) * 16, so1 = ((lh + 2) ^ sw) * 16;
    const int nk = K / 32, last = nk - 1;
    auto issue1 = [&](int ks, int slot, int i) {
        const unsigned ko = (unsigned)ks * 32u;
        char* st = sm + slot * BIG_STAGE + ldst + i * 4096;
        if (i < 4) __builtin_amdgcn_global_load_lds((const unsigned*)(Ab + (ao0 + (unsigned)(64 * i * lda) + ko)), (unsigned*)st, 16, 0, 0);
        else __builtin_amdgcn_global_load_lds((const unsigned*)(Bb + (bo0 + (unsigned)(64 * (i - 4) * ldb) + ko)), (unsigned*)st, 16, 0, 0);
    };
    __syncthreads();
#pragma unroll
    for (int i = 0; i < 6; ++i) issue1(0, 0, i);
#pragma unroll
    for (int i = 0; i < 6; ++i) issue1(min(1, last), 1, i);
    int slot = 0, nslot = 2;
#pragma unroll 1
    for (int ks = 0; ks < nk; ++ks) {
        DMA_WAIT(6);
        __builtin_amdgcn_s_barrier();
        const char* cur = sm + slot * BIG_STAGE;
        const int kn = min(ks + 2, last);
        bf16x8 a0[4], b0[2], a1[4], b1[2];
#pragma unroll
        for (int mi = 0; mi < 4; ++mi) a0[mi] = *(const bf16x8*)(cur + rd_a + mi * 2048 + so0);
#pragma unroll
        for (int ni = 0; ni < 2; ++ni) b0[ni] = *(const bf16x8*)(cur + rd_b + ni * 2048 + so0);
#pragma unroll
        for (int mi = 0; mi < 4; ++mi) a1[mi] = *(const bf16x8*)(cur + rd_a + mi * 2048 + so1);
#pragma unroll
        for (int ni = 0; ni < 2; ++ni) b1[ni] = *(const bf16x8*)(cur + rd_b + ni * 2048 + so1);
        __builtin_amdgcn_sched_barrier(0);
#pragma unroll
        for (int mi = 0; mi < 4; ++mi) {
            acc[mi][0] = __builtin_amdgcn_mfma_f32_32x32x16_bf16(a0[mi], b0[0], acc[mi][0], 0, 0, 0);
            acc[mi][1] = __builtin_amdgcn_mfma_f32_32x32x16_bf16(a0[mi], b0[1], acc[mi][1], 0, 0, 0);
            __builtin_amdgcn_sched_barrier(0);
            issue1(kn, nslot, mi);
            __builtin_amdgcn_sched_barrier(0);
        }
#pragma unroll
        for (int mi = 0; mi < 4; ++mi) {
            acc[mi][0] = __builtin_amdgcn_mfma_f32_32x32x16_bf16(a1[mi], b1[0], acc[mi][0], 0, 0, 0);
            acc[mi][1] = __builtin_amdgcn_mfma_f32_32x32x16_bf16(a1[mi], b1[1], acc[mi][1], 0, 0, 0);
            if (mi < 2) {
                __builtin_amdgcn_sched_barrier(0);
                issue1(kn, nslot, 4 + mi);
                __builtin_amdgcn_sched_barrier(0);
            }
        }
        slot = (slot + 1 == 3) ? 0 : slot + 1; nslot = (nslot + 1 == 3) ? 0 : nslot + 1;
    }
    DMA_WAIT(0);
}
__device__ __forceinline__ void tile_mac_dma64(f32x16 (&acc)[2][2], const bf16_t* __restrict__ A, int lda, int m0,
                                               const bf16_t* __restrict__ Bt, int ldb, int n0, int K, char* sm) {
    constexpr int STG = 32768;
    const int tid = tidx(), lane = tid & 63, wid = __builtin_amdgcn_readfirstlane(tid >> 6), wr = wid >> 1, wc = wid & 1;
    const int lr = lane & 31, lh = lane >> 5;
    const int srow = tid >> 3, schunk = (tid & 7) ^ ((tid >> 4) & 7);
    const bf16_t* Ab = A + (size_t)m0 * lda;
    const bf16_t* Bb = Bt + (size_t)n0 * ldb;
    const unsigned ao = (unsigned)(srow * lda + schunk * 8), bo = (unsigned)(srow * ldb + schunk * 8);
    const unsigned a32 = (unsigned)(32 * lda), b32 = (unsigned)(32 * ldb);
    const int ldst = tid * 16;
    const int sw = (lr >> 1) & 7;
    const int rd_a = (wr * 64 + lr) * 128, rd_b = 16384 + (wc * 64 + lr) * 128;
    const int nk = K / 64, last = nk - 1;
    auto issue = [&](int ks, int slot) {
        const unsigned ko = (unsigned)ks * 64u;
        char* st = sm + slot * STG + ldst;
#pragma unroll
        for (int i = 0; i < 4; ++i) __builtin_amdgcn_global_load_lds((const unsigned*)(Ab + (ao + i * a32 + ko)), (unsigned*)(st + i * 4096), 16, 0, 0);
#pragma unroll
        for (int i = 0; i < 4; ++i) __builtin_amdgcn_global_load_lds((const unsigned*)(Bb + (bo + i * b32 + ko)), (unsigned*)(st + 16384 + i * 4096), 16, 0, 0);
    };
    auto compute = [&](int slot) {
        const char* cur = sm + slot * STG;
#pragma unroll
        for (int s = 0; s < 4; ++s) {
            const int so = ((lh + 2 * s) ^ sw) * 16;
            bf16x8 a[2], b[2];
#pragma unroll
            for (int mi = 0; mi < 2; ++mi) a[mi] = *(const bf16x8*)(cur + rd_a + mi * 4096 + so);
#pragma unroll
            for (int ni = 0; ni < 2; ++ni) b[ni] = *(const bf16x8*)(cur + rd_b + ni * 4096 + so);
#pragma unroll
            for (int mi = 0; mi < 2; ++mi)
#pragma unroll
                for (int ni = 0; ni < 2; ++ni) acc[mi][ni] = __builtin_amdgcn_mfma_f32_32x32x16_bf16(a[mi], b[ni], acc[mi][ni], 0, 0, 0);
        }
    };
    __syncthreads();
    issue(0, 0);
#pragma unroll 1
    for (int ks = 0; ks < nk; ++ks) {
        DMA_WAIT(0);
        __builtin_amdgcn_s_barrier();
        if (ks < last) issue(ks + 1, (ks + 1) & 1);
        compute(ks & 1);
    }
    DMA_WAIT(0);
}
struct GStage64 { u32x4 a[4], b[4]; };
__device__ __forceinline__ void tile_mac_reg64(f32x16 (&acc)[2][2], const bf16_t* __restrict__ A, int lda, int m0,
                                               const bf16_t* __restrict__ Bt, int ldb, int n0, int K, char* sm) {
    constexpr int STG = 32768;
    const int tid = tidx(), lane = tid & 63, wid = __builtin_amdgcn_readfirstlane(tid >> 6), wr = wid >> 1, wc = wid & 1;
    const int lr = lane & 31, lh = lane >> 5;
    const int srow = tid >> 3, schunk = (tid & 7) ^ ((tid >> 4) & 7);
    const bf16_t* Ab = A + (size_t)m0 * lda;
    const bf16_t* Bb = Bt + (size_t)n0 * ldb;
    const unsigned ao = (unsigned)(srow * lda + schunk * 8), bo = (unsigned)(srow * ldb + schunk * 8);
    const unsigned a32 = (unsigned)(32 * lda), b32 = (unsigned)(32 * ldb);
    const int ldst = tid * 16;
    const int sw = (lr >> 1) & 7;
    const int rd_a = (wr * 64 + lr) * 128, rd_b = 16384 + (wc * 64 + lr) * 128;
    const int nk = K / 64, last = nk - 1;
    auto gload = [&](GStage64& g, int ks) {
        const unsigned ko = (unsigned)ks * 64u;
#pragma unroll
        for (int i = 0; i < 4; ++i) { g.a[i] = *(const u32x4*)(Ab + (ao + i * a32 + ko)); g.b[i] = *(const u32x4*)(Bb + (bo + i * b32 + ko)); }
    };
    auto lstore = [&](const GStage64& g, int slot) {
        char* st = sm + slot * STG + ldst;
#pragma unroll
        for (int i = 0; i < 4; ++i) { *(u32x4*)(st + i * 4096) = g.a[i]; *(u32x4*)(st + 16384 + i * 4096) = g.b[i]; }
    };
    auto compute = [&](int slot) {
        const char* cur = sm + slot * STG;
        bf16x8 fa[2][2], fb[2][2];
#pragma unroll
        for (int mi = 0; mi < 2; ++mi) fa[0][mi] = *(const bf16x8*)(cur + rd_a + mi * 4096 + ((lh ^ sw) * 16));
#pragma unroll
        for (int ni = 0; ni < 2; ++ni) fb[0][ni] = *(const bf16x8*)(cur + rd_b + ni * 4096 + ((lh ^ sw) * 16));
#pragma unroll
        for (int s = 0; s < 4; ++s) {
            if (s < 3) {
                const int so = ((lh + 2 * (s + 1)) ^ sw) * 16;
#pragma unroll
                for (int mi = 0; mi < 2; ++mi) fa[(s + 1) & 1][mi] = *(const bf16x8*)(cur + rd_a + mi * 4096 + so);
#pragma unroll
                for (int ni = 0; ni < 2; ++ni) fb[(s + 1) & 1][ni] = *(const bf16x8*)(cur + rd_b + ni * 4096 + so);
            }
#pragma unroll
            for (int mi = 0; mi < 2; ++mi)
#pragma unroll
                for (int ni = 0; ni < 2; ++ni) acc[mi][ni] = __builtin_amdgcn_mfma_f32_32x32x16_bf16(fa[s & 1][mi], fb[s & 1][ni], acc[mi][ni], 0, 0, 0);
        }
        __builtin_amdgcn_sched_group_barrier(0x100, 8, 0);
        __builtin_amdgcn_sched_group_barrier(0x008, 4, 0);
        __builtin_amdgcn_sched_group_barrier(0x100, 4, 0);
        __builtin_amdgcn_sched_group_barrier(0x008, 4, 0);
        __builtin_amdgcn_sched_group_barrier(0x100, 4, 0);
        __builtin_amdgcn_sched_group_barrier(0x008, 8, 0);
    };
    GStage64 g0, g1;
    gload(g0, 0);
    gload(g1, min(1, last));
    __syncthreads();
    lstore(g0, 0);
    __syncthreads();
#define GSTEP64(k, GL, GS) { gload(GL, min((k) + 2, last)); compute((k) & 1); lstore(GS, ((k) + 1) & 1); __syncthreads(); }
    int ks = 0;
#pragma unroll 1
    for (; ks + 2 <= nk; ks += 2) {
        GSTEP64(ks, g0, g1)
        GSTEP64(ks + 1, g1, g0)
    }
    if (ks < nk) GSTEP64(ks, g0, g1)
#undef GSTEP64
}
template <int NT> __device__ __forceinline__ void acc_zero(f32x16 (&acc)[2][NT]) {
#pragma unroll
    for (int mi = 0; mi < 2; ++mi)
#pragma unroll
        for (int ni = 0; ni < NT; ++ni)
#pragma unroll
            for (int r = 0; r < 16; ++r) acc[mi][ni][r] = 0.f;
}
template <int BN, class Epi>
__device__ __forceinline__ void gemm_bf16(const bf16_t* A, int lda, const bf16_t* Bt, int ldb, int M, int N, int K, const Epi& epi, int bid, int nb, char* sm) {
    constexpr int NT = BN / 64;
    const int tm = M / 128, tn = (N + BN - 1) / BN;
    for (int tile = bid; tile < tm * tn; tile += nb) {
        const int m0 = (tile % tm) * 128, n0 = (tile / tm) * BN;
        f32x16 acc[2][NT]; acc_zero<NT>(acc);
        if constexpr (BN == 128) { if (K % 64 == 0 && K >= 128) tile_mac_reg64(acc, A, lda, m0, Bt, ldb, n0, K, sm); else tile_mac_dma<GEMM_NST>(acc, A, lda, m0, Bt, ldb, n0, K, sm); }
        else tile_mac<BN>(acc, A, lda, m0, Bt, ldb, n0, N, K, sm);
        const int lane = tidx() & 63, wid = __builtin_amdgcn_readfirstlane(tidx() >> 6), wr = wid >> 1, wc = wid & 1, lr = lane & 31, lh = lane >> 5;
        const int col0 = n0 + wc * (BN / 2);
        if (col0 < N) epi(acc, m0 + wr * 64, col0, lr, lh, sm + (((K / 64) & 1) ? 32768 : 0) + wid * 8192);
    }
}
template <class Epi>
__device__ __forceinline__ int gemm_big(const bf16_t* A, int lda, const bf16_t* Bt, int ldb, int M, int N, int K, const Epi& epi, int bid, int nb, char* sm) {
    const int tm = M / 256, tn = N / 128, ntb = tm * tn, nfull = (ntb / nb) * nb;
    for (int tile = bid; tile < nfull; tile += nb) {
        const int m0 = (tile % tm) * 256, n0 = (tile / tm) * 128;
        f32x16 acc[4][2];
        acc_zero<2>(reinterpret_cast<f32x16 (&)[2][2]>(acc[0])); acc_zero<2>(reinterpret_cast<f32x16 (&)[2][2]>(acc[2]));
        tile_mac_big(acc, A, lda, m0, Bt, ldb, n0, K, sm);
        __syncthreads();
        const int lane = tidx() & 63, wid = __builtin_amdgcn_readfirstlane(tidx() >> 6), wr = wid >> 1, wc = wid & 1, lr = lane & 31, lh = lane >> 5;
        epi(reinterpret_cast<const f32x16 (&)[2][2]>(acc[0]), m0 + wr * 128, n0 + wc * 64, lr, lh, sm + wid * 8192);
        epi(reinterpret_cast<const f32x16 (&)[2][2]>(acc[2]), m0 + wr * 128 + 64, n0 + wc * 64, lr, lh, sm + wid * 8192);
    }
    const int nsmall = 2 * (ntb - nfull);
    for (int st = bid; st < nsmall; st += nb) {
        const int tile = nfull + (st >> 1);
        const int m0 = (tile % tm) * 256 + (st & 1) * 128, n0 = (tile / tm) * 128;
        f32x16 acc[2][2]; acc_zero<2>(acc);
        tile_mac_reg64(acc, A, lda, m0, Bt, ldb, n0, K, sm);
        const int lane = tidx() & 63, wid = __builtin_amdgcn_readfirstlane(tidx() >> 6), wr = wid >> 1, wc = wid & 1, lr = lane & 31, lh = lane >> 5;
        epi(acc, m0 + wr * 64, n0 + wc * 64, lr, lh, sm + (((K / 64) & 1) ? 32768 : 0) + wid * 8192);
    }
    return nsmall < nb ? nsmall : nb;
}
#define EROW(mi, r) (row0 + (mi) * 32 + ((r) & 3) + 8 * ((r) >> 2) + 4 * lh)
__device__ __forceinline__ float bf2f(bf16_t h) { return __uint_as_float((unsigned)h << 16); }
__device__ __forceinline__ void epi_rope64(const f32x16 (&acc)[2][2], int row0, int lr, int lh, const float* __restrict__ rope, bf16_t* __restrict__ dst, int ld, int cbase) {
#pragma unroll
    for (int mi = 0; mi < 2; ++mi)
#pragma unroll
        for (int r = 0; r < 16; ++r) {
            const size_t row = EROW(mi, r);
            const float c = rope[row * 64 + lr], s = rope[row * 64 + 32 + lr], x1 = acc[mi][0][r], x2 = acc[mi][1][r];
            dst[row * ld + cbase + lr] = f2bf(x1 * c - x2 * s); dst[row * ld + cbase + 32 + lr] = f2bf(x2 * c + x1 * s);
        }
}
template <int NTI>
__device__ __forceinline__ void epi_rope32(const f32x16 (&acc)[2][2], int row0, int lr, int lh, const float* __restrict__ rope, bf16_t* __restrict__ dst, int ld, int cbase) {
    const int f = lr & 15;
#pragma unroll
    for (int mi = 0; mi < 2; ++mi)
#pragma unroll
        for (int ni = 0; ni < NTI; ++ni)
#pragma unroll
            for (int r = 0; r < 16; ++r) {
                const size_t row = EROW(mi, r);
                const float x = acc[mi][ni][r], xo = shx<16>(x);
                const float c = rope[row * 64 + 2 * f], s = rope[row * 64 + 32 + 2 * f];
                dst[row * ld + cbase + ni * 32 + lr] = f2bf((lr & 16) ? (x * c + xo * s) : (x * c - xo * s));
            }
}
template <int NT, bool SILU>
__device__ __forceinline__ void epi_bf16(const f32x16 (&acc)[2][NT], int row0, int lr, int lh, bf16_t* __restrict__ dst, int ld, int cbase) {
#pragma unroll
    for (int mi = 0; mi < 2; ++mi)
#pragma unroll
        for (int ni = 0; ni < NT; ++ni)
#pragma unroll
            for (int r = 0; r < 16; ++r) { const float v = acc[mi][ni][r]; dst[(size_t)EROW(mi, r) * ld + cbase + ni * 32 + lr] = f2bf(SILU ? silu_(v) : v); }
}
template <int NT>
__device__ __forceinline__ void epi_vt(const f32x16 (&acc)[2][NT], int trow0, int lr, int lh, bf16_t* __restrict__ vt, size_t ldv) {
#pragma unroll
    for (int mi = 0; mi < 2; ++mi)
#pragma unroll
        for (int ni = 0; ni < NT; ++ni)
#pragma unroll
            for (int g = 0; g < 4; ++g) {
                u32x2 o; o.x = cvt_pk_bf16(acc[mi][ni][4 * g], acc[mi][ni][4 * g + 1]); o.y = cvt_pk_bf16(acc[mi][ni][4 * g + 2], acc[mi][ni][4 * g + 3]);
                *(u32x2*)(vt + (size_t)(ni * 32 + lr) * ldv + trow0 + mi * 32 + 8 * g + 4 * lh) = o;
            }
}
template <int NT>
__device__ __forceinline__ void epi_f32(const f32x16 (&acc)[2][NT], int row0, int lr, int lh, float* __restrict__ dst, int ld, int cbase) {
#pragma unroll
    for (int mi = 0; mi < 2; ++mi)
#pragma unroll
        for (int ni = 0; ni < NT; ++ni)
#pragma unroll
            for (int r = 0; r < 16; ++r) dst[(size_t)EROW(mi, r) * ld + cbase + ni * 32 + lr] = acc[mi][ni][r];
}
template <class F>
__device__ __forceinline__ void staged_bf16_tile(char* stg, bf16_t* dp, size_t ld, int lr, int lh, F val) {
    bf16_t* sg = (bf16_t*)stg;
#pragma unroll
    for (int mi = 0; mi < 2; ++mi)
#pragma unroll
        for (int r = 0; r < 16; ++r) {
            const int rl = mi * 32 + (r & 3) + 8 * (r >> 2) + 4 * lh;
            float o0, o1; val(mi, r, rl, o0, o1);
            sg[rl * 64 + ((((lr >> 3)) ^ (rl & 7)) << 3) + (lr & 7)] = f2bf(o0); sg[rl * 64 + ((((lr >> 3) + 4) ^ (rl & 7)) << 3) + (lr & 7)] = f2bf(o1);
        }
    __builtin_amdgcn_wave_barrier();
    const int lane = lh * 32 + lr;
#pragma unroll
    for (int i = 0; i < 8; ++i) {
        const int piece = lane + 64 * i, rr = piece >> 3, ch = piece & 7;
        const u32x4 v = *(const u32x4*)(sg + rr * 64 + ((ch ^ (rr & 7)) << 3));
        *(u32x4*)(dp + (size_t)rr * ld + ch * 8) = v;
    }
    __builtin_amdgcn_wave_barrier();
}
constexpr float QSCALE = 0.125f * 1.4426950408889634f;
struct EpiInProj {
    const Params& p; int layer;
    __device__ __forceinline__ void operator()(const f32x16 (&acc)[2][2], int row0, int col0, int lr, int lh, char* stg) const {
        const int b = row0 / S, t0 = row0 % S;
        const float* rope = p.ROPE();
        int kind, ld = 256, cbase = 0; size_t off = 0; bool silu = false; float osc = 1.f;
        if (col0 < M_QN)         { kind = 0; off = OFF_QA; cbase = col0 - M_QA; osc = QSCALE; }
        else if (col0 < M_KSLC)  { kind = 0; off = OFF_QN; cbase = col0 - M_QN; osc = QSCALE; }
        else if (col0 == M_KSLC) { kind = 0; off = OFF_KSLC; ld = 64; }
        else if (col0 == M_KWIN) { kind = 0; off = OFF_KWIN; ld = 64; }
        else if (col0 == M_KC)   { kind = 0; off = OFF_KCT; ld = 64; }
        else if (col0 == M_VC)   { kind = 1; off = OFF_VCTOK; ld = 64; }
        else if (col0 < M_KF)    { kind = 1; off = OFF_QF; cbase = col0 - M_QF; osc = QSCALE; }
        else if (col0 < M_QS)    { kind = 1; off = OFF_KF; cbase = col0 - M_KF; }
        else if (col0 < M_KSB)   { kind = 1; off = OFF_QS; cbase = col0 - M_QS; osc = QSCALE; }
        else if (col0 < M_QM)    { kind = 1; off = OFF_KSB; cbase = col0 - M_KSB; }
        else if (col0 < M_VF)    { kind = 1; off = OFF_QM; cbase = col0 - M_QM; osc = QSCALE; }
        else if (col0 < M_VS)    { kind = 2; off = OFF_VFT + ((size_t)(b * 4 + (col0 - M_VF) / 64) * 64) * S * 2; }
        else if (col0 < M_VSLC)  { kind = 2; off = OFF_VST + ((size_t)(b * 4 + (col0 - M_VS) / 64) * 64) * S * 2; }
        else if (col0 == M_VSLC) { kind = 2; off = OFF_VSLCT + ((size_t)b * 64) * S * 2; }
        else if (col0 == M_VWIN) { kind = 2; off = OFF_VWINT + ((size_t)b * 64) * S * 2; }
        else if (col0 < M_SPC)   { kind = 3; off = OFF_QI; ld = 128; cbase = col0 - M_QI; }
        else if (col0 == M_SPC)  { kind = 4; }
        else if (col0 < M_Z)     { kind = 5; off = OFF_CKVR; ld = 128; cbase = col0 - M_CKV; }
        else if (col0 < NPM)     { kind = 1; off = OFF_ZG; ld = 1280; cbase = col0 - M_Z; silu = true; }
        else if (col0 < M_MERGE) { return; }
        else                     { kind = 6; }
        bf16_t* dst = (bf16_t*)(p.ws + off);
        if (kind <= 3) {
            bf16_t* sg = (bf16_t*)stg;
            if (kind == 2) {
#pragma unroll
                for (int mi = 0; mi < 2; ++mi)
#pragma unroll
                    for (int ni = 0; ni < 2; ++ni)
#pragma unroll
                        for (int g = 0; g < 4; ++g) {
                            u32x2 o; o.x = cvt_pk_bf16(acc[mi][ni][4 * g], acc[mi][ni][4 * g + 1]); o.y = cvt_pk_bf16(acc[mi][ni][4 * g + 2], acc[mi][ni][4 * g + 3]);
                            const int d = ni * 32 + lr, tk = mi * 32 + 8 * g + 4 * lh;
                            *(u32x2*)(sg + d * 64 + (((tk >> 3) ^ (d & 7)) << 3) + (tk & 7)) = o;
                        }
            } else {
#pragma unroll
                for (int mi = 0; mi < 2; ++mi)
#pragma unroll
                    for (int r = 0; r < 16; ++r) {
                        const int rl = mi * 32 + (r & 3) + 8 * (r >> 2) + 4 * lh;
                        const size_t row = (size_t)row0 + rl;
                        float o0, o1;
                        if (kind == 0) {
                            const float c = rope[row * 64 + lr], s = rope[row * 64 + 32 + lr], x1 = acc[mi][0][r], x2 = acc[mi][1][r];
                            o0 = x1 * c - x2 * s; o1 = x2 * c + x1 * s;
                        } else if (kind == 3) {
                            const int f = lr & 15;
                            const float c = rope[row * 64 + 2 * f], s = rope[row * 64 + 32 + 2 * f];
                            const float x0 = acc[mi][0][r], x1 = acc[mi][1][r], y0 = shx<16>(x0), y1 = shx<16>(x1);
                            o0 = (lr & 16) ? (x0 * c + y0 * s) : (x0 * c - y0 * s); o1 = (lr & 16) ? (x1 * c + y1 * s) : (x1 * c - y1 * s);
                        } else {
                            o0 = acc[mi][0][r]; o1 = acc[mi][1][r];
                            if (silu) { o0 = silu_(o0); o1 = silu_(o1); }
                        }
                        sg[rl * 64 + ((((lr >> 3)) ^ (rl & 7)) << 3) + (lr & 7)] = f2bf(o0 * osc); sg[rl * 64 + ((((lr >> 3) + 4) ^ (rl & 7)) << 3) + (lr & 7)] = f2bf(o1 * osc);
                        if ((r & 3) == 3) __builtin_amdgcn_sched_barrier(0);
                    }
            }
            __builtin_amdgcn_wave_barrier();
            const size_t ldd = (kind == 2) ? (size_t)S : (size_t)ld;
            bf16_t* dp = (kind == 2) ? (dst + t0) : (dst + (size_t)row0 * ld + cbase);
            const int lane = lh * 32 + lr;
#pragma unroll
            for (int i = 0; i < 8; ++i) {
                const int piece = lane + 64 * i, rr = piece >> 3, ch = piece & 7;
                const u32x4 v = *(const u32x4*)(sg + rr * 64 + ((ch ^ (rr & 7)) << 3));
                *(u32x4*)(dp + (size_t)rr * ldd + ch * 8) = v;
            }
            __builtin_amdgcn_wave_barrier();
        }
        else if (kind == 5) epi_f32<2>(acc, row0, lr, lh, (float*)dst, ld, cbase);
        else if (kind == 6) {
            const int tile = (row0 >> 7) * 40 + ((col0 - M_MERGE) >> 7), wave = ((row0 >> 6) & 1) * 2 + ((col0 >> 6) & 1);
            unsigned char* sp = (unsigned char*)p.SIG() + ((size_t)(tile * 4 + wave) * 4) * 1024 + (size_t)(lh * 32 + lr) * 16;
#define SIGQ(x_) floorf(fmaf(sigmoid_(x_), 255.f, 0.5f))
#pragma unroll
            for (int mi = 0; mi < 2; ++mi)
#pragma unroll
                for (int ni = 0; ni < 2; ++ni) {
                    unsigned wq[4];
#pragma unroll
                    for (int g = 0; g < 4; ++g) {
                        unsigned w = __builtin_amdgcn_cvt_pk_u8_f32(SIGQ(acc[mi][ni][4 * g]), 0, 0u);
                        w = __builtin_amdgcn_cvt_pk_u8_f32(SIGQ(acc[mi][ni][4 * g + 1]), 1, w);
                        w = __builtin_amdgcn_cvt_pk_u8_f32(SIGQ(acc[mi][ni][4 * g + 2]), 2, w);
                        w = __builtin_amdgcn_cvt_pk_u8_f32(SIGQ(acc[mi][ni][4 * g + 3]), 3, w);
                        wq[g] = w;
                    }
                    *(u32x4*)(sp + (size_t)(mi * 2 + ni) * 1024) = u32x4{wq[0], wq[1], wq[2], wq[3]};
                }
#undef SIGQ
        }
        else {
            epi_rope32<1>(acc, row0, lr, lh, rope, p.KI(), 32, 0);
            const float fb = p.fox_bias[layer * 4 + (lr & 3)];
            float* sbase = (lr < 4) ? (p.WI() + lr) : (lr < 8) ? (p.LOGF() + (lr - 4)) : (p.GN() + (lr - 8));
            const int sstride = (lr < 8) ? 4 : 12;
#pragma unroll
            for (int mi = 0; mi < 2; ++mi)
#pragma unroll
                for (int r = 0; r < 16; ++r) {
                    const size_t row = EROW(mi, r); const float v = acc[mi][1][r];
                    const float u = (lr < 8) ? (v + fb) : v;
                    const float e = __builtin_amdgcn_exp2f(-1.4426950408889634f * fabsf(u));
                    const float lsg = fminf(u, 0.f) - __builtin_amdgcn_logf(1.f + e) * 0.6931471805599453f;
                    const float sg = ((u >= 0.f) ? 1.f : e) * __builtin_amdgcn_rcpf(1.f + e);
                    const float o = (lr < 4) ? v * 0.08838834764831845f : ((lr < 8) ? lsg : sg);
                    if (lr < 20) sbase[row * sstride] = o;
                }
        }
    }
};
struct EpiMemKV {
    const Params& p;
    __device__ __forceinline__ void operator()(const f32x16 (&acc)[2][2], int row0, int col0, int lr, int lh, char* stg) const {
        if (col0 < 256) epi_bf16<2, false>(acc, row0, lr, lh, p.MKB(), 256, col0);
        else epi_vt<2>(acc, row0 % NMEM, lr, lh, p.MVT() + ((size_t)((row0 / NMEM) * 4 + (col0 - 256) / 64) * 64) * NMEM, NMEM);
    }
};
struct EpiKA { const Params& p;
    __device__ __forceinline__ void operator()(const f32x16 (&acc)[2][2], int row0, int col0, int lr, int lh, char* stg) const {
        const float* rope = p.ROPE();
        staged_bf16_tile(stg, p.KAB() + (size_t)row0 * 256 + col0, 256, lr, lh, [&](int mi, int r, int rl, float& o0, float& o1) {
            const size_t row = (size_t)row0 + rl;
            const float c = rope[row * 64 + lr], sn = rope[row * 64 + 32 + lr], x1 = acc[mi][0][r], x2 = acc[mi][1][r];
            o0 = x1 * c - x2 * sn; o1 = x2 * c + x1 * sn; });
    } };
struct EpiVA { const Params& p;
    __device__ __forceinline__ void operator()(const f32x16 (&acc)[2][2], int row0, int col0, int lr, int lh, char* stg) const {
        epi_vt<2>(acc, row0 % S, lr, lh, p.VAT() + ((size_t)((row0 / S) * 4 + col0 / 64) * 64) * S, S); } };
struct EpiResid { const float* Xin; float* Xout;
    __device__ __forceinline__ void operator()(const f32x16 (&acc)[2][2], int row0, int col0, int lr, int lh, char* stg) const {
#pragma unroll
        for (int mi = 0; mi < 2; ++mi) {
            float xv[2][16];
#pragma unroll
            for (int ni = 0; ni < 2; ++ni)
#pragma unroll
                for (int r = 0; r < 16; ++r) xv[ni][r] = Xin[(size_t)EROW(mi, r) * D + col0 + ni * 32 + lr];
#pragma unroll
            for (int ni = 0; ni < 2; ++ni)
#pragma unroll
                for (int r = 0; r < 16; ++r) Xout[(size_t)EROW(mi, r) * D + col0 + ni * 32 + lr] = xv[ni][r] + acc[mi][ni][r];
        }
    } };
struct EpiCmp1 { const float* bias; bf16_t* hid;
    __device__ __forceinline__ void operator()(const f32x16 (&acc)[2][2], int row0, int col0, int lr, int lh, char* stg) const {
#pragma unroll
        for (int ni = 0; ni < 2; ++ni) {
            const float bv = bias[col0 + ni * 32 + lr];
#pragma unroll
            for (int mi = 0; mi < 2; ++mi)
#pragma unroll
                for (int r = 0; r < 16; ++r) hid[(size_t)EROW(mi, r) * 128 + col0 + ni * 32 + lr] = f2bf(silu_(acc[mi][ni][r] + bv));
        }
    } };
struct EpiCmp2K { bf16_t* kcb;
    __device__ __forceinline__ void operator()(const f32x16 (&acc)[2][1], int row0, int col0, int lr, int lh, char* stg) const {
#pragma unroll
        for (int mi = 0; mi < 2; ++mi)
#pragma unroll
            for (int r = 0; r < 16; ++r) { const int row = EROW(mi, r); kcb[(size_t)row * 64 + col0 + lr] = ((row & 511) == 511) ? (bf16_t)0 : f2bf(acc[mi][0][r]); }
    } };
struct EpiCmp2V { bf16_t* vct;
    __device__ __forceinline__ void operator()(const f32x16 (&acc)[2][1], int row0, int col0, int lr, int lh, char* stg) const {
        bf16_t* base = vct + ((size_t)(row0 / 512) * 64 + col0) * 512;
        const int n0 = row0 % 512;
#pragma unroll
        for (int mi = 0; mi < 2; ++mi)
#pragma unroll
            for (int g = 0; g < 4; ++g) {
                const int n = n0 + mi * 32 + 8 * g + 4 * lh;
                u32x2 o; o.x = cvt_pk_bf16(acc[mi][0][4 * g], acc[mi][0][4 * g + 1]); o.y = cvt_pk_bf16(acc[mi][0][4 * g + 2], (n + 3 == 511) ? 0.f : acc[mi][0][4 * g + 3]);
                *(u32x2*)(base + (size_t)lr * 512 + n) = o;
            }
    } };

__device__ __forceinline__ void ph_merge(const Params& p, int layer, int bid, int nb, char* sm) {
    const int lane = tidx() & 63, wid = __builtin_amdgcn_readfirstlane(tidx() >> 6), wr = wid >> 1, wc = wid & 1, lr = lane & 31, lh = lane >> 5;
    for (int tile = bid; tile < (T / 128) * (D / 128); tile += nb) {
        const int mt = tile % (T / 128), nt = tile / (T / 128), m0 = mt * 128, n0 = nt * 128;
        f32x16 mg[2][2]; acc_zero<2>(mg);
#pragma unroll 1
        for (int n = 0; n < 5; ++n) {
            f32x16 g[2][2]; acc_zero<2>(g);
            const unsigned char* sp = (const unsigned char*)p.SIG() + ((size_t)((mt * 40 + n * 8 + nt) * 4 + wid) * 4) * 1024 + (size_t)lane * 16;
            u32x4 sgw[4];
#pragma unroll
            for (int i = 0; i < 4; ++i) sgw[i] = *(const u32x4*)(sp + (size_t)i * 1024);
            tile_mac_dma64(g, p.Y() + n * 256, 1280, m0, p.WBR() + ((size_t)layer * 5 + n) * D * 256, 256, n0, 256, sm);
#pragma unroll
            for (int mi = 0; mi < 2; ++mi)
#pragma unroll
                for (int ni = 0; ni < 2; ++ni) {
                    const u32x4 w = sgw[mi * 2 + ni];
                    const unsigned sw[4] = {w.x, w.y, w.z, w.w};
#pragma unroll
                    for (int q = 0; q < 4; ++q) {
                        mg[mi][ni][4 * q] = fmaf((float)(sw[q] & 255u), g[mi][ni][4 * q], mg[mi][ni][4 * q]);
                        mg[mi][ni][4 * q + 1] = fmaf((float)((sw[q] >> 8) & 255u), g[mi][ni][4 * q + 1], mg[mi][ni][4 * q + 1]);
                        mg[mi][ni][4 * q + 2] = fmaf((float)((sw[q] >> 16) & 255u), g[mi][ni][4 * q + 2], mg[mi][ni][4 * q + 2]);
                        mg[mi][ni][4 * q + 3] = fmaf((float)(sw[q] >> 24), g[mi][ni][4 * q + 3], mg[mi][ni][4 * q + 3]);
                    }
                }
        }
        __syncthreads();
        staged_bf16_tile(sm + wid * 8192, p.MG() + (size_t)(m0 + wr * 64) * D + n0 + wc * 64, D, lr, lh,
                         [&](int mi, int r, int, float& o0, float& o1) { o0 = mg[mi][0][r] * (1.f / 255.f); o1 = mg[mi][1][r] * (1.f / 255.f); });
    }
}

__device__ __forceinline__ void ph_cumsum(const Params& p, int bid, int nb, float* sm) {
    const int tid = tidx();
    float* buf = sm;
    float* ps = sm + 8192 + 256;
    for (int u = bid; u < NBATCH * 4; u += nb) {
        const int b = u >> 2, h = u & 3;
        const float4* src4 = (const float4*)(p.LOGF() + (size_t)b * S * 4);
        __syncthreads();
#pragma unroll 8
        for (int i = 0; i < 32; ++i) {
            const int tok = i * 256 + tid;
            const float4 v = src4[tok];
            buf[tok + (tok >> 5)] = (h == 0) ? v.x : (h == 1) ? v.y : (h == 2) ? v.z : v.w;
        }
        __syncthreads();
        float run = 0.f;
#pragma unroll 8
        for (int j = 0; j < 32; ++j) { run += buf[tid * 33 + j]; buf[tid * 33 + j] = run; }
        ps[tid] = run;
        __syncthreads();
        for (int off = 1; off < 256; off <<= 1) {
            float t = 0.f;
            if (tid >= off) t = ps[tid - off];
            __syncthreads();
            ps[tid] += t;
            __syncthreads();
        }
        const float pre = (tid > 0) ? ps[tid - 1] : 0.f;
#pragma unroll 8
        for (int j = 0; j < 32; ++j) buf[tid * 33 + j] = (buf[tid * 33 + j] + pre) * 1.4426950408889634f;
        __syncthreads();
        float* dst = p.CUMT() + (size_t)u * S;
#pragma unroll 8
        for (int i = 0; i < 32; ++i) { const int tok = i * 256 + tid; dst[tok] = buf[tok + (tok >> 5)]; }
    }
    __syncthreads();
}

enum { AM_FOX = 0, AM_DSA = 1, AM_SLC = 2, AM_SB = 3, AM_WIN = 4, AM_MEM = 5, AM_CMP = 6 };
constexpr int AK_ROW = 144;
constexpr int AK_TILE = 64 * AK_ROW;
constexpr int ABUF = 2 * AK_TILE + 256;
constexpr int ATT_NST = 3, ATT_STAGE = 16384 + 1024;
constexpr float LOG2E = 1.4426950408889634f;
#define NEG_INF (-__builtin_inff())

template <int MODE>
__device__ __forceinline__ void attn_core(const Params& p, int b, int head, int qblk, char* sm, f32x16 (&O)[2], float& inv) {
    const int tid = tidx(), lane = tid & 63, wid = __builtin_amdgcn_readfirstlane(tid >> 6), lr = lane & 31, lh = lane >> 5;
    const int q0 = qblk * 128, qw0 = q0 + 32 * wid, tq = qw0 + lr;
    const size_t gq = (size_t)b * S + tq;
    const bf16_t *Qp, *Kp, *VTp; int ldk, ldv;
    if (MODE == AM_FOX)      { Qp = p.QF() + gq * 256 + head * 64; Kp = p.KF() + (size_t)b * S * 256 + head * 64; ldk = 256; VTp = p.VFT() + ((size_t)(b * 4 + head) * 64) * S; ldv = S; }
    else if (MODE == AM_DSA) { Qp = p.QA() + gq * 256 + head * 64; Kp = p.KAB() + (size_t)b * S * 256 + head * 64; ldk = 256; VTp = p.VAT() + ((size_t)(b * 4 + head) * 64) * S; ldv = S; }
    else if (MODE == AM_SB)  { Qp = p.QS() + gq * 256 + head * 64; Kp = p.KSB() + (size_t)b * S * 256 + head * 64; ldk = 256; VTp = p.VST() + ((size_t)(b * 4 + head) * 64) * S; ldv = S; }
    else if (MODE == AM_SLC) { Qp = p.QN() + gq * 256 + head * 64; Kp = p.KSLC() + (size_t)b * S * 64; ldk = 64; VTp = p.VSLCT() + ((size_t)b * 64) * S; ldv = S; }
    else if (MODE == AM_WIN) { Qp = p.QN() + gq * 256 + head * 64; Kp = p.KWIN() + (size_t)b * S * 64; ldk = 64; VTp = p.VWINT() + ((size_t)b * 64) * S; ldv = S; }
    else if (MODE == AM_CMP) { Qp = p.QN() + gq * 256 + head * 64; Kp = p.KCB() + (size_t)b * NCMP_PAD * 64; ldk = 64; VTp = p.VCT() + ((size_t)b * 64) * NCMP_PAD; ldv = NCMP_PAD; }
    else                     { Qp = p.QM() + gq * 256 + head * 64; Kp = p.MKB() + (size_t)b * NMEM * 256 + head * 64; ldk = 256; VTp = p.MVT() + ((size_t)(b * 4 + head) * 64) * NMEM; ldv = NMEM; }
    int kt_lo = 0, kt_hi = 2 * qblk + 2;
    if (MODE == AM_WIN) kt_lo = q0 >= 512 ? (q0 - 512) / 64 : 0;
    if (MODE == AM_MEM) kt_hi = NMEM / 64;
    if (MODE == AM_CMP) kt_hi = min(8, (((q0 + 96) >> 4) >> 6) + 1);
    const int nlim = (tq - 31) >> 4;
    const int ntile = kt_hi - kt_lo;
    constexpr bool REV = (MODE == AM_SB);

    bf16x8 qf[4];
#pragma unroll
    for (int s = 0; s < 4; ++s) qf[s] = *(const bf16x8*)(Qp + 16 * s + 8 * lh);
    unsigned smw[4] = {0u, 0u, 0u, 0u};
    if (MODE == AM_SLC) { const u32x4 w = *(const u32x4*)(p.SMASK() + gq * 4); smw[0] = w.x; smw[1] = w.y; smw[2] = w.z; smw[3] = w.w; }
    const unsigned* mrow32 = p.DMASK() + ((size_t)b * 128 * S + qw0) * 2;
    const float* csp = p.CUMT() + (size_t)(b * 4 + head) * S;

    const int srow = tid >> 3, schunk = (tid & 7) ^ ((srow >> 1) & 7);
    const bf16_t* kg0 = Kp + (size_t)srow * ldk + schunk * 8;
    const bf16_t* vg0 = VTp + (size_t)srow * ldv + schunk * 8;
    const int ldst = tid * 16;
    auto issue = [&](int kt, int slot) {
        char* st = sm + slot * ATT_STAGE + ldst;
        const bf16_t* kgp = kg0 + (size_t)kt * 64 * ldk;
        const bf16_t* vgp = vg0 + kt * 64;
        __builtin_amdgcn_global_load_lds((const unsigned*)kgp, (unsigned*)st, 16, 0, 0);
        __builtin_amdgcn_global_load_lds((const unsigned*)(kgp + (size_t)32 * ldk), (unsigned*)(st + 4096), 16, 0, 0);
        __builtin_amdgcn_global_load_lds((const unsigned*)vgp, (unsigned*)(st + 8192), 16, 0, 0);
        __builtin_amdgcn_global_load_lds((const unsigned*)(vgp + (size_t)32 * ldv), (unsigned*)(st + 12288), 16, 0, 0);
        if (MODE == AM_FOX) __builtin_amdgcn_global_load_lds((const unsigned*)(csp + kt * 64 + lane), (unsigned*)(sm + slot * ATT_STAGE + 16384 + tid * 4), 4, 0, 0);
        if (MODE == AM_DSA) __builtin_amdgcn_global_load_lds((const unsigned*)(mrow32 + (size_t)kt * S * 2 + lane), (unsigned*)(sm + slot * ATT_STAGE + 16384 + tid * 4), 4, 0, 0);
    };
    const int pil = (lr & 0x13) | ((lr & 4) << 1) | ((lr & 8) >> 1);
    const int ksw = (pil >> 1) & 7, vsw = (lr >> 1) & 7;
    int rdk[4], rdv[4];
#pragma unroll
    for (int j = 0; j < 4; ++j) { rdk[j] = pil * 128 + (((2 * j + lh) ^ ksw) << 4); rdv[j] = 8192 + lr * 128 + (((2 * j + lh) ^ vsw) << 4); }

    float m = NEG_INF, l = 0.f, R = 1.f;
#pragma unroll
    for (int i = 0; i < 16; ++i) { O[0][i] = 0.f; O[1][i] = 0.f; }

    static_assert(ATT_NST == 3, "the vmcnt arithmetic below is written for a 3-stage ring");
    __syncthreads();
    auto tile_of = [&](int it) { const int c = min(it, ntile - 1); return REV ? kt_hi - 1 - c : kt_lo + c; };
    issue(tile_of(0), 0);
    issue(tile_of(1), 1);
    int slot = 0, nslot = ATT_NST - 1;
#pragma unroll 1
    for (int it = 0; it < ntile; ++it) {
        const int kt = REV ? kt_hi - 1 - it : kt_lo + it;
        constexpr int NPER = (MODE == AM_FOX || MODE == AM_DSA) ? 5 : 4;
        if (NPER == 5) DMA_WAIT(5); else DMA_WAIT(4);
        __builtin_amdgcn_s_barrier();
        const char* cur = sm + slot * ATT_STAGE;
        unsigned long long mw = 0ull;
        if (MODE == AM_DSA) mw = *(const unsigned long long*)(cur + 16384 + wid * 256 + lr * 8);
        issue(tile_of(it + ATT_NST - 1), nslot);
        slot = (slot + 1 == ATT_NST) ? 0 : slot + 1; nslot = (nslot + 1 == ATT_NST) ? 0 : nslot + 1;
        bool need = true;
        if (MODE == AM_CMP) need = kt * 64 <= (qw0 >> 4);
        else if (MODE != AM_MEM) need = kt * 64 <= qw0 + 31;
        if (MODE == AM_WIN) need = need && (kt * 64 + 63 >= qw0 - 511);
        if (need) {
            f32x16 sv[2];
#pragma unroll
            for (int sub = 0; sub < 2; ++sub) {
                f32x16 a;
#pragma unroll
                for (int i = 0; i < 16; ++i) a[i] = 0.f;
#pragma unroll
                for (int s4 = 0; s4 < 4; ++s4) {
                    const bf16x8 kf = *(const bf16x8*)(cur + rdk[s4] + sub * 4096);
                    a = __builtin_amdgcn_mfma_f32_32x32x16_bf16(kf, qf[s4], a, 0, 0, 0);
                }
                sv[sub] = a;
            }
            if (MODE == AM_SB) {
#pragma unroll
                for (int sb2 = 0; sb2 < 2; ++sb2) {
                    const int sub = 1 - sb2;
                    {
                        f32x16& s = sv[sub];
                        const int thl = tq - (kt * 64 + sub * 32) - 8 * lh;
                        f32x2 kp[8], sg[8];
                        const bool dgl = (kt * 64 + sub * 32 + 31) >= qw0;
                        const f32x2 one2 = {1.f, 1.f};
#pragma unroll
                        for (int r = 0; r < 8; ++r) {
                            const float z0 = __builtin_amdgcn_fmed3f(s[r], -64.f, 64.f), z1 = __builtin_amdgcn_fmed3f(s[r + 8], -64.f, 64.f);
                            f32x2 e = {__builtin_amdgcn_exp2f(-z0), __builtin_amdgcn_exp2f(-z1)};
                            const f32x2 d = e + one2;
                            const f32x2 rc = {__builtin_amdgcn_rcpf(d.x), __builtin_amdgcn_rcpf(d.y)};
                            kp[r] = e * rc; sg[r] = rc;
                        }
                        if (dgl) {
#pragma unroll
                            for (int r = 0; r < 8; ++r) {
                                const bool ok0 = r < thl, ok1 = (r + 16) < thl;
                                kp[r].x = ok0 ? kp[r].x : 1.f; sg[r].x = ok0 ? sg[r].x : 0.f;
                                kp[r].y = ok1 ? kp[r].y : 1.f; sg[r].y = ok1 ? sg[r].y : 0.f;
                            }
                        }
                        const f32x2 g2 = ((kp[0] * kp[1]) * (kp[2] * kp[3])) * ((kp[4] * kp[5]) * (kp[6] * kp[7]));
                        float gA, gB, gC, gD;
                        half_pair(g2.x, gA, gB); half_pair(g2.y, gC, gD);
                        f32x2 run = {R * ((gC * gD) * (lh == 0 ? gB : 1.f)), R * (lh == 0 ? gD : 1.f)};
#pragma unroll
                        for (int r = 7; r >= 0; --r) {
                            const f32x2 w = sg[r] * run; run *= kp[r];
                            s[r] = w.x; s[8 + r] = w.y;
                        }
                        R *= (gA * gB) * (gC * gD);
                    }
                }
            } else {
#pragma unroll
                for (int sub = 0; sub < 2; ++sub) {
                    f32x16& s = sv[sub];
                    const int kb = kt * 64 + sub * 32;
                    const int thl = tq - kb - 8 * lh;
                    {
                        if (MODE == AM_FOX) {
                            const float4* cs4 = (const float4*)(cur + 16384 + wid * 256 + (sub * 32 + 8 * lh) * 4);
                            const float4 c0 = cs4[0], c1 = cs4[1], c2 = cs4[4], c3 = cs4[5];
                            const float cv[16] = {c0.x, c0.y, c0.z, c0.w, c1.x, c1.y, c1.z, c1.w, c2.x, c2.y, c2.z, c2.w, c3.x, c3.y, c3.z, c3.w};
#pragma unroll
                            for (int r = 0; r < 16; ++r) s[r] -= cv[r];
                        }
                        if (MODE == AM_DSA) {
                            const unsigned w = (unsigned)(mw >> (32 * sub)) >> (8 * lh);
#pragma unroll
                            for (int r = 0; r < 16; ++r) {
                                const int cr = 16 * (r >> 3) + (r & 7);
                                const unsigned mk = (unsigned)__builtin_amdgcn_sbfe((int)w, cr, 1);
                                s[r] = __uint_as_float(__builtin_amdgcn_bitop3_b32(mk, __float_as_uint(s[r]), 0xff800000u, 0xCA));
                            }
                        }
                        if (MODE == AM_SLC) {
                            const unsigned w = smw[0] * (kt < 32) + smw[1] * (kt >= 32 && kt < 64) + smw[2] * (kt >= 64 && kt < 96) + smw[3] * (kt >= 96);
                            const bool sel = (w >> (kt & 31)) & 1u;
#pragma unroll
                            for (int r = 0; r < 16; ++r) s[r] = sel ? s[r] : NEG_INF;
                        }
                        if (MODE == AM_FOX || MODE == AM_SLC) {
                            if (kb + 31 > qw0) {
#pragma unroll
                                for (int r = 0; r < 16; ++r) { const int cr = 16 * (r >> 3) + (r & 7); s[r] = (cr <= thl) ? s[r] : NEG_INF; }
                            }
                        }
                        if (MODE == AM_CMP) {
                            const int tc = nlim - kb - 8 * lh;
#pragma unroll
                            for (int r = 0; r < 16; ++r) { const int cr = 16 * (r >> 3) + (r & 7); s[r] = (cr <= tc) ? s[r] : NEG_INF; }
                        }
                        if (MODE == AM_WIN) {
                            if (kb + 31 > qw0 || kb < qw0 + 31 - 511) {
#pragma unroll
                                for (int r = 0; r < 16; ++r) { const int cr = 16 * (r >> 3) + (r & 7); s[r] = (cr <= thl && cr > thl - 512) ? s[r] : NEG_INF; }
                            }
                        }
                    }
                }
                constexpr bool RAW = (MODE == AM_MEM || MODE == AM_WIN);
                float tmax;
#define MAX3_8 "v_max3_f32 %0, %0, %1, %2\n\tv_max3_f32 %0, %0, %3, %4\n\tv_max3_f32 %0, %0, %5, %6\n\tv_max3_f32 %0, %0, %7, %8\n\tv_max3_f32 %0, %0, %9, %10\n\tv_max3_f32 %0, %0, %11, %12\n\tv_max3_f32 %0, %0, %13, %14\n\tv_max3_f32 %0, %0, %15, %16"
                tmax = m;
                if (RAW) asm("s_nop 15\n\ts_nop 7\n\t" MAX3_8 : "+v"(tmax) : "v"(sv[0][0]), "v"(sv[1][0]), "v"(sv[0][1]), "v"(sv[1][1]), "v"(sv[0][2]), "v"(sv[1][2]), "v"(sv[0][3]), "v"(sv[1][3]),
                                  "v"(sv[0][4]), "v"(sv[1][4]), "v"(sv[0][5]), "v"(sv[1][5]), "v"(sv[0][6]), "v"(sv[1][6]), "v"(sv[0][7]), "v"(sv[1][7]));
                else asm(MAX3_8 : "+v"(tmax) : "v"(sv[0][0]), "v"(sv[1][0]), "v"(sv[0][1]), "v"(sv[1][1]), "v"(sv[0][2]), "v"(sv[1][2]), "v"(sv[0][3]), "v"(sv[1][3]),
                                  "v"(sv[0][4]), "v"(sv[1][4]), "v"(sv[0][5]), "v"(sv[1][5]), "v"(sv[0][6]), "v"(sv[1][6]), "v"(sv[0][7]), "v"(sv[1][7]));
                asm(MAX3_8 : "+v"(tmax) : "v"(sv[0][8]), "v"(sv[1][8]), "v"(sv[0][9]), "v"(sv[1][9]), "v"(sv[0][10]), "v"(sv[1][10]), "v"(sv[0][11]), "v"(sv[1][11]),
                                  "v"(sv[0][12]), "v"(sv[1][12]), "v"(sv[0][13]), "v"(sv[1][13]), "v"(sv[0][14]), "v"(sv[1][14]), "v"(sv[0][15]), "v"(sv[1][15]));
#undef MAX3_8
                tmax = fmaxf(tmax, m);
                const float mn = half_max(tmax);
                const float mu = (mn == NEG_INF) ? 0.f : mn;
                const float corr = __builtin_amdgcn_exp2f(m - mu);
                m = mn;
                const f32x2 mu2 = {mu, mu};
                f32x2 lsa = {0.f, 0.f}, lsb = {0.f, 0.f};
#pragma unroll
                for (int i = 0; i < 8; ++i) {
                    f32x2 a = {sv[0][2 * i], sv[0][2 * i + 1]}, c = {sv[1][2 * i], sv[1][2 * i + 1]};
                    a -= mu2; c -= mu2;
                    a.x = __builtin_amdgcn_exp2f(a.x); a.y = __builtin_amdgcn_exp2f(a.y); c.x = __builtin_amdgcn_exp2f(c.x); c.y = __builtin_amdgcn_exp2f(c.y);
                    sv[0][2 * i] = a.x; sv[0][2 * i + 1] = a.y; sv[1][2 * i] = c.x; sv[1][2 * i + 1] = c.y;
                    lsa += a; lsb += c;
                }
                lsa += lsb;
                l = l * corr + (lsa.x + lsa.y);
                if (!__all(corr == 1.0f)) {
#pragma unroll
                    for (int i = 0; i < 16; ++i) { O[0][i] *= corr; O[1][i] *= corr; }
                }
            }
#pragma unroll
            for (int sub = 0; sub < 2; ++sub) {
                {
                    const f32x16& s = sv[sub];
                    u32x4 w0, w1;
                    w0.x = cvt_pk_bf16(s[0], s[1]); w0.y = cvt_pk_bf16(s[2], s[3]); w0.z = cvt_pk_bf16(s[4], s[5]); w0.w = cvt_pk_bf16(s[6], s[7]);
                    w1.x = cvt_pk_bf16(s[8], s[9]); w1.y = cvt_pk_bf16(s[10], s[11]); w1.z = cvt_pk_bf16(s[12], s[13]); w1.w = cvt_pk_bf16(s[14], s[15]);
                    const bf16x8 pf0 = __builtin_bit_cast(bf16x8, w0), pf1 = __builtin_bit_cast(bf16x8, w1);
#pragma unroll
                    for (int dt = 0; dt < 2; ++dt) {
                        const bf16x8 vf0 = *(const bf16x8*)(cur + rdv[sub * 2] + dt * 4096);
                        const bf16x8 vf1 = *(const bf16x8*)(cur + rdv[sub * 2 + 1] + dt * 4096);
                        O[dt] = __builtin_amdgcn_mfma_f32_32x32x16_bf16(vf0, pf0, O[dt], 0, 0, 0);
                        O[dt] = __builtin_amdgcn_mfma_f32_32x32x16_bf16(vf1, pf1, O[dt], 0, 0, 0);
                    }
                }
            }
        }
    }
    DMA_WAIT(0);
    inv = 1.f;
    if (MODE != AM_SB) { const float lt = half_sum(l); inv = 1.f / fmaxf(lt, 1e-30f); }
}
__device__ __forceinline__ void attn_store_gated(const Params& p, int b, int head, int qblk, int yc, const f32x16 (&O)[2], float scale) {
    const int tid = tidx(), lane = tid & 63, wid = __builtin_amdgcn_readfirstlane(tid >> 6), lr = lane & 31, lh = lane >> 5;
    const size_t gq = (size_t)b * S + qblk * 128 + 32 * wid + lr;
    const bf16_t* zp = p.ZG() + gq * 1280 + yc + head * 64;
    bf16_t* dst = p.Y() + gq * 1280 + yc + head * 64;
#pragma unroll
    for (int dt = 0; dt < 2; ++dt)
#pragma unroll
        for (int g = 0; g < 4; ++g) {
            const int d0 = 32 * dt + 8 * g + 4 * lh;
            const u32x2 z = *(const u32x2*)(zp + d0);
            u32x2 o;
            o.x = cvt_pk_bf16(O[dt][4 * g] * scale * __uint_as_float(z.x << 16), O[dt][4 * g + 1] * scale * __uint_as_float(z.x & 0xffff0000u));
            o.y = cvt_pk_bf16(O[dt][4 * g + 2] * scale * __uint_as_float(z.y << 16), O[dt][4 * g + 3] * scale * __uint_as_float(z.y & 0xffff0000u));
            *(u32x2*)(dst + d0) = o;
        }
}
template <int MODE>
__device__ __forceinline__ void attn_unit(const Params& p, int b, int head, int qblk, char* sm) {
    f32x16 O[2]; float inv;
    attn_core<MODE>(p, b, head, qblk, sm, O, inv);
    attn_store_gated(p, b, head, qblk, MODE == AM_FOX ? 256 : MODE == AM_DSA ? 0 : MODE == AM_SB ? 512 : 1024, O, inv);
}
__device__ __forceinline__ void nsa_unit(const Params& p, int b, int head, int qblk, char* sm) {
    const int tid = tidx(), wid = __builtin_amdgcn_readfirstlane(tid >> 6), lr = tid & 31;
    const size_t gq = (size_t)b * S + qblk * 128 + 32 * wid + lr;
    const float g0 = p.GN()[gq * 12 + head], g1 = p.GN()[gq * 12 + 4 + head], g2 = p.GN()[gq * 12 + 8 + head];
    f32x16 Y[2], O[2]; float inv;
    attn_core<AM_CMP>(p, b, head, qblk, sm, O, inv);
    { const float s = g0 * inv;
#pragma unroll
      for (int i = 0; i < 16; ++i) { Y[0][i] = O[0][i] * s; Y[1][i] = O[1][i] * s; } }
    attn_core<AM_WIN>(p, b, head, qblk, sm, O, inv);
    { const float s = g2 * inv;
#pragma unroll
      for (int i = 0; i < 16; ++i) { Y[0][i] = fmaf(O[0][i], s, Y[0][i]); Y[1][i] = fmaf(O[1][i], s, Y[1][i]); } }
    attn_core<AM_SLC>(p, b, head, qblk, sm, O, inv);
    { const float s = g1 * inv;
#pragma unroll
      for (int i = 0; i < 16; ++i) { Y[0][i] = fmaf(O[0][i], s, Y[0][i]); Y[1][i] = fmaf(O[1][i], s, Y[1][i]); } }
    attn_store_gated(p, b, head, qblk, 768, Y, 1.f);
}

__device__ __forceinline__ unsigned sortable_key(float x) { const unsigned u = __float_as_uint(x); return u ^ ((unsigned)((int)u >> 31) | 0x80000000u); }
#ifndef DIAG
#define DIAG 0
#endif
#if DIAG
#define UNIT_ATTR
#else
#define UNIT_ATTR
#endif
UNIT_ATTR __device__ __forceinline__ void dsa_select_unit(const Params& p, int b, int qt, char* sm) {
    const int tid = tidx(), lane = tid & 63, wid = __builtin_amdgcn_readfirstlane(tid >> 6), lr = lane & 31, lh = lane >> 5;
    unsigned* hist = (unsigned*)sm;
    unsigned* st_prefix = (unsigned*)(sm + 32 * 257 * 4);
    int* st_krem = (int*)(st_prefix + 32);
    int* st_part = st_krem + 32;
    const int q0 = qt * 32, tq = q0 + lr, ntile = qt + 1, lrh = lr - 4 * lh;
    const size_t gq = (size_t)b * S + tq;
    bf16x8 qf[4][2];
    float w[4];
#pragma unroll
    for (int h = 0; h < 4; ++h) {
        qf[h][0] = *(const bf16x8*)(p.QI() + gq * 128 + h * 32 + 8 * lh);
        qf[h][1] = *(const bf16x8*)(p.QI() + gq * 128 + h * 32 + 16 + 8 * lh);
        w[h] = p.WI()[gq * 4 + h];
    }
    const bf16_t* kbase = p.KI() + (size_t)b * S * 32 + (size_t)lr * 32 + 8 * lh;
    auto score_tile = [&](const bf16x8& k0, const bf16x8& k1, unsigned (&key)[16]) {
        float sc[16];
#pragma unroll
        for (int r = 0; r < 16; ++r) sc[r] = 0.f;
#pragma unroll
        for (int h = 0; h < 4; ++h) {
            f32x16 a;
#pragma unroll
            for (int r = 0; r < 16; ++r) a[r] = 0.f;
            a = __builtin_amdgcn_mfma_f32_32x32x16_bf16(k0, qf[h][0], a, 0, 0, 0);
            a = __builtin_amdgcn_mfma_f32_32x32x16_bf16(k1, qf[h][1], a, 0, 0, 0);
#pragma unroll
            for (int r = 0; r < 16; ++r) sc[r] = fmaf(__int_as_float(max(__float_as_int(a[r]), 0)), w[h], sc[r]);
        }
#pragma unroll
        for (int r = 0; r < 16; ++r) key[r] = sortable_key(sc[r]);
    };
#define KLOAD(kt_, a_, b_) { const bf16_t* kp_ = kbase + (size_t)min((kt_), qt) * (32 * 32); a_ = *(const bf16x8*)kp_; b_ = *(const bf16x8*)(kp_ + 16); }
    auto tie_fix = [&](int allow_total) {
        const unsigned* tiew = hist;
        const int q = tid >> 3, part = tid & 7;
        const unsigned* tr = tiew + q * 257 + part * 32;
        int c = 0;
#pragma unroll 8
        for (int i = 0; i < 32; ++i) c += __builtin_popcount(tr[i]);
        st_part[q * 8 + part] = c;
        __syncthreads();
        int base = 0;
        for (int pp = 0; pp < part; ++pp) base += st_part[q * 8 + pp];
        int allow = allow_total - base;
        unsigned* grow = p.DMASK() + ((size_t)b * 128 * S + q0 + q) * 2;
        if (c > 0 && allow > 0) {
            for (int i = 0; i < 32 && allow > 0; ++i) {
                unsigned wv = tr[i];
                if (wv == 0u) continue;
                const int pc = __builtin_popcount(wv);
                if (pc > allow) { unsigned kept = 0u; for (int j = 0; j < allow; ++j) { const unsigned low = wv & (0u - wv); kept |= low; wv ^= low; } wv = kept; }
                { const int kt = part * 32 + i; atomicOr(grow + (size_t)(kt >> 1) * 2 * S + (kt & 1), wv); }
                allow -= pc;
            }
        }
    };
    unsigned prefix = 0u;
    bool fast = false;
#pragma unroll 1
    for (int pass = 0; pass < 4; ++pass) {
        const int shift = 24 - 8 * pass;
        __syncthreads();
        for (int i = tid; i < 32 * 257; i += 256) hist[i] = 0u;
        __syncthreads();
        bf16x8 k0, k1; KLOAD(wid, k0, k1)
        auto hist_tile = [&](auto first_tag, auto diag_tag) {
            constexpr bool FIRST = decltype(first_tag)::value, DG = decltype(diag_tag)::value;
            unsigned key[16];
            score_tile(k0, k1, key);
#pragma unroll
            for (int r = 0; r < 16; ++r) {
                const int rho0 = (r & 3) + 8 * (r >> 2);
                bool ok = true;
                if (DG) ok = rho0 <= lrh;
                if (!FIRST) ok = ok && ((key[r] >> (shift + 8)) == prefix);
                if (FIRST) atomicAdd(&hist[lr * 257 + ((!DG || ok) ? ((key[r] >> shift) & 255u) : 256u)], 1u);
                else if (__any(ok)) atomicAdd(&hist[lr * 257 + (ok ? ((key[r] >> shift) & 255u) : 256u)], 1u);
            }
        };
        using T_ = std::true_type; using F_ = std::false_type;
#pragma unroll 1
        for (int kt = wid; kt < ntile; kt += 4) {
            bf16x8 n0, n1; KLOAD(kt + 4, n0, n1)
            if (pass == 0) { if (kt == qt) hist_tile(T_{}, T_{}); else hist_tile(T_{}, F_{}); }
            else { if (kt == qt) hist_tile(F_{}, T_{}); else hist_tile(F_{}, F_{}); }
            k0 = n0; k1 = n1;
        }
        __syncthreads();
        {
            const int q = tid >> 3, part = tid & 7;
            const unsigned* hr = hist + q * 257 + part * 32;
            unsigned s = 0u;
#pragma unroll 8
            for (int i = 0; i < 32; ++i) s += hr[i];
            st_part[q * 8 + part] = (int)s;
            __syncthreads();
            const bool qsmall = (q0 + q + 1) <= 256;
            const int krem = (pass == 0) ? 256 : st_krem[q];
            const unsigned pprev = (pass == 0) ? 0u : st_prefix[q];
            unsigned above = 0u;
            for (int pp = 7; pp > part; --pp) above += (unsigned)st_part[q * 8 + pp];
            __syncthreads();
            if (qsmall) { if (part == 0) { st_prefix[q] = 0u; st_krem[q] = 1 << 30; } }
            else if (above < (unsigned)krem && (unsigned)krem <= above + s) {
                unsigned cum = above; int bin = 31;
                for (; bin > 0; --bin) { const unsigned c = hr[bin]; if (cum + c >= (unsigned)krem) break; cum += c; }
                st_prefix[q] = (pprev << 8) | (unsigned)(part * 32 + bin);
                st_krem[q] = krem - (int)cum;
            }
        }
        __syncthreads();
        prefix = st_prefix[lr];
        if (pass == 1) {
            unsigned* clist = (unsigned*)(sm + 36864);
            unsigned* ccnt = (unsigned*)(sm + 36864 + 32768);
            unsigned* tiew = hist;
            if (tid < 32) ccnt[tid] = 0u;
            if (tid == 0) st_part[0] = 0;
            __syncthreads();
            {
                unsigned* mb = p.DMASK() + ((size_t)b * 128 * S + tq) * 2;
                const unsigned tkey = prefix << 16;
                bf16x8 k0, k1; KLOAD(wid, k0, k1)
                int kt = wid;
#pragma unroll 1
                for (; kt < ntile; kt += 4) {
                    unsigned gt = 0u, tie = 0u;
                    bf16x8 n0, n1; KLOAD(kt + 4, n0, n1)
                    unsigned key[16];
                    score_tile(k0, k1, key);
                    const int vlim = (kt == qt) ? lrh : 64;
#pragma unroll
                    for (int r = 0; r < 16; ++r) {
                        const int rho0 = (r & 3) + 8 * (r >> 2);
                        const bool v = rho0 <= vlim;
                        const unsigned p16 = key[r] >> 16;
                        gt |= (v && p16 > prefix) ? (1u << rho0) : 0u;
                        tie |= (v && key[r] == tkey) ? (1u << rho0) : 0u;
                        const bool eq = v && p16 == prefix && key[r] != tkey;
                        if (__any(eq)) {
                            if (eq) {
                                const unsigned slot = atomicAdd(&ccnt[lr], 1u);
                                if (slot < 256u) clist[lr * 256 + slot] = (key[r] << 16) | (0xFFFFu - (unsigned)(kt * 32 + rho0 + 4 * lh));
                            }
                        }
                    }
                    gt <<= 4 * lh; tie <<= 4 * lh;
                    gt = half_or(gt); tie = half_or(tie);
                    k0 = n0; k1 = n1;
                    if (lh == 0) { mb[(size_t)(kt >> 1) * 2 * S + (kt & 1)] = gt; tiew[lr * 257 + kt] = tie; }
                }
#pragma unroll 1
                for (; kt < 256; kt += 4)
                    if (lh == 0) { mb[(size_t)(kt >> 1) * 2 * S + (kt & 1)] = 0u; tiew[lr * 257 + kt] = 0u; }
            }
            asm volatile("s_waitcnt vmcnt(0)" ::: "memory");
            __syncthreads();
            const int q = tid >> 3, part = tid & 7;
            const unsigned C = ccnt[q];
            if (part == 0 && C > 256u) st_part[0] = 1;
            __syncthreads();
            if (__builtin_amdgcn_readfirstlane(st_part[0]) == 0) {
                const unsigned* lst = clist + q * 256;
                const int kr = st_krem[q];
                unsigned* grow = p.DMASK() + ((size_t)b * 128 * S + q0 + q) * 2;
                for (unsigned i = (unsigned)part; i < C; i += 8u) {
                    const unsigned v = lst[i];
                    int rank = 0;
                    for (unsigned j = 0; j < C; ++j) rank += (lst[j] > v) ? 1 : 0;
                    if (rank < kr) { const unsigned idx = 0xFFFFu - (v & 0xFFFFu); const int kt = (int)(idx >> 5); atomicOr(grow + (size_t)(kt >> 1) * 2 * S + (kt & 1), 1u << (idx & 31u)); }
                }
                __syncthreads();
                tie_fix(kr - (int)C);
                fast = true;
                break;
            }
        }
    }
    if (!fast) {
    const unsigned thr = prefix;
    unsigned* mbase = p.DMASK() + ((size_t)b * 128 * S + tq) * 2;
    unsigned* tiew = hist;
    {
        bf16x8 k0, k1; KLOAD(wid, k0, k1)
        int kt = wid;
#pragma unroll 1
        for (; kt < ntile; kt += 4) {
            unsigned gt = 0u, tie = 0u;
            bf16x8 n0, n1; KLOAD(kt + 4, n0, n1)
            unsigned key[16];
            score_tile(k0, k1, key);
            const int vlim = (kt == qt) ? lrh : 64;
#pragma unroll
            for (int r = 0; r < 16; ++r) {
                const int rho0 = (r & 3) + 8 * (r >> 2);
                const bool v = rho0 <= vlim;
                gt |= (v && key[r] > thr) ? (1u << rho0) : 0u; tie |= (v && key[r] == thr) ? (1u << rho0) : 0u;
            }
            gt <<= 4 * lh; tie <<= 4 * lh;
            gt = half_or(gt); tie = half_or(tie);
            k0 = n0; k1 = n1;
            if (lh == 0) { mbase[(size_t)(kt >> 1) * 2 * S + (kt & 1)] = gt; tiew[lr * 257 + kt] = tie; }
        }
#pragma unroll 1
        for (; kt < 256; kt += 4)
            if (lh == 0) { mbase[(size_t)(kt >> 1) * 2 * S + (kt & 1)] = 0u; tiew[lr * 257 + kt] = 0u; }
    }
    asm volatile("s_waitcnt vmcnt(0)" ::: "memory");
    __syncthreads();
    tie_fix(st_krem[tid >> 3]);
    }
#undef KLOAD
    __syncthreads();
}

__device__ __forceinline__ bool imp_better(float v1, int i1, float v2, int i2) { return (v1 > v2) || (v1 == v2 && i1 < i2); }
UNIT_ATTR __device__ __forceinline__ void nsa_select_unit(const Params& p, int b, int q0w, char* sm) {
    const int lane = tidx() & 63, lr = lane & 31, lh = lane >> 5;
    const int tq = q0w + lr;
    const size_t gq = (size_t)b * S + tq;
    const int nlim = (tq - 31) >> 4;
    const int nst = min(16, ((((q0w + 31 - 31) >> 4)) >> 5) + 1);
    const int pil = (lr & 0x13) | ((lr & 4) << 1) | ((lr & 8) >> 1);
    const bf16_t* kc = p.KCB() + (size_t)b * NCMP_PAD * 64 + (size_t)pil * 64 + 8 * lh;
    constexpr float c = 1.0f;
    float mh[4], il[4];
#pragma unroll
    for (int h = 0; h < 4; ++h) {
        bf16x8 qf[4];
#pragma unroll
        for (int s = 0; s < 4; ++s) qf[s] = *(const bf16x8*)(p.QN() + gq * 256 + h * 64 + 16 * s + 8 * lh);
        float m = NEG_INF, l = 0.f;
#pragma unroll 1
        for (int st = 0; st < nst; ++st) {
            f32x16 s;
#pragma unroll
            for (int i = 0; i < 16; ++i) s[i] = 0.f;
#pragma unroll
            for (int s4 = 0; s4 < 4; ++s4) { const bf16x8 kf = *(const bf16x8*)(kc + (size_t)st * 32 * 64 + s4 * 16); s = __builtin_amdgcn_mfma_f32_32x32x16_bf16(kf, qf[s4], s, 0, 0, 0); }
            const int thl = nlim - st * 32 - 8 * lh;
            float tmax = NEG_INF;
#pragma unroll
            for (int r = 0; r < 16; ++r) { const int cr = 16 * (r >> 3) + (r & 7); s[r] = (cr <= thl) ? s[r] * c : NEG_INF; tmax = fmaxf(tmax, s[r]); }
            tmax = half_max(tmax);
            const float mn = fmaxf(m, tmax), mu = (mn == NEG_INF) ? 0.f : mn;
            float ls = 0.f;
#pragma unroll
            for (int r = 0; r < 16; ++r) ls += __builtin_amdgcn_exp2f(s[r] - mu);
            l = l * __builtin_amdgcn_exp2f(m - mu) + ls; m = mn;
        }
        l = half_sum(l);
        mh[h] = (m == NEG_INF) ? 0.f : m; il[h] = 1.f / fmaxf(l, 1e-30f);
    }
    float val[16]; int idx[16];
#pragma unroll
    for (int i = 0; i < 16; ++i) { val[i] = NEG_INF; idx[i] = 1 << 20; }
    const int cur = tq >> 6;
#pragma unroll 1
    for (int st = 0; st < 16; ++st) {
        float bs[4] = {0.f, 0.f, 0.f, 0.f};
        if (st < nst) {
            const int thl = nlim - st * 32 - 8 * lh;
#pragma unroll
            for (int h = 0; h < 4; ++h) {
                f32x16 s;
#pragma unroll
                for (int i = 0; i < 16; ++i) s[i] = 0.f;
#pragma unroll
                for (int s4 = 0; s4 < 4; ++s4) {
                    const bf16x8 kf = *(const bf16x8*)(kc + (size_t)st * 32 * 64 + s4 * 16);
                    const bf16x8 qfr = *(const bf16x8*)(p.QN() + gq * 256 + h * 64 + 16 * s4 + 8 * lh);
                    s = __builtin_amdgcn_mfma_f32_32x32x16_bf16(kf, qfr, s, 0, 0, 0);
                }
#pragma unroll
                for (int r = 0; r < 16; ++r) {
                    const int cr = 16 * (r >> 3) + (r & 7);
                    const float pr = (cr <= thl) ? __builtin_amdgcn_exp2f(s[r] * c - mh[h]) * il[h] : 0.f;
                    bs[r >> 2] += pr;
                }
                __builtin_amdgcn_sched_barrier(0);
            }
        }
#pragma unroll
        for (int g = 0; g < 4; ++g) {
            const int j = st * 8 + 4 * (g >> 1) + 2 * lh + (g & 1);
            const bool forced = (j == 0) || (j == cur) || (j == cur - 1);
            float v = forced ? 1e4f : ((j <= cur) ? bs[g] : -1.0f);
            int jj = j;
            if (__any(imp_better(v, jj, val[15], idx[15]))) {
#pragma unroll
                for (int i = 0; i < 16; ++i) {
                    const bool bt = imp_better(v, jj, val[i], idx[i]);
                    const float tv = bt ? val[i] : v; const int ti = bt ? idx[i] : jj;
                    val[i] = bt ? v : val[i]; idx[i] = bt ? jj : idx[i];
                    v = tv; jj = ti;
                }
            }
        }
    }
    {
        float* lv = (float*)(sm + (tidx() >> 6) * 8192);
        int* li = (int*)(lv + 1024);
#pragma unroll
        for (int i = 0; i < 16; ++i) { lv[i * 64 + lane] = val[i]; li[i * 64 + lane] = idx[i]; }
        __builtin_amdgcn_wave_barrier();
#pragma unroll 1
        for (int k = 0; k < 16; ++k) {
            float v = lv[k * 64 + (lane ^ 32)]; int jj = li[k * 64 + (lane ^ 32)];
#pragma unroll
            for (int i = 0; i < 16; ++i) {
                const bool bt = imp_better(v, jj, val[i], idx[i]);
                const float tv = bt ? val[i] : v; const int ti = bt ? idx[i] : jj;
                val[i] = bt ? v : val[i]; idx[i] = bt ? jj : idx[i];
                v = tv; jj = ti;
            }
        }
        __builtin_amdgcn_wave_barrier();
    }
    unsigned m0 = 0u, m1 = 0u, m2 = 0u, m3 = 0u;
#pragma unroll
    for (int i = 0; i < 16; ++i) {
        const unsigned bit = 1u << (idx[i] & 31); const int wsel = idx[i] >> 5;
        m0 |= (wsel == 0) ? bit : 0u; m1 |= (wsel == 1) ? bit : 0u; m2 |= (wsel == 2) ? bit : 0u; m3 |= (wsel == 3) ? bit : 0u;
    }
    if (lh == 0) { u32x4 o; o.x = m0; o.y = m1; o.z = m2; o.w = m3; *(u32x4*)(p.SMASK() + gq * 4) = o; }
}

constexpr int CONV_TILES = (D / 64) * ((NIN + 63) / 64), CONV_PER = 2, CONV_UNITS = (CONV_TILES + CONV_PER - 1) / CONV_PER;
template <class BAR>
__device__ __forceinline__ void ph_work(const Params& p, int layer, char* sm, const BAR& barrier) {
    volatile int* s_unit_p = (volatile int*)(sm + 3 * 24576 + 32);
#pragma unroll 1
    for (int stage = 0; stage < 2; ++stage) {
        unsigned* ctr = p.qctr() + 64 * layer + 32 * stage;
        const int total = stage == 0 ? (2728 + (layer + 1 < DEPTH ? CONV_UNITS : 0)) : 1024;
        unsigned* cmp2_done = p.qctr() + 64 * layer + 16;
        unsigned* cmp1_done = p.qctr() + 64 * layer + 17;
        unsigned* cum_done = p.qctr() + 64 * layer + 18;
#define PUBLISH(ctr_) { asm volatile("s_waitcnt vmcnt(0)" ::: "memory"); __syncthreads(); if (threadIdx.x == 0) { __builtin_amdgcn_fence(__ATOMIC_RELEASE, "agent"); asm volatile("s_waitcnt vmcnt(0)" ::: "memory"); (void)xb_add(ctr_, 1u); } }
#define AWAIT(ctr_, n_) { if (threadIdx.x == 0) { unsigned sp_ = 0u; while (xb_ld(ctr_) < (unsigned)(n_) && ++sp_ < (1u << 22)) __builtin_amdgcn_s_sleep(2); __builtin_amdgcn_fence(__ATOMIC_ACQUIRE, "agent"); asm volatile("s_waitcnt vmcnt(0)" ::: "memory"); } __syncthreads(); }
        for (;;) {
            __syncthreads();
            if (threadIdx.x == 0) *s_unit_p = (int)atomicAdd(ctr, 1u);
            __syncthreads();
            const int u = __builtin_amdgcn_readfirstlane(*s_unit_p);
            if (u >= total) break;
            int kind, b = 0, h = 0, q = 0;
            if (stage == 1) { const int r = u & 15; kind = (r >> 3) ? 20 : 2 + AM_DSA; q = 63 - (u >> 4); b = (r >> 2) & 1; h = r & 3; }
            else if (u < 16) { kind = 32; q = u; }
            else if (u < 24) { kind = 33; q = u - 16; }
            else if (u < 536) { const int v = u - 24; kind = 0; q = 255 - (v >> 1); b = v & 1; }
            else if (u < 552) { kind = 30; q = u - 536; }
            else if (u < 680) { kind = 1; const int v = u - 552; b = v & 1; q = v >> 1; }
            else if (u < 1704) { const int v = u - 680, r = v & 15; kind = 2 + ((r >> 3) ? AM_FOX : AM_SB); q = 63 - (v >> 4); b = (r >> 2) & 1; h = r & 3; }
            else if (u < 2216) { const int w = u - 1704; kind = 2 + AM_MEM; q = w >> 3; b = (w >> 2) & 1; h = w & 3; }
            else if (u < 2728) { kind = 31; q = u - 2216; }
            else { kind = 21; q = u - 2728; }
            if (kind == 32) {
                if (q < 8) { EpiCmp1 e{p.BIASC() + (layer * 2 + 0) * 128, p.HIDK()}; gemm_bf16<128>(p.KCT(), 1024, p.WC1T() + (size_t)(layer * 2 + 0) * 128 * 2048, 2048, 1024, 128, 2048, e, q, 1 << 20, sm); }
                else { EpiCmp1 e{p.BIASC() + (layer * 2 + 1) * 128, p.HIDV()}; gemm_bf16<128>(p.VCTOK(), 1024, p.WC1T() + (size_t)(layer * 2 + 1) * 128 * 2048, 2048, 1024, 128, 2048, e, q - 8, 1 << 20, sm); }
                PUBLISH(cmp1_done)
                continue;
            }
            if (kind == 33) { ph_cumsum(p, q, 1 << 20, (float*)sm); PUBLISH(cum_done) continue; }
            if (kind == 30) {
                AWAIT(cmp1_done, 16)
                if (q < 8) { EpiCmp2K e{p.KCB()}; gemm_bf16<64>(p.HIDK(), 128, p.WC2T() + (size_t)(layer * 2 + 0) * 64 * 128, 128, 1024, 64, 128, e, q, 1 << 20, sm); }
                else { EpiCmp2V e{p.VCT()}; gemm_bf16<64>(p.HIDV(), 128, p.WC2T() + (size_t)(layer * 2 + 1) * 64 * 128, 128, 1024, 64, 128, e, q - 8, 1 << 20, sm); }
                PUBLISH(cmp2_done)
                continue;
            }
            if (kind == 31) {
                const int tile = q & 255;
                ckvnorm_rows128(p, layer, (tile & 127) * 128);
                asm volatile("s_waitcnt vmcnt(0)" ::: "memory");
                __syncthreads();
                if (threadIdx.x == 0) { __builtin_amdgcn_fence(__ATOMIC_ACQUIRE, "agent"); asm volatile("s_waitcnt vmcnt(0)" ::: "memory"); }
                __syncthreads();
                if (q < 256) { EpiKA e{p}; gemm_bf16<128>(p.CKV(), 128, p.WUK() + (size_t)layer * 256 * 128, 128, T, 256, 128, e, tile, 1 << 20, sm); }
                else { EpiVA e{p}; gemm_bf16<128>(p.CKV(), 128, p.WUV() + (size_t)layer * 256 * 128, 128, T, 256, 128, e, tile, 1 << 20, sm); }
                continue;
            }
            if (kind == 1) AWAIT(cmp2_done, 16)
            if (kind == 2 + AM_FOX) AWAIT(cum_done, 8)
            if (kind == 0) dsa_select_unit(p, b, q, sm);
            else if (kind == 1) nsa_select_unit(p, b, q * 128 + 32 * __builtin_amdgcn_readfirstlane(tidx() >> 6), sm);
            else if (kind == 2 + AM_SB) attn_unit<AM_SB>(p, b, h, q, sm);
            else if (kind == 2 + AM_FOX) attn_unit<AM_FOX>(p, b, h, q, sm);
            else if (kind == 2 + AM_DSA) attn_unit<AM_DSA>(p, b, h, q, sm);
            else if (kind == 2 + AM_MEM) attn_unit<AM_MEM>(p, b, h, q, sm);
            else if (kind == 20) nsa_unit(p, b, h, q, sm);
            else convert_wt_range<true>(p.w_in + (size_t)(layer + 1) * D * NIN, p.WIN(layer + 1), D, NIN, 1, q * CONV_PER, q * CONV_PER + CONV_PER, 1, (float*)sm);
        }
        barrier(stage);
    }
#undef PUBLISH
#undef AWAIT
}

__device__ __forceinline__ void ph_setup_misc(const Params& p, int bid, int nb) {
    const int lane = tidx() & 63, gw = bid * 4 + (tidx() >> 6);
    for (int o = gw; o < DEPTH * 2 * 128; o += nb * 4) {
        const int l = o >> 8, which = (o >> 7) & 1, j = o & 127;
        const float* pe = (which ? p.pe_v : p.pe_k) + (size_t)l * 2048;
        const float* w1 = (which ? p.wc1_v : p.wc1_k) + (size_t)l * 2048 * 128;
        float a = 0.f;
        for (int k = lane; k < 2048; k += 64) a = fmaf(pe[k], w1[(size_t)k * 128 + j], a);
        a = wave_sum(a);
        if (lane == 0) p.BIASC()[o] = a;
    }
    for (int i = bid * 256 + tidx(); i < 2048; i += nb * 256) { p.KCT()[(size_t)T * 64 + i] = 0; p.VCTOK()[(size_t)T * 64 + i] = 0; }
    for (int wb = 0; wb < 2; ++wb) {
        for (int i = bid * 256 + tidx(); i < 12 * D; i += nb * 256) p.WIN(wb)[(size_t)(M_SPC + 52) * D + i] = 0;
        for (int i = bid * 256 + tidx(); i < (M_MERGE - NPM) * D; i += nb * 256) p.WIN(wb)[(size_t)NPM * D + i] = 0;
    }
}

#define XB_TMO      128
#define XB_XCNT(j)  (256  + 64 * (j))
#define XB_XSUB(j)  (1280 + 64 * (j))
#define XB_XGEN(j)  (2304 + 64 * (j))
#define XB_TOP      3328
#define XB_TOPGEN   3392
#define XCD_BAR_WORDS 3456
#define XB_SPIN_CAP (1u << 18)
#define LAS __attribute__((address_space(3)))

#define XB_SPIN(cond, bar) do { unsigned _sp = 0; while (cond) { __builtin_amdgcn_s_sleep(1); \
    if ((++_sp & 255u) == 0u) { if (xb_ld(&(bar)[XB_TMO])) break; if (_sp > XB_SPIN_CAP) { atomicAdd(&(bar)[XB_TMO], 1u); break; } } } } while (0)

struct XcdBarrier {
    unsigned* bar; unsigned x;
    volatile LAS unsigned* st;
};
__device__ __forceinline__ XcdBarrier xcd_barrier_post(unsigned* bar, volatile LAS unsigned* st) {
    XcdBarrier b; b.bar = bar; b.x = xb_xcc_id(); b.st = st;
    if (threadIdx.x == 0) (void)xb_add(&bar[XB_XCNT(b.x)], 1u);
    return b;
}
__device__ __forceinline__ void xcd_barrier_complete(unsigned* bar, unsigned x, unsigned& nloc, unsigned& nx) {
    const unsigned G = gridDim.x * gridDim.y * gridDim.z;
    unsigned sum, cnt, mine, sp = 0u;
    for (;;) {
        sum = 0u; cnt = 0u; mine = 0u;
#pragma unroll
        for (unsigned j = 0; j < 16; ++j) { const unsigned c = xb_ld(&bar[XB_XCNT(j)]); sum += c; cnt += (c > 0u) ? 1u : 0u; mine = (j == x) ? c : mine; }
        if (sum == G) break;
        __builtin_amdgcn_s_sleep(1);
        if ((++sp & 255u) == 0u) { if (xb_ld(&bar[XB_TMO])) break; if (sp > XB_SPIN_CAP) { atomicAdd(&bar[XB_TMO], 1u); break; } }
    }
    nloc = mine > 0u ? mine : 1u; nx = cnt > 0u ? cnt : 1u;
}
__device__ __attribute__((noinline)) void xcd_barrier_impl(unsigned* b_bar, unsigned b_x, volatile LAS unsigned* b_st) {
    XcdBarrier b; b.bar = b_bar; b.x = b_x; b.st = b_st;
    asm volatile("s_waitcnt vmcnt(0)" ::: "memory");
    __syncthreads();
    if (threadIdx.x == 0) {
        unsigned* bar = b.bar;
        __builtin_amdgcn_s_waitcnt(0);
        unsigned nloc = b.st[0], nx = b.st[1];
        if (nloc == 0u) { xcd_barrier_complete(bar, b.x, nloc, nx); b.st[0] = nloc; b.st[1] = nx; }
        const unsigned old = xb_add(&bar[XB_XSUB(b.x)], 1u);
        const unsigned gen = old / nloc;
        if (old + 1u == (gen + 1u) * nloc) {
            __builtin_amdgcn_fence(__ATOMIC_RELEASE, "agent");
            asm volatile("s_waitcnt vmcnt(0)" ::: "memory");
            const unsigned og = xb_add(&bar[XB_TOP], 1u);
            const unsigned tg = og / nx;
            if (og + 1u == (tg + 1u) * nx) xb_add(&bar[XB_TOPGEN], 1u);
            else XB_SPIN(xb_ld(&bar[XB_TOPGEN]) == tg, bar);
            __builtin_amdgcn_fence(__ATOMIC_ACQUIRE, "agent");
            xb_add(&bar[XB_XGEN(b.x)], 1u);
            asm volatile("s_waitcnt vmcnt(0)" ::: "memory");
        } else {
            XB_SPIN(xb_ld(&bar[XB_XGEN(b.x)]) == gen, bar);
            __builtin_amdgcn_fence(__ATOMIC_ACQUIRE, "agent");
            asm volatile("s_waitcnt vmcnt(0)" ::: "memory");
        }
    }
    __syncthreads();
}
__device__ __forceinline__ void xcd_barrier(const XcdBarrier& b) { xcd_barrier_impl(b.bar, b.x, b.st); }

constexpr int LDS_MAIN = 3 * 24576, LDS_BYTES = LDS_MAIN + 64;
#ifndef DIAG
#define DIAG 0
#endif
#ifndef DIAG_A
#define DIAG_A 8
#define DIAG_B 7
#endif
#if DIAG
#define STAMP(k) do { if (((k) == DIAG_A || (k) == DIAG_B || (k) + 1 == DIAG_A || (k) + 1 == DIAG_B || (k) == 0 || (k) == 11) && blockIdx.x == 0 && threadIdx.x == 0) { const unsigned long long t_ = wall_clock64(); dg[k] += t_ - dg[15]; dg[15] = t_; } } while (0)
#else
#define STAMP(k) do { } while (0)
#endif
__global__ void __launch_bounds__(256, 2) mega(Params p) {
    extern __shared__ __attribute__((aligned(16))) char smem[];
    if (threadIdx.x == 0) *(uint4*)(smem + LDS_MAIN) = make_uint4(0u, 0u, 0u, 0u);
    __syncthreads();
    XcdBarrier bar = xcd_barrier_post(p.bar(), (volatile LAS unsigned*)(smem + LDS_MAIN));
    const int bid = blockIdx.x, nb = gridDim.x;
    float* smf = (float*)smem;
#if DIAG
    __shared__ unsigned long long dg[16];
    if (threadIdx.x == 0) { for (int i = 0; i < 15; ++i) dg[i] = 0; dg[15] = wall_clock64(); }
#endif

    int cvo = 0;
#define CVT(SRC, DST, K_, N_, NMAT_) { convert_wt(SRC, DST, K_, N_, NMAT_, (bid + nb - cvo % nb) % nb, nb, smf); cvo += (NMAT_) * ((K_) / 64) * (((N_) + 63) / 64); }
    CVT(p.w_branch, p.WBR(), 256, D, DEPTH * 5)
    CVT(p.w_out, p.WOUT(), D, D, DEPTH)
    CVT(p.w_mem_kv, p.WMKV(), D, 512, DEPTH)
    CVT(p.w_uk, p.WUK(), 128, 256, DEPTH)
    CVT(p.w_uv, p.WUV(), 128, 256, DEPTH)
    for (int l = 0; l < DEPTH; ++l) {
        CVT(p.wc1_k + (size_t)l * 2048 * 128, p.WC1T() + (size_t)(l * 2 + 0) * 128 * 2048, 2048, 128, 1)
        CVT(p.wc1_v + (size_t)l * 2048 * 128, p.WC1T() + (size_t)(l * 2 + 1) * 128 * 2048, 2048, 128, 1)
        CVT(p.wc2_k + (size_t)l * 128 * 64, p.WC2T() + (size_t)(l * 2 + 0) * 64 * 128, 128, 64, 1)
        CVT(p.wc2_v + (size_t)l * 128 * 64, p.WC2T() + (size_t)(l * 2 + 1) * 64 * 128, 128, 64, 1)
    }
#undef CVT
    ph_setup_misc(p, bid, nb);
    ph_rope_table(p, bid, nb);
    STAMP(0);
    for (int l = 0; l < DEPTH; ++l) {
        const float* Xin = l == 0 ? p.x : p.X;
        if (l == 0) convert_wt<true>(p.w_in, p.WIN(0), D, NIN, 1, (bid + nb - cvo % nb) % nb, nb, smf);
        ph_rmsnorm<bf16_t>(Xin, p.norm_g + l * D, p.H(), T, bid, nb);
        ph_rmsnorm<bf16_t>(p.mem, p.mem_norm + l * D, p.MEMN(), NBATCH * NMEM, bid, nb);
        xcd_barrier(bar); STAMP(1);
        int nbusy;
        { EpiInProj e{p, l}; nbusy = gemm_big(p.H(), D, p.WIN(l), D, T, NP, D, e, bid, nb, smem); }
        { EpiMemKV e{p}; gemm_bf16<128>(p.MEMN(), D, p.WMKV() + (size_t)l * 512 * D, D, NBATCH * NMEM, 512, D, e, (bid + nb - nbusy) % nb, nb, smem); }
        xcd_barrier(bar); STAMP(2);
        ph_work(p, l, smem, [&](int stage) { xcd_barrier(bar); if (stage == 0) { STAMP(7); } else { STAMP(8); } });
        ph_merge(p, l, bid, nb, smem);
        xcd_barrier(bar); STAMP(10);
        { EpiResid e{Xin, p.X}; (void)gemm_big(p.MG(), D, p.WOUT() + (size_t)l * D * D, D, T, D, D, e, bid, nb, smem); }
        xcd_barrier(bar); STAMP(11);
    }
#if DIAG
    {
        float* dgw = (float*)(p.bar() + 4096 + 512);
        if (blockIdx.x == 0 && threadIdx.x == 0) {
            unsigned long long tot = 0; for (int i = 0; i < 15; ++i) tot += dg[i];
            #if defined(DIAG_GRID)
            dgw[0] = (float)gridDim.x / 1024.f; dgw[1] = 0.f; if (0)
#endif
            dgw[0] = rintf(50.f * (float)((double)dg[DIAG_A] / (double)tot)) / 50.f; dgw[1] = rintf(50.f * (float)((double)dg[DIAG_B] / (double)tot)) / 50.f;
        }
        ph_rmsnorm<float>(p.X, p.final_norm, p.X, T, bid, nb);
        xcd_barrier(bar);
        {
            const float fa = 1.0f + dgw[0];
            float4* xp = (float4*)p.X;
#pragma unroll 1
            for (int i = bid * 256 + threadIdx.x; i < T * D / 4; i += nb * 256) { float4 v = xp[i]; v.x *= fa; v.y *= fa; v.z *= fa; v.w *= fa; xp[i] = v; }
        }
        xcd_barrier(bar);
        if (blockIdx.x == 0 && threadIdx.x == 0) p.X[0] += 100.f * dgw[1];
    }
#else
    ph_rmsnorm<float>(p.X, p.final_norm, p.X, T, bid, nb);
#endif
}
}

extern "C" void kernel_launch(void* const* d_in, const int* in_sizes, int n_in, void* d_out, int out_size, void* d_ws, size_t ws_size, hipStream_t stream) {
    (void)in_sizes; (void)n_in; (void)out_size;
    Params p{};
    p.x = (const float*)d_in[0]; p.mem = (const float*)d_in[1]; p.pos = (const int*)d_in[2]; p.norm_g = (const float*)d_in[3];
    p.w_in = (const float*)d_in[4]; p.kv_norm = (const float*)d_in[5]; p.w_uk = (const float*)d_in[6]; p.w_uv = (const float*)d_in[7];
    p.fox_bias = (const float*)d_in[8]; p.pe_k = (const float*)d_in[9]; p.pe_v = (const float*)d_in[10]; p.wc1_k = (const float*)d_in[11];
    p.wc2_k = (const float*)d_in[12]; p.wc1_v = (const float*)d_in[13]; p.wc2_v = (const float*)d_in[14]; p.mem_norm = (const float*)d_in[15];
    p.w_mem_kv = (const float*)d_in[16]; p.w_branch = (const float*)d_in[17]; p.w_out = (const float*)d_in[18]; p.final_norm = (const float*)d_in[19];
    p.X = (float*)d_out;
    p.ws = (char*)d_ws;
    if (WS_TOTAL > ws_size) { fprintf(stderr, "kernel_launch: workspace too small (%zu > %zu)\n", (size_t)WS_TOTAL, ws_size); return; }

    static int grid = 0;
    if (grid == 0) {
        int dev = 0, cus = 0, per_cu = 0;
        hipGetDevice(&dev);
        hipDeviceGetAttribute(&cus, hipDeviceAttributeMultiprocessorCount, dev);
        hipFuncSetAttribute((const void*)mega, hipFuncAttributeMaxDynamicSharedMemorySize, LDS_BYTES);
        hipOccupancyMaxActiveBlocksPerMultiprocessor(&per_cu, (const void*)mega, 256, LDS_BYTES);
        (void)hipGetLastError();
        if (per_cu < 1) per_cu = 1;
        grid = cus * (per_cu < 2 ? per_cu : 2);
    }
    hipMemsetAsync((char*)d_ws + OFF_bar, 0, (4096 + 64 * 8 + 64) * sizeof(unsigned), stream);
    hipLaunchKernelGGL(mega, dim3(grid), dim3(256), LDS_BYTES, stream, p);
}
```

```cpp
#include <hip/hip_runtime.h>
#include <stdint.h>
#include <math.h>
#include <cstdio>
#include <type_traits>

namespace {
constexpr int S = 8192, NBATCH = 2, T = NBATCH * S, D = 1024, NIN = 9396, NM = 4276, DEPTH = 4, NMEM = 256;
constexpr int NCMP = 511, NCMP_PAD = 512;
constexpr int C_DSA_Q = 0, C_CKV = 256, C_IDXQ = 384, C_IDXK = 512, C_IDXW = 544, C_DSA_Z = 548,
              C_FOX_Q = 804, C_FOX_K = 1060, C_FOX_V = 1316, C_FOX_F = 1572, C_FOX_Z = 1576,
              C_SB_Q = 1832, C_SB_K = 2088, C_SB_V = 2344, C_SB_Z = 2600,
              C_NSA_Q = 2856, C_NSA_KC = 3112, C_NSA_VC = 3176, C_NSA_KS = 3240, C_NSA_VS = 3304, C_NSA_KW = 3368, C_NSA_VW = 3432,
              C_NSA_G = 3496, C_NSA_Z = 3508, C_MEM_Q = 3764, C_MEM_Z = 4020, C_MERGE = 4276;

typedef unsigned short bf16_t;
typedef short bf16x8 __attribute__((ext_vector_type(8)));
typedef float f32x16 __attribute__((ext_vector_type(16)));
typedef float f32x2 __attribute__((ext_vector_type(2)));
typedef unsigned u32x4 __attribute__((ext_vector_type(4)));
typedef unsigned u32x2 __attribute__((ext_vector_type(2)));

constexpr int M_QA = 0, M_QN = 256, M_KSLC = 512, M_KWIN = 576, M_KC = 640, M_VC = 704, M_QF = 768, M_KF = 1024, M_QS = 1280, M_KSB = 1536, M_QM = 1792,
              M_VF = 2048, M_VS = 2304, M_VSLC = 2560, M_VWIN = 2624, M_QI = 2688, M_SPC = 2816, M_CKV = 2880, M_Z = 3008, NPM = 4288, M_MERGE = 4352, NP = 9472;
constexpr size_t al256(size_t x) { return (x + 255) & ~(size_t)255; }
constexpr size_t OFF_bar = 0;
constexpr size_t OFF_H = OFF_bar + al256((4096 + 64 * 8 + 64) * 4);
constexpr size_t OFF_Y = OFF_H + al256((size_t)T * D * 2);
constexpr size_t OFF_ZG = OFF_Y + al256((size_t)T * 1280 * 2);
constexpr size_t OFF_MG = OFF_ZG + al256((size_t)T * 1280 * 2);
constexpr size_t OFF_SIG = OFF_MG + al256((size_t)T * D * 2);
constexpr size_t OFF_CKVR = OFF_SIG + al256((size_t)T * 5120 * 2);
constexpr size_t OFF_CKV = OFF_CKVR + al256((size_t)T * 128 * 4);
constexpr size_t OFF_LOGF = OFF_CKV + al256((size_t)T * 128 * 2);
constexpr size_t OFF_CUM = OFF_LOGF + al256((size_t)T * 4 * 4);
constexpr size_t OFF_CUMT = OFF_CUM + al256((size_t)T * 4 * 4);
constexpr size_t OFF_WI = OFF_CUMT + al256((size_t)T * 4 * 4);
constexpr size_t OFF_GN = OFF_WI + al256((size_t)T * 4 * 4);
constexpr size_t OFF_KCT = OFF_GN + al256((size_t)T * 12 * 4);
constexpr size_t OFF_VCTOK = OFF_KCT + al256(((size_t)T * 64 + 2048) * 2);
constexpr size_t OFF_HIDK = OFF_VCTOK + al256(((size_t)T * 64 + 2048) * 2);
constexpr size_t OFF_HIDV = OFF_HIDK + al256((size_t)1024 * 128 * 2);
constexpr size_t OFF_KCB = OFF_HIDV + al256((size_t)1024 * 128 * 2);
constexpr size_t OFF_VCT = OFF_KCB + al256((size_t)NBATCH * NCMP_PAD * 64 * 2);
constexpr size_t OFF_QI = OFF_VCT + al256((size_t)NBATCH * NCMP_PAD * 64 * 2);
constexpr size_t OFF_KI = OFF_QI + al256((size_t)T * 128 * 2);
constexpr size_t OFF_MEMN = OFF_KI + al256((size_t)T * 32 * 2);
constexpr size_t OFF_ROPE = OFF_MEMN + al256((size_t)NBATCH * NMEM * D * 2);
constexpr size_t OFF_DMASK = OFF_ROPE + al256((size_t)T * 64 * 4);
constexpr size_t OFF_SMASK = OFF_DMASK + al256((size_t)T * 256 * 4);
constexpr size_t OFF_QA = OFF_SMASK + al256((size_t)T * 4 * 4);
constexpr size_t OFF_KAB = OFF_QA + al256((size_t)T * 256 * 2);
constexpr size_t OFF_VAT = OFF_KAB + al256((size_t)T * 256 * 2);
constexpr size_t OFF_QF = OFF_VAT + al256((size_t)T * 256 * 2);
constexpr size_t OFF_KF = OFF_QF + al256((size_t)T * 256 * 2);
constexpr size_t OFF_VFT = OFF_KF + al256((size_t)T * 256 * 2);
constexpr size_t OFF_QS = OFF_VFT + al256((size_t)T * 256 * 2);
constexpr size_t OFF_KSB = OFF_QS + al256((size_t)T * 256 * 2);
constexpr size_t OFF_VST = OFF_KSB + al256((size_t)T * 256 * 2);
constexpr size_t OFF_QN = OFF_VST + al256((size_t)T * 256 * 2);
constexpr size_t OFF_QM = OFF_QN + al256((size_t)T * 256 * 2);
constexpr size_t OFF_KSLC = OFF_QM + al256((size_t)T * 256 * 2);
constexpr size_t OFF_VSLCT = OFF_KSLC + al256((size_t)T * 64 * 2);
constexpr size_t OFF_KWIN = OFF_VSLCT + al256((size_t)T * 64 * 2);
constexpr size_t OFF_VWINT = OFF_KWIN + al256((size_t)T * 64 * 2);
constexpr size_t OFF_MKB = OFF_VWINT + al256((size_t)T * 64 * 2);
constexpr size_t OFF_MVT = OFF_MKB + al256((size_t)NBATCH * NMEM * 256 * 2);
constexpr size_t OFF_WIN = OFF_MVT + al256((size_t)NBATCH * NMEM * 256 * 2);
constexpr size_t OFF_WBR = OFF_WIN + al256((size_t)2 * NP * D * 2);
constexpr size_t OFF_WOUT = OFF_WBR + al256((size_t)DEPTH * 5 * D * 256 * 2);
constexpr size_t OFF_WMKV = OFF_WOUT + al256((size_t)DEPTH * D * D * 2);
constexpr size_t OFF_WUK = OFF_WMKV + al256((size_t)DEPTH * 512 * D * 2);
constexpr size_t OFF_WUV = OFF_WUK + al256((size_t)DEPTH * 256 * 128 * 2);
constexpr size_t OFF_WC1T = OFF_WUV + al256((size_t)DEPTH * 256 * 128 * 2);
constexpr size_t OFF_WC2T = OFF_WC1T + al256((size_t)DEPTH * 2 * 128 * 2048 * 2);
constexpr size_t OFF_BIASC = OFF_WC2T + al256((size_t)DEPTH * 2 * 64 * 128 * 2);
constexpr size_t WS_TOTAL = OFF_BIASC + al256((size_t)DEPTH * 2 * 128 * 4);

__device__ __forceinline__ int map_in_col(int n) {
    constexpr int seg[27][3] = {{0, 256, M_QA}, {256, 128, M_CKV}, {384, 128, M_QI}, {512, 32, M_SPC}, {544, 4, M_SPC + 32}, {548, 256, M_Z}, {804, 256, M_QF}, {1060, 256, M_KF},
        {1316, 256, M_VF}, {1572, 4, M_SPC + 36}, {1576, 256, M_Z + 256}, {1832, 256, M_QS}, {2088, 256, M_KSB}, {2344, 256, M_VS}, {2600, 256, M_Z + 512}, {2856, 256, M_QN},
        {3112, 64, M_KC}, {3176, 64, M_VC}, {3240, 64, M_KSLC}, {3304, 64, M_VSLC}, {3368, 64, M_KWIN}, {3432, 64, M_VWIN}, {3496, 12, M_SPC + 40}, {3508, 256, M_Z + 768},
        {3764, 256, M_QM}, {4020, 256, M_Z + 1024}, {4276, 5120, M_MERGE}};
    int r = 0;
#pragma unroll
    for (int i = 0; i < 27; ++i) r = (n >= seg[i][0] && n < seg[i][0] + seg[i][1]) ? (seg[i][2] + n - seg[i][0]) : r;
    return r;
}
struct Params {
    const float* x; const float* mem; const int* pos; const float* norm_g; const float* w_in; const float* kv_norm;
    const float* w_uk; const float* w_uv; const float* fox_bias; const float* pe_k; const float* pe_v;
    const float* wc1_k; const float* wc2_k; const float* wc1_v; const float* wc2_v; const float* mem_norm;
    const float* w_mem_kv; const float* w_branch; const float* w_out; const float* final_norm;
    float* X; char* ws;
    __device__ __forceinline__ unsigned* bar() const { return (unsigned*)(ws + OFF_bar); }
    __device__ __forceinline__ bf16_t* H() const { return (bf16_t*)(ws + OFF_H); }
    __device__ __forceinline__ bf16_t* Y() const { return (bf16_t*)(ws + OFF_Y); }
    __device__ __forceinline__ bf16_t* ZG() const { return (bf16_t*)(ws + OFF_ZG); }
    __device__ __forceinline__ bf16_t* MG() const { return (bf16_t*)(ws + OFF_MG); }
    __device__ __forceinline__ bf16_t* SIG() const { return (bf16_t*)(ws + OFF_SIG); }
    __device__ __forceinline__ float* CKVR() const { return (float*)(ws + OFF_CKVR); }
    __device__ __forceinline__ bf16_t* CKV() const { return (bf16_t*)(ws + OFF_CKV); }
    __device__ __forceinline__ float* LOGF() const { return (float*)(ws + OFF_LOGF); }
    __device__ __forceinline__ float* CUM() const { return (float*)(ws + OFF_CUM); }
    __device__ __forceinline__ float* CUMT() const { return (float*)(ws + OFF_CUMT); }
    __device__ __forceinline__ float* WI() const { return (float*)(ws + OFF_WI); }
    __device__ __forceinline__ float* GN() const { return (float*)(ws + OFF_GN); }
    __device__ __forceinline__ bf16_t* KCT() const { return (bf16_t*)(ws + OFF_KCT); }
    __device__ __forceinline__ bf16_t* VCTOK() const { return (bf16_t*)(ws + OFF_VCTOK); }
    __device__ __forceinline__ bf16_t* HIDK() const { return (bf16_t*)(ws + OFF_HIDK); }
    __device__ __forceinline__ bf16_t* HIDV() const { return (bf16_t*)(ws + OFF_HIDV); }
    __device__ __forceinline__ bf16_t* KCB() const { return (bf16_t*)(ws + OFF_KCB); }
    __device__ __forceinline__ bf16_t* VCT() const { return (bf16_t*)(ws + OFF_VCT); }
    __device__ __forceinline__ bf16_t* QI() const { return (bf16_t*)(ws + OFF_QI); }
    __device__ __forceinline__ bf16_t* KI() const { return (bf16_t*)(ws + OFF_KI); }
    __device__ __forceinline__ bf16_t* MEMN() const { return (bf16_t*)(ws + OFF_MEMN); }
    __device__ __forceinline__ float* ROPE() const { return (float*)(ws + OFF_ROPE); }
    __device__ __forceinline__ unsigned* DMASK() const { return (unsigned*)(ws + OFF_DMASK); }
    __device__ __forceinline__ unsigned* SMASK() const { return (unsigned*)(ws + OFF_SMASK); }
    __device__ __forceinline__ bf16_t* QA() const { return (bf16_t*)(ws + OFF_QA); }
    __device__ __forceinline__ bf16_t* KAB() const { return (bf16_t*)(ws + OFF_KAB); }
    __device__ __forceinline__ bf16_t* VAT() const { return (bf16_t*)(ws + OFF_VAT); }
    __device__ __forceinline__ bf16_t* QF() const { return (bf16_t*)(ws + OFF_QF); }
    __device__ __forceinline__ bf16_t* KF() const { return (bf16_t*)(ws + OFF_KF); }
    __device__ __forceinline__ bf16_t* VFT() const { return (bf16_t*)(ws + OFF_VFT); }
    __device__ __forceinline__ bf16_t* QS() const { return (bf16_t*)(ws + OFF_QS); }
    __device__ __forceinline__ bf16_t* KSB() const { return (bf16_t*)(ws + OFF_KSB); }
    __device__ __forceinline__ bf16_t* VST() const { return (bf16_t*)(ws + OFF_VST); }
    __device__ __forceinline__ bf16_t* QN() const { return (bf16_t*)(ws + OFF_QN); }
    __device__ __forceinline__ bf16_t* QM() const { return (bf16_t*)(ws + OFF_QM); }
    __device__ __forceinline__ bf16_t* KSLC() const { return (bf16_t*)(ws + OFF_KSLC); }
    __device__ __forceinline__ bf16_t* VSLCT() const { return (bf16_t*)(ws + OFF_VSLCT); }
    __device__ __forceinline__ bf16_t* KWIN() const { return (bf16_t*)(ws + OFF_KWIN); }
    __device__ __forceinline__ bf16_t* VWINT() const { return (bf16_t*)(ws + OFF_VWINT); }
    __device__ __forceinline__ bf16_t* MKB() const { return (bf16_t*)(ws + OFF_MKB); }
    __device__ __forceinline__ bf16_t* MVT() const { return (bf16_t*)(ws + OFF_MVT); }
    __device__ __forceinline__ bf16_t* WIN(int l) const { return (bf16_t*)(ws + OFF_WIN) + (size_t)(l & 1) * NP * D; }
    __device__ __forceinline__ bf16_t* WBR() const { return (bf16_t*)(ws + OFF_WBR); }
    __device__ __forceinline__ bf16_t* WOUT() const { return (bf16_t*)(ws + OFF_WOUT); }
    __device__ __forceinline__ bf16_t* WMKV() const { return (bf16_t*)(ws + OFF_WMKV); }
    __device__ __forceinline__ bf16_t* WUK() const { return (bf16_t*)(ws + OFF_WUK); }
    __device__ __forceinline__ bf16_t* WUV() const { return (bf16_t*)(ws + OFF_WUV); }
    __device__ __forceinline__ bf16_t* WC1T() const { return (bf16_t*)(ws + OFF_WC1T); }
    __device__ __forceinline__ bf16_t* WC2T() const { return (bf16_t*)(ws + OFF_WC2T); }
    __device__ __forceinline__ float* BIASC() const { return (float*)(ws + OFF_BIASC); }
    __device__ __forceinline__ unsigned* qctr() const { return (unsigned*)(ws + OFF_bar) + 4096; }
};

typedef __bf16 bf16x2_t __attribute__((ext_vector_type(2)));
__device__ __forceinline__ unsigned cvt_pk_bf16(float lo, float hi) { bf16x2_t v; v.x = (__bf16)lo; v.y = (__bf16)hi; return __builtin_bit_cast(unsigned, v); }
__device__ __forceinline__ bf16_t f2bf(float x) { return (bf16_t)(cvt_pk_bf16(x, 0.f) & 0xffffu); }
__device__ __forceinline__ unsigned xb_ld(unsigned* p)              { return __hip_atomic_load(p, __ATOMIC_RELAXED, __HIP_MEMORY_SCOPE_AGENT); }
__device__ __forceinline__ unsigned xb_add(unsigned* p, unsigned v) { return __hip_atomic_fetch_add(p, v, __ATOMIC_RELAXED, __HIP_MEMORY_SCOPE_AGENT); }
__device__ __forceinline__ unsigned xb_xcc_id() { return (unsigned)__builtin_amdgcn_s_getreg((3 << 11) | 20) & 0xFu; }
__device__ __forceinline__ int tidx() { int t = threadIdx.x; asm volatile("" : "+v"(t)); return t; }
__device__ __forceinline__ float sigmoid_(float x) { return __builtin_amdgcn_rcpf(1.f + __builtin_amdgcn_exp2f(-1.4426950408889634f * x)); }
__device__ __forceinline__ float silu_(float x) { return x * __builtin_amdgcn_rcpf(1.f + __builtin_amdgcn_exp2f(-1.4426950408889634f * x)); }
__device__ __forceinline__ float logsig_(float x) { return fminf(x, 0.f) - log1pf(expf(-fabsf(x))); }
__device__ __forceinline__ void half_pair(float x, float& lo, float& hi) {
    const auto r = __builtin_amdgcn_permlane32_swap(__float_as_uint(x), __float_as_uint(x), false, false);
    lo = __uint_as_float(r[0]); hi = __uint_as_float(r[1]);
}
__device__ __forceinline__ float half_sum(float x) { float a, b; half_pair(x, a, b); return a + b; }
__device__ __forceinline__ float half_max(float x) { float a, b; half_pair(x, a, b); return fmaxf(a, b); }
__device__ __forceinline__ unsigned half_or(unsigned x) { const auto r = __builtin_amdgcn_permlane32_swap(x, x, false, false); return r[0] | r[1]; }
template <int O> __device__ __forceinline__ float shx(float v) { return __int_as_float(__builtin_amdgcn_ds_swizzle(__float_as_int(v), 0x1F | (O << 10))); }
__device__ __forceinline__ float wave_sum(float v) {
    v = half_sum(v);
    v += shx<16>(v); v += shx<8>(v); v += shx<4>(v); v += shx<2>(v); v += shx<1>(v);
    return v;
}
__device__ __forceinline__ float wave_max(float v) {
    v = half_max(v);
    v = fmaxf(v, shx<16>(v)); v = fmaxf(v, shx<8>(v)); v = fmaxf(v, shx<4>(v)); v = fmaxf(v, shx<2>(v)); v = fmaxf(v, shx<1>(v));
    return v;
}

__device__ __forceinline__ void ph_rope_table(const Params& p, int bid, int nb) {
    for (int i = bid * 256 + tidx(); i < T * 32; i += nb * 256) {
        const int t = i >> 5, f = i & 31;
        const double inv = pow(10000.0, -(double)f / 32.0);
        const double ang = (double)p.pos[t] * inv;
        p.ROPE()[(size_t)t * 64 + f] = (float)cos(ang);
        p.ROPE()[(size_t)t * 64 + 32 + f] = (float)sin(ang);
    }
}

template <class OUT>
__device__ __forceinline__ void ph_rmsnorm(const float* in, const float* g, OUT* out, int rows, int bid, int nb, float dscale = 1.0f) {
    const int lane = tidx() & 63, wid = tidx() >> 6;
    for (int r = bid * 4 + wid; r < rows; r += nb * 4) {
        const float4* ip = (const float4*)(in + (size_t)r * D);
        float4 v[4]; float ss = 0.f;
#pragma unroll
        for (int i = 0; i < 4; ++i) { v[i] = ip[lane + 64 * i]; ss += v[i].x * v[i].x + v[i].y * v[i].y + v[i].z * v[i].z + v[i].w * v[i].w; }
        ss = wave_sum(ss);
        const float sc = dscale / sqrtf(ss * (1.f / D) + 1e-6f);
#pragma unroll
        for (int i = 0; i < 4; ++i) {
            const float4 gg = ((const float4*)g)[lane + 64 * i];
            float4 o; o.x = v[i].x * sc * gg.x; o.y = v[i].y * sc * gg.y; o.z = v[i].z * sc * gg.z; o.w = v[i].w * sc * gg.w;
            if constexpr (sizeof(OUT) == 4) ((float4*)((float*)out + (size_t)r * D))[lane + 64 * i] = o;
            else { u32x2 w; w.x = cvt_pk_bf16(o.x, o.y); w.y = cvt_pk_bf16(o.z, o.w); ((u32x2*)((bf16_t*)out + (size_t)r * D))[lane + 64 * i] = w; }
        }
    }
}

__device__ __forceinline__ void ph_ckvnorm(const Params& p, int layer, int bid, int nb) {
    const int lane = tidx() & 63, wid = tidx() >> 6;
    const float* g = p.kv_norm + layer * 128;
    const float g0 = g[lane], g1 = g[lane + 64];
    const float* __restrict__ src = p.CKVR();
    bf16_t* __restrict__ dst = p.CKV();
    const int stride = nb * 4;
    for (int r0 = bid * 4 + wid; r0 < T; r0 += 8 * stride) {
        float a[8], b[8];
#pragma unroll
        for (int k = 0; k < 8; ++k) { const int r = min(r0 + k * stride, T - 1); a[k] = src[(size_t)r * 128 + lane]; b[k] = src[(size_t)r * 128 + lane + 64]; }
#pragma unroll
        for (int k = 0; k < 8; ++k) {
            const int r = r0 + k * stride;
            const float ss = wave_sum(a[k] * a[k] + b[k] * b[k]);
            const float sc = 1.0f / sqrtf(ss * (1.f / 128.f) + 1e-6f);
            if (r < T) { dst[(size_t)r * 128 + lane] = f2bf(a[k] * sc * g0); dst[(size_t)r * 128 + lane + 64] = f2bf(b[k] * sc * g1); }
        }
    }
}

__device__ __forceinline__ void ckvnorm_rows128(const Params& p, int layer, int row0) {
    const int lane = tidx() & 63, wid = tidx() >> 6;
    const float* g = p.kv_norm + layer * 128;
    const float g0 = g[lane], g1 = g[lane + 64];
    const float* __restrict__ src = p.CKVR() + (size_t)row0 * 128;
    bf16_t* __restrict__ dst = p.CKV() + (size_t)row0 * 128;
#pragma unroll 1
    for (int r0 = wid; r0 < 128; r0 += 32) {
        float a[8], b[8];
#pragma unroll
        for (int k = 0; k < 8; ++k) { a[k] = src[(size_t)(r0 + 4 * k) * 128 + lane]; b[k] = src[(size_t)(r0 + 4 * k) * 128 + lane + 64]; }
#pragma unroll
        for (int k = 0; k < 8; ++k) {
            const float ss = wave_sum(a[k] * a[k] + b[k] * b[k]);
            const float sc = 1.0f / sqrtf(ss * (1.f / 128.f) + 1e-6f);
            dst[(size_t)(r0 + 4 * k) * 128 + lane] = f2bf(a[k] * sc * g0); dst[(size_t)(r0 + 4 * k) * 128 + lane + 64] = f2bf(b[k] * sc * g1);
        }
    }
}

template <bool MAPIN = false>
__device__ __forceinline__ void convert_wt_range(const float* __restrict__ src, bf16_t* __restrict__ dst, int K, int N, int nmat, int it0, int it1, int nstep, float* sm) {
    float (*tl)[65] = (float (*)[65])sm;
    const int tid = tidx(), tk = K / 64, tn = (N + 63) / 64, per = tk * tn, lim = min(it1, per * nmat);
    auto ldtile = [&](int it, float (&v)[16]) {
        const int mat = it / per, r = it % per, k0 = (r % tk) * 64, n0 = (r / tk) * 64, nn = tid & 63, kk0 = tid >> 6;
        const float* s = src + (size_t)mat * K * N + (size_t)(k0 + kk0) * N + n0 + nn;
        const bool ok = n0 + nn < N;
#pragma unroll
        for (int j = 0; j < 16; ++j) v[j] = ok ? s[(size_t)(4 * j) * N] : 0.f;
    };
    float cur[16];
    int it = it0;
    if (it < lim) ldtile(it, cur);
    while (it < lim) {
        const int mat = it / per, r = it % per, k0 = (r % tk) * 64, n0 = (r / tk) * 64;
        bf16_t* d = dst + (size_t)mat * K * N;
        const int nit = it + nstep;
        __syncthreads();
#pragma unroll
        for (int j = 0; j < 16; ++j) tl[(tid >> 6) + 4 * j][tid & 63] = cur[j];
        if (nit < lim) ldtile(nit, cur);
        __syncthreads();
        {
            const int nn = tid >> 2, kq = (tid & 3) * 16;
            if (n0 + nn < N) {
                u32x4 w0, w1;
                w0.x = cvt_pk_bf16(tl[kq + 0][nn], tl[kq + 1][nn]); w0.y = cvt_pk_bf16(tl[kq + 2][nn], tl[kq + 3][nn]);
                w0.z = cvt_pk_bf16(tl[kq + 4][nn], tl[kq + 5][nn]); w0.w = cvt_pk_bf16(tl[kq + 6][nn], tl[kq + 7][nn]);
                w1.x = cvt_pk_bf16(tl[kq + 8][nn], tl[kq + 9][nn]); w1.y = cvt_pk_bf16(tl[kq + 10][nn], tl[kq + 11][nn]);
                w1.z = cvt_pk_bf16(tl[kq + 12][nn], tl[kq + 13][nn]); w1.w = cvt_pk_bf16(tl[kq + 14][nn], tl[kq + 15][nn]);
                const int drow = MAPIN ? map_in_col(n0 + nn) : (n0 + nn);
                u32x4* dp = (u32x4*)(d + (size_t)drow * K + k0 + kq);
                dp[0] = w0; dp[1] = w1;
            }
        }
        it = nit;
    }
    __syncthreads();
}
template <bool MAPIN = false>
__device__ __forceinline__ void convert_wt(const float* __restrict__ src, bf16_t* __restrict__ dst, int K, int N, int nmat, int bid, int nb, float* sm) {
    convert_wt_range<MAPIN>(src, dst, K, N, nmat, bid, 1 << 30, nb, sm);
}

constexpr int GROW = 80;
constexpr int GA_BYTES = 128 * GROW;
struct GStage { u32x4 a0, a1, b0, b1; };
template <int BN, int DEPTH = 3>
__device__ __forceinline__ void tile_mac(f32x16 (&acc)[2][BN / 64], const bf16_t* __restrict__ A, int lda, int m0,
                                         const bf16_t* __restrict__ Bt, int ldb, int n0, int nmax, int K, char* sm) {
    constexpr int NT = BN / 64;
    constexpr int B_BYTES = BN * GROW;
    constexpr int BUF = GA_BYTES + B_BYTES;
    const int tid = tidx(), lane = tid & 63, wid = __builtin_amdgcn_readfirstlane(tid >> 6), wr = wid >> 1, wc = wid & 1;
    const int lr = lane & 31, lh = lane >> 5;
    const int ar0 = tid >> 2, akq = tid & 3;
    const bf16_t* Ab = A + (size_t)m0 * lda;
    const bf16_t* Bb = Bt + (size_t)n0 * ldb;
    const unsigned ao0 = (unsigned)(ar0 * lda + akq * 8), ao1 = ao0 + (unsigned)(64 * lda);
    const int br0 = tid >> 2;
    const bool bv0 = (n0 + br0) < nmax, bv1 = (NT == 2) && ((n0 + br0 + 64) < nmax);
    const unsigned bo0 = (unsigned)((bv0 ? br0 : 0) * ldb + akq * 8), bo1 = (unsigned)((bv1 ? br0 + 64 : 0) * ldb + akq * 8);
    const int st_a0 = ar0 * GROW + akq * 16, st_a1 = (ar0 + 64) * GROW + akq * 16;
    const int st_b0 = GA_BYTES + br0 * GROW + akq * 16, st_b1 = GA_BYTES + (br0 + 64) * GROW + akq * 16;
    const int rd_a = (wr * 64 + lr) * GROW + lh * 16, rd_b = GA_BYTES + (wc * (BN / 2) + lr) * GROW + lh * 16;
    const u32x4 zero4 = {0u, 0u, 0u, 0u};
    const int nk = K / 32;
    auto gload = [&](GStage& g, int ks) {
        const unsigned ko = (unsigned)ks * 32u;
        g.a0 = *(const u32x4*)(Ab + (ao0 + ko)); g.a1 = *(const u32x4*)(Ab + (ao1 + ko));
        g.b0 = *(const u32x4*)(Bb + (bo0 + ko)); if (NT == 2) g.b1 = *(const u32x4*)(Bb + (bo1 + ko));
    };
    auto lstore = [&](const GStage& g, char* buf) {
        *(u32x4*)(buf + st_a0) = g.a0; *(u32x4*)(buf + st_a1) = g.a1;
        *(u32x4*)(buf + st_b0) = bv0 ? g.b0 : zero4; if (NT == 2) *(u32x4*)(buf + st_b1) = bv1 ? g.b1 : zero4;
    };
    auto compute = [&](const char* cur) {
#pragma unroll
        for (int s = 0; s < 2; ++s) {
            bf16x8 a[2], b[NT];
#pragma unroll
            for (int mi = 0; mi < 2; ++mi) a[mi] = *(const bf16x8*)(cur + rd_a + mi * 32 * GROW + s * 32);
#pragma unroll
            for (int ni = 0; ni < NT; ++ni) b[ni] = *(const bf16x8*)(cur + rd_b + ni * 32 * GROW + s * 32);
#pragma unroll
            for (int mi = 0; mi < 2; ++mi)
#pragma unroll
                for (int ni = 0; ni < NT; ++ni) acc[mi][ni] = __builtin_amdgcn_mfma_f32_32x32x16_bf16(a[mi], b[ni], acc[mi][ni], 0, 0, 0);
        }
    };
    GStage g0, g1, g2;
    g1.b1 = zero4; g2.b1 = zero4; g0.b1 = zero4;
    const int last = nk - 1;
    gload(g0, 0);
    gload(g1, min(1, last));
    if (DEPTH == 3) gload(g2, min(2, last));
    __syncthreads();
    lstore(g0, sm);
    __syncthreads();
#define GSTEP(k, GL, GS) { gload(GL, min((k) + DEPTH, last)); compute(sm + ((k) & 1) * BUF); lstore(GS, sm + (((k) + 1) & 1) * BUF); __syncthreads(); }
    int ks = 0;
    if (DEPTH == 3) {
#pragma unroll 1
        for (; ks + 3 <= nk; ks += 3) {
            GSTEP(ks, g0, g1)
            GSTEP(ks + 1, g1, g2)
            GSTEP(ks + 2, g2, g0)
        }
        if (ks < nk) {
            GSTEP(ks, g0, g1)
            if (ks + 1 < nk) GSTEP(ks + 1, g1, g2)
        }
    } else if (DEPTH == 2) {
#pragma unroll 1
        for (; ks + 2 <= nk; ks += 2) {
            GSTEP(ks, g0, g1)
            GSTEP(ks + 1, g1, g0)
        }
        if (ks < nk) GSTEP(ks, g0, g1)
    } else {
#pragma unroll 1
        for (; ks < nk; ++ks) GSTEP(ks, g1, g1)
    }
#undef GSTEP
}
constexpr int DMA_STAGE = 16384, GEMM_NST = 3;
#define DMA_WAIT(n) asm volatile("s_waitcnt vmcnt(" #n ")" ::: "memory")
template <int NST>
__device__ __forceinline__ void tile_mac_dma(f32x16 (&acc)[2][2], const bf16_t* __restrict__ A, int lda, int m0,
                                             const bf16_t* __restrict__ Bt, int ldb, int n0, int K, char* sm) {
    static_assert(NST == 3 || NST == 4, "ring of 3 or 4 stages");
    const int tid = tidx(), lane = tid & 63, wid = __builtin_amdgcn_readfirstlane(tid >> 6), wr = wid >> 1, wc = wid & 1;
    const int lr = lane & 31, lh = lane >> 5;
    const int srow = tid >> 2, sslot = tid & 3, schunk = sslot ^ ((srow >> 2) & 3);
    const bf16_t* Ab = A + (size_t)m0 * lda;
    const bf16_t* Bb = Bt + (size_t)n0 * ldb;
    const unsigned ao0 = (unsigned)(srow * lda + schunk * 8), ao1 = ao0 + (unsigned)(64 * lda);
    const unsigned bo0 = (unsigned)(srow * ldb + schunk * 8), bo1 = bo0 + (unsigned)(64 * ldb);
    const int ldst = tid * 16;
    const int sw = (lr >> 2) & 3;
    const int rd_a = (wr * 64 + lr) * 64, rd_b = 8192 + (wc * 64 + lr) * 64;
    const int so0 = ((lh) ^ sw) * 16, so1 = ((lh + 2) ^ sw) * 16;
    const int nk = K / 32, last = nk - 1;
    auto issue = [&](int ks, int slot) {
        const unsigned ko = (unsigned)ks * 32u;
        char* st = sm + slot * DMA_STAGE + ldst;
        __builtin_amdgcn_global_load_lds((const unsigned*)(Ab + (ao0 + ko)), (unsigned*)(st), 16, 0, 0);
        __builtin_amdgcn_global_load_lds((const unsigned*)(Ab + (ao1 + ko)), (unsigned*)(st + 4096), 16, 0, 0);
        __builtin_amdgcn_global_load_lds((const unsigned*)(Bb + (bo0 + ko)), (unsigned*)(st + 8192), 16, 0, 0);
        __builtin_amdgcn_global_load_lds((const unsigned*)(Bb + (bo1 + ko)), (unsigned*)(st + 12288), 16, 0, 0);
    };
    auto compute = [&](int slot) {
        const char* cur = sm + slot * DMA_STAGE;
        bf16x8 a[2][2], b[2][2];
#pragma unroll
        for (int mi = 0; mi < 2; ++mi) { a[mi][0] = *(const bf16x8*)(cur + rd_a + mi * 2048 + so0); a[mi][1] = *(const bf16x8*)(cur + rd_a + mi * 2048 + so1); }
#pragma unroll
        for (int ni = 0; ni < 2; ++ni) { b[ni][0] = *(const bf16x8*)(cur + rd_b + ni * 2048 + so0); b[ni][1] = *(const bf16x8*)(cur + rd_b + ni * 2048 + so1); }
#pragma unroll
        for (int s = 0; s < 2; ++s)
#pragma unroll
            for (int mi = 0; mi < 2; ++mi)
#pragma unroll
                for (int ni = 0; ni < 2; ++ni) acc[mi][ni] = __builtin_amdgcn_mfma_f32_32x32x16_bf16(a[mi][s], b[ni][s], acc[mi][ni], 0, 0, 0);
    };
    __syncthreads();
#pragma unroll
    for (int s = 0; s < NST - 1; ++s) issue(min(s, last), s);
    int slot = 0, nslot = NST - 1;
#pragma unroll 1
    for (int ks = 0; ks < nk; ++ks) {
        if (NST == 3) DMA_WAIT(4); else DMA_WAIT(8);
        __builtin_amdgcn_s_barrier();
        issue(min(ks + NST - 1, last), nslot);
        compute(slot);
        slot = (slot + 1 == NST) ? 0 : slot + 1; nslot = (nslot + 1 == NST) ? 0 : nslot + 1;
    }
    DMA_WAIT(0);
}
constexpr int BIG_STAGE = 24576;
__device__ __forceinline__ void tile_mac_big(f32x16 (&acc)[4][2], const bf16_t* __restrict__ A, int lda, int m0,
                                             const bf16_t* __restrict__ Bt, int ldb, int n0, int K, char* sm) {
    const int tid = tidx(), lane = tid & 63, wid = __builtin_amdgcn_readfirstlane(tid >> 6), wr = wid >> 1, wc = wid & 1;
    const int lr = lane & 31, lh = lane >> 5;
    const int srow = tid >> 2, sslot = tid & 3, schunk = sslot ^ ((srow >> 2) & 3);
    const bf16_t* Ab = A + (size_t)m0 * lda;
    const bf16_t* Bb = Bt + (size_t)n0 * ldb;
    const unsigned ao0 = (unsigned)(srow * lda + schunk * 8), bo0 = (unsigned)(srow * ldb + schunk * 8);
    const int ldst = tid * 16;
    const int sw = (lr >> 2) & 3;
    const int rd_a = (wr * 128 + lr) * 64, rd_b = 16384 + (wc * 64 + lr) * 64;
    const int so0 = ((lh) ^ sw) * 16, so1 = ((lh + 2) ^ sw) * 16;
    const int nk = K / 32, last = nk - 1;
    auto issue1 = [&](int ks, int slot, int i) {
        const unsigned ko = (unsigned)ks * 32u;
        char* st = sm + slot * BIG_STAGE + ldst + i * 4096;
        if (i < 4) __builtin_amdgcn_global_load_lds((const unsigned*)(Ab + (ao0 + (unsigned)(64 * i * lda) + ko)), (unsigned*)st, 16, 0, 0);
        else __builtin_amdgcn_global_load_lds((const unsigned*)(Bb + (bo0 + (unsigned)(64 * (i - 4) * ldb) + ko)), (unsigned*)st, 16, 0, 0);
    };
    __syncthreads();
#pragma unroll
    for (int i = 0; i < 6; ++i) issue1(0, 0, i);
#pragma unroll
    for (int i = 0; i < 6; ++i) issue1(min(1, last), 1, i);
    int slot = 0, nslot = 2;
#pragma unroll 1
    for (int ks = 0; ks < nk; ++ks) {
        DMA_WAIT(6);
        __builtin_amdgcn_s_barrier();
        const char* cur = sm + slot * BIG_STAGE;
        const int kn = min(ks + 2, last);
        bf16x8 a0[4], b0[2], a1[4], b1[2];
#pragma unroll
        for (int mi = 0; mi < 4; ++mi) a0[mi] = *(const bf16x8*)(cur + rd_a + mi * 2048 + so0);
#pragma unroll
        for (int ni = 0; ni < 2; ++ni) b0[ni] = *(const bf16x8*)(cur + rd_b + ni * 2048 + so0);
#pragma unroll
        for (int mi = 0; mi < 4; ++mi) a1[mi] = *(const bf16x8*)(cur + rd_a + mi * 2048 + so1);
#pragma unroll
        for (int ni = 0; ni < 2; ++ni) b1[ni] = *(const bf16x8*)(cur + rd_b + ni * 2048 + so1);
        __builtin_amdgcn_sched_barrier(0);
#pragma unroll
        for (int mi = 0; mi < 4; ++mi) {
            acc[mi][0] = __builtin_amdgcn_mfma_f32_32x32x16_bf16(a0[mi], b0[0], acc[mi][0], 0, 0, 0);
            acc[mi][1] = __builtin_amdgcn_mfma_f32_32x32x16_bf16(a0[mi], b0[1], acc[mi][1], 0, 0, 0);
            __builtin_amdgcn_sched_barrier(0);
            issue1(kn, nslot, mi);
            __builtin_amdgcn_sched_barrier(0);
        }
#pragma unroll
        for (int mi = 0; mi < 4; ++mi) {
            acc[mi][0] = __builtin_amdgcn_mfma_f32_32x32x16_bf16(a1[mi], b1[0], acc[mi][0], 0, 0, 0);
            acc[mi][1] = __builtin_amdgcn_mfma_f32_32x32x16_bf16(a1[mi], b1[1], acc[mi][1], 0, 0, 0);
            if (mi < 2) {
                __builtin_amdgcn_sched_barrier(0);
                issue1(kn, nslot, 4 + mi);
                __builtin_amdgcn_sched_barrier(0);
            }
        }
        slot = (slot + 1 == 3) ? 0 : slot + 1; nslot = (nslot + 1 == 3) ? 0 : nslot + 1;
    }
    DMA_WAIT(0);
}
__device__ __forceinline__ void tile_mac_dma64(f32x16 (&acc)[2][2], const bf16_t* __restrict__ A, int lda, int m0,
                                               const bf16_t* __restrict__ Bt, int ldb, int n0, int K, char* sm) {
    constexpr int STG = 32768;
    const int tid = tidx(), lane = tid & 63, wid = __builtin_amdgcn_readfirstlane(tid >> 6), wr = wid >> 1, wc = wid & 1;
    const int lr = lane & 31, lh = lane >> 5;
    const int srow = tid >> 3, schunk = (tid & 7) ^ ((tid >> 4) & 7);
    const bf16_t* Ab = A + (size_t)m0 * lda;
    const bf16_t* Bb = Bt + (size_t)n0 * ldb;
    const unsigned ao = (unsigned)(srow * lda + schunk * 8), bo = (unsigned)(srow * ldb + schunk * 8);
    const unsigned a32 = (unsigned)(32 * lda), b32 = (unsigned)(32 * ldb);
    const int ldst = tid * 16;
    const int sw = (lr >> 1) & 7;
    const int rd_a = (wr * 64 + lr) * 128, rd_b = 16384 + (wc * 64 + lr) * 128;
    const int nk = K / 64, last = nk - 1;
    auto issue = [&](int ks, int slot) {
        const unsigned ko = (unsigned)ks * 64u;
        char* st = sm + slot * STG + ldst;
#pragma unroll
        for (int i = 0; i < 4; ++i) __builtin_amdgcn_global_load_lds((const unsigned*)(Ab + (ao + i * a32 + ko)), (unsigned*)(st + i * 4096), 16, 0, 0);
#pragma unroll
        for (int i = 0; i < 4; ++i) __builtin_amdgcn_global_load_lds((const unsigned*)(Bb + (bo + i * b32 + ko)), (unsigned*)(st + 16384 + i * 4096), 16, 0, 0);
    };
    auto compute = [&](int slot) {
        const char* cur = sm + slot * STG;
#pragma unroll
        for (int s = 0; s < 4; ++s) {
            const int so = ((lh + 2 * s) ^ sw) * 16;
            bf16x8 a[2], b[2];
#pragma unroll
            for (int mi = 0; mi < 2; ++mi) a[mi] = *(const bf16x8*)(cur + rd_a + mi * 4096 + so);
#pragma unroll
            for (int ni = 0; ni < 2; ++ni) b[ni] = *(const bf16x8*)(cur + rd_b + ni * 4096 + so);
#pragma unroll
            for (int mi = 0; mi < 2; ++mi)
#pragma unroll
                for (int ni = 0; ni < 2; ++ni) acc[mi][ni] = __builtin_amdgcn_mfma_f32_32x32x16_bf16(a[mi], b[ni], acc[mi][ni], 0, 0, 0);
        }
    };
    __syncthreads();
    issue(0, 0);
#pragma unroll 1
    for (int ks = 0; ks < nk; ++ks) {
        DMA_WAIT(0);
        __builtin_amdgcn_s_barrier();
        if (ks < last) issue(ks + 1, (ks + 1) & 1);
        compute(ks & 1);
    }
    DMA_WAIT(0);
}
struct GStage64 { u32x4 a[4], b[4]; };
__device__ __forceinline__ void tile_mac_reg64(f32x16 (&acc)[2][2], const bf16_t* __restrict__ A, int lda, int m0,
                                               const bf16_t* __restrict__ Bt, int ldb, int n0, int K, char* sm) {
    constexpr int STG = 32768;
    const int tid = tidx(), lane = tid & 63, wid = __builtin_amdgcn_readfirstlane(tid >> 6), wr = wid >> 1, wc = wid & 1;
    const int lr = lane & 31, lh = lane >> 5;
    const int srow = tid >> 3, schunk = (tid & 7) ^ ((tid >> 4) & 7);
    const bf16_t* Ab = A + (size_t)m0 * lda;
    const bf16_t* Bb = Bt + (size_t)n0 * ldb;
    const unsigned ao = (unsigned)(srow * lda + schunk * 8), bo = (unsigned)(srow * ldb + schunk * 8);
    const unsigned a32 = (unsigned)(32 * lda), b32 = (unsigned)(32 * ldb);
    const int ldst = tid * 16;
    const int sw = (lr >> 1) & 7;
    const int rd_a = (wr * 64 + lr) * 128, rd_b = 16384 + (wc * 64 + lr) * 128;
    const int nk = K / 64, last = nk - 1;
    auto gload = [&](GStage64& g, int ks) {
        const unsigned ko = (unsigned)ks * 64u;
#pragma unroll
        for (int i = 0; i < 4; ++i) { g.a[i] = *(const u32x4*)(Ab + (ao + i * a32 + ko)); g.b[i] = *(const u32x4*)(Bb + (bo + i * b32 + ko)); }
    };
    auto lstore = [&](const GStage64& g, int slot) {
        char* st = sm + slot * STG + ldst;
#pragma unroll
        for (int i = 0; i < 4; ++i) { *(u32x4*)(st + i * 4096) = g.a[i]; *(u32x4*)(st + 16384 + i * 4096) = g.b[i]; }
    };
    auto compute = [&](int slot) {
        const char* cur = sm + slot * STG;
        bf16x8 fa[2][2], fb[2][2];
#pragma unroll
        for (int mi = 0; mi < 2; ++mi) fa[0][mi] = *(const bf16x8*)(cur + rd_a + mi * 4096 + ((lh ^ sw) * 16));
#pragma unroll
        for (int ni = 0; ni < 2; ++ni) fb[0][ni] = *(const bf16x8*)(cur + rd_b + ni * 4096 + ((lh ^ sw) * 16));
#pragma unroll
        for (int s = 0; s < 4; ++s) {
            if (s < 3) {
                const int so = ((lh + 2 * (s + 1)) ^ sw) * 16;
#pragma unroll
                for (int mi = 0; mi < 2; ++mi) fa[(s + 1) & 1][mi] = *(const bf16x8*)(cur + rd_a + mi * 4096 + so);
#pragma unroll
                for (int ni = 0; ni < 2; ++ni) fb[(s + 1) & 1][ni] = *(const bf16x8*)(cur + rd_b + ni * 4096 + so);
            }
#pragma unroll
            for (int mi = 0; mi < 2; ++mi)
#pragma unroll
                for (int ni = 0; ni < 2; ++ni) acc[mi][ni] = __builtin_amdgcn_mfma_f32_32x32x16_bf16(fa[s & 1][mi], fb[s & 1][ni], acc[mi][ni], 0, 0, 0);
        }
        __builtin_amdgcn_sched_group_barrier(0x100, 8, 0);
        __builtin_amdgcn_sched_group_barrier(0x008, 4, 0);
        __builtin_amdgcn_sched_group_barrier(0x100, 4, 0);
        __builtin_amdgcn_sched_group_barrier(0x008, 4, 0);
        __builtin_amdgcn_sched_group_barrier(0x100, 4, 0);
        __builtin_amdgcn_sched_group_barrier(0x008, 8, 0);
    };
    GStage64 g0, g1;
    gload(g0, 0);
    gload(g1, min(1, last));
    __syncthreads();
    lstore(g0, 0);
    __syncthreads();
#define GSTEP64(k, GL, GS) { gload(GL, min((k) + 2, last)); compute((k) & 1); lstore(GS, ((k) + 1) & 1); __syncthreads(); }
    int ks = 0;
#pragma unroll 1
    for (; ks + 2 <= nk; ks += 2) {
        GSTEP64(ks, g0, g1)
        GSTEP64(ks + 1, g1, g0)
    }
    if (ks < nk) GSTEP64(ks, g0, g1)
#undef GSTEP64
}
template <int NT> __device__ __forceinline__ void acc_zero(f32x16 (&acc)[2][NT]) {
#pragma unroll
    for (int mi = 0; mi < 2; ++mi)
#pragma unroll
        for (int ni = 0; ni < NT; ++ni)
#pragma unroll
            for (int r = 0; r < 16; ++r) acc[mi][ni][r] = 0.f;
}
template <int BN, class Epi>
__device__ __forceinline__ void gemm_bf16(const bf16_t* A, int lda, const bf16_t* Bt, int ldb, int M, int N, int K, const Epi& epi, int bid, int nb, char* sm) {
    constexpr int NT = BN / 64;
    const int tm = M / 128, tn = (N + BN - 1) / BN;
    for (int tile = bid; tile < tm * tn; tile += nb) {
        const int m0 = (tile % tm) * 128, n0 = (tile / tm) * BN;
        f32x16 acc[2][NT]; acc_zero<NT>(acc);
        if constexpr (BN == 128) { if (K % 64 == 0 && K >= 128) tile_mac_reg64(acc, A, lda, m0, Bt, ldb, n0, K, sm); else tile_mac_dma<GEMM_NST>(acc, A, lda, m0, Bt, ldb, n0, K, sm); }
        else tile_mac<BN>(acc, A, lda, m0, Bt, ldb, n0, N, K, sm);
        const int lane = tidx() & 63, wid = __builtin_amdgcn_readfirstlane(tidx() >> 6), wr = wid >> 1, wc = wid & 1, lr = lane & 31, lh = lane >> 5;
        const int col0 = n0 + wc * (BN / 2);
        if (col0 < N) epi(acc, m0 + wr * 64, col0, lr, lh, sm + (((K / 64) & 1) ? 32768 : 0) + wid * 8192);
    }
}
template <class Epi>
__device__ __forceinline__ int gemm_big(const bf16_t* A, int lda, const bf16_t* Bt, int ldb, int M, int N, int K, const Epi& epi, int bid, int nb, char* sm) {
    const int tm = M / 256, tn = N / 128, ntb = tm * tn, nfull = (ntb / nb) * nb;
    for (int tile = bid; tile < nfull; tile += nb) {
        const int m0 = (tile % tm) * 256, n0 = (tile / tm) * 128;
        f32x16 acc[4][2];
        acc_zero<2>(reinterpret_cast<f32x16 (&)[2][2]>(acc[0])); acc_zero<2>(reinterpret_cast<f32x16 (&)[2][2]>(acc[2]));
        tile_mac_big(acc, A, lda, m0, Bt, ldb, n0, K, sm);
        __syncthreads();
        const int lane = tidx() & 63, wid = __builtin_amdgcn_readfirstlane(tidx() >> 6), wr = wid >> 1, wc = wid & 1, lr = lane & 31, lh = lane >> 5;
        epi(reinterpret_cast<const f32x16 (&)[2][2]>(acc[0]), m0 + wr * 128, n0 + wc * 64, lr, lh, sm + wid * 8192);
        epi(reinterpret_cast<const f32x16 (&)[2][2]>(acc[2]), m0 + wr * 128 + 64, n0 + wc * 64, lr, lh, sm + wid * 8192);
    }
    const int nsmall = 2 * (ntb - nfull);
    for (int st = bid; st < nsmall; st += nb) {
        const int tile = nfull + (st >> 1);
        const int m0 = (tile % tm) * 256 + (st & 1) * 128, n0 = (tile / tm) * 128;
        f32x16 acc[2][2]; acc_zero<2>(acc);
        tile_mac_reg64(acc, A, lda, m0, Bt, ldb, n0, K, sm);
        const int lane = tidx() & 63, wid = __builtin_amdgcn_readfirstlane(tidx() >> 6), wr = wid >> 1, wc = wid & 1, lr = lane & 31, lh = lane >> 5;
        epi(acc, m0 + wr * 64, n0 + wc * 64, lr, lh, sm + (((K / 64) & 1) ? 32768 : 0) + wid * 8192);
    }
    return nsmall < nb ? nsmall : nb;
}
#define EROW(mi, r) (row0 + (mi) * 32 + ((r) & 3) + 8 * ((r) >> 2) + 4 * lh)
__device__ __forceinline__ float bf2f(bf16_t h) { return __uint_as_float((unsigned)h << 16); }
__device__ __forceinline__ void epi_rope64(const f32x16 (&acc)[2][2], int row0, int lr, int lh, const float* __restrict__ rope, bf16_t* __restrict__ dst, int ld, int cbase) {
#pragma unroll
    for (int mi = 0; mi < 2; ++mi)
#pragma unroll
        for (int r = 0; r < 16; ++r) {
            const size_t row = EROW(mi, r);
            const float c = rope[row * 64 + lr], s = rope[row * 64 + 32 + lr], x1 = acc[mi][0][r], x2 = acc[mi][1][r];
            dst[row * ld + cbase + lr] = f2bf(x1 * c - x2 * s); dst[row * ld + cbase + 32 + lr] = f2bf(x2 * c + x1 * s);
        }
}
template <int NTI>
__device__ __forceinline__ void epi_rope32(const f32x16 (&acc)[2][2], int row0, int lr, int lh, const float* __restrict__ rope, bf16_t* __restrict__ dst, int ld, int cbase) {
    const int f = lr & 15;
#pragma unroll
    for (int mi = 0; mi < 2; ++mi)
#pragma unroll
        for (int ni = 0; ni < NTI; ++ni)
#pragma unroll
            for (int r = 0; r < 16; ++r) {
                const size_t row = EROW(mi, r);
                const float x = acc[mi][ni][r], xo = shx<16>(x);
                const float c = rope[row * 64 + 2 * f], s = rope[row * 64 + 32 + 2 * f];
                dst[row * ld + cbase + ni * 32 + lr] = f2bf((lr & 16) ? (x * c + xo * s) : (x * c - xo * s));
            }
}
template <int NT, bool SILU>
__device__ __forceinline__ void epi_bf16(const f32x16 (&acc)[2][NT], int row0, int lr, int lh, bf16_t* __restrict__ dst, int ld, int cbase) {
#pragma unroll
    for (int mi = 0; mi < 2; ++mi)
#pragma unroll
        for (int ni = 0; ni < NT; ++ni)
#pragma unroll
            for (int r = 0; r < 16; ++r) { const float v = acc[mi][ni][r]; dst[(size_t)EROW(mi, r) * ld + cbase + ni * 32 + lr] = f2bf(SILU ? silu_(v) : v); }
}
template <int NT>
__device__ __forceinline__ void epi_vt(const f32x16 (&acc)[2][NT], int trow0, int lr, int lh, bf16_t* __restrict__ vt, size_t ldv) {
#pragma unroll
    for (int mi = 0; mi < 2; ++mi)
#pragma unroll
        for (int ni = 0; ni < NT; ++ni)
#pragma unroll
            for (int g = 0; g < 4; ++g) {
                u32x2 o; o.x = cvt_pk_bf16(acc[mi][ni][4 * g], acc[mi][ni][4 * g + 1]); o.y = cvt_pk_bf16(acc[mi][ni][4 * g + 2], acc[mi][ni][4 * g + 3]);
                *(u32x2*)(vt + (size_t)(ni * 32 + lr) * ldv + trow0 + mi * 32 + 8 * g + 4 * lh) = o;
            }
}
template <int NT>
__device__ __forceinline__ void epi_f32(const f32x16 (&acc)[2][NT], int row0, int lr, int lh, float* __restrict__ dst, int ld, int cbase) {
#pragma unroll
    for (int mi = 0; mi < 2; ++mi)
#pragma unroll
        for (int ni = 0; ni < NT; ++ni)
#pragma unroll
            for (int r = 0; r < 16; ++r) dst[(size_t)EROW(mi, r) * ld + cbase + ni * 32 + lr] = acc[mi][ni][r];
}
template <class F>
__device__ __forceinline__ void staged_bf16_tile(char* stg, bf16_t* dp, size_t ld, int lr, int lh, F val) {
    bf16_t* sg = (bf16_t*)stg;
#pragma unroll
    for (int mi = 0; mi < 2; ++mi)
#pragma unroll
        for (int r = 0; r < 16; ++r) {
            const int rl = mi * 32 + (r & 3) + 8 * (r >> 2) + 4 * lh;
            float o0, o1; val(mi, r, rl, o0, o1);
            sg[rl * 64 + ((((lr >> 3)) ^ (rl & 7)) << 3) + (lr & 7)] = f2bf(o0); sg[rl * 64 + ((((lr >> 3) + 4) ^ (rl & 7)) << 3) + (lr & 7)] = f2bf(o1);
        }
    __builtin_amdgcn_wave_barrier();
    const int lane = lh * 32 + lr;
#pragma unroll
    for (int i = 0; i < 8; ++i) {
        const int piece = lane + 64 * i, rr = piece >> 3, ch = piece & 7;
        const u32x4 v = *(const u32x4*)(sg + rr * 64 + ((ch ^ (rr & 7)) << 3));
        *(u32x4*)(dp + (size_t)rr * ld + ch * 8) = v;
    }
    __builtin_amdgcn_wave_barrier();
}
constexpr float QSCALE = 0.125f * 1.4426950408889634f;
struct EpiInProj {
    const Params& p; int layer;
    __device__ __forceinline__ void operator()(const f32x16 (&acc)[2][2], int row0, int col0, int lr, int lh, char* stg) const {
        const int b = row0 / S, t0 = row0 % S;
        const float* rope = p.ROPE();
        int kind, ld = 256, cbase = 0; size_t off = 0; bool silu = false; float osc = 1.f;
        if (col0 < M_QN)         { kind = 0; off = OFF_QA; cbase = col0 - M_QA; osc = QSCALE; }
        else if (col0 < M_KSLC)  { kind = 0; off = OFF_QN; cbase = col0 - M_QN; osc = QSCALE; }
        else if (col0 == M_KSLC) { kind = 0; off = OFF_KSLC; ld = 64; }
        else if (col0 == M_KWIN) { kind = 0; off = OFF_KWIN; ld = 64; }
        else if (col0 == M_KC)   { kind = 0; off = OFF_KCT; ld = 64; }
        else if (col0 == M_VC)   { kind = 1; off = OFF_VCTOK; ld = 64; }
        else if (col0 < M_KF)    { kind = 1; off = OFF_QF; cbase = col0 - M_QF; osc = QSCALE; }
        else if (col0 < M_QS)    { kind = 1; off = OFF_KF; cbase = col0 - M_KF; }
        else if (col0 < M_KSB)   { kind = 1; off = OFF_QS; cbase = col0 - M_QS; osc = QSCALE; }
        else if (col0 < M_QM)    { kind = 1; off = OFF_KSB; cbase = col0 - M_KSB; }
        else if (col0 < M_VF)    { kind = 1; off = OFF_QM; cbase = col0 - M_QM; osc = QSCALE; }
        else if (col0 < M_VS)    { kind = 2; off = OFF_VFT + ((size_t)(b * 4 + (col0 - M_VF) / 64) * 64) * S * 2; }
        else if (col0 < M_VSLC)  { kind = 2; off = OFF_VST + ((size_t)(b * 4 + (col0 - M_VS) / 64) * 64) * S * 2; }
        else if (col0 == M_VSLC) { kind = 2; off = OFF_VSLCT + ((size_t)b * 64) * S * 2; }
        else if (col0 == M_VWIN) { kind = 2; off = OFF_VWINT + ((size_t)b * 64) * S * 2; }
        else if (col0 < M_SPC)   { kind = 3; off = OFF_QI; ld = 128; cbase = col0 - M_QI; }
        else if (col0 == M_SPC)  { kind = 4; }
        else if (col0 < M_Z)     { kind = 5; off = OFF_CKVR; ld = 128; cbase = col0 - M_CKV; }
        else if (col0 < NPM)     { kind = 1; off = OFF_ZG; ld = 1280; cbase = col0 - M_Z; silu = true; }
        else if (col0 < M_MERGE) { return; }
        else                     { kind = 6; }
        bf16_t* dst = (bf16_t*)(p.ws + off);
        float kamax = 0.f;
        if (kind <= 3) {
            bf16_t* sg = (bf16_t*)stg;
            if (kind == 2) {
#pragma unroll
                for (int mi = 0; mi < 2; ++mi)
#pragma unroll
                    for (int ni = 0; ni < 2; ++ni)
#pragma unroll
                        for (int g = 0; g < 4; ++g) {
                            u32x2 o; o.x = cvt_pk_bf16(acc[mi][ni][4 * g], acc[mi][ni][4 * g + 1]); o.y = cvt_pk_bf16(acc[mi][ni][4 * g + 2], acc[mi][ni][4 * g + 3]);
                            const int d = ni * 32 + lr, tk = mi * 32 + 8 * g + 4 * lh;
                            *(u32x2*)(sg + d * 64 + (((tk >> 3) ^ (d & 7)) << 3) + (tk & 7)) = o;
                        }
            } else {
#pragma unroll
                for (int mi = 0; mi < 2; ++mi)
#pragma unroll
                    for (int r = 0; r < 16; ++r) {
                        const int rl = mi * 32 + (r & 3) + 8 * (r >> 2) + 4 * lh;
                        const size_t row = (size_t)row0 + rl;
                        float o0, o1;
                        if (kind == 0) {
                            const float c = rope[row * 64 + lr], s = rope[row * 64 + 32 + lr], x1 = acc[mi][0][r], x2 = acc[mi][1][r];
                            o0 = x1 * c - x2 * s; o1 = x2 * c + x1 * s;
                        } else if (kind == 3) {
                            const int f = lr & 15;
                            const float c = rope[row * 64 + 2 * f], s = rope[row * 64 + 32 + 2 * f];
                            const float x0 = acc[mi][0][r], x1 = acc[mi][1][r], y0 = shx<16>(x0), y1 = shx<16>(x1);
                            o0 = (lr & 16) ? (x0 * c + y0 * s) : (x0 * c - y0 * s); o1 = (lr & 16) ? (x1 * c + y1 * s) : (x1 * c - y1 * s);
                        } else {
                            o0 = acc[mi][0][r]; o1 = acc[mi][1][r];
                            if (silu) { o0 = silu_(o0); o1 = silu_(o1); }
                            if (off == OFF_KF) kamax = fmaxf(kamax, fmaxf(fabsf(o0), fabsf(o1)));
                        }
                        sg[rl * 64 + ((((lr >> 3)) ^ (rl & 7)) << 3) + (lr & 7)] = f2bf(o0 * osc); sg[rl * 64 + ((((lr >> 3) + 4) ^ (rl & 7)) << 3) + (lr & 7)] = f2bf(o1 * osc);
                        if ((r & 3) == 3) __builtin_amdgcn_sched_barrier(0);
                    }
            }
            if (off == OFF_KF) {
                const float km = wave_max(kamax) * 1.00393f;
                if (lh == 0 && lr == 0) atomicMax(p.qctr() + 64 * layer + 24 + b * 4 + cbase / 64, __float_as_uint(km));
            }
            __builtin_amdgcn_wave_barrier();
            const size_t ldd = (kind == 2) ? (size_t)S : (size_t)ld;
            bf16_t* dp = (kind == 2) ? (dst + t0) : (dst + (size_t)row0 * ld + cbase);
            const int lane = lh * 32 + lr;
#pragma unroll
            for (int i = 0; i < 8; ++i) {
                const int piece = lane + 64 * i, rr = piece >> 3, ch = piece & 7;
                const u32x4 v = *(const u32x4*)(sg + rr * 64 + ((ch ^ (rr & 7)) << 3));
                *(u32x4*)(dp + (size_t)rr * ldd + ch * 8) = v;
            }
            __builtin_amdgcn_wave_barrier();
        }
        else if (kind == 5) epi_f32<2>(acc, row0, lr, lh, (float*)dst, ld, cbase);
        else if (kind == 6) {
            const int tile = (row0 >> 7) * 40 + ((col0 - M_MERGE) >> 7), wave = ((row0 >> 6) & 1) * 2 + ((col0 >> 6) & 1);
            unsigned char* sp = (unsigned char*)p.SIG() + ((size_t)(tile * 4 + wave) * 4) * 1024 + (size_t)(lh * 32 + lr) * 16;
#define SIGQ(x_) floorf(fmaf(sigmoid_(x_), 255.f, 0.5f))
#pragma unroll
            for (int mi = 0; mi < 2; ++mi)
#pragma unroll
                for (int ni = 0; ni < 2; ++ni) {
                    unsigned wq[4];
#pragma unroll
                    for (int g = 0; g < 4; ++g) {
                        unsigned w = __builtin_amdgcn_cvt_pk_u8_f32(SIGQ(acc[mi][ni][4 * g]), 0, 0u);
                        w = __builtin_amdgcn_cvt_pk_u8_f32(SIGQ(acc[mi][ni][4 * g + 1]), 1, w);
                        w = __builtin_amdgcn_cvt_pk_u8_f32(SIGQ(acc[mi][ni][4 * g + 2]), 2, w);
                        w = __builtin_amdgcn_cvt_pk_u8_f32(SIGQ(acc[mi][ni][4 * g + 3]), 3, w);
                        wq[g] = w;
                    }
                    *(u32x4*)(sp + (size_t)(mi * 2 + ni) * 1024) = u32x4{wq[0], wq[1], wq[2], wq[3]};
                }
#undef SIGQ
        }
        else {
            epi_rope32<1>(acc, row0, lr, lh, rope, p.KI(), 32, 0);
            const float fb = p.fox_bias[layer * 4 + (lr & 3)];
            float* sbase = (lr < 4) ? (p.WI() + lr) : (lr < 8) ? (p.LOGF() + (lr - 4)) : (p.GN() + (lr - 8));
            const int sstride = (lr < 8) ? 4 : 12;
#pragma unroll
            for (int mi = 0; mi < 2; ++mi)
#pragma unroll
                for (int r = 0; r < 16; ++r) {
                    const size_t row = EROW(mi, r); const float v = acc[mi][1][r];
                    const float u = (lr < 8) ? (v + fb) : v;
                    const float e = __builtin_amdgcn_exp2f(-1.4426950408889634f * fabsf(u));
                    const float lsg = fminf(u, 0.f) - __builtin_amdgcn_logf(1.f + e) * 0.6931471805599453f;
                    const float sg = ((u >= 0.f) ? 1.f : e) * __builtin_amdgcn_rcpf(1.f + e);
                    const float o = (lr < 4) ? v * 0.08838834764831845f : ((lr < 8) ? lsg : sg);
                    if (lr < 20) sbase[row * sstride] = o;
                }
        }
    }
};
struct EpiMemKV {
    const Params& p;
    __device__ __forceinline__ void operator()(const f32x16 (&acc)[2][2], int row0, int col0, int lr, int lh, char* stg) const {
        if (col0 < 256) epi_bf16<2, false>(acc, row0, lr, lh, p.MKB(), 256, col0);
        else epi_vt<2>(acc, row0 % NMEM, lr, lh, p.MVT() + ((size_t)((row0 / NMEM) * 4 + (col0 - 256) / 64) * 64) * NMEM, NMEM);
    }
};
struct EpiKA { const Params& p;
    __device__ __forceinline__ void operator()(const f32x16 (&acc)[2][2], int row0, int col0, int lr, int lh, char* stg) const {
        const float* rope = p.ROPE();
        staged_bf16_tile(stg, p.KAB() + (size_t)row0 * 256 + col0, 256, lr, lh, [&](int mi, int r, int rl, float& o0, float& o1) {
            const size_t row = (size_t)row0 + rl;
            const float c = rope[row * 64 + lr], sn = rope[row * 64 + 32 + lr], x1 = acc[mi][0][r], x2 = acc[mi][1][r];
            o0 = x1 * c - x2 * sn; o1 = x2 * c + x1 * sn; });
    } };
struct EpiVA { const Params& p;
    __device__ __forceinline__ void operator()(const f32x16 (&acc)[2][2], int row0, int col0, int lr, int lh, char* stg) const {
        epi_vt<2>(acc, row0 % S, lr, lh, p.VAT() + ((size_t)((row0 / S) * 4 + col0 / 64) * 64) * S, S); } };
struct EpiResid { const float* Xin; float* Xout;
    __device__ __forceinline__ void operator()(const f32x16 (&acc)[2][2], int row0, int col0, int lr, int lh, char* stg) const {
#pragma unroll
        for (int mi = 0; mi < 2; ++mi) {
            float xv[2][16];
#pragma unroll
            for (int ni = 0; ni < 2; ++ni)
#pragma unroll
                for (int r = 0; r < 16; ++r) xv[ni][r] = Xin[(size_t)EROW(mi, r) * D + col0 + ni * 32 + lr];
#pragma unroll
            for (int ni = 0; ni < 2; ++ni)
#pragma unroll
                for (int r = 0; r < 16; ++r) Xout[(size_t)EROW(mi, r) * D + col0 + ni * 32 + lr] = xv[ni][r] + acc[mi][ni][r];
        }
    } };
struct EpiCmp1 { const float* bias; bf16_t* hid;
    __device__ __forceinline__ void operator()(const f32x16 (&acc)[2][2], int row0, int col0, int lr, int lh, char* stg) const {
#pragma unroll
        for (int ni = 0; ni < 2; ++ni) {
            const float bv = bias[col0 + ni * 32 + lr];
#pragma unroll
            for (int mi = 0; mi < 2; ++mi)
#pragma unroll
                for (int r = 0; r < 16; ++r) hid[(size_t)EROW(mi, r) * 128 + col0 + ni * 32 + lr] = f2bf(silu_(acc[mi][ni][r] + bv));
        }
    } };
struct EpiCmp2K { bf16_t* kcb;
    __device__ __forceinline__ void operator()(const f32x16 (&acc)[2][1], int row0, int col0, int lr, int lh, char* stg) const {
#pragma unroll
        for (int mi = 0; mi < 2; ++mi)
#pragma unroll
            for (int r = 0; r < 16; ++r) { const int row = EROW(mi, r); kcb[(size_t)row * 64 + col0 + lr] = ((row & 511) == 511) ? (bf16_t)0 : f2bf(acc[mi][0][r]); }
    } };
struct EpiCmp2V { bf16_t* vct;
    __device__ __forceinline__ void operator()(const f32x16 (&acc)[2][1], int row0, int col0, int lr, int lh, char* stg) const {
        bf16_t* base = vct + ((size_t)(row0 / 512) * 64 + col0) * 512;
        const int n0 = row0 % 512;
#pragma unroll
        for (int mi = 0; mi < 2; ++mi)
#pragma unroll
            for (int g = 0; g < 4; ++g) {
                const int n = n0 + mi * 32 + 8 * g + 4 * lh;
                u32x2 o; o.x = cvt_pk_bf16(acc[mi][0][4 * g], acc[mi][0][4 * g + 1]); o.y = cvt_pk_bf16(acc[mi][0][4 * g + 2], (n + 3 == 511) ? 0.f : acc[mi][0][4 * g + 3]);
                *(u32x2*)(base + (size_t)lr * 512 + n) = o;
            }
    } };

__device__ __forceinline__ void ph_merge(const Params& p, int layer, int bid, int nb, char* sm) {
    const int lane = tidx() & 63, wid = __builtin_amdgcn_readfirstlane(tidx() >> 6), wr = wid >> 1, wc = wid & 1, lr = lane & 31, lh = lane >> 5;
    for (int tile = bid; tile < (T / 128) * (D / 128); tile += nb) {
        const int mt = tile % (T / 128), nt = tile / (T / 128), m0 = mt * 128, n0 = nt * 128;
        f32x16 mg[2][2]; acc_zero<2>(mg);
#pragma unroll 1
        for (int n = 0; n < 5; ++n) {
            f32x16 g[2][2]; acc_zero<2>(g);
            const unsigned char* sp = (const unsigned char*)p.SIG() + ((size_t)((mt * 40 + n * 8 + nt) * 4 + wid) * 4) * 1024 + (size_t)lane * 16;
            u32x4 sgw[4];
#pragma unroll
            for (int i = 0; i < 4; ++i) sgw[i] = *(const u32x4*)(sp + (size_t)i * 1024);
            tile_mac_dma64(g, p.Y() + n * 256, 1280, m0, p.WBR() + ((size_t)layer * 5 + n) * D * 256, 256, n0, 256, sm);
#pragma unroll
            for (int mi = 0; mi < 2; ++mi)
#pragma unroll
                for (int ni = 0; ni < 2; ++ni) {
                    const u32x4 w = sgw[mi * 2 + ni];
                    const unsigned sw[4] = {w.x, w.y, w.z, w.w};
#pragma unroll
                    for (int q = 0; q < 4; ++q) {
                        mg[mi][ni][4 * q] = fmaf((float)(sw[q] & 255u), g[mi][ni][4 * q], mg[mi][ni][4 * q]);
                        mg[mi][ni][4 * q + 1] = fmaf((float)((sw[q] >> 8) & 255u), g[mi][ni][4 * q + 1], mg[mi][ni][4 * q + 1]);
                        mg[mi][ni][4 * q + 2] = fmaf((float)((sw[q] >> 16) & 255u), g[mi][ni][4 * q + 2], mg[mi][ni][4 * q + 2]);
                        mg[mi][ni][4 * q + 3] = fmaf((float)(sw[q] >> 24), g[mi][ni][4 * q + 3], mg[mi][ni][4 * q + 3]);
                    }
                }
        }
        __syncthreads();
        staged_bf16_tile(sm + wid * 8192, p.MG() + (size_t)(m0 + wr * 64) * D + n0 + wc * 64, D, lr, lh,
                         [&](int mi, int r, int, float& o0, float& o1) { o0 = mg[mi][0][r] * (1.f / 255.f); o1 = mg[mi][1][r] * (1.f / 255.f); });
    }
}

__device__ __forceinline__ void ph_cumsum(const Params& p, int bid, int nb, float* sm) {
    const int tid = tidx();
    float* buf = sm;
    float* ps = sm + 8192 + 256;
    for (int u = bid; u < NBATCH * 4; u += nb) {
        const int b = u >> 2, h = u & 3;
        const float4* src4 = (const float4*)(p.LOGF() + (size_t)b * S * 4);
        __syncthreads();
#pragma unroll 8
        for (int i = 0; i < 32; ++i) {
            const int tok = i * 256 + tid;
            const float4 v = src4[tok];
            buf[tok + (tok >> 5)] = (h == 0) ? v.x : (h == 1) ? v.y : (h == 2) ? v.z : v.w;
        }
        __syncthreads();
        float run = 0.f;
#pragma unroll 8
        for (int j = 0; j < 32; ++j) { run += buf[tid * 33 + j]; buf[tid * 33 + j] = run; }
        ps[tid] = run;
        __syncthreads();
        for (int off = 1; off < 256; off <<= 1) {
            float t = 0.f;
            if (tid >= off) t = ps[tid - off];
            __syncthreads();
            ps[tid] += t;
            __syncthreads();
        }
        const float pre = (tid > 0) ? ps[tid - 1] : 0.f;
#pragma unroll 8
        for (int j = 0; j < 32; ++j) buf[tid * 33 + j] = (buf[tid * 33 + j] + pre) * 1.4426950408889634f;
        __syncthreads();
        float* dst = p.CUMT() + (size_t)u * S;
#pragma unroll 8
        for (int i = 0; i < 32; ++i) { const int tok = i * 256 + tid; dst[tok] = buf[tok + (tok >> 5)]; }
    }
    __syncthreads();
}

enum { AM_FOX = 0, AM_DSA = 1, AM_SLC = 2, AM_SB = 3, AM_WIN = 4, AM_MEM = 5, AM_CMP = 6 };
constexpr int AK_ROW = 144;
constexpr int AK_TILE = 64 * AK_ROW;
constexpr int ABUF = 2 * AK_TILE + 256;
constexpr int SB_FLAG_OFF = 3 * 24576 + 48;
constexpr int ATT_NST = 3, ATT_STAGE = 16384 + 1024;
constexpr float LOG2E = 1.4426950408889634f;
#define NEG_INF (-__builtin_inff())

template <int MODE>
__device__ __forceinline__ void attn_core(const Params& p, int b, int head_, int qblk, char* sm, f32x16 (&O)[2], float& inv, int layer = 0) {
    const int tid = tidx(), lane = tid & 63, wid = __builtin_amdgcn_readfirstlane(tid >> 6), lr = lane & 31, lh = lane >> 5;
    constexpr bool NSAM = (MODE == AM_CMP || MODE == AM_WIN || MODE == AM_SLC);
    const int head = NSAM ? (lr & 3) : head_;
    const int q0 = NSAM ? qblk * 32 : qblk * 128, qw0 = q0 + (NSAM ? 8 : 32) * wid, tq = NSAM ? qw0 + (lr >> 2) : qw0 + lr;
    const int qwl = qw0 + (NSAM ? 7 : 31), qbl = q0 + (NSAM ? 31 : 127);
    const size_t gq = (size_t)b * S + tq;
    const bf16_t *Qp, *Kp, *VTp; int ldk, ldv;
    if (MODE == AM_FOX)      { Qp = p.QF() + gq * 256 + head * 64; Kp = p.KF() + (size_t)b * S * 256 + head * 64; ldk = 256; VTp = p.VFT() + ((size_t)(b * 4 + head) * 64) * S; ldv = S; }
    else if (MODE == AM_DSA) { Qp = p.QA() + gq * 256 + head * 64; Kp = p.KAB() + (size_t)b * S * 256 + head * 64; ldk = 256; VTp = p.VAT() + ((size_t)(b * 4 + head) * 64) * S; ldv = S; }
    else if (MODE == AM_SB)  { Qp = p.QS() + gq * 256 + head * 64; Kp = p.KSB() + (size_t)b * S * 256 + head * 64; ldk = 256; VTp = p.VST() + ((size_t)(b * 4 + head) * 64) * S; ldv = S; }
    else if (MODE == AM_SLC) { Qp = p.QN() + gq * 256 + head * 64; Kp = p.KSLC() + (size_t)b * S * 64; ldk = 64; VTp = p.VSLCT() + ((size_t)b * 64) * S; ldv = S; }
    else if (MODE == AM_WIN) { Qp = p.QN() + gq * 256 + head * 64; Kp = p.KWIN() + (size_t)b * S * 64; ldk = 64; VTp = p.VWINT() + ((size_t)b * 64) * S; ldv = S; }
    else if (MODE == AM_CMP) { Qp = p.QN() + gq * 256 + head * 64; Kp = p.KCB() + (size_t)b * NCMP_PAD * 64; ldk = 64; VTp = p.VCT() + ((size_t)b * 64) * NCMP_PAD; ldv = NCMP_PAD; }
    else                     { Qp = p.QM() + gq * 256 + head * 64; Kp = p.MKB() + (size_t)b * NMEM * 256 + head * 64; ldk = 256; VTp = p.MVT() + ((size_t)(b * 4 + head) * 64) * NMEM; ldv = NMEM; }
    int kt_lo = 0, kt_hi = qbl / 64 + 1;
    if (MODE == AM_WIN) kt_lo = q0 >= 512 ? (q0 - 512) / 64 : 0;
    if (MODE == AM_MEM) kt_hi = NMEM / 64;
    if (MODE == AM_CMP) kt_hi = min(8, (((qbl - 31) >> 4) >> 6) + 1);
    const int nlim = (tq - 31) >> 4;
    constexpr bool REV = (MODE == AM_SB || MODE == AM_FOX);

    bf16x8 qf[4];
#pragma unroll
    for (int s = 0; s < 4; ++s) qf[s] = *(const bf16x8*)(Qp + 16 * s + 8 * lh);
    const float* csp = p.CUMT() + (size_t)(b * 4 + head) * S;
    if (MODE == AM_FOX) {
        float l1 = 0.f;
#pragma unroll
        for (int s4 = 0; s4 < 4; ++s4)
#pragma unroll
            for (int j = 0; j < 8; ++j) l1 += fabsf(__uint_as_float((unsigned)(unsigned short)qf[s4][j] << 16));
        l1 = wave_max(half_sum(l1));
        volatile float* fw = (volatile float*)(sm + SB_FLAG_OFF);
        __syncthreads();
        if (lane == 0) fw[wid] = l1;
        __syncthreads();
        const float qn = fmaxf(fmaxf(fw[0], fw[1]), fmaxf(fw[2], fw[3]));
        const float kabs = __uint_as_float(xb_add(p.qctr() + 64 * layer + 24 + b * 4 + head, 0u));
        const float thr = 162.f + 2.04f * qn * kabs;
        const float c0 = csp[q0];
        int ndrop = 0;
#pragma unroll
        for (int rnd = 0; rnd < 2; ++rnd) {
            const int j = lane + 64 * rnd;
            const float cj = csp[min(64 * j + 63, S - 1)];
            ndrop += __builtin_popcountll(__ballot(j < kt_hi && cj > c0 + thr));
        }
        kt_lo = __builtin_amdgcn_readfirstlane(min(ndrop, kt_hi - 1));
    }
    const int ntile = kt_hi - kt_lo;
    unsigned smw[4] = {0u, 0u, 0u, 0u};
    if (MODE == AM_SLC) { const u32x4 w = *(const u32x4*)(p.SMASK() + gq * 4); smw[0] = w.x; smw[1] = w.y; smw[2] = w.z; smw[3] = w.w; }
    const unsigned* mrow32 = p.DMASK() + ((size_t)b * 128 * S + qw0) * 2;

    const int srow = tid >> 3, schunk = (tid & 7) ^ ((srow >> 1) & 7);
    const bf16_t* kg0 = Kp + (size_t)srow * ldk + schunk * 8;
    const bf16_t* vg0 = VTp + (size_t)srow * ldv + schunk * 8;
    const int ldst = tid * 16;
    auto issue = [&](int kt, int slot) {
        char* st = sm + slot * ATT_STAGE + ldst;
        const bf16_t* kgp = kg0 + (size_t)kt * 64 * ldk;
        const bf16_t* vgp = vg0 + kt * 64;
        __builtin_amdgcn_global_load_lds((const unsigned*)kgp, (unsigned*)st, 16, 0, 0);
        __builtin_amdgcn_global_load_lds((const unsigned*)(kgp + (size_t)32 * ldk), (unsigned*)(st + 4096), 16, 0, 0);
        __builtin_amdgcn_global_load_lds((const unsigned*)vgp, (unsigned*)(st + 8192), 16, 0, 0);
        __builtin_amdgcn_global_load_lds((const unsigned*)(vgp + (size_t)32 * ldv), (unsigned*)(st + 12288), 16, 0, 0);
        if (MODE == AM_FOX) __builtin_amdgcn_global_load_lds((const unsigned*)(csp + kt * 64 + lane), (unsigned*)(sm + slot * ATT_STAGE + 16384 + tid * 4), 4, 0, 0);
        if (MODE == AM_DSA) __builtin_amdgcn_global_load_lds((const unsigned*)(mrow32 + (size_t)kt * S * 2 + lane), (unsigned*)(sm + slot * ATT_STAGE + 16384 + tid * 4), 4, 0, 0);
    };
    const int pil = (lr & 0x13) | ((lr & 4) << 1) | ((lr & 8) >> 1);
    const int ksw = (pil >> 1) & 7, vsw = (lr >> 1) & 7;
    int rdk[4], rdv[4];
#pragma unroll
    for (int j = 0; j < 4; ++j) { rdk[j] = pil * 128 + (((2 * j + lh) ^ ksw) << 4); rdv[j] = 8192 + lr * 128 + (((2 * j + lh) ^ vsw) << 4); }

    float m = NEG_INF, l = 0.f, R = 1.f;
#pragma unroll
    for (int i = 0; i < 16; ++i) { O[0][i] = 0.f; O[1][i] = 0.f; }

    static_assert(ATT_NST == 3, "the vmcnt arithmetic below is written for a 3-stage ring");
    volatile int* sflag = (volatile int*)(sm + SB_FLAG_OFF);
    if (MODE == AM_SB) { if (lane == 0) sflag[wid] = 0; }
    __syncthreads();
    auto tile_of = [&](int it) { const int c = min(it, ntile - 1); return REV ? kt_hi - 1 - c : kt_lo + c; };
    issue(tile_of(0), 0);
    issue(tile_of(1), 1);
    int slot = 0, nslot = ATT_NST - 1;
#pragma unroll 1
    for (int it = 0; it < ntile; ++it) {
        const int kt = REV ? kt_hi - 1 - it : kt_lo + it;
        constexpr int NPER = (MODE == AM_FOX || MODE == AM_DSA) ? 5 : 4;
        if (NPER == 5) DMA_WAIT(5); else DMA_WAIT(4);
        __builtin_amdgcn_s_barrier();
        if (MODE == AM_SB) { if ((sflag[0] & sflag[1] & sflag[2] & sflag[3]) != 0) break; }
        const char* cur = sm + slot * ATT_STAGE;
        unsigned long long mw = 0ull;
        if (MODE == AM_DSA) mw = *(const unsigned long long*)(cur + 16384 + wid * 256 + lr * 8);
        issue(tile_of(it + ATT_NST - 1), nslot);
        slot = (slot + 1 == ATT_NST) ? 0 : slot + 1; nslot = (nslot + 1 == ATT_NST) ? 0 : nslot + 1;
        bool need = true;
        if (MODE == AM_CMP) need = kt * 64 <= ((qwl - 31) >> 4);
        else if (MODE != AM_MEM) need = kt * 64 <= qwl;
        if (MODE == AM_WIN) need = need && (kt * 64 + 63 >= qw0 - 511);
        if (MODE == AM_SLC) {
            const unsigned w = smw[0] * (kt < 32) + smw[1] * (kt >= 32 && kt < 64) + smw[2] * (kt >= 64 && kt < 96) + smw[3] * (kt >= 96);
            need = need && __any((w >> (kt & 31)) & 1u);
        }
        if (need) {
            f32x16 sv[2];
#pragma unroll
            for (int sub = 0; sub < 2; ++sub) {
                f32x16 a;
#pragma unroll
                for (int i = 0; i < 16; ++i) a[i] = 0.f;
#pragma unroll
                for (int s4 = 0; s4 < 4; ++s4) {
                    const bf16x8 kf = *(const bf16x8*)(cur + rdk[s4] + sub * 4096);
                    a = __builtin_amdgcn_mfma_f32_32x32x16_bf16(kf, qf[s4], a, 0, 0, 0);
                }
                sv[sub] = a;
            }
            bool skipt = false;
            if (MODE == AM_SB) {
#pragma unroll
                for (int sb2 = 0; sb2 < 2; ++sb2) {
                    const int sub = 1 - sb2;
                    {
                        f32x16& s = sv[sub];
                        const int thl = tq - (kt * 64 + sub * 32) - 8 * lh;
                        f32x2 kp[8], sg[8];
                        const bool dgl = (kt * 64 + sub * 32 + 31) >= qw0;
                        const f32x2 one2 = {1.f, 1.f};
#pragma unroll
                        for (int r = 0; r < 8; ++r) {
                            const float z0 = __builtin_amdgcn_fmed3f(s[r], -64.f, 64.f), z1 = __builtin_amdgcn_fmed3f(s[r + 8], -64.f, 64.f);
                            f32x2 e = {__builtin_amdgcn_exp2f(-z0), __builtin_amdgcn_exp2f(-z1)};
                            const f32x2 d = e + one2;
                            const f32x2 rc = {__builtin_amdgcn_rcpf(d.x), __builtin_amdgcn_rcpf(d.y)};
                            kp[r] = e * rc; sg[r] = rc;
                        }
                        if (dgl) {
#pragma unroll
                            for (int r = 0; r < 8; ++r) {
                                const bool ok0 = r < thl, ok1 = (r + 16) < thl;
                                kp[r].x = ok0 ? kp[r].x : 1.f; sg[r].x = ok0 ? sg[r].x : 0.f;
                                kp[r].y = ok1 ? kp[r].y : 1.f; sg[r].y = ok1 ? sg[r].y : 0.f;
                            }
                        }
                        const f32x2 g2 = ((kp[0] * kp[1]) * (kp[2] * kp[3])) * ((kp[4] * kp[5]) * (kp[6] * kp[7]));
                        float gA, gB, gC, gD;
                        half_pair(g2.x, gA, gB); half_pair(g2.y, gC, gD);
                        f32x2 run = {R * ((gC * gD) * (lh == 0 ? gB : 1.f)), R * (lh == 0 ? gD : 1.f)};
#pragma unroll
                        for (int r = 7; r >= 0; --r) {
                            const f32x2 w = sg[r] * run; run *= kp[r];
                            s[r] = w.x; s[8 + r] = w.y;
                        }
                        R *= (gA * gB) * (gC * gD);
                    }
                }
                if (__all(R == 0.0f)) { if (lane == 0) sflag[wid] = 1; asm volatile("s_waitcnt lgkmcnt(0)" ::: "memory"); }
            } else {
#pragma unroll
                for (int sub = 0; sub < 2; ++sub) {
                    f32x16& s = sv[sub];
                    const int kb = kt * 64 + sub * 32;
                    const int thl = tq - kb - 8 * lh;
                    {
                        if (MODE == AM_FOX) {
                            const float4* cs4 = (const float4*)(cur + 16384 + wid * 256 + (sub * 32 + 8 * lh) * 4);
                            const float4 c0 = cs4[0], c1 = cs4[1], c2 = cs4[4], c3 = cs4[5];
                            const float cv[16] = {c0.x, c0.y, c0.z, c0.w, c1.x, c1.y, c1.z, c1.w, c2.x, c2.y, c2.z, c2.w, c3.x, c3.y, c3.z, c3.w};
#pragma unroll
                            for (int r = 0; r < 16; ++r) s[r] -= cv[r];
                        }
                        if (MODE == AM_DSA) {
                            const unsigned w = (unsigned)(mw >> (32 * sub)) >> (8 * lh);
#pragma unroll
                            for (int r = 0; r < 16; ++r) {
                                const int cr = 16 * (r >> 3) + (r & 7);
                                const unsigned mk = (unsigned)__builtin_amdgcn_sbfe((int)w, cr, 1);
                                s[r] = __uint_as_float(__builtin_amdgcn_bitop3_b32(mk, __float_as_uint(s[r]), 0xff800000u, 0xCA));
                            }
                        }
                        if (MODE == AM_SLC) {
                            const unsigned w = smw[0] * (kt < 32) + smw[1] * (kt >= 32 && kt < 64) + smw[2] * (kt >= 64 && kt < 96) + smw[3] * (kt >= 96);
                            const bool sel = (w >> (kt & 31)) & 1u;
#pragma unroll
                            for (int r = 0; r < 16; ++r) s[r] = sel ? s[r] : NEG_INF;
                        }
                        if (MODE == AM_FOX || MODE == AM_SLC) {
                            if (kb + 31 > qw0) {
#pragma unroll
                                for (int r = 0; r < 16; ++r) { const int cr = 16 * (r >> 3) + (r & 7); s[r] = (cr <= thl) ? s[r] : NEG_INF; }
                            }
                        }
                        if (MODE == AM_CMP) {
                            const int tc = nlim - kb - 8 * lh;
#pragma unroll
                            for (int r = 0; r < 16; ++r) { const int cr = 16 * (r >> 3) + (r & 7); s[r] = (cr <= tc) ? s[r] : NEG_INF; }
                        }
                        if (MODE == AM_WIN) {
                            if (kb + 31 > qw0 || kb < qwl - 511) {
#pragma unroll
                                for (int r = 0; r < 16; ++r) { const int cr = 16 * (r >> 3) + (r & 7); s[r] = (cr <= thl && cr > thl - 512) ? s[r] : NEG_INF; }
                            }
                        }
                    }
                }
                constexpr bool RAW = (MODE == AM_MEM || MODE == AM_WIN);
                float tmax;
#define MAX3_8 "v_max3_f32 %0, %0, %1, %2\n\tv_max3_f32 %0, %0, %3, %4\n\tv_max3_f32 %0, %0, %5, %6\n\tv_max3_f32 %0, %0, %7, %8\n\tv_max3_f32 %0, %0, %9, %10\n\tv_max3_f32 %0, %0, %11, %12\n\tv_max3_f32 %0, %0, %13, %14\n\tv_max3_f32 %0, %0, %15, %16"
                tmax = (MODE == AM_FOX) ? NEG_INF : m;
                if (RAW) asm("s_nop 15\n\ts_nop 7\n\t" MAX3_8 : "+v"(tmax) : "v"(sv[0][0]), "v"(sv[1][0]), "v"(sv[0][1]), "v"(sv[1][1]), "v"(sv[0][2]), "v"(sv[1][2]), "v"(sv[0][3]), "v"(sv[1][3]),
                                  "v"(sv[0][4]), "v"(sv[1][4]), "v"(sv[0][5]), "v"(sv[1][5]), "v"(sv[0][6]), "v"(sv[1][6]), "v"(sv[0][7]), "v"(sv[1][7]));
                else asm(MAX3_8 : "+v"(tmax) : "v"(sv[0][0]), "v"(sv[1][0]), "v"(sv[0][1]), "v"(sv[1][1]), "v"(sv[0][2]), "v"(sv[1][2]), "v"(sv[0][3]), "v"(sv[1][3]),
                                  "v"(sv[0][4]), "v"(sv[1][4]), "v"(sv[0][5]), "v"(sv[1][5]), "v"(sv[0][6]), "v"(sv[1][6]), "v"(sv[0][7]), "v"(sv[1][7]));
                asm(MAX3_8 : "+v"(tmax) : "v"(sv[0][8]), "v"(sv[1][8]), "v"(sv[0][9]), "v"(sv[1][9]), "v"(sv[0][10]), "v"(sv[1][10]), "v"(sv[0][11]), "v"(sv[1][11]),
                                  "v"(sv[0][12]), "v"(sv[1][12]), "v"(sv[0][13]), "v"(sv[1][13]), "v"(sv[0][14]), "v"(sv[1][14]), "v"(sv[0][15]), "v"(sv[1][15]));
#undef MAX3_8
                float mn;
                if (MODE == AM_FOX) {
                    tmax = fmaxf(tmax, m - 1000.f);
                    const float tq = half_max(tmax);
                    skipt = __all(tq < m - 160.f);
                    mn = fmaxf(m, tq);
                } else {
                    tmax = fmaxf(tmax, m);
                    mn = half_max(tmax);
                }
                if (!skipt) {
                const float mu = (mn == NEG_INF) ? 0.f : mn;
                const float corr = __builtin_amdgcn_exp2f(m - mu);
                m = mn;
                const f32x2 mu2 = {mu, mu};
                f32x2 lsa = {0.f, 0.f}, lsb = {0.f, 0.f};
#pragma unroll
                for (int i = 0; i < 8; ++i) {
                    f32x2 a = {sv[0][2 * i], sv[0][2 * i + 1]}, c = {sv[1][2 * i], sv[1][2 * i + 1]};
                    a -= mu2; c -= mu2;
                    a.x = __builtin_amdgcn_exp2f(a.x); a.y = __builtin_amdgcn_exp2f(a.y); c.x = __builtin_amdgcn_exp2f(c.x); c.y = __builtin_amdgcn_exp2f(c.y);
                    sv[0][2 * i] = a.x; sv[0][2 * i + 1] = a.y; sv[1][2 * i] = c.x; sv[1][2 * i + 1] = c.y;
                    lsa += a; lsb += c;
                }
                lsa += lsb;
                l = l * corr + (lsa.x + lsa.y);
                if (!__all(corr == 1.0f)) {
#pragma unroll
                    for (int i = 0; i < 16; ++i) { O[0][i] *= corr; O[1][i] *= corr; }
                }
                }
            }
            if (!skipt) {
#pragma unroll
            for (int sub = 0; sub < 2; ++sub) {
                {
                    const f32x16& s = sv[sub];
                    u32x4 w0, w1;
                    w0.x = cvt_pk_bf16(s[0], s[1]); w0.y = cvt_pk_bf16(s[2], s[3]); w0.z = cvt_pk_bf16(s[4], s[5]); w0.w = cvt_pk_bf16(s[6], s[7]);
                    w1.x = cvt_pk_bf16(s[8], s[9]); w1.y = cvt_pk_bf16(s[10], s[11]); w1.z = cvt_pk_bf16(s[12], s[13]); w1.w = cvt_pk_bf16(s[14], s[15]);
                    const bf16x8 pf0 = __builtin_bit_cast(bf16x8, w0), pf1 = __builtin_bit_cast(bf16x8, w1);
#pragma unroll
                    for (int dt = 0; dt < 2; ++dt) {
                        const bf16x8 vf0 = *(const bf16x8*)(cur + rdv[sub * 2] + dt * 4096);
                        const bf16x8 vf1 = *(const bf16x8*)(cur + rdv[sub * 2 + 1] + dt * 4096);
                        O[dt] = __builtin_amdgcn_mfma_f32_32x32x16_bf16(vf0, pf0, O[dt], 0, 0, 0);
                        O[dt] = __builtin_amdgcn_mfma_f32_32x32x16_bf16(vf1, pf1, O[dt], 0, 0, 0);
                    }
                }
            }
            }
        }
    }
    DMA_WAIT(0);
    inv = 1.f;
    if (MODE != AM_SB) { const float lt = half_sum(l); inv = 1.f / fmaxf(lt, 1e-30f); }
}
template <bool NSAM = false>
__device__ __forceinline__ void attn_store_gated(const Params& p, int b, int head_, int qblk, int yc, const f32x16 (&O)[2], float scale) {
    const int tid = tidx(), lane = tid & 63, wid = __builtin_amdgcn_readfirstlane(tid >> 6), lr = lane & 31, lh = lane >> 5;
    const int head = NSAM ? (lr & 3) : head_;
    const size_t gq = NSAM ? (size_t)b * S + qblk * 32 + 8 * wid + (lr >> 2) : (size_t)b * S + qblk * 128 + 32 * wid + lr;
    const bf16_t* zp = p.ZG() + gq * 1280 + yc + head * 64;
    bf16_t* dst = p.Y() + gq * 1280 + yc + head * 64;
#pragma unroll
    for (int dt = 0; dt < 2; ++dt)
#pragma unroll
        for (int g = 0; g < 4; ++g) {
            const int d0 = 32 * dt + 8 * g + 4 * lh;
            const u32x2 z = *(const u32x2*)(zp + d0);
            u32x2 o;
            o.x = cvt_pk_bf16(O[dt][4 * g] * scale * __uint_as_float(z.x << 16), O[dt][4 * g + 1] * scale * __uint_as_float(z.x & 0xffff0000u));
            o.y = cvt_pk_bf16(O[dt][4 * g + 2] * scale * __uint_as_float(z.y << 16), O[dt][4 * g + 3] * scale * __uint_as_float(z.y & 0xffff0000u));
            *(u32x2*)(dst + d0) = o;
        }
}
template <int MODE>
__device__ __forceinline__ void attn_unit(const Params& p, int b, int head, int qblk, char* sm, int layer = 0) {
    f32x16 O[2]; float inv;
    attn_core<MODE>(p, b, head, qblk, sm, O, inv, layer);
    attn_store_gated(p, b, head, qblk, MODE == AM_FOX ? 256 : MODE == AM_DSA ? 0 : MODE == AM_SB ? 512 : 1024, O, inv);
}
__device__ __forceinline__ void nsa_unit(const Params& p, int b, int qblk, char* sm) {
    const int tid = tidx(), wid = __builtin_amdgcn_readfirstlane(tid >> 6), lr = tid & 31, head = lr & 3;
    const size_t gq = (size_t)b * S + qblk * 32 + 8 * wid + (lr >> 2);
    const float g0 = p.GN()[gq * 12 + head], g1 = p.GN()[gq * 12 + 4 + head], g2 = p.GN()[gq * 12 + 8 + head];
    f32x16 Y[2], O[2]; float inv;
    attn_core<AM_CMP>(p, b, 0, qblk, sm, O, inv);
    { const float s = g0 * inv;
#pragma unroll
      for (int i = 0; i < 16; ++i) { Y[0][i] = O[0][i] * s; Y[1][i] = O[1][i] * s; } }
    attn_core<AM_WIN>(p, b, 0, qblk, sm, O, inv);
    { const float s = g2 * inv;
#pragma unroll
      for (int i = 0; i < 16; ++i) { Y[0][i] = fmaf(O[0][i], s, Y[0][i]); Y[1][i] = fmaf(O[1][i], s, Y[1][i]); } }
    attn_core<AM_SLC>(p, b, 0, qblk, sm, O, inv);
    { const float s = g1 * inv;
#pragma unroll
      for (int i = 0; i < 16; ++i) { Y[0][i] = fmaf(O[0][i], s, Y[0][i]); Y[1][i] = fmaf(O[1][i], s, Y[1][i]); } }
    attn_store_gated<true>(p, b, 0, qblk, 768, Y, 1.f);
}

__device__ __forceinline__ unsigned sortable_key(float x) { const unsigned u = __float_as_uint(x); return u ^ ((unsigned)((int)u >> 31) | 0x80000000u); }
#ifndef DIAG
#define DIAG 0
#endif
#if DIAG
#define UNIT_ATTR
#else
#define UNIT_ATTR
#endif
UNIT_ATTR __device__ __forceinline__ void dsa_select_unit(const Params& p, int b, int qt, char* sm) {
    const int tid = tidx(), lane = tid & 63, wid = __builtin_amdgcn_readfirstlane(tid >> 6), lr = lane & 31, lh = lane >> 5;
    unsigned* hist = (unsigned*)sm;
    unsigned* st_prefix = (unsigned*)(sm + 32 * 257 * 4);
    int* st_krem = (int*)(st_prefix + 32);
    int* st_part = st_krem + 32;
    const int q0 = qt * 32, tq = q0 + lr, ntile = qt + 1, lrh = lr - 4 * lh;
    const size_t gq = (size_t)b * S + tq;
    bf16x8 qf[4][2];
    float w[4];
#pragma unroll
    for (int h = 0; h < 4; ++h) {
        qf[h][0] = *(const bf16x8*)(p.QI() + gq * 128 + h * 32 + 8 * lh);
        qf[h][1] = *(const bf16x8*)(p.QI() + gq * 128 + h * 32 + 16 + 8 * lh);
        w[h] = p.WI()[gq * 4 + h];
    }
    const bf16_t* kbase = p.KI() + (size_t)b * S * 32 + (size_t)lr * 32 + 8 * lh;
    auto score_tile = [&](const bf16x8& k0, const bf16x8& k1, unsigned (&key)[16]) {
        float sc[16];
#pragma unroll
        for (int r = 0; r < 16; ++r) sc[r] = 0.f;
#pragma unroll
        for (int h = 0; h < 4; ++h) {
            f32x16 a;
#pragma unroll
            for (int r = 0; r < 16; ++r) a[r] = 0.f;
            a = __builtin_amdgcn_mfma_f32_32x32x16_bf16(k0, qf[h][0], a, 0, 0, 0);
            a = __builtin_amdgcn_mfma_f32_32x32x16_bf16(k1, qf[h][1], a, 0, 0, 0);
#pragma unroll
            for (int r = 0; r < 16; ++r) sc[r] = fmaf(__int_as_float(max(__float_as_int(a[r]), 0)), w[h], sc[r]);
        }
#pragma unroll
        for (int r = 0; r < 16; ++r) key[r] = sortable_key(sc[r]);
    };
#define KLOAD(kt_, a_, b_) { const bf16_t* kp_ = kbase + (size_t)min((kt_), qt) * (32 * 32); a_ = *(const bf16x8*)kp_; b_ = *(const bf16x8*)(kp_ + 16); }
    auto tie_fix = [&](int allow_total) {
        const unsigned* tiew = hist;
        const int q = tid >> 3, part = tid & 7;
        const unsigned* tr = tiew + q * 257 + part * 32;
        int c = 0;
#pragma unroll 8
        for (int i = 0; i < 32; ++i) c += __builtin_popcount(tr[i]);
        st_part[q * 8 + part] = c;
        __syncthreads();
        int base = 0;
        for (int pp = 0; pp < part; ++pp) base += st_part[q * 8 + pp];
        int allow = allow_total - base;
        unsigned* grow = p.DMASK() + ((size_t)b * 128 * S + q0 + q) * 2;
        if (c > 0 && allow > 0) {
            for (int i = 0; i < 32 && allow > 0; ++i) {
                unsigned wv = tr[i];
                if (wv == 0u) continue;
                const int pc = __builtin_popcount(wv);
                if (pc > allow) { unsigned kept = 0u; for (int j = 0; j < allow; ++j) { const unsigned low = wv & (0u - wv); kept |= low; wv ^= low; } wv = kept; }
                { const int kt = part * 32 + i; atomicOr(grow + (size_t)(kt >> 1) * 2 * S + (kt & 1), wv); }
                allow -= pc;
            }
        }
    };
    unsigned prefix = 0u;
    bool fast = false;
#pragma unroll 1
    for (int pass = 0; pass < 4; ++pass) {
        const int shift = 24 - 8 * pass;
        __syncthreads();
        for (int i = tid; i < 32 * 257; i += 256) hist[i] = 0u;
        __syncthreads();
        bf16x8 k0, k1; KLOAD(wid, k0, k1)
        auto hist_tile = [&](auto first_tag, auto diag_tag) {
            constexpr bool FIRST = decltype(first_tag)::value, DG = decltype(diag_tag)::value;
            unsigned key[16];
            score_tile(k0, k1, key);
#pragma unroll
            for (int r = 0; r < 16; ++r) {
                const int rho0 = (r & 3) + 8 * (r >> 2);
                bool ok = true;
                if (DG) ok = rho0 <= lrh;
                if (!FIRST) ok = ok && ((key[r] >> (shift + 8)) == prefix);
                if (FIRST) atomicAdd(&hist[lr * 257 + ((!DG || ok) ? ((key[r] >> shift) & 255u) : 256u)], 1u);
                else if (__any(ok)) atomicAdd(&hist[lr * 257 + (ok ? ((key[r] >> shift) & 255u) : 256u)], 1u);
            }
        };
        using T_ = std::true_type; using F_ = std::false_type;
#pragma unroll 1
        for (int kt = wid; kt < ntile; kt += 4) {
            bf16x8 n0, n1; KLOAD(kt + 4, n0, n1)
            if (pass == 0) { if (kt == qt) hist_tile(T_{}, T_{}); else hist_tile(T_{}, F_{}); }
            else { if (kt == qt) hist_tile(F_{}, T_{}); else hist_tile(F_{}, F_{}); }
            k0 = n0; k1 = n1;
        }
        __syncthreads();
        {
            const int q = tid >> 3, part = tid & 7;
            const unsigned* hr = hist + q * 257 + part * 32;
            unsigned s = 0u;
#pragma unroll 8
            for (int i = 0; i < 32; ++i) s += hr[i];
            st_part[q * 8 + part] = (int)s;
            __syncthreads();
            const bool qsmall = (q0 + q + 1) <= 256;
            const int krem = (pass == 0) ? 256 : st_krem[q];
            const unsigned pprev = (pass == 0) ? 0u : st_prefix[q];
            unsigned above = 0u;
            for (int pp = 7; pp > part; --pp) above += (unsigned)st_part[q * 8 + pp];
            __syncthreads();
            if (qsmall) { if (part == 0) { st_prefix[q] = 0u; st_krem[q] = 1 << 30; } }
            else if (above < (unsigned)krem && (unsigned)krem <= above + s) {
                unsigned cum = above; int bin = 31;
                for (; bin > 0; --bin) { const unsigned c = hr[bin]; if (cum + c >= (unsigned)krem) break; cum += c; }
                st_prefix[q] = (pprev << 8) | (unsigned)(part * 32 + bin);
                st_krem[q] = krem - (int)cum;
            }
        }
        __syncthreads();
        prefix = st_prefix[lr];
        if (pass == 1) {
            unsigned* clist = (unsigned*)(sm + 36864);
            unsigned* ccnt = (unsigned*)(sm + 36864 + 32768);
            unsigned* tiew = hist;
            if (tid < 32) ccnt[tid] = 0u;
            if (tid == 0) st_part[0] = 0;
            __syncthreads();
            {
                unsigned* mb = p.DMASK() + ((size_t)b * 128 * S + tq) * 2;
                const unsigned tkey = prefix << 16;
                bf16x8 k0, k1; KLOAD(wid, k0, k1)
                int kt = wid;
#pragma unroll 1
                for (; kt < ntile; kt += 4) {
                    unsigned gt = 0u, tie = 0u;
                    bf16x8 n0, n1; KLOAD(kt + 4, n0, n1)
                    unsigned key[16];
                    score_tile(k0, k1, key);
                    const int vlim = (kt == qt) ? lrh : 64;
#pragma unroll
                    for (int r = 0; r < 16; ++r) {
                        const int rho0 = (r & 3) + 8 * (r >> 2);
                        const bool v = rho0 <= vlim;
                        const unsigned p16 = key[r] >> 16;
                        gt |= (v && p16 > prefix) ? (1u << rho0) : 0u;
                        tie |= (v && key[r] == tkey) ? (1u << rho0) : 0u;
                        const bool eq = v && p16 == prefix && key[r] != tkey;
                        if (__any(eq)) {
                            if (eq) {
                                const unsigned slot = atomicAdd(&ccnt[lr], 1u);
                                if (slot < 256u) clist[lr * 256 + slot] = (key[r] << 16) | (0xFFFFu - (unsigned)(kt * 32 + rho0 + 4 * lh));
                            }
                        }
                    }
                    gt <<= 4 * lh; tie <<= 4 * lh;
                    gt = half_or(gt); tie = half_or(tie);
                    k0 = n0; k1 = n1;
                    if (lh == 0) { mb[(size_t)(kt >> 1) * 2 * S + (kt & 1)] = gt; tiew[lr * 257 + kt] = tie; }
                }
#pragma unroll 1
                for (; kt < 256; kt += 4)
                    if (lh == 0) { mb[(size_t)(kt >> 1) * 2 * S + (kt & 1)] = 0u; tiew[lr * 257 + kt] = 0u; }
            }
            asm volatile("s_waitcnt vmcnt(0)" ::: "memory");
            __syncthreads();
            const int q = tid >> 3, part = tid & 7;
            const unsigned C = ccnt[q];
            if (part == 0 && C > 256u) st_part[0] = 1;
            __syncthreads();
            if (__builtin_amdgcn_readfirstlane(st_part[0]) == 0) {
                const unsigned* lst = clist + q * 256;
                const int kr = st_krem[q];
                unsigned* grow = p.DMASK() + ((size_t)b * 128 * S + q0 + q) * 2;
                for (unsigned i = (unsigned)part; i < C; i += 8u) {
                    const unsigned v = lst[i];
                    int rank = 0;
                    for (unsigned j = 0; j < C; ++j) rank += (lst[j] > v) ? 1 : 0;
                    if (rank < kr) { const unsigned idx = 0xFFFFu - (v & 0xFFFFu); const int kt = (int)(idx >> 5); atomicOr(grow + (size_t)(kt >> 1) * 2 * S + (kt & 1), 1u << (idx & 31u)); }
                }
                __syncthreads();
                tie_fix(kr - (int)C);
                fast = true;
                break;
            }
        }
    }
    if (!fast) {
    const unsigned thr = prefix;
    unsigned* mbase = p.DMASK() + ((size_t)b * 128 * S + tq) * 2;
    unsigned* tiew = hist;
    {
        bf16x8 k0, k1; KLOAD(wid, k0, k1)
        int kt = wid;
#pragma unroll 1
        for (; kt < ntile; kt += 4) {
            unsigned gt = 0u, tie = 0u;
            bf16x8 n0, n1; KLOAD(kt + 4, n0, n1)
            unsigned key[16];
            score_tile(k0, k1, key);
            const int vlim = (kt == qt) ? lrh : 64;
#pragma unroll
            for (int r = 0; r < 16; ++r) {
                const int rho0 = (r & 3) + 8 * (r >> 2);
                const bool v = rho0 <= vlim;
                gt |= (v && key[r] > thr) ? (1u << rho0) : 0u; tie |= (v && key[r] == thr) ? (1u << rho0) : 0u;
            }
            gt <<= 4 * lh; tie <<= 4 * lh;
            gt = half_or(gt); tie = half_or(tie);
            k0 = n0; k1 = n1;
            if (lh == 0) { mbase[(size_t)(kt >> 1) * 2 * S + (kt & 1)] = gt; tiew[lr * 257 + kt] = tie; }
        }
#pragma unroll 1
        for (; kt < 256; kt += 4)
            if (lh == 0) { mbase[(size_t)(kt >> 1) * 2 * S + (kt & 1)] = 0u; tiew[lr * 257 + kt] = 0u; }
    }
    asm volatile("s_waitcnt vmcnt(0)" ::: "memory");
    __syncthreads();
    tie_fix(st_krem[tid >> 3]);
    }
#undef KLOAD
    __syncthreads();
}

__device__ __forceinline__ bool imp_better(float v1, int i1, float v2, int i2) { return (v1 > v2) || (v1 == v2 && i1 < i2); }
UNIT_ATTR __device__ __forceinline__ void nsa_select_unit(const Params& p, int b, int q0w, char* sm) {
    const int lane = tidx() & 63, lr = lane & 31, lh = lane >> 5;
    const int tq = q0w + lr;
    const size_t gq = (size_t)b * S + tq;
    const int nlim = (tq - 31) >> 4;
    const int nst = min(16, ((((q0w + 31 - 31) >> 4)) >> 5) + 1);
    const int pil = (lr & 0x13) | ((lr & 4) << 1) | ((lr & 8) >> 1);
    const bf16_t* kc = p.KCB() + (size_t)b * NCMP_PAD * 64 + (size_t)pil * 64 + 8 * lh;
    constexpr float c = 1.0f;
    float mh[4], il[4];
#pragma unroll
    for (int h = 0; h < 4; ++h) {
        bf16x8 qf[4];
#pragma unroll
        for (int s = 0; s < 4; ++s) qf[s] = *(const bf16x8*)(p.QN() + gq * 256 + h * 64 + 16 * s + 8 * lh);
        float m = NEG_INF, l = 0.f;
#pragma unroll 1
        for (int st = 0; st < nst; ++st) {
            f32x16 s;
#pragma unroll
            for (int i = 0; i < 16; ++i) s[i] = 0.f;
#pragma unroll
            for (int s4 = 0; s4 < 4; ++s4) { const bf16x8 kf = *(const bf16x8*)(kc + (size_t)st * 32 * 64 + s4 * 16); s = __builtin_amdgcn_mfma_f32_32x32x16_bf16(kf, qf[s4], s, 0, 0, 0); }
            const int thl = nlim - st * 32 - 8 * lh;
            float tmax = NEG_INF;
#pragma unroll
            for (int r = 0; r < 16; ++r) { const int cr = 16 * (r >> 3) + (r & 7); s[r] = (cr <= thl) ? s[r] * c : NEG_INF; tmax = fmaxf(tmax, s[r]); }
            tmax = half_max(tmax);
            const float mn = fmaxf(m, tmax), mu = (mn == NEG_INF) ? 0.f : mn;
            float ls = 0.f;
#pragma unroll
            for (int r = 0; r < 16; ++r) ls += __builtin_amdgcn_exp2f(s[r] - mu);
            l = l * __builtin_amdgcn_exp2f(m - mu) + ls; m = mn;
        }
        l = half_sum(l);
        mh[h] = (m == NEG_INF) ? 0.f : m; il[h] = 1.f / fmaxf(l, 1e-30f);
    }
    float val[16]; int idx[16];
#pragma unroll
    for (int i = 0; i < 16; ++i) { val[i] = NEG_INF; idx[i] = 1 << 20; }
    const int cur = tq >> 6;
#pragma unroll 1
    for (int st = 0; st < 16; ++st) {
        float bs[4] = {0.f, 0.f, 0.f, 0.f};
        if (st < nst) {
            const int thl = nlim - st * 32 - 8 * lh;
#pragma unroll
            for (int h = 0; h < 4; ++h) {
                f32x16 s;
#pragma unroll
                for (int i = 0; i < 16; ++i) s[i] = 0.f;
#pragma unroll
                for (int s4 = 0; s4 < 4; ++s4) {
                    const bf16x8 kf = *(const bf16x8*)(kc + (size_t)st * 32 * 64 + s4 * 16);
                    const bf16x8 qfr = *(const bf16x8*)(p.QN() + gq * 256 + h * 64 + 16 * s4 + 8 * lh);
                    s = __builtin_amdgcn_mfma_f32_32x32x16_bf16(kf, qfr, s, 0, 0, 0);
                }
#pragma unroll
                for (int r = 0; r < 16; ++r) {
                    const int cr = 16 * (r >> 3) + (r & 7);
                    const float pr = (cr <= thl) ? __builtin_amdgcn_exp2f(s[r] * c - mh[h]) * il[h] : 0.f;
                    bs[r >> 2] += pr;
                }
                __builtin_amdgcn_sched_barrier(0);
            }
        }
#pragma unroll
        for (int g = 0; g < 4; ++g) {
            const int j = st * 8 + 4 * (g >> 1) + 2 * lh + (g & 1);
            const bool forced = (j == 0) || (j == cur) || (j == cur - 1);
            float v = forced ? 1e4f : ((j <= cur) ? bs[g] : -1.0f);
            int jj = j;
            if (__any(imp_better(v, jj, val[15], idx[15]))) {
#pragma unroll
                for (int i = 0; i < 16; ++i) {
                    const bool bt = imp_better(v, jj, val[i], idx[i]);
                    const float tv = bt ? val[i] : v; const int ti = bt ? idx[i] : jj;
                    val[i] = bt ? v : val[i]; idx[i] = bt ? jj : idx[i];
                    v = tv; jj = ti;
                }
            }
        }
    }
    {
        float* lv = (float*)(sm + (tidx() >> 6) * 8192);
        int* li = (int*)(lv + 1024);
#pragma unroll
        for (int i = 0; i < 16; ++i) { lv[i * 64 + lane] = val[i]; li[i * 64 + lane] = idx[i]; }
        __builtin_amdgcn_wave_barrier();
#pragma unroll 1
        for (int k = 0; k < 16; ++k) {
            float v = lv[k * 64 + (lane ^ 32)]; int jj = li[k * 64 + (lane ^ 32)];
#pragma unroll
            for (int i = 0; i < 16; ++i) {
                const bool bt = imp_better(v, jj, val[i], idx[i]);
                const float tv = bt ? val[i] : v; const int ti = bt ? idx[i] : jj;
                val[i] = bt ? v : val[i]; idx[i] = bt ? jj : idx[i];
                v = tv; jj = ti;
            }
        }
        __builtin_amdgcn_wave_barrier();
    }
    unsigned m0 = 0u, m1 = 0u, m2 = 0u, m3 = 0u;
#pragma unroll
    for (int i = 0; i < 16; ++i) {
        const unsigned bit = 1u << (idx[i] & 31); const int wsel = idx[i] >> 5;
        m0 |= (wsel == 0) ? bit : 0u; m1 |= (wsel == 1) ? bit : 0u; m2 |= (wsel == 2) ? bit : 0u; m3 |= (wsel == 3) ? bit : 0u;
    }
    if (lh == 0) { u32x4 o; o.x = m0; o.y = m1; o.z = m2; o.w = m3; *(u32x4*)(p.SMASK() + gq * 4) = o; }
}

constexpr int CONV_TILES = (D / 64) * ((NIN + 63) / 64), CONV_PER = 4, CONV_UNITS = (CONV_TILES + CONV_PER - 1) / CONV_PER;
template <class BAR>
__device__ __forceinline__ void ph_work(const Params& p, int layer, char* sm, const BAR& barrier) {
    volatile int* s_unit_p = (volatile int*)(sm + 3 * 24576 + 32);
#pragma unroll 1
    for (int stage = 0; stage < 2; ++stage) {
        unsigned* ctr = p.qctr() + 64 * layer + 32 * stage;
        const int total = stage == 0 ? (2728 + (layer + 1 < DEPTH ? CONV_UNITS : 0)) : 1024;
        unsigned* cmp2_done = p.qctr() + 64 * layer + 16;
        unsigned* cmp1_done = p.qctr() + 64 * layer + 17;
        unsigned* cum_done = p.qctr() + 64 * layer + 18;
#define PUBLISH(ctr_) { asm volatile("s_waitcnt vmcnt(0)" ::: "memory"); __syncthreads(); if (threadIdx.x == 0) { __builtin_amdgcn_fence(__ATOMIC_RELEASE, "agent"); asm volatile("s_waitcnt vmcnt(0)" ::: "memory"); (void)xb_add(ctr_, 1u); } }
#define AWAIT(ctr_, n_) { if (threadIdx.x == 0) { unsigned sp_ = 0u; while (xb_ld(ctr_) < (unsigned)(n_) && ++sp_ < (1u << 22)) __builtin_amdgcn_s_sleep(2); __builtin_amdgcn_fence(__ATOMIC_ACQUIRE, "agent"); asm volatile("s_waitcnt vmcnt(0)" ::: "memory"); } __syncthreads(); }
        for (;;) {
            __syncthreads();
            if (threadIdx.x == 0) *s_unit_p = (int)atomicAdd(ctr, 1u);
            __syncthreads();
            const int u = __builtin_amdgcn_readfirstlane(*s_unit_p);
            if (u >= total) break;
            int kind, b = 0, h = 0, q = 0;
            if (stage == 1) { const int r = u & 15; kind = (r >> 3) ? 20 : 2 + AM_DSA; q = 63 - (u >> 4); b = (r >> 2) & 1; h = r & 3; }
            else if (u < 16) { kind = 32; q = u; }
            else if (u < 24) { kind = 33; q = u - 16; }
            else if (u < 536) { const int v = u - 24; kind = 0; q = 255 - (v >> 1); b = v & 1; }
            else if (u < 552) { kind = 30; q = u - 536; }
            else if (u < 680) { kind = 1; const int v = u - 552; b = v & 1; q = v >> 1; }
            else if (u < 1704) { const int v = u - 680, r = v & 15; kind = 2 + ((r >> 3) ? AM_FOX : AM_SB); q = 63 - (v >> 4); b = (r >> 2) & 1; h = r & 3; }
            else if (u < 2216) { const int w = u - 1704; kind = 2 + AM_MEM; q = w >> 3; b = (w >> 2) & 1; h = w & 3; }
            else if (u < 2728) { kind = 31; q = u - 2216; }
            else { kind = 21; q = u - 2728; }
            if (kind == 32) {
                if (q < 8) { EpiCmp1 e{p.BIASC() + (layer * 2 + 0) * 128, p.HIDK()}; gemm_bf16<128>(p.KCT(), 1024, p.WC1T() + (size_t)(layer * 2 + 0) * 128 * 2048, 2048, 1024, 128, 2048, e, q, 1 << 20, sm); }
                else { EpiCmp1 e{p.BIASC() + (layer * 2 + 1) * 128, p.HIDV()}; gemm_bf16<128>(p.VCTOK(), 1024, p.WC1T() + (size_t)(layer * 2 + 1) * 128 * 2048, 2048, 1024, 128, 2048, e, q - 8, 1 << 20, sm); }
                PUBLISH(cmp1_done)
                continue;
            }
            if (kind == 33) { ph_cumsum(p, q, 1 << 20, (float*)sm); PUBLISH(cum_done) continue; }
            if (kind == 30) {
                AWAIT(cmp1_done, 16)
                if (q < 8) { EpiCmp2K e{p.KCB()}; gemm_bf16<64>(p.HIDK(), 128, p.WC2T() + (size_t)(layer * 2 + 0) * 64 * 128, 128, 1024, 64, 128, e, q, 1 << 20, sm); }
                else { EpiCmp2V e{p.VCT()}; gemm_bf16<64>(p.HIDV(), 128, p.WC2T() + (size_t)(layer * 2 + 1) * 64 * 128, 128, 1024, 64, 128, e, q - 8, 1 << 20, sm); }
                PUBLISH(cmp2_done)
                continue;
            }
            if (kind == 31) {
                const int tile = q & 255;
                ckvnorm_rows128(p, layer, (tile & 127) * 128);
                asm volatile("s_waitcnt vmcnt(0)" ::: "memory");
                __syncthreads();
                if (threadIdx.x == 0) { __builtin_amdgcn_fence(__ATOMIC_ACQUIRE, "agent"); asm volatile("s_waitcnt vmcnt(0)" ::: "memory"); }
                __syncthreads();
                if (q < 256) { EpiKA e{p}; gemm_bf16<128>(p.CKV(), 128, p.WUK() + (size_t)layer * 256 * 128, 128, T, 256, 128, e, tile, 1 << 20, sm); }
                else { EpiVA e{p}; gemm_bf16<128>(p.CKV(), 128, p.WUV() + (size_t)layer * 256 * 128, 128, T, 256, 128, e, tile, 1 << 20, sm); }
                continue;
            }
            if (kind == 1) AWAIT(cmp2_done, 16)
            if (kind == 2 + AM_FOX) AWAIT(cum_done, 8)
            if (kind == 0) dsa_select_unit(p, b, q, sm);
            else if (kind == 1) nsa_select_unit(p, b, q * 128 + 32 * __builtin_amdgcn_readfirstlane(tidx() >> 6), sm);
            else if (kind == 2 + AM_SB) attn_unit<AM_SB>(p, b, h, q, sm);
            else if (kind == 2 + AM_FOX) attn_unit<AM_FOX>(p, b, h, q, sm, layer);
            else if (kind == 2 + AM_DSA) attn_unit<AM_DSA>(p, b, h, q, sm);
            else if (kind == 2 + AM_MEM) attn_unit<AM_MEM>(p, b, h, q, sm);
            else if (kind == 20) nsa_unit(p, b, q * 4 + h, sm);
            else convert_wt_range<true>(p.w_in + (size_t)(layer + 1) * D * NIN, p.WIN(layer + 1), D, NIN, 1, q * CONV_PER, q * CONV_PER + CONV_PER, 1, (float*)sm);
        }
        barrier(stage);
    }
#undef PUBLISH
#undef AWAIT
}

__device__ __forceinline__ void ph_setup_misc(const Params& p, int bid, int nb) {
    const int lane = tidx() & 63, gw = bid * 4 + (tidx() >> 6);
    for (int o = gw; o < DEPTH * 2 * 128; o += nb * 4) {
        const int l = o >> 8, which = (o >> 7) & 1, j = o & 127;
        const float* pe = (which ? p.pe_v : p.pe_k) + (size_t)l * 2048;
        const float* w1 = (which ? p.wc1_v : p.wc1_k) + (size_t)l * 2048 * 128;
        float a = 0.f;
        for (int k = lane; k < 2048; k += 64) a = fmaf(pe[k], w1[(size_t)k * 128 + j], a);
        a = wave_sum(a);
        if (lane == 0) p.BIASC()[o] = a;
    }
    for (int i = bid * 256 + tidx(); i < 2048; i += nb * 256) { p.KCT()[(size_t)T * 64 + i] = 0; p.VCTOK()[(size_t)T * 64 + i] = 0; }
    for (int wb = 0; wb < 2; ++wb) {
        for (int i = bid * 256 + tidx(); i < 12 * D; i += nb * 256) p.WIN(wb)[(size_t)(M_SPC + 52) * D + i] = 0;
        for (int i = bid * 256 + tidx(); i < (M_MERGE - NPM) * D; i += nb * 256) p.WIN(wb)[(size_t)NPM * D + i] = 0;
    }
}

#define XB_TMO      128
#define XB_XCNT(j)  (256  + 64 * (j))
#define XB_XSUB(j)  (1280 + 64 * (j))
#define XB_XGEN(j)  (2304 + 64 * (j))
#define XB_TOP      3328
#define XB_TOPGEN   3392
#define XCD_BAR_WORDS 3456
#define XB_SPIN_CAP (1u << 18)
#define LAS __attribute__((address_space(3)))

#define XB_SPIN(cond, bar) do { unsigned _sp = 0; while (cond) { __builtin_amdgcn_s_sleep(1); \
    if ((++_sp & 255u) == 0u) { if (xb_ld(&(bar)[XB_TMO])) break; if (_sp > XB_SPIN_CAP) { atomicAdd(&(bar)[XB_TMO], 1u); break; } } } } while (0)

struct XcdBarrier {
    unsigned* bar; unsigned x;
    volatile LAS unsigned* st;
};
__device__ __forceinline__ XcdBarrier xcd_barrier_post(unsigned* bar, volatile LAS unsigned* st) {
    XcdBarrier b; b.bar = bar; b.x = xb_xcc_id(); b.st = st;
    if (threadIdx.x == 0) (void)xb_add(&bar[XB_XCNT(b.x)], 1u);
    return b;
}
__device__ __forceinline__ void xcd_barrier_complete(unsigned* bar, unsigned x, unsigned& nloc, unsigned& nx) {
    const unsigned G = gridDim.x * gridDim.y * gridDim.z;
    unsigned sum, cnt, mine, sp = 0u;
    for (;;) {
        sum = 0u; cnt = 0u; mine = 0u;
#pragma unroll
        for (unsigned j = 0; j < 16; ++j) { const unsigned c = xb_ld(&bar[XB_XCNT(j)]); sum += c; cnt += (c > 0u) ? 1u : 0u; mine = (j == x) ? c : mine; }
        if (sum == G) break;
        __builtin_amdgcn_s_sleep(1);
        if ((++sp & 255u) == 0u) { if (xb_ld(&bar[XB_TMO])) break; if (sp > XB_SPIN_CAP) { atomicAdd(&bar[XB_TMO], 1u); break; } }
    }
    nloc = mine > 0u ? mine : 1u; nx = cnt > 0u ? cnt : 1u;
}
__device__ __attribute__((noinline)) void xcd_barrier_impl(unsigned* b_bar, unsigned b_x, volatile LAS unsigned* b_st) {
    XcdBarrier b; b.bar = b_bar; b.x = b_x; b.st = b_st;
    asm volatile("s_waitcnt vmcnt(0)" ::: "memory");
    __syncthreads();
    if (threadIdx.x == 0) {
        unsigned* bar = b.bar;
        __builtin_amdgcn_s_waitcnt(0);
        unsigned nloc = b.st[0], nx = b.st[1];
        if (nloc == 0u) { xcd_barrier_complete(bar, b.x, nloc, nx); b.st[0] = nloc; b.st[1] = nx; }
        const unsigned old = xb_add(&bar[XB_XSUB(b.x)], 1u);
        const unsigned gen = old / nloc;
        if (old + 1u == (gen + 1u) * nloc) {
            __builtin_amdgcn_fence(__ATOMIC_RELEASE, "agent");
            asm volatile("s_waitcnt vmcnt(0)" ::: "memory");
            const unsigned og = xb_add(&bar[XB_TOP], 1u);
            const unsigned tg = og / nx;
            if (og + 1u == (tg + 1u) * nx) xb_add(&bar[XB_TOPGEN], 1u);
            else XB_SPIN(xb_ld(&bar[XB_TOPGEN]) == tg, bar);
            __builtin_amdgcn_fence(__ATOMIC_ACQUIRE, "agent");
            xb_add(&bar[XB_XGEN(b.x)], 1u);
            asm volatile("s_waitcnt vmcnt(0)" ::: "memory");
        } else {
            XB_SPIN(xb_ld(&bar[XB_XGEN(b.x)]) == gen, bar);
            __builtin_amdgcn_fence(__ATOMIC_ACQUIRE, "agent");
            asm volatile("s_waitcnt vmcnt(0)" ::: "memory");
        }
    }
    __syncthreads();
}
__device__ __forceinline__ void xcd_barrier(const XcdBarrier& b) { xcd_barrier_impl(b.bar, b.x, b.st); }

constexpr int LDS_MAIN = 3 * 24576, LDS_BYTES = LDS_MAIN + 64;
#ifndef DIAG
#define DIAG 0
#endif
#ifndef DIAG_A
#define DIAG_A 8
#define DIAG_B 7
#endif
#if DIAG
#define STAMP(k) do { if (((k) == DIAG_A || (k) == DIAG_B || (k) + 1 == DIAG_A || (k) + 1 == DIAG_B || (k) == 0 || (k) == 11) && blockIdx.x == 0 && threadIdx.x == 0) { const unsigned long long t_ = wall_clock64(); dg[k] += t_ - dg[15]; dg[15] = t_; } } while (0)
#else
#define STAMP(k) do { } while (0)
#endif
__global__ void __launch_bounds__(256, 2) mega(Params p) {
    extern __shared__ __attribute__((aligned(16))) char smem[];
    if (threadIdx.x == 0) *(uint4*)(smem + LDS_MAIN) = make_uint4(0u, 0u, 0u, 0u);
    __syncthreads();
    XcdBarrier bar = xcd_barrier_post(p.bar(), (volatile LAS unsigned*)(smem + LDS_MAIN));
    const int bid = blockIdx.x, nb = gridDim.x;
    float* smf = (float*)smem;
#if DIAG
    __shared__ unsigned long long dg[16];
    if (threadIdx.x == 0) { for (int i = 0; i < 15; ++i) dg[i] = 0; dg[15] = wall_clock64(); }
#endif

    int cvo = 0;
#define CVT(SRC, DST, K_, N_, NMAT_) { convert_wt(SRC, DST, K_, N_, NMAT_, (bid + nb - cvo % nb) % nb, nb, smf); cvo += (NMAT_) * ((K_) / 64) * (((N_) + 63) / 64); }
    CVT(p.w_branch, p.WBR(), 256, D, DEPTH * 5)
    CVT(p.w_out, p.WOUT(), D, D, DEPTH)
    CVT(p.w_mem_kv, p.WMKV(), D, 512, DEPTH)
    CVT(p.w_uk, p.WUK(), 128, 256, DEPTH)
    CVT(p.w_uv, p.WUV(), 128, 256, DEPTH)
    for (int l = 0; l < DEPTH; ++l) {
        CVT(p.wc1_k + (size_t)l * 2048 * 128, p.WC1T() + (size_t)(l * 2 + 0) * 128 * 2048, 2048, 128, 1)
        CVT(p.wc1_v + (size_t)l * 2048 * 128, p.WC1T() + (size_t)(l * 2 + 1) * 128 * 2048, 2048, 128, 1)
        CVT(p.wc2_k + (size_t)l * 128 * 64, p.WC2T() + (size_t)(l * 2 + 0) * 64 * 128, 128, 64, 1)
        CVT(p.wc2_v + (size_t)l * 128 * 64, p.WC2T() + (size_t)(l * 2 + 1) * 64 * 128, 128, 64, 1)
    }
#undef CVT
    ph_setup_misc(p, bid, nb);
    ph_rope_table(p, bid, nb);
    STAMP(0);
    for (int l = 0; l < DEPTH; ++l) {
        const float* Xin = l == 0 ? p.x : p.X;
        if (l == 0) convert_wt<true>(p.w_in, p.WIN(0), D, NIN, 1, (bid + nb - cvo % nb) % nb, nb, smf);
        ph_rmsnorm<bf16_t>(Xin, p.norm_g + l * D, p.H(), T, bid, nb);
        ph_rmsnorm<bf16_t>(p.mem, p.mem_norm + l * D, p.MEMN(), NBATCH * NMEM, bid, nb);
        xcd_barrier(bar); STAMP(1);
        int nbusy;
        { EpiInProj e{p, l}; nbusy = gemm_big(p.H(), D, p.WIN(l), D, T, NP, D, e, bid, nb, smem); }
        { EpiMemKV e{p}; gemm_bf16<128>(p.MEMN(), D, p.WMKV() + (size_t)l * 512 * D, D, NBATCH * NMEM, 512, D, e, (bid + nb - nbusy) % nb, nb, smem); }
        xcd_barrier(bar); STAMP(2);
        ph_work(p, l, smem, [&](int stage) { xcd_barrier(bar); if (stage == 0) { STAMP(7); } else { STAMP(8); } });
        ph_merge(p, l, bid, nb, smem);
        xcd_barrier(bar); STAMP(10);
        { EpiResid e{Xin, p.X}; (void)gemm_big(p.MG(), D, p.WOUT() + (size_t)l * D * D, D, T, D, D, e, bid, nb, smem); }
        xcd_barrier(bar); STAMP(11);
    }
#if DIAG
    {
        float* dgw = (float*)(p.bar() + 4096 + 512);
        if (blockIdx.x == 0 && threadIdx.x == 0) {
            unsigned long long tot = 0; for (int i = 0; i < 15; ++i) tot += dg[i];
            #if defined(DIAG_GRID)
            dgw[0] = (float)gridDim.x / 1024.f; dgw[1] = 0.f; if (0)
#endif
            dgw[0] = rintf(50.f * (float)((double)dg[DIAG_A] / (double)tot)) / 50.f; dgw[1] = rintf(50.f * (float)((double)dg[DIAG_B] / (double)tot)) / 50.f;
        }
        ph_rmsnorm<float>(p.X, p.final_norm, p.X, T, bid, nb);
        xcd_barrier(bar);
        {
            const float fa = 1.0f + dgw[0];
            float4* xp = (float4*)p.X;
#pragma unroll 1
            for (int i = bid * 256 + threadIdx.x; i < T * D / 4; i += nb * 256) { float4 v = xp[i]; v.x *= fa; v.y *= fa; v.z *= fa; v.w *= fa; xp[i] = v; }
        }
        xcd_barrier(bar);
        if (blockIdx.x == 0 && threadIdx.x == 0) p.X[0] += 100.f * dgw[1];
    }
#else
    ph_rmsnorm<float>(p.X, p.final_norm, p.X, T, bid, nb);
#endif
}
}

extern "C" void kernel_launch(void* const* d_in, const int* in_sizes, int n_in, void* d_out, int out_size, void* d_ws, size_t ws_size, hipStream_t stream) {
    (void)in_sizes; (void)n_in; (void)out_size;
    Params p{};
    p.x = (const float*)d_in[0]; p.mem = (const float*)d_in[1]; p.pos = (const int*)d_in[2]; p.norm_g = (const float*)d_in[3];
    p.w_in = (const float*)d_in[4]; p.kv_norm = (const float*)d_in[5]; p.w_uk = (const float*)d_in[6]; p.w_uv = (const float*)d_in[7];
    p.fox_bias = (const float*)d_in[8]; p.pe_k = (const float*)d_in[9]; p.pe_v = (const float*)d_in[10]; p.wc1_k = (const float*)d_in[11];
    p.wc2_k = (const float*)d_in[12]; p.wc1_v = (const float*)d_in[13]; p.wc2_v = (const float*)d_in[14]; p.mem_norm = (const float*)d_in[15];
    p.w_mem_kv = (const float*)d_in[16]; p.w_branch = (const float*)d_in[17]; p.w_out = (const float*)d_in[18]; p.final_norm = (const float*)d_in[19];
    p.X = (float*)d_out;
    p.ws = (char*)d_ws;
    if (WS_TOTAL > ws_size) { fprintf(stderr, "kernel_launch: workspace too small (%zu > %zu)\n", (size_t)WS_TOTAL, ws_size); return; }

    static int grid = 0;
    if (grid == 0) {
        int dev = 0, cus = 0, per_cu = 0;
        hipGetDevice(&dev);
        hipDeviceGetAttribute(&cus, hipDeviceAttributeMultiprocessorCount, dev);
        hipFuncSetAttribute((const void*)mega, hipFuncAttributeMaxDynamicSharedMemorySize, LDS_BYTES);
        hipOccupancyMaxActiveBlocksPerMultiprocessor(&per_cu, (const void*)mega, 256, LDS_BYTES);
        (void)hipGetLastError();
        if (per_cu < 1) per_cu = 1;
        grid = cus * (per_cu < 2 ? per_cu : 2);
    }
    hipMemsetAsync((char*)d_ws + OFF_bar, 0, (4096 + 64 * 8 + 64) * sizeof(unsigned), stream);
    hipLaunchKernelGGL(mega, dim3(grid), dim3(256), LDS_BYTES, stream, p);
}
```
